# Optimizing an MI355X kernel written in HIP

```python
import math
import jax, jax.numpy as jnp
from jax import lax
import numpy as np

D_MODEL = 1024
BATCH = 2
SEQ = 8192
DEPTH = 4
DEC_BATCH = 8
DEC_SEQ = 16
PAST_LEN = 4096

CHUNK = 64
N_META = 16
CONV_K = 4
EPS = 1e-6
N_SSD = (DEPTH + 1) // 2
N_GDN = DEPTH // 2
SSD_INNER = 2 * D_MODEL
SSD_HEADDIM = 64
SSD_HEADS = SSD_INNER // SSD_HEADDIM
SSD_GROUPS = 4
SSD_STATE = 128
SSD_CONV_DIM = SSD_INNER + 2 * SSD_GROUPS * SSD_STATE
SSD_IN_DIM = SSD_INNER + SSD_CONV_DIM + SSD_HEADS
GDN_DK = 128
GDN_DV = 256
GDN_HEADS = D_MODEL // GDN_DK
GDN_KEY_DIM = GDN_HEADS * GDN_DK
GDN_VAL_DIM = GDN_HEADS * GDN_DV
GDN_CONV_DIM = 2 * GDN_KEY_DIM + GDN_VAL_DIM
GDN_IN_DIM = GDN_CONV_DIM + GDN_VAL_DIM + 2 * GDN_HEADS

kernel_name = 'hybrid_ssd_gdn_stream'


def rmsnorm(x, w):
    x32 = x.astype(jnp.float32)
    y = x32 * lax.rsqrt(jnp.mean(x32 * x32, axis=-1, keepdims=True) + EPS)
    return (y * w.astype(jnp.float32)).astype(x.dtype)


def causal_conv(u, buf, w, b):
    T = u.shape[1]
    xp = jnp.concatenate([buf.astype(u.dtype), u], axis=1)
    out = xp[:, 0:T] * w[0]
    for k in range(1, CONV_K):
        out = out + xp[:, k:k + T] * w[k]
    if b is not None:
        out = out + b
    return out, xp[:, -(CONV_K - 1):]


def _segments(T, with_meta):
    if with_meta:
        return ((0, N_META, N_META), (N_META, T, CHUNK))
    return ((0, T, min(T, CHUNK)),)


def ssd_scan(xs, dt, a, bm, cm, h0, L):
    Bz, T, H, P = xs.shape
    G, N = bm.shape[2], bm.shape[3]
    R = H // G
    C = T // L
    xc = xs.reshape(Bz, C, L, G, R, P)
    dtc = dt.reshape(Bz, C, L, G, R)
    bc = bm.reshape(Bz, C, L, G, N)
    cc = cm.reshape(Bz, C, L, G, N)
    cs = jnp.cumsum(dtc * a.reshape(G, R), axis=2)
    incl = jnp.tril(jnp.ones((L, L), dtype=bool))[:, :, None, None]
    seg = cs[:, :, :, None] - cs[:, :, None, :]
    decay = jnp.where(incl, jnp.exp(jnp.where(incl, seg, 0.0)), 0.0)
    xdt = xc * dtc[..., None]
    cb = jnp.einsum('bclgn,bcsgn->bclsg', cc, bc)
    y_diag = jnp.einsum('bclsg,bclsgr,bcsgrp->bclgrp', cb, decay, xdt)
    cs_last = cs[:, :, -1]
    chunk_states = jnp.einsum('bcsgn,bcsgr,bcsgrp->bcgrpn', bc, jnp.exp(cs_last[:, :, None] - cs), xdt)

    def step(h, inp):
        dec, add = inp
        return h * dec[..., None, None] + add, h

    h_fin, h_prev = lax.scan(step, h0.reshape(Bz, G, R, P, N),
                             (jnp.moveaxis(jnp.exp(cs_last), 1, 0), jnp.moveaxis(chunk_states, 1, 0)))
    h_prev = jnp.moveaxis(h_prev, 0, 1)
    y_off = jnp.einsum('bclgn,bcgrpn,bclgr->bclgrp', cc, h_prev, jnp.exp(cs))
    y = (y_diag + y_off).reshape(Bz, T, H, P)
    return y, h_fin.reshape(Bz, H, P, N)


def gdn_scan(q, k, v, g, beta, h0, L):
    Bz, T, H, K = q.shape
    V = v.shape[-1]
    C = T // L
    to_blk = lambda t: jnp.swapaxes(t.reshape(Bz, C, L, H, t.shape[-1]), 2, 3)
    qc, kc, vc = to_blk(q), to_blk(k), to_blk(v)
    gc = jnp.cumsum(jnp.swapaxes(g.reshape(Bz, C, L, H), 2, 3), axis=-1)
    bc = jnp.swapaxes(beta.reshape(Bz, C, L, H), 2, 3)[..., None]
    incl = jnp.tril(jnp.ones((L, L), dtype=bool))
    strict = jnp.tril(jnp.ones((L, L), dtype=bool), -1)
    gdiff = gc[..., :, None] - gc[..., None, :]
    dec = jnp.where(incl, jnp.exp(jnp.where(incl, gdiff, 0.0)), 0.0)
    kb = kc * bc
    a_mat = jnp.where(strict, jnp.einsum('bchlk,bchsk->bchls', kb, kc) * dec, 0.0) + jnp.eye(L, dtype=q.dtype)
    u = lax.linalg.triangular_solve(a_mat, vc * bc, left_side=True, lower=True, unit_diagonal=True)
    w = lax.linalg.triangular_solve(a_mat, kb * jnp.exp(gc)[..., None], left_side=True, lower=True, unit_diagonal=True)
    qk = jnp.einsum('bchlk,bchsk->bchls', qc, kc) * dec
    q_g = qc * jnp.exp(gc)[..., None]
    g_last = gc[..., -1]
    k_g = kc * jnp.exp(g_last[..., None] - gc)[..., None]

    def step(S, inp):
        u_c, w_c, qg_c, qk_c, kg_c, gl_c = inp
        v_new = u_c - jnp.einsum('bhlk,bhkv->bhlv', w_c, S)
        o = jnp.einsum('bhlk,bhkv->bhlv', qg_c, S) + jnp.einsum('bhls,bhsv->bhlv', qk_c, v_new)
        S = S * jnp.exp(gl_c)[..., None, None] + jnp.einsum('bhlk,bhlv->bhkv', kg_c, v_new)
        return S, o

    mv = lambda t: jnp.moveaxis(t, 1, 0)
    S_fin, o = lax.scan(step, h0, (mv(u), mv(w), mv(q_g), mv(qk), mv(k_g), mv(g_last)))
    o = jnp.swapaxes(jnp.moveaxis(o, 0, 1), 2, 3).reshape(Bz, T, H, V)
    return o, S_fin


def ssd_layer(h, conv_buf, ssm_state, with_meta, norm_w, w_in, conv_w, conv_b, dt_bias, a_log, d_skip, gnorm_w, w_out):
    Bz, T, _ = h.shape
    proj = rmsnorm(h, norm_w) @ w_in
    z = proj[..., :SSD_INNER]
    xbc = proj[..., SSD_INNER:SSD_INNER + SSD_CONV_DIM]
    dt_raw = proj[..., SSD_INNER + SSD_CONV_DIM:]
    xbc, new_buf = causal_conv(xbc, conv_buf, conv_w, conv_b)
    xbc = jax.nn.silu(xbc).astype(jnp.float32)
    xs = xbc[..., :SSD_INNER].reshape(Bz, T, SSD_HEADS, SSD_HEADDIM)
    bm = xbc[..., SSD_INNER:SSD_INNER + SSD_GROUPS * SSD_STATE].reshape(Bz, T, SSD_GROUPS, SSD_STATE)
    cm = xbc[..., SSD_INNER + SSD_GROUPS * SSD_STATE:].reshape(Bz, T, SSD_GROUPS, SSD_STATE)
    dt = jax.nn.softplus(dt_raw.astype(jnp.float32) + dt_bias.astype(jnp.float32))
    a = -jnp.exp(a_log.astype(jnp.float32))
    st = ssm_state.astype(jnp.float32)
    ys = []
    for (s, e, L) in _segments(T, with_meta):
        y_s, st = ssd_scan(xs[:, s:e], dt[:, s:e], a, bm[:, s:e], cm[:, s:e], st, L)
        ys.append(y_s)
    y = jnp.concatenate(ys, axis=1) + xs * d_skip.astype(jnp.float32)[:, None]
    yg = y.reshape(Bz, T, SSD_INNER) * jax.nn.silu(z.astype(jnp.float32))
    yg = yg.reshape(Bz, T, SSD_GROUPS, SSD_INNER // SSD_GROUPS)
    yg = yg * lax.rsqrt(jnp.mean(yg * yg, axis=-1, keepdims=True) + EPS)
    yg = (yg.reshape(Bz, T, SSD_INNER) * gnorm_w.astype(jnp.float32)).astype(h.dtype)
    return h + yg @ w_out, new_buf, st


def _l2norm(t):
    return t * lax.rsqrt(jnp.sum(t * t, axis=-1, keepdims=True) + EPS)


def gdn_layer(h, conv_buf, S0, with_meta, norm_w, w_in, conv_w, dt_bias, a_log, onorm_w, w_out):
    Bz, T, _ = h.shape
    proj = rmsnorm(h, norm_w) @ w_in
    qkv = proj[..., :GDN_CONV_DIM]
    z = proj[..., GDN_CONV_DIM:GDN_CONV_DIM + GDN_VAL_DIM]
    a_raw = proj[..., GDN_CONV_DIM + GDN_VAL_DIM:GDN_CONV_DIM + GDN_VAL_DIM + GDN_HEADS]
    b_raw = proj[..., GDN_CONV_DIM + GDN_VAL_DIM + GDN_HEADS:]
    qkv, new_buf = causal_conv(qkv, conv_buf, conv_w, None)
    qkv = jax.nn.silu(qkv).astype(jnp.float32)
    q = _l2norm(qkv[..., :GDN_KEY_DIM].reshape(Bz, T, GDN_HEADS, GDN_DK)) * (GDN_DK ** -0.5)
    k = _l2norm(qkv[..., GDN_KEY_DIM:2 * GDN_KEY_DIM].reshape(Bz, T, GDN_HEADS, GDN_DK))
    v = qkv[..., 2 * GDN_KEY_DIM:].reshape(Bz, T, GDN_HEADS, GDN_DV)
    g = -jnp.exp(a_log.astype(jnp.float32)) * jax.nn.softplus(a_raw.astype(jnp.float32) + dt_bias.astype(jnp.float32))
    beta = jax.nn.sigmoid(b_raw.astype(jnp.float32))
    st = S0.astype(jnp.float32)
    os_ = []
    for (s, e, L) in _segments(T, with_meta):
        o_s, st = gdn_scan(q[:, s:e], k[:, s:e], v[:, s:e], g[:, s:e], beta[:, s:e], st, L)
        os_.append(o_s)
    o = jnp.concatenate(os_, axis=1)
    o = o * lax.rsqrt(jnp.mean(o * o, axis=-1, keepdims=True) + EPS) * onorm_w.astype(jnp.float32)
    o = o * jax.nn.silu(z.astype(jnp.float32)).reshape(Bz, T, GDN_HEADS, GDN_DV)
    o = o.reshape(Bz, T, GDN_VAL_DIM).astype(h.dtype)
    return h + o @ w_out, new_buf, st


def setup_inputs(seed: int = 0) -> dict:
    key = jax.random.key(seed)
    ks = jax.random.split(key, 32)

    def nrm(k, shape, scale):
        return jax.random.normal(k, shape, jnp.float32) * scale

    def dt_bias_init(k, shape):
        u = jax.random.uniform(k, shape, jnp.float32)
        dt = jnp.exp(math.log(1e-3) + u * (math.log(1e-1) - math.log(1e-3)))
        return dt + jnp.log(-jnp.expm1(-dt))

    return {
        'x_prompt': nrm(ks[0], (BATCH, SEQ, D_MODEL), 1.0),
        'x_sample': nrm(ks[1], (DEC_BATCH, DEC_SEQ, D_MODEL), 1.0),
        'state_ssd': nrm(ks[2], (N_SSD, DEC_BATCH, SSD_HEADS, SSD_HEADDIM, SSD_STATE), 0.1),
        'state_ssd_conv': nrm(ks[3], (N_SSD, DEC_BATCH, CONV_K - 1, SSD_CONV_DIM), 1.0),
        'state_gdn': nrm(ks[4], (N_GDN, DEC_BATCH, GDN_HEADS, GDN_DK, GDN_DV), 0.1),
        'state_gdn_conv': nrm(ks[5], (N_GDN, DEC_BATCH, CONV_K - 1, GDN_CONV_DIM), 1.0),
        'meta_tokens': nrm(ks[6], (N_META, D_MODEL), 1.0),
        'ssd_norm_w': 1.0 + nrm(ks[7], (N_SSD, D_MODEL), 0.02),
        'ssd_w_in': nrm(ks[8], (N_SSD, D_MODEL, SSD_IN_DIM), D_MODEL ** -0.5),
        'ssd_conv_w': nrm(ks[9], (N_SSD, CONV_K, SSD_CONV_DIM), CONV_K ** -0.5),
        'ssd_conv_b': nrm(ks[10], (N_SSD, SSD_CONV_DIM), 0.02),
        'ssd_dt_bias': dt_bias_init(ks[11], (N_SSD, SSD_HEADS)),
        'ssd_a_log': jnp.log(jax.random.uniform(ks[12], (N_SSD, SSD_HEADS), jnp.float32, 1.0, 16.0)),
        'ssd_d': 1.0 + nrm(ks[13], (N_SSD, SSD_HEADS), 0.02),
        'ssd_gnorm_w': 1.0 + nrm(ks[14], (N_SSD, SSD_INNER), 0.02),
        'ssd_w_out': nrm(ks[15], (N_SSD, SSD_INNER, D_MODEL), SSD_INNER ** -0.5),
        'gdn_norm_w': 1.0 + nrm(ks[16], (N_GDN, D_MODEL), 0.02),
        'gdn_w_in': nrm(ks[17], (N_GDN, D_MODEL, GDN_IN_DIM), D_MODEL ** -0.5),
        'gdn_conv_w': nrm(ks[18], (N_GDN, CONV_K, GDN_CONV_DIM), CONV_K ** -0.5),
        'gdn_dt_bias': dt_bias_init(ks[19], (N_GDN, GDN_HEADS)),
        'gdn_a_log': jnp.log(jax.random.uniform(ks[20], (N_GDN, GDN_HEADS), jnp.float32, 1.0, 16.0)),
        'gdn_onorm_w': 1.0 + nrm(ks[21], (N_GDN, GDN_DV), 0.02),
        'gdn_w_out': nrm(ks[22], (N_GDN, GDN_VAL_DIM, D_MODEL), GDN_VAL_DIM ** -0.5),
        'final_norm_w': 1.0 + nrm(ks[23], (D_MODEL,), 0.02),
    }


def reference(x_prompt, x_sample, state_ssd, state_ssd_conv, state_gdn, state_gdn_conv, meta_tokens,
              ssd_norm_w, ssd_w_in, ssd_conv_w, ssd_conv_b, ssd_dt_bias, ssd_a_log, ssd_d, ssd_gnorm_w, ssd_w_out,
              gdn_norm_w, gdn_w_in, gdn_conv_w, gdn_dt_bias, gdn_a_log, gdn_onorm_w, gdn_w_out, final_norm_w):
    Bp = x_prompt.shape[0]
    meta = jnp.broadcast_to(meta_tokens.astype(x_prompt.dtype)[None], (Bp, N_META, D_MODEL))
    hp = jnp.concatenate([meta, x_prompt], axis=1)
    hs = x_sample
    p_ssd, p_ssd_conv, p_gdn, p_gdn_conv = [], [], [], []
    s_ssd, s_ssd_conv, s_gdn, s_gdn_conv = [], [], [], []
    for i in range(DEPTH):
        j = i // 2
        if i % 2 == 0:
            w = (ssd_norm_w[j], ssd_w_in[j], ssd_conv_w[j], ssd_conv_b[j], ssd_dt_bias[j], ssd_a_log[j],
                 ssd_d[j], ssd_gnorm_w[j], ssd_w_out[j])
            zb = jnp.zeros((Bp, CONV_K - 1, SSD_CONV_DIM), hp.dtype)
            zs = jnp.zeros((Bp, SSD_HEADS, SSD_HEADDIM, SSD_STATE), jnp.float32)
            hp, cb, st = ssd_layer(hp, zb, zs, True, *w)
            p_ssd.append(st.astype(state_ssd.dtype))
            p_ssd_conv.append(cb.astype(state_ssd_conv.dtype))
            hs, cb, st = ssd_layer(hs, state_ssd_conv[j], state_ssd[j], False, *w)
            s_ssd.append(st.astype(state_ssd.dtype))
            s_ssd_conv.append(cb.astype(state_ssd_conv.dtype))
        else:
            w = (gdn_norm_w[j], gdn_w_in[j], gdn_conv_w[j], gdn_dt_bias[j], gdn_a_log[j], gdn_onorm_w[j], gdn_w_out[j])
            zb = jnp.zeros((Bp, CONV_K - 1, GDN_CONV_DIM), hp.dtype)
            zs = jnp.zeros((Bp, GDN_HEADS, GDN_DK, GDN_DV), jnp.float32)
            hp, cb, st = gdn_layer(hp, zb, zs, True, *w)
            p_gdn.append(st.astype(state_gdn.dtype))
            p_gdn_conv.append(cb.astype(state_gdn_conv.dtype))
            hs, cb, st = gdn_layer(hs, state_gdn_conv[j], state_gdn[j], False, *w)
            s_gdn.append(st.astype(state_gdn.dtype))
            s_gdn_conv.append(cb.astype(state_gdn_conv.dtype))
    y_prompt = rmsnorm(hp, final_norm_w)[:, N_META:]
    y_sample = rmsnorm(hs, final_norm_w)
    return (y_prompt, y_sample,
            jnp.stack(p_ssd), jnp.stack(p_ssd_conv), jnp.stack(p_gdn), jnp.stack(p_gdn_conv),
            jnp.stack(s_ssd), jnp.stack(s_ssd_conv), jnp.stack(s_gdn), jnp.stack(s_gdn_conv))
```

```cpp
#include <hip/hip_runtime.h>
#include <hip/hip_cooperative_groups.h>
#include <cstdio>
#include <cstdint>
namespace cg = cooperative_groups;

#define LAS __attribute__((address_space(3)))
typedef unsigned short bf16_t;
typedef short bf16x8 __attribute__((ext_vector_type(8)));
typedef float f32x4 __attribute__((ext_vector_type(4)));
typedef unsigned u32x4 __attribute__((ext_vector_type(4)));
typedef unsigned u32x2 __attribute__((ext_vector_type(2)));

constexpr int D = 1024;
constexpr int SEQ = 8192, NMETA = 16, PADF = 48;
constexpr int TPP = 8256;
constexpr int ROW_S0 = 2 * TPP;
constexpr int M_TOT = ROW_S0 + 128;
constexpr int NSEQ = 10;
constexpr float EPS = 1e-6f;
constexpr int LDP = 6144;
constexpr int SSD_INNER = 2048, SSD_HEADS = 32, SSD_P = 64, SSD_N = 128, SSD_CONV = 3072, SSD_IN = 5152, SSD_IN_PAD = 5376;
constexpr int GDN_HEADS = 8, GDN_DK = 128, GDN_DV = 256, GDN_CONV = 4096, GDN_VAL = 2048, GDN_IN = 6160, GDN_IN_PAD = 6400;

constexpr size_t O_YP = 0, O_YS = 16777216, O_PSSD = 16908288, O_PSSDC = 17956864, O_PGDN = 17993728, O_PGDNC = 19042304,
                 O_SSSD = 19091456, O_SSSDC = 23285760, O_SGDN = 23433216, O_SGDNC = 27627520;

constexpr size_t WS_CTL = 0;
constexpr size_t WS_HB = 65536;
constexpr size_t WS_WIN = WS_HB + (size_t)M_TOT * D * 2;
constexpr size_t WS_WOUT = WS_WIN + (size_t)GDN_IN_PAD * D * 2;
constexpr size_t WS_DTB = WS_WOUT + (size_t)1024 * 2048 * 2;
constexpr size_t WS_RSS = WS_DTB + (size_t)M_TOT * 32 * 4;
constexpr size_t WS_PROJ = WS_RSS + (size_t)M_TOT * 16 * 4;
constexpr size_t WS_END = WS_PROJ + (size_t)M_TOT * LDP * 2;

constexpr int NTHREADS = 512;
constexpr int LDS_BYTES = 147456;

__device__ __forceinline__ float bf2f(bf16_t b) { return __uint_as_float(((unsigned)b) << 16); }
__device__ __forceinline__ bf16_t f2bf(float f) { unsigned u = __float_as_uint(f); u += 0x7FFFu + ((u >> 16) & 1u); return (bf16_t)(u >> 16); }
__device__ __forceinline__ unsigned cvt_pk_bf16(float lo, float hi) { unsigned r; asm("v_cvt_pk_bf16_f32 %0, %1, %2" : "=v"(r) : "v"(lo), "v"(hi)); return r; }
__device__ __forceinline__ float silu_f(float x) { return x / (1.0f + __expf(-x)); }
__device__ __forceinline__ float softplus_f(float x) { return x > 20.f ? x : log1pf(__expf(x)); }
__device__ __forceinline__ float wave_sum(float v) {
#pragma unroll
    for (int o = 32; o >= 1; o >>= 1) v += __shfl_xor(v, o);
    return v;
}
__device__ __forceinline__ int seq_base(int s) { return s < 2 ? s * TPP + 64 - NMETA : ROW_S0 + 16 * (s - 2); }
__device__ __forceinline__ int seq_len(int s) { return s < 2 ? SEQ + NMETA : 16; }
__device__ __forceinline__ int seq_chunks(int s) { return s < 2 ? 129 : 1; }

namespace pg8 {
constexpr int BM = 256, BK = 64, HALF = 128, HTB = HALF * BK * 2, STAGE_BYTES = 8 * HTB, NXCD = 8, WGM = 8;
__device__ __forceinline__ int lds_byte(int r, int c) { const int st = (r >> 4) * 2 + (c >> 5), rr = r & 15, cc = c & 31, ob = rr * 64 + cc * 2; return st * 1024 + (ob ^ (((ob >> 9) & 1) << 5)); }
__device__ __forceinline__ void stage_rc(int b, int& R, int& C) { const int st = b / 1024, sb = b % 1024, swz = sb ^ (((sb >> 9) & 1) << 5); R = (st >> 1) * 16 + swz / 64; C = (st & 1) * 32 + (swz % 64) / 2; }
__device__ __forceinline__ int perm32(int rho) { const int n = rho >> 4, i = rho & 15; return 8 * (i >> 2) + 4 * n + (i & 3); }
struct Unit { int pm, pn; };
struct Gemm { const bf16_t* A; const bf16_t* Bt; int M, N, K, lda, ldb; };
struct StaticOrder {
    int nM, nN, nwg, G, c;
    __device__ void init(int M, int N, int G_, int c_) { nM = M / BM; nN = N / BM; nwg = nM * nN; G = G_; c = c_; }
    __device__ bool next(int i, Unit& u) const {
        const long L = (long)i * G + c; if (L >= nwg) return false;
        int wgid = (int)L; { const int q = nwg / NXCD, r = nwg % NXCD, xcd = wgid % NXCD, off = wgid / NXCD; wgid = (xcd < r ? xcd * (q + 1) : r * (q + 1) + (xcd - r) * q) + off; }
        const int nig = WGM * nN, gid = wgid / nig, fm = gid * WGM, gsz = (nM - fm) < WGM ? (nM - fm) : WGM;
        u.pm = fm + ((wgid % nig) % gsz); u.pn = (wgid % nig) / gsz; return true;
    }
};

template <class Epi>
__device__ __forceinline__ void gemm_phase(LAS unsigned char* lds, const Gemm g, const StaticOrder& S, const Epi& E, const int tid) {
    const int wid = __builtin_amdgcn_readfirstlane(tid >> 6), lane = tid & 63, wr = wid >> 2, wc = wid & 3, fr = lane & 15, fq = lane >> 4;
    const int K = g.K, nt = K / BK;
    unsigned voffA[2], voffB[2];
#pragma unroll
    for (int i = 0; i < 2; ++i) { int R, C; stage_rc(tid * 16 + i * 8192, R, C); const int Rb = Epi::PERM ? ((R & ~31) + perm32(R & 31)) : R;
        voffA[i] = (unsigned)(R * g.lda + C) * 2u; voffB[i] = (unsigned)(Rb * g.ldb + C) * 2u; }
    const size_t kstep = (size_t)(BK * 2);
    const size_t hstepA = (size_t)HALF * g.lda * 2, hstepB = (size_t)HALF * g.ldb * 2;
    const size_t tstepA = 2 * hstepA, tstepB = 2 * hstepB;
    const unsigned ldsw = (unsigned)wid * 1024u;
    const int aoff = lds_byte(wr * 64 + fr, fq * 8), boff = lds_byte(wc * 32 + fr, fq * 8);
#define PG8_SA(b, h) (((b) * 2 + (h)) * HTB)
#define PG8_SB(b, h) ((4 + (b) * 2 + (h)) * HTB)
#define PG8_STAGE(bufoff, gbase, voff) do { _Pragma("unroll") for (int _i = 0; _i < 2; ++_i) \
        __builtin_amdgcn_global_load_lds((const unsigned*)((const char*)(gbase) + (voff)[_i]), (LAS unsigned*)(lds + (bufoff) + ldsw + _i * 8192), 16, 0, 0); } while (0)
#define PG8_LDA(dst, b, h) do { _Pragma("unroll") for (int m = 0; m < 4; ++m) _Pragma("unroll") for (int k = 0; k < 2; ++k) dst[m][k] = *(const LAS bf16x8*)(lds + PG8_SA(b, h) + aoff + m * 2048 + k * 1024); } while (0)
#define PG8_LDB(dst, b, h) do { _Pragma("unroll") for (int n = 0; n < 2; ++n) _Pragma("unroll") for (int k = 0; k < 2; ++k) dst[n][k] = *(const LAS bf16x8*)(lds + PG8_SB(b, h) + boff + n * 2048 + k * 1024); } while (0)
#define PG8_MMA(ai, bj, At, Bt) do { __builtin_amdgcn_s_setprio(1); _Pragma("unroll") for (int m = 0; m < 4; ++m) _Pragma("unroll") for (int n = 0; n < 2; ++n) _Pragma("unroll") for (int k = 0; k < 2; ++k) \
        acc[ai][bj][m][n] = __builtin_amdgcn_mfma_f32_16x16x32_bf16(Bt[n][k], At[m][k], acc[ai][bj][m][n], 0, 0, 0); __builtin_amdgcn_s_setprio(0); } while (0)
#define PG8_WAIT_V(n) asm volatile("s_waitcnt vmcnt(" #n ")" ::: "memory")
#define PG8_WAIT_L(n) asm volatile("s_waitcnt lgkmcnt(" #n ")" ::: "memory")
#define PG8_BAR __builtin_amdgcn_s_barrier()
#define PG8_SCHED __builtin_amdgcn_sched_barrier(0)
    Unit cur, nxt; int ui = 0;
    if (!S.next(0, cur)) return;
    f32x4 acc[2][2][4][2];
#pragma unroll
    for (int a = 0; a < 2; ++a)
#pragma unroll
        for (int b = 0; b < 2; ++b)
#pragma unroll
            for (int m = 0; m < 4; ++m)
#pragma unroll
                for (int n = 0; n < 2; ++n) acc[a][b][m][n] = (f32x4){0.f, 0.f, 0.f, 0.f};
    bf16x8 At[4][2], B0[2][2], B1[2][2];
    const char* cA = (const char*)g.A + (size_t)cur.pm * tstepA; const char* cB = (const char*)g.Bt + (size_t)cur.pn * tstepB;
    PG8_STAGE(PG8_SB(0, 0), cB, voffB); PG8_STAGE(PG8_SA(0, 0), cA, voffA); PG8_STAGE(PG8_SB(0, 1), cB + hstepB, voffB); PG8_STAGE(PG8_SA(0, 1), cA + hstepA, voffA);
    if (wr == 1) PG8_BAR;
    PG8_WAIT_V(4); PG8_BAR;
    PG8_STAGE(PG8_SB(1, 0), cB + kstep, voffB); PG8_STAGE(PG8_SA(1, 0), cA + kstep, voffA); PG8_STAGE(PG8_SB(1, 1), cB + hstepB + kstep, voffB);
    PG8_WAIT_V(6); PG8_BAR;
    for (;;) {
        const bool has_next = S.next(ui + 1, nxt);
        const char* nA = has_next ? (const char*)g.A + (size_t)nxt.pm * tstepA : cA; const char* nB = has_next ? (const char*)g.Bt + (size_t)nxt.pn * tstepB : cB;
        for (int t = 0; t < nt; t += 2) {
            const bool last = (t == nt - 2);
            const char* a1 = cA + (size_t)(t + 1) * kstep;
            const char* a2 = last ? nA : cA + (size_t)(t + 2) * kstep; const char* b2 = last ? nB : cB + (size_t)(t + 2) * kstep;
            const char* a3 = a2 + kstep; const char* b3 = b2 + kstep;
            PG8_LDB(B0, 0, 0); PG8_SCHED; PG8_LDA(At, 0, 0); PG8_STAGE(PG8_SA(1, 1), a1 + hstepA, voffA);
            PG8_WAIT_L(8); PG8_BAR; PG8_WAIT_L(0); PG8_MMA(0, 0, At, B0); PG8_BAR; PG8_SCHED;
            PG8_LDB(B1, 0, 1); PG8_STAGE(PG8_SB(0, 0), b2, voffB);
            PG8_BAR; PG8_WAIT_L(0); PG8_MMA(0, 1, At, B1); PG8_BAR;
            PG8_LDA(At, 0, 1); PG8_STAGE(PG8_SA(0, 0), a2, voffA);
            PG8_BAR; PG8_WAIT_L(0); PG8_MMA(1, 0, At, B0); PG8_BAR; PG8_SCHED;
            PG8_STAGE(PG8_SB(0, 1), b2 + hstepB, voffB);
            PG8_WAIT_V(6); PG8_BAR; PG8_MMA(1, 1, At, B1); PG8_BAR;
            PG8_LDB(B0, 1, 0); PG8_SCHED; PG8_LDA(At, 1, 0); PG8_STAGE(PG8_SA(0, 1), a2 + hstepA, voffA);
            PG8_WAIT_L(8); PG8_BAR; PG8_WAIT_L(0); PG8_MMA(0, 0, At, B0); PG8_BAR; PG8_SCHED;
            PG8_LDB(B1, 1, 1); PG8_STAGE(PG8_SB(1, 0), b3, voffB);
            PG8_BAR; PG8_WAIT_L(0); PG8_MMA(0, 1, At, B1); PG8_BAR;
            PG8_LDA(At, 1, 1); PG8_STAGE(PG8_SA(1, 0), a3, voffA);
            PG8_BAR; PG8_WAIT_L(0); PG8_MMA(1, 0, At, B0); PG8_BAR; PG8_SCHED;
            PG8_STAGE(PG8_SB(1, 1), b3 + hstepB, voffB);
            PG8_WAIT_V(6); PG8_BAR; PG8_MMA(1, 1, At, B1); PG8_BAR;
        }
        E(acc, cur, wr, wc, fr, fq);
        if (!has_next) break;
#pragma unroll
        for (int a = 0; a < 2; ++a)
#pragma unroll
            for (int b = 0; b < 2; ++b)
#pragma unroll
                for (int m = 0; m < 4; ++m)
#pragma unroll
                    for (int n = 0; n < 2; ++n) acc[a][b][m][n] = (f32x4){0.f, 0.f, 0.f, 0.f};
        cur = nxt; cA = nA; cB = nB; ++ui;
    }
    PG8_WAIT_V(0);
    if (wr == 0) PG8_BAR;
    PG8_BAR;
#undef PG8_SA
#undef PG8_SB
#undef PG8_STAGE
#undef PG8_LDA
#undef PG8_LDB
#undef PG8_MMA
#undef PG8_WAIT_V
#undef PG8_WAIT_L
#undef PG8_BAR
#undef PG8_SCHED
}

struct EpiInProj {
    static constexpr bool PERM = true;
    bf16_t* proj; float* dtb; const float* rowss; int nt_main;
    __device__ __forceinline__ void operator()(const f32x4 (&acc)[2][2][4][2], const Unit& u, int wr, int wc, int fr, int fq) const {
        const int row0 = u.pm * BM + wr * 64 + fr;
#pragma unroll
        for (int ai = 0; ai < 2; ++ai)
#pragma unroll
            for (int m = 0; m < 4; ++m) {
                const int r = row0 + ai * HALF + m * 16;
                const f32x4* rp = (const f32x4*)(rowss + (size_t)r * 16);
                const f32x4 p0 = rp[0], p1 = rp[1], p2 = rp[2], p3 = rp[3];
                const float ss = ((p0[0] + p0[1]) + (p0[2] + p0[3])) + ((p1[0] + p1[1]) + (p1[2] + p1[3])) + ((p2[0] + p2[1]) + (p2[2] + p2[3])) + ((p3[0] + p3[1]) + (p3[2] + p3[3]));
                const float rstd = rsqrtf(ss * (1.0f / 1024.0f) + EPS);
                if (u.pn < nt_main) {
                    bf16_t* rowp = proj + (size_t)r * LDP + u.pn * BM + wc * 32 + 8 * fq;
#pragma unroll
                    for (int bj = 0; bj < 2; ++bj) { const f32x4 v0 = acc[ai][bj][m][0] * rstd, v1 = acc[ai][bj][m][1] * rstd;
                        u32x4 w; w.x = cvt_pk_bf16(v0[0], v0[1]); w.y = cvt_pk_bf16(v0[2], v0[3]); w.z = cvt_pk_bf16(v1[0], v1[1]); w.w = cvt_pk_bf16(v1[2], v1[3]);
                        *(u32x4*)(rowp + bj * HALF) = w; }
                } else if (wc == 0) {
                    float* dp = dtb + (size_t)r * 32 + 8 * fq;
                    *(f32x4*)(dp) = acc[ai][0][m][0] * rstd; *(f32x4*)(dp + 4) = acc[ai][0][m][1] * rstd;
                }
            }
    }
};
struct EpiOutProj {
    static constexpr bool PERM = false;
    bf16_t* hb; float* rowss;
    __device__ __forceinline__ void operator()(const f32x4 (&acc)[2][2][4][2], const Unit& u, int wr, int wc, int fr, int fq) const {
        const int row0 = u.pm * BM + wr * 64 + fr, col0 = u.pn * BM + wc * 32 + 4 * fq;
#pragma unroll
        for (int ai = 0; ai < 2; ++ai)
#pragma unroll
            for (int m = 0; m < 4; ++m) {
                const int r = row0 + ai * HALF + m * 16; float ss = 0.f;
                bf16_t* rowp = hb + (size_t)r * D + col0;
#pragma unroll
                for (int bj = 0; bj < 2; ++bj)
#pragma unroll
                    for (int n = 0; n < 2; ++n) {
                        u32x2* p = (u32x2*)(rowp + bj * HALF + n * 16); const u32x2 o = *p;
                        const f32x4 a = acc[ai][bj][m][n];
                        const float h0 = __uint_as_float(o.x << 16) + a[0], h1 = __uint_as_float(o.x & 0xffff0000u) + a[1];
                        const float h2 = __uint_as_float(o.y << 16) + a[2], h3 = __uint_as_float(o.y & 0xffff0000u) + a[3];
                        ss += (h0 * h0 + h1 * h1) + (h2 * h2 + h3 * h3);
                        u32x2 w; w.x = cvt_pk_bf16(h0, h1); w.y = cvt_pk_bf16(h2, h3); *p = w;
                    }
                ss += __shfl_xor(ss, 16); ss += __shfl_xor(ss, 32);
                if (fq == 0) rowss[(size_t)r * 16 + u.pn * 4 + wc] = ss;
            }
    }
};
}

struct Args { const float* in[24]; float* out; unsigned char* ws; int ph_lo, ph_hi; };

struct Frame {
    const Args* ap; float* out; unsigned char* ws;
    __device__ __forceinline__ const float* inp(int i) const { asm volatile("" : "+s"(i)); return ap->in[i]; }
    unsigned char* lds; LAS unsigned char* ldsl;
    int tid, lane, wave, G, bid;
    bf16_t* hb; bf16_t* win; bf16_t* wout; float* dtb; float* rss; bf16_t* proj;
};

__device__ __forceinline__ Frame relaunder(Frame F) {
    int t = F.tid; asm volatile("" : "+v"(t));
    F.tid = t; F.lane = t & 63; F.wave = __builtin_amdgcn_readfirstlane(t >> 6);
    unsigned char* w = F.ws; asm volatile("" : "+s"(w));
    F.ws = w; F.hb = (bf16_t*)(w + WS_HB); F.win = (bf16_t*)(w + WS_WIN); F.wout = (bf16_t*)(w + WS_WOUT);
    F.dtb = (float*)(w + WS_DTB); F.rss = (float*)(w + WS_RSS); F.proj = (bf16_t*)(w + WS_PROJ);
    return F;
}
__device__ void phase_init_h(const Frame& F0) {
    const Frame F = relaunder(F0);
    const float* xp = F.inp(0); const float* xs = F.inp(1); const float* meta = F.inp(6);
    for (int row = F.bid * 8 + F.wave; row < M_TOT; row += F.G * 8) {
        const float* src = nullptr;
        if (row < ROW_S0) { const int b = row / TPP, r = row % TPP; if (r >= 64) src = xp + ((size_t)b * SEQ + (r - 64)) * D; else if (r >= PADF) src = meta + (size_t)(r - PADF) * D; }
        else src = xs + (size_t)(row - ROW_S0) * D;
        float ss = 0.f;
#pragma unroll
        for (int i = 0; i < 4; ++i) {
            f32x4 v = (f32x4){0.f, 0.f, 0.f, 0.f};
            if (src) v = *(const f32x4*)(src + (F.lane + 64 * i) * 4);
            ss += (v[0] * v[0] + v[1] * v[1]) + (v[2] * v[2] + v[3] * v[3]);
            u32x2 w; w.x = cvt_pk_bf16(v[0], v[1]); w.y = cvt_pk_bf16(v[2], v[3]);
            *(u32x2*)(F.hb + (size_t)row * D + (F.lane + 64 * i) * 4) = w;
        }
        ss = wave_sum(ss);
        if (F.lane < 16) F.rss[(size_t)row * 16 + F.lane] = (F.lane == 0) ? ss : 0.f;
    }
}

__device__ void transpose_convert(const Frame& F, const float* src, int K, int N, int Npad, bf16_t* dst, const float* scale, int smod) {
    float* tile = (float*)F.lds;
    const int ntk = K / 64, ntn = Npad / 64, ntile = ntk * ntn;
    for (int ti = F.bid; ti < ntile; ti += F.G) {
        const int kt = ti % ntk, nt_ = ti / ntk, k0 = kt * 64, n0 = nt_ * 64;
        const int kk = F.tid >> 4, n4 = (F.tid & 15) * 4;
#pragma unroll
        for (int h = 0; h < 2; ++h) {
            const int k = k0 + kk + 32 * h, n = n0 + n4;
            f32x4 v = (f32x4){0.f, 0.f, 0.f, 0.f};
            if (n < N) v = *(const f32x4*)(src + (size_t)k * N + n);
            const float s = scale[k % smod];
            float* tp = tile + (kk + 32 * h) * 65 + n4;
            tp[0] = v[0] * s; tp[1] = v[1] * s; tp[2] = v[2] * s; tp[3] = v[3] * s;
        }
        __syncthreads();
        const int nn = F.tid >> 3, kg = (F.tid & 7) * 8;
        float x[8];
#pragma unroll
        for (int j = 0; j < 8; ++j) x[j] = tile[(kg + j) * 65 + nn];
        u32x4 w; w.x = cvt_pk_bf16(x[0], x[1]); w.y = cvt_pk_bf16(x[2], x[3]); w.z = cvt_pk_bf16(x[4], x[5]); w.w = cvt_pk_bf16(x[6], x[7]);
        *(u32x4*)(dst + (size_t)(n0 + nn) * K + k0 + kg) = w;
        __syncthreads();
    }
}
__device__ void phase_wprep(const Frame& F0, int L) {
    const Frame F = relaunder(F0);
    const int j = L >> 1;
    if ((L & 1) == 0) {
        transpose_convert(F, F.inp(8) + (size_t)j * D * SSD_IN, D, SSD_IN, SSD_IN_PAD, F.win, F.inp(7) + j * D, D);
        transpose_convert(F, F.inp(15) + (size_t)j * SSD_INNER * D, SSD_INNER, D, D, F.wout, F.inp(14) + j * SSD_INNER, SSD_INNER);
    } else {
        transpose_convert(F, F.inp(17) + (size_t)j * D * GDN_IN, D, GDN_IN, GDN_IN_PAD, F.win, F.inp(16) + j * D, D);
        transpose_convert(F, F.inp(22) + (size_t)j * GDN_VAL * D, GDN_VAL, D, D, F.wout, F.inp(21) + j * GDN_DV, GDN_DV);
    }
}

__device__ void phase_inproj(const Frame& F0, int L) {
    const Frame F = relaunder(F0);
    const int npad = (L & 1) ? GDN_IN_PAD : SSD_IN_PAD;
    pg8::Gemm g{F.hb, F.win, M_TOT, npad, D, D, D};
    pg8::StaticOrder S; S.init(M_TOT, npad, F.G, F.bid);
    pg8::EpiInProj E{F.proj, F.dtb, F.rss, npad / 256 - 1};
    pg8::gemm_phase<pg8::EpiInProj>(F.ldsl, g, S, E, F.tid);
}
__device__ void phase_outproj(const Frame& F0, int L) {
    const Frame F = relaunder(F0);
    const bf16_t* A = F.proj + ((L & 1) ? 4096 : 0);
    pg8::Gemm g{A, F.wout, M_TOT, D, 2048, LDP, 2048};
    pg8::StaticOrder S; S.init(M_TOT, D, F.G, F.bid);
    pg8::EpiOutProj E{F.hb, F.rss};
    pg8::gemm_phase<pg8::EpiOutProj>(F.ldsl, g, S, E, F.tid);
}

__device__ void phase_ssd_naive(const Frame& F0, int j) {
    const Frame F = relaunder(F0);
    float* xs = (float*)F.lds;
    float* Bs = xs + 64 * 64;
    float* Cs = Bs + 64 * 128;
    float* dts = Cs + 64 * 128;
    float* das = dts + 64;
    const float* conv_w = F.inp(9) + (size_t)j * 4 * SSD_CONV; const float* conv_b = F.inp(10) + (size_t)j * SSD_CONV;
    const int p = F.tid >> 3, nq = F.tid & 7;
    for (int task = F.bid; task < NSEQ * SSD_HEADS; task += F.G) {
        const int s = task / SSD_HEADS, head = task % SSD_HEADS, grp = head >> 3;
        const int base = seq_base(s), nch = seq_chunks(s);
        const float dt_bias = F.inp(11)[j * SSD_HEADS + head], a = -__expf(F.inp(12)[j * SSD_HEADS + head]), dsk = F.inp(13)[j * SSD_HEADS + head];
        float h[16];
        if (s < 2) {
#pragma unroll
            for (int n = 0; n < 16; ++n) h[n] = 0.f;
        } else {
            const float* st = F.inp(2) + ((((size_t)j * 8 + (s - 2)) * SSD_HEADS + head) * SSD_P + p) * SSD_N + nq * 16;
#pragma unroll
            for (int n = 0; n < 16; ++n) h[n] = st[n];
        }
        int cidx = -1;
        if (F.tid < 64) cidx = head * 64 + F.tid; else if (F.tid < 192) cidx = 2048 + grp * 128 + (F.tid - 64); else if (F.tid < 320) cidx = 2560 + grp * 128 + (F.tid - 192);
        float w0 = 0, w1 = 0, w2 = 0, w3 = 0, cb = 0;
        if (cidx >= 0) { w0 = conv_w[cidx]; w1 = conv_w[SSD_CONV + cidx]; w2 = conv_w[2 * SSD_CONV + cidx]; w3 = conv_w[3 * SSD_CONV + cidx]; cb = conv_b[cidx]; }
        const float* cst = (s >= 2) ? F.inp(3) + (((size_t)j * 8 + (s - 2)) * 3) * SSD_CONV : nullptr;
        for (int c = 0; c < nch; ++c) {
            const int t0 = 64 * c - PADF;
            __syncthreads();
            if (cidx >= 0) {
                float r3, r2, r1;
                {   float rv[3];
#pragma unroll
                    for (int q = 0; q < 3; ++q) { const int t = t0 - 3 + q; float v = 0.f;
                        if (t >= 0) v = bf2f(F.proj[(size_t)(base + t) * LDP + 2048 + cidx]); else if (t >= -3 && cst) v = cst[(3 + t) * SSD_CONV + cidx];
                        rv[q] = v; }
                    r3 = rv[0]; r2 = rv[1]; r1 = rv[2]; }
                for (int i = 0; i < 64; ++i) {
                    const int t = t0 + i; float v = 0.f;
                    if (t >= 0) v = bf2f(F.proj[(size_t)(base + t) * LDP + 2048 + cidx]); else if (t >= -3 && cst) v = cst[(3 + t) * SSD_CONV + cidx];
                    const float o = silu_f(cb + w0 * r3 + w1 * r2 + w2 * r1 + w3 * v);
                    r3 = r2; r2 = r1; r1 = v;
                    if (F.tid < 64) xs[i * 64 + F.tid] = o; else if (F.tid < 192) Bs[i * 128 + (F.tid - 64)] = o; else Cs[i * 128 + (F.tid - 192)] = o;
                }
            } else if (F.tid >= 448) {
                const int i = F.tid - 448, t = t0 + i;
                float dt = 0.f, da = 1.f;
                if (t >= 0) { dt = softplus_f(F.dtb[(size_t)(base + t) * 32 + head] + dt_bias); da = __expf(dt * a); }
                dts[i] = dt; das[i] = da;
            }
            __syncthreads();
            for (int i = 0; i < 64; ++i) {
                const int t = t0 + i;
                const float dt = dts[i], da = das[i], xv = xs[i * 64 + p], dx = dt * xv;
                const float* bp = Bs + i * 128 + nq * 16; const float* cp = Cs + i * 128 + nq * 16;
                float accv = 0.f;
#pragma unroll
                for (int n = 0; n < 16; ++n) { h[n] = h[n] * da + dx * bp[n]; accv += cp[n] * h[n]; }
                accv += __shfl_xor(accv, 1); accv += __shfl_xor(accv, 2); accv += __shfl_xor(accv, 4);
                if (nq == 0 && t >= 0) {
                    bf16_t* zp = F.proj + (size_t)(base + t) * LDP + head * 64 + p;
                    const float z = bf2f(*zp);
                    *zp = f2bf((accv + dsk * xv) * silu_f(z));
                }
            }
        }
        float* so = (s < 2) ? F.out + O_PSSD + ((((size_t)j * 2 + s) * SSD_HEADS + head) * SSD_P + p) * SSD_N + nq * 16
                            : F.out + O_SSSD + ((((size_t)j * 8 + (s - 2)) * SSD_HEADS + head) * SSD_P + p) * SSD_N + nq * 16;
#pragma unroll
        for (int n = 0; n < 16; ++n) so[n] = h[n];
    }
}

__device__ void phase_ssd_post(const Frame& F0, int j) {
    const Frame F = relaunder(F0);
    for (int it = F.bid * 8 + F.wave; it < M_TOT * 4; it += F.G * 8) {
        const int row = it >> 2, grp = it & 3;
        u32x4* p = (u32x4*)(F.proj + (size_t)row * LDP + grp * 512 + F.lane * 8);
        const u32x4 v = *p; float x[8];
        x[0] = __uint_as_float(v.x << 16); x[1] = __uint_as_float(v.x & 0xffff0000u); x[2] = __uint_as_float(v.y << 16); x[3] = __uint_as_float(v.y & 0xffff0000u);
        x[4] = __uint_as_float(v.z << 16); x[5] = __uint_as_float(v.z & 0xffff0000u); x[6] = __uint_as_float(v.w << 16); x[7] = __uint_as_float(v.w & 0xffff0000u);
        float ss = 0.f;
#pragma unroll
        for (int q = 0; q < 8; ++q) ss += x[q] * x[q];
        ss = wave_sum(ss);
        const float rs = rsqrtf(ss * (1.0f / 512.0f) + EPS);
        u32x4 w; w.x = cvt_pk_bf16(x[0] * rs, x[1] * rs); w.y = cvt_pk_bf16(x[2] * rs, x[3] * rs); w.z = cvt_pk_bf16(x[4] * rs, x[5] * rs); w.w = cvt_pk_bf16(x[6] * rs, x[7] * rs);
        *p = w;
    }
    for (int e = F.bid * NTHREADS + F.tid; e < NSEQ * 3 * SSD_CONV; e += F.G * NTHREADS) {
        const int s = e / (3 * SSD_CONV), r = (e / SSD_CONV) % 3, c = e % SSD_CONV;
        const int row = seq_base(s) + seq_len(s) - 3 + r;
        const float v = bf2f(F.proj[(size_t)row * LDP + 2048 + c]);
        if (s < 2) F.out[O_PSSDC + (((size_t)j * 2 + s) * 3 + r) * SSD_CONV + c] = v;
        else F.out[O_SSSDC + (((size_t)j * 8 + (s - 2)) * 3 + r) * SSD_CONV + c] = v;
    }
}

__device__ void phase_gdn_naive(const Frame& F0, int j) {
    const Frame F = relaunder(F0);
    constexpr int QP = 129;
    float* qs = (float*)F.lds;
    float* ks = qs + 64 * QP;
    float* vs = ks + 64 * QP;
    float* gs = vs + 64 * 256;
    float* bs = gs + 64;
    float* qk = bs + 64;
    float* exk = qk + 64;
    float* exq = exk + 2 * 2 * 256;
    float* exv = exq + 2 * 2 * 256;
    const float* conv_w = F.inp(18) + (size_t)j * 4 * GDN_CONV;
    const int v = F.tid & 255, kh = F.tid >> 8;
    for (int task = F.bid; task < NSEQ * GDN_HEADS; task += F.G) {
        const int s = task / GDN_HEADS, head = task % GDN_HEADS;
        const int base = seq_base(s), nch = seq_chunks(s);
        const float dt_bias = F.inp(19)[j * GDN_HEADS + head], aneg = -__expf(F.inp(20)[j * GDN_HEADS + head]);
        float S[64];
        if (s < 2) {
#pragma unroll
            for (int kk = 0; kk < 64; ++kk) S[kk] = 0.f;
        } else {
            const float* st = F.inp(4) + ((((size_t)j * 8 + (s - 2)) * GDN_HEADS + head) * GDN_DK + kh * 64) * GDN_DV + v;
#pragma unroll
            for (int kk = 0; kk < 64; ++kk) S[kk] = st[(size_t)kk * GDN_DV];
        }
        const int cidx = F.tid < 128 ? head * 128 + F.tid : (F.tid < 256 ? 1024 + head * 128 + (F.tid - 128) : 2048 + head * 256 + (F.tid - 256));
        const float w0 = conv_w[cidx], w1 = conv_w[GDN_CONV + cidx], w2 = conv_w[2 * GDN_CONV + cidx], w3 = conv_w[3 * GDN_CONV + cidx];
        const float* cst = (s >= 2) ? F.inp(5) + (((size_t)j * 8 + (s - 2)) * 3) * GDN_CONV : nullptr;
        for (int c = 0; c < nch; ++c) {
            const int t0 = 64 * c - PADF;
            __syncthreads();
            {
                float r3, r2, r1;
                {   float rv[3];
#pragma unroll
                    for (int q = 0; q < 3; ++q) { const int t = t0 - 3 + q; float x = 0.f;
                        if (t >= 0) x = bf2f(F.proj[(size_t)(base + t) * LDP + cidx]); else if (t >= -3 && cst) x = cst[(3 + t) * GDN_CONV + cidx];
                        rv[q] = x; }
                    r3 = rv[0]; r2 = rv[1]; r1 = rv[2]; }
                for (int i = 0; i < 64; ++i) {
                    const int t = t0 + i; float x = 0.f;
                    if (t >= 0) x = bf2f(F.proj[(size_t)(base + t) * LDP + cidx]); else if (t >= -3 && cst) x = cst[(3 + t) * GDN_CONV + cidx];
                    const float o = silu_f(w0 * r3 + w1 * r2 + w2 * r1 + w3 * x);
                    r3 = r2; r2 = r1; r1 = x;
                    if (F.tid < 128) qs[i * QP + F.tid] = o; else if (F.tid < 256) ks[i * QP + (F.tid - 128)] = o; else vs[i * 256 + (F.tid - 256)] = o;
                }
            }
            __syncthreads();
            if (F.tid < 128) {
                const int i = F.tid & 63; float* rowp = (F.tid < 64 ? qs : ks) + i * QP; float ss = 0.f;
                for (int k = 0; k < 128; ++k) ss += rowp[k] * rowp[k];
                const float sc = rsqrtf(ss + EPS) * (F.tid < 64 ? 0.08838834764831845f : 1.0f);
                for (int k = 0; k < 128; ++k) rowp[k] *= sc;
            } else if (F.tid < 192) {
                const int i = F.tid - 128, t = t0 + i; float ga = 1.f, be = 0.f;
                if (t >= 0) { const float* dp = F.dtb + (size_t)(base + t) * 32; ga = __expf(aneg * softplus_f(dp[head] + dt_bias)); be = 1.0f / (1.0f + __expf(-dp[8 + head])); }
                gs[i] = ga; bs[i] = be;
            }
            __syncthreads();
            if (F.tid < 64) { float d = 0.f; for (int k = 0; k < 128; ++k) d += qs[F.tid * QP + k] * ks[F.tid * QP + k]; qk[F.tid] = d; }
            __syncthreads();
            for (int i = 0; i < 64; ++i) {
                const float* kp = ks + i * QP + kh * 64; const float* qp = qs + i * QP + kh * 64;
                float pk = 0.f, pq = 0.f;
#pragma unroll
                for (int kk = 0; kk < 64; ++kk) { pk += kp[kk] * S[kk]; pq += qp[kk] * S[kk]; }
                const int eb = (i & 1) * 512;
                exk[eb + kh * 256 + v] = pk; exq[eb + kh * 256 + v] = pq; if (kh == 0) exv[(i & 1) * 256 + v] = vs[i * 256 + v];
                __syncthreads();
                const float kS = exk[eb + v] + exk[eb + 256 + v], qS = exq[eb + v] + exq[eb + 256 + v], vv = exv[(i & 1) * 256 + v];
                const float ga = gs[i], be = bs[i];
                const float delta = vv - ga * kS;
                const float bd = be * delta;
#pragma unroll
                for (int kk = 0; kk < 64; ++kk) S[kk] = ga * S[kk] + kp[kk] * bd;
                if (kh == 0) vs[i * 256 + v] = ga * qS + qk[i] * bd;
            }
            __syncthreads();
            for (int q = 0; q < 8; ++q) {
                const int i = F.wave * 8 + q, t = t0 + i;
                const f32x4 o = *(const f32x4*)(vs + i * 256 + F.lane * 4);
                float ss = (o[0] * o[0] + o[1] * o[1]) + (o[2] * o[2] + o[3] * o[3]);
                ss = wave_sum(ss);
                const float rs = rsqrtf(ss * (1.0f / 256.0f) + EPS);
                if (t >= 0) {
                    u32x2* zp = (u32x2*)(F.proj + (size_t)(base + t) * LDP + 4096 + head * 256 + F.lane * 4);
                    const u32x2 z = *zp;
                    const float z0 = __uint_as_float(z.x << 16), z1 = __uint_as_float(z.x & 0xffff0000u), z2 = __uint_as_float(z.y << 16), z3 = __uint_as_float(z.y & 0xffff0000u);
                    u32x2 w; w.x = cvt_pk_bf16(o[0] * rs * silu_f(z0), o[1] * rs * silu_f(z1)); w.y = cvt_pk_bf16(o[2] * rs * silu_f(z2), o[3] * rs * silu_f(z3));
                    *zp = w;
                }
            }
        }
        float* so = (s < 2) ? F.out + O_PGDN + ((((size_t)j * 2 + s) * GDN_HEADS + head) * GDN_DK + kh * 64) * GDN_DV + v
                            : F.out + O_SGDN + ((((size_t)j * 8 + (s - 2)) * GDN_HEADS + head) * GDN_DK + kh * 64) * GDN_DV + v;
#pragma unroll
        for (int kk = 0; kk < 64; ++kk) so[(size_t)kk * GDN_DV] = S[kk];
    }
}
__device__ void phase_gdn_post(const Frame& F0, int j) {
    const Frame F = relaunder(F0);
    for (int e = F.bid * NTHREADS + F.tid; e < NSEQ * 3 * GDN_CONV; e += F.G * NTHREADS) {
        const int s = e / (3 * GDN_CONV), r = (e / GDN_CONV) % 3, c = e % GDN_CONV;
        const int row = seq_base(s) + seq_len(s) - 3 + r;
        const float v = bf2f(F.proj[(size_t)row * LDP + c]);
        if (s < 2) F.out[O_PGDNC + (((size_t)j * 2 + s) * 3 + r) * GDN_CONV + c] = v;
        else F.out[O_SGDNC + (((size_t)j * 8 + (s - 2)) * 3 + r) * GDN_CONV + c] = v;
    }
}

__device__ void phase_final(const Frame& F0) {
    const Frame F = relaunder(F0);
    const float* fw = F.inp(23);
    for (int it = F.bid * 8 + F.wave; it < 2 * SEQ + 128; it += F.G * 8) {
        int row; float* dst;
        if (it < 2 * SEQ) { const int b = it / SEQ, t = it % SEQ; row = b * TPP + 64 + t; dst = F.out + O_YP + (size_t)it * D; }
        else { row = ROW_S0 + (it - 2 * SEQ); dst = F.out + O_YS + (size_t)(it - 2 * SEQ) * D; }
        float x[16]; float ss = 0.f;
#pragma unroll
        for (int i = 0; i < 4; ++i) {
            const u32x2 v = *(const u32x2*)(F.hb + (size_t)row * D + (F.lane + 64 * i) * 4);
            x[4 * i + 0] = __uint_as_float(v.x << 16); x[4 * i + 1] = __uint_as_float(v.x & 0xffff0000u); x[4 * i + 2] = __uint_as_float(v.y << 16); x[4 * i + 3] = __uint_as_float(v.y & 0xffff0000u);
            ss += (x[4 * i] * x[4 * i] + x[4 * i + 1] * x[4 * i + 1]) + (x[4 * i + 2] * x[4 * i + 2] + x[4 * i + 3] * x[4 * i + 3]);
        }
        ss = wave_sum(ss);
        const float rs = rsqrtf(ss * (1.0f / 1024.0f) + EPS);
#pragma unroll
        for (int i = 0; i < 4; ++i) {
            const int c = (F.lane + 64 * i) * 4; const f32x4 w = *(const f32x4*)(fw + c);
            f32x4 o; o[0] = x[4 * i] * rs * w[0]; o[1] = x[4 * i + 1] * rs * w[1]; o[2] = x[4 * i + 2] * rs * w[2]; o[3] = x[4 * i + 3] * rs * w[3];
            *(f32x4*)(dst + c) = o;
        }
    }
}

constexpr int N_PHASES = 22;
__global__ void __launch_bounds__(NTHREADS, 2) hybrid_fwd(Args args) {
    extern __shared__ __attribute__((aligned(16))) unsigned char lds[];
#ifndef PHMASK
#define PHMASK 0xFF
#endif
    for (int ph = args.ph_lo; ph < args.ph_hi; ++ph) {
        int tid_ = threadIdx.x; asm volatile("" : "+v"(tid_));
        unsigned char* ws_ = args.ws; asm volatile("" : "+s"(ws_));
        float* out_ = args.out; asm volatile("" : "+s"(out_));
        Frame F;
        F.ap = &args;
        F.out = out_; F.ws = ws_; F.lds = lds; F.ldsl = (LAS unsigned char*)lds;
        F.tid = tid_; F.lane = F.tid & 63; F.wave = __builtin_amdgcn_readfirstlane(F.tid >> 6); F.G = gridDim.x; F.bid = blockIdx.x;
        F.hb = (bf16_t*)(ws_ + WS_HB); F.win = (bf16_t*)(ws_ + WS_WIN); F.wout = (bf16_t*)(ws_ + WS_WOUT);
        F.dtb = (float*)(ws_ + WS_DTB); F.rss = (float*)(ws_ + WS_RSS); F.proj = (bf16_t*)(ws_ + WS_PROJ);
        if (ph == 0) { if (PHMASK & 1) phase_init_h(F); }
        else if (ph == N_PHASES - 1) { if (PHMASK & 1) phase_final(F); }
        else {
            const int L = (ph - 1) / 5, sub = (ph - 1) % 5, j = L >> 1;
            if (sub == 0) { if (PHMASK & 2) phase_wprep(F, L); }
            else if (sub == 1) { if (PHMASK & 4) phase_inproj(F, L); }
            else if (sub == 2) { if (L & 1) { if (PHMASK & 8) phase_gdn_naive(F, j); } else { if (PHMASK & 16) phase_ssd_naive(F, j); } }
            else if (sub == 3) { if (PHMASK & 32) { if (L & 1) phase_gdn_post(F, j); else phase_ssd_post(F, j); } }
            else { if (PHMASK & 64) phase_outproj(F, L); }
        }
    }
}

extern "C" void kernel_launch(void* const* d_in, const int* in_sizes, int n_in, void* d_out, int out_size, void* d_ws, size_t ws_size, hipStream_t stream) {
    static int grid = 0;
    if (grid == 0) {
        if (n_in != 24 || ws_size < WS_END) { fprintf(stderr, "kernel_launch: unexpected n_in %d / ws %zu (need %zu)\n", n_in, ws_size, (size_t)WS_END); grid = -1; return; }
        int dev = 0, cus = 0;
        if (hipGetDevice(&dev) != hipSuccess || hipDeviceGetAttribute(&cus, hipDeviceAttributeMultiprocessorCount, dev) != hipSuccess) { grid = -1; return; }
        if (hipFuncSetAttribute((const void*)hybrid_fwd, hipFuncAttributeMaxDynamicSharedMemorySize, LDS_BYTES) != hipSuccess) { fprintf(stderr, "kernel_launch: hipFuncSetAttribute failed\n"); grid = -1; return; }
        grid = cus;
    }
    if (grid < 0) return;
    Args a{};
    for (int i = 0; i < 24; ++i) a.in[i] = (const float*)d_in[i];
    a.out = (float*)d_out; a.ws = (unsigned char*)d_ws;
    for (int ph = 0; ph < N_PHASES; ++ph) {
        a.ph_lo = ph; a.ph_hi = ph + 1;
        hipLaunchKernelGGL(hybrid_fwd, dim3(grid), dim3(NTHREADS), LDS_BYTES, stream, a);
    }
}
```

```cpp
#include <hip/hip_runtime.h>
#include <hip/hip_cooperative_groups.h>
#include <cstdio>
#include <cstdint>
namespace cg = cooperative_groups;

#define LAS __attribute__((address_space(3)))
typedef unsigned short bf16_t;
typedef short bf16x8 __attribute__((ext_vector_type(8)));
typedef float f32x4 __attribute__((ext_vector_type(4)));
typedef unsigned u32x4 __attribute__((ext_vector_type(4)));
typedef unsigned u32x2 __attribute__((ext_vector_type(2)));

constexpr int D = 1024;
constexpr int SEQ = 8192, NMETA = 16, PADF = 48;
constexpr int TPP = 8256;
constexpr int ROW_S0 = 2 * TPP;
constexpr int M_TOT = ROW_S0 + 128;
constexpr int NSEQ = 10;
constexpr float EPS = 1e-6f;
constexpr int LDP = 6144;
constexpr int SSD_INNER = 2048, SSD_HEADS = 32, SSD_P = 64, SSD_N = 128, SSD_CONV = 3072, SSD_IN = 5152, SSD_IN_PAD = 5376;
constexpr int GDN_HEADS = 8, GDN_DK = 128, GDN_DV = 256, GDN_CONV = 4096, GDN_VAL = 2048, GDN_IN = 6160, GDN_IN_PAD = 6400;

constexpr size_t O_YP = 0, O_YS = 16777216, O_PSSD = 16908288, O_PSSDC = 17956864, O_PGDN = 17993728, O_PGDNC = 19042304,
                 O_SSSD = 19091456, O_SSSDC = 23285760, O_SGDN = 23433216, O_SGDNC = 27627520;

constexpr size_t WS_CTL = 0;
constexpr size_t WS_HB = 65536;
constexpr size_t WS_WIN = WS_HB + (size_t)M_TOT * D * 2;
constexpr size_t WS_WOUT = WS_WIN + (size_t)GDN_IN_PAD * D * 2;
constexpr size_t WS_DTB = WS_WOUT + (size_t)2 * 1024 * 2048 * 2;
constexpr size_t WS_RSS = WS_DTB + (size_t)M_TOT * 32 * 4;
constexpr size_t WS_PROJ = WS_RSS + (size_t)M_TOT * 16 * 4;
constexpr size_t WS_END = WS_PROJ + (size_t)M_TOT * LDP * 2;

constexpr int NTHREADS = 512;
constexpr int LDS_BYTES = 147456;

__device__ __forceinline__ float bf2f(bf16_t b) { return __uint_as_float(((unsigned)b) << 16); }
__device__ __forceinline__ bf16_t f2bf(float f) { unsigned u = __float_as_uint(f); u += 0x7FFFu + ((u >> 16) & 1u); return (bf16_t)(u >> 16); }
__device__ __forceinline__ unsigned cvt_pk_bf16(float lo, float hi) { unsigned r; asm("v_cvt_pk_bf16_f32 %0, %1, %2" : "=v"(r) : "v"(lo), "v"(hi)); return r; }
__device__ __forceinline__ float silu_f(float x) { return x / (1.0f + __expf(-x)); }
__device__ __forceinline__ float softplus_f(float x) { return x > 20.f ? x : log1pf(__expf(x)); }
__device__ __forceinline__ float wave_sum(float v) {
#pragma unroll
    for (int o = 32; o >= 1; o >>= 1) v += __shfl_xor(v, o);
    return v;
}
__device__ __forceinline__ int seq_base(int s) { return s < 2 ? s * TPP + 64 - NMETA : ROW_S0 + 16 * (s - 2); }
__device__ __forceinline__ int seq_len(int s) { return s < 2 ? SEQ + NMETA : 16; }
__device__ __forceinline__ int seq_chunks(int s) { return s < 2 ? 129 : 1; }

namespace pg8 {
constexpr int BM = 256, BK = 64, HALF = 128, HTB = HALF * BK * 2, STAGE_BYTES = 8 * HTB, NXCD = 8, WGM = 8;
__device__ __forceinline__ int lds_byte(int r, int c) { const int st = (r >> 4) * 2 + (c >> 5), rr = r & 15, cc = c & 31, ob = rr * 64 + cc * 2; return st * 1024 + (ob ^ (((ob >> 9) & 1) << 5)); }
__device__ __forceinline__ void stage_rc(int b, int& R, int& C) { const int st = b / 1024, sb = b % 1024, swz = sb ^ (((sb >> 9) & 1) << 5); R = (st >> 1) * 16 + swz / 64; C = (st & 1) * 32 + (swz % 64) / 2; }
__device__ __forceinline__ int perm32(int rho) { const int n = rho >> 4, i = rho & 15; return 8 * (i >> 2) + 4 * n + (i & 3); }
struct Unit { int pm, pn; };
struct Gemm { const bf16_t* A; const bf16_t* Bt; int M, N, K, lda, ldb; };
struct StaticOrder {
    int nM, nN, nwg, G, c;
    __device__ void init(int M, int N, int G_, int c_) { nM = M / BM; nN = N / BM; nwg = nM * nN; G = G_; c = c_; }
    __device__ bool next(int i, Unit& u) const {
        const long L = (long)i * G + c; if (L >= nwg) return false;
        int wgid = (int)L; { const int q = nwg / NXCD, r = nwg % NXCD, xcd = wgid % NXCD, off = wgid / NXCD; wgid = (xcd < r ? xcd * (q + 1) : r * (q + 1) + (xcd - r) * q) + off; }
        const int nig = WGM * nN, gid = wgid / nig, fm = gid * WGM, gsz = (nM - fm) < WGM ? (nM - fm) : WGM;
        u.pm = fm + ((wgid % nig) % gsz); u.pn = (wgid % nig) / gsz; return true;
    }
};

template <class Epi>
__device__ __forceinline__ void gemm_phase(LAS unsigned char* lds, const Gemm g, const StaticOrder& S, const Epi& E, const int tid) {
    const int wid = __builtin_amdgcn_readfirstlane(tid >> 6), lane = tid & 63, wr = wid >> 2, wc = wid & 3, fr = lane & 15, fq = lane >> 4;
    const int K = g.K, nt = K / BK;
    unsigned voffA[2], voffB[2];
#pragma unroll
    for (int i = 0; i < 2; ++i) { int R, C; stage_rc(tid * 16 + i * 8192, R, C); const int Rb = Epi::PERM ? ((R & ~31) + perm32(R & 31)) : R;
        voffA[i] = (unsigned)(R * g.lda + C) * 2u; voffB[i] = (unsigned)(Rb * g.ldb + C) * 2u; }
    const size_t kstep = (size_t)(BK * 2);
    const size_t hstepA = (size_t)HALF * g.lda * 2, hstepB = (size_t)HALF * g.ldb * 2;
    const size_t tstepA = 2 * hstepA, tstepB = 2 * hstepB;
    const unsigned ldsw = (unsigned)wid * 1024u;
    const int aoff = lds_byte(wr * 64 + fr, fq * 8), boff = lds_byte(wc * 32 + fr, fq * 8);
#define PG8_SA(b, h) (((b) * 2 + (h)) * HTB)
#define PG8_SB(b, h) ((4 + (b) * 2 + (h)) * HTB)
#define PG8_STAGE(bufoff, gbase, voff) do { _Pragma("unroll") for (int _i = 0; _i < 2; ++_i) \
        __builtin_amdgcn_global_load_lds((const unsigned*)((const char*)(gbase) + (voff)[_i]), (LAS unsigned*)(lds + (bufoff) + ldsw + _i * 8192), 16, 0, 0); } while (0)
#define PG8_LDA(dst, b, h) do { _Pragma("unroll") for (int m = 0; m < 4; ++m) _Pragma("unroll") for (int k = 0; k < 2; ++k) dst[m][k] = *(const LAS bf16x8*)(lds + PG8_SA(b, h) + aoff + m * 2048 + k * 1024); } while (0)
#define PG8_LDB(dst, b, h) do { _Pragma("unroll") for (int n = 0; n < 2; ++n) _Pragma("unroll") for (int k = 0; k < 2; ++k) dst[n][k] = *(const LAS bf16x8*)(lds + PG8_SB(b, h) + boff + n * 2048 + k * 1024); } while (0)
#define PG8_MMA(ai, bj, At, Bt) do { __builtin_amdgcn_s_setprio(1); _Pragma("unroll") for (int m = 0; m < 4; ++m) _Pragma("unroll") for (int n = 0; n < 2; ++n) _Pragma("unroll") for (int k = 0; k < 2; ++k) \
        acc[ai][bj][m][n] = __builtin_amdgcn_mfma_f32_16x16x32_bf16(Bt[n][k], At[m][k], acc[ai][bj][m][n], 0, 0, 0); __builtin_amdgcn_s_setprio(0); } while (0)
#define PG8_WAIT_V(n) asm volatile("s_waitcnt vmcnt(" #n ")" ::: "memory")
#define PG8_WAIT_L(n) asm volatile("s_waitcnt lgkmcnt(" #n ")" ::: "memory")
#define PG8_BAR __builtin_amdgcn_s_barrier()
#define PG8_SCHED __builtin_amdgcn_sched_barrier(0)
    Unit cur, nxt; int ui = 0;
    if (!S.next(0, cur)) return;
    f32x4 acc[2][2][4][2];
#pragma unroll
    for (int a = 0; a < 2; ++a)
#pragma unroll
        for (int b = 0; b < 2; ++b)
#pragma unroll
            for (int m = 0; m < 4; ++m)
#pragma unroll
                for (int n = 0; n < 2; ++n) acc[a][b][m][n] = (f32x4){0.f, 0.f, 0.f, 0.f};
    bf16x8 At[4][2], B0[2][2], B1[2][2];
    const char* cA = (const char*)g.A + (size_t)cur.pm * tstepA; const char* cB = (const char*)g.Bt + (size_t)cur.pn * tstepB;
    PG8_STAGE(PG8_SB(0, 0), cB, voffB); PG8_STAGE(PG8_SA(0, 0), cA, voffA); PG8_STAGE(PG8_SB(0, 1), cB + hstepB, voffB); PG8_STAGE(PG8_SA(0, 1), cA + hstepA, voffA);
    if (wr == 1) PG8_BAR;
    PG8_WAIT_V(4); PG8_BAR;
    PG8_STAGE(PG8_SB(1, 0), cB + kstep, voffB); PG8_STAGE(PG8_SA(1, 0), cA + kstep, voffA); PG8_STAGE(PG8_SB(1, 1), cB + hstepB + kstep, voffB);
    PG8_WAIT_V(6); PG8_BAR;
    for (;;) {
        const bool has_next = S.next(ui + 1, nxt);
        const char* nA = has_next ? (const char*)g.A + (size_t)nxt.pm * tstepA : cA; const char* nB = has_next ? (const char*)g.Bt + (size_t)nxt.pn * tstepB : cB;
        for (int t = 0; t < nt; t += 2) {
            const bool last = (t == nt - 2);
            const char* a1 = cA + (size_t)(t + 1) * kstep;
            const char* a2 = last ? nA : cA + (size_t)(t + 2) * kstep; const char* b2 = last ? nB : cB + (size_t)(t + 2) * kstep;
            const char* a3 = a2 + kstep; const char* b3 = b2 + kstep;
            PG8_LDB(B0, 0, 0); PG8_SCHED; PG8_LDA(At, 0, 0); PG8_STAGE(PG8_SA(1, 1), a1 + hstepA, voffA);
            PG8_WAIT_L(8); PG8_BAR; PG8_WAIT_L(0); PG8_MMA(0, 0, At, B0); PG8_BAR; PG8_SCHED;
            PG8_LDB(B1, 0, 1); PG8_STAGE(PG8_SB(0, 0), b2, voffB);
            PG8_BAR; PG8_WAIT_L(0); PG8_MMA(0, 1, At, B1); PG8_BAR;
            PG8_LDA(At, 0, 1); PG8_STAGE(PG8_SA(0, 0), a2, voffA);
            PG8_BAR; PG8_WAIT_L(0); PG8_MMA(1, 0, At, B0); PG8_BAR; PG8_SCHED;
            PG8_STAGE(PG8_SB(0, 1), b2 + hstepB, voffB);
            PG8_WAIT_V(6); PG8_BAR; PG8_MMA(1, 1, At, B1); PG8_BAR;
            PG8_LDB(B0, 1, 0); PG8_SCHED; PG8_LDA(At, 1, 0); PG8_STAGE(PG8_SA(0, 1), a2 + hstepA, voffA);
            PG8_WAIT_L(8); PG8_BAR; PG8_WAIT_L(0); PG8_MMA(0, 0, At, B0); PG8_BAR; PG8_SCHED;
            PG8_LDB(B1, 1, 1); PG8_STAGE(PG8_SB(1, 0), b3, voffB);
            PG8_BAR; PG8_WAIT_L(0); PG8_MMA(0, 1, At, B1); PG8_BAR;
            PG8_LDA(At, 1, 1); PG8_STAGE(PG8_SA(1, 0), a3, voffA);
            PG8_BAR; PG8_WAIT_L(0); PG8_MMA(1, 0, At, B0); PG8_BAR; PG8_SCHED;
            PG8_STAGE(PG8_SB(1, 1), b3 + hstepB, voffB);
            PG8_WAIT_V(6); PG8_BAR; PG8_MMA(1, 1, At, B1); PG8_BAR;
        }
        E(acc, cur, wr, wc, fr, fq);
        if (!has_next) break;
#pragma unroll
        for (int a = 0; a < 2; ++a)
#pragma unroll
            for (int b = 0; b < 2; ++b)
#pragma unroll
                for (int m = 0; m < 4; ++m)
#pragma unroll
                    for (int n = 0; n < 2; ++n) acc[a][b][m][n] = (f32x4){0.f, 0.f, 0.f, 0.f};
        cur = nxt; cA = nA; cB = nB; ++ui;
    }
    PG8_WAIT_V(0);
    if (wr == 0) PG8_BAR;
    PG8_BAR;
#undef PG8_SA
#undef PG8_SB
#undef PG8_STAGE
#undef PG8_LDA
#undef PG8_LDB
#undef PG8_MMA
#undef PG8_WAIT_V
#undef PG8_WAIT_L
#undef PG8_BAR
#undef PG8_SCHED
}

struct EpiInProj {
    static constexpr bool PERM = true;
    bf16_t* proj; float* dtb; const float* rowss; int nt_main;
    __device__ __forceinline__ void operator()(const f32x4 (&acc)[2][2][4][2], const Unit& u, int wr, int wc, int fr, int fq) const {
        const int row0 = u.pm * BM + wr * 64 + fr;
#pragma unroll
        for (int ai = 0; ai < 2; ++ai)
#pragma unroll
            for (int m = 0; m < 4; ++m) {
                const int r = row0 + ai * HALF + m * 16;
                const f32x4* rp = (const f32x4*)(rowss + (size_t)r * 16);
                const f32x4 p0 = rp[0], p1 = rp[1], p2 = rp[2], p3 = rp[3];
                const float ss = ((p0[0] + p0[1]) + (p0[2] + p0[3])) + ((p1[0] + p1[1]) + (p1[2] + p1[3])) + ((p2[0] + p2[1]) + (p2[2] + p2[3])) + ((p3[0] + p3[1]) + (p3[2] + p3[3]));
                const float rstd = rsqrtf(ss * (1.0f / 1024.0f) + EPS);
                if (u.pn < nt_main) {
                    bf16_t* rowp = proj + (size_t)r * LDP + u.pn * BM + wc * 32 + 8 * fq;
#pragma unroll
                    for (int bj = 0; bj < 2; ++bj) { const f32x4 v0 = acc[ai][bj][m][0] * rstd, v1 = acc[ai][bj][m][1] * rstd;
                        u32x4 w; w.x = cvt_pk_bf16(v0[0], v0[1]); w.y = cvt_pk_bf16(v0[2], v0[3]); w.z = cvt_pk_bf16(v1[0], v1[1]); w.w = cvt_pk_bf16(v1[2], v1[3]);
                        *(u32x4*)(rowp + bj * HALF) = w; }
                } else if (wc == 0) {
                    float* dp = dtb + (size_t)r * 32 + 8 * fq;
                    *(f32x4*)(dp) = acc[ai][0][m][0] * rstd; *(f32x4*)(dp + 4) = acc[ai][0][m][1] * rstd;
                }
            }
    }
};
struct EpiOutProj {
    static constexpr bool PERM = false;
    bf16_t* hb; float* rowss;
    __device__ __forceinline__ void operator()(const f32x4 (&acc)[2][2][4][2], const Unit& u, int wr, int wc, int fr, int fq) const {
        const int row0 = u.pm * BM + wr * 64 + fr, col0 = u.pn * BM + wc * 32 + 4 * fq;
#pragma unroll
        for (int ai = 0; ai < 2; ++ai)
#pragma unroll
            for (int m = 0; m < 4; ++m) {
                const int r = row0 + ai * HALF + m * 16; float ss = 0.f;
                bf16_t* rowp = hb + (size_t)r * D + col0;
#pragma unroll
                for (int bj = 0; bj < 2; ++bj)
#pragma unroll
                    for (int n = 0; n < 2; ++n) {
                        u32x2* p = (u32x2*)(rowp + bj * HALF + n * 16); const u32x2 o = *p;
                        const f32x4 a = acc[ai][bj][m][n];
                        const float h0 = __uint_as_float(o.x << 16) + a[0], h1 = __uint_as_float(o.x & 0xffff0000u) + a[1];
                        const float h2 = __uint_as_float(o.y << 16) + a[2], h3 = __uint_as_float(o.y & 0xffff0000u) + a[3];
                        ss += (h0 * h0 + h1 * h1) + (h2 * h2 + h3 * h3);
                        u32x2 w; w.x = cvt_pk_bf16(h0, h1); w.y = cvt_pk_bf16(h2, h3); *p = w;
                    }
                ss += __shfl_xor(ss, 16); ss += __shfl_xor(ss, 32);
                if (fq == 0) rowss[(size_t)r * 16 + u.pn * 4 + wc] = ss;
            }
    }
};
}

#define XB_TMO      128
#define XB_XCNT(j)  (256  + 64 * (j))
#define XB_XSUB(j)  (1280 + 64 * (j))
#define XB_XGEN(j)  (2304 + 64 * (j))
#define XB_TOP      3328
#define XB_TOPGEN   3392
#define XCD_BAR_WORDS 3456
#define XB_SPIN_CAP (1u << 24)
__device__ __forceinline__ unsigned xb_ld(unsigned* p)              { return __hip_atomic_load(p, __ATOMIC_RELAXED, __HIP_MEMORY_SCOPE_AGENT); }
__device__ __forceinline__ unsigned xb_add(unsigned* p, unsigned v) { return __hip_atomic_fetch_add(p, v, __ATOMIC_RELAXED, __HIP_MEMORY_SCOPE_AGENT); }
__device__ __forceinline__ unsigned xb_xcc_id() { return (unsigned)__builtin_amdgcn_s_getreg((3 << 11) | 20) & 0xFu; }
#define XB_SPIN(cond, bar) do { unsigned _sp = 0; while (cond) { __builtin_amdgcn_s_sleep(1); \
    if ((++_sp & 255u) == 0u) { if (xb_ld(&(bar)[XB_TMO])) break; if (_sp > XB_SPIN_CAP) { atomicAdd(&(bar)[XB_TMO], 1u); break; } } } } while (0)
struct XcdBarrier { unsigned* bar; unsigned x; volatile LAS unsigned* st; };
__device__ __forceinline__ XcdBarrier xcd_barrier_post(unsigned* bar, volatile LAS unsigned* st) {
    XcdBarrier b; b.bar = bar; b.x = xb_xcc_id(); b.st = st;
    if (threadIdx.x == 0) (void)xb_add(&bar[XB_XCNT(b.x)], 1u);
    return b;
}
__device__ __forceinline__ void xcd_barrier_complete(unsigned* bar, unsigned x, unsigned& nloc, unsigned& nx) {
    const unsigned G = gridDim.x * gridDim.y * gridDim.z;
    unsigned sum, cnt, mine, sp = 0u;
    for (;;) {
        sum = 0u; cnt = 0u; mine = 0u;
#pragma unroll
        for (unsigned j = 0; j < 16; ++j) { const unsigned c = xb_ld(&bar[XB_XCNT(j)]); sum += c; cnt += (c > 0u) ? 1u : 0u; mine = (j == x) ? c : mine; }
        if (sum == G) break;
        __builtin_amdgcn_s_sleep(1);
        if ((++sp & 255u) == 0u) { if (xb_ld(&bar[XB_TMO])) break; if (sp > XB_SPIN_CAP) { atomicAdd(&bar[XB_TMO], 1u); break; } }
    }
    nloc = mine > 0u ? mine : 1u; nx = cnt > 0u ? cnt : 1u;
}
__device__ __forceinline__ void xcd_barrier(const XcdBarrier& b) {
    asm volatile("s_waitcnt vmcnt(0)" ::: "memory");
    __syncthreads();
    if (threadIdx.x == 0) {
        unsigned* bar = b.bar;
        __builtin_amdgcn_s_waitcnt(0);
        unsigned nloc = b.st[0], nx = b.st[1];
        if (nloc == 0u) { xcd_barrier_complete(bar, b.x, nloc, nx); b.st[0] = nloc; b.st[1] = nx; }
        const unsigned old = xb_add(&bar[XB_XSUB(b.x)], 1u);
        const unsigned gen = old / nloc;
        if (old + 1u == (gen + 1u) * nloc) {
            __builtin_amdgcn_fence(__ATOMIC_RELEASE, "agent");
            asm volatile("s_waitcnt vmcnt(0)" ::: "memory");
            const unsigned og = xb_add(&bar[XB_TOP], 1u);
            const unsigned tg = og / nx;
            if (og + 1u == (tg + 1u) * nx) xb_add(&bar[XB_TOPGEN], 1u);
            else XB_SPIN(xb_ld(&bar[XB_TOPGEN]) == tg, bar);
            __builtin_amdgcn_fence(__ATOMIC_ACQUIRE, "agent");
            xb_add(&bar[XB_XGEN(b.x)], 1u);
            asm volatile("s_waitcnt vmcnt(0)" ::: "memory");
        } else {
            XB_SPIN(xb_ld(&bar[XB_XGEN(b.x)]) == gen, bar);
            __builtin_amdgcn_fence(__ATOMIC_ACQUIRE, "agent");
            asm volatile("s_waitcnt vmcnt(0)" ::: "memory");
        }
    }
    __syncthreads();
}

struct Args { const float* in[24]; float* out; unsigned char* ws; int ph_lo, ph_hi; };

struct Frame {
    const Args* ap; float* out; unsigned char* ws;
    __device__ __forceinline__ const float* inp(int i) const { asm volatile("" : "+s"(i)); return ap->in[i]; }
    unsigned char* lds; LAS unsigned char* ldsl;
    int tid, lane, wave, G, bid;
    bf16_t* hb; bf16_t* win; bf16_t* wout; float* dtb; float* rss; bf16_t* proj;
};

__device__ __forceinline__ Frame relaunder(Frame F) {
    int t = F.tid; asm volatile("" : "+v"(t));
    F.tid = t; F.lane = t & 63; F.wave = __builtin_amdgcn_readfirstlane(t >> 6);
    unsigned char* w = F.ws; asm volatile("" : "+s"(w));
    F.ws = w; F.hb = (bf16_t*)(w + WS_HB); F.win = (bf16_t*)(w + WS_WIN); F.wout = (bf16_t*)(w + WS_WOUT);
    F.dtb = (float*)(w + WS_DTB); F.rss = (float*)(w + WS_RSS); F.proj = (bf16_t*)(w + WS_PROJ);
    return F;
}
__device__ void phase_init_h(const Frame& F0) {
    const Frame F = relaunder(F0);
    const float* xp = F.inp(0); const float* xs = F.inp(1); const float* meta = F.inp(6);
    for (int row = F.bid * 8 + F.wave; row < M_TOT; row += F.G * 8) {
        const float* src = nullptr;
        if (row < ROW_S0) { const int b = row / TPP, r = row % TPP; if (r >= 64) src = xp + ((size_t)b * SEQ + (r - 64)) * D; else if (r >= PADF) src = meta + (size_t)(r - PADF) * D; }
        else src = xs + (size_t)(row - ROW_S0) * D;
        float ss = 0.f;
#pragma unroll
        for (int i = 0; i < 4; ++i) {
            f32x4 v = (f32x4){0.f, 0.f, 0.f, 0.f};
            if (src) v = *(const f32x4*)(src + (F.lane + 64 * i) * 4);
            ss += (v[0] * v[0] + v[1] * v[1]) + (v[2] * v[2] + v[3] * v[3]);
            u32x2 w; w.x = cvt_pk_bf16(v[0], v[1]); w.y = cvt_pk_bf16(v[2], v[3]);
            *(u32x2*)(F.hb + (size_t)row * D + (F.lane + 64 * i) * 4) = w;
        }
        ss = wave_sum(ss);
        if (F.lane < 16) F.rss[(size_t)row * 16 + F.lane] = (F.lane == 0) ? ss : 0.f;
    }
}

__device__ void transpose_convert(const Frame& F, const float* src, int K, int N, int Npad, bf16_t* dst, const float* scale, int smod) {
    float* tile = (float*)F.lds;
    const int ntk = K / 64, ntn = Npad / 64, ntile = ntk * ntn;
    for (int ti = F.bid; ti < ntile; ti += F.G) {
        const int kt = ti % ntk, nt_ = ti / ntk, k0 = kt * 64, n0 = nt_ * 64;
        const int kk = F.tid >> 4, n4 = (F.tid & 15) * 4;
#pragma unroll
        for (int h = 0; h < 2; ++h) {
            const int k = k0 + kk + 32 * h, n = n0 + n4;
            f32x4 v = (f32x4){0.f, 0.f, 0.f, 0.f};
            if (n < N) v = *(const f32x4*)(src + (size_t)k * N + n);
            const float s = scale[k % smod];
            float* tp = tile + (kk + 32 * h) * 65 + n4;
            tp[0] = v[0] * s; tp[1] = v[1] * s; tp[2] = v[2] * s; tp[3] = v[3] * s;
        }
        __syncthreads();
        const int nn = F.tid >> 3, kg = (F.tid & 7) * 8;
        float x[8];
#pragma unroll
        for (int j = 0; j < 8; ++j) x[j] = tile[(kg + j) * 65 + nn];
        u32x4 w; w.x = cvt_pk_bf16(x[0], x[1]); w.y = cvt_pk_bf16(x[2], x[3]); w.z = cvt_pk_bf16(x[4], x[5]); w.w = cvt_pk_bf16(x[6], x[7]);
        *(u32x4*)(dst + (size_t)(n0 + nn) * K + k0 + kg) = w;
        __syncthreads();
    }
}
__device__ void phase_wprep(const Frame& F0, int L) {
    const Frame F = relaunder(F0);
    const int j = L >> 1;
    if ((L & 1) == 0) {
        transpose_convert(F, F.inp(8) + (size_t)j * D * SSD_IN, D, SSD_IN, SSD_IN_PAD, F.win, F.inp(7) + j * D, D);
        transpose_convert(F, F.inp(15) + (size_t)j * SSD_INNER * D, SSD_INNER, D, D, F.wout + (size_t)(L & 1) * 1024 * 2048, F.inp(14) + j * SSD_INNER, SSD_INNER);
    } else {
        transpose_convert(F, F.inp(17) + (size_t)j * D * GDN_IN, D, GDN_IN, GDN_IN_PAD, F.win, F.inp(16) + j * D, D);
        transpose_convert(F, F.inp(22) + (size_t)j * GDN_VAL * D, GDN_VAL, D, D, F.wout + (size_t)(L & 1) * 1024 * 2048, F.inp(21) + j * GDN_DV, GDN_DV);
    }
}

__device__ void phase_inproj(const Frame& F0, int L) {
    const Frame F = relaunder(F0);
    const int npad = (L & 1) ? GDN_IN_PAD : SSD_IN_PAD;
    pg8::Gemm g{F.hb, F.win, M_TOT, npad, D, D, D};
    pg8::StaticOrder S; S.init(M_TOT, npad, F.G, F.bid);
    pg8::EpiInProj E{F.proj, F.dtb, F.rss, npad / 256 - 1};
    pg8::gemm_phase<pg8::EpiInProj>(F.ldsl, g, S, E, F.tid);
}
__device__ void phase_outproj(const Frame& F0, int L) {
    const Frame F = relaunder(F0);
    const bf16_t* A = F.proj + ((L & 1) ? 4096 : 0);
    pg8::Gemm g{A, F.wout + (size_t)(L & 1) * 1024 * 2048, M_TOT, D, 2048, LDP, 2048};
    pg8::StaticOrder S; S.init(M_TOT, D, F.G, F.bid);
    pg8::EpiOutProj E{F.hb, F.rss};
    pg8::gemm_phase<pg8::EpiOutProj>(F.ldsl, g, S, E, F.tid);
}

__device__ void phase_ssd_naive(const Frame& F0, int j) {
    const Frame F = relaunder(F0);
    float* xs = (float*)F.lds;
    float* Bs = xs + 64 * 64;
    float* Cs = Bs + 64 * 128;
    float* dts = Cs + 64 * 128;
    float* das = dts + 64;
    const float* conv_w = F.inp(9) + (size_t)j * 4 * SSD_CONV; const float* conv_b = F.inp(10) + (size_t)j * SSD_CONV;
    const int p = F.tid >> 3, nq = F.tid & 7;
    for (int task = F.bid; task < NSEQ * SSD_HEADS; task += F.G) {
        const int s = task / SSD_HEADS, head = task % SSD_HEADS, grp = head >> 3;
        const int base = seq_base(s), nch = seq_chunks(s);
        const float dt_bias = F.inp(11)[j * SSD_HEADS + head], a = -__expf(F.inp(12)[j * SSD_HEADS + head]), dsk = F.inp(13)[j * SSD_HEADS + head];
        float h[16];
        if (s < 2) {
#pragma unroll
            for (int n = 0; n < 16; ++n) h[n] = 0.f;
        } else {
            const float* st = F.inp(2) + ((((size_t)j * 8 + (s - 2)) * SSD_HEADS + head) * SSD_P + p) * SSD_N + nq * 16;
#pragma unroll
            for (int n = 0; n < 16; ++n) h[n] = st[n];
        }
        int cidx = -1;
        if (F.tid < 64) cidx = head * 64 + F.tid; else if (F.tid < 192) cidx = 2048 + grp * 128 + (F.tid - 64); else if (F.tid < 320) cidx = 2560 + grp * 128 + (F.tid - 192);
        float w0 = 0, w1 = 0, w2 = 0, w3 = 0, cb = 0;
        if (cidx >= 0) { w0 = conv_w[cidx]; w1 = conv_w[SSD_CONV + cidx]; w2 = conv_w[2 * SSD_CONV + cidx]; w3 = conv_w[3 * SSD_CONV + cidx]; cb = conv_b[cidx]; }
        const float* cst = (s >= 2) ? F.inp(3) + (((size_t)j * 8 + (s - 2)) * 3) * SSD_CONV : nullptr;
        for (int c = 0; c < nch; ++c) {
            const int t0 = 64 * c - PADF;
            __syncthreads();
            if (cidx >= 0) {
                float r3, r2, r1;
                {   float rv[3];
#pragma unroll
                    for (int q = 0; q < 3; ++q) { const int t = t0 - 3 + q; float v = 0.f;
                        if (t >= 0) v = bf2f(F.proj[(size_t)(base + t) * LDP + 2048 + cidx]); else if (t >= -3 && cst) v = cst[(3 + t) * SSD_CONV + cidx];
                        rv[q] = v; }
                    r3 = rv[0]; r2 = rv[1]; r1 = rv[2]; }
                for (int i = 0; i < 64; ++i) {
                    const int t = t0 + i; float v = 0.f;
                    if (t >= 0) v = bf2f(F.proj[(size_t)(base + t) * LDP + 2048 + cidx]); else if (t >= -3 && cst) v = cst[(3 + t) * SSD_CONV + cidx];
                    const float o = silu_f(cb + w0 * r3 + w1 * r2 + w2 * r1 + w3 * v);
                    r3 = r2; r2 = r1; r1 = v;
                    if (F.tid < 64) xs[i * 64 + F.tid] = o; else if (F.tid < 192) Bs[i * 128 + (F.tid - 64)] = o; else Cs[i * 128 + (F.tid - 192)] = o;
                }
            } else if (F.tid >= 448) {
                const int i = F.tid - 448, t = t0 + i;
                float dt = 0.f, da = 1.f;
                if (t >= 0) { dt = softplus_f(F.dtb[(size_t)(base + t) * 32 + head] + dt_bias); da = __expf(dt * a); }
                dts[i] = dt; das[i] = da;
            }
            __syncthreads();
            for (int i = 0; i < 64; ++i) {
                const int t = t0 + i;
                const float dt = dts[i], da = das[i], xv = xs[i * 64 + p], dx = dt * xv;
                const float* bp = Bs + i * 128 + nq * 16; const float* cp = Cs + i * 128 + nq * 16;
                float accv = 0.f;
#pragma unroll
                for (int n = 0; n < 16; ++n) { h[n] = h[n] * da + dx * bp[n]; accv += cp[n] * h[n]; }
                accv += __shfl_xor(accv, 1); accv += __shfl_xor(accv, 2); accv += __shfl_xor(accv, 4);
                if (nq == 0 && t >= 0) {
                    bf16_t* zp = F.proj + (size_t)(base + t) * LDP + head * 64 + p;
                    const float z = bf2f(*zp);
                    *zp = f2bf((accv + dsk * xv) * silu_f(z));
                }
            }
        }
        float* so = (s < 2) ? F.out + O_PSSD + ((((size_t)j * 2 + s) * SSD_HEADS + head) * SSD_P + p) * SSD_N + nq * 16
                            : F.out + O_SSSD + ((((size_t)j * 8 + (s - 2)) * SSD_HEADS + head) * SSD_P + p) * SSD_N + nq * 16;
#pragma unroll
        for (int n = 0; n < 16; ++n) so[n] = h[n];
    }
}

__device__ void phase_ssd_post(const Frame& F0, int j) {
    const Frame F = relaunder(F0);
    for (int it = F.bid * 8 + F.wave; it < M_TOT * 4; it += F.G * 8) {
        const int row = it >> 2, grp = it & 3;
        u32x4* p = (u32x4*)(F.proj + (size_t)row * LDP + grp * 512 + F.lane * 8);
        const u32x4 v = *p; float x[8];
        x[0] = __uint_as_float(v.x << 16); x[1] = __uint_as_float(v.x & 0xffff0000u); x[2] = __uint_as_float(v.y << 16); x[3] = __uint_as_float(v.y & 0xffff0000u);
        x[4] = __uint_as_float(v.z << 16); x[5] = __uint_as_float(v.z & 0xffff0000u); x[6] = __uint_as_float(v.w << 16); x[7] = __uint_as_float(v.w & 0xffff0000u);
        float ss = 0.f;
#pragma unroll
        for (int q = 0; q < 8; ++q) ss += x[q] * x[q];
        ss = wave_sum(ss);
        const float rs = rsqrtf(ss * (1.0f / 512.0f) + EPS);
        u32x4 w; w.x = cvt_pk_bf16(x[0] * rs, x[1] * rs); w.y = cvt_pk_bf16(x[2] * rs, x[3] * rs); w.z = cvt_pk_bf16(x[4] * rs, x[5] * rs); w.w = cvt_pk_bf16(x[6] * rs, x[7] * rs);
        *p = w;
    }
    for (int e = F.bid * NTHREADS + F.tid; e < NSEQ * 3 * SSD_CONV; e += F.G * NTHREADS) {
        const int s = e / (3 * SSD_CONV), r = (e / SSD_CONV) % 3, c = e % SSD_CONV;
        const int row = seq_base(s) + seq_len(s) - 3 + r;
        const float v = bf2f(F.proj[(size_t)row * LDP + 2048 + c]);
        if (s < 2) F.out[O_PSSDC + (((size_t)j * 2 + s) * 3 + r) * SSD_CONV + c] = v;
        else F.out[O_SSSDC + (((size_t)j * 8 + (s - 2)) * 3 + r) * SSD_CONV + c] = v;
    }
}

__device__ void phase_gdn_naive(const Frame& F0, int j) {
    const Frame F = relaunder(F0);
    constexpr int QP = 129;
    float* qs = (float*)F.lds;
    float* ks = qs + 64 * QP;
    float* vs = ks + 64 * QP;
    float* gs = vs + 64 * 256;
    float* bs = gs + 64;
    float* qk = bs + 64;
    float* exk = qk + 64;
    float* exq = exk + 2 * 2 * 256;
    float* exv = exq + 2 * 2 * 256;
    const float* conv_w = F.inp(18) + (size_t)j * 4 * GDN_CONV;
    const int v = F.tid & 255, kh = F.tid >> 8;
    for (int task = F.bid; task < NSEQ * GDN_HEADS; task += F.G) {
        const int s = task / GDN_HEADS, head = task % GDN_HEADS;
        const int base = seq_base(s), nch = seq_chunks(s);
        const float dt_bias = F.inp(19)[j * GDN_HEADS + head], aneg = -__expf(F.inp(20)[j * GDN_HEADS + head]);
        float S[64];
        if (s < 2) {
#pragma unroll
            for (int kk = 0; kk < 64; ++kk) S[kk] = 0.f;
        } else {
            const float* st = F.inp(4) + ((((size_t)j * 8 + (s - 2)) * GDN_HEADS + head) * GDN_DK + kh * 64) * GDN_DV + v;
#pragma unroll
            for (int kk = 0; kk < 64; ++kk) S[kk] = st[(size_t)kk * GDN_DV];
        }
        const int cidx = F.tid < 128 ? head * 128 + F.tid : (F.tid < 256 ? 1024 + head * 128 + (F.tid - 128) : 2048 + head * 256 + (F.tid - 256));
        const float w0 = conv_w[cidx], w1 = conv_w[GDN_CONV + cidx], w2 = conv_w[2 * GDN_CONV + cidx], w3 = conv_w[3 * GDN_CONV + cidx];
        const float* cst = (s >= 2) ? F.inp(5) + (((size_t)j * 8 + (s - 2)) * 3) * GDN_CONV : nullptr;
        for (int c = 0; c < nch; ++c) {
            const int t0 = 64 * c - PADF;
            __syncthreads();
            {
                float r3, r2, r1;
                {   float rv[3];
#pragma unroll
                    for (int q = 0; q < 3; ++q) { const int t = t0 - 3 + q; float x = 0.f;
                        if (t >= 0) x = bf2f(F.proj[(size_t)(base + t) * LDP + cidx]); else if (t >= -3 && cst) x = cst[(3 + t) * GDN_CONV + cidx];
                        rv[q] = x; }
                    r3 = rv[0]; r2 = rv[1]; r1 = rv[2]; }
                for (int i = 0; i < 64; ++i) {
                    const int t = t0 + i; float x = 0.f;
                    if (t >= 0) x = bf2f(F.proj[(size_t)(base + t) * LDP + cidx]); else if (t >= -3 && cst) x = cst[(3 + t) * GDN_CONV + cidx];
                    const float o = silu_f(w0 * r3 + w1 * r2 + w2 * r1 + w3 * x);
                    r3 = r2; r2 = r1; r1 = x;
                    if (F.tid < 128) qs[i * QP + F.tid] = o; else if (F.tid < 256) ks[i * QP + (F.tid - 128)] = o; else vs[i * 256 + (F.tid - 256)] = o;
                }
            }
            __syncthreads();
            if (F.tid < 128) {
                const int i = F.tid & 63; float* rowp = (F.tid < 64 ? qs : ks) + i * QP; float ss = 0.f;
                for (int k = 0; k < 128; ++k) ss += rowp[k] * rowp[k];
                const float sc = rsqrtf(ss + EPS) * (F.tid < 64 ? 0.08838834764831845f : 1.0f);
                for (int k = 0; k < 128; ++k) rowp[k] *= sc;
            } else if (F.tid < 192) {
                const int i = F.tid - 128, t = t0 + i; float ga = 1.f, be = 0.f;
                if (t >= 0) { const float* dp = F.dtb + (size_t)(base + t) * 32; ga = __expf(aneg * softplus_f(dp[head] + dt_bias)); be = 1.0f / (1.0f + __expf(-dp[8 + head])); }
                gs[i] = ga; bs[i] = be;
            }
            __syncthreads();
            if (F.tid < 64) { float d = 0.f; for (int k = 0; k < 128; ++k) d += qs[F.tid * QP + k] * ks[F.tid * QP + k]; qk[F.tid] = d; }
            __syncthreads();
            for (int i = 0; i < 64; ++i) {
                const float* kp = ks + i * QP + kh * 64; const float* qp = qs + i * QP + kh * 64;
                float pk = 0.f, pq = 0.f;
#pragma unroll
                for (int kk = 0; kk < 64; ++kk) { pk += kp[kk] * S[kk]; pq += qp[kk] * S[kk]; }
                const int eb = (i & 1) * 512;
                exk[eb + kh * 256 + v] = pk; exq[eb + kh * 256 + v] = pq; if (kh == 0) exv[(i & 1) * 256 + v] = vs[i * 256 + v];
                __syncthreads();
                const float kS = exk[eb + v] + exk[eb + 256 + v], qS = exq[eb + v] + exq[eb + 256 + v], vv = exv[(i & 1) * 256 + v];
                const float ga = gs[i], be = bs[i];
                const float delta = vv - ga * kS;
                const float bd = be * delta;
#pragma unroll
                for (int kk = 0; kk < 64; ++kk) S[kk] = ga * S[kk] + kp[kk] * bd;
                if (kh == 0) vs[i * 256 + v] = ga * qS + qk[i] * bd;
            }
            __syncthreads();
            for (int q = 0; q < 8; ++q) {
                const int i = F.wave * 8 + q, t = t0 + i;
                const f32x4 o = *(const f32x4*)(vs + i * 256 + F.lane * 4);
                float ss = (o[0] * o[0] + o[1] * o[1]) + (o[2] * o[2] + o[3] * o[3]);
                ss = wave_sum(ss);
                const float rs = rsqrtf(ss * (1.0f / 256.0f) + EPS);
                if (t >= 0) {
                    u32x2* zp = (u32x2*)(F.proj + (size_t)(base + t) * LDP + 4096 + head * 256 + F.lane * 4);
                    const u32x2 z = *zp;
                    const float z0 = __uint_as_float(z.x << 16), z1 = __uint_as_float(z.x & 0xffff0000u), z2 = __uint_as_float(z.y << 16), z3 = __uint_as_float(z.y & 0xffff0000u);
                    u32x2 w; w.x = cvt_pk_bf16(o[0] * rs * silu_f(z0), o[1] * rs * silu_f(z1)); w.y = cvt_pk_bf16(o[2] * rs * silu_f(z2), o[3] * rs * silu_f(z3));
                    *zp = w;
                }
            }
        }
        float* so = (s < 2) ? F.out + O_PGDN + ((((size_t)j * 2 + s) * GDN_HEADS + head) * GDN_DK + kh * 64) * GDN_DV + v
                            : F.out + O_SGDN + ((((size_t)j * 8 + (s - 2)) * GDN_HEADS + head) * GDN_DK + kh * 64) * GDN_DV + v;
#pragma unroll
        for (int kk = 0; kk < 64; ++kk) so[(size_t)kk * GDN_DV] = S[kk];
    }
}
__device__ void phase_gdn_post(const Frame& F0, int j) {
    const Frame F = relaunder(F0);
    for (int e = F.bid * NTHREADS + F.tid; e < NSEQ * 3 * GDN_CONV; e += F.G * NTHREADS) {
        const int s = e / (3 * GDN_CONV), r = (e / GDN_CONV) % 3, c = e % GDN_CONV;
        const int row = seq_base(s) + seq_len(s) - 3 + r;
        const float v = bf2f(F.proj[(size_t)row * LDP + c]);
        if (s < 2) F.out[O_PGDNC + (((size_t)j * 2 + s) * 3 + r) * GDN_CONV + c] = v;
        else F.out[O_SGDNC + (((size_t)j * 8 + (s - 2)) * 3 + r) * GDN_CONV + c] = v;
    }
}

__device__ void phase_final(const Frame& F0) {
    const Frame F = relaunder(F0);
    const float* fw = F.inp(23);
    for (int it = F.bid * 8 + F.wave; it < 2 * SEQ + 128; it += F.G * 8) {
        int row; float* dst;
        if (it < 2 * SEQ) { const int b = it / SEQ, t = it % SEQ; row = b * TPP + 64 + t; dst = F.out + O_YP + (size_t)it * D; }
        else { row = ROW_S0 + (it - 2 * SEQ); dst = F.out + O_YS + (size_t)(it - 2 * SEQ) * D; }
        float x[16]; float ss = 0.f;
#pragma unroll
        for (int i = 0; i < 4; ++i) {
            const u32x2 v = *(const u32x2*)(F.hb + (size_t)row * D + (F.lane + 64 * i) * 4);
            x[4 * i + 0] = __uint_as_float(v.x << 16); x[4 * i + 1] = __uint_as_float(v.x & 0xffff0000u); x[4 * i + 2] = __uint_as_float(v.y << 16); x[4 * i + 3] = __uint_as_float(v.y & 0xffff0000u);
            ss += (x[4 * i] * x[4 * i] + x[4 * i + 1] * x[4 * i + 1]) + (x[4 * i + 2] * x[4 * i + 2] + x[4 * i + 3] * x[4 * i + 3]);
        }
        ss = wave_sum(ss);
        const float rs = rsqrtf(ss * (1.0f / 1024.0f) + EPS);
#pragma unroll
        for (int i = 0; i < 4; ++i) {
            const int c = (F.lane + 64 * i) * 4; const f32x4 w = *(const f32x4*)(fw + c);
            f32x4 o; o[0] = x[4 * i] * rs * w[0]; o[1] = x[4 * i + 1] * rs * w[1]; o[2] = x[4 * i + 2] * rs * w[2]; o[3] = x[4 * i + 3] * rs * w[3];
            *(f32x4*)(dst + c) = o;
        }
    }
}

constexpr int N_PHASES = 18;
#ifndef MK_ONE_LAUNCH
#define MK_ONE_LAUNCH 1
#endif
__global__ void __launch_bounds__(NTHREADS, 2) hybrid_fwd(Args args) {
    extern __shared__ __attribute__((aligned(16))) unsigned char lds[];
    volatile LAS unsigned* bst = (volatile LAS unsigned*)((LAS unsigned char*)lds + LDS_BYTES - 16);
    if (threadIdx.x < 4) bst[threadIdx.x] = 0u;
    __syncthreads();
    XcdBarrier bar; bar.bar = (unsigned*)(args.ws + WS_CTL); bar.x = 0; bar.st = bst;
    if (args.ph_hi - args.ph_lo > 1) bar = xcd_barrier_post((unsigned*)(args.ws + WS_CTL), bst);
    for (int ph = args.ph_lo; ph < args.ph_hi; ++ph) {
        int tid_ = threadIdx.x; asm volatile("" : "+v"(tid_));
        Frame F;
        F.ap = &args;
        F.out = args.out; F.ws = args.ws; F.lds = lds; F.ldsl = (LAS unsigned char*)lds;
        F.tid = tid_; F.lane = F.tid & 63; F.wave = __builtin_amdgcn_readfirstlane(F.tid >> 6); F.G = gridDim.x; F.bid = blockIdx.x;
        F.hb = nullptr; F.win = nullptr; F.wout = nullptr; F.dtb = nullptr; F.rss = nullptr; F.proj = nullptr;
        if (ph == 0) { phase_init_h(F); phase_wprep(F, 0); }
        else if (ph == N_PHASES - 1) phase_final(F);
        else {
            const int L = (ph - 1) >> 2, sub = (ph - 1) & 3, j = L >> 1;
            if (sub == 0) phase_inproj(F, L);
            else if (sub == 1) { if (L & 1) phase_gdn_naive(F, j); else phase_ssd_naive(F, j); }
            else if (sub == 2) { if (L & 1) phase_gdn_post(F, j); else phase_ssd_post(F, j); if (L < 3) phase_wprep(F, L + 1); }
            else phase_outproj(F, L);
        }
        if (ph + 1 < args.ph_hi) {
            if (ph == args.ph_lo) { __threadfence(); cg::this_grid().sync(); }
            else xcd_barrier(bar);
        }
    }
}

extern "C" void kernel_launch(void* const* d_in, const int* in_sizes, int n_in, void* d_out, int out_size, void* d_ws, size_t ws_size, hipStream_t stream) {
    static int grid = 0;
    if (grid == 0) {
        if (n_in != 24 || ws_size < WS_END) { fprintf(stderr, "kernel_launch: unexpected n_in %d / ws %zu (need %zu)\n", n_in, ws_size, (size_t)WS_END); grid = -1; return; }
        int dev = 0, cus = 0, per_cu = 0;
        if (hipGetDevice(&dev) != hipSuccess || hipDeviceGetAttribute(&cus, hipDeviceAttributeMultiprocessorCount, dev) != hipSuccess) { grid = -1; return; }
        if (hipFuncSetAttribute((const void*)hybrid_fwd, hipFuncAttributeMaxDynamicSharedMemorySize, LDS_BYTES) != hipSuccess) { fprintf(stderr, "kernel_launch: hipFuncSetAttribute failed\n"); grid = -1; return; }
        if (hipOccupancyMaxActiveBlocksPerMultiprocessor(&per_cu, (const void*)hybrid_fwd, NTHREADS, LDS_BYTES) != hipSuccess || per_cu < 1) { fprintf(stderr, "kernel_launch: occupancy query says %d blocks per CU\n", per_cu); grid = -1; return; }
        (void)hipGetLastError();
        grid = cus;
    }
    if (grid < 0) return;
    Args a{};
    for (int i = 0; i < 24; ++i) a.in[i] = (const float*)d_in[i];
    a.out = (float*)d_out; a.ws = (unsigned char*)d_ws;
#if MK_ONE_LAUNCH
    (void)hipMemsetAsync((char*)d_ws + WS_CTL, 0, 16384, stream);
    a.ph_lo = 0; a.ph_hi = N_PHASES;
    void* kargs[] = {&a};
    hipError_t e = hipLaunchCooperativeKernel((const void*)hybrid_fwd, dim3(grid), dim3(NTHREADS), kargs, LDS_BYTES, stream);
    if (e != hipSuccess) fprintf(stderr, "kernel_launch: cooperative launch failed: %s (grid %d)\n", hipGetErrorString(e), grid);
#else
    for (int ph = 0; ph < N_PHASES; ++ph) {
        a.ph_lo = ph; a.ph_hi = ph + 1;
        hipLaunchKernelGGL(hybrid_fwd, dim3(grid), dim3(NTHREADS), LDS_BYTES, stream, a);
    }
#endif
}
```

```cpp
#include <hip/hip_runtime.h>
#include <hip/hip_cooperative_groups.h>
#include <cstdio>
#include <cstdint>
namespace cg = cooperative_groups;

#define LAS __attribute__((address_space(3)))
typedef unsigned short bf16_t;
typedef short bf16x8 __attribute__((ext_vector_type(8)));
typedef float f32x4 __attribute__((ext_vector_type(4)));
typedef unsigned u32x4 __attribute__((ext_vector_type(4)));
typedef unsigned u32x2 __attribute__((ext_vector_type(2)));

constexpr int D = 1024;
constexpr int SEQ = 8192, NMETA = 16, PADF = 48;
constexpr int TPP = 8256;
constexpr int ROW_S0 = 2 * TPP;
constexpr int M_TOT = ROW_S0 + 128;
constexpr int NSEQ = 10;
constexpr float EPS = 1e-6f;
constexpr int LDP = 6144;
constexpr int SSD_INNER = 2048, SSD_HEADS = 32, SSD_P = 64, SSD_N = 128, SSD_CONV = 3072, SSD_IN = 5152, SSD_IN_PAD = 5376;
constexpr int GDN_HEADS = 8, GDN_DK = 128, GDN_DV = 256, GDN_CONV = 4096, GDN_VAL = 2048, GDN_IN = 6160, GDN_IN_PAD = 6400;

constexpr size_t O_YP = 0, O_YS = 16777216, O_PSSD = 16908288, O_PSSDC = 17956864, O_PGDN = 17993728, O_PGDNC = 19042304,
                 O_SSSD = 19091456, O_SSSDC = 23285760, O_SGDN = 23433216, O_SGDNC = 27627520;

constexpr size_t WS_CTL = 0;
constexpr size_t WS_HB = 65536;
constexpr size_t WS_WIN = WS_HB + (size_t)M_TOT * D * 2;
constexpr size_t WS_WOUT = WS_WIN + (size_t)GDN_IN_PAD * D * 2;
constexpr size_t WS_DTB = WS_WOUT + (size_t)2 * 1024 * 2048 * 2;
constexpr size_t WS_RSS = WS_DTB + (size_t)M_TOT * 32 * 4;
constexpr size_t WS_PROJ = WS_RSS + (size_t)M_TOT * 16 * 4;
constexpr size_t WS_END = WS_PROJ + (size_t)M_TOT * LDP * 2;

constexpr int NTHREADS = 512;
constexpr int LDS_BYTES = 147456;

__device__ __forceinline__ float bf2f(bf16_t b) { return __uint_as_float(((unsigned)b) << 16); }
__device__ __forceinline__ bf16_t f2bf(float f) { unsigned u = __float_as_uint(f); u += 0x7FFFu + ((u >> 16) & 1u); return (bf16_t)(u >> 16); }
typedef __bf16 bf16v2_t __attribute__((ext_vector_type(2)));
typedef float f32x2_t __attribute__((ext_vector_type(2)));
__device__ __forceinline__ unsigned cvt_pk_bf16(float lo, float hi) { const bf16v2_t r = __builtin_convertvector((f32x2_t){lo, hi}, bf16v2_t); return __builtin_bit_cast(unsigned, r); }
__device__ __forceinline__ float silu_f(float x) { return x / (1.0f + __expf(-x)); }
__device__ __forceinline__ float softplus_f(float x) { return x > 20.f ? x : log1pf(__expf(x)); }
__device__ __forceinline__ float wave_sum(float v) {
#pragma unroll
    for (int o = 32; o >= 1; o >>= 1) v += __shfl_xor(v, o);
    return v;
}
__device__ __forceinline__ int seq_base(int s) { return s < 2 ? s * TPP + 64 - NMETA : ROW_S0 + 16 * (s - 2); }
__device__ __forceinline__ int seq_len(int s) { return s < 2 ? SEQ + NMETA : 16; }
__device__ __forceinline__ int seq_chunks(int s) { return s < 2 ? 129 : 1; }

namespace pg8 {
constexpr int BM = 256, BK = 64, HALF = 128, HTB = HALF * BK * 2, STAGE_BYTES = 8 * HTB, NXCD = 8, WGM = 8;
__device__ __forceinline__ int lds_byte(int r, int c) { const int st = (r >> 4) * 2 + (c >> 5), rr = r & 15, cc = c & 31, ob = rr * 64 + cc * 2; return st * 1024 + (ob ^ (((ob >> 9) & 1) << 5)); }
__device__ __forceinline__ void stage_rc(int b, int& R, int& C) { const int st = b / 1024, sb = b % 1024, swz = sb ^ (((sb >> 9) & 1) << 5); R = (st >> 1) * 16 + swz / 64; C = (st & 1) * 32 + (swz % 64) / 2; }
__device__ __forceinline__ int perm32(int rho) { const int n = rho >> 4, i = rho & 15; return 8 * (i >> 2) + 4 * n + (i & 3); }
struct Unit { int pm, pn; };
struct Gemm { const bf16_t* A; const bf16_t* Bt; int M, N, K, lda, ldb; };
struct StaticOrder {
    int nM, nN, nwg, G, c;
    __device__ void init(int M, int N, int G_, int c_) { nM = M / BM; nN = N / BM; nwg = nM * nN; G = G_; c = c_; }
    __device__ bool next(int i, Unit& u) const {
        const long L = (long)i * G + c; if (L >= nwg) return false;
        int wgid = (int)L; { const int q = nwg / NXCD, r = nwg % NXCD, xcd = wgid % NXCD, off = wgid / NXCD; wgid = (xcd < r ? xcd * (q + 1) : r * (q + 1) + (xcd - r) * q) + off; }
        const int nig = WGM * nN, gid = wgid / nig, fm = gid * WGM, gsz = (nM - fm) < WGM ? (nM - fm) : WGM;
        u.pm = fm + ((wgid % nig) % gsz); u.pn = (wgid % nig) / gsz; return true;
    }
};

template <class Epi>
__device__ __forceinline__ void gemm_phase(LAS unsigned char* lds, const Gemm g, const StaticOrder& S, const Epi& E, const int tid) {
    const int wid = __builtin_amdgcn_readfirstlane(tid >> 6), lane = tid & 63, wr = wid >> 2, wc = wid & 3, fr = lane & 15, fq = lane >> 4;
    const int K = g.K, nt = K / BK;
    unsigned voffA[2], voffB[2];
#pragma unroll
    for (int i = 0; i < 2; ++i) { int R, C; stage_rc(tid * 16 + i * 8192, R, C); const int Rb = Epi::PERM ? ((R & ~31) + perm32(R & 31)) : R;
        voffA[i] = (unsigned)(R * g.lda + C) * 2u; voffB[i] = (unsigned)(Rb * g.ldb + C) * 2u; }
    const size_t kstep = (size_t)(BK * 2);
    const size_t hstepA = (size_t)HALF * g.lda * 2, hstepB = (size_t)HALF * g.ldb * 2;
    const size_t tstepA = 2 * hstepA, tstepB = 2 * hstepB;
    const unsigned ldsw = (unsigned)wid * 1024u;
    const int aoff = lds_byte(wr * 64 + fr, fq * 8), boff = lds_byte(wc * 32 + fr, fq * 8);
#define PG8_SA(b, h) (((b) * 2 + (h)) * HTB)
#define PG8_SB(b, h) ((4 + (b) * 2 + (h)) * HTB)
#define PG8_STAGE(bufoff, gbase, voff) do { _Pragma("unroll") for (int _i = 0; _i < 2; ++_i) \
        __builtin_amdgcn_global_load_lds((const unsigned*)((const char*)(gbase) + (voff)[_i]), (LAS unsigned*)(lds + (bufoff) + ldsw + _i * 8192), 16, 0, 0); } while (0)
#define PG8_LDA(dst, b, h) do { _Pragma("unroll") for (int m = 0; m < 4; ++m) _Pragma("unroll") for (int k = 0; k < 2; ++k) dst[m][k] = *(const LAS bf16x8*)(lds + PG8_SA(b, h) + aoff + m * 2048 + k * 1024); } while (0)
#define PG8_LDB(dst, b, h) do { _Pragma("unroll") for (int n = 0; n < 2; ++n) _Pragma("unroll") for (int k = 0; k < 2; ++k) dst[n][k] = *(const LAS bf16x8*)(lds + PG8_SB(b, h) + boff + n * 2048 + k * 1024); } while (0)
#define PG8_MMA(ai, bj, At, Bt) do { __builtin_amdgcn_s_setprio(1); _Pragma("unroll") for (int m = 0; m < 4; ++m) _Pragma("unroll") for (int n = 0; n < 2; ++n) _Pragma("unroll") for (int k = 0; k < 2; ++k) \
        acc[ai][bj][m][n] = __builtin_amdgcn_mfma_f32_16x16x32_bf16(Bt[n][k], At[m][k], acc[ai][bj][m][n], 0, 0, 0); __builtin_amdgcn_s_setprio(0); } while (0)
#define PG8_WAIT_V(n) asm volatile("s_waitcnt vmcnt(" #n ")" ::: "memory")
#define PG8_WAIT_L(n) asm volatile("s_waitcnt lgkmcnt(" #n ")" ::: "memory")
#define PG8_BAR __builtin_amdgcn_s_barrier()
#define PG8_SCHED __builtin_amdgcn_sched_barrier(0)
    Unit cur, nxt; int ui = 0;
    if (!S.next(0, cur)) return;
    f32x4 acc[2][2][4][2];
#pragma unroll
    for (int a = 0; a < 2; ++a)
#pragma unroll
        for (int b = 0; b < 2; ++b)
#pragma unroll
            for (int m = 0; m < 4; ++m)
#pragma unroll
                for (int n = 0; n < 2; ++n) acc[a][b][m][n] = (f32x4){0.f, 0.f, 0.f, 0.f};
    bf16x8 At[4][2], B0[2][2], B1[2][2];
    const char* cA = (const char*)g.A + (size_t)cur.pm * tstepA; const char* cB = (const char*)g.Bt + (size_t)cur.pn * tstepB;
    PG8_STAGE(PG8_SB(0, 0), cB, voffB); PG8_STAGE(PG8_SA(0, 0), cA, voffA); PG8_STAGE(PG8_SB(0, 1), cB + hstepB, voffB); PG8_STAGE(PG8_SA(0, 1), cA + hstepA, voffA);
    if (wr == 1) PG8_BAR;
    PG8_WAIT_V(4); PG8_BAR;
    PG8_STAGE(PG8_SB(1, 0), cB + kstep, voffB); PG8_STAGE(PG8_SA(1, 0), cA + kstep, voffA); PG8_STAGE(PG8_SB(1, 1), cB + hstepB + kstep, voffB);
    PG8_WAIT_V(6); PG8_BAR;
    for (;;) {
        const bool has_next = S.next(ui + 1, nxt);
        const char* nA = has_next ? (const char*)g.A + (size_t)nxt.pm * tstepA : cA; const char* nB = has_next ? (const char*)g.Bt + (size_t)nxt.pn * tstepB : cB;
        for (int t = 0; t < nt; t += 2) {
            const bool last = (t == nt - 2);
            const char* a1 = cA + (size_t)(t + 1) * kstep;
            const char* a2 = last ? nA : cA + (size_t)(t + 2) * kstep; const char* b2 = last ? nB : cB + (size_t)(t + 2) * kstep;
            const char* a3 = a2 + kstep; const char* b3 = b2 + kstep;
            PG8_LDB(B0, 0, 0); PG8_SCHED; PG8_LDA(At, 0, 0); PG8_STAGE(PG8_SA(1, 1), a1 + hstepA, voffA);
            PG8_WAIT_L(8); PG8_BAR; PG8_WAIT_L(0); PG8_MMA(0, 0, At, B0); PG8_BAR; PG8_SCHED;
            PG8_LDB(B1, 0, 1); PG8_STAGE(PG8_SB(0, 0), b2, voffB);
            PG8_BAR; PG8_WAIT_L(0); PG8_MMA(0, 1, At, B1); PG8_BAR;
            PG8_LDA(At, 0, 1); PG8_STAGE(PG8_SA(0, 0), a2, voffA);
            PG8_BAR; PG8_WAIT_L(0); PG8_MMA(1, 0, At, B0); PG8_BAR; PG8_SCHED;
            PG8_STAGE(PG8_SB(0, 1), b2 + hstepB, voffB);
            PG8_WAIT_V(6); PG8_BAR; PG8_MMA(1, 1, At, B1); PG8_BAR;
            PG8_LDB(B0, 1, 0); PG8_SCHED; PG8_LDA(At, 1, 0); PG8_STAGE(PG8_SA(0, 1), a2 + hstepA, voffA);
            PG8_WAIT_L(8); PG8_BAR; PG8_WAIT_L(0); PG8_MMA(0, 0, At, B0); PG8_BAR; PG8_SCHED;
            PG8_LDB(B1, 1, 1); PG8_STAGE(PG8_SB(1, 0), b3, voffB);
            PG8_BAR; PG8_WAIT_L(0); PG8_MMA(0, 1, At, B1); PG8_BAR;
            PG8_LDA(At, 1, 1); PG8_STAGE(PG8_SA(1, 0), a3, voffA);
            PG8_BAR; PG8_WAIT_L(0); PG8_MMA(1, 0, At, B0); PG8_BAR; PG8_SCHED;
            PG8_STAGE(PG8_SB(1, 1), b3 + hstepB, voffB);
            PG8_WAIT_V(6); PG8_BAR; PG8_MMA(1, 1, At, B1); PG8_BAR;
        }
        E(acc, cur, wr, wc, fr, fq);
        if (!has_next) break;
#pragma unroll
        for (int a = 0; a < 2; ++a)
#pragma unroll
            for (int b = 0; b < 2; ++b)
#pragma unroll
                for (int m = 0; m < 4; ++m)
#pragma unroll
                    for (int n = 0; n < 2; ++n) acc[a][b][m][n] = (f32x4){0.f, 0.f, 0.f, 0.f};
        cur = nxt; cA = nA; cB = nB; ++ui;
    }
    PG8_WAIT_V(0);
    if (wr == 0) PG8_BAR;
    PG8_BAR;
#undef PG8_SA
#undef PG8_SB
#undef PG8_STAGE
#undef PG8_LDA
#undef PG8_LDB
#undef PG8_MMA
#undef PG8_WAIT_V
#undef PG8_WAIT_L
#undef PG8_BAR
#undef PG8_SCHED
}

struct EpiInProj {
    static constexpr bool PERM = true;
    bf16_t* proj; float* dtb; const float* rowss; int nt_main;
    __device__ __forceinline__ void operator()(const f32x4 (&acc)[2][2][4][2], const Unit& u, int wr, int wc, int fr, int fq) const {
        const int row0 = u.pm * BM + wr * 64 + fr;
#pragma unroll
        for (int ai = 0; ai < 2; ++ai)
#pragma unroll
            for (int m = 0; m < 4; ++m) {
                const int r = row0 + ai * HALF + m * 16;
                const f32x4* rp = (const f32x4*)(rowss + (size_t)r * 16);
                const f32x4 p0 = rp[0], p1 = rp[1], p2 = rp[2], p3 = rp[3];
                const float ss = ((p0[0] + p0[1]) + (p0[2] + p0[3])) + ((p1[0] + p1[1]) + (p1[2] + p1[3])) + ((p2[0] + p2[1]) + (p2[2] + p2[3])) + ((p3[0] + p3[1]) + (p3[2] + p3[3]));
                const float rstd = rsqrtf(ss * (1.0f / 1024.0f) + EPS);
                if (u.pn < nt_main) {
                    bf16_t* rowp = proj + (size_t)r * LDP + u.pn * BM + wc * 32 + 8 * fq;
#pragma unroll
                    for (int bj = 0; bj < 2; ++bj) { const f32x4 v0 = acc[ai][bj][m][0] * rstd, v1 = acc[ai][bj][m][1] * rstd;
                        u32x4 w; w.x = cvt_pk_bf16(v0[0], v0[1]); w.y = cvt_pk_bf16(v0[2], v0[3]); w.z = cvt_pk_bf16(v1[0], v1[1]); w.w = cvt_pk_bf16(v1[2], v1[3]);
                        *(u32x4*)(rowp + bj * HALF) = w; }
                } else if (wc == 0) {
                    float* dp = dtb + (size_t)r * 32 + 8 * fq;
                    *(f32x4*)(dp) = acc[ai][0][m][0] * rstd; *(f32x4*)(dp + 4) = acc[ai][0][m][1] * rstd;
                }
            }
    }
};
struct EpiOutProj {
    static constexpr bool PERM = false;
    bf16_t* hb; float* rowss;
    __device__ __forceinline__ void operator()(const f32x4 (&acc)[2][2][4][2], const Unit& u, int wr, int wc, int fr, int fq) const {
        const int row0 = u.pm * BM + wr * 64 + fr, col0 = u.pn * BM + wc * 32 + 4 * fq;
#pragma unroll
        for (int ai = 0; ai < 2; ++ai)
#pragma unroll
            for (int m = 0; m < 4; ++m) {
                const int r = row0 + ai * HALF + m * 16; float ss = 0.f;
                bf16_t* rowp = hb + (size_t)r * D + col0;
#pragma unroll
                for (int bj = 0; bj < 2; ++bj)
#pragma unroll
                    for (int n = 0; n < 2; ++n) {
                        u32x2* p = (u32x2*)(rowp + bj * HALF + n * 16); const u32x2 o = *p;
                        const f32x4 a = acc[ai][bj][m][n];
                        const float h0 = __uint_as_float(o.x << 16) + a[0], h1 = __uint_as_float(o.x & 0xffff0000u) + a[1];
                        const float h2 = __uint_as_float(o.y << 16) + a[2], h3 = __uint_as_float(o.y & 0xffff0000u) + a[3];
                        ss += (h0 * h0 + h1 * h1) + (h2 * h2 + h3 * h3);
                        u32x2 w; w.x = cvt_pk_bf16(h0, h1); w.y = cvt_pk_bf16(h2, h3); *p = w;
                    }
                ss += __shfl_xor(ss, 16); ss += __shfl_xor(ss, 32);
                if (fq == 0) rowss[(size_t)r * 16 + u.pn * 4 + wc] = ss;
            }
    }
};
}

#define XB_TMO      128
#define XB_XCNT(j)  (256  + 64 * (j))
#define XB_XSUB(j)  (1280 + 64 * (j))
#define XB_XGEN(j)  (2304 + 64 * (j))
#define XB_TOP      3328
#define XB_TOPGEN   3392
#define XCD_BAR_WORDS 3456
#define XB_SPIN_CAP (1u << 24)
__device__ __forceinline__ unsigned xb_ld(unsigned* p)              { return __hip_atomic_load(p, __ATOMIC_RELAXED, __HIP_MEMORY_SCOPE_AGENT); }
__device__ __forceinline__ unsigned xb_add(unsigned* p, unsigned v) { return __hip_atomic_fetch_add(p, v, __ATOMIC_RELAXED, __HIP_MEMORY_SCOPE_AGENT); }
__device__ __forceinline__ unsigned xb_xcc_id() { return (unsigned)__builtin_amdgcn_s_getreg((3 << 11) | 20) & 0xFu; }
#define XB_SPIN(cond, bar) do { unsigned _sp = 0; while (cond) { __builtin_amdgcn_s_sleep(1); \
    if ((++_sp & 255u) == 0u) { if (xb_ld(&(bar)[XB_TMO])) break; if (_sp > XB_SPIN_CAP) { atomicAdd(&(bar)[XB_TMO], 1u); break; } } } } while (0)
struct XcdBarrier { unsigned* bar; unsigned x; volatile LAS unsigned* st; };
__device__ __forceinline__ XcdBarrier xcd_barrier_post(unsigned* bar, volatile LAS unsigned* st) {
    XcdBarrier b; b.bar = bar; b.x = xb_xcc_id(); b.st = st;
    if (threadIdx.x == 0) (void)xb_add(&bar[XB_XCNT(b.x)], 1u);
    return b;
}
__device__ __forceinline__ void xcd_barrier_complete(unsigned* bar, unsigned x, unsigned& nloc, unsigned& nx) {
    const unsigned G = gridDim.x * gridDim.y * gridDim.z;
    unsigned sum, cnt, mine, sp = 0u;
    for (;;) {
        sum = 0u; cnt = 0u; mine = 0u;
#pragma unroll
        for (unsigned j = 0; j < 16; ++j) { const unsigned c = xb_ld(&bar[XB_XCNT(j)]); sum += c; cnt += (c > 0u) ? 1u : 0u; mine = (j == x) ? c : mine; }
        if (sum == G) break;
        __builtin_amdgcn_s_sleep(1);
        if ((++sp & 255u) == 0u) { if (xb_ld(&bar[XB_TMO])) break; if (sp > XB_SPIN_CAP) { atomicAdd(&bar[XB_TMO], 1u); break; } }
    }
    nloc = mine > 0u ? mine : 1u; nx = cnt > 0u ? cnt : 1u;
}
__device__ __forceinline__ void xcd_barrier(const XcdBarrier& b) {
    asm volatile("s_waitcnt vmcnt(0)" ::: "memory");
    __syncthreads();
    if (threadIdx.x == 0) {
        unsigned* bar = b.bar;
        __builtin_amdgcn_s_waitcnt(0);
        unsigned nloc = b.st[0], nx = b.st[1];
        if (nloc == 0u) { xcd_barrier_complete(bar, b.x, nloc, nx); b.st[0] = nloc; b.st[1] = nx; }
        const unsigned old = xb_add(&bar[XB_XSUB(b.x)], 1u);
        const unsigned gen = old / nloc;
        if (old + 1u == (gen + 1u) * nloc) {
            __builtin_amdgcn_fence(__ATOMIC_RELEASE, "agent");
            asm volatile("s_waitcnt vmcnt(0)" ::: "memory");
            const unsigned og = xb_add(&bar[XB_TOP], 1u);
            const unsigned tg = og / nx;
            if (og + 1u == (tg + 1u) * nx) xb_add(&bar[XB_TOPGEN], 1u);
            else XB_SPIN(xb_ld(&bar[XB_TOPGEN]) == tg, bar);
            __builtin_amdgcn_fence(__ATOMIC_ACQUIRE, "agent");
            xb_add(&bar[XB_XGEN(b.x)], 1u);
            asm volatile("s_waitcnt vmcnt(0)" ::: "memory");
        } else {
            XB_SPIN(xb_ld(&bar[XB_XGEN(b.x)]) == gen, bar);
            __builtin_amdgcn_fence(__ATOMIC_ACQUIRE, "agent");
            asm volatile("s_waitcnt vmcnt(0)" ::: "memory");
        }
    }
    __syncthreads();
}

struct Args { const float* in[24]; float* out; unsigned char* ws; int ph_lo, ph_hi; };

struct Frame {
    const Args* ap; float* out; unsigned char* ws;
    __device__ __forceinline__ const float* inp(int i) const { asm volatile("" : "+s"(i)); return ap->in[i]; }
    unsigned char* lds; LAS unsigned char* ldsl;
    int tid, lane, wave, G, bid;
    bf16_t* hb; bf16_t* win; bf16_t* wout; float* dtb; float* rss; bf16_t* proj;
};

__device__ __forceinline__ Frame relaunder(Frame F) {
    int t = F.tid; asm volatile("" : "+v"(t));
    F.tid = t; F.lane = t & 63; F.wave = __builtin_amdgcn_readfirstlane(t >> 6);
    unsigned char* w = F.ws; asm volatile("" : "+s"(w));
    F.ws = w; F.hb = (bf16_t*)(w + WS_HB); F.win = (bf16_t*)(w + WS_WIN); F.wout = (bf16_t*)(w + WS_WOUT);
    F.dtb = (float*)(w + WS_DTB); F.rss = (float*)(w + WS_RSS); F.proj = (bf16_t*)(w + WS_PROJ);
    return F;
}
__device__ void phase_init_h(const Frame& F0) {
    const Frame F = relaunder(F0);
    const float* xp = F.inp(0); const float* xs = F.inp(1); const float* meta = F.inp(6);
    for (int row = F.bid * 8 + F.wave; row < M_TOT; row += F.G * 8) {
        const float* src = nullptr;
        if (row < ROW_S0) { const int b = row / TPP, r = row % TPP; if (r >= 64) src = xp + ((size_t)b * SEQ + (r - 64)) * D; else if (r >= PADF) src = meta + (size_t)(r - PADF) * D; }
        else src = xs + (size_t)(row - ROW_S0) * D;
        float ss = 0.f;
#pragma unroll
        for (int i = 0; i < 4; ++i) {
            f32x4 v = (f32x4){0.f, 0.f, 0.f, 0.f};
            if (src) v = *(const f32x4*)(src + (F.lane + 64 * i) * 4);
            ss += (v[0] * v[0] + v[1] * v[1]) + (v[2] * v[2] + v[3] * v[3]);
            u32x2 w; w.x = cvt_pk_bf16(v[0], v[1]); w.y = cvt_pk_bf16(v[2], v[3]);
            *(u32x2*)(F.hb + (size_t)row * D + (F.lane + 64 * i) * 4) = w;
        }
        ss = wave_sum(ss);
        if (F.lane < 16) F.rss[(size_t)row * 16 + F.lane] = (F.lane == 0) ? ss : 0.f;
    }
}

__device__ void transpose_convert(const Frame& F, const float* src, int K, int N, int Npad, bf16_t* dst, const float* scale, int smod) {
    float* tile = (float*)F.lds;
    const int ntk = K / 64, ntn = Npad / 64, ntile = ntk * ntn;
    for (int ti = F.bid; ti < ntile; ti += F.G) {
        const int kt = ti % ntk, nt_ = ti / ntk, k0 = kt * 64, n0 = nt_ * 64;
        const int kk = F.tid >> 4, n4 = (F.tid & 15) * 4;
#pragma unroll
        for (int h = 0; h < 2; ++h) {
            const int k = k0 + kk + 32 * h, n = n0 + n4;
            f32x4 v = (f32x4){0.f, 0.f, 0.f, 0.f};
            if (n < N) v = *(const f32x4*)(src + (size_t)k * N + n);
            const float s = scale[k % smod];
            float* tp = tile + (kk + 32 * h) * 65 + n4;
            tp[0] = v[0] * s; tp[1] = v[1] * s; tp[2] = v[2] * s; tp[3] = v[3] * s;
        }
        __syncthreads();
        const int nn = F.tid >> 3, kg = (F.tid & 7) * 8;
        float x[8];
#pragma unroll
        for (int j = 0; j < 8; ++j) x[j] = tile[(kg + j) * 65 + nn];
        u32x4 w; w.x = cvt_pk_bf16(x[0], x[1]); w.y = cvt_pk_bf16(x[2], x[3]); w.z = cvt_pk_bf16(x[4], x[5]); w.w = cvt_pk_bf16(x[6], x[7]);
        *(u32x4*)(dst + (size_t)(n0 + nn) * K + k0 + kg) = w;
        __syncthreads();
    }
}
__device__ void phase_wprep(const Frame& F0, int L) {
    const Frame F = relaunder(F0);
    const int j = L >> 1;
    if ((L & 1) == 0) {
        transpose_convert(F, F.inp(8) + (size_t)j * D * SSD_IN, D, SSD_IN, SSD_IN_PAD, F.win, F.inp(7) + j * D, D);
        transpose_convert(F, F.inp(15) + (size_t)j * SSD_INNER * D, SSD_INNER, D, D, F.wout + (size_t)(L & 1) * 1024 * 2048, F.inp(14) + j * SSD_INNER, SSD_INNER);
    } else {
        transpose_convert(F, F.inp(17) + (size_t)j * D * GDN_IN, D, GDN_IN, GDN_IN_PAD, F.win, F.inp(16) + j * D, D);
        transpose_convert(F, F.inp(22) + (size_t)j * GDN_VAL * D, GDN_VAL, D, D, F.wout + (size_t)(L & 1) * 1024 * 2048, F.inp(21) + j * GDN_DV, GDN_DV);
    }
}

__device__ void phase_inproj(const Frame& F0, int L) {
    const Frame F = relaunder(F0);
    const int npad = (L & 1) ? GDN_IN_PAD : SSD_IN_PAD;
    pg8::Gemm g{F.hb, F.win, M_TOT, npad, D, D, D};
    pg8::StaticOrder S; S.init(M_TOT, npad, F.G, F.bid);
    pg8::EpiInProj E{F.proj, F.dtb, F.rss, npad / 256 - 1};
    pg8::gemm_phase<pg8::EpiInProj>(F.ldsl, g, S, E, F.tid);
}
__device__ void phase_outproj(const Frame& F0, int L) {
    const Frame F = relaunder(F0);
    const bf16_t* A = F.proj + ((L & 1) ? 4096 : 0);
    pg8::Gemm g{A, F.wout + (size_t)(L & 1) * 1024 * 2048, M_TOT, D, 2048, LDP, 2048};
    pg8::StaticOrder S; S.init(M_TOT, D, F.G, F.bid);
    pg8::EpiOutProj E{F.hb, F.rss};
    pg8::gemm_phase<pg8::EpiOutProj>(F.ldsl, g, S, E, F.tid);
}

__device__ void phase_ssd_naive(const Frame& F0, int j) {
    const Frame F = relaunder(F0);
    float* xs = (float*)F.lds;
    float* Bs = xs + 64 * 64;
    float* Cs = Bs + 64 * 128;
    float* dts = Cs + 64 * 128;
    float* das = dts + 64;
    const float* conv_w = F.inp(9) + (size_t)j * 4 * SSD_CONV; const float* conv_b = F.inp(10) + (size_t)j * SSD_CONV;
    const int p = F.tid >> 3, nq = F.tid & 7;
    for (int task = F.bid; task < NSEQ * SSD_HEADS; task += F.G) {
        const int s = task / SSD_HEADS, head = task % SSD_HEADS, grp = head >> 3;
        const int base = seq_base(s), nch = seq_chunks(s);
        const float dt_bias = F.inp(11)[j * SSD_HEADS + head], a = -__expf(F.inp(12)[j * SSD_HEADS + head]), dsk = F.inp(13)[j * SSD_HEADS + head];
        float h[16];
        if (s < 2) {
#pragma unroll
            for (int n = 0; n < 16; ++n) h[n] = 0.f;
        } else {
            const float* st = F.inp(2) + ((((size_t)j * 8 + (s - 2)) * SSD_HEADS + head) * SSD_P + p) * SSD_N + nq * 16;
#pragma unroll
            for (int n = 0; n < 16; ++n) h[n] = st[n];
        }
        int cidx = -1;
        if (F.tid < 64) cidx = head * 64 + F.tid; else if (F.tid < 192) cidx = 2048 + grp * 128 + (F.tid - 64); else if (F.tid < 320) cidx = 2560 + grp * 128 + (F.tid - 192);
        float w0 = 0, w1 = 0, w2 = 0, w3 = 0, cb = 0;
        if (cidx >= 0) { w0 = conv_w[cidx]; w1 = conv_w[SSD_CONV + cidx]; w2 = conv_w[2 * SSD_CONV + cidx]; w3 = conv_w[3 * SSD_CONV + cidx]; cb = conv_b[cidx]; }
        const float* cst = (s >= 2) ? F.inp(3) + (((size_t)j * 8 + (s - 2)) * 3) * SSD_CONV : nullptr;
        for (int c = 0; c < nch; ++c) {
            const int t0 = 64 * c - PADF;
            __syncthreads();
            if (cidx >= 0) {
                float r3, r2, r1;
                {   float rv[3];
#pragma unroll
                    for (int q = 0; q < 3; ++q) { const int t = t0 - 3 + q; float v = 0.f;
                        if (t >= 0) v = bf2f(F.proj[(size_t)(base + t) * LDP + 2048 + cidx]); else if (t >= -3 && cst) v = cst[(3 + t) * SSD_CONV + cidx];
                        rv[q] = v; }
                    r3 = rv[0]; r2 = rv[1]; r1 = rv[2]; }
                for (int i = 0; i < 64; ++i) {
                    const int t = t0 + i; float v = 0.f;
                    if (t >= 0) v = bf2f(F.proj[(size_t)(base + t) * LDP + 2048 + cidx]); else if (t >= -3 && cst) v = cst[(3 + t) * SSD_CONV + cidx];
                    const float o = silu_f(cb + w0 * r3 + w1 * r2 + w2 * r1 + w3 * v);
                    r3 = r2; r2 = r1; r1 = v;
                    if (F.tid < 64) xs[i * 64 + F.tid] = o; else if (F.tid < 192) Bs[i * 128 + (F.tid - 64)] = o; else Cs[i * 128 + (F.tid - 192)] = o;
                }
            } else if (F.tid >= 448) {
                const int i = F.tid - 448, t = t0 + i;
                float dt = 0.f, da = 1.f;
                if (t >= 0) { dt = softplus_f(F.dtb[(size_t)(base + t) * 32 + head] + dt_bias); da = __expf(dt * a); }
                dts[i] = dt; das[i] = da;
            }
            __syncthreads();
            for (int i = 0; i < 64; ++i) {
                const int t = t0 + i;
                const float dt = dts[i], da = das[i], xv = xs[i * 64 + p], dx = dt * xv;
                const float* bp = Bs + i * 128 + nq * 16; const float* cp = Cs + i * 128 + nq * 16;
                float accv = 0.f;
#pragma unroll
                for (int n = 0; n < 16; ++n) { h[n] = h[n] * da + dx * bp[n]; accv += cp[n] * h[n]; }
                accv += __shfl_xor(accv, 1); accv += __shfl_xor(accv, 2); accv += __shfl_xor(accv, 4);
                if (nq == 0 && t >= 0) {
                    bf16_t* zp = F.proj + (size_t)(base + t) * LDP + head * 64 + p;
                    const float z = bf2f(*zp);
                    *zp = f2bf((accv + dsk * xv) * silu_f(z));
                }
            }
        }
        float* so = (s < 2) ? F.out + O_PSSD + ((((size_t)j * 2 + s) * SSD_HEADS + head) * SSD_P + p) * SSD_N + nq * 16
                            : F.out + O_SSSD + ((((size_t)j * 8 + (s - 2)) * SSD_HEADS + head) * SSD_P + p) * SSD_N + nq * 16;
#pragma unroll
        for (int n = 0; n < 16; ++n) so[n] = h[n];
    }
}


constexpr int NCHT = 266;
constexpr size_t SC_BT = 0;
constexpr size_t SC_C = SC_BT + (size_t)NCHT * 4 * 16384;
constexpr size_t SC_CB = SC_C + (size_t)NCHT * 4 * 16384;
constexpr size_t SC_VEC = SC_CB + (size_t)NCHT * 4 * 8192;
constexpr size_t SC_SSD_END = SC_VEC + (size_t)NCHT * 32 * 1024;
static_assert(SC_SSD_END <= (size_t)16777216 * 4, "scratch must fit the y_prompt region");
__device__ __forceinline__ int qperm(int s) { return (s & ~31) | (((s >> 2) & 3) << 3) | (((s >> 4) & 1) << 2) | (s & 3); }
__device__ __forceinline__ int qnat(int q) { return (q & ~31) | (((q >> 2) & 1) << 4) | (((q >> 3) & 3) << 2) | (q & 3); }
__device__ __forceinline__ bf16x8 pack8(f32x4 a, f32x4 b) {
    u32x4 w; w.x = cvt_pk_bf16(a[0], a[1]); w.y = cvt_pk_bf16(a[2], a[3]); w.z = cvt_pk_bf16(b[0], b[1]); w.w = cvt_pk_bf16(b[2], b[3]);
    return __builtin_bit_cast(bf16x8, w);
}
__device__ __forceinline__ void chunk_of(int cgi, int& seq, int& c) { if (cgi < 258) { seq = cgi / 129; c = cgi % 129; } else { seq = 2 + (cgi - 258); c = 0; } }
__device__ __forceinline__ int cgi_of(int seq, int c) { return seq < 2 ? seq * 129 + c : 258 + (seq - 2); }

__device__ void phase_ssd_prep(const Frame& F0, int j) {
    const Frame F = relaunder(F0);
    bf16_t* Bs = (bf16_t*)F.lds;
    bf16_t* Cs = Bs + 64 * 136;
    unsigned char* sc = (unsigned char*)F.out;
    const float* conv_w = F.inp(9) + (size_t)j * 4 * SSD_CONV; const float* conv_b = F.inp(10) + (size_t)j * SSD_CONV;
    const int i16 = F.lane & 15, g4 = F.lane >> 4;
    for (int task = F.bid; task < NCHT * 4; task += F.G) {
        const int cgi = task >> 2, grp = task & 3; int seq, c; chunk_of(cgi, seq, c);
        const int base = seq_base(seq), t0 = 64 * c - PADF;
        __syncthreads();
        {
            const int ch = F.tid & 255, half = F.tid >> 8, isC = ch >> 7, n = ch & 127;
            const int cidx = 2048 + isC * 512 + grp * 128 + n;
            const float w0 = conv_w[cidx], w1 = conv_w[SSD_CONV + cidx], w2 = conv_w[2 * SSD_CONV + cidx], w3 = conv_w[3 * SSD_CONV + cidx], cb = conv_b[cidx];
            const float* cst = (seq >= 2) ? F.inp(3) + (((size_t)j * 8 + (seq - 2)) * 3) * SSD_CONV : nullptr;
            bf16_t* dst = (isC ? Cs : Bs) + n;
            float r3, r2, r1;
            {   float rv[3];
#pragma unroll
                for (int q = 0; q < 3; ++q) { const int t = t0 + half * 32 - 3 + q; float v = 0.f;
                    if (t >= 0) v = bf2f(F.proj[(size_t)(base + t) * LDP + 2048 + cidx]); else if (t >= -3 && cst) v = cst[(3 + t) * SSD_CONV + cidx];
                    rv[q] = v; }
                r3 = rv[0]; r2 = rv[1]; r1 = rv[2]; }
            for (int ii = 0; ii < 32; ++ii) {
                const int p = half * 32 + ii, t = t0 + p; float v = 0.f;
                if (t >= 0) v = bf2f(F.proj[(size_t)(base + t) * LDP + 2048 + cidx]); else if (t >= -3 && cst) v = cst[(3 + t) * SSD_CONV + cidx];
                const float o = silu_f(cb + w0 * r3 + w1 * r2 + w2 * r1 + w3 * v);
                r3 = r2; r2 = r1; r1 = v;
                dst[p * 136] = f2bf(o);
            }
        }
        __syncthreads();
        {
            bf16_t* BT = (bf16_t*)(sc + SC_BT) + (size_t)(cgi * 4 + grp) * 8192;
            const int n = F.tid >> 2, qg = (F.tid & 3) * 16;
#pragma unroll
            for (int u = 0; u < 2; ++u) {
                const int q0 = qg + 8 * u; unsigned short e[8];
#pragma unroll
                for (int jj = 0; jj < 8; ++jj) e[jj] = Bs[qnat(q0 + jj) * 136 + n];
                u32x4 w; w.x = e[0] | ((unsigned)e[1] << 16); w.y = e[2] | ((unsigned)e[3] << 16); w.z = e[4] | ((unsigned)e[5] << 16); w.w = e[6] | ((unsigned)e[7] << 16);
                *(u32x4*)(BT + n * 64 + q0) = w;
            }
            bf16_t* Cg = (bf16_t*)(sc + SC_C) + (size_t)(cgi * 4 + grp) * 8192;
#pragma unroll
            for (int u = 0; u < 2; ++u) {
                const int idx = F.tid + 512 * u, l = idx >> 4, qg8 = idx & 15, kk = qg8 >> 2, gg = qg8 & 3;
                const u32x2 a = *(const u32x2*)(Cs + l * 136 + 32 * kk + 4 * gg), b = *(const u32x2*)(Cs + l * 136 + 32 * kk + 16 + 4 * gg);
                u32x4 w; w.x = a.x; w.y = a.y; w.z = b.x; w.w = b.y;
                *(u32x4*)(Cg + l * 128 + 8 * qg8) = w;
            }
        }
        {
            bf16_t* CB = (bf16_t*)(sc + SC_CB) + (size_t)(cgi * 4 + grp) * 4096;
            const int m = F.wave >> 1;
#pragma unroll
            for (int u = 0; u < 2; ++u) {
                const int st = 2 * (F.wave & 1) + u; f32x4 acc = (f32x4){0.f, 0.f, 0.f, 0.f};
#pragma unroll
                for (int kk = 0; kk < 4; ++kk) {
                    const bf16x8 a = *(const bf16x8*)(Cs + (16 * m + i16) * 136 + 32 * kk + 8 * g4);
                    const bf16x8 b = *(const bf16x8*)(Bs + (16 * st + i16) * 136 + 32 * kk + 8 * g4);
                    acc = __builtin_amdgcn_mfma_f32_16x16x32_bf16(a, b, acc, 0, 0, 0);
                }
                const int qs = qperm(16 * st + i16);
#pragma unroll
                for (int jj = 0; jj < 4; ++jj) CB[(16 * m + 4 * g4 + jj) * 64 + qs] = f2bf(acc[jj]);
            }
        }
        {
            const int head = grp * 8 + F.wave, t = t0 + F.lane;
            const float a = -__expf(F.inp(12)[j * SSD_HEADS + head]);
            float dt = 0.f;
            if (t >= 0) dt = softplus_f(F.dtb[(size_t)(base + t) * 32 + head] + F.inp(11)[j * SSD_HEADS + head]);
            float cs = dt * a;
#pragma unroll
            for (int o = 1; o < 64; o <<= 1) { const float y = __shfl_up(cs, o); if (F.lane >= o) cs += y; }
            const float cs_last = __shfl(cs, 63), cs_be = __shfl(cs, F.lane | 3);
            float* vp = (float*)(sc + SC_VEC) + (size_t)(cgi * 32 + head) * 256;
            vp[F.lane] = cs; vp[64 + F.lane] = __expf(cs_be - cs) * dt; vp[128 + F.lane] = dt * __expf(cs_last - cs); vp[192 + F.lane] = __expf(cs);
        }
    }
}

__device__ void phase_ssd_chain(const Frame& F0, int j) {
    const Frame F = relaunder(F0);
    unsigned char* sc = (unsigned char*)F.out;
    const int i = F.lane & 15, g = F.lane >> 4;
    const float* conv_w = F.inp(9) + (size_t)j * 4 * SSD_CONV; const float* conv_b = F.inp(10) + (size_t)j * SSD_CONV;
    for (int bt = F.bid; bt < 192; bt += F.G) {
        int sh;
        if (bt < 64) { if (F.wave >= 4) continue; sh = bt; } else sh = 64 + (bt - 64) * 2 + (F.wave >> 2);
        const int seq = sh < 64 ? (sh >> 5) : 2 + ((sh - 64) >> 5), head = sh & 31, ps = F.wave & 3, grp = head >> 3;
        const int base = seq_base(seq), nch = seq_chunks(seq);
        const float dsk = F.inp(13)[j * SSD_HEADS + head];
        const int cx = head * 64 + ps * 16 + i;
        const float w0 = conv_w[cx], w1 = conv_w[SSD_CONV + cx], w2 = conv_w[2 * SSD_CONV + cx], w3 = conv_w[3 * SSD_CONV + cx], cb = conv_b[cx];
        const float* cst = (seq >= 2) ? F.inp(3) + (((size_t)j * 8 + (seq - 2)) * 3) * SSD_CONV + cx : nullptr;
        f32x4 HT[8];
        if (seq < 2) {
#pragma unroll
            for (int m8 = 0; m8 < 8; ++m8) HT[m8] = (f32x4){0.f, 0.f, 0.f, 0.f};
        } else {
            const float* st = F.inp(2) + ((((size_t)j * 8 + (seq - 2)) * SSD_HEADS + head) * SSD_P + ps * 16 + i) * SSD_N + 4 * g;
#pragma unroll
            for (int m8 = 0; m8 < 8; ++m8) HT[m8] = *(const f32x4*)(st + 16 * m8);
        }
        for (int c = 0; c < nch; ++c) {
            const int cgi = cgi_of(seq, c), t0 = 64 * c - PADF;
            const bf16_t* Cp = (const bf16_t*)(sc + SC_C) + (size_t)(cgi * 4 + grp) * 8192;
            const bf16_t* BTp = (const bf16_t*)(sc + SC_BT) + (size_t)(cgi * 4 + grp) * 8192;
            const bf16_t* CBp = (const bf16_t*)(sc + SC_CB) + (size_t)(cgi * 4 + grp) * 4096;
            const float* vp = (const float*)(sc + SC_VEC) + (size_t)(cgi * 32 + head) * 256;
            f32x4 cs4[4], e24[4], w4[4], ecs4[4]; float cs_row[4];
#pragma unroll
            for (int m = 0; m < 4; ++m) { cs4[m] = *(const f32x4*)(vp + 16 * m + 4 * g); e24[m] = *(const f32x4*)(vp + 64 + 16 * m + 4 * g); w4[m] = *(const f32x4*)(vp + 128 + 16 * m + 4 * g);
                ecs4[m] = *(const f32x4*)(vp + 192 + 16 * m + 4 * g); cs_row[m] = vp[16 * m + i]; }
            const float ecl = vp[192 + 63];
            bf16x8 Hf[4];
#pragma unroll
            for (int kk = 0; kk < 4; ++kk) Hf[kk] = pack8(HT[2 * kk], HT[2 * kk + 1]);
            f32x4 Y[4];
#pragma unroll
            for (int m = 0; m < 4; ++m) {
                f32x4 acc = (f32x4){0.f, 0.f, 0.f, 0.f};
#pragma unroll
                for (int kk = 0; kk < 4; ++kk) { const bf16x8 cf = *(const bf16x8*)(Cp + (16 * m + i) * 128 + 32 * kk + 8 * g); acc = __builtin_amdgcn_mfma_f32_16x16x32_bf16(cf, Hf[kk], acc, 0, 0, 0); }
                Y[m] = acc * ecs4[m];
            }
            f32x4 xv[4];
#pragma unroll
            for (int m = 0; m < 4; ++m) {
                float r[7];
#pragma unroll
                for (int q = 0; q < 7; ++q) { const int t = t0 + 16 * m + 4 * g - 3 + q; float v = 0.f;
                    if (t >= 0) v = bf2f(F.proj[(size_t)(base + t) * LDP + 2048 + cx]); else if (t >= -3 && cst) v = cst[(3 + t) * SSD_CONV];
                    r[q] = v; }
#pragma unroll
                for (int jj = 0; jj < 4; ++jj) xv[m][jj] = silu_f(cb + w0 * r[jj] + w1 * r[jj + 1] + w2 * r[jj + 2] + w3 * r[jj + 3]);
            }
            bf16x8 xsf[2], xwf[2];
#pragma unroll
            for (int k2 = 0; k2 < 2; ++k2) { xsf[k2] = pack8(xv[2 * k2] * e24[2 * k2], xv[2 * k2 + 1] * e24[2 * k2 + 1]); xwf[k2] = pack8(xv[2 * k2] * w4[2 * k2], xv[2 * k2 + 1] * w4[2 * k2 + 1]); }
#pragma unroll
            for (int m = 0; m < 4; ++m) {
                const int l = 16 * m + i;
#pragma unroll
                for (int k2 = 0; k2 < 2; ++k2) {
                    const u32x4 cbw = *(const u32x4*)(CBp + l * 64 + 32 * k2 + 8 * g);
                    const float e1a = __expf(cs_row[m] - cs4[2 * k2][3]), e1b = __expf(cs_row[m] - cs4[2 * k2 + 1][3]);
                    const int sa = 32 * k2 + 4 * g, sb = sa + 16;
                    f32x4 va, vb;
                    va[0] = (sa + 0 <= l) ? __uint_as_float(cbw.x << 16) * e1a : 0.f; va[1] = (sa + 1 <= l) ? __uint_as_float(cbw.x & 0xffff0000u) * e1a : 0.f;
                    va[2] = (sa + 2 <= l) ? __uint_as_float(cbw.y << 16) * e1a : 0.f; va[3] = (sa + 3 <= l) ? __uint_as_float(cbw.y & 0xffff0000u) * e1a : 0.f;
                    vb[0] = (sb + 0 <= l) ? __uint_as_float(cbw.z << 16) * e1b : 0.f; vb[1] = (sb + 1 <= l) ? __uint_as_float(cbw.z & 0xffff0000u) * e1b : 0.f;
                    vb[2] = (sb + 2 <= l) ? __uint_as_float(cbw.w << 16) * e1b : 0.f; vb[3] = (sb + 3 <= l) ? __uint_as_float(cbw.w & 0xffff0000u) * e1b : 0.f;
                    Y[m] = __builtin_amdgcn_mfma_f32_16x16x32_bf16(pack8(va, vb), xsf[k2], Y[m], 0, 0, 0);
                }
            }
#pragma unroll
            for (int m8 = 0; m8 < 8; ++m8) {
                f32x4 acc = HT[m8] * ecl;
#pragma unroll
                for (int k2 = 0; k2 < 2; ++k2) { const bf16x8 bf = *(const bf16x8*)(BTp + (16 * m8 + i) * 64 + 32 * k2 + 8 * g); acc = __builtin_amdgcn_mfma_f32_16x16x32_bf16(bf, xwf[k2], acc, 0, 0, 0); }
                HT[m8] = acc;
            }
#pragma unroll
            for (int m = 0; m < 4; ++m)
#pragma unroll
                for (int jj = 0; jj < 4; ++jj) {
                    const int t = t0 + 16 * m + 4 * g + jj;
                    if (t >= 0) { bf16_t* zp = F.proj + (size_t)(base + t) * LDP + cx; const float z = bf2f(*zp); *zp = f2bf((Y[m][jj] + dsk * xv[m][jj]) * silu_f(z)); }
                }
        }
        float* so = (seq < 2) ? F.out + O_PSSD + ((((size_t)j * 2 + seq) * SSD_HEADS + head) * SSD_P + ps * 16 + i) * SSD_N + 4 * g
                              : F.out + O_SSSD + ((((size_t)j * 8 + (seq - 2)) * SSD_HEADS + head) * SSD_P + ps * 16 + i) * SSD_N + 4 * g;
#pragma unroll
        for (int m8 = 0; m8 < 8; ++m8) *(f32x4*)(so + 16 * m8) = HT[m8];
    }
}

__device__ void phase_ssd_post(const Frame& F0, int j) {
    const Frame F = relaunder(F0);
    for (int it = F.bid * 8 + F.wave; it < M_TOT * 4; it += F.G * 8) {
        const int row = it >> 2, grp = it & 3;
        u32x4* p = (u32x4*)(F.proj + (size_t)row * LDP + grp * 512 + F.lane * 8);
        const u32x4 v = *p; float x[8];
        x[0] = __uint_as_float(v.x << 16); x[1] = __uint_as_float(v.x & 0xffff0000u); x[2] = __uint_as_float(v.y << 16); x[3] = __uint_as_float(v.y & 0xffff0000u);
        x[4] = __uint_as_float(v.z << 16); x[5] = __uint_as_float(v.z & 0xffff0000u); x[6] = __uint_as_float(v.w << 16); x[7] = __uint_as_float(v.w & 0xffff0000u);
        float ss = 0.f;
#pragma unroll
        for (int q = 0; q < 8; ++q) ss += x[q] * x[q];
        ss = wave_sum(ss);
        const float rs = rsqrtf(ss * (1.0f / 512.0f) + EPS);
        u32x4 w; w.x = cvt_pk_bf16(x[0] * rs, x[1] * rs); w.y = cvt_pk_bf16(x[2] * rs, x[3] * rs); w.z = cvt_pk_bf16(x[4] * rs, x[5] * rs); w.w = cvt_pk_bf16(x[6] * rs, x[7] * rs);
        *p = w;
    }
    for (int e = F.bid * NTHREADS + F.tid; e < NSEQ * 3 * SSD_CONV; e += F.G * NTHREADS) {
        const int s = e / (3 * SSD_CONV), r = (e / SSD_CONV) % 3, c = e % SSD_CONV;
        const int row = seq_base(s) + seq_len(s) - 3 + r;
        const float v = bf2f(F.proj[(size_t)row * LDP + 2048 + c]);
        if (s < 2) F.out[O_PSSDC + (((size_t)j * 2 + s) * 3 + r) * SSD_CONV + c] = v;
        else F.out[O_SSSDC + (((size_t)j * 8 + (s - 2)) * 3 + r) * SSD_CONV + c] = v;
    }
}

__device__ void phase_gdn_naive(const Frame& F0, int j) {
    const Frame F = relaunder(F0);
    constexpr int QP = 129;
    float* qs = (float*)F.lds;
    float* ks = qs + 64 * QP;
    float* vs = ks + 64 * QP;
    float* gs = vs + 64 * 256;
    float* bs = gs + 64;
    float* qk = bs + 64;
    float* exk = qk + 64;
    float* exq = exk + 2 * 2 * 256;
    float* exv = exq + 2 * 2 * 256;
    const float* conv_w = F.inp(18) + (size_t)j * 4 * GDN_CONV;
    const int v = F.tid & 255, kh = F.tid >> 8;
    for (int task = F.bid; task < NSEQ * GDN_HEADS; task += F.G) {
        const int s = task / GDN_HEADS, head = task % GDN_HEADS;
        const int base = seq_base(s), nch = seq_chunks(s);
        const float dt_bias = F.inp(19)[j * GDN_HEADS + head], aneg = -__expf(F.inp(20)[j * GDN_HEADS + head]);
        float S[64];
        if (s < 2) {
#pragma unroll
            for (int kk = 0; kk < 64; ++kk) S[kk] = 0.f;
        } else {
            const float* st = F.inp(4) + ((((size_t)j * 8 + (s - 2)) * GDN_HEADS + head) * GDN_DK + kh * 64) * GDN_DV + v;
#pragma unroll
            for (int kk = 0; kk < 64; ++kk) S[kk] = st[(size_t)kk * GDN_DV];
        }
        const int cidx = F.tid < 128 ? head * 128 + F.tid : (F.tid < 256 ? 1024 + head * 128 + (F.tid - 128) : 2048 + head * 256 + (F.tid - 256));
        const float w0 = conv_w[cidx], w1 = conv_w[GDN_CONV + cidx], w2 = conv_w[2 * GDN_CONV + cidx], w3 = conv_w[3 * GDN_CONV + cidx];
        const float* cst = (s >= 2) ? F.inp(5) + (((size_t)j * 8 + (s - 2)) * 3) * GDN_CONV : nullptr;
        for (int c = 0; c < nch; ++c) {
            const int t0 = 64 * c - PADF;
            __syncthreads();
            {
                float r3, r2, r1;
                {   float rv[3];
#pragma unroll
                    for (int q = 0; q < 3; ++q) { const int t = t0 - 3 + q; float x = 0.f;
                        if (t >= 0) x = bf2f(F.proj[(size_t)(base + t) * LDP + cidx]); else if (t >= -3 && cst) x = cst[(3 + t) * GDN_CONV + cidx];
                        rv[q] = x; }
                    r3 = rv[0]; r2 = rv[1]; r1 = rv[2]; }
                for (int i = 0; i < 64; ++i) {
                    const int t = t0 + i; float x = 0.f;
                    if (t >= 0) x = bf2f(F.proj[(size_t)(base + t) * LDP + cidx]); else if (t >= -3 && cst) x = cst[(3 + t) * GDN_CONV + cidx];
                    const float o = silu_f(w0 * r3 + w1 * r2 + w2 * r1 + w3 * x);
                    r3 = r2; r2 = r1; r1 = x;
                    if (F.tid < 128) qs[i * QP + F.tid] = o; else if (F.tid < 256) ks[i * QP + (F.tid - 128)] = o; else vs[i * 256 + (F.tid - 256)] = o;
                }
            }
            __syncthreads();
            if (F.tid < 128) {
                const int i = F.tid & 63; float* rowp = (F.tid < 64 ? qs : ks) + i * QP; float ss = 0.f;
                for (int k = 0; k < 128; ++k) ss += rowp[k] * rowp[k];
                const float sc = rsqrtf(ss + EPS) * (F.tid < 64 ? 0.08838834764831845f : 1.0f);
                for (int k = 0; k < 128; ++k) rowp[k] *= sc;
            } else if (F.tid < 192) {
                const int i = F.tid - 128, t = t0 + i; float ga = 1.f, be = 0.f;
                if (t >= 0) { const float* dp = F.dtb + (size_t)(base + t) * 32; ga = __expf(aneg * softplus_f(dp[head] + dt_bias)); be = 1.0f / (1.0f + __expf(-dp[8 + head])); }
                gs[i] = ga; bs[i] = be;
            }
            __syncthreads();
            if (F.tid < 64) { float d = 0.f; for (int k = 0; k < 128; ++k) d += qs[F.tid * QP + k] * ks[F.tid * QP + k]; qk[F.tid] = d; }
            __syncthreads();
            for (int i = 0; i < 64; ++i) {
                const float* kp = ks + i * QP + kh * 64; const float* qp = qs + i * QP + kh * 64;
                float pk = 0.f, pq = 0.f;
#pragma unroll
                for (int kk = 0; kk < 64; ++kk) { pk += kp[kk] * S[kk]; pq += qp[kk] * S[kk]; }
                const int eb = (i & 1) * 512;
                exk[eb + kh * 256 + v] = pk; exq[eb + kh * 256 + v] = pq; if (kh == 0) exv[(i & 1) * 256 + v] = vs[i * 256 + v];
                __syncthreads();
                const float kS = exk[eb + v] + exk[eb + 256 + v], qS = exq[eb + v] + exq[eb + 256 + v], vv = exv[(i & 1) * 256 + v];
                const float ga = gs[i], be = bs[i];
                const float delta = vv - ga * kS;
                const float bd = be * delta;
#pragma unroll
                for (int kk = 0; kk < 64; ++kk) S[kk] = ga * S[kk] + kp[kk] * bd;
                if (kh == 0) vs[i * 256 + v] = ga * qS + qk[i] * bd;
            }
            __syncthreads();
            for (int q = 0; q < 8; ++q) {
                const int i = F.wave * 8 + q, t = t0 + i;
                const f32x4 o = *(const f32x4*)(vs + i * 256 + F.lane * 4);
                float ss = (o[0] * o[0] + o[1] * o[1]) + (o[2] * o[2] + o[3] * o[3]);
                ss = wave_sum(ss);
                const float rs = rsqrtf(ss * (1.0f / 256.0f) + EPS);
                if (t >= 0) {
                    u32x2* zp = (u32x2*)(F.proj + (size_t)(base + t) * LDP + 4096 + head * 256 + F.lane * 4);
                    const u32x2 z = *zp;
                    const float z0 = __uint_as_float(z.x << 16), z1 = __uint_as_float(z.x & 0xffff0000u), z2 = __uint_as_float(z.y << 16), z3 = __uint_as_float(z.y & 0xffff0000u);
                    u32x2 w; w.x = cvt_pk_bf16(o[0] * rs * silu_f(z0), o[1] * rs * silu_f(z1)); w.y = cvt_pk_bf16(o[2] * rs * silu_f(z2), o[3] * rs * silu_f(z3));
                    *zp = w;
                }
            }
        }
        float* so = (s < 2) ? F.out + O_PGDN + ((((size_t)j * 2 + s) * GDN_HEADS + head) * GDN_DK + kh * 64) * GDN_DV + v
                            : F.out + O_SGDN + ((((size_t)j * 8 + (s - 2)) * GDN_HEADS + head) * GDN_DK + kh * 64) * GDN_DV + v;
#pragma unroll
        for (int kk = 0; kk < 64; ++kk) so[(size_t)kk * GDN_DV] = S[kk];
    }
}
__device__ void phase_gdn_post(const Frame& F0, int j) {
    const Frame F = relaunder(F0);
    for (int e = F.bid * NTHREADS + F.tid; e < NSEQ * 3 * GDN_CONV; e += F.G * NTHREADS) {
        const int s = e / (3 * GDN_CONV), r = (e / GDN_CONV) % 3, c = e % GDN_CONV;
        const int row = seq_base(s) + seq_len(s) - 3 + r;
        const float v = bf2f(F.proj[(size_t)row * LDP + c]);
        if (s < 2) F.out[O_PGDNC + (((size_t)j * 2 + s) * 3 + r) * GDN_CONV + c] = v;
        else F.out[O_SGDNC + (((size_t)j * 8 + (s - 2)) * 3 + r) * GDN_CONV + c] = v;
    }
}

__device__ void phase_final(const Frame& F0) {
    const Frame F = relaunder(F0);
    const float* fw = F.inp(23);
    for (int it = F.bid * 8 + F.wave; it < 2 * SEQ + 128; it += F.G * 8) {
        int row; float* dst;
        if (it < 2 * SEQ) { const int b = it / SEQ, t = it % SEQ; row = b * TPP + 64 + t; dst = F.out + O_YP + (size_t)it * D; }
        else { row = ROW_S0 + (it - 2 * SEQ); dst = F.out + O_YS + (size_t)(it - 2 * SEQ) * D; }
        float x[16]; float ss = 0.f;
#pragma unroll
        for (int i = 0; i < 4; ++i) {
            const u32x2 v = *(const u32x2*)(F.hb + (size_t)row * D + (F.lane + 64 * i) * 4);
            x[4 * i + 0] = __uint_as_float(v.x << 16); x[4 * i + 1] = __uint_as_float(v.x & 0xffff0000u); x[4 * i + 2] = __uint_as_float(v.y << 16); x[4 * i + 3] = __uint_as_float(v.y & 0xffff0000u);
            ss += (x[4 * i] * x[4 * i] + x[4 * i + 1] * x[4 * i + 1]) + (x[4 * i + 2] * x[4 * i + 2] + x[4 * i + 3] * x[4 * i + 3]);
        }
        ss = wave_sum(ss);
        const float rs = rsqrtf(ss * (1.0f / 1024.0f) + EPS);
#pragma unroll
        for (int i = 0; i < 4; ++i) {
            const int c = (F.lane + 64 * i) * 4; const f32x4 w = *(const f32x4*)(fw + c);
            f32x4 o; o[0] = x[4 * i] * rs * w[0]; o[1] = x[4 * i + 1] * rs * w[1]; o[2] = x[4 * i + 2] * rs * w[2]; o[3] = x[4 * i + 3] * rs * w[3];
            *(f32x4*)(dst + c) = o;
        }
    }
}

constexpr int N_PHASES = 22;
#ifndef MK_ONE_LAUNCH
#define MK_ONE_LAUNCH 1
#endif
__global__ void __launch_bounds__(NTHREADS, 2) hybrid_fwd(Args args) {
    extern __shared__ __attribute__((aligned(16))) unsigned char lds[];
    volatile LAS unsigned* bst = (volatile LAS unsigned*)((LAS unsigned char*)lds + LDS_BYTES - 16);
    if (threadIdx.x < 4) bst[threadIdx.x] = 0u;
    __syncthreads();
    XcdBarrier bar; bar.bar = (unsigned*)(args.ws + WS_CTL); bar.x = 0; bar.st = bst;
    if (args.ph_hi - args.ph_lo > 1) bar = xcd_barrier_post((unsigned*)(args.ws + WS_CTL), bst);
    for (int ph = args.ph_lo; ph < args.ph_hi; ++ph) {
        int tid_ = threadIdx.x; asm volatile("" : "+v"(tid_));
        Frame F;
        F.ap = &args;
        F.out = args.out; F.ws = args.ws; F.lds = lds; F.ldsl = (LAS unsigned char*)lds;
        F.tid = tid_; F.lane = F.tid & 63; F.wave = __builtin_amdgcn_readfirstlane(F.tid >> 6); F.G = gridDim.x; F.bid = blockIdx.x;
        F.hb = nullptr; F.win = nullptr; F.wout = nullptr; F.dtb = nullptr; F.rss = nullptr; F.proj = nullptr;
        if (ph == 0) { phase_init_h(F); phase_wprep(F, 0); }
        else if (ph == N_PHASES - 1) phase_final(F);
        else {
            const int L = (ph - 1) / 5, sub = (ph - 1) % 5, j = L >> 1;
            if (sub == 0) phase_inproj(F, L);
            else if (sub == 1) { if (!(L & 1)) phase_ssd_prep(F, j); }
            else if (sub == 2) { if (L & 1) phase_gdn_naive(F, j); else phase_ssd_chain(F, j); }
            else if (sub == 3) { if (L & 1) phase_gdn_post(F, j); else phase_ssd_post(F, j); if (L < 3) phase_wprep(F, L + 1); }
            else phase_outproj(F, L);
        }
        if (ph + 1 < args.ph_hi) {
            if (ph == args.ph_lo) { __threadfence(); cg::this_grid().sync(); }
            else xcd_barrier(bar);
        }
    }
}

extern "C" void kernel_launch(void* const* d_in, const int* in_sizes, int n_in, void* d_out, int out_size, void* d_ws, size_t ws_size, hipStream_t stream) {
    static int grid = 0;
    if (grid == 0) {
        if (n_in != 24 || ws_size < WS_END) { fprintf(stderr, "kernel_launch: unexpected n_in %d / ws %zu (need %zu)\n", n_in, ws_size, (size_t)WS_END); grid = -1; return; }
        int dev = 0, cus = 0, per_cu = 0;
        if (hipGetDevice(&dev) != hipSuccess || hipDeviceGetAttribute(&cus, hipDeviceAttributeMultiprocessorCount, dev) != hipSuccess) { grid = -1; return; }
        if (hipFuncSetAttribute((const void*)hybrid_fwd, hipFuncAttributeMaxDynamicSharedMemorySize, LDS_BYTES) != hipSuccess) { fprintf(stderr, "kernel_launch: hipFuncSetAttribute failed\n"); grid = -1; return; }
        if (hipOccupancyMaxActiveBlocksPerMultiprocessor(&per_cu, (const void*)hybrid_fwd, NTHREADS, LDS_BYTES) != hipSuccess || per_cu < 1) { fprintf(stderr, "kernel_launch: occupancy query says %d blocks per CU\n", per_cu); grid = -1; return; }
        (void)hipGetLastError();
        grid = cus;
    }
    if (grid < 0) return;
    Args a{};
    for (int i = 0; i < 24; ++i) a.in[i] = (const float*)d_in[i];
    a.out = (float*)d_out; a.ws = (unsigned char*)d_ws;
#if MK_ONE_LAUNCH
    (void)hipMemsetAsync((char*)d_ws + WS_CTL, 0, 16384, stream);
    a.ph_lo = 0; a.ph_hi = N_PHASES;
    void* kargs[] = {&a};
    hipError_t e = hipLaunchCooperativeKernel((const void*)hybrid_fwd, dim3(grid), dim3(NTHREADS), kargs, LDS_BYTES, stream);
    if (e != hipSuccess) fprintf(stderr, "kernel_launch: cooperative launch failed: %s (grid %d)\n", hipGetErrorString(e), grid);
#else
    for (int ph = 0; ph < N_PHASES; ++ph) {
        a.ph_lo = ph; a.ph_hi = ph + 1;
        hipLaunchKernelGGL(hybrid_fwd, dim3(grid), dim3(NTHREADS), LDS_BYTES, stream, a);
    }
#endif
}
```

```cpp
#include <hip/hip_runtime.h>
#include <hip/hip_cooperative_groups.h>
#include <cstdio>
#include <cstdint>
namespace cg = cooperative_groups;

#define LAS __attribute__((address_space(3)))
typedef unsigned short bf16_t;
typedef short bf16x8 __attribute__((ext_vector_type(8)));
typedef float f32x4 __attribute__((ext_vector_type(4)));
typedef unsigned u32x4 __attribute__((ext_vector_type(4)));
typedef unsigned u32x2 __attribute__((ext_vector_type(2)));

constexpr int D = 1024;
constexpr int SEQ = 8192, NMETA = 16, PADF = 48;
constexpr int TPP = 8256;
constexpr int ROW_S0 = 2 * TPP;
constexpr int M_TOT = ROW_S0 + 128;
constexpr int NSEQ = 10;
constexpr float EPS = 1e-6f;
constexpr int LDP = 6144;
constexpr int SSD_INNER = 2048, SSD_HEADS = 32, SSD_P = 64, SSD_N = 128, SSD_CONV = 3072, SSD_IN = 5152, SSD_IN_PAD = 5376;
constexpr int GDN_HEADS = 8, GDN_DK = 128, GDN_DV = 256, GDN_CONV = 4096, GDN_VAL = 2048, GDN_IN = 6160, GDN_IN_PAD = 6400;

constexpr size_t O_YP = 0, O_YS = 16777216, O_PSSD = 16908288, O_PSSDC = 17956864, O_PGDN = 17993728, O_PGDNC = 19042304,
                 O_SSSD = 19091456, O_SSSDC = 23285760, O_SGDN = 23433216, O_SGDNC = 27627520;

constexpr size_t WS_CTL = 0;
constexpr size_t WS_HB = 65536;
constexpr size_t WS_WIN = WS_HB + (size_t)M_TOT * D * 2;
constexpr size_t WS_WOUT = WS_WIN + (size_t)GDN_IN_PAD * D * 2;
constexpr size_t WS_TAIL = WS_WOUT + (size_t)1024 * 2048 * 2;
constexpr size_t WS_DTB = WS_TAIL + (size_t)258 * 3 * 4096 * 2;
constexpr size_t WS_RSS = WS_DTB + (size_t)M_TOT * 32 * 4;
constexpr size_t WS_PROJ = WS_RSS + (size_t)M_TOT * 16 * 4;
constexpr size_t WS_END = WS_PROJ + (size_t)M_TOT * LDP * 2;

constexpr int NTHREADS = 512;
constexpr int LDS_BYTES = 147456;

__device__ __forceinline__ float bf2f(bf16_t b) { return __uint_as_float(((unsigned)b) << 16); }
__device__ __forceinline__ bf16_t f2bf(float f) { unsigned u = __float_as_uint(f); u += 0x7FFFu + ((u >> 16) & 1u); return (bf16_t)(u >> 16); }
typedef __bf16 bf16v2_t __attribute__((ext_vector_type(2)));
typedef float f32x2_t __attribute__((ext_vector_type(2)));
__device__ __forceinline__ unsigned cvt_pk_bf16(float lo, float hi) { const bf16v2_t r = __builtin_convertvector((f32x2_t){lo, hi}, bf16v2_t); return __builtin_bit_cast(unsigned, r); }
__device__ __forceinline__ float silu_f(float x) { return x / (1.0f + __expf(-x)); }
__device__ __forceinline__ float softplus_f(float x) { return x > 20.f ? x : log1pf(__expf(x)); }
__device__ __forceinline__ float wave_sum(float v) {
#pragma unroll
    for (int o = 32; o >= 1; o >>= 1) v += __shfl_xor(v, o);
    return v;
}
__device__ __forceinline__ int seq_base(int s) { return s < 2 ? s * TPP + 64 - NMETA : ROW_S0 + 16 * (s - 2); }
__device__ __forceinline__ int seq_len(int s) { return s < 2 ? SEQ + NMETA : 16; }
__device__ __forceinline__ int seq_chunks(int s) { return s < 2 ? 129 : 1; }

namespace pg8 {
constexpr int BM = 256, BK = 64, HALF = 128, HTB = HALF * BK * 2, STAGE_BYTES = 8 * HTB, NXCD = 8, WGM = 8;
__device__ __forceinline__ int lds_byte(int r, int c) { const int st = (r >> 4) * 2 + (c >> 5), rr = r & 15, cc = c & 31, ob = rr * 64 + cc * 2; return st * 1024 + (ob ^ (((ob >> 9) & 1) << 5)); }
__device__ __forceinline__ void stage_rc(int b, int& R, int& C) { const int st = b / 1024, sb = b % 1024, swz = sb ^ (((sb >> 9) & 1) << 5); R = (st >> 1) * 16 + swz / 64; C = (st & 1) * 32 + (swz % 64) / 2; }
__device__ __forceinline__ int perm32(int rho) { const int n = rho >> 4, i = rho & 15; return 8 * (i >> 2) + 4 * n + (i & 3); }
struct Unit { int pm, pn; };
struct Gemm { const bf16_t* A; const bf16_t* Bt; int M, N, K, lda, ldb; };
struct StaticOrder {
    int nM, nN, nwg, G, c;
    __device__ void init(int M, int N, int G_, int c_) { nM = M / BM; nN = N / BM; nwg = nM * nN; G = G_; c = c_; }
    __device__ bool next(int i, Unit& u) const {
        const long L = (long)i * G + c; if (L >= nwg) return false;
        int wgid = (int)L; { const int q = nwg / NXCD, r = nwg % NXCD, xcd = wgid % NXCD, off = wgid / NXCD; wgid = (xcd < r ? xcd * (q + 1) : r * (q + 1) + (xcd - r) * q) + off; }
        const int nig = WGM * nN, gid = wgid / nig, fm = gid * WGM, gsz = (nM - fm) < WGM ? (nM - fm) : WGM;
        u.pm = fm + ((wgid % nig) % gsz); u.pn = (wgid % nig) / gsz; return true;
    }
};

template <class Epi>
__device__ __forceinline__ void gemm_phase(LAS unsigned char* lds, const Gemm g, const StaticOrder& S, const Epi& E, const int tid) {
    const int wid = __builtin_amdgcn_readfirstlane(tid >> 6), lane = tid & 63, wr = wid >> 2, wc = wid & 3, fr = lane & 15, fq = lane >> 4;
    const int K = g.K, nt = K / BK;
    unsigned voffA[2], voffB[2];
#pragma unroll
    for (int i = 0; i < 2; ++i) { int R, C; stage_rc(tid * 16 + i * 8192, R, C); const int Rb = Epi::PERM ? ((R & ~31) + perm32(R & 31)) : R;
        voffA[i] = (unsigned)(R * g.lda + C) * 2u; voffB[i] = (unsigned)(Rb * g.ldb + C) * 2u; }
    const size_t kstep = (size_t)(BK * 2);
    const size_t hstepA = (size_t)HALF * g.lda * 2, hstepB = (size_t)HALF * g.ldb * 2;
    const size_t tstepA = 2 * hstepA, tstepB = 2 * hstepB;
    const unsigned ldsw = (unsigned)wid * 1024u;
    const int aoff = lds_byte(wr * 64 + fr, fq * 8), boff = lds_byte(wc * 32 + fr, fq * 8);
#define PG8_SA(b, h) (((b) * 2 + (h)) * HTB)
#define PG8_SB(b, h) ((4 + (b) * 2 + (h)) * HTB)
#define PG8_STAGE(bufoff, gbase, voff) do { _Pragma("unroll") for (int _i = 0; _i < 2; ++_i) \
        __builtin_amdgcn_global_load_lds((const unsigned*)((const char*)(gbase) + (voff)[_i]), (LAS unsigned*)(lds + (bufoff) + ldsw + _i * 8192), 16, 0, 0); } while (0)
#define PG8_LDA(dst, b, h) do { _Pragma("unroll") for (int m = 0; m < 4; ++m) _Pragma("unroll") for (int k = 0; k < 2; ++k) dst[m][k] = *(const LAS bf16x8*)(lds + PG8_SA(b, h) + aoff + m * 2048 + k * 1024); } while (0)
#define PG8_LDB(dst, b, h) do { _Pragma("unroll") for (int n = 0; n < 2; ++n) _Pragma("unroll") for (int k = 0; k < 2; ++k) dst[n][k] = *(const LAS bf16x8*)(lds + PG8_SB(b, h) + boff + n * 2048 + k * 1024); } while (0)
#define PG8_MMA(ai, bj, At, Bt) do { __builtin_amdgcn_s_setprio(1); _Pragma("unroll") for (int m = 0; m < 4; ++m) _Pragma("unroll") for (int n = 0; n < 2; ++n) _Pragma("unroll") for (int k = 0; k < 2; ++k) \
        acc[ai][bj][m][n] = __builtin_amdgcn_mfma_f32_16x16x32_bf16(Bt[n][k], At[m][k], acc[ai][bj][m][n], 0, 0, 0); __builtin_amdgcn_s_setprio(0); } while (0)
#define PG8_WAIT_V(n) asm volatile("s_waitcnt vmcnt(" #n ")" ::: "memory")
#define PG8_WAIT_L(n) asm volatile("s_waitcnt lgkmcnt(" #n ")" ::: "memory")
#define PG8_BAR __builtin_amdgcn_s_barrier()
#define PG8_SCHED __builtin_amdgcn_sched_barrier(0)
    Unit cur, nxt; int ui = 0;
    if (!S.next(0, cur)) return;
    f32x4 acc[2][2][4][2];
#pragma unroll
    for (int a = 0; a < 2; ++a)
#pragma unroll
        for (int b = 0; b < 2; ++b)
#pragma unroll
            for (int m = 0; m < 4; ++m)
#pragma unroll
                for (int n = 0; n < 2; ++n) acc[a][b][m][n] = (f32x4){0.f, 0.f, 0.f, 0.f};
    bf16x8 At[4][2], B0[2][2], B1[2][2];
    const char* cA = (const char*)g.A + (size_t)cur.pm * tstepA; const char* cB = (const char*)g.Bt + (size_t)cur.pn * tstepB;
    PG8_STAGE(PG8_SB(0, 0), cB, voffB); PG8_STAGE(PG8_SA(0, 0), cA, voffA); PG8_STAGE(PG8_SB(0, 1), cB + hstepB, voffB); PG8_STAGE(PG8_SA(0, 1), cA + hstepA, voffA);
    if (wr == 1) PG8_BAR;
    PG8_WAIT_V(4); PG8_BAR;
    PG8_STAGE(PG8_SB(1, 0), cB + kstep, voffB); PG8_STAGE(PG8_SA(1, 0), cA + kstep, voffA); PG8_STAGE(PG8_SB(1, 1), cB + hstepB + kstep, voffB);
    PG8_WAIT_V(6); PG8_BAR;
    for (;;) {
        const bool has_next = S.next(ui + 1, nxt);
        const char* nA = has_next ? (const char*)g.A + (size_t)nxt.pm * tstepA : cA; const char* nB = has_next ? (const char*)g.Bt + (size_t)nxt.pn * tstepB : cB;
        for (int t = 0; t < nt; t += 2) {
            const bool last = (t == nt - 2);
            const char* a1 = cA + (size_t)(t + 1) * kstep;
            const char* a2 = last ? nA : cA + (size_t)(t + 2) * kstep; const char* b2 = last ? nB : cB + (size_t)(t + 2) * kstep;
            const char* a3 = a2 + kstep; const char* b3 = b2 + kstep;
            PG8_LDB(B0, 0, 0); PG8_SCHED; PG8_LDA(At, 0, 0); PG8_STAGE(PG8_SA(1, 1), a1 + hstepA, voffA);
            PG8_WAIT_L(8); PG8_BAR; PG8_WAIT_L(0); PG8_MMA(0, 0, At, B0); PG8_BAR; PG8_SCHED;
            PG8_LDB(B1, 0, 1); PG8_STAGE(PG8_SB(0, 0), b2, voffB);
            PG8_BAR; PG8_WAIT_L(0); PG8_MMA(0, 1, At, B1); PG8_BAR;
            PG8_LDA(At, 0, 1); PG8_STAGE(PG8_SA(0, 0), a2, voffA);
            PG8_BAR; PG8_WAIT_L(0); PG8_MMA(1, 0, At, B0); PG8_BAR; PG8_SCHED;
            PG8_STAGE(PG8_SB(0, 1), b2 + hstepB, voffB);
            PG8_WAIT_V(6); PG8_BAR; PG8_MMA(1, 1, At, B1); PG8_BAR;
            PG8_LDB(B0, 1, 0); PG8_SCHED; PG8_LDA(At, 1, 0); PG8_STAGE(PG8_SA(0, 1), a2 + hstepA, voffA);
            PG8_WAIT_L(8); PG8_BAR; PG8_WAIT_L(0); PG8_MMA(0, 0, At, B0); PG8_BAR; PG8_SCHED;
            PG8_LDB(B1, 1, 1); PG8_STAGE(PG8_SB(1, 0), b3, voffB);
            PG8_BAR; PG8_WAIT_L(0); PG8_MMA(0, 1, At, B1); PG8_BAR;
            PG8_LDA(At, 1, 1); PG8_STAGE(PG8_SA(1, 0), a3, voffA);
            PG8_BAR; PG8_WAIT_L(0); PG8_MMA(1, 0, At, B0); PG8_BAR; PG8_SCHED;
            PG8_STAGE(PG8_SB(1, 1), b3 + hstepB, voffB);
            PG8_WAIT_V(6); PG8_BAR; PG8_MMA(1, 1, At, B1); PG8_BAR;
        }
        E(acc, cur, wr, wc, fr, fq);
        if (!has_next) break;
#pragma unroll
        for (int a = 0; a < 2; ++a)
#pragma unroll
            for (int b = 0; b < 2; ++b)
#pragma unroll
                for (int m = 0; m < 4; ++m)
#pragma unroll
                    for (int n = 0; n < 2; ++n) acc[a][b][m][n] = (f32x4){0.f, 0.f, 0.f, 0.f};
        cur = nxt; cA = nA; cB = nB; ++ui;
    }
    PG8_WAIT_V(0);
    if (wr == 0) PG8_BAR;
    PG8_BAR;
#undef PG8_SA
#undef PG8_SB
#undef PG8_STAGE
#undef PG8_LDA
#undef PG8_LDB
#undef PG8_MMA
#undef PG8_WAIT_V
#undef PG8_WAIT_L
#undef PG8_BAR
#undef PG8_SCHED
}

struct EpiInProj {
    static constexpr bool PERM = true;
    bf16_t* proj; float* dtb; const float* rowss; int nt_main; bf16_t* tails;
    __device__ __forceinline__ void operator()(const f32x4 (&acc)[2][2][4][2], const Unit& u, int wr, int wc, int fr, int fq) const {
        const int row0 = u.pm * BM + wr * 64 + fr;
#pragma unroll
        for (int ai = 0; ai < 2; ++ai)
#pragma unroll
            for (int m = 0; m < 4; ++m) {
                const int r = row0 + ai * HALF + m * 16;
                const f32x4* rp = (const f32x4*)(rowss + (size_t)r * 16);
                const f32x4 p0 = rp[0], p1 = rp[1], p2 = rp[2], p3 = rp[3];
                const float ss = ((p0[0] + p0[1]) + (p0[2] + p0[3])) + ((p1[0] + p1[1]) + (p1[2] + p1[3])) + ((p2[0] + p2[1]) + (p2[2] + p2[3])) + ((p3[0] + p3[1]) + (p3[2] + p3[3]));
                const float rstd = rsqrtf(ss * (1.0f / 1024.0f) + EPS);
                if (u.pn < nt_main) {
                    bf16_t* rowp = proj + (size_t)r * LDP + u.pn * BM + wc * 32 + 8 * fq;
#pragma unroll
                    for (int bj = 0; bj < 2; ++bj) { const f32x4 v0 = acc[ai][bj][m][0] * rstd, v1 = acc[ai][bj][m][1] * rstd;
                        u32x4 w; w.x = cvt_pk_bf16(v0[0], v0[1]); w.y = cvt_pk_bf16(v0[2], v0[3]); w.z = cvt_pk_bf16(v1[0], v1[1]); w.w = cvt_pk_bf16(v1[2], v1[3]);
                        *(u32x4*)(rowp + bj * HALF) = w;
                        if (tails && u.pn < 16 && r < ROW_S0 && (r & 63) >= 61) *(u32x4*)(tails + ((size_t)(r >> 6) * 3 + ((r & 63) - 61)) * 4096 + u.pn * BM + wc * 32 + 8 * fq + bj * HALF) = w; }
                } else if (wc == 0) {
                    float* dp = dtb + (size_t)r * 32 + 8 * fq;
                    *(f32x4*)(dp) = acc[ai][0][m][0] * rstd; *(f32x4*)(dp + 4) = acc[ai][0][m][1] * rstd;
                }
            }
    }
};
struct EpiOutProj {
    static constexpr bool PERM = false;
    bf16_t* hb; float* rowss;
    __device__ __forceinline__ void operator()(const f32x4 (&acc)[2][2][4][2], const Unit& u, int wr, int wc, int fr, int fq) const {
        const int row0 = u.pm * BM + wr * 64 + fr, col0 = u.pn * BM + wc * 32 + 4 * fq;
#pragma unroll
        for (int ai = 0; ai < 2; ++ai)
#pragma unroll
            for (int m = 0; m < 4; ++m) {
                const int r = row0 + ai * HALF + m * 16; float ss = 0.f;
                bf16_t* rowp = hb + (size_t)r * D + col0;
#pragma unroll
                for (int bj = 0; bj < 2; ++bj)
#pragma unroll
                    for (int n = 0; n < 2; ++n) {
                        u32x2* p = (u32x2*)(rowp + bj * HALF + n * 16); const u32x2 o = *p;
                        const f32x4 a = acc[ai][bj][m][n];
                        const float h0 = __uint_as_float(o.x << 16) + a[0], h1 = __uint_as_float(o.x & 0xffff0000u) + a[1];
                        const float h2 = __uint_as_float(o.y << 16) + a[2], h3 = __uint_as_float(o.y & 0xffff0000u) + a[3];
                        ss += (h0 * h0 + h1 * h1) + (h2 * h2 + h3 * h3);
                        u32x2 w; w.x = cvt_pk_bf16(h0, h1); w.y = cvt_pk_bf16(h2, h3); *p = w;
                    }
                ss += __shfl_xor(ss, 16); ss += __shfl_xor(ss, 32);
                if (fq == 0) rowss[(size_t)r * 16 + u.pn * 4 + wc] = ss;
            }
    }
};
}

#define XB_TMO      128
#define XB_XCNT(j)  (256  + 64 * (j))
#define XB_XSUB(j)  (1280 + 64 * (j))
#define XB_XGEN(j)  (2304 + 64 * (j))
#define XB_TOP      3328
#define XB_TOPGEN   3392
#define XCD_BAR_WORDS 3456
#define XB_SPIN_CAP (1u << 24)
__device__ __forceinline__ unsigned xb_ld(unsigned* p)              { return __hip_atomic_load(p, __ATOMIC_RELAXED, __HIP_MEMORY_SCOPE_AGENT); }
__device__ __forceinline__ unsigned xb_add(unsigned* p, unsigned v) { return __hip_atomic_fetch_add(p, v, __ATOMIC_RELAXED, __HIP_MEMORY_SCOPE_AGENT); }
__device__ __forceinline__ unsigned xb_xcc_id() { return (unsigned)__builtin_amdgcn_s_getreg((3 << 11) | 20) & 0xFu; }
#define XB_SPIN(cond, bar) do { unsigned _sp = 0; while (cond) { __builtin_amdgcn_s_sleep(1); \
    if ((++_sp & 255u) == 0u) { if (xb_ld(&(bar)[XB_TMO])) break; if (_sp > XB_SPIN_CAP) { atomicAdd(&(bar)[XB_TMO], 1u); break; } } } } while (0)
struct XcdBarrier { unsigned* bar; unsigned x; volatile LAS unsigned* st; };
__device__ __forceinline__ XcdBarrier xcd_barrier_post(unsigned* bar, volatile LAS unsigned* st) {
    XcdBarrier b; b.bar = bar; b.x = xb_xcc_id(); b.st = st;
    if (threadIdx.x == 0) (void)xb_add(&bar[XB_XCNT(b.x)], 1u);
    return b;
}
__device__ __forceinline__ void xcd_barrier_complete(unsigned* bar, unsigned x, unsigned& nloc, unsigned& nx) {
    const unsigned G = gridDim.x * gridDim.y * gridDim.z;
    unsigned sum, cnt, mine, sp = 0u;
    for (;;) {
        sum = 0u; cnt = 0u; mine = 0u;
#pragma unroll
        for (unsigned j = 0; j < 16; ++j) { const unsigned c = xb_ld(&bar[XB_XCNT(j)]); sum += c; cnt += (c > 0u) ? 1u : 0u; mine = (j == x) ? c : mine; }
        if (sum == G) break;
        __builtin_amdgcn_s_sleep(1);
        if ((++sp & 255u) == 0u) { if (xb_ld(&bar[XB_TMO])) break; if (sp > XB_SPIN_CAP) { atomicAdd(&bar[XB_TMO], 1u); break; } }
    }
    nloc = mine > 0u ? mine : 1u; nx = cnt > 0u ? cnt : 1u;
}
__device__ __forceinline__ void xcd_barrier(const XcdBarrier& b) {
    asm volatile("s_waitcnt vmcnt(0)" ::: "memory");
    __syncthreads();
    if (threadIdx.x == 0) {
        unsigned* bar = b.bar;
        __builtin_amdgcn_s_waitcnt(0);
        unsigned nloc = b.st[0], nx = b.st[1];
        if (nloc == 0u) { xcd_barrier_complete(bar, b.x, nloc, nx); b.st[0] = nloc; b.st[1] = nx; }
        const unsigned old = xb_add(&bar[XB_XSUB(b.x)], 1u);
        const unsigned gen = old / nloc;
        if (old + 1u == (gen + 1u) * nloc) {
            __builtin_amdgcn_fence(__ATOMIC_RELEASE, "agent");
            asm volatile("s_waitcnt vmcnt(0)" ::: "memory");
            const unsigned og = xb_add(&bar[XB_TOP], 1u);
            const unsigned tg = og / nx;
            if (og + 1u == (tg + 1u) * nx) xb_add(&bar[XB_TOPGEN], 1u);
            else XB_SPIN(xb_ld(&bar[XB_TOPGEN]) == tg, bar);
            __builtin_amdgcn_fence(__ATOMIC_ACQUIRE, "agent");
            xb_add(&bar[XB_XGEN(b.x)], 1u);
            asm volatile("s_waitcnt vmcnt(0)" ::: "memory");
        } else {
            XB_SPIN(xb_ld(&bar[XB_XGEN(b.x)]) == gen, bar);
            __builtin_amdgcn_fence(__ATOMIC_ACQUIRE, "agent");
            asm volatile("s_waitcnt vmcnt(0)" ::: "memory");
        }
    }
    __syncthreads();
}

struct Args { const float* in[24]; float* out; unsigned char* ws; int ph_lo, ph_hi; };

struct Frame {
    const Args* ap; float* out; unsigned char* ws;
    __device__ __forceinline__ const float* inp(int i) const { asm volatile("" : "+s"(i)); return ap->in[i]; }
    unsigned char* lds; LAS unsigned char* ldsl;
    int tid, lane, wave, G, bid;
    bf16_t* hb; bf16_t* win; bf16_t* wout; float* dtb; float* rss; bf16_t* proj; bf16_t* tails;
};

__device__ __forceinline__ Frame relaunder(Frame F) {
    int t = F.tid; asm volatile("" : "+v"(t));
    F.tid = t; F.lane = t & 63; F.wave = __builtin_amdgcn_readfirstlane(t >> 6);
    unsigned char* w = F.ws; asm volatile("" : "+s"(w));
    F.ws = w; F.hb = (bf16_t*)(w + WS_HB); F.win = (bf16_t*)(w + WS_WIN); F.wout = (bf16_t*)(w + WS_WOUT);
    F.dtb = (float*)(w + WS_DTB); F.rss = (float*)(w + WS_RSS); F.proj = (bf16_t*)(w + WS_PROJ); F.tails = (bf16_t*)(w + WS_TAIL);
    return F;
}
__device__ void phase_init_h(const Frame& F0) {
    const Frame F = relaunder(F0);
    const float* xp = F.inp(0); const float* xs = F.inp(1); const float* meta = F.inp(6);
    for (int row = F.bid * 8 + F.wave; row < M_TOT; row += F.G * 8) {
        const float* src = nullptr;
        if (row < ROW_S0) { const int b = row / TPP, r = row % TPP; if (r >= 64) src = xp + ((size_t)b * SEQ + (r - 64)) * D; else if (r >= PADF) src = meta + (size_t)(r - PADF) * D; }
        else src = xs + (size_t)(row - ROW_S0) * D;
        float ss = 0.f;
#pragma unroll
        for (int i = 0; i < 4; ++i) {
            f32x4 v = (f32x4){0.f, 0.f, 0.f, 0.f};
            if (src) v = *(const f32x4*)(src + (F.lane + 64 * i) * 4);
            ss += (v[0] * v[0] + v[1] * v[1]) + (v[2] * v[2] + v[3] * v[3]);
            u32x2 w; w.x = cvt_pk_bf16(v[0], v[1]); w.y = cvt_pk_bf16(v[2], v[3]);
            *(u32x2*)(F.hb + (size_t)row * D + (F.lane + 64 * i) * 4) = w;
        }
        ss = wave_sum(ss);
        if (F.lane < 16) F.rss[(size_t)row * 16 + F.lane] = (F.lane == 0) ? ss : 0.f;
    }
}

__device__ void transpose_convert(const Frame& F, const float* src, int K, int N, int Npad, bf16_t* dst, const float* scale, int smod) {
    float* tile = (float*)F.lds;
    const int ntk = K / 64, ntn = Npad / 64, ntile = ntk * ntn;
    for (int ti = F.bid; ti < ntile; ti += F.G) {
        const int kt = ti % ntk, nt_ = ti / ntk, k0 = kt * 64, n0 = nt_ * 64;
        const int kk = F.tid >> 4, n4 = (F.tid & 15) * 4;
#pragma unroll
        for (int h = 0; h < 2; ++h) {
            const int k = k0 + kk + 32 * h, n = n0 + n4;
            f32x4 v = (f32x4){0.f, 0.f, 0.f, 0.f};
            if (n < N) v = *(const f32x4*)(src + (size_t)k * N + n);
            const float s = scale[k % smod];
            float* tp = tile + (kk + 32 * h) * 65 + n4;
            tp[0] = v[0] * s; tp[1] = v[1] * s; tp[2] = v[2] * s; tp[3] = v[3] * s;
        }
        __syncthreads();
        const int nn = F.tid >> 3, kg = (F.tid & 7) * 8;
        float x[8];
#pragma unroll
        for (int j = 0; j < 8; ++j) x[j] = tile[(kg + j) * 65 + nn];
        u32x4 w; w.x = cvt_pk_bf16(x[0], x[1]); w.y = cvt_pk_bf16(x[2], x[3]); w.z = cvt_pk_bf16(x[4], x[5]); w.w = cvt_pk_bf16(x[6], x[7]);
        *(u32x4*)(dst + (size_t)(n0 + nn) * K + k0 + kg) = w;
        __syncthreads();
    }
}
__device__ void phase_wprep_in(const Frame& F0, int L) {
    const Frame F = relaunder(F0);
    const int j = L >> 1;
    if ((L & 1) == 0) transpose_convert(F, F.inp(8) + (size_t)j * D * SSD_IN, D, SSD_IN, SSD_IN_PAD, F.win, F.inp(7) + j * D, D);
    else transpose_convert(F, F.inp(17) + (size_t)j * D * GDN_IN, D, GDN_IN, GDN_IN_PAD, F.win, F.inp(16) + j * D, D);
}
__device__ void phase_wprep_out(const Frame& F0, int L) {
    const Frame F = relaunder(F0);
    const int j = L >> 1;
    if ((L & 1) == 0) transpose_convert(F, F.inp(15) + (size_t)j * SSD_INNER * D, SSD_INNER, D, D, F.wout, F.inp(14) + j * SSD_INNER, SSD_INNER);
    else transpose_convert(F, F.inp(22) + (size_t)j * GDN_VAL * D, GDN_VAL, D, D, F.wout, F.inp(21) + j * GDN_DV, GDN_DV);
}

__device__ void phase_inproj(const Frame& F0, int L) {
    const Frame F = relaunder(F0);
    const int npad = (L & 1) ? GDN_IN_PAD : SSD_IN_PAD;
    pg8::Gemm g{F.hb, F.win, M_TOT, npad, D, D, D};
    pg8::StaticOrder S; S.init(M_TOT, npad, F.G, F.bid);
    pg8::EpiInProj E{F.proj, F.dtb, F.rss, npad / 256 - 1, (L & 1) ? F.tails : nullptr};
    pg8::gemm_phase<pg8::EpiInProj>(F.ldsl, g, S, E, F.tid);
}
__device__ void phase_outproj(const Frame& F0, int L) {
    const Frame F = relaunder(F0);
    const bf16_t* A = F.proj + ((L & 1) ? 4096 : 0);
    pg8::Gemm g{A, F.wout, M_TOT, D, 2048, LDP, 2048};
    pg8::StaticOrder S; S.init(M_TOT, D, F.G, F.bid);
    pg8::EpiOutProj E{F.hb, F.rss};
    pg8::gemm_phase<pg8::EpiOutProj>(F.ldsl, g, S, E, F.tid);
}

__device__ void phase_ssd_naive(const Frame& F0, int j) {
    const Frame F = relaunder(F0);
    float* xs = (float*)F.lds;
    float* Bs = xs + 64 * 64;
    float* Cs = Bs + 64 * 128;
    float* dts = Cs + 64 * 128;
    float* das = dts + 64;
    const float* conv_w = F.inp(9) + (size_t)j * 4 * SSD_CONV; const float* conv_b = F.inp(10) + (size_t)j * SSD_CONV;
    const int p = F.tid >> 3, nq = F.tid & 7;
    for (int task = F.bid; task < NSEQ * SSD_HEADS; task += F.G) {
        const int s = task / SSD_HEADS, head = task % SSD_HEADS, grp = head >> 3;
        const int base = seq_base(s), nch = seq_chunks(s);
        const float dt_bias = F.inp(11)[j * SSD_HEADS + head], a = -__expf(F.inp(12)[j * SSD_HEADS + head]), dsk = F.inp(13)[j * SSD_HEADS + head];
        float h[16];
        if (s < 2) {
#pragma unroll
            for (int n = 0; n < 16; ++n) h[n] = 0.f;
        } else {
            const float* st = F.inp(2) + ((((size_t)j * 8 + (s - 2)) * SSD_HEADS + head) * SSD_P + p) * SSD_N + nq * 16;
#pragma unroll
            for (int n = 0; n < 16; ++n) h[n] = st[n];
        }
        int cidx = -1;
        if (F.tid < 64) cidx = head * 64 + F.tid; else if (F.tid < 192) cidx = 2048 + grp * 128 + (F.tid - 64); else if (F.tid < 320) cidx = 2560 + grp * 128 + (F.tid - 192);
        float w0 = 0, w1 = 0, w2 = 0, w3 = 0, cb = 0;
        if (cidx >= 0) { w0 = conv_w[cidx]; w1 = conv_w[SSD_CONV + cidx]; w2 = conv_w[2 * SSD_CONV + cidx]; w3 = conv_w[3 * SSD_CONV + cidx]; cb = conv_b[cidx]; }
        const float* cst = (s >= 2) ? F.inp(3) + (((size_t)j * 8 + (s - 2)) * 3) * SSD_CONV : nullptr;
        for (int c = 0; c < nch; ++c) {
            const int t0 = 64 * c - PADF;
            __syncthreads();
            if (cidx >= 0) {
                float r3, r2, r1;
                {   float rv[3];
#pragma unroll
                    for (int q = 0; q < 3; ++q) { const int t = t0 - 3 + q; float v = 0.f;
                        if (t >= 0) v = bf2f(F.proj[(size_t)(base + t) * LDP + 2048 + cidx]); else if (t >= -3 && cst) v = cst[(3 + t) * SSD_CONV + cidx];
                        rv[q] = v; }
                    r3 = rv[0]; r2 = rv[1]; r1 = rv[2]; }
                for (int i = 0; i < 64; ++i) {
                    const int t = t0 + i; float v = 0.f;
                    if (t >= 0) v = bf2f(F.proj[(size_t)(base + t) * LDP + 2048 + cidx]); else if (t >= -3 && cst) v = cst[(3 + t) * SSD_CONV + cidx];
                    const float o = silu_f(cb + w0 * r3 + w1 * r2 + w2 * r1 + w3 * v);
                    r3 = r2; r2 = r1; r1 = v;
                    if (F.tid < 64) xs[i * 64 + F.tid] = o; else if (F.tid < 192) Bs[i * 128 + (F.tid - 64)] = o; else Cs[i * 128 + (F.tid - 192)] = o;
                }
            } else if (F.tid >= 448) {
                const int i = F.tid - 448, t = t0 + i;
                float dt = 0.f, da = 1.f;
                if (t >= 0) { dt = softplus_f(F.dtb[(size_t)(base + t) * 32 + head] + dt_bias); da = __expf(dt * a); }
                dts[i] = dt; das[i] = da;
            }
            __syncthreads();
            for (int i = 0; i < 64; ++i) {
                const int t = t0 + i;
                const float dt = dts[i], da = das[i], xv = xs[i * 64 + p], dx = dt * xv;
                const float* bp = Bs + i * 128 + nq * 16; const float* cp = Cs + i * 128 + nq * 16;
                float accv = 0.f;
#pragma unroll
                for (int n = 0; n < 16; ++n) { h[n] = h[n] * da + dx * bp[n]; accv += cp[n] * h[n]; }
                accv += __shfl_xor(accv, 1); accv += __shfl_xor(accv, 2); accv += __shfl_xor(accv, 4);
                if (nq == 0 && t >= 0) {
                    bf16_t* zp = F.proj + (size_t)(base + t) * LDP + head * 64 + p;
                    const float z = bf2f(*zp);
                    *zp = f2bf((accv + dsk * xv) * silu_f(z));
                }
            }
        }
        float* so = (s < 2) ? F.out + O_PSSD + ((((size_t)j * 2 + s) * SSD_HEADS + head) * SSD_P + p) * SSD_N + nq * 16
                            : F.out + O_SSSD + ((((size_t)j * 8 + (s - 2)) * SSD_HEADS + head) * SSD_P + p) * SSD_N + nq * 16;
#pragma unroll
        for (int n = 0; n < 16; ++n) so[n] = h[n];
    }
}


constexpr int NCHT = 266;
constexpr size_t SC_BT = 0;
constexpr size_t SC_C = SC_BT + (size_t)NCHT * 4 * 16384;
constexpr size_t SC_CB = SC_C + (size_t)NCHT * 4 * 16384;
constexpr size_t SC_VEC = SC_CB + (size_t)NCHT * 4 * 8192;
constexpr size_t SC_SSD_END = SC_VEC + (size_t)NCHT * 32 * 1024;
static_assert(SC_SSD_END <= (size_t)16777216 * 4, "scratch must fit the y_prompt region");
__device__ __forceinline__ int qperm(int s) { return (s & ~31) | (((s >> 2) & 3) << 3) | (((s >> 4) & 1) << 2) | (s & 3); }
__device__ __forceinline__ int qnat(int q) { return (q & ~31) | (((q >> 2) & 1) << 4) | (((q >> 3) & 3) << 2) | (q & 3); }
__device__ __forceinline__ bf16x8 pack8(f32x4 a, f32x4 b) {
    u32x4 w; w.x = cvt_pk_bf16(a[0], a[1]); w.y = cvt_pk_bf16(a[2], a[3]); w.z = cvt_pk_bf16(b[0], b[1]); w.w = cvt_pk_bf16(b[2], b[3]);
    return __builtin_bit_cast(bf16x8, w);
}
__device__ __forceinline__ void chunk_of(int cgi, int& seq, int& c) { if (cgi < 258) { seq = cgi / 129; c = cgi % 129; } else { seq = 2 + (cgi - 258); c = 0; } }
__device__ __forceinline__ int cgi_of(int seq, int c) { return seq < 2 ? seq * 129 + c : 258 + (seq - 2); }

__device__ void phase_ssd_prep(const Frame& F0, int j) {
    const Frame F = relaunder(F0);
    bf16_t* Bs = (bf16_t*)F.lds;
    bf16_t* Cs = Bs + 64 * 136;
    unsigned char* sc = (unsigned char*)F.out;
    const float* conv_w = F.inp(9) + (size_t)j * 4 * SSD_CONV; const float* conv_b = F.inp(10) + (size_t)j * SSD_CONV;
    const int i16 = F.lane & 15, g4 = F.lane >> 4;
    for (int task = F.bid; task < NCHT * 4; task += F.G) {
        const int cgi = task >> 2, grp = task & 3; int seq, c; chunk_of(cgi, seq, c);
        const int base = seq_base(seq), t0 = 64 * c - PADF;
        __syncthreads();
        {
            const int ch = F.tid & 255, half = F.tid >> 8, isC = ch >> 7, n = ch & 127;
            const int cidx = 2048 + isC * 512 + grp * 128 + n;
            const float w0 = conv_w[cidx], w1 = conv_w[SSD_CONV + cidx], w2 = conv_w[2 * SSD_CONV + cidx], w3 = conv_w[3 * SSD_CONV + cidx], cb = conv_b[cidx];
            const float* cst = (seq >= 2) ? F.inp(3) + (((size_t)j * 8 + (seq - 2)) * 3) * SSD_CONV : nullptr;
            bf16_t* dst = (isC ? Cs : Bs) + n;
            float r3, r2, r1;
            {   float rv[3];
#pragma unroll
                for (int q = 0; q < 3; ++q) { const int t = t0 + half * 32 - 3 + q; float v = 0.f;
                    if (t >= 0) v = bf2f(F.proj[(size_t)(base + t) * LDP + 2048 + cidx]); else if (t >= -3 && cst) v = cst[(3 + t) * SSD_CONV + cidx];
                    rv[q] = v; }
                r3 = rv[0]; r2 = rv[1]; r1 = rv[2]; }
            for (int ii = 0; ii < 32; ++ii) {
                const int p = half * 32 + ii, t = t0 + p; float v = 0.f;
                if (t >= 0) v = bf2f(F.proj[(size_t)(base + t) * LDP + 2048 + cidx]); else if (t >= -3 && cst) v = cst[(3 + t) * SSD_CONV + cidx];
                const float o = silu_f(cb + w0 * r3 + w1 * r2 + w2 * r1 + w3 * v);
                r3 = r2; r2 = r1; r1 = v;
                dst[p * 136] = f2bf(o);
            }
        }
        __syncthreads();
        {
            bf16_t* BT = (bf16_t*)(sc + SC_BT) + (size_t)(cgi * 4 + grp) * 8192;
            const int n = F.tid >> 2, qg = (F.tid & 3) * 16;
#pragma unroll
            for (int u = 0; u < 2; ++u) {
                const int q0 = qg + 8 * u; unsigned short e[8];
#pragma unroll
                for (int jj = 0; jj < 8; ++jj) e[jj] = Bs[qnat(q0 + jj) * 136 + n];
                u32x4 w; w.x = e[0] | ((unsigned)e[1] << 16); w.y = e[2] | ((unsigned)e[3] << 16); w.z = e[4] | ((unsigned)e[5] << 16); w.w = e[6] | ((unsigned)e[7] << 16);
                *(u32x4*)(BT + n * 64 + q0) = w;
            }
            bf16_t* Cg = (bf16_t*)(sc + SC_C) + (size_t)(cgi * 4 + grp) * 8192;
#pragma unroll
            for (int u = 0; u < 2; ++u) {
                const int idx = F.tid + 512 * u, l = idx >> 4, qg8 = idx & 15, kk = qg8 >> 2, gg = qg8 & 3;
                const u32x2 a = *(const u32x2*)(Cs + l * 136 + 32 * kk + 4 * gg), b = *(const u32x2*)(Cs + l * 136 + 32 * kk + 16 + 4 * gg);
                u32x4 w; w.x = a.x; w.y = a.y; w.z = b.x; w.w = b.y;
                *(u32x4*)(Cg + l * 128 + 8 * qg8) = w;
            }
        }
        {
            bf16_t* CB = (bf16_t*)(sc + SC_CB) + (size_t)(cgi * 4 + grp) * 4096;
            const int m = F.wave >> 1;
#pragma unroll
            for (int u = 0; u < 2; ++u) {
                const int st = 2 * (F.wave & 1) + u; f32x4 acc = (f32x4){0.f, 0.f, 0.f, 0.f};
#pragma unroll
                for (int kk = 0; kk < 4; ++kk) {
                    const bf16x8 a = *(const bf16x8*)(Cs + (16 * m + i16) * 136 + 32 * kk + 8 * g4);
                    const bf16x8 b = *(const bf16x8*)(Bs + (16 * st + i16) * 136 + 32 * kk + 8 * g4);
                    acc = __builtin_amdgcn_mfma_f32_16x16x32_bf16(a, b, acc, 0, 0, 0);
                }
                const int qs = qperm(16 * st + i16);
#pragma unroll
                for (int jj = 0; jj < 4; ++jj) CB[(16 * m + 4 * g4 + jj) * 64 + qs] = f2bf(acc[jj]);
            }
        }
        {
            const int head = grp * 8 + F.wave, t = t0 + F.lane;
            const float a = -__expf(F.inp(12)[j * SSD_HEADS + head]);
            float dt = 0.f;
            if (t >= 0) dt = softplus_f(F.dtb[(size_t)(base + t) * 32 + head] + F.inp(11)[j * SSD_HEADS + head]);
            float cs = dt * a;
#pragma unroll
            for (int o = 1; o < 64; o <<= 1) { const float y = __shfl_up(cs, o); if (F.lane >= o) cs += y; }
            const float cs_last = __shfl(cs, 63), cs_be = __shfl(cs, F.lane | 3);
            float* vp = (float*)(sc + SC_VEC) + (size_t)(cgi * 32 + head) * 256;
            vp[F.lane] = cs; vp[64 + F.lane] = __expf(cs_be - cs) * dt; vp[128 + F.lane] = dt * __expf(cs_last - cs); vp[192 + F.lane] = __expf(cs);
        }
    }
}

__device__ void phase_ssd_chain(const Frame& F0, int j) {
    const Frame F = relaunder(F0);
    unsigned char* sc = (unsigned char*)F.out;
    const int i = F.lane & 15, g = F.lane >> 4;
    const float* conv_w = F.inp(9) + (size_t)j * 4 * SSD_CONV; const float* conv_b = F.inp(10) + (size_t)j * SSD_CONV;
    for (int bt = F.bid; bt < 192; bt += F.G) {
        int sh;
        if (bt < 64) { if (F.wave >= 4) continue; sh = bt; } else sh = 64 + (bt - 64) * 2 + (F.wave >> 2);
        const int seq = sh < 64 ? (sh >> 5) : 2 + ((sh - 64) >> 5), head = sh & 31, ps = F.wave & 3, grp = head >> 3;
        const int base = seq_base(seq), nch = seq_chunks(seq);
        const float dsk = F.inp(13)[j * SSD_HEADS + head];
        const int cx = head * 64 + ps * 16 + i;
        const float w0 = conv_w[cx], w1 = conv_w[SSD_CONV + cx], w2 = conv_w[2 * SSD_CONV + cx], w3 = conv_w[3 * SSD_CONV + cx], cb = conv_b[cx];
        const float* cst = (seq >= 2) ? F.inp(3) + (((size_t)j * 8 + (seq - 2)) * 3) * SSD_CONV + cx : nullptr;
        f32x4 HT[8];
        if (seq < 2) {
#pragma unroll
            for (int m8 = 0; m8 < 8; ++m8) HT[m8] = (f32x4){0.f, 0.f, 0.f, 0.f};
        } else {
            const float* st = F.inp(2) + ((((size_t)j * 8 + (seq - 2)) * SSD_HEADS + head) * SSD_P + ps * 16 + i) * SSD_N + 4 * g;
#pragma unroll
            for (int m8 = 0; m8 < 8; ++m8) HT[m8] = *(const f32x4*)(st + 16 * m8);
        }
        for (int c = 0; c < nch; ++c) {
            const int cgi = cgi_of(seq, c), t0 = 64 * c - PADF;
            const bf16_t* Cp = (const bf16_t*)(sc + SC_C) + (size_t)(cgi * 4 + grp) * 8192;
            const bf16_t* BTp = (const bf16_t*)(sc + SC_BT) + (size_t)(cgi * 4 + grp) * 8192;
            const bf16_t* CBp = (const bf16_t*)(sc + SC_CB) + (size_t)(cgi * 4 + grp) * 4096;
            const float* vp = (const float*)(sc + SC_VEC) + (size_t)(cgi * 32 + head) * 256;
            f32x4 cs4[4], e24[4], w4[4], ecs4[4]; float cs_row[4];
#pragma unroll
            for (int m = 0; m < 4; ++m) { cs4[m] = *(const f32x4*)(vp + 16 * m + 4 * g); e24[m] = *(const f32x4*)(vp + 64 + 16 * m + 4 * g); w4[m] = *(const f32x4*)(vp + 128 + 16 * m + 4 * g);
                ecs4[m] = *(const f32x4*)(vp + 192 + 16 * m + 4 * g); cs_row[m] = vp[16 * m + i]; }
            const float ecl = vp[192 + 63];
            bf16x8 Hf[4];
#pragma unroll
            for (int kk = 0; kk < 4; ++kk) Hf[kk] = pack8(HT[2 * kk], HT[2 * kk + 1]);
            f32x4 Y[4];
#pragma unroll
            for (int m = 0; m < 4; ++m) {
                f32x4 acc = (f32x4){0.f, 0.f, 0.f, 0.f};
#pragma unroll
                for (int kk = 0; kk < 4; ++kk) { const bf16x8 cf = *(const bf16x8*)(Cp + (16 * m + i) * 128 + 32 * kk + 8 * g); acc = __builtin_amdgcn_mfma_f32_16x16x32_bf16(cf, Hf[kk], acc, 0, 0, 0); }
                Y[m] = acc * ecs4[m];
            }
            f32x4 xv[4];
#pragma unroll
            for (int m = 0; m < 4; ++m) {
                float r[7];
#pragma unroll
                for (int q = 0; q < 7; ++q) { const int t = t0 + 16 * m + 4 * g - 3 + q; float v = 0.f;
                    if (t >= 0) v = bf2f(F.proj[(size_t)(base + t) * LDP + 2048 + cx]); else if (t >= -3 && cst) v = cst[(3 + t) * SSD_CONV];
                    r[q] = v; }
#pragma unroll
                for (int jj = 0; jj < 4; ++jj) xv[m][jj] = silu_f(cb + w0 * r[jj] + w1 * r[jj + 1] + w2 * r[jj + 2] + w3 * r[jj + 3]);
            }
            bf16x8 xsf[2], xwf[2];
#pragma unroll
            for (int k2 = 0; k2 < 2; ++k2) { xsf[k2] = pack8(xv[2 * k2] * e24[2 * k2], xv[2 * k2 + 1] * e24[2 * k2 + 1]); xwf[k2] = pack8(xv[2 * k2] * w4[2 * k2], xv[2 * k2 + 1] * w4[2 * k2 + 1]); }
#pragma unroll
            for (int m = 0; m < 4; ++m) {
                const int l = 16 * m + i;
#pragma unroll
                for (int k2 = 0; k2 < 2; ++k2) {
                    const u32x4 cbw = *(const u32x4*)(CBp + l * 64 + 32 * k2 + 8 * g);
                    const float e1a = __expf(cs_row[m] - cs4[2 * k2][3]), e1b = __expf(cs_row[m] - cs4[2 * k2 + 1][3]);
                    const int sa = 32 * k2 + 4 * g, sb = sa + 16;
                    f32x4 va, vb;
                    va[0] = (sa + 0 <= l) ? __uint_as_float(cbw.x << 16) * e1a : 0.f; va[1] = (sa + 1 <= l) ? __uint_as_float(cbw.x & 0xffff0000u) * e1a : 0.f;
                    va[2] = (sa + 2 <= l) ? __uint_as_float(cbw.y << 16) * e1a : 0.f; va[3] = (sa + 3 <= l) ? __uint_as_float(cbw.y & 0xffff0000u) * e1a : 0.f;
                    vb[0] = (sb + 0 <= l) ? __uint_as_float(cbw.z << 16) * e1b : 0.f; vb[1] = (sb + 1 <= l) ? __uint_as_float(cbw.z & 0xffff0000u) * e1b : 0.f;
                    vb[2] = (sb + 2 <= l) ? __uint_as_float(cbw.w << 16) * e1b : 0.f; vb[3] = (sb + 3 <= l) ? __uint_as_float(cbw.w & 0xffff0000u) * e1b : 0.f;
                    Y[m] = __builtin_amdgcn_mfma_f32_16x16x32_bf16(pack8(va, vb), xsf[k2], Y[m], 0, 0, 0);
                }
            }
#pragma unroll
            for (int m8 = 0; m8 < 8; ++m8) {
                f32x4 acc = HT[m8] * ecl;
#pragma unroll
                for (int k2 = 0; k2 < 2; ++k2) { const bf16x8 bf = *(const bf16x8*)(BTp + (16 * m8 + i) * 64 + 32 * k2 + 8 * g); acc = __builtin_amdgcn_mfma_f32_16x16x32_bf16(bf, xwf[k2], acc, 0, 0, 0); }
                HT[m8] = acc;
            }
#pragma unroll
            for (int m = 0; m < 4; ++m)
#pragma unroll
                for (int jj = 0; jj < 4; ++jj) {
                    const int t = t0 + 16 * m + 4 * g + jj;
                    if (t >= 0) { bf16_t* zp = F.proj + (size_t)(base + t) * LDP + cx; const float z = bf2f(*zp); *zp = f2bf((Y[m][jj] + dsk * xv[m][jj]) * silu_f(z)); }
                }
        }
        float* so = (seq < 2) ? F.out + O_PSSD + ((((size_t)j * 2 + seq) * SSD_HEADS + head) * SSD_P + ps * 16 + i) * SSD_N + 4 * g
                              : F.out + O_SSSD + ((((size_t)j * 8 + (seq - 2)) * SSD_HEADS + head) * SSD_P + ps * 16 + i) * SSD_N + 4 * g;
#pragma unroll
        for (int m8 = 0; m8 < 8; ++m8) *(f32x4*)(so + 16 * m8) = HT[m8];
    }
}

__device__ void phase_ssd_post(const Frame& F0, int j) {
    const Frame F = relaunder(F0);
    for (int it = F.bid * 8 + F.wave; it < M_TOT * 4; it += F.G * 8) {
        const int row = it >> 2, grp = it & 3;
        u32x4* p = (u32x4*)(F.proj + (size_t)row * LDP + grp * 512 + F.lane * 8);
        const u32x4 v = *p; float x[8];
        x[0] = __uint_as_float(v.x << 16); x[1] = __uint_as_float(v.x & 0xffff0000u); x[2] = __uint_as_float(v.y << 16); x[3] = __uint_as_float(v.y & 0xffff0000u);
        x[4] = __uint_as_float(v.z << 16); x[5] = __uint_as_float(v.z & 0xffff0000u); x[6] = __uint_as_float(v.w << 16); x[7] = __uint_as_float(v.w & 0xffff0000u);
        float ss = 0.f;
#pragma unroll
        for (int q = 0; q < 8; ++q) ss += x[q] * x[q];
        ss = wave_sum(ss);
        const float rs = rsqrtf(ss * (1.0f / 512.0f) + EPS);
        u32x4 w; w.x = cvt_pk_bf16(x[0] * rs, x[1] * rs); w.y = cvt_pk_bf16(x[2] * rs, x[3] * rs); w.z = cvt_pk_bf16(x[4] * rs, x[5] * rs); w.w = cvt_pk_bf16(x[6] * rs, x[7] * rs);
        *p = w;
    }
    for (int e = F.bid * NTHREADS + F.tid; e < NSEQ * 3 * SSD_CONV; e += F.G * NTHREADS) {
        const int s = e / (3 * SSD_CONV), r = (e / SSD_CONV) % 3, c = e % SSD_CONV;
        const int row = seq_base(s) + seq_len(s) - 3 + r;
        const float v = bf2f(F.proj[(size_t)row * LDP + 2048 + c]);
        if (s < 2) F.out[O_PSSDC + (((size_t)j * 2 + s) * 3 + r) * SSD_CONV + c] = v;
        else F.out[O_SSSDC + (((size_t)j * 8 + (s - 2)) * 3 + r) * SSD_CONV + c] = v;
    }
}

__device__ void phase_gdn_naive(const Frame& F0, int j) {
    const Frame F = relaunder(F0);
    constexpr int QP = 129;
    float* qs = (float*)F.lds;
    float* ks = qs + 64 * QP;
    float* vs = ks + 64 * QP;
    float* gs = vs + 64 * 256;
    float* bs = gs + 64;
    float* qk = bs + 64;
    float* exk = qk + 64;
    float* exq = exk + 2 * 2 * 256;
    float* exv = exq + 2 * 2 * 256;
    const float* conv_w = F.inp(18) + (size_t)j * 4 * GDN_CONV;
    const int v = F.tid & 255, kh = F.tid >> 8;
    for (int task = F.bid; task < NSEQ * GDN_HEADS; task += F.G) {
        const int s = task / GDN_HEADS, head = task % GDN_HEADS;
        const int base = seq_base(s), nch = seq_chunks(s);
        const float dt_bias = F.inp(19)[j * GDN_HEADS + head], aneg = -__expf(F.inp(20)[j * GDN_HEADS + head]);
        float S[64];
        if (s < 2) {
#pragma unroll
            for (int kk = 0; kk < 64; ++kk) S[kk] = 0.f;
        } else {
            const float* st = F.inp(4) + ((((size_t)j * 8 + (s - 2)) * GDN_HEADS + head) * GDN_DK + kh * 64) * GDN_DV + v;
#pragma unroll
            for (int kk = 0; kk < 64; ++kk) S[kk] = st[(size_t)kk * GDN_DV];
        }
        const int cidx = F.tid < 128 ? head * 128 + F.tid : (F.tid < 256 ? 1024 + head * 128 + (F.tid - 128) : 2048 + head * 256 + (F.tid - 256));
        const float w0 = conv_w[cidx], w1 = conv_w[GDN_CONV + cidx], w2 = conv_w[2 * GDN_CONV + cidx], w3 = conv_w[3 * GDN_CONV + cidx];
        const float* cst = (s >= 2) ? F.inp(5) + (((size_t)j * 8 + (s - 2)) * 3) * GDN_CONV : nullptr;
        for (int c = 0; c < nch; ++c) {
            const int t0 = 64 * c - PADF;
            __syncthreads();
            {
                float r3, r2, r1;
                {   float rv[3];
#pragma unroll
                    for (int q = 0; q < 3; ++q) { const int t = t0 - 3 + q; float x = 0.f;
                        if (t >= 0) x = bf2f(F.proj[(size_t)(base + t) * LDP + cidx]); else if (t >= -3 && cst) x = cst[(3 + t) * GDN_CONV + cidx];
                        rv[q] = x; }
                    r3 = rv[0]; r2 = rv[1]; r1 = rv[2]; }
                for (int i = 0; i < 64; ++i) {
                    const int t = t0 + i; float x = 0.f;
                    if (t >= 0) x = bf2f(F.proj[(size_t)(base + t) * LDP + cidx]); else if (t >= -3 && cst) x = cst[(3 + t) * GDN_CONV + cidx];
                    const float o = silu_f(w0 * r3 + w1 * r2 + w2 * r1 + w3 * x);
                    r3 = r2; r2 = r1; r1 = x;
                    if (F.tid < 128) qs[i * QP + F.tid] = o; else if (F.tid < 256) ks[i * QP + (F.tid - 128)] = o; else vs[i * 256 + (F.tid - 256)] = o;
                }
            }
            __syncthreads();
            if (F.tid < 128) {
                const int i = F.tid & 63; float* rowp = (F.tid < 64 ? qs : ks) + i * QP; float ss = 0.f;
                for (int k = 0; k < 128; ++k) ss += rowp[k] * rowp[k];
                const float sc = rsqrtf(ss + EPS) * (F.tid < 64 ? 0.08838834764831845f : 1.0f);
                for (int k = 0; k < 128; ++k) rowp[k] *= sc;
            } else if (F.tid < 192) {
                const int i = F.tid - 128, t = t0 + i; float ga = 1.f, be = 0.f;
                if (t >= 0) { const float* dp = F.dtb + (size_t)(base + t) * 32; ga = __expf(aneg * softplus_f(dp[head] + dt_bias)); be = 1.0f / (1.0f + __expf(-dp[8 + head])); }
                gs[i] = ga; bs[i] = be;
            }
            __syncthreads();
            if (F.tid < 64) { float d = 0.f; for (int k = 0; k < 128; ++k) d += qs[F.tid * QP + k] * ks[F.tid * QP + k]; qk[F.tid] = d; }
            __syncthreads();
            for (int i = 0; i < 64; ++i) {
                const float* kp = ks + i * QP + kh * 64; const float* qp = qs + i * QP + kh * 64;
                float pk = 0.f, pq = 0.f;
#pragma unroll
                for (int kk = 0; kk < 64; ++kk) { pk += kp[kk] * S[kk]; pq += qp[kk] * S[kk]; }
                const int eb = (i & 1) * 512;
                exk[eb + kh * 256 + v] = pk; exq[eb + kh * 256 + v] = pq; if (kh == 0) exv[(i & 1) * 256 + v] = vs[i * 256 + v];
                __syncthreads();
                const float kS = exk[eb + v] + exk[eb + 256 + v], qS = exq[eb + v] + exq[eb + 256 + v], vv = exv[(i & 1) * 256 + v];
                const float ga = gs[i], be = bs[i];
                const float delta = vv - ga * kS;
                const float bd = be * delta;
#pragma unroll
                for (int kk = 0; kk < 64; ++kk) S[kk] = ga * S[kk] + kp[kk] * bd;
                if (kh == 0) vs[i * 256 + v] = ga * qS + qk[i] * bd;
            }
            __syncthreads();
            for (int q = 0; q < 8; ++q) {
                const int i = F.wave * 8 + q, t = t0 + i;
                const f32x4 o = *(const f32x4*)(vs + i * 256 + F.lane * 4);
                float ss = (o[0] * o[0] + o[1] * o[1]) + (o[2] * o[2] + o[3] * o[3]);
                ss = wave_sum(ss);
                const float rs = rsqrtf(ss * (1.0f / 256.0f) + EPS);
                if (t >= 0) {
                    u32x2* zp = (u32x2*)(F.proj + (size_t)(base + t) * LDP + 4096 + head * 256 + F.lane * 4);
                    const u32x2 z = *zp;
                    const float z0 = __uint_as_float(z.x << 16), z1 = __uint_as_float(z.x & 0xffff0000u), z2 = __uint_as_float(z.y << 16), z3 = __uint_as_float(z.y & 0xffff0000u);
                    u32x2 w; w.x = cvt_pk_bf16(o[0] * rs * silu_f(z0), o[1] * rs * silu_f(z1)); w.y = cvt_pk_bf16(o[2] * rs * silu_f(z2), o[3] * rs * silu_f(z3));
                    *zp = w;
                }
            }
        }
        float* so = (s < 2) ? F.out + O_PGDN + ((((size_t)j * 2 + s) * GDN_HEADS + head) * GDN_DK + kh * 64) * GDN_DV + v
                            : F.out + O_SGDN + ((((size_t)j * 8 + (s - 2)) * GDN_HEADS + head) * GDN_DK + kh * 64) * GDN_DV + v;
#pragma unroll
        for (int kk = 0; kk < 64; ++kk) so[(size_t)kk * GDN_DV] = S[kk];
    }
}
__device__ void phase_gdn_post(const Frame& F0, int j) {
    const Frame F = relaunder(F0);
    for (int e = F.bid * NTHREADS + F.tid; e < NSEQ * 3 * GDN_CONV; e += F.G * NTHREADS) {
        const int s = e / (3 * GDN_CONV), r = (e / GDN_CONV) % 3, c = e % GDN_CONV;
        const int row = seq_base(s) + seq_len(s) - 3 + r;
        const float v = bf2f(F.proj[(size_t)row * LDP + c]);
        if (s < 2) F.out[O_PGDNC + (((size_t)j * 2 + s) * 3 + r) * GDN_CONV + c] = v;
        else F.out[O_SGDNC + (((size_t)j * 8 + (s - 2)) * 3 + r) * GDN_CONV + c] = v;
    }
}


constexpr size_t SG_W = 0;
constexpr size_t SG_QK = SG_W + (size_t)NCHT * 8 * 16384;
constexpr size_t SG_VEC = SG_QK + (size_t)NCHT * 8 * 8192;
constexpr size_t SG_PART = SG_VEC + (size_t)NCHT * 8 * 1024;
constexpr size_t SG_SIDE = SG_PART + (size_t)M_TOT * 128 * 2;
constexpr size_t SG_END = SG_SIDE + (size_t)64 * 65536;
static_assert(SG_END <= (size_t)16777216 * 4, "scratch must fit the y_prompt region");
struct GTile { bf16_t* q; bf16_t* k; bf16_t* v; int sq, sk, sv; };
__device__ __forceinline__ GTile gdn_tile(const Frame& F, int seq, int c, int head) {
    GTile t;
    if (seq < 2) { bf16_t* r0 = F.proj + (size_t)(seq * TPP + 64 * c) * LDP; t.q = r0 + head * 128; t.k = r0 + 1024 + head * 128; t.v = r0 + 2048 + head * 256; t.sq = LDP; t.sk = LDP; t.sv = LDP; }
    else { bf16_t* b = (bf16_t*)((unsigned char*)F.out + SG_SIDE) + (size_t)((seq - 2) * 8 + head) * 32768; t.q = b; t.k = b + 8192; t.v = b + 16384; t.sq = 128; t.sk = 128; t.sv = 256; }
    return t;
}

__device__ void phase_gdn_prep(const Frame& F0, int j) {
    const Frame F = relaunder(F0);
    float* Am = (float*)F.lds;
    float* vgc = Am + 64 * 68;
    float* vbe = vgc + 64;
    float* vnq = vbe + 64;
    float* vnk = vnq + 64;
    bf16_t* qs = (bf16_t*)(vnk + 64);
    bf16_t* ks = qs + 64 * 136;
    bf16_t* kT = ks + 64 * 136;
    bf16_t* vT = kT + 128 * 72;
    bf16_t* Tb = vT + 256 * 72;
    unsigned char* sc = (unsigned char*)F.out;
    const float* conv_w = F.inp(18) + (size_t)j * 4 * GDN_CONV;
    const int i16 = F.lane & 15, g4 = F.lane >> 4;
    constexpr float CQ = 0.08838834764831845f;
    for (int task = F.bid; task < NCHT * 8; task += F.G) {
        const int cgi = task >> 3, head = task & 7; int seq, c; chunk_of(cgi, seq, c);
        const int base = seq_base(seq), t0 = 64 * c - PADF;
        const GTile tl = gdn_tile(F, seq, c, head);
        __syncthreads();
        if (F.wave == 0) {
            const int t = t0 + F.lane; float gg = 0.f, be = 0.f;
            if (t >= 0) { const float* dp = F.dtb + (size_t)(base + t) * 32; gg = -__expf(F.inp(20)[j * GDN_HEADS + head]) * softplus_f(dp[head] + F.inp(19)[j * GDN_HEADS + head]); be = 1.0f / (1.0f + __expf(-dp[8 + head])); }
#pragma unroll
            for (int o = 1; o < 64; o <<= 1) { const float y = __shfl_up(gg, o); if (F.lane >= o) gg += y; }
            vgc[F.lane] = gg; vbe[F.lane] = be;
        }
        __syncthreads();
        {
            const int ch = F.tid;
            const int cidx = ch < 128 ? head * 128 + ch : (ch < 256 ? 1024 + head * 128 + (ch - 128) : 2048 + head * 256 + (ch - 256));
            const float w0 = conv_w[cidx], w1 = conv_w[GDN_CONV + cidx], w2 = conv_w[2 * GDN_CONV + cidx], w3 = conv_w[3 * GDN_CONV + cidx];
            const float* cst = (seq >= 2) ? F.inp(5) + (((size_t)j * 8 + (seq - 2)) * 3) * GDN_CONV + cidx : nullptr;
            const bf16_t* tailp = (seq < 2 && c > 0) ? F.tails + (size_t)(cgi - 1) * 3 * 4096 + cidx : nullptr;
            float r3 = 0.f, r2 = 0.f, r1 = 0.f;
            if (tailp) { r3 = bf2f(tailp[0]); r2 = bf2f(tailp[4096]); r1 = bf2f(tailp[2 * 4096]); }
            for (int p = 0; p < 64; ++p) {
                const int t = t0 + p; float x = 0.f;
                if (t >= 0) x = bf2f(F.proj[(size_t)(base + t) * LDP + cidx]); else if (t >= -3 && cst) x = cst[(3 + t) * GDN_CONV];
                const float o = silu_f(w0 * r3 + w1 * r2 + w2 * r1 + w3 * x);
                r3 = r2; r2 = r1; r1 = x;
                if (ch < 128) qs[p * 136 + ch] = f2bf(o);
                else if (ch < 256) { const bf16_t b = f2bf(o); ks[p * 136 + (ch - 128)] = b; kT[(ch - 128) * 72 + p] = b; }
                else vT[(ch - 256) * 72 + p] = f2bf(o * vbe[p]);
            }
        }
        __syncthreads();
        if (F.tid < 128) {
            const int l = F.tid & 63; const bf16_t* rowp = (F.tid < 64 ? qs : ks) + l * 136; float ss = 0.f;
#pragma unroll
            for (int q = 0; q < 16; ++q) { const u32x4 v = *(const u32x4*)(rowp + 8 * q);
                const float a0 = __uint_as_float(v.x << 16), a1 = __uint_as_float(v.x & 0xffff0000u), a2 = __uint_as_float(v.y << 16), a3 = __uint_as_float(v.y & 0xffff0000u);
                const float a4 = __uint_as_float(v.z << 16), a5 = __uint_as_float(v.z & 0xffff0000u), a6 = __uint_as_float(v.w << 16), a7 = __uint_as_float(v.w & 0xffff0000u);
                ss += ((a0 * a0 + a1 * a1) + (a2 * a2 + a3 * a3)) + ((a4 * a4 + a5 * a5) + (a6 * a6 + a7 * a7)); }
            (F.tid < 64 ? vnq : vnk)[l] = rsqrtf(ss + EPS);
        }
        __syncthreads();
        {
            bf16_t* QKg = (bf16_t*)(sc + SG_QK) + (size_t)task * 4096;
            const int m = F.wave >> 1;
#pragma unroll
            for (int u = 0; u < 2; ++u) {
                const int st = 2 * (F.wave & 1) + u; f32x4 aK = (f32x4){0.f, 0.f, 0.f, 0.f}, aQ = (f32x4){0.f, 0.f, 0.f, 0.f};
#pragma unroll
                for (int kk = 0; kk < 4; ++kk) {
                    const bf16x8 ak = *(const bf16x8*)(ks + (16 * m + i16) * 136 + 32 * kk + 8 * g4);
                    const bf16x8 aq = *(const bf16x8*)(qs + (16 * m + i16) * 136 + 32 * kk + 8 * g4);
                    const bf16x8 b = *(const bf16x8*)(ks + (16 * st + i16) * 136 + 32 * kk + 8 * g4);
                    aK = __builtin_amdgcn_mfma_f32_16x16x32_bf16(ak, b, aK, 0, 0, 0);
                    aQ = __builtin_amdgcn_mfma_f32_16x16x32_bf16(aq, b, aQ, 0, 0, 0);
                }
                const int s_ = 16 * st + i16; const float gs = vgc[s_], nks = vnk[s_]; const int qs_ = qperm(s_);
#pragma unroll
                for (int jj = 0; jj < 4; ++jj) {
                    const int l = 16 * m + 4 * g4 + jj;
                    const float dec = (s_ <= l) ? __expf(vgc[l] - gs) : 0.f;
                    Am[l * 68 + s_] = (s_ < l) ? vbe[l] * vnk[l] * nks * aK[jj] * dec : 0.f;
                    QKg[l * 64 + qs_] = f2bf(CQ * vnq[l] * nks * aQ[jj] * dec);
                }
            }
        }
        __syncthreads();
        if (F.wave == 0) {
            int cc = F.lane; asm volatile("" : "+v"(cc));
            float x[64];
#pragma unroll
            for (int l = 0; l < 64; ++l) {
                float a0 = (l == cc) ? 1.f : 0.f, a1 = 0.f, a2 = 0.f, a3 = 0.f;
#pragma unroll
                for (int s4 = 0; s4 + 4 <= l; s4 += 4) { const f32x4 av = *(const f32x4*)(Am + l * 68 + s4); a0 -= av[0] * x[s4]; a1 -= av[1] * x[s4 + 1]; a2 -= av[2] * x[s4 + 2]; a3 -= av[3] * x[s4 + 3]; }
                if (l & 3) { const f32x4 av = *(const f32x4*)(Am + l * 68 + (l & ~3));
                    a0 -= av[0] * x[l & ~3]; if ((l & 3) > 1) a1 -= av[1] * x[(l & ~3) + 1]; if ((l & 3) > 2) a2 -= av[2] * x[(l & ~3) + 2]; }
                x[l] = (a0 + a1) + (a2 + a3);
            }
            const float csc = vbe[cc] * __expf(vgc[cc]) * vnk[cc];
#pragma unroll
            for (int l = 0; l < 64; ++l) { Tb[l * 72 + cc] = f2bf(x[l]); Tb[64 * 72 + l * 72 + cc] = f2bf(x[l] * csc); }
        } else {
            const int t7 = F.tid - 64;
            for (int idx = t7; idx < 1024; idx += 448) {
                const int l = idx >> 4, qg8 = idx & 15, kk = qg8 >> 2, gg = qg8 & 3;
                const u32x2 a = *(const u32x2*)(qs + l * 136 + 32 * kk + 4 * gg), b = *(const u32x2*)(qs + l * 136 + 32 * kk + 16 + 4 * gg);
                u32x4 w; w.x = a.x; w.y = a.y; w.z = b.x; w.w = b.y;
                *(u32x4*)(tl.q + (size_t)l * tl.sq + 8 * qg8) = w;
            }
            for (int idx = t7; idx < 1024; idx += 448) {
                const int kd = idx >> 3, pg = idx & 7, kk2 = pg >> 2, gg = pg & 3;
                const u32x2 a = *(const u32x2*)(kT + kd * 72 + 32 * kk2 + 4 * gg), b = *(const u32x2*)(kT + kd * 72 + 32 * kk2 + 16 + 4 * gg);
                u32x4 w; w.x = a.x; w.y = a.y; w.z = b.x; w.w = b.y;
                *(u32x4*)(tl.k + (size_t)(kd >> 1) * tl.sk + (kd & 1) * 64 + 8 * pg) = w;
            }
            if (t7 < 64) {
                float* vp = (float*)(sc + SG_VEC) + (size_t)task * 256; const float gl = vgc[63];
                vp[t7] = __expf(vgc[t7]) * CQ * vnq[t7]; vp[64 + t7] = vnk[t7] * __expf(gl - vgc[t7]); vp[128 + t7] = __expf(gl); vp[192 + t7] = 0.f;
            }
        }
        __syncthreads();
        {
            bf16_t* Wg = (bf16_t*)(sc + SG_W) + (size_t)task * 8192;
            bf16x8 bk[2];
#pragma unroll
            for (int k2 = 0; k2 < 2; ++k2) bk[k2] = *(const bf16x8*)(kT + (16 * F.wave + i16) * 72 + 32 * k2 + 8 * g4);
            const int qkd = qperm(16 * F.wave + i16);
#pragma unroll
            for (int m = 0; m < 4; ++m) {
                f32x4 acc = (f32x4){0.f, 0.f, 0.f, 0.f};
#pragma unroll
                for (int k2 = 0; k2 < 2; ++k2) { const bf16x8 a = *(const bf16x8*)(Tb + 64 * 72 + (16 * m + i16) * 72 + 32 * k2 + 8 * g4); acc = __builtin_amdgcn_mfma_f32_16x16x32_bf16(a, bk[k2], acc, 0, 0, 0); }
#pragma unroll
                for (int jj = 0; jj < 4; ++jj) Wg[(16 * m + 4 * g4 + jj) * 128 + qkd] = f2bf(acc[jj]);
            }
#pragma unroll
            for (int u = 0; u < 2; ++u) {
                const int v = 16 * (2 * F.wave + u) + i16;
                bf16x8 bv[2];
#pragma unroll
                for (int k2 = 0; k2 < 2; ++k2) bv[k2] = *(const bf16x8*)(vT + v * 72 + 32 * k2 + 8 * g4);
#pragma unroll
                for (int m = 0; m < 4; ++m) {
                    f32x4 acc = (f32x4){0.f, 0.f, 0.f, 0.f};
#pragma unroll
                    for (int k2 = 0; k2 < 2; ++k2) { const bf16x8 a = *(const bf16x8*)(Tb + (16 * m + i16) * 72 + 32 * k2 + 8 * g4); acc = __builtin_amdgcn_mfma_f32_16x16x32_bf16(a, bv[k2], acc, 0, 0, 0); }
                    u32x2 w; w.x = cvt_pk_bf16(acc[0], acc[1]); w.y = cvt_pk_bf16(acc[2], acc[3]);
                    *(u32x2*)(tl.v + (size_t)(v >> 2) * tl.sv + (v & 3) * 64 + 16 * m + 4 * g4) = w;
                }
            }
        }
    }
}

__device__ void phase_gdn_chain(const Frame& F0, int j) {
    const Frame F = relaunder(F0);
    unsigned char* sc = (unsigned char*)F.out;
    const int i = F.lane & 15, g = F.lane >> 4;
    for (int wt = F.wave * F.G + F.bid; wt < 1280; wt += F.G * 8) {
        const int seq = wt < 256 ? (wt >> 7) : 2 + ((wt - 256) >> 7), head = (wt >> 4) & 7, vs = wt & 15;
        const int base = seq_base(seq), nch = seq_chunks(seq);
        const int vcol = vs * 16 + i;
        f32x4 S[8];
        if (seq < 2) {
#pragma unroll
            for (int m8 = 0; m8 < 8; ++m8) S[m8] = (f32x4){0.f, 0.f, 0.f, 0.f};
        } else {
            const float* st = F.inp(4) + (((size_t)j * 8 + (seq - 2)) * GDN_HEADS + head) * GDN_DK * GDN_DV + vcol;
#pragma unroll
            for (int m8 = 0; m8 < 8; ++m8)
#pragma unroll
                for (int jj = 0; jj < 4; ++jj) S[m8][jj] = st[(size_t)(16 * m8 + 4 * g + jj) * GDN_DV];
        }
        for (int c = 0; c < nch; ++c) {
            const int cgi = cgi_of(seq, c), t0 = 64 * c - PADF, task = cgi * 8 + head;
            const GTile tl = gdn_tile(F, seq, c, head);
            const bf16_t* Wp = (const bf16_t*)(sc + SG_W) + (size_t)task * 8192;
            const bf16_t* QKp = (const bf16_t*)(sc + SG_QK) + (size_t)task * 4096;
            const float* vp = (const float*)(sc + SG_VEC) + (size_t)task * 256;
            f32x4 rsc[4], vsc[4];
#pragma unroll
            for (int m = 0; m < 4; ++m) { rsc[m] = *(const f32x4*)(vp + 16 * m + 4 * g); vsc[m] = *(const f32x4*)(vp + 64 + 16 * m + 4 * g); }
            const float egl = vp[128];
            bf16x8 Sf[4];
#pragma unroll
            for (int kk = 0; kk < 4; ++kk) Sf[kk] = pack8(S[2 * kk], S[2 * kk + 1]);
            f32x4 vn[4], O[4];
#pragma unroll
            for (int m = 0; m < 4; ++m) {
                f32x4 a1 = (f32x4){0.f, 0.f, 0.f, 0.f}, a2 = (f32x4){0.f, 0.f, 0.f, 0.f};
#pragma unroll
                for (int kk = 0; kk < 4; ++kk) {
                    const bf16x8 wf = *(const bf16x8*)(Wp + (16 * m + i) * 128 + 32 * kk + 8 * g);
                    const bf16x8 qf = *(const bf16x8*)(tl.q + (size_t)(16 * m + i) * tl.sq + 32 * kk + 8 * g);
                    a1 = __builtin_amdgcn_mfma_f32_16x16x32_bf16(wf, Sf[kk], a1, 0, 0, 0);
                    a2 = __builtin_amdgcn_mfma_f32_16x16x32_bf16(qf, Sf[kk], a2, 0, 0, 0);
                }
                const u32x2 uw = *(const u32x2*)(tl.v + (size_t)(vcol >> 2) * tl.sv + (vcol & 3) * 64 + 16 * m + 4 * g);
                vn[m][0] = __uint_as_float(uw.x << 16) - a1[0]; vn[m][1] = __uint_as_float(uw.x & 0xffff0000u) - a1[1];
                vn[m][2] = __uint_as_float(uw.y << 16) - a1[2]; vn[m][3] = __uint_as_float(uw.y & 0xffff0000u) - a1[3];
                O[m] = a2 * rsc[m];
            }
            bf16x8 Vf[2], Vsf[2];
#pragma unroll
            for (int k2 = 0; k2 < 2; ++k2) { Vf[k2] = pack8(vn[2 * k2], vn[2 * k2 + 1]); Vsf[k2] = pack8(vn[2 * k2] * vsc[2 * k2], vn[2 * k2 + 1] * vsc[2 * k2 + 1]); }
#pragma unroll
            for (int m = 0; m < 4; ++m)
#pragma unroll
                for (int k2 = 0; k2 < 2; ++k2) { const bf16x8 qk = *(const bf16x8*)(QKp + (16 * m + i) * 64 + 32 * k2 + 8 * g); O[m] = __builtin_amdgcn_mfma_f32_16x16x32_bf16(qk, Vf[k2], O[m], 0, 0, 0); }
#pragma unroll
            for (int m8 = 0; m8 < 8; ++m8) {
                f32x4 acc = S[m8] * egl; const int kd = 16 * m8 + i;
#pragma unroll
                for (int k2 = 0; k2 < 2; ++k2) { const bf16x8 kf = *(const bf16x8*)(tl.k + (size_t)(kd >> 1) * tl.sk + (kd & 1) * 64 + 32 * k2 + 8 * g); acc = __builtin_amdgcn_mfma_f32_16x16x32_bf16(kf, Vsf[k2], acc, 0, 0, 0); }
                S[m8] = acc;
            }
#pragma unroll
            for (int m = 0; m < 4; ++m)
#pragma unroll
                for (int jj = 0; jj < 4; ++jj) {
                    const int t = t0 + 16 * m + 4 * g + jj; const float o = O[m][jj];
                    float ss = o * o; ss += __shfl_xor(ss, 1); ss += __shfl_xor(ss, 2); ss += __shfl_xor(ss, 4); ss += __shfl_xor(ss, 8);
                    if (t >= 0) {
                        const int row = base + t;
                        bf16_t* zp = F.proj + (size_t)row * LDP + 4096 + head * 256 + vcol; const float z = bf2f(*zp); *zp = f2bf(o * silu_f(z));
                        if (i == 0) ((bf16_t*)(sc + SG_PART))[(size_t)row * 128 + head * 16 + vs] = f2bf(ss);
                    }
                }
        }
        float* so = (seq < 2) ? F.out + O_PGDN + (((size_t)j * 2 + seq) * GDN_HEADS + head) * GDN_DK * GDN_DV + vcol
                              : F.out + O_SGDN + (((size_t)j * 8 + (seq - 2)) * GDN_HEADS + head) * GDN_DK * GDN_DV + vcol;
#pragma unroll
        for (int m8 = 0; m8 < 8; ++m8)
#pragma unroll
            for (int jj = 0; jj < 4; ++jj) so[(size_t)(16 * m8 + 4 * g + jj) * GDN_DV] = S[m8][jj];
    }
}

__device__ void phase_gdn_post2(const Frame& F0, int j) {
    const Frame F = relaunder(F0);
    unsigned char* sc = (unsigned char*)F.out;
    for (int it = F.bid * 8 + F.wave; it < M_TOT * 8; it += F.G * 8) {
        const int row = it >> 3, head = it & 7;
        if (row < ROW_S0 && (row % TPP) < PADF) continue;
        const u32x4* pp = (const u32x4*)((const bf16_t*)(sc + SG_PART) + (size_t)row * 128 + head * 16);
        const u32x4 p0 = pp[0], p1 = pp[1];
        float ss = 0.f;
        ss += __uint_as_float(p0.x << 16) + __uint_as_float(p0.x & 0xffff0000u) + __uint_as_float(p0.y << 16) + __uint_as_float(p0.y & 0xffff0000u);
        ss += __uint_as_float(p0.z << 16) + __uint_as_float(p0.z & 0xffff0000u) + __uint_as_float(p0.w << 16) + __uint_as_float(p0.w & 0xffff0000u);
        ss += __uint_as_float(p1.x << 16) + __uint_as_float(p1.x & 0xffff0000u) + __uint_as_float(p1.y << 16) + __uint_as_float(p1.y & 0xffff0000u);
        ss += __uint_as_float(p1.z << 16) + __uint_as_float(p1.z & 0xffff0000u) + __uint_as_float(p1.w << 16) + __uint_as_float(p1.w & 0xffff0000u);
        const float rs = rsqrtf(ss * (1.0f / 256.0f) + EPS);
        u32x2* zp = (u32x2*)(F.proj + (size_t)row * LDP + 4096 + head * 256 + F.lane * 4);
        const u32x2 z = *zp;
        u32x2 w; w.x = cvt_pk_bf16(__uint_as_float(z.x << 16) * rs, __uint_as_float(z.x & 0xffff0000u) * rs); w.y = cvt_pk_bf16(__uint_as_float(z.y << 16) * rs, __uint_as_float(z.y & 0xffff0000u) * rs);
        *zp = w;
    }
    for (int e = F.bid * NTHREADS + F.tid; e < NSEQ * 3 * GDN_CONV; e += F.G * NTHREADS) {
        const int s = e / (3 * GDN_CONV), r = (e / GDN_CONV) % 3, c = e % GDN_CONV;
        if (s < 2) F.out[O_PGDNC + (((size_t)j * 2 + s) * 3 + r) * GDN_CONV + c] = bf2f(F.tails[((size_t)(s * 129 + 128) * 3 + r) * 4096 + c]);
        else F.out[O_SGDNC + (((size_t)j * 8 + (s - 2)) * 3 + r) * GDN_CONV + c] = bf2f(F.proj[(size_t)(seq_base(s) + 13 + r) * LDP + c]);
    }
}

__device__ void phase_final(const Frame& F0) {
    const Frame F = relaunder(F0);
    const float* fw = F.inp(23);
    for (int it = F.bid * 8 + F.wave; it < 2 * SEQ + 128; it += F.G * 8) {
        int row; float* dst;
        if (it < 2 * SEQ) { const int b = it / SEQ, t = it % SEQ; row = b * TPP + 64 + t; dst = F.out + O_YP + (size_t)it * D; }
        else { row = ROW_S0 + (it - 2 * SEQ); dst = F.out + O_YS + (size_t)(it - 2 * SEQ) * D; }
        float x[16]; float ss = 0.f;
#pragma unroll
        for (int i = 0; i < 4; ++i) {
            const u32x2 v = *(const u32x2*)(F.hb + (size_t)row * D + (F.lane + 64 * i) * 4);
            x[4 * i + 0] = __uint_as_float(v.x << 16); x[4 * i + 1] = __uint_as_float(v.x & 0xffff0000u); x[4 * i + 2] = __uint_as_float(v.y << 16); x[4 * i + 3] = __uint_as_float(v.y & 0xffff0000u);
            ss += (x[4 * i] * x[4 * i] + x[4 * i + 1] * x[4 * i + 1]) + (x[4 * i + 2] * x[4 * i + 2] + x[4 * i + 3] * x[4 * i + 3]);
        }
        ss = wave_sum(ss);
        const float rs = rsqrtf(ss * (1.0f / 1024.0f) + EPS);
#pragma unroll
        for (int i = 0; i < 4; ++i) {
            const int c = (F.lane + 64 * i) * 4; const f32x4 w = *(const f32x4*)(fw + c);
            f32x4 o; o[0] = x[4 * i] * rs * w[0]; o[1] = x[4 * i + 1] * rs * w[1]; o[2] = x[4 * i + 2] * rs * w[2]; o[3] = x[4 * i + 3] * rs * w[3];
            *(f32x4*)(dst + c) = o;
        }
    }
}

constexpr int N_PHASES = 22;
#ifndef MK_ONE_LAUNCH
#define MK_ONE_LAUNCH 1
#endif
__global__ void __launch_bounds__(NTHREADS, 2) hybrid_fwd(Args args) {
    extern __shared__ __attribute__((aligned(16))) unsigned char lds[];
    volatile LAS unsigned* bst = (volatile LAS unsigned*)((LAS unsigned char*)lds + LDS_BYTES - 16);
    if (threadIdx.x < 4) bst[threadIdx.x] = 0u;
    __syncthreads();
    XcdBarrier bar; bar.bar = (unsigned*)(args.ws + WS_CTL); bar.x = 0; bar.st = bst;
    if (args.ph_hi - args.ph_lo > 1) bar = xcd_barrier_post((unsigned*)(args.ws + WS_CTL), bst);
    for (int ph = args.ph_lo; ph < args.ph_hi; ++ph) {
        int tid_ = threadIdx.x; asm volatile("" : "+v"(tid_));
        Frame F;
        F.ap = &args;
        F.out = args.out; F.ws = args.ws; F.lds = lds; F.ldsl = (LAS unsigned char*)lds;
        F.tid = tid_; F.lane = F.tid & 63; F.wave = __builtin_amdgcn_readfirstlane(F.tid >> 6); F.G = gridDim.x; F.bid = blockIdx.x;
        F.hb = nullptr; F.win = nullptr; F.wout = nullptr; F.dtb = nullptr; F.rss = nullptr; F.proj = nullptr; F.tails = nullptr;
        if (ph == 0) { phase_init_h(F); phase_wprep_in(F, 0); }
        else if (ph == N_PHASES - 1) phase_final(F);
        else {
            const int L = (ph - 1) / 5, sub = (ph - 1) % 5, j = L >> 1;
            if (sub == 0) phase_inproj(F, L);
            else if (sub == 1) { if (L & 1) phase_gdn_prep(F, j); else phase_ssd_prep(F, j); phase_wprep_out(F, L); }
            else if (sub == 2) { if (L & 1) phase_gdn_chain(F, j); else phase_ssd_chain(F, j); }
            else if (sub == 3) { if (L & 1) phase_gdn_post2(F, j); else phase_ssd_post(F, j); if (L < 3) phase_wprep_in(F, L + 1); }
            else phase_outproj(F, L);
        }
        if (ph + 1 < args.ph_hi) {
            if (ph == args.ph_lo) { __threadfence(); cg::this_grid().sync(); }
            else xcd_barrier(bar);
        }
    }
}

extern "C" void kernel_launch(void* const* d_in, const int* in_sizes, int n_in, void* d_out, int out_size, void* d_ws, size_t ws_size, hipStream_t stream) {
    static int grid = 0;
    if (grid == 0) {
        if (n_in != 24 || ws_size < WS_END) { fprintf(stderr, "kernel_launch: unexpected n_in %d / ws %zu (need %zu)\n", n_in, ws_size, (size_t)WS_END); grid = -1; return; }
        int dev = 0, cus = 0, per_cu = 0;
        if (hipGetDevice(&dev) != hipSuccess || hipDeviceGetAttribute(&cus, hipDeviceAttributeMultiprocessorCount, dev) != hipSuccess) { grid = -1; return; }
        if (hipFuncSetAttribute((const void*)hybrid_fwd, hipFuncAttributeMaxDynamicSharedMemorySize, LDS_BYTES) != hipSuccess) { fprintf(stderr, "kernel_launch: hipFuncSetAttribute failed\n"); grid = -1; return; }
        if (hipOccupancyMaxActiveBlocksPerMultiprocessor(&per_cu, (const void*)hybrid_fwd, NTHREADS, LDS_BYTES) != hipSuccess || per_cu < 1) { fprintf(stderr, "kernel_launch: occupancy query says %d blocks per CU\n", per_cu); grid = -1; return; }
        (void)hipGetLastError();
        grid = cus;
    }
    if (grid < 0) return;
    Args a{};
    for (int i = 0; i < 24; ++i) a.in[i] = (const float*)d_in[i];
    a.out = (float*)d_out; a.ws = (unsigned char*)d_ws;
#if MK_ONE_LAUNCH
    (void)hipMemsetAsync((char*)d_ws + WS_CTL, 0, 16384, stream);
    a.ph_lo = 0; a.ph_hi = N_PHASES;
    void* kargs[] = {&a};
    hipError_t e = hipLaunchCooperativeKernel((const void*)hybrid_fwd, dim3(grid), dim3(NTHREADS), kargs, LDS_BYTES, stream);
    if (e != hipSuccess) fprintf(stderr, "kernel_launch: cooperative launch failed: %s (grid %d)\n", hipGetErrorString(e), grid);
#else
    for (int ph = 0; ph < N_PHASES; ++ph) {
        a.ph_lo = ph; a.ph_hi = ph + 1;
        hipLaunchKernelGGL(hybrid_fwd, dim3(grid), dim3(NTHREADS), LDS_BYTES, stream, a);
    }
#endif
}
```

```cpp
#include <hip/hip_runtime.h>
#include <hip/hip_cooperative_groups.h>
#include <cstdio>
#include <cstdint>
namespace cg = cooperative_groups;

#define LAS __attribute__((address_space(3)))
typedef unsigned short bf16_t;
typedef short bf16x8 __attribute__((ext_vector_type(8)));
typedef float f32x4 __attribute__((ext_vector_type(4)));
typedef unsigned u32x4 __attribute__((ext_vector_type(4)));
typedef unsigned u32x2 __attribute__((ext_vector_type(2)));

constexpr int D = 1024;
constexpr int SEQ = 8192, NMETA = 16, PADF = 48;
constexpr int TPP = 8256;
constexpr int ROW_S0 = 2 * TPP;
constexpr int M_TOT = ROW_S0 + 128;
constexpr int NSEQ = 10;
constexpr float EPS = 1e-6f;
constexpr int LDP = 6144;
constexpr int SSD_INNER = 2048, SSD_HEADS = 32, SSD_P = 64, SSD_N = 128, SSD_CONV = 3072, SSD_IN = 5152, SSD_IN_PAD = 5376;
constexpr int GDN_HEADS = 8, GDN_DK = 128, GDN_DV = 256, GDN_CONV = 4096, GDN_VAL = 2048, GDN_IN = 6160, GDN_IN_PAD = 6400;

constexpr size_t O_YP = 0, O_YS = 16777216, O_PSSD = 16908288, O_PSSDC = 17956864, O_PGDN = 17993728, O_PGDNC = 19042304,
                 O_SSSD = 19091456, O_SSSDC = 23285760, O_SGDN = 23433216, O_SGDNC = 27627520;

constexpr size_t WS_CTL = 0;
constexpr size_t WS_HB = 65536;
constexpr size_t WS_WIN = WS_HB + (size_t)M_TOT * D * 2;
constexpr size_t WS_WOUT = WS_WIN + (size_t)GDN_IN_PAD * D * 2;
constexpr size_t WS_TAIL = WS_WOUT + (size_t)1024 * 2048 * 2;
constexpr size_t WS_DTB = WS_TAIL + (size_t)258 * 3 * 4096 * 2;
constexpr size_t WS_RSS = WS_DTB + (size_t)M_TOT * 32 * 4;
constexpr size_t WS_PROJ = WS_RSS + (size_t)M_TOT * 16 * 4;
constexpr size_t WS_END = WS_PROJ + (size_t)M_TOT * LDP * 2;

constexpr int NTHREADS = 512;
constexpr int LDS_BYTES = 147456;

__device__ __forceinline__ float bf2f(bf16_t b) { return __uint_as_float(((unsigned)b) << 16); }
__device__ __forceinline__ bf16_t f2bf(float f) { unsigned u = __float_as_uint(f); u += 0x7FFFu + ((u >> 16) & 1u); return (bf16_t)(u >> 16); }
typedef __bf16 bf16v2_t __attribute__((ext_vector_type(2)));
typedef float f32x2_t __attribute__((ext_vector_type(2)));
__device__ __forceinline__ unsigned cvt_pk_bf16(float lo, float hi) { const bf16v2_t r = __builtin_convertvector((f32x2_t){lo, hi}, bf16v2_t); return __builtin_bit_cast(unsigned, r); }
__device__ __forceinline__ float silu_f(float x) { return x / (1.0f + __expf(-x)); }
__device__ __forceinline__ float softplus_f(float x) { return x > 20.f ? x : log1pf(__expf(x)); }
__device__ __forceinline__ float wave_sum(float v) {
#pragma unroll
    for (int o = 32; o >= 1; o >>= 1) v += __shfl_xor(v, o);
    return v;
}
#define KEEP(x) asm volatile("" :: "v"(x))
__device__ __forceinline__ int seq_base(int s) { return s < 2 ? s * TPP + 64 - NMETA : ROW_S0 + 16 * (s - 2); }
__device__ __forceinline__ int seq_len(int s) { return s < 2 ? SEQ + NMETA : 16; }
__device__ __forceinline__ int seq_chunks(int s) { return s < 2 ? 129 : 1; }

namespace pg8 {
constexpr int BM = 256, BK = 64, HALF = 128, HTB = HALF * BK * 2, STAGE_BYTES = 8 * HTB, NXCD = 8, WGM = 8;
__device__ __forceinline__ int lds_byte(int r, int c) { const int st = (r >> 4) * 2 + (c >> 5), rr = r & 15, cc = c & 31, ob = rr * 64 + cc * 2; return st * 1024 + (ob ^ (((ob >> 9) & 1) << 5)); }
__device__ __forceinline__ void stage_rc(int b, int& R, int& C) { const int st = b / 1024, sb = b % 1024, swz = sb ^ (((sb >> 9) & 1) << 5); R = (st >> 1) * 16 + swz / 64; C = (st & 1) * 32 + (swz % 64) / 2; }
__device__ __forceinline__ int perm32(int rho) { const int n = rho >> 4, i = rho & 15; return 8 * (i >> 2) + 4 * n + (i & 3); }
struct Unit { int pm, pn; };
struct Gemm { const bf16_t* A; const bf16_t* Bt; int M, N, K, lda, ldb; };
struct StaticOrder {
    int nM, nN, nwg, G, c;
    __device__ void init(int M, int N, int G_, int c_) { nM = M / BM; nN = N / BM; nwg = nM * nN; G = G_; c = c_; }
    __device__ bool next(int i, Unit& u) const {
        const long L = (long)i * G + c; if (L >= nwg) return false;
        int wgid = (int)L; { const int q = nwg / NXCD, r = nwg % NXCD, xcd = wgid % NXCD, off = wgid / NXCD; wgid = (xcd < r ? xcd * (q + 1) : r * (q + 1) + (xcd - r) * q) + off; }
        const int nig = WGM * nN, gid = wgid / nig, fm = gid * WGM, gsz = (nM - fm) < WGM ? (nM - fm) : WGM;
        u.pm = fm + ((wgid % nig) % gsz); u.pn = (wgid % nig) / gsz; return true;
    }
};

template <class Epi>
__device__ __forceinline__ void gemm_phase(LAS unsigned char* lds, const Gemm g, const StaticOrder& S, const Epi& E, const int tid) {
    const int wid = __builtin_amdgcn_readfirstlane(tid >> 6), lane = tid & 63, wr = wid >> 2, wc = wid & 3, fr = lane & 15, fq = lane >> 4;
    const int K = g.K, nt = K / BK;
    unsigned voffA[2], voffB[2];
#pragma unroll
    for (int i = 0; i < 2; ++i) { int R, C; stage_rc(tid * 16 + i * 8192, R, C); const int Rb = Epi::PERM ? ((R & ~31) + perm32(R & 31)) : R;
        voffA[i] = (unsigned)(R * g.lda + C) * 2u; voffB[i] = (unsigned)(Rb * g.ldb + C) * 2u; }
    const size_t kstep = (size_t)(BK * 2);
    const size_t hstepA = (size_t)HALF * g.lda * 2, hstepB = (size_t)HALF * g.ldb * 2;
    const size_t tstepA = 2 * hstepA, tstepB = 2 * hstepB;
    const unsigned ldsw = (unsigned)wid * 1024u;
    const int aoff = lds_byte(wr * 64 + fr, fq * 8), boff = lds_byte(wc * 32 + fr, fq * 8);
#define PG8_SA(b, h) (((b) * 2 + (h)) * HTB)
#define PG8_SB(b, h) ((4 + (b) * 2 + (h)) * HTB)
#define PG8_STAGE(bufoff, gbase, voff) do { _Pragma("unroll") for (int _i = 0; _i < 2; ++_i) \
        __builtin_amdgcn_global_load_lds((const unsigned*)((const char*)(gbase) + (voff)[_i]), (LAS unsigned*)(lds + (bufoff) + ldsw + _i * 8192), 16, 0, 0); } while (0)
#define PG8_LDA(dst, b, h) do { _Pragma("unroll") for (int m = 0; m < 4; ++m) _Pragma("unroll") for (int k = 0; k < 2; ++k) dst[m][k] = *(const LAS bf16x8*)(lds + PG8_SA(b, h) + aoff + m * 2048 + k * 1024); } while (0)
#define PG8_LDB(dst, b, h) do { _Pragma("unroll") for (int n = 0; n < 2; ++n) _Pragma("unroll") for (int k = 0; k < 2; ++k) dst[n][k] = *(const LAS bf16x8*)(lds + PG8_SB(b, h) + boff + n * 2048 + k * 1024); } while (0)
#define PG8_MMA(ai, bj, At, Bt) do { __builtin_amdgcn_s_setprio(1); _Pragma("unroll") for (int m = 0; m < 4; ++m) _Pragma("unroll") for (int n = 0; n < 2; ++n) _Pragma("unroll") for (int k = 0; k < 2; ++k) \
        acc[ai][bj][m][n] = __builtin_amdgcn_mfma_f32_16x16x32_bf16(Bt[n][k], At[m][k], acc[ai][bj][m][n], 0, 0, 0); __builtin_amdgcn_s_setprio(0); } while (0)
#define PG8_WAIT_V(n) asm volatile("s_waitcnt vmcnt(" #n ")" ::: "memory")
#define PG8_WAIT_L(n) asm volatile("s_waitcnt lgkmcnt(" #n ")" ::: "memory")
#define PG8_BAR __builtin_amdgcn_s_barrier()
#define PG8_SCHED __builtin_amdgcn_sched_barrier(0)
    Unit cur, nxt; int ui = 0;
    if (!S.next(0, cur)) return;
    f32x4 acc[2][2][4][2];
#pragma unroll
    for (int a = 0; a < 2; ++a)
#pragma unroll
        for (int b = 0; b < 2; ++b)
#pragma unroll
            for (int m = 0; m < 4; ++m)
#pragma unroll
                for (int n = 0; n < 2; ++n) acc[a][b][m][n] = (f32x4){0.f, 0.f, 0.f, 0.f};
    bf16x8 At[4][2], B0[2][2], B1[2][2];
    const char* cA = (const char*)g.A + (size_t)cur.pm * tstepA; const char* cB = (const char*)g.Bt + (size_t)cur.pn * tstepB;
    PG8_STAGE(PG8_SB(0, 0), cB, voffB); PG8_STAGE(PG8_SA(0, 0), cA, voffA); PG8_STAGE(PG8_SB(0, 1), cB + hstepB, voffB); PG8_STAGE(PG8_SA(0, 1), cA + hstepA, voffA);
    if (wr == 1) PG8_BAR;
    PG8_WAIT_V(4); PG8_BAR;
    PG8_STAGE(PG8_SB(1, 0), cB + kstep, voffB); PG8_STAGE(PG8_SA(1, 0), cA + kstep, voffA); PG8_STAGE(PG8_SB(1, 1), cB + hstepB + kstep, voffB);
    PG8_WAIT_V(6); PG8_BAR;
    for (;;) {
        const bool has_next = S.next(ui + 1, nxt);
        const char* nA = has_next ? (const char*)g.A + (size_t)nxt.pm * tstepA : cA; const char* nB = has_next ? (const char*)g.Bt + (size_t)nxt.pn * tstepB : cB;
        for (int t = 0; t < nt; t += 2) {
            const bool last = (t == nt - 2);
            const char* a1 = cA + (size_t)(t + 1) * kstep;
            const char* a2 = last ? nA : cA + (size_t)(t + 2) * kstep; const char* b2 = last ? nB : cB + (size_t)(t + 2) * kstep;
            const char* a3 = a2 + kstep; const char* b3 = b2 + kstep;
            PG8_LDB(B0, 0, 0); PG8_SCHED; PG8_LDA(At, 0, 0); PG8_STAGE(PG8_SA(1, 1), a1 + hstepA, voffA);
            PG8_WAIT_L(8); PG8_BAR; PG8_WAIT_L(0); PG8_MMA(0, 0, At, B0); PG8_BAR; PG8_SCHED;
            PG8_LDB(B1, 0, 1); PG8_STAGE(PG8_SB(0, 0), b2, voffB);
            PG8_BAR; PG8_WAIT_L(0); PG8_MMA(0, 1, At, B1); PG8_BAR;
            PG8_LDA(At, 0, 1); PG8_STAGE(PG8_SA(0, 0), a2, voffA);
            PG8_BAR; PG8_WAIT_L(0); PG8_MMA(1, 0, At, B0); PG8_BAR; PG8_SCHED;
            PG8_STAGE(PG8_SB(0, 1), b2 + hstepB, voffB);
            PG8_WAIT_V(6); PG8_BAR; PG8_MMA(1, 1, At, B1); PG8_BAR;
            PG8_LDB(B0, 1, 0); PG8_SCHED; PG8_LDA(At, 1, 0); PG8_STAGE(PG8_SA(0, 1), a2 + hstepA, voffA);
            PG8_WAIT_L(8); PG8_BAR; PG8_WAIT_L(0); PG8_MMA(0, 0, At, B0); PG8_BAR; PG8_SCHED;
            PG8_LDB(B1, 1, 1); PG8_STAGE(PG8_SB(1, 0), b3, voffB);
            PG8_BAR; PG8_WAIT_L(0); PG8_MMA(0, 1, At, B1); PG8_BAR;
            PG8_LDA(At, 1, 1); PG8_STAGE(PG8_SA(1, 0), a3, voffA);
            PG8_BAR; PG8_WAIT_L(0); PG8_MMA(1, 0, At, B0); PG8_BAR; PG8_SCHED;
            PG8_STAGE(PG8_SB(1, 1), b3 + hstepB, voffB);
            PG8_WAIT_V(6); PG8_BAR; PG8_MMA(1, 1, At, B1); PG8_BAR;
        }
        E(acc, cur, wr, wc, fr, fq);
        if (!has_next) break;
#pragma unroll
        for (int a = 0; a < 2; ++a)
#pragma unroll
            for (int b = 0; b < 2; ++b)
#pragma unroll
                for (int m = 0; m < 4; ++m)
#pragma unroll
                    for (int n = 0; n < 2; ++n) acc[a][b][m][n] = (f32x4){0.f, 0.f, 0.f, 0.f};
        cur = nxt; cA = nA; cB = nB; ++ui;
    }
    PG8_WAIT_V(0);
    if (wr == 0) PG8_BAR;
    PG8_BAR;
#undef PG8_SA
#undef PG8_SB
#undef PG8_STAGE
#undef PG8_LDA
#undef PG8_LDB
#undef PG8_MMA
#undef PG8_WAIT_V
#undef PG8_WAIT_L
#undef PG8_BAR
#undef PG8_SCHED
}

struct EpiInProj {
    static constexpr bool PERM = true;
    bf16_t* proj; float* dtb; const float* rowss; int nt_main; bf16_t* tails; int tl_lo, tl_hi;
    __device__ __forceinline__ void operator()(const f32x4 (&acc)[2][2][4][2], const Unit& u, int wr, int wc, int fr, int fq) const {
        const int row0 = u.pm * BM + wr * 64 + fr;
#pragma unroll
        for (int ai = 0; ai < 2; ++ai)
#pragma unroll
            for (int m = 0; m < 4; ++m) {
                const int r = row0 + ai * HALF + m * 16;
                const f32x4* rp = (const f32x4*)(rowss + (size_t)r * 16);
                const f32x4 p0 = rp[0], p1 = rp[1], p2 = rp[2], p3 = rp[3];
                const float ss = ((p0[0] + p0[1]) + (p0[2] + p0[3])) + ((p1[0] + p1[1]) + (p1[2] + p1[3])) + ((p2[0] + p2[1]) + (p2[2] + p2[3])) + ((p3[0] + p3[1]) + (p3[2] + p3[3]));
                const float rstd = rsqrtf(ss * (1.0f / 1024.0f) + EPS);
                if (u.pn < nt_main) {
                    bf16_t* rowp = proj + (size_t)r * LDP + u.pn * BM + wc * 32 + 8 * fq;
#pragma unroll
                    for (int bj = 0; bj < 2; ++bj) { const f32x4 v0 = acc[ai][bj][m][0] * rstd, v1 = acc[ai][bj][m][1] * rstd;
                        u32x4 w; w.x = cvt_pk_bf16(v0[0], v0[1]); w.y = cvt_pk_bf16(v0[2], v0[3]); w.z = cvt_pk_bf16(v1[0], v1[1]); w.w = cvt_pk_bf16(v1[2], v1[3]);
                        *(u32x4*)(rowp + bj * HALF) = w;
                        if (u.pn >= tl_lo && u.pn < tl_hi && r < ROW_S0 && (r & 63) >= 61) *(u32x4*)(tails + ((size_t)(r >> 6) * 3 + ((r & 63) - 61)) * 4096 + (u.pn - tl_lo) * BM + wc * 32 + 8 * fq + bj * HALF) = w; }
                } else if (wc == 0) {
                    float* dp = dtb + (size_t)r * 32 + 8 * fq;
                    *(f32x4*)(dp) = acc[ai][0][m][0] * rstd; *(f32x4*)(dp + 4) = acc[ai][0][m][1] * rstd;
                }
            }
    }
};
struct EpiOutProj {
    static constexpr bool PERM = false;
    bf16_t* hb; float* rowss;
    __device__ __forceinline__ void operator()(const f32x4 (&acc)[2][2][4][2], const Unit& u, int wr, int wc, int fr, int fq) const {
        const int row0 = u.pm * BM + wr * 64 + fr, col0 = u.pn * BM + wc * 32 + 4 * fq;
#pragma unroll
        for (int ai = 0; ai < 2; ++ai)
#pragma unroll
            for (int m = 0; m < 4; ++m) {
                const int r = row0 + ai * HALF + m * 16; float ss = 0.f;
                bf16_t* rowp = hb + (size_t)r * D + col0;
#pragma unroll
                for (int bj = 0; bj < 2; ++bj)
#pragma unroll
                    for (int n = 0; n < 2; ++n) {
                        u32x2* p = (u32x2*)(rowp + bj * HALF + n * 16); const u32x2 o = *p;
                        const f32x4 a = acc[ai][bj][m][n];
                        const float h0 = __uint_as_float(o.x << 16) + a[0], h1 = __uint_as_float(o.x & 0xffff0000u) + a[1];
                        const float h2 = __uint_as_float(o.y << 16) + a[2], h3 = __uint_as_float(o.y & 0xffff0000u) + a[3];
                        ss += (h0 * h0 + h1 * h1) + (h2 * h2 + h3 * h3);
                        u32x2 w; w.x = cvt_pk_bf16(h0, h1); w.y = cvt_pk_bf16(h2, h3); *p = w;
                    }
                ss += __shfl_xor(ss, 16); ss += __shfl_xor(ss, 32);
                if (fq == 0) rowss[(size_t)r * 16 + u.pn * 4 + wc] = ss;
            }
    }
};
}

#define XB_TMO      128
#define XB_XCNT(j)  (256  + 64 * (j))
#define XB_XSUB(j)  (1280 + 64 * (j))
#define XB_XGEN(j)  (2304 + 64 * (j))
#define XB_TOP      3328
#define XB_TOPGEN   3392
#define XCD_BAR_WORDS 3456
#define XB_SPIN_CAP (1u << 24)
__device__ __forceinline__ unsigned xb_ld(unsigned* p)              { return __hip_atomic_load(p, __ATOMIC_RELAXED, __HIP_MEMORY_SCOPE_AGENT); }
__device__ __forceinline__ unsigned xb_add(unsigned* p, unsigned v) { return __hip_atomic_fetch_add(p, v, __ATOMIC_RELAXED, __HIP_MEMORY_SCOPE_AGENT); }
__device__ __forceinline__ unsigned xb_xcc_id() { return (unsigned)__builtin_amdgcn_s_getreg((3 << 11) | 20) & 0xFu; }
#define XB_SPIN(cond, bar) do { unsigned _sp = 0; while (cond) { __builtin_amdgcn_s_sleep(1); \
    if ((++_sp & 255u) == 0u) { if (xb_ld(&(bar)[XB_TMO])) break; if (_sp > XB_SPIN_CAP) { atomicAdd(&(bar)[XB_TMO], 1u); break; } } } } while (0)
struct XcdBarrier { unsigned* bar; unsigned x; volatile LAS unsigned* st; };
__device__ __forceinline__ XcdBarrier xcd_barrier_post(unsigned* bar, volatile LAS unsigned* st) {
    XcdBarrier b; b.bar = bar; b.x = xb_xcc_id(); b.st = st;
    if (threadIdx.x == 0) (void)xb_add(&bar[XB_XCNT(b.x)], 1u);
    return b;
}
__device__ __forceinline__ void xcd_barrier_complete(unsigned* bar, unsigned x, unsigned& nloc, unsigned& nx) {
    const unsigned G = gridDim.x * gridDim.y * gridDim.z;
    unsigned sum, cnt, mine, sp = 0u;
    for (;;) {
        sum = 0u; cnt = 0u; mine = 0u;
#pragma unroll
        for (unsigned j = 0; j < 16; ++j) { const unsigned c = xb_ld(&bar[XB_XCNT(j)]); sum += c; cnt += (c > 0u) ? 1u : 0u; mine = (j == x) ? c : mine; }
        if (sum == G) break;
        __builtin_amdgcn_s_sleep(1);
        if ((++sp & 255u) == 0u) { if (xb_ld(&bar[XB_TMO])) break; if (sp > XB_SPIN_CAP) { atomicAdd(&bar[XB_TMO], 1u); break; } }
    }
    nloc = mine > 0u ? mine : 1u; nx = cnt > 0u ? cnt : 1u;
}
__device__ __forceinline__ void xcd_barrier(const XcdBarrier& b) {
    asm volatile("s_waitcnt vmcnt(0)" ::: "memory");
    __syncthreads();
    if (threadIdx.x == 0) {
        unsigned* bar = b.bar;
        __builtin_amdgcn_s_waitcnt(0);
        unsigned nloc = b.st[0], nx = b.st[1];
        if (nloc == 0u) { xcd_barrier_complete(bar, b.x, nloc, nx); b.st[0] = nloc; b.st[1] = nx; }
        const unsigned old = xb_add(&bar[XB_XSUB(b.x)], 1u);
        const unsigned gen = old / nloc;
        if (old + 1u == (gen + 1u) * nloc) {
            __builtin_amdgcn_fence(__ATOMIC_RELEASE, "agent");
            asm volatile("s_waitcnt vmcnt(0)" ::: "memory");
            const unsigned og = xb_add(&bar[XB_TOP], 1u);
            const unsigned tg = og / nx;
            if (og + 1u == (tg + 1u) * nx) xb_add(&bar[XB_TOPGEN], 1u);
            else XB_SPIN(xb_ld(&bar[XB_TOPGEN]) == tg, bar);
            __builtin_amdgcn_fence(__ATOMIC_ACQUIRE, "agent");
            xb_add(&bar[XB_XGEN(b.x)], 1u);
            asm volatile("s_waitcnt vmcnt(0)" ::: "memory");
        } else {
            XB_SPIN(xb_ld(&bar[XB_XGEN(b.x)]) == gen, bar);
            __builtin_amdgcn_fence(__ATOMIC_ACQUIRE, "agent");
            asm volatile("s_waitcnt vmcnt(0)" ::: "memory");
        }
    }
    __syncthreads();
}

struct Args { const float* in[24]; float* out; unsigned char* ws; int ph_lo, ph_hi; };

struct Frame {
    const Args* ap; float* out; unsigned char* ws;
    __device__ __forceinline__ const float* inp(int i) const { asm volatile("" : "+s"(i)); return ap->in[i]; }
    unsigned char* lds; LAS unsigned char* ldsl;
    int tid, lane, wave, G, bid;
    bf16_t* hb; bf16_t* win; bf16_t* wout; float* dtb; float* rss; bf16_t* proj; bf16_t* tails;
};

__device__ __forceinline__ Frame relaunder(Frame F) {
    int t = F.tid; asm volatile("" : "+v"(t));
    F.tid = t; F.lane = t & 63; F.wave = __builtin_amdgcn_readfirstlane(t >> 6);
    unsigned char* w = F.ws; asm volatile("" : "+s"(w));
    F.ws = w; F.hb = (bf16_t*)(w + WS_HB); F.win = (bf16_t*)(w + WS_WIN); F.wout = (bf16_t*)(w + WS_WOUT);
    F.dtb = (float*)(w + WS_DTB); F.rss = (float*)(w + WS_RSS); F.proj = (bf16_t*)(w + WS_PROJ); F.tails = (bf16_t*)(w + WS_TAIL);
    return F;
}
__device__ void phase_init_h(const Frame& F0) {
    const Frame F = relaunder(F0);
    const float* xp = F.inp(0); const float* xs = F.inp(1); const float* meta = F.inp(6);
    for (int row = F.bid * 8 + F.wave; row < M_TOT; row += F.G * 8) {
        const float* src = nullptr;
        if (row < ROW_S0) { const int b = row / TPP, r = row % TPP; if (r >= 64) src = xp + ((size_t)b * SEQ + (r - 64)) * D; else if (r >= PADF) src = meta + (size_t)(r - PADF) * D; }
        else src = xs + (size_t)(row - ROW_S0) * D;
        float ss = 0.f;
#pragma unroll
        for (int i = 0; i < 4; ++i) {
            f32x4 v = (f32x4){0.f, 0.f, 0.f, 0.f};
            if (src) v = *(const f32x4*)(src + (F.lane + 64 * i) * 4);
            ss += (v[0] * v[0] + v[1] * v[1]) + (v[2] * v[2] + v[3] * v[3]);
            u32x2 w; w.x = cvt_pk_bf16(v[0], v[1]); w.y = cvt_pk_bf16(v[2], v[3]);
            *(u32x2*)(F.hb + (size_t)row * D + (F.lane + 64 * i) * 4) = w;
        }
        ss = wave_sum(ss);
        if (F.lane < 16) F.rss[(size_t)row * 16 + F.lane] = (F.lane == 0) ? ss : 0.f;
    }
}

__device__ void transpose_convert(const Frame& F, const float* src, int K, int N, int Npad, bf16_t* dst, const float* scale, int smod) {
    float* tile = (float*)F.lds;
    const int ntk = K / 64, ntn = Npad / 64, ntile = ntk * ntn;
    __syncthreads();
    for (int ti = F.bid; ti < ntile; ti += F.G) {
        const int kt = ti % ntk, nt_ = ti / ntk, k0 = kt * 64, n0 = nt_ * 64;
        const int kk = F.tid >> 4, n4 = (F.tid & 15) * 4;
#pragma unroll
        for (int h = 0; h < 2; ++h) {
            const int k = k0 + kk + 32 * h, n = n0 + n4;
            f32x4 v = (f32x4){0.f, 0.f, 0.f, 0.f};
            if (n < N) v = *(const f32x4*)(src + (size_t)k * N + n);
            const float s = scale[k % smod];
            float* tp = tile + (kk + 32 * h) * 65 + n4;
            tp[0] = v[0] * s; tp[1] = v[1] * s; tp[2] = v[2] * s; tp[3] = v[3] * s;
        }
        __syncthreads();
        const int nn = F.tid >> 3, kg = (F.tid & 7) * 8;
        float x[8];
#pragma unroll
        for (int j = 0; j < 8; ++j) x[j] = tile[(kg + j) * 65 + nn];
        u32x4 w; w.x = cvt_pk_bf16(x[0], x[1]); w.y = cvt_pk_bf16(x[2], x[3]); w.z = cvt_pk_bf16(x[4], x[5]); w.w = cvt_pk_bf16(x[6], x[7]);
        *(u32x4*)(dst + (size_t)(n0 + nn) * K + k0 + kg) = w;
        __syncthreads();
    }
}
__device__ void phase_wprep_in(const Frame& F0, int L) {
    const Frame F = relaunder(F0);
    const int j = L >> 1;
    if ((L & 1) == 0) transpose_convert(F, F.inp(8) + (size_t)j * D * SSD_IN, D, SSD_IN, SSD_IN_PAD, F.win, F.inp(7) + j * D, D);
    else transpose_convert(F, F.inp(17) + (size_t)j * D * GDN_IN, D, GDN_IN, GDN_IN_PAD, F.win, F.inp(16) + j * D, D);
}
__device__ void phase_wprep_out(const Frame& F0, int L) {
    const Frame F = relaunder(F0);
    const int j = L >> 1;
    if ((L & 1) == 0) transpose_convert(F, F.inp(15) + (size_t)j * SSD_INNER * D, SSD_INNER, D, D, F.wout, F.inp(14) + j * SSD_INNER, SSD_INNER);
    else transpose_convert(F, F.inp(22) + (size_t)j * GDN_VAL * D, GDN_VAL, D, D, F.wout, F.inp(21) + j * GDN_DV, GDN_DV);
}

__device__ void phase_inproj(const Frame& F0, int L) {
    const Frame F = relaunder(F0);
    const int npad = (L & 1) ? GDN_IN_PAD : SSD_IN_PAD;
    pg8::Gemm g{F.hb, F.win, M_TOT, npad, D, D, D};
    pg8::StaticOrder S; S.init(M_TOT, npad, F.G, F.bid);
    pg8::EpiInProj E{F.proj, F.dtb, F.rss, npad / 256 - 1, F.tails, (L & 1) ? 0 : 8, 16};
    pg8::gemm_phase<pg8::EpiInProj>(F.ldsl, g, S, E, F.tid);
}
__device__ void phase_outproj(const Frame& F0, int L) {
    const Frame F = relaunder(F0);
    const bf16_t* A = F.proj + ((L & 1) ? 4096 : 0);
    pg8::Gemm g{A, F.wout, M_TOT, D, 2048, LDP, 2048};
    pg8::StaticOrder S; S.init(M_TOT, D, F.G, F.bid);
    pg8::EpiOutProj E{F.hb, F.rss};
    pg8::gemm_phase<pg8::EpiOutProj>(F.ldsl, g, S, E, F.tid);
}

__device__ void phase_ssd_naive(const Frame& F0, int j) {
    const Frame F = relaunder(F0);
    float* xs = (float*)F.lds;
    float* Bs = xs + 64 * 64;
    float* Cs = Bs + 64 * 128;
    float* dts = Cs + 64 * 128;
    float* das = dts + 64;
    const float* conv_w = F.inp(9) + (size_t)j * 4 * SSD_CONV; const float* conv_b = F.inp(10) + (size_t)j * SSD_CONV;
    const int p = F.tid >> 3, nq = F.tid & 7;
    for (int task = F.bid; task < NSEQ * SSD_HEADS; task += F.G) {
        const int s = task / SSD_HEADS, head = task % SSD_HEADS, grp = head >> 3;
        const int base = seq_base(s), nch = seq_chunks(s);
        const float dt_bias = F.inp(11)[j * SSD_HEADS + head], a = -__expf(F.inp(12)[j * SSD_HEADS + head]), dsk = F.inp(13)[j * SSD_HEADS + head];
        float h[16];
        if (s < 2) {
#pragma unroll
            for (int n = 0; n < 16; ++n) h[n] = 0.f;
        } else {
            const float* st = F.inp(2) + ((((size_t)j * 8 + (s - 2)) * SSD_HEADS + head) * SSD_P + p) * SSD_N + nq * 16;
#pragma unroll
            for (int n = 0; n < 16; ++n) h[n] = st[n];
        }
        int cidx = -1;
        if (F.tid < 64) cidx = head * 64 + F.tid; else if (F.tid < 192) cidx = 2048 + grp * 128 + (F.tid - 64); else if (F.tid < 320) cidx = 2560 + grp * 128 + (F.tid - 192);
        float w0 = 0, w1 = 0, w2 = 0, w3 = 0, cb = 0;
        if (cidx >= 0) { w0 = conv_w[cidx]; w1 = conv_w[SSD_CONV + cidx]; w2 = conv_w[2 * SSD_CONV + cidx]; w3 = conv_w[3 * SSD_CONV + cidx]; cb = conv_b[cidx]; }
        const float* cst = (s >= 2) ? F.inp(3) + (((size_t)j * 8 + (s - 2)) * 3) * SSD_CONV : nullptr;
        for (int c = 0; c < nch; ++c) {
            const int t0 = 64 * c - PADF;
            __syncthreads();
            if (cidx >= 0) {
                float r3, r2, r1;
                {   float rv[3];
#pragma unroll
                    for (int q = 0; q < 3; ++q) { const int t = t0 - 3 + q; float v = 0.f;
                        if (t >= 0) v = bf2f(F.proj[(size_t)(base + t) * LDP + 2048 + cidx]); else if (t >= -3 && cst) v = cst[(3 + t) * SSD_CONV + cidx];
                        rv[q] = v; }
                    r3 = rv[0]; r2 = rv[1]; r1 = rv[2]; }
                for (int i = 0; i < 64; ++i) {
                    const int t = t0 + i; float v = 0.f;
                    if (t >= 0) v = bf2f(F.proj[(size_t)(base + t) * LDP + 2048 + cidx]); else if (t >= -3 && cst) v = cst[(3 + t) * SSD_CONV + cidx];
                    const float o = silu_f(cb + w0 * r3 + w1 * r2 + w2 * r1 + w3 * v);
                    r3 = r2; r2 = r1; r1 = v;
                    if (F.tid < 64) xs[i * 64 + F.tid] = o; else if (F.tid < 192) Bs[i * 128 + (F.tid - 64)] = o; else Cs[i * 128 + (F.tid - 192)] = o;
                }
            } else if (F.tid >= 448) {
                const int i = F.tid - 448, t = t0 + i;
                float dt = 0.f, da = 1.f;
                if (t >= 0) { dt = softplus_f(F.dtb[(size_t)(base + t) * 32 + head] + dt_bias); da = __expf(dt * a); }
                dts[i] = dt; das[i] = da;
            }
            __syncthreads();
            for (int i = 0; i < 64; ++i) {
                const int t = t0 + i;
                const float dt = dts[i], da = das[i], xv = xs[i * 64 + p], dx = dt * xv;
                const float* bp = Bs + i * 128 + nq * 16; const float* cp = Cs + i * 128 + nq * 16;
                float accv = 0.f;
#pragma unroll
                for (int n = 0; n < 16; ++n) { h[n] = h[n] * da + dx * bp[n]; accv += cp[n] * h[n]; }
                accv += __shfl_xor(accv, 1); accv += __shfl_xor(accv, 2); accv += __shfl_xor(accv, 4);
                if (nq == 0 && t >= 0) {
                    bf16_t* zp = F.proj + (size_t)(base + t) * LDP + head * 64 + p;
                    const float z = bf2f(*zp);
                    *zp = f2bf((accv + dsk * xv) * silu_f(z));
                }
            }
        }
        float* so = (s < 2) ? F.out + O_PSSD + ((((size_t)j * 2 + s) * SSD_HEADS + head) * SSD_P + p) * SSD_N + nq * 16
                            : F.out + O_SSSD + ((((size_t)j * 8 + (s - 2)) * SSD_HEADS + head) * SSD_P + p) * SSD_N + nq * 16;
#pragma unroll
        for (int n = 0; n < 16; ++n) so[n] = h[n];
    }
}


constexpr int NCHT = 266;
constexpr size_t SC_BT = 0;
constexpr size_t SC_C = SC_BT + (size_t)NCHT * 4 * 16384;
constexpr size_t SC_CB = SC_C + (size_t)NCHT * 4 * 16384;
constexpr size_t SC_VEC = SC_CB + (size_t)NCHT * 4 * 8192;
constexpr size_t SC_XS = SC_VEC + (size_t)NCHT * 32 * 1024;
constexpr size_t SC_SSD_END = SC_XS + (size_t)256 * 8192;
static_assert(SC_SSD_END <= (size_t)16777216 * 4, "scratch must fit the y_prompt region");
__device__ __forceinline__ int qperm(int s) { return (s & ~31) | (((s >> 2) & 3) << 3) | (((s >> 4) & 1) << 2) | (s & 3); }
__device__ __forceinline__ int qnat(int q) { return (q & ~31) | (((q >> 2) & 1) << 4) | (((q >> 3) & 3) << 2) | (q & 3); }
__device__ __forceinline__ bf16x8 pack8(f32x4 a, f32x4 b) {
    u32x4 w; w.x = cvt_pk_bf16(a[0], a[1]); w.y = cvt_pk_bf16(a[2], a[3]); w.z = cvt_pk_bf16(b[0], b[1]); w.w = cvt_pk_bf16(b[2], b[3]);
    return __builtin_bit_cast(bf16x8, w);
}
__device__ __forceinline__ void chunk_of(int cgi, int& seq, int& c) { if (cgi < 258) { seq = cgi / 129; c = cgi % 129; } else { seq = 2 + (cgi - 258); c = 0; } }
__device__ __forceinline__ int cgi_of(int seq, int c) { return seq < 2 ? seq * 129 + c : 258 + (seq - 2); }
struct XTile { bf16_t* p; int stride; };
__device__ __forceinline__ XTile ssd_xtile(const Frame& F, int seq, int c, int head) {
    XTile t;
    if (seq < 2) { t.p = F.proj + (size_t)(seq * TPP + 64 * c) * LDP + 2048 + head * 64; t.stride = LDP; }
    else { t.p = (bf16_t*)((unsigned char*)F.out + SC_XS) + (size_t)((seq - 2) * 32 + head) * 4096; t.stride = 64; }
    return t;
}

template <bool DRY>
__device__ void phase_ssd_prep(const Frame& F0, int j) {
    const Frame F = relaunder(F0);
    bf16_t* Bs = (bf16_t*)F.lds;
    bf16_t* Cs = Bs + 64 * 136;
    unsigned char* sc = (unsigned char*)F.out;
    const float* conv_w = F.inp(9) + (size_t)j * 4 * SSD_CONV; const float* conv_b = F.inp(10) + (size_t)j * SSD_CONV;
    const int i16 = F.lane & 15, g4 = F.lane >> 4;
    for (int task = F.bid; task < NCHT * 4; task += F.G) {
        const int cgi = task >> 2, grp = task & 3; int seq, c; chunk_of(cgi, seq, c);
        const int base = seq_base(seq), t0 = 64 * c - PADF;
        __syncthreads();
        {
            const int hl = F.tid >> 6, p = F.tid & 63, head = grp * 8 + hl, cidx = head * 64 + p;
            const float w0 = conv_w[cidx], w1 = conv_w[SSD_CONV + cidx], w2 = conv_w[2 * SSD_CONV + cidx], w3 = conv_w[3 * SSD_CONV + cidx], cb = conv_b[cidx];
            float r3 = 0.f, r2 = 0.f, r1 = 0.f;
            if (seq < 2 && c > 0) { const bf16_t* tp = F.tails + (size_t)(cgi - 1) * 3 * 4096 + cidx; r3 = bf2f(tp[0]); r2 = bf2f(tp[4096]); r1 = bf2f(tp[2 * 4096]); }
            else if (seq >= 2) { const float* cst = F.inp(3) + (((size_t)j * 8 + (seq - 2)) * 3) * SSD_CONV + cidx; r3 = cst[0]; r2 = cst[SSD_CONV]; r1 = cst[2 * SSD_CONV]; }
            const bf16_t* xcol = F.proj + 2048 + cidx;
            bf16_t* xrow = (bf16_t*)F.lds + F.tid * 72;
#pragma unroll 1
            for (int s8 = 0; s8 < 8; ++s8) {
                float o[8];
#pragma unroll
                for (int h = 0; h < 8; ++h) {
                    const int t = t0 + 8 * s8 + h;
                    const float v = (t >= 0) ? bf2f(xcol[(size_t)(base + (t > 0 ? t : 0)) * LDP]) : 0.f;
                    o[h] = silu_f(cb + w0 * r3 + w1 * r2 + w2 * r1 + w3 * v);
                    if (t >= 0) { r3 = r2; r2 = r1; r1 = v; }
                }
                u32x4 w; w.x = cvt_pk_bf16(o[0], o[1]); w.y = cvt_pk_bf16(o[2], o[3]); w.z = cvt_pk_bf16(o[4], o[5]); w.w = cvt_pk_bf16(o[6], o[7]);
                *(u32x4*)(xrow + 8 * s8) = w;
            }
            __syncthreads();
            const XTile xt = ssd_xtile(F, seq, c, head);
#pragma unroll
            for (int q = 0; q < 8; ++q) { const u32x4 w = *(const u32x4*)(xrow + 8 * q);
                if (!DRY) *(u32x4*)(xt.p + (size_t)p * xt.stride + 8 * q) = w; else KEEP(w); }
        }
        __syncthreads();
        {
            const int ch = F.tid & 255, half = F.tid >> 8, isC = ch >> 7, n = ch & 127;
            const int cidx = 2048 + isC * 512 + grp * 128 + n;
            const float w0 = conv_w[cidx], w1 = conv_w[SSD_CONV + cidx], w2 = conv_w[2 * SSD_CONV + cidx], w3 = conv_w[3 * SSD_CONV + cidx], cb = conv_b[cidx];
            const float* cst = (seq >= 2) ? F.inp(3) + (((size_t)j * 8 + (seq - 2)) * 3) * SSD_CONV : nullptr;
            bf16_t* dst = (isC ? Cs : Bs) + n;
            float r3, r2, r1;
            {   float rv[3];
#pragma unroll
                for (int q = 0; q < 3; ++q) { const int t = t0 + half * 32 - 3 + q; float v = 0.f;
                    if (t >= 0) v = bf2f(F.proj[(size_t)(base + t) * LDP + 2048 + cidx]); else if (t >= -3 && cst) v = cst[(3 + t) * SSD_CONV + cidx];
                    rv[q] = v; }
                r3 = rv[0]; r2 = rv[1]; r1 = rv[2]; }
            for (int ii = 0; ii < 32; ++ii) {
                const int p = half * 32 + ii, t = t0 + p; float v = 0.f;
                if (t >= 0) v = bf2f(F.proj[(size_t)(base + t) * LDP + 2048 + cidx]); else if (t >= -3 && cst) v = cst[(3 + t) * SSD_CONV + cidx];
                const float o = silu_f(cb + w0 * r3 + w1 * r2 + w2 * r1 + w3 * v);
                r3 = r2; r2 = r1; r1 = v;
                dst[p * 136] = f2bf(o);
            }
        }
        __syncthreads();
        {
            bf16_t* BT = (bf16_t*)(sc + SC_BT) + (size_t)(cgi * 4 + grp) * 8192;
            const int n = F.tid >> 2, qg = (F.tid & 3) * 16;
#pragma unroll
            for (int u = 0; u < 2; ++u) {
                const int q0 = qg + 8 * u; unsigned short e[8];
#pragma unroll
                for (int jj = 0; jj < 8; ++jj) e[jj] = Bs[qnat(q0 + jj) * 136 + n];
                u32x4 w; w.x = e[0] | ((unsigned)e[1] << 16); w.y = e[2] | ((unsigned)e[3] << 16); w.z = e[4] | ((unsigned)e[5] << 16); w.w = e[6] | ((unsigned)e[7] << 16);
                if (!DRY) *(u32x4*)(BT + n * 64 + q0) = w; else KEEP(w);
            }
            bf16_t* Cg = (bf16_t*)(sc + SC_C) + (size_t)(cgi * 4 + grp) * 8192;
#pragma unroll
            for (int u = 0; u < 2; ++u) {
                const int idx = F.tid + 512 * u, l = idx >> 4, qg8 = idx & 15, kk = qg8 >> 2, gg = qg8 & 3;
                const u32x2 a = *(const u32x2*)(Cs + l * 136 + 32 * kk + 4 * gg), b = *(const u32x2*)(Cs + l * 136 + 32 * kk + 16 + 4 * gg);
                u32x4 w; w.x = a.x; w.y = a.y; w.z = b.x; w.w = b.y;
                if (!DRY) *(u32x4*)(Cg + l * 128 + 8 * qg8) = w; else KEEP(w);
            }
        }
        {
            bf16_t* CB = (bf16_t*)(sc + SC_CB) + (size_t)(cgi * 4 + grp) * 4096;
            const int m = F.wave >> 1;
#pragma unroll
            for (int u = 0; u < 2; ++u) {
                const int st = 2 * (F.wave & 1) + u; f32x4 acc = (f32x4){0.f, 0.f, 0.f, 0.f};
#pragma unroll
                for (int kk = 0; kk < 4; ++kk) {
                    const bf16x8 a = *(const bf16x8*)(Cs + (16 * m + i16) * 136 + 32 * kk + 8 * g4);
                    const bf16x8 b = *(const bf16x8*)(Bs + (16 * st + i16) * 136 + 32 * kk + 8 * g4);
                    acc = __builtin_amdgcn_mfma_f32_16x16x32_bf16(a, b, acc, 0, 0, 0);
                }
                const int qs = qperm(16 * st + i16);
#pragma unroll
                for (int jj = 0; jj < 4; ++jj) { if (!DRY) CB[(16 * m + 4 * g4 + jj) * 64 + qs] = f2bf(acc[jj]); else KEEP(acc[jj]); }
            }
        }
        {
            const int head = grp * 8 + F.wave, t = t0 + F.lane;
            const float a = -__expf(F.inp(12)[j * SSD_HEADS + head]);
            float dt = 0.f;
            if (t >= 0) dt = softplus_f(F.dtb[(size_t)(base + t) * 32 + head] + F.inp(11)[j * SSD_HEADS + head]);
            float cs = dt * a;
#pragma unroll
            for (int o = 1; o < 64; o <<= 1) { const float y = __shfl_up(cs, o); if (F.lane >= o) cs += y; }
            const float cs_last = __shfl(cs, 63), cs_be = __shfl(cs, F.lane | 3);
            float* vp = (float*)(sc + SC_VEC) + (size_t)(cgi * 32 + head) * 256;
            const float v1 = __expf(cs_be - cs) * dt, v2 = dt * __expf(cs_last - cs), v3 = __expf(cs);
            if (!DRY) { vp[F.lane] = cs; vp[64 + F.lane] = v1; vp[128 + F.lane] = v2; vp[192 + F.lane] = v3; } else { KEEP(v1); KEEP(v2); KEEP(v3); }
        }
    }
}

constexpr int SL_C = 0, SL_BT = 16384, SL_M = 32768, SL_XT = 40960, SL_VEC = 49152, SL_SIZE = 50176;
#define PD(d) P[11 + ((d) >> 2)][(d) & 3]
__device__ __forceinline__ void ssd_stage_load(u32x4 (&P)[15], const Frame& F, const unsigned char* sc, int lt, int seq, int head, int c) {
    const int cgi = cgi_of(seq, c), grp = head >> 3;
    const bf16_t* Cp = (const bf16_t*)(sc + SC_C) + (size_t)(cgi * 4 + grp) * 8192;
    const bf16_t* BTp = (const bf16_t*)(sc + SC_BT) + (size_t)(cgi * 4 + grp) * 8192;
    const bf16_t* CBp = (const bf16_t*)(sc + SC_CB) + (size_t)(cgi * 4 + grp) * 4096;
    const float* vp = (const float*)(sc + SC_VEC) + (size_t)(cgi * 32 + head) * 256;
    const XTile xt = ssd_xtile(F, seq, c, head);
#pragma unroll
    for (int r = 0; r < 4; ++r) { const int k = lt + 256 * r; P[r] = *(const u32x4*)(Cp + k * 8); P[4 + r] = *(const u32x4*)(BTp + k * 8); }
#pragma unroll
    for (int r = 0; r < 2; ++r) { const int k = lt + 256 * r, l = k >> 3, ch = k & 7, sa = 32 * (ch >> 2) + 4 * (ch & 3);
        P[8 + r] = *(const u32x4*)(CBp + k * 8); PD(3 * r) = __float_as_uint(vp[l]); PD(3 * r + 1) = __float_as_uint(vp[sa + 3]); PD(3 * r + 2) = __float_as_uint(vp[sa + 19]);
        P[13 + r] = *(const u32x4*)(xt.p + (size_t)l * xt.stride + ch * 8); }
    P[10] = *(const u32x4*)(vp + 64 + 4 * (lt < 48 ? lt : 0));
}
__device__ __forceinline__ void ssd_stage_write(const u32x4 (&P)[15], unsigned char* img, int lt) {
#pragma unroll
    for (int r = 0; r < 4; ++r) { const int k = lt + 256 * r;
        { const int row = k >> 4, ch = k & 15; *(u32x4*)(img + SL_C + (row * 16 + (ch ^ (row & 15))) * 16) = P[r]; }
        { const int row = k >> 3, ch = k & 7; *(u32x4*)(img + SL_BT + (row * 8 + (ch ^ ((row >> 1) & 7))) * 16) = P[4 + r]; } }
#pragma unroll
    for (int r = 0; r < 2; ++r) {
        const int k = lt + 256 * r, l = k >> 3, ch = k & 7, sa = 32 * (ch >> 2) + 4 * (ch & 3), sb = sa + 16;
        const float csl = __uint_as_float(PD(3 * r)), e1a = __expf(csl - __uint_as_float(PD(3 * r + 1))), e1b = __expf(csl - __uint_as_float(PD(3 * r + 2)));
        const u32x4 cbw = P[8 + r]; f32x4 va, vb;
        va[0] = (sa + 0 <= l) ? __uint_as_float(cbw.x << 16) * e1a : 0.f; va[1] = (sa + 1 <= l) ? __uint_as_float(cbw.x & 0xffff0000u) * e1a : 0.f;
        va[2] = (sa + 2 <= l) ? __uint_as_float(cbw.y << 16) * e1a : 0.f; va[3] = (sa + 3 <= l) ? __uint_as_float(cbw.y & 0xffff0000u) * e1a : 0.f;
        vb[0] = (sb + 0 <= l) ? __uint_as_float(cbw.z << 16) * e1b : 0.f; vb[1] = (sb + 1 <= l) ? __uint_as_float(cbw.z & 0xffff0000u) * e1b : 0.f;
        vb[2] = (sb + 2 <= l) ? __uint_as_float(cbw.w << 16) * e1b : 0.f; vb[3] = (sb + 3 <= l) ? __uint_as_float(cbw.w & 0xffff0000u) * e1b : 0.f;
        u32x4 w; w.x = cvt_pk_bf16(va[0], va[1]); w.y = cvt_pk_bf16(va[2], va[3]); w.z = cvt_pk_bf16(vb[0], vb[1]); w.w = cvt_pk_bf16(vb[2], vb[3]);
        const int slot = l * 8 + (ch ^ ((l >> 1) & 7));
        *(u32x4*)(img + SL_M + slot * 16) = w;
        *(u32x4*)(img + SL_XT + slot * 16) = P[13 + r];
    }
    if (lt < 48) *(u32x4*)(img + SL_VEC + 16 * lt) = P[10];
}
template <bool DRY>
__device__ __forceinline__ void ssd_ytile_out(const unsigned char* img, const XTile& xt, int lt) {
#pragma unroll
    for (int r = 0; r < 2; ++r) { const int k = lt + 256 * r, p = k >> 3, ch = k & 7;
        const u32x4 w = *(const u32x4*)(img + SL_XT + (p * 8 + (ch ^ ((p >> 1) & 7))) * 16);
        if (!DRY) *(u32x4*)(xt.p + (size_t)p * xt.stride + ch * 8) = w; else KEEP(w); }
}
template <bool DRY>
__device__ void phase_ssd_chain(const Frame& F0, int j) {
    const Frame F = relaunder(F0);
    const unsigned char* sc = (const unsigned char*)F.out;
    const bool loader = F.wave >= 4; const int lt = F.tid - 256, ps = F.wave & 3;
    for (int sh = F.bid; sh < 320; sh += F.G) {
        const int seq = sh < 64 ? (sh >> 5) : 2 + ((sh - 64) >> 5), head = sh & 31;
        const int nch = seq_chunks(seq);
        const float dsk = F.inp(13)[j * SSD_HEADS + head];
        u32x4 P[15];
#pragma unroll
        for (int q = 0; q < 15; ++q) P[q] = (u32x4){0u, 0u, 0u, 0u};
        if (!loader && seq >= 2) {
            const int i = F.lane & 15, g = F.lane >> 4;
            const float* st = F.inp(2) + ((((size_t)j * 8 + (seq - 2)) * SSD_HEADS + head) * SSD_P + ps * 16 + i) * SSD_N + 4 * g;
#pragma unroll
            for (int m8 = 0; m8 < 8; ++m8) P[m8] = *(const u32x4*)(st + 16 * m8);
        }
        __syncthreads();
        if (loader) { ssd_stage_load(P, F, sc, lt, seq, head, 0); ssd_stage_write(P, F.lds, lt); if (nch > 1) ssd_stage_load(P, F, sc, lt, seq, head, 1); }
        __syncthreads();
        for (int c = 0; c < nch; ++c) {
            int cur = (c & 1) * SL_SIZE, nxt = ((c + 1) & 1) * SL_SIZE, lane_ = F.lane, lt_ = lt;
            asm volatile("" : "+s"(cur), "+s"(nxt), "+v"(lane_), "+v"(lt_));
            unsigned char* img = F.lds + cur;
            if (loader) {
                if (c > 0) ssd_ytile_out<DRY>(F.lds + nxt, ssd_xtile(F, seq, c - 1, head), lt_);
                if (c + 1 < nch) ssd_stage_write(P, F.lds + nxt, lt_);
                if (c + 2 < nch) ssd_stage_load(P, F, sc, lt_, seq, head, c + 2);
            } else {
                const int i = lane_ & 15, g = lane_ >> 4, prow = ps * 16 + i, psw = (prow >> 1) & 7;
                const unsigned char* pc[4]; const unsigned char* pm[2];
#pragma unroll
                for (int kk = 0; kk < 4; ++kk) pc[kk] = img + SL_C + i * 256 + (((4 * kk + g) ^ i) * 16);
#pragma unroll
                for (int k2 = 0; k2 < 2; ++k2) pm[k2] = img + i * 128 + (((4 * k2 + g) ^ (i >> 1)) * 16);
                f32x4 e24[4], w4[4], ecs4[4];
#pragma unroll
                for (int m = 0; m < 4; ++m) { e24[m] = *(const f32x4*)(img + SL_VEC + (16 * m + 4 * g) * 4); w4[m] = *(const f32x4*)(img + SL_VEC + 256 + (16 * m + 4 * g) * 4); ecs4[m] = *(const f32x4*)(img + SL_VEC + 512 + (16 * m + 4 * g) * 4); }
                const float ecl = *(const float*)(img + SL_VEC + 512 + 63 * 4);
                bf16x8 Hf[4];
#pragma unroll
                for (int kk = 0; kk < 4; ++kk) Hf[kk] = pack8(__builtin_bit_cast(f32x4, P[2 * kk]), __builtin_bit_cast(f32x4, P[2 * kk + 1]));
                f32x4 Y[4];
#pragma unroll
                for (int m = 0; m < 4; ++m) {
                    f32x4 acc = (f32x4){0.f, 0.f, 0.f, 0.f};
#pragma unroll
                    for (int kk = 0; kk < 4; ++kk) { const bf16x8 cf = *(const bf16x8*)(pc[kk] + m * 4096); acc = __builtin_amdgcn_mfma_f32_16x16x32_bf16(cf, Hf[kk], acc, 0, 0, 0); }
                    Y[m] = acc * ecs4[m];
                }
                f32x4 xv[4];
                unsigned char* xrow = img + SL_XT + prow * 128 + 8 * (g & 1);
#pragma unroll
                for (int m = 0; m < 4; ++m) {
                    const u32x2 xw = *(const u32x2*)(xrow + ((2 * m + (g >> 1)) ^ psw) * 16);
                    xv[m][0] = __uint_as_float(xw.x << 16); xv[m][1] = __uint_as_float(xw.x & 0xffff0000u); xv[m][2] = __uint_as_float(xw.y << 16); xv[m][3] = __uint_as_float(xw.y & 0xffff0000u);
                }
                bf16x8 xsf[2], xwf[2];
#pragma unroll
                for (int k2 = 0; k2 < 2; ++k2) { xsf[k2] = pack8(xv[2 * k2] * e24[2 * k2], xv[2 * k2 + 1] * e24[2 * k2 + 1]); xwf[k2] = pack8(xv[2 * k2] * w4[2 * k2], xv[2 * k2 + 1] * w4[2 * k2 + 1]); }
#pragma unroll
                for (int m = 0; m < 4; ++m)
#pragma unroll
                    for (int k2 = 0; k2 < 2; ++k2) { const bf16x8 mf = *(const bf16x8*)(pm[k2] + SL_M + m * 2048); Y[m] = __builtin_amdgcn_mfma_f32_16x16x32_bf16(mf, xsf[k2], Y[m], 0, 0, 0); }
#pragma unroll
                for (int m8 = 0; m8 < 8; ++m8) {
                    f32x4 acc = __builtin_bit_cast(f32x4, P[m8]) * ecl;
#pragma unroll
                    for (int k2 = 0; k2 < 2; ++k2) { const bf16x8 bf = *(const bf16x8*)(pm[k2] + SL_BT + m8 * 2048); acc = __builtin_amdgcn_mfma_f32_16x16x32_bf16(bf, xwf[k2], acc, 0, 0, 0); }
                    P[m8] = __builtin_bit_cast(u32x4, acc);
                }
#pragma unroll
                for (int m = 0; m < 4; ++m) {
                    const f32x4 y = Y[m] + xv[m] * dsk; u32x2 w; w.x = cvt_pk_bf16(y[0], y[1]); w.y = cvt_pk_bf16(y[2], y[3]);
                    *(u32x2*)(xrow + ((2 * m + (g >> 1)) ^ psw) * 16) = w;
                }
            }
            __syncthreads();
        }
        if (loader) ssd_ytile_out<DRY>(F.lds + ((nch - 1) & 1) * SL_SIZE, ssd_xtile(F, seq, nch - 1, head), lt);
        else {
            const int i = F.lane & 15, g = F.lane >> 4;
            float* so = (seq < 2) ? F.out + O_PSSD + ((((size_t)j * 2 + seq) * SSD_HEADS + head) * SSD_P + ps * 16 + i) * SSD_N + 4 * g
                                  : F.out + O_SSSD + ((((size_t)j * 8 + (seq - 2)) * SSD_HEADS + head) * SSD_P + ps * 16 + i) * SSD_N + 4 * g;
#pragma unroll
            for (int m8 = 0; m8 < 8; ++m8) { if (!DRY) *(u32x4*)(so + 16 * m8) = P[m8]; else KEEP(P[m8]); }
        }
    }
}

__device__ void phase_ssd_post(const Frame& F0, int j) {
    const Frame F = relaunder(F0);
    constexpr int RS = 68;
    bf16_t* YT = (bf16_t*)F.lds;
    for (int task = F.bid; task < NCHT * 4; task += F.G) {
        const int cgi = task >> 2, grp = task & 3; int seq, c; chunk_of(cgi, seq, c);
        const int base = seq_base(seq), t0 = 64 * c - PADF;
        __syncthreads();
#pragma unroll
        for (int r = 0; r < 8; ++r) {
            const int k = F.tid + 512 * r, hl = k >> 9, p = (k >> 3) & 63, ch = k & 7;
            const XTile xt = ssd_xtile(F, seq, c, grp * 8 + hl);
            const u32x4 w = *(const u32x4*)(xt.p + (size_t)p * xt.stride + ch * 8);
            u32x2* d = (u32x2*)(YT + (hl * 64 + p) * RS + ch * 8); u32x2 a, b; a.x = w.x; a.y = w.y; b.x = w.z; b.y = w.w; d[0] = a; d[1] = b;
        }
        __syncthreads();
        for (int q = 0; q < 8; ++q) {
            const int l = F.wave + 8 * q, t = t0 + l;
            if (t < 0 && seq >= 2) continue;
            const int row = seq < 2 ? seq * TPP + 64 * c + l : base + t;
            bf16_t* zrow = F.proj + (size_t)row * LDP + grp * 512 + F.lane;
            float yg[8]; float ss = 0.f;
#pragma unroll
            for (int e = 0; e < 8; ++e) { const float y = bf2f(YT[(e * 64 + F.lane) * RS + l]), z = bf2f(zrow[64 * e]); yg[e] = y * silu_f(z); ss += yg[e] * yg[e]; }
            ss = wave_sum(ss);
            const float rs = rsqrtf(ss * (1.0f / 512.0f) + EPS);
#pragma unroll
            for (int e = 0; e < 8; ++e) zrow[64 * e] = f2bf(yg[e] * rs);
        }
    }
    for (int e = F.bid * NTHREADS + F.tid; e < NSEQ * 3 * SSD_CONV; e += F.G * NTHREADS) {
        const int s = e / (3 * SSD_CONV), r = (e / SSD_CONV) % 3, c = e % SSD_CONV;
        const int row = seq_base(s) + seq_len(s) - 3 + r;
        float v;
        if (s < 2 && c < 2048) v = bf2f(F.tails[((size_t)(s * 129 + 128) * 3 + r) * 4096 + c]);
        else v = bf2f(F.proj[(size_t)row * LDP + 2048 + c]);
        if (s < 2) F.out[O_PSSDC + (((size_t)j * 2 + s) * 3 + r) * SSD_CONV + c] = v;
        else F.out[O_SSSDC + (((size_t)j * 8 + (s - 2)) * 3 + r) * SSD_CONV + c] = v;
    }
}

constexpr size_t SG_W = 0;
constexpr size_t SG_QK = SG_W + (size_t)NCHT * 8 * 16384;
constexpr size_t SG_VEC = SG_QK + (size_t)NCHT * 8 * 8192;
constexpr size_t SG_PART = SG_VEC + (size_t)NCHT * 8 * 1024;
constexpr size_t SG_SIDE = SG_PART + (size_t)M_TOT * 128 * 2;
constexpr size_t SG_END = SG_SIDE + (size_t)64 * 65536;
static_assert(SG_END <= (size_t)16777216 * 4, "scratch must fit the y_prompt region");
struct GTile { bf16_t* q; bf16_t* k; bf16_t* v; int sq, sk, sv; };
__device__ __forceinline__ GTile gdn_tile(const Frame& F, int seq, int c, int head) {
    GTile t;
    if (seq < 2) { bf16_t* r0 = F.proj + (size_t)(seq * TPP + 64 * c) * LDP; t.q = r0 + head * 128; t.k = r0 + 1024 + head * 128; t.v = r0 + 2048 + head * 256; t.sq = LDP; t.sk = LDP; t.sv = LDP; }
    else { bf16_t* b = (bf16_t*)((unsigned char*)F.out + SG_SIDE) + (size_t)((seq - 2) * 8 + head) * 32768; t.q = b; t.k = b + 8192; t.v = b + 16384; t.sq = 128; t.sk = 128; t.sv = 256; }
    return t;
}

template <bool DRY>
__device__ void phase_gdn_prep(const Frame& F0, int j) {
    const Frame F = relaunder(F0);
    float* Am = (float*)F.lds;
    float* vgc = Am + 64 * 68;
    float* vbe = vgc + 64;
    float* vnq = vbe + 64;
    float* vnk = vnq + 64;
    bf16_t* qs = (bf16_t*)(vnk + 64);
    bf16_t* ks = qs + 64 * 136;
    bf16_t* kT = ks + 64 * 136;
    bf16_t* vT = kT + 128 * 72;
    bf16_t* Tb = vT + 256 * 72;
    unsigned char* sc = (unsigned char*)F.out;
    const float* conv_w = F.inp(18) + (size_t)j * 4 * GDN_CONV;
    const int i16 = F.lane & 15, g4 = F.lane >> 4;
    constexpr float CQ = 0.08838834764831845f;
    for (int task = F.bid; task < NCHT * 8; task += F.G) {
        const int cgi = task >> 3, head = task & 7; int seq, c; chunk_of(cgi, seq, c);
        const int base = seq_base(seq), t0 = 64 * c - PADF;
        const GTile tl = gdn_tile(F, seq, c, head);
        __syncthreads();
        if (F.wave == 0) {
            const int t = t0 + F.lane; float gg = 0.f, be = 0.f;
            if (t >= 0) { const float* dp = F.dtb + (size_t)(base + t) * 32; gg = -__expf(F.inp(20)[j * GDN_HEADS + head]) * softplus_f(dp[head] + F.inp(19)[j * GDN_HEADS + head]); be = 1.0f / (1.0f + __expf(-dp[8 + head])); }
#pragma unroll
            for (int o = 1; o < 64; o <<= 1) { const float y = __shfl_up(gg, o); if (F.lane >= o) gg += y; }
            vgc[F.lane] = gg; vbe[F.lane] = be;
        }
        __syncthreads();
        {
            const int ch = F.tid;
            const int cidx = ch < 128 ? head * 128 + ch : (ch < 256 ? 1024 + head * 128 + (ch - 128) : 2048 + head * 256 + (ch - 256));
            const float w0 = conv_w[cidx], w1 = conv_w[GDN_CONV + cidx], w2 = conv_w[2 * GDN_CONV + cidx], w3 = conv_w[3 * GDN_CONV + cidx];
            const float* cst = (seq >= 2) ? F.inp(5) + (((size_t)j * 8 + (seq - 2)) * 3) * GDN_CONV + cidx : nullptr;
            const bf16_t* tailp = (seq < 2 && c > 0) ? F.tails + (size_t)(cgi - 1) * 3 * 4096 + cidx : nullptr;
            float r3 = 0.f, r2 = 0.f, r1 = 0.f;
            if (tailp) { r3 = bf2f(tailp[0]); r2 = bf2f(tailp[4096]); r1 = bf2f(tailp[2 * 4096]); }
            for (int p = 0; p < 64; ++p) {
                const int t = t0 + p; float x = 0.f;
                if (t >= 0) x = bf2f(F.proj[(size_t)(base + t) * LDP + cidx]); else if (t >= -3 && cst) x = cst[(3 + t) * GDN_CONV];
                const float o = silu_f(w0 * r3 + w1 * r2 + w2 * r1 + w3 * x);
                r3 = r2; r2 = r1; r1 = x;
                if (ch < 128) qs[p * 136 + ch] = f2bf(o);
                else if (ch < 256) { const bf16_t b = f2bf(o); ks[p * 136 + (ch - 128)] = b; kT[(ch - 128) * 72 + p] = b; }
                else vT[(ch - 256) * 72 + p] = f2bf(o * vbe[p]);
            }
        }
        __syncthreads();
        if (F.tid < 128) {
            const int l = F.tid & 63; const bf16_t* rowp = (F.tid < 64 ? qs : ks) + l * 136; float ss = 0.f;
#pragma unroll
            for (int q = 0; q < 16; ++q) { const u32x4 v = *(const u32x4*)(rowp + 8 * q);
                const float a0 = __uint_as_float(v.x << 16), a1 = __uint_as_float(v.x & 0xffff0000u), a2 = __uint_as_float(v.y << 16), a3 = __uint_as_float(v.y & 0xffff0000u);
                const float a4 = __uint_as_float(v.z << 16), a5 = __uint_as_float(v.z & 0xffff0000u), a6 = __uint_as_float(v.w << 16), a7 = __uint_as_float(v.w & 0xffff0000u);
                ss += ((a0 * a0 + a1 * a1) + (a2 * a2 + a3 * a3)) + ((a4 * a4 + a5 * a5) + (a6 * a6 + a7 * a7)); }
            (F.tid < 64 ? vnq : vnk)[l] = rsqrtf(ss + EPS);
        }
        __syncthreads();
        {
            bf16_t* QKg = (bf16_t*)(sc + SG_QK) + (size_t)task * 4096;
            const int m = F.wave >> 1;
#pragma unroll
            for (int u = 0; u < 2; ++u) {
                const int st = 2 * (F.wave & 1) + u; f32x4 aK = (f32x4){0.f, 0.f, 0.f, 0.f}, aQ = (f32x4){0.f, 0.f, 0.f, 0.f};
#pragma unroll
                for (int kk = 0; kk < 4; ++kk) {
                    const bf16x8 ak = *(const bf16x8*)(ks + (16 * m + i16) * 136 + 32 * kk + 8 * g4);
                    const bf16x8 aq = *(const bf16x8*)(qs + (16 * m + i16) * 136 + 32 * kk + 8 * g4);
                    const bf16x8 b = *(const bf16x8*)(ks + (16 * st + i16) * 136 + 32 * kk + 8 * g4);
                    aK = __builtin_amdgcn_mfma_f32_16x16x32_bf16(ak, b, aK, 0, 0, 0);
                    aQ = __builtin_amdgcn_mfma_f32_16x16x32_bf16(aq, b, aQ, 0, 0, 0);
                }
                const int s_ = 16 * st + i16; const float gs = vgc[s_], nks = vnk[s_]; const int qs_ = qperm(s_);
#pragma unroll
                for (int jj = 0; jj < 4; ++jj) {
                    const int l = 16 * m + 4 * g4 + jj;
                    const float dec = (s_ <= l) ? __expf(vgc[l] - gs) : 0.f;
                    Am[l * 68 + s_] = (s_ < l) ? vbe[l] * vnk[l] * nks * aK[jj] * dec : 0.f;
                    { const float r = CQ * vnq[l] * nks * aQ[jj] * dec; if (!DRY) QKg[l * 64 + qs_] = f2bf(r); else KEEP(r); }
                }
            }
        }
        __syncthreads();
        if (F.wave == 0) {
            int cc = F.lane; asm volatile("" : "+v"(cc));
            float x[64];
#pragma unroll
            for (int l = 0; l < 64; ++l) {
                float a0 = (l == cc) ? 1.f : 0.f, a1 = 0.f, a2 = 0.f, a3 = 0.f;
#pragma unroll
                for (int s4 = 0; s4 + 4 <= l; s4 += 4) { const f32x4 av = *(const f32x4*)(Am + l * 68 + s4); a0 -= av[0] * x[s4]; a1 -= av[1] * x[s4 + 1]; a2 -= av[2] * x[s4 + 2]; a3 -= av[3] * x[s4 + 3]; }
                if (l & 3) { const f32x4 av = *(const f32x4*)(Am + l * 68 + (l & ~3));
                    a0 -= av[0] * x[l & ~3]; if ((l & 3) > 1) a1 -= av[1] * x[(l & ~3) + 1]; if ((l & 3) > 2) a2 -= av[2] * x[(l & ~3) + 2]; }
                x[l] = (a0 + a1) + (a2 + a3);
            }
            const float csc = vbe[cc] * __expf(vgc[cc]) * vnk[cc];
#pragma unroll
            for (int l = 0; l < 64; ++l) { Tb[l * 72 + cc] = f2bf(x[l]); Tb[64 * 72 + l * 72 + cc] = f2bf(x[l] * csc); }
        } else {
            const int t7 = F.tid - 64;
            for (int idx = t7; idx < 1024; idx += 448) {
                const int l = idx >> 4, qg8 = idx & 15, kk = qg8 >> 2, gg = qg8 & 3;
                const u32x2 a = *(const u32x2*)(qs + l * 136 + 32 * kk + 4 * gg), b = *(const u32x2*)(qs + l * 136 + 32 * kk + 16 + 4 * gg);
                u32x4 w; w.x = a.x; w.y = a.y; w.z = b.x; w.w = b.y;
                if (!DRY) *(u32x4*)(tl.q + (size_t)l * tl.sq + 8 * qg8) = w; else KEEP(w);
            }
            for (int idx = t7; idx < 1024; idx += 448) {
                const int kd = idx >> 3, pg = idx & 7, kk2 = pg >> 2, gg = pg & 3;
                const u32x2 a = *(const u32x2*)(kT + kd * 72 + 32 * kk2 + 4 * gg), b = *(const u32x2*)(kT + kd * 72 + 32 * kk2 + 16 + 4 * gg);
                u32x4 w; w.x = a.x; w.y = a.y; w.z = b.x; w.w = b.y;
                if (!DRY) *(u32x4*)(tl.k + (size_t)(kd >> 1) * tl.sk + (kd & 1) * 64 + 8 * pg) = w; else KEEP(w);
            }
            if (t7 < 64) {
                float* vp = (float*)(sc + SG_VEC) + (size_t)task * 256; const float gl = vgc[63];
                const float v0 = __expf(vgc[t7]) * CQ * vnq[t7], v1 = vnk[t7] * __expf(gl - vgc[t7]), v2 = __expf(gl);
                if (!DRY) { vp[t7] = v0; vp[64 + t7] = v1; vp[128 + t7] = v2; vp[192 + t7] = 0.f; } else { KEEP(v0); KEEP(v1); KEEP(v2); }
            }
        }
        __syncthreads();
        {
            bf16_t* Wg = (bf16_t*)(sc + SG_W) + (size_t)task * 8192;
            bf16x8 bk[2];
#pragma unroll
            for (int k2 = 0; k2 < 2; ++k2) bk[k2] = *(const bf16x8*)(kT + (16 * F.wave + i16) * 72 + 32 * k2 + 8 * g4);
            const int qkd = qperm(16 * F.wave + i16);
#pragma unroll
            for (int m = 0; m < 4; ++m) {
                f32x4 acc = (f32x4){0.f, 0.f, 0.f, 0.f};
#pragma unroll
                for (int k2 = 0; k2 < 2; ++k2) { const bf16x8 a = *(const bf16x8*)(Tb + 64 * 72 + (16 * m + i16) * 72 + 32 * k2 + 8 * g4); acc = __builtin_amdgcn_mfma_f32_16x16x32_bf16(a, bk[k2], acc, 0, 0, 0); }
#pragma unroll
                for (int jj = 0; jj < 4; ++jj) { if (!DRY) Wg[(16 * m + 4 * g4 + jj) * 128 + qkd] = f2bf(acc[jj]); else KEEP(acc[jj]); }
            }
#pragma unroll
            for (int u = 0; u < 2; ++u) {
                const int v = 16 * (2 * F.wave + u) + i16;
                bf16x8 bv[2];
#pragma unroll
                for (int k2 = 0; k2 < 2; ++k2) bv[k2] = *(const bf16x8*)(vT + v * 72 + 32 * k2 + 8 * g4);
#pragma unroll
                for (int m = 0; m < 4; ++m) {
                    f32x4 acc = (f32x4){0.f, 0.f, 0.f, 0.f};
#pragma unroll
                    for (int k2 = 0; k2 < 2; ++k2) { const bf16x8 a = *(const bf16x8*)(Tb + (16 * m + i16) * 72 + 32 * k2 + 8 * g4); acc = __builtin_amdgcn_mfma_f32_16x16x32_bf16(a, bv[k2], acc, 0, 0, 0); }
                    u32x2 w; w.x = cvt_pk_bf16(acc[0], acc[1]); w.y = cvt_pk_bf16(acc[2], acc[3]);
                    if (!DRY) *(u32x2*)(tl.v + (size_t)(v >> 2) * tl.sv + (v & 3) * 64 + 16 * m + 4 * g4) = w; else KEEP(w);
                }
            }
        }
    }
}

template <bool DRY>
__device__ void phase_gdn_chain(const Frame& F0, int j) {
    const Frame F = relaunder(F0);
    unsigned char* sc = (unsigned char*)F.out;
    const int i = F.lane & 15, g = F.lane >> 4;
    for (int wt = F.wave * F.G + F.bid; wt < 1280; wt += F.G * 8) {
        const int seq = wt < 256 ? (wt >> 7) : 2 + ((wt - 256) >> 7), head = (wt >> 4) & 7, vs = wt & 15;
        const int base = seq_base(seq), nch = seq_chunks(seq);
        const int vcol = vs * 16 + i;
        f32x4 S[8];
        if (seq < 2) {
#pragma unroll
            for (int m8 = 0; m8 < 8; ++m8) S[m8] = (f32x4){0.f, 0.f, 0.f, 0.f};
        } else {
            const float* st = F.inp(4) + (((size_t)j * 8 + (seq - 2)) * GDN_HEADS + head) * GDN_DK * GDN_DV + vcol;
#pragma unroll
            for (int m8 = 0; m8 < 8; ++m8)
#pragma unroll
                for (int jj = 0; jj < 4; ++jj) S[m8][jj] = st[(size_t)(16 * m8 + 4 * g + jj) * GDN_DV];
        }
        for (int c = 0; c < nch; ++c) {
            const int cgi = cgi_of(seq, c), t0 = 64 * c - PADF, task = cgi * 8 + head;
            const GTile tl = gdn_tile(F, seq, c, head);
            const bf16_t* Wp = (const bf16_t*)(sc + SG_W) + (size_t)task * 8192;
            const bf16_t* QKp = (const bf16_t*)(sc + SG_QK) + (size_t)task * 4096;
            const float* vp = (const float*)(sc + SG_VEC) + (size_t)task * 256;
            f32x4 rsc[4], vsc[4];
#pragma unroll
            for (int m = 0; m < 4; ++m) { rsc[m] = *(const f32x4*)(vp + 16 * m + 4 * g); vsc[m] = *(const f32x4*)(vp + 64 + 16 * m + 4 * g); }
            const float egl = vp[128];
            bf16x8 Sf[4];
#pragma unroll
            for (int kk = 0; kk < 4; ++kk) Sf[kk] = pack8(S[2 * kk], S[2 * kk + 1]);
            f32x4 vn[4], O[4];
#pragma unroll
            for (int m = 0; m < 4; ++m) {
                f32x4 a1 = (f32x4){0.f, 0.f, 0.f, 0.f}, a2 = (f32x4){0.f, 0.f, 0.f, 0.f};
#pragma unroll
                for (int kk = 0; kk < 4; ++kk) {
                    const bf16x8 wf = *(const bf16x8*)(Wp + (16 * m + i) * 128 + 32 * kk + 8 * g);
                    const bf16x8 qf = *(const bf16x8*)(tl.q + (size_t)(16 * m + i) * tl.sq + 32 * kk + 8 * g);
                    a1 = __builtin_amdgcn_mfma_f32_16x16x32_bf16(wf, Sf[kk], a1, 0, 0, 0);
                    a2 = __builtin_amdgcn_mfma_f32_16x16x32_bf16(qf, Sf[kk], a2, 0, 0, 0);
                }
                const u32x2 uw = *(const u32x2*)(tl.v + (size_t)(vcol >> 2) * tl.sv + (vcol & 3) * 64 + 16 * m + 4 * g);
                vn[m][0] = __uint_as_float(uw.x << 16) - a1[0]; vn[m][1] = __uint_as_float(uw.x & 0xffff0000u) - a1[1];
                vn[m][2] = __uint_as_float(uw.y << 16) - a1[2]; vn[m][3] = __uint_as_float(uw.y & 0xffff0000u) - a1[3];
                O[m] = a2 * rsc[m];
            }
            bf16x8 Vf[2], Vsf[2];
#pragma unroll
            for (int k2 = 0; k2 < 2; ++k2) { Vf[k2] = pack8(vn[2 * k2], vn[2 * k2 + 1]); Vsf[k2] = pack8(vn[2 * k2] * vsc[2 * k2], vn[2 * k2 + 1] * vsc[2 * k2 + 1]); }
#pragma unroll
            for (int m = 0; m < 4; ++m)
#pragma unroll
                for (int k2 = 0; k2 < 2; ++k2) { const bf16x8 qk = *(const bf16x8*)(QKp + (16 * m + i) * 64 + 32 * k2 + 8 * g); O[m] = __builtin_amdgcn_mfma_f32_16x16x32_bf16(qk, Vf[k2], O[m], 0, 0, 0); }
#pragma unroll
            for (int m8 = 0; m8 < 8; ++m8) {
                f32x4 acc = S[m8] * egl; const int kd = 16 * m8 + i;
#pragma unroll
                for (int k2 = 0; k2 < 2; ++k2) { const bf16x8 kf = *(const bf16x8*)(tl.k + (size_t)(kd >> 1) * tl.sk + (kd & 1) * 64 + 32 * k2 + 8 * g); acc = __builtin_amdgcn_mfma_f32_16x16x32_bf16(kf, Vsf[k2], acc, 0, 0, 0); }
                S[m8] = acc;
            }
#pragma unroll
            for (int m = 0; m < 4; ++m)
#pragma unroll
                for (int jj = 0; jj < 4; ++jj) {
                    const int t = t0 + 16 * m + 4 * g + jj; const float o = O[m][jj];
                    float ss = o * o; ss += __shfl_xor(ss, 1); ss += __shfl_xor(ss, 2); ss += __shfl_xor(ss, 4); ss += __shfl_xor(ss, 8);
                    if (t >= 0) {
                        const int row = base + t;
                        bf16_t* zp = F.proj + (size_t)row * LDP + 4096 + head * 256 + vcol; const float z = bf2f(*zp); const float r = o * silu_f(z);
                        if (!DRY) { *zp = f2bf(r); if (i == 0) ((bf16_t*)(sc + SG_PART))[(size_t)row * 128 + head * 16 + vs] = f2bf(ss); } else { KEEP(r); KEEP(ss); }
                    }
                }
        }
        float* so = (seq < 2) ? F.out + O_PGDN + (((size_t)j * 2 + seq) * GDN_HEADS + head) * GDN_DK * GDN_DV + vcol
                              : F.out + O_SGDN + (((size_t)j * 8 + (seq - 2)) * GDN_HEADS + head) * GDN_DK * GDN_DV + vcol;
#pragma unroll
        for (int m8 = 0; m8 < 8; ++m8)
#pragma unroll
            for (int jj = 0; jj < 4; ++jj) { if (!DRY) so[(size_t)(16 * m8 + 4 * g + jj) * GDN_DV] = S[m8][jj]; else KEEP(S[m8][jj]); }
    }
}

__device__ void phase_gdn_post2(const Frame& F0, int j) {
    const Frame F = relaunder(F0);
    unsigned char* sc = (unsigned char*)F.out;
    for (int it = F.bid * 8 + F.wave; it < M_TOT * 8; it += F.G * 8) {
        const int row = it >> 3, head = it & 7;
        if (row < ROW_S0 && (row % TPP) < PADF) continue;
        const u32x4* pp = (const u32x4*)((const bf16_t*)(sc + SG_PART) + (size_t)row * 128 + head * 16);
        const u32x4 p0 = pp[0], p1 = pp[1];
        float ss = 0.f;
        ss += __uint_as_float(p0.x << 16) + __uint_as_float(p0.x & 0xffff0000u) + __uint_as_float(p0.y << 16) + __uint_as_float(p0.y & 0xffff0000u);
        ss += __uint_as_float(p0.z << 16) + __uint_as_float(p0.z & 0xffff0000u) + __uint_as_float(p0.w << 16) + __uint_as_float(p0.w & 0xffff0000u);
        ss += __uint_as_float(p1.x << 16) + __uint_as_float(p1.x & 0xffff0000u) + __uint_as_float(p1.y << 16) + __uint_as_float(p1.y & 0xffff0000u);
        ss += __uint_as_float(p1.z << 16) + __uint_as_float(p1.z & 0xffff0000u) + __uint_as_float(p1.w << 16) + __uint_as_float(p1.w & 0xffff0000u);
        const float rs = rsqrtf(ss * (1.0f / 256.0f) + EPS);
        u32x2* zp = (u32x2*)(F.proj + (size_t)row * LDP + 4096 + head * 256 + F.lane * 4);
        const u32x2 z = *zp;
        u32x2 w; w.x = cvt_pk_bf16(__uint_as_float(z.x << 16) * rs, __uint_as_float(z.x & 0xffff0000u) * rs); w.y = cvt_pk_bf16(__uint_as_float(z.y << 16) * rs, __uint_as_float(z.y & 0xffff0000u) * rs);
        *zp = w;
    }
    for (int e = F.bid * NTHREADS + F.tid; e < NSEQ * 3 * GDN_CONV; e += F.G * NTHREADS) {
        const int s = e / (3 * GDN_CONV), r = (e / GDN_CONV) % 3, c = e % GDN_CONV;
        if (s < 2) F.out[O_PGDNC + (((size_t)j * 2 + s) * 3 + r) * GDN_CONV + c] = bf2f(F.tails[((size_t)(s * 129 + 128) * 3 + r) * 4096 + c]);
        else F.out[O_SGDNC + (((size_t)j * 8 + (s - 2)) * 3 + r) * GDN_CONV + c] = bf2f(F.proj[(size_t)(seq_base(s) + 13 + r) * LDP + c]);
    }
}

__device__ void phase_final(const Frame& F0) {
    const Frame F = relaunder(F0);
    const float* fw = F.inp(23);
    for (int it = F.bid * 8 + F.wave; it < 2 * SEQ + 128; it += F.G * 8) {
        int row; float* dst;
        if (it < 2 * SEQ) { const int b = it / SEQ, t = it % SEQ; row = b * TPP + 64 + t; dst = F.out + O_YP + (size_t)it * D; }
        else { row = ROW_S0 + (it - 2 * SEQ); dst = F.out + O_YS + (size_t)(it - 2 * SEQ) * D; }
        float x[16]; float ss = 0.f;
#pragma unroll
        for (int i = 0; i < 4; ++i) {
            const u32x2 v = *(const u32x2*)(F.hb + (size_t)row * D + (F.lane + 64 * i) * 4);
            x[4 * i + 0] = __uint_as_float(v.x << 16); x[4 * i + 1] = __uint_as_float(v.x & 0xffff0000u); x[4 * i + 2] = __uint_as_float(v.y << 16); x[4 * i + 3] = __uint_as_float(v.y & 0xffff0000u);
            ss += (x[4 * i] * x[4 * i] + x[4 * i + 1] * x[4 * i + 1]) + (x[4 * i + 2] * x[4 * i + 2] + x[4 * i + 3] * x[4 * i + 3]);
        }
        ss = wave_sum(ss);
        const float rs = rsqrtf(ss * (1.0f / 1024.0f) + EPS);
#pragma unroll
        for (int i = 0; i < 4; ++i) {
            const int c = (F.lane + 64 * i) * 4; const f32x4 w = *(const f32x4*)(fw + c);
            f32x4 o; o[0] = x[4 * i] * rs * w[0]; o[1] = x[4 * i + 1] * rs * w[1]; o[2] = x[4 * i + 2] * rs * w[2]; o[3] = x[4 * i + 3] * rs * w[3];
            *(f32x4*)(dst + c) = o;
        }
    }
}

constexpr int N_PHASES = 22;
#ifndef REP_INPROJ
#define REP_INPROJ 1
#endif
#ifndef REP_SSD_PREP
#define REP_SSD_PREP 1
#endif
#ifndef REP_SSD_CHAIN
#define REP_SSD_CHAIN 1
#endif
#ifndef REP_GDN_PREP
#define REP_GDN_PREP 1
#endif
#ifndef REP_GDN_CHAIN
#define REP_GDN_CHAIN 1
#endif
#ifndef MK_ONE_LAUNCH
#define MK_ONE_LAUNCH 1
#endif
__global__ void __launch_bounds__(NTHREADS, 2) hybrid_fwd(Args args) {
    extern __shared__ __attribute__((aligned(16))) unsigned char lds[];
    volatile LAS unsigned* bst = (volatile LAS unsigned*)((LAS unsigned char*)lds + LDS_BYTES - 16);
    if (threadIdx.x < 4) bst[threadIdx.x] = 0u;
    __syncthreads();
    XcdBarrier bar; bar.bar = (unsigned*)(args.ws + WS_CTL); bar.x = 0; bar.st = bst;
    if (args.ph_hi - args.ph_lo > 1) bar = xcd_barrier_post((unsigned*)(args.ws + WS_CTL), bst);
    for (int ph = args.ph_lo; ph < args.ph_hi; ++ph) {
        int tid_ = threadIdx.x; asm volatile("" : "+v"(tid_));
        Frame F;
        F.ap = &args;
        F.out = args.out; F.ws = args.ws; F.lds = lds; F.ldsl = (LAS unsigned char*)lds;
        F.tid = tid_; F.lane = F.tid & 63; F.wave = __builtin_amdgcn_readfirstlane(F.tid >> 6); F.G = gridDim.x; F.bid = blockIdx.x;
        F.hb = nullptr; F.win = nullptr; F.wout = nullptr; F.dtb = nullptr; F.rss = nullptr; F.proj = nullptr; F.tails = nullptr;
        if (ph == 0) { phase_init_h(F); phase_wprep_in(F, 0); }
        else if (ph == N_PHASES - 1) phase_final(F);
        else {
            const int L = (ph - 1) / 5, sub = (ph - 1) % 5, j = L >> 1;
            if (sub == 0) { for (int r = 0; r < REP_INPROJ; ++r) phase_inproj(F, L); }
            else if (sub == 1) {
                if (L & 1) { for (int r = 1; r < REP_GDN_PREP; ++r) phase_gdn_prep<true>(F, j); phase_gdn_prep<false>(F, j); }
                else { for (int r = 1; r < REP_SSD_PREP; ++r) phase_ssd_prep<true>(F, j); phase_ssd_prep<false>(F, j); }
                phase_wprep_out(F, L); }
            else if (sub == 2) {
                if (L & 1) { for (int r = 1; r < REP_GDN_CHAIN; ++r) phase_gdn_chain<true>(F, j); phase_gdn_chain<false>(F, j); }
                else { for (int r = 1; r < REP_SSD_CHAIN; ++r) phase_ssd_chain<true>(F, j); phase_ssd_chain<false>(F, j); } }
            else if (sub == 3) { if (L & 1) phase_gdn_post2(F, j); else phase_ssd_post(F, j); if (L < 3) phase_wprep_in(F, L + 1); }
            else phase_outproj(F, L);
        }
        if (ph + 1 < args.ph_hi) {
            if (ph == args.ph_lo) { __threadfence(); cg::this_grid().sync(); }
            else xcd_barrier(bar);
        }
    }
}

extern "C" void kernel_launch(void* const* d_in, const int* in_sizes, int n_in, void* d_out, int out_size, void* d_ws, size_t ws_size, hipStream_t stream) {
    static int grid = 0;
    if (grid == 0) {
        if (n_in != 24 || ws_size < WS_END) { fprintf(stderr, "kernel_launch: unexpected n_in %d / ws %zu (need %zu)\n", n_in, ws_size, (size_t)WS_END); grid = -1; return; }
        int dev = 0, cus = 0, per_cu = 0;
        if (hipGetDevice(&dev) != hipSuccess || hipDeviceGetAttribute(&cus, hipDeviceAttributeMultiprocessorCount, dev) != hipSuccess) { grid = -1; return; }
        if (hipFuncSetAttribute((const void*)hybrid_fwd, hipFuncAttributeMaxDynamicSharedMemorySize, LDS_BYTES) != hipSuccess) { fprintf(stderr, "kernel_launch: hipFuncSetAttribute failed\n"); grid = -1; return; }
        if (hipOccupancyMaxActiveBlocksPerMultiprocessor(&per_cu, (const void*)hybrid_fwd, NTHREADS, LDS_BYTES) != hipSuccess || per_cu < 1) { fprintf(stderr, "kernel_launch: occupancy query says %d blocks per CU\n", per_cu); grid = -1; return; }
        (void)hipGetLastError();
        grid = cus;
    }
    if (grid < 0) return;
    Args a{};
    for (int i = 0; i < 24; ++i) a.in[i] = (const float*)d_in[i];
    a.out = (float*)d_out; a.ws = (unsigned char*)d_ws;
#if MK_ONE_LAUNCH
    (void)hipMemsetAsync((char*)d_ws + WS_CTL, 0, 16384, stream);
    a.ph_lo = 0; a.ph_hi = N_PHASES;
    void* kargs[] = {&a};
    hipError_t e = hipLaunchCooperativeKernel((const void*)hybrid_fwd, dim3(grid), dim3(NTHREADS), kargs, LDS_BYTES, stream);
    if (e != hipSuccess) fprintf(stderr, "kernel_launch: cooperative launch failed: %s (grid %d)\n", hipGetErrorString(e), grid);
#else
    for (int ph = 0; ph < N_PHASES; ++ph) {
        a.ph_lo = ph; a.ph_hi = ph + 1;
        hipLaunchKernelGGL(hybrid_fwd, dim3(grid), dim3(NTHREADS), LDS_BYTES, stream, a);
    }
#endif
}
```

```cpp
#include <hip/hip_runtime.h>
#include <hip/hip_cooperative_groups.h>
#include <cstdio>
#include <cstdint>
namespace cg = cooperative_groups;

#define LAS __attribute__((address_space(3)))
typedef unsigned short bf16_t;
typedef short bf16x8 __attribute__((ext_vector_type(8)));
typedef float f32x4 __attribute__((ext_vector_type(4)));
typedef unsigned u32x4 __attribute__((ext_vector_type(4)));
typedef unsigned u32x2 __attribute__((ext_vector_type(2)));

constexpr int D = 1024;
constexpr int SEQ = 8192, NMETA = 16, PADF = 48;
constexpr int TPP = 8256;
constexpr int ROW_S0 = 2 * TPP;
constexpr int M_TOT = ROW_S0 + 128;
constexpr int NSEQ = 10;
constexpr float EPS = 1e-6f;
constexpr int LDP = 6144;
constexpr int SSD_INNER = 2048, SSD_HEADS = 32, SSD_P = 64, SSD_N = 128, SSD_CONV = 3072, SSD_IN = 5152, SSD_IN_PAD = 5376;
constexpr int GDN_HEADS = 8, GDN_DK = 128, GDN_DV = 256, GDN_CONV = 4096, GDN_VAL = 2048, GDN_IN = 6160, GDN_IN_PAD = 6400;

constexpr size_t O_YP = 0, O_YS = 16777216, O_PSSD = 16908288, O_PSSDC = 17956864, O_PGDN = 17993728, O_PGDNC = 19042304,
                 O_SSSD = 19091456, O_SSSDC = 23285760, O_SGDN = 23433216, O_SGDNC = 27627520;

constexpr size_t WS_CTL = 0;
constexpr size_t WS_HB = 65536;
constexpr size_t WS_WIN = WS_HB + (size_t)M_TOT * D * 2;
constexpr size_t WS_WOUT = WS_WIN + (size_t)GDN_IN_PAD * D * 2;
constexpr size_t WS_TAIL = WS_WOUT + (size_t)1024 * 2048 * 2;
constexpr size_t WS_DTB = WS_TAIL + (size_t)258 * 3 * 4096 * 2;
constexpr size_t WS_RSS = WS_DTB + (size_t)M_TOT * 32 * 4;
constexpr size_t WS_PROJ = WS_RSS + (size_t)M_TOT * 16 * 4;
constexpr size_t WS_END = WS_PROJ + (size_t)M_TOT * LDP * 2;

constexpr int NTHREADS = 512;
constexpr int LDS_BYTES = 147456;

__device__ __forceinline__ float bf2f(bf16_t b) { return __uint_as_float(((unsigned)b) << 16); }
__device__ __forceinline__ bf16_t f2bf(float f) { unsigned u = __float_as_uint(f); u += 0x7FFFu + ((u >> 16) & 1u); return (bf16_t)(u >> 16); }
typedef __bf16 bf16v2_t __attribute__((ext_vector_type(2)));
typedef float f32x2_t __attribute__((ext_vector_type(2)));
__device__ __forceinline__ unsigned cvt_pk_bf16(float lo, float hi) { const bf16v2_t r = __builtin_convertvector((f32x2_t){lo, hi}, bf16v2_t); return __builtin_bit_cast(unsigned, r); }
__device__ __forceinline__ float silu_f(float x) { return x / (1.0f + __expf(-x)); }
__device__ __forceinline__ float softplus_f(float x) { return x > 20.f ? x : log1pf(__expf(x)); }
__device__ __forceinline__ float wave_sum(float v) {
#pragma unroll
    for (int o = 32; o >= 1; o >>= 1) v += __shfl_xor(v, o);
    return v;
}
#define KEEP(x) asm volatile("" :: "v"(x))
__device__ __forceinline__ int seq_base(int s) { return s < 2 ? s * TPP + 64 - NMETA : ROW_S0 + 16 * (s - 2); }
__device__ __forceinline__ int seq_len(int s) { return s < 2 ? SEQ + NMETA : 16; }
__device__ __forceinline__ int seq_chunks(int s) { return s < 2 ? 129 : 1; }

namespace pg8 {
constexpr int BM = 256, BK = 64, HALF = 128, HTB = HALF * BK * 2, STAGE_BYTES = 8 * HTB, NXCD = 8, WGM = 8;
__device__ __forceinline__ int lds_byte(int r, int c) { const int st = (r >> 4) * 2 + (c >> 5), rr = r & 15, cc = c & 31, ob = rr * 64 + cc * 2; return st * 1024 + (ob ^ (((ob >> 9) & 1) << 5)); }
__device__ __forceinline__ void stage_rc(int b, int& R, int& C) { const int st = b / 1024, sb = b % 1024, swz = sb ^ (((sb >> 9) & 1) << 5); R = (st >> 1) * 16 + swz / 64; C = (st & 1) * 32 + (swz % 64) / 2; }
__device__ __forceinline__ int perm32(int rho) { const int n = rho >> 4, i = rho & 15; return 8 * (i >> 2) + 4 * n + (i & 3); }
struct Unit { int pm, pn; };
struct Gemm { const bf16_t* A; const bf16_t* Bt; int M, N, K, lda, ldb; };
struct StaticOrder {
    int nM, nN, nwg, G, c;
    __device__ void init(int M, int N, int G_, int c_) { nM = M / BM; nN = N / BM; nwg = nM * nN; G = G_; c = c_; }
    __device__ bool next(int i, Unit& u) const {
        const long L = (long)i * G + c; if (L >= nwg) return false;
        int wgid = (int)L; { const int q = nwg / NXCD, r = nwg % NXCD, xcd = wgid % NXCD, off = wgid / NXCD; wgid = (xcd < r ? xcd * (q + 1) : r * (q + 1) + (xcd - r) * q) + off; }
        const int nig = WGM * nN, gid = wgid / nig, fm = gid * WGM, gsz = (nM - fm) < WGM ? (nM - fm) : WGM;
        u.pm = fm + ((wgid % nig) % gsz); u.pn = (wgid % nig) / gsz; return true;
    }
};

template <class Epi>
__device__ __forceinline__ void gemm_phase(LAS unsigned char* lds, const Gemm g, const StaticOrder& S, const Epi& E, const int tid) {
    const int wid = __builtin_amdgcn_readfirstlane(tid >> 6), lane = tid & 63, wr = wid >> 2, wc = wid & 3, fr = lane & 15, fq = lane >> 4;
    const int K = g.K, nt = K / BK;
    unsigned voffA[2], voffB[2];
#pragma unroll
    for (int i = 0; i < 2; ++i) { int R, C; stage_rc(tid * 16 + i * 8192, R, C); const int Rb = Epi::PERM ? ((R & ~31) + perm32(R & 31)) : R;
        voffA[i] = (unsigned)(R * g.lda + C) * 2u; voffB[i] = (unsigned)(Rb * g.ldb + C) * 2u; }
    const size_t kstep = (size_t)(BK * 2);
    const size_t hstepA = (size_t)HALF * g.lda * 2, hstepB = (size_t)HALF * g.ldb * 2;
    const size_t tstepA = 2 * hstepA, tstepB = 2 * hstepB;
    const unsigned ldsw = (unsigned)wid * 1024u;
    const int aoff = lds_byte(wr * 64 + fr, fq * 8), boff = lds_byte(wc * 32 + fr, fq * 8);
#define PG8_SA(b, h) (((b) * 2 + (h)) * HTB)
#define PG8_SB(b, h) ((4 + (b) * 2 + (h)) * HTB)
#define PG8_STAGE(bufoff, gbase, voff) do { _Pragma("unroll") for (int _i = 0; _i < 2; ++_i) \
        __builtin_amdgcn_global_load_lds((const unsigned*)((const char*)(gbase) + (voff)[_i]), (LAS unsigned*)(lds + (bufoff) + ldsw + _i * 8192), 16, 0, 0); } while (0)
#define PG8_LDA(dst, b, h) do { _Pragma("unroll") for (int m = 0; m < 4; ++m) _Pragma("unroll") for (int k = 0; k < 2; ++k) dst[m][k] = *(const LAS bf16x8*)(lds + PG8_SA(b, h) + aoff + m * 2048 + k * 1024); } while (0)
#define PG8_LDB(dst, b, h) do { _Pragma("unroll") for (int n = 0; n < 2; ++n) _Pragma("unroll") for (int k = 0; k < 2; ++k) dst[n][k] = *(const LAS bf16x8*)(lds + PG8_SB(b, h) + boff + n * 2048 + k * 1024); } while (0)
#define PG8_MMA(ai, bj, At, Bt) do { __builtin_amdgcn_s_setprio(1); _Pragma("unroll") for (int m = 0; m < 4; ++m) _Pragma("unroll") for (int n = 0; n < 2; ++n) _Pragma("unroll") for (int k = 0; k < 2; ++k) \
        acc[ai][bj][m][n] = __builtin_amdgcn_mfma_f32_16x16x32_bf16(Bt[n][k], At[m][k], acc[ai][bj][m][n], 0, 0, 0); __builtin_amdgcn_s_setprio(0); } while (0)
#define PG8_WAIT_V(n) asm volatile("s_waitcnt vmcnt(" #n ")" ::: "memory")
#define PG8_WAIT_L(n) asm volatile("s_waitcnt lgkmcnt(" #n ")" ::: "memory")
#define PG8_BAR __builtin_amdgcn_s_barrier()
#define PG8_SCHED __builtin_amdgcn_sched_barrier(0)
    Unit cur, nxt; int ui = 0;
    if (!S.next(0, cur)) return;
    f32x4 acc[2][2][4][2];
#pragma unroll
    for (int a = 0; a < 2; ++a)
#pragma unroll
        for (int b = 0; b < 2; ++b)
#pragma unroll
            for (int m = 0; m < 4; ++m)
#pragma unroll
                for (int n = 0; n < 2; ++n) acc[a][b][m][n] = (f32x4){0.f, 0.f, 0.f, 0.f};
    bf16x8 At[4][2], B0[2][2], B1[2][2];
    const char* cA = (const char*)g.A + (size_t)cur.pm * tstepA; const char* cB = (const char*)g.Bt + (size_t)cur.pn * tstepB;
    PG8_STAGE(PG8_SB(0, 0), cB, voffB); PG8_STAGE(PG8_SA(0, 0), cA, voffA); PG8_STAGE(PG8_SB(0, 1), cB + hstepB, voffB); PG8_STAGE(PG8_SA(0, 1), cA + hstepA, voffA);
    if (wr == 1) PG8_BAR;
    PG8_WAIT_V(4); PG8_BAR;
    PG8_STAGE(PG8_SB(1, 0), cB + kstep, voffB); PG8_STAGE(PG8_SA(1, 0), cA + kstep, voffA); PG8_STAGE(PG8_SB(1, 1), cB + hstepB + kstep, voffB);
    PG8_WAIT_V(6); PG8_BAR;
    for (;;) {
        const bool has_next = S.next(ui + 1, nxt);
        const char* nA = has_next ? (const char*)g.A + (size_t)nxt.pm * tstepA : cA; const char* nB = has_next ? (const char*)g.Bt + (size_t)nxt.pn * tstepB : cB;
        for (int t = 0; t < nt; t += 2) {
            const bool last = (t == nt - 2);
            const char* a1 = cA + (size_t)(t + 1) * kstep;
            const char* a2 = last ? nA : cA + (size_t)(t + 2) * kstep; const char* b2 = last ? nB : cB + (size_t)(t + 2) * kstep;
            const char* a3 = a2 + kstep; const char* b3 = b2 + kstep;
            PG8_LDB(B0, 0, 0); PG8_SCHED; PG8_LDA(At, 0, 0); PG8_STAGE(PG8_SA(1, 1), a1 + hstepA, voffA);
            PG8_WAIT_L(8); PG8_BAR; PG8_WAIT_L(0); PG8_MMA(0, 0, At, B0); PG8_BAR; PG8_SCHED;
            PG8_LDB(B1, 0, 1); PG8_STAGE(PG8_SB(0, 0), b2, voffB);
            PG8_BAR; PG8_WAIT_L(0); PG8_MMA(0, 1, At, B1); PG8_BAR;
            PG8_LDA(At, 0, 1); PG8_STAGE(PG8_SA(0, 0), a2, voffA);
            PG8_BAR; PG8_WAIT_L(0); PG8_MMA(1, 0, At, B0); PG8_BAR; PG8_SCHED;
            PG8_STAGE(PG8_SB(0, 1), b2 + hstepB, voffB);
            PG8_WAIT_V(6); PG8_BAR; PG8_MMA(1, 1, At, B1); PG8_BAR;
            PG8_LDB(B0, 1, 0); PG8_SCHED; PG8_LDA(At, 1, 0); PG8_STAGE(PG8_SA(0, 1), a2 + hstepA, voffA);
            PG8_WAIT_L(8); PG8_BAR; PG8_WAIT_L(0); PG8_MMA(0, 0, At, B0); PG8_BAR; PG8_SCHED;
            PG8_LDB(B1, 1, 1); PG8_STAGE(PG8_SB(1, 0), b3, voffB);
            PG8_BAR; PG8_WAIT_L(0); PG8_MMA(0, 1, At, B1); PG8_BAR;
            PG8_LDA(At, 1, 1); PG8_STAGE(PG8_SA(1, 0), a3, voffA);
            PG8_BAR; PG8_WAIT_L(0); PG8_MMA(1, 0, At, B0); PG8_BAR; PG8_SCHED;
            PG8_STAGE(PG8_SB(1, 1), b3 + hstepB, voffB);
            PG8_WAIT_V(6); PG8_BAR; PG8_MMA(1, 1, At, B1); PG8_BAR;
        }
        E(acc, cur, wr, wc, fr, fq);
        if (!has_next) break;
#pragma unroll
        for (int a = 0; a < 2; ++a)
#pragma unroll
            for (int b = 0; b < 2; ++b)
#pragma unroll
                for (int m = 0; m < 4; ++m)
#pragma unroll
                    for (int n = 0; n < 2; ++n) acc[a][b][m][n] = (f32x4){0.f, 0.f, 0.f, 0.f};
        cur = nxt; cA = nA; cB = nB; ++ui;
    }
    PG8_WAIT_V(0);
    if (wr == 0) PG8_BAR;
    PG8_BAR;
#undef PG8_SA
#undef PG8_SB
#undef PG8_STAGE
#undef PG8_LDA
#undef PG8_LDB
#undef PG8_MMA
#undef PG8_WAIT_V
#undef PG8_WAIT_L
#undef PG8_BAR
#undef PG8_SCHED
}

struct EpiInProj {
    static constexpr bool PERM = true;
    bf16_t* proj; float* dtb; const float* rowss; int nt_main; bf16_t* tails; int tl_lo, tl_hi;
    __device__ __forceinline__ void operator()(const f32x4 (&acc)[2][2][4][2], const Unit& u, int wr, int wc, int fr, int fq) const {
        const int row0 = u.pm * BM + wr * 64 + fr;
#pragma unroll
        for (int ai = 0; ai < 2; ++ai)
#pragma unroll
            for (int m = 0; m < 4; ++m) {
                const int r = row0 + ai * HALF + m * 16;
                const f32x4* rp = (const f32x4*)(rowss + (size_t)r * 16);
                const f32x4 p0 = rp[0], p1 = rp[1], p2 = rp[2], p3 = rp[3];
                const float ss = ((p0[0] + p0[1]) + (p0[2] + p0[3])) + ((p1[0] + p1[1]) + (p1[2] + p1[3])) + ((p2[0] + p2[1]) + (p2[2] + p2[3])) + ((p3[0] + p3[1]) + (p3[2] + p3[3]));
                const float rstd = rsqrtf(ss * (1.0f / 1024.0f) + EPS);
                if (u.pn < nt_main) {
                    bf16_t* rowp = proj + (size_t)r * LDP + u.pn * BM + wc * 32 + 8 * fq;
#pragma unroll
                    for (int bj = 0; bj < 2; ++bj) { const f32x4 v0 = acc[ai][bj][m][0] * rstd, v1 = acc[ai][bj][m][1] * rstd;
                        u32x4 w; w.x = cvt_pk_bf16(v0[0], v0[1]); w.y = cvt_pk_bf16(v0[2], v0[3]); w.z = cvt_pk_bf16(v1[0], v1[1]); w.w = cvt_pk_bf16(v1[2], v1[3]);
                        *(u32x4*)(rowp + bj * HALF) = w;
                        if (u.pn >= tl_lo && u.pn < tl_hi && r < ROW_S0 && (r & 63) >= 61) *(u32x4*)(tails + ((size_t)(r >> 6) * 3 + ((r & 63) - 61)) * 4096 + (u.pn - tl_lo) * BM + wc * 32 + 8 * fq + bj * HALF) = w; }
                } else if (wc == 0) {
                    float* dp = dtb + (size_t)r * 32 + 8 * fq;
                    *(f32x4*)(dp) = acc[ai][0][m][0] * rstd; *(f32x4*)(dp + 4) = acc[ai][0][m][1] * rstd;
                }
            }
    }
};
struct EpiOutProj {
    static constexpr bool PERM = false;
    bf16_t* hb; float* rowss;
    __device__ __forceinline__ void operator()(const f32x4 (&acc)[2][2][4][2], const Unit& u, int wr, int wc, int fr, int fq) const {
        const int row0 = u.pm * BM + wr * 64 + fr, col0 = u.pn * BM + wc * 32 + 4 * fq;
#pragma unroll
        for (int ai = 0; ai < 2; ++ai)
#pragma unroll
            for (int m = 0; m < 4; ++m) {
                const int r = row0 + ai * HALF + m * 16; float ss = 0.f;
                bf16_t* rowp = hb + (size_t)r * D + col0;
#pragma unroll
                for (int bj = 0; bj < 2; ++bj)
#pragma unroll
                    for (int n = 0; n < 2; ++n) {
                        u32x2* p = (u32x2*)(rowp + bj * HALF + n * 16); const u32x2 o = *p;
                        const f32x4 a = acc[ai][bj][m][n];
                        const float h0 = __uint_as_float(o.x << 16) + a[0], h1 = __uint_as_float(o.x & 0xffff0000u) + a[1];
                        const float h2 = __uint_as_float(o.y << 16) + a[2], h3 = __uint_as_float(o.y & 0xffff0000u) + a[3];
                        ss += (h0 * h0 + h1 * h1) + (h2 * h2 + h3 * h3);
                        u32x2 w; w.x = cvt_pk_bf16(h0, h1); w.y = cvt_pk_bf16(h2, h3); *p = w;
                    }
                ss += __shfl_xor(ss, 16); ss += __shfl_xor(ss, 32);
                if (fq == 0) rowss[(size_t)r * 16 + u.pn * 4 + wc] = ss;
            }
    }
};
}

#define XB_TMO      128
#define XB_XCNT(j)  (256  + 64 * (j))
#define XB_XSUB(j)  (1280 + 64 * (j))
#define XB_XGEN(j)  (2304 + 64 * (j))
#define XB_TOP      3328
#define XB_TOPGEN   3392
#define XCD_BAR_WORDS 3456
#define XB_SPIN_CAP (1u << 24)
__device__ __forceinline__ unsigned xb_ld(unsigned* p)              { return __hip_atomic_load(p, __ATOMIC_RELAXED, __HIP_MEMORY_SCOPE_AGENT); }
__device__ __forceinline__ unsigned xb_add(unsigned* p, unsigned v) { return __hip_atomic_fetch_add(p, v, __ATOMIC_RELAXED, __HIP_MEMORY_SCOPE_AGENT); }
__device__ __forceinline__ unsigned xb_xcc_id() { return (unsigned)__builtin_amdgcn_s_getreg((3 << 11) | 20) & 0xFu; }
#define XB_SPIN(cond, bar) do { unsigned _sp = 0; while (cond) { __builtin_amdgcn_s_sleep(1); \
    if ((++_sp & 255u) == 0u) { if (xb_ld(&(bar)[XB_TMO])) break; if (_sp > XB_SPIN_CAP) { atomicAdd(&(bar)[XB_TMO], 1u); break; } } } } while (0)
struct XcdBarrier { unsigned* bar; unsigned x; volatile LAS unsigned* st; };
__device__ __forceinline__ XcdBarrier xcd_barrier_post(unsigned* bar, volatile LAS unsigned* st) {
    XcdBarrier b; b.bar = bar; b.x = xb_xcc_id(); b.st = st;
    if (threadIdx.x == 0) (void)xb_add(&bar[XB_XCNT(b.x)], 1u);
    return b;
}
__device__ __forceinline__ void xcd_barrier_complete(unsigned* bar, unsigned x, unsigned& nloc, unsigned& nx) {
    const unsigned G = gridDim.x * gridDim.y * gridDim.z;
    unsigned sum, cnt, mine, sp = 0u;
    for (;;) {
        sum = 0u; cnt = 0u; mine = 0u;
#pragma unroll
        for (unsigned j = 0; j < 16; ++j) { const unsigned c = xb_ld(&bar[XB_XCNT(j)]); sum += c; cnt += (c > 0u) ? 1u : 0u; mine = (j == x) ? c : mine; }
        if (sum == G) break;
        __builtin_amdgcn_s_sleep(1);
        if ((++sp & 255u) == 0u) { if (xb_ld(&bar[XB_TMO])) break; if (sp > XB_SPIN_CAP) { atomicAdd(&bar[XB_TMO], 1u); break; } }
    }
    nloc = mine > 0u ? mine : 1u; nx = cnt > 0u ? cnt : 1u;
}
__device__ __forceinline__ void xcd_barrier(const XcdBarrier& b) {
    asm volatile("s_waitcnt vmcnt(0)" ::: "memory");
    __syncthreads();
    if (threadIdx.x == 0) {
        unsigned* bar = b.bar;
        __builtin_amdgcn_s_waitcnt(0);
        unsigned nloc = b.st[0], nx = b.st[1];
        if (nloc == 0u) { xcd_barrier_complete(bar, b.x, nloc, nx); b.st[0] = nloc; b.st[1] = nx; }
        const unsigned old = xb_add(&bar[XB_XSUB(b.x)], 1u);
        const unsigned gen = old / nloc;
        if (old + 1u == (gen + 1u) * nloc) {
            __builtin_amdgcn_fence(__ATOMIC_RELEASE, "agent");
            asm volatile("s_waitcnt vmcnt(0)" ::: "memory");
            const unsigned og = xb_add(&bar[XB_TOP], 1u);
            const unsigned tg = og / nx;
            if (og + 1u == (tg + 1u) * nx) xb_add(&bar[XB_TOPGEN], 1u);
            else XB_SPIN(xb_ld(&bar[XB_TOPGEN]) == tg, bar);
            __builtin_amdgcn_fence(__ATOMIC_ACQUIRE, "agent");
            xb_add(&bar[XB_XGEN(b.x)], 1u);
            asm volatile("s_waitcnt vmcnt(0)" ::: "memory");
        } else {
            XB_SPIN(xb_ld(&bar[XB_XGEN(b.x)]) == gen, bar);
            __builtin_amdgcn_fence(__ATOMIC_ACQUIRE, "agent");
            asm volatile("s_waitcnt vmcnt(0)" ::: "memory");
        }
    }
    __syncthreads();
}

struct Args { const float* in[24]; float* out; unsigned char* ws; int ph_lo, ph_hi; };

struct Frame {
    const Args* ap; float* out; unsigned char* ws;
    __device__ __forceinline__ const float* inp(int i) const { asm volatile("" : "+s"(i)); return ap->in[i]; }
    unsigned char* lds; LAS unsigned char* ldsl;
    int tid, lane, wave, G, bid;
    bf16_t* hb; bf16_t* win; bf16_t* wout; float* dtb; float* rss; bf16_t* proj; bf16_t* tails;
};

__device__ __forceinline__ Frame relaunder(Frame F) {
    int t = F.tid; asm volatile("" : "+v"(t));
    F.tid = t; F.lane = t & 63; F.wave = __builtin_amdgcn_readfirstlane(t >> 6);
    unsigned char* w = F.ws; asm volatile("" : "+s"(w));
    F.ws = w; F.hb = (bf16_t*)(w + WS_HB); F.win = (bf16_t*)(w + WS_WIN); F.wout = (bf16_t*)(w + WS_WOUT);
    F.dtb = (float*)(w + WS_DTB); F.rss = (float*)(w + WS_RSS); F.proj = (bf16_t*)(w + WS_PROJ); F.tails = (bf16_t*)(w + WS_TAIL);
    return F;
}
__device__ void phase_init_h(const Frame& F0) {
    const Frame F = relaunder(F0);
    const float* xp = F.inp(0); const float* xs = F.inp(1); const float* meta = F.inp(6);
    for (int row = F.bid * 8 + F.wave; row < M_TOT; row += F.G * 8) {
        const float* src = nullptr;
        if (row < ROW_S0) { const int b = row / TPP, r = row % TPP; if (r >= 64) src = xp + ((size_t)b * SEQ + (r - 64)) * D; else if (r >= PADF) src = meta + (size_t)(r - PADF) * D; }
        else src = xs + (size_t)(row - ROW_S0) * D;
        float ss = 0.f;
#pragma unroll
        for (int i = 0; i < 4; ++i) {
            f32x4 v = (f32x4){0.f, 0.f, 0.f, 0.f};
            if (src) v = *(const f32x4*)(src + (F.lane + 64 * i) * 4);
            ss += (v[0] * v[0] + v[1] * v[1]) + (v[2] * v[2] + v[3] * v[3]);
            u32x2 w; w.x = cvt_pk_bf16(v[0], v[1]); w.y = cvt_pk_bf16(v[2], v[3]);
            *(u32x2*)(F.hb + (size_t)row * D + (F.lane + 64 * i) * 4) = w;
        }
        ss = wave_sum(ss);
        if (F.lane < 16) F.rss[(size_t)row * 16 + F.lane] = (F.lane == 0) ? ss : 0.f;
    }
}

__device__ void transpose_convert(const Frame& F, const float* src, int K, int N, int Npad, bf16_t* dst, const float* scale, int smod) {
    float* tile = (float*)F.lds;
    const int ntk = K / 64, ntn = Npad / 64, ntile = ntk * ntn;
    __syncthreads();
    for (int ti = F.bid; ti < ntile; ti += F.G) {
        const int kt = ti % ntk, nt_ = ti / ntk, k0 = kt * 64, n0 = nt_ * 64;
        const int kk = F.tid >> 4, n4 = (F.tid & 15) * 4;
#pragma unroll
        for (int h = 0; h < 2; ++h) {
            const int k = k0 + kk + 32 * h, n = n0 + n4;
            f32x4 v = (f32x4){0.f, 0.f, 0.f, 0.f};
            if (n < N) v = *(const f32x4*)(src + (size_t)k * N + n);
            const float s = scale[k % smod];
            float* tp = tile + (kk + 32 * h) * 65 + n4;
            tp[0] = v[0] * s; tp[1] = v[1] * s; tp[2] = v[2] * s; tp[3] = v[3] * s;
        }
        __syncthreads();
        const int nn = F.tid >> 3, kg = (F.tid & 7) * 8;
        float x[8];
#pragma unroll
        for (int j = 0; j < 8; ++j) x[j] = tile[(kg + j) * 65 + nn];
        u32x4 w; w.x = cvt_pk_bf16(x[0], x[1]); w.y = cvt_pk_bf16(x[2], x[3]); w.z = cvt_pk_bf16(x[4], x[5]); w.w = cvt_pk_bf16(x[6], x[7]);
        *(u32x4*)(dst + (size_t)(n0 + nn) * K + k0 + kg) = w;
        __syncthreads();
    }
}
__device__ void phase_wprep_in(const Frame& F0, int L) {
    const Frame F = relaunder(F0);
    const int j = L >> 1;
    if ((L & 1) == 0) transpose_convert(F, F.inp(8) + (size_t)j * D * SSD_IN, D, SSD_IN, SSD_IN_PAD, F.win, F.inp(7) + j * D, D);
    else transpose_convert(F, F.inp(17) + (size_t)j * D * GDN_IN, D, GDN_IN, GDN_IN_PAD, F.win, F.inp(16) + j * D, D);
}
__device__ void phase_wprep_out(const Frame& F0, int L) {
    const Frame F = relaunder(F0);
    const int j = L >> 1;
    if ((L & 1) == 0) transpose_convert(F, F.inp(15) + (size_t)j * SSD_INNER * D, SSD_INNER, D, D, F.wout, F.inp(14) + j * SSD_INNER, SSD_INNER);
    else transpose_convert(F, F.inp(22) + (size_t)j * GDN_VAL * D, GDN_VAL, D, D, F.wout, F.inp(21) + j * GDN_DV, GDN_DV);
}

__device__ void phase_inproj(const Frame& F0, int L) {
    const Frame F = relaunder(F0);
    const int npad = (L & 1) ? GDN_IN_PAD : SSD_IN_PAD;
    pg8::Gemm g{F.hb, F.win, M_TOT, npad, D, D, D};
    pg8::StaticOrder S; S.init(M_TOT, npad, F.G, F.bid);
    pg8::EpiInProj E{F.proj, F.dtb, F.rss, npad / 256 - 1, F.tails, (L & 1) ? 0 : 8, 16};
    pg8::gemm_phase<pg8::EpiInProj>(F.ldsl, g, S, E, F.tid);
}
__device__ void phase_outproj(const Frame& F0, int L) {
    const Frame F = relaunder(F0);
    const bf16_t* A = F.proj + ((L & 1) ? 4096 : 0);
    pg8::Gemm g{A, F.wout, M_TOT, D, 2048, LDP, 2048};
    pg8::StaticOrder S; S.init(M_TOT, D, F.G, F.bid);
    pg8::EpiOutProj E{F.hb, F.rss};
    pg8::gemm_phase<pg8::EpiOutProj>(F.ldsl, g, S, E, F.tid);
}

__device__ void phase_ssd_naive(const Frame& F0, int j) {
    const Frame F = relaunder(F0);
    float* xs = (float*)F.lds;
    float* Bs = xs + 64 * 64;
    float* Cs = Bs + 64 * 128;
    float* dts = Cs + 64 * 128;
    float* das = dts + 64;
    const float* conv_w = F.inp(9) + (size_t)j * 4 * SSD_CONV; const float* conv_b = F.inp(10) + (size_t)j * SSD_CONV;
    const int p = F.tid >> 3, nq = F.tid & 7;
    for (int task = F.bid; task < NSEQ * SSD_HEADS; task += F.G) {
        const int s = task / SSD_HEADS, head = task % SSD_HEADS, grp = head >> 3;
        const int base = seq_base(s), nch = seq_chunks(s);
        const float dt_bias = F.inp(11)[j * SSD_HEADS + head], a = -__expf(F.inp(12)[j * SSD_HEADS + head]), dsk = F.inp(13)[j * SSD_HEADS + head];
        float h[16];
        if (s < 2) {
#pragma unroll
            for (int n = 0; n < 16; ++n) h[n] = 0.f;
        } else {
            const float* st = F.inp(2) + ((((size_t)j * 8 + (s - 2)) * SSD_HEADS + head) * SSD_P + p) * SSD_N + nq * 16;
#pragma unroll
            for (int n = 0; n < 16; ++n) h[n] = st[n];
        }
        int cidx = -1;
        if (F.tid < 64) cidx = head * 64 + F.tid; else if (F.tid < 192) cidx = 2048 + grp * 128 + (F.tid - 64); else if (F.tid < 320) cidx = 2560 + grp * 128 + (F.tid - 192);
        float w0 = 0, w1 = 0, w2 = 0, w3 = 0, cb = 0;
        if (cidx >= 0) { w0 = conv_w[cidx]; w1 = conv_w[SSD_CONV + cidx]; w2 = conv_w[2 * SSD_CONV + cidx]; w3 = conv_w[3 * SSD_CONV + cidx]; cb = conv_b[cidx]; }
        const float* cst = (s >= 2) ? F.inp(3) + (((size_t)j * 8 + (s - 2)) * 3) * SSD_CONV : nullptr;
        for (int c = 0; c < nch; ++c) {
            const int t0 = 64 * c - PADF;
            __syncthreads();
            if (cidx >= 0) {
                float r3, r2, r1;
                {   float rv[3];
#pragma unroll
                    for (int q = 0; q < 3; ++q) { const int t = t0 - 3 + q; float v = 0.f;
                        if (t >= 0) v = bf2f(F.proj[(size_t)(base + t) * LDP + 2048 + cidx]); else if (t >= -3 && cst) v = cst[(3 + t) * SSD_CONV + cidx];
                        rv[q] = v; }
                    r3 = rv[0]; r2 = rv[1]; r1 = rv[2]; }
                for (int i = 0; i < 64; ++i) {
                    const int t = t0 + i; float v = 0.f;
                    if (t >= 0) v = bf2f(F.proj[(size_t)(base + t) * LDP + 2048 + cidx]); else if (t >= -3 && cst) v = cst[(3 + t) * SSD_CONV + cidx];
                    const float o = silu_f(cb + w0 * r3 + w1 * r2 + w2 * r1 + w3 * v);
                    r3 = r2; r2 = r1; r1 = v;
                    if (F.tid < 64) xs[i * 64 + F.tid] = o; else if (F.tid < 192) Bs[i * 128 + (F.tid - 64)] = o; else Cs[i * 128 + (F.tid - 192)] = o;
                }
            } else if (F.tid >= 448) {
                const int i = F.tid - 448, t = t0 + i;
                float dt = 0.f, da = 1.f;
                if (t >= 0) { dt = softplus_f(F.dtb[(size_t)(base + t) * 32 + head] + dt_bias); da = __expf(dt * a); }
                dts[i] = dt; das[i] = da;
            }
            __syncthreads();
            for (int i = 0; i < 64; ++i) {
                const int t = t0 + i;
                const float dt = dts[i], da = das[i], xv = xs[i * 64 + p], dx = dt * xv;
                const float* bp = Bs + i * 128 + nq * 16; const float* cp = Cs + i * 128 + nq * 16;
                float accv = 0.f;
#pragma unroll
                for (int n = 0; n < 16; ++n) { h[n] = h[n] * da + dx * bp[n]; accv += cp[n] * h[n]; }
                accv += __shfl_xor(accv, 1); accv += __shfl_xor(accv, 2); accv += __shfl_xor(accv, 4);
                if (nq == 0 && t >= 0) {
                    bf16_t* zp = F.proj + (size_t)(base + t) * LDP + head * 64 + p;
                    const float z = bf2f(*zp);
                    *zp = f2bf((accv + dsk * xv) * silu_f(z));
                }
            }
        }
        float* so = (s < 2) ? F.out + O_PSSD + ((((size_t)j * 2 + s) * SSD_HEADS + head) * SSD_P + p) * SSD_N + nq * 16
                            : F.out + O_SSSD + ((((size_t)j * 8 + (s - 2)) * SSD_HEADS + head) * SSD_P + p) * SSD_N + nq * 16;
#pragma unroll
        for (int n = 0; n < 16; ++n) so[n] = h[n];
    }
}


constexpr int NCHT = 266;
constexpr size_t SC_BT = 0;
constexpr size_t SC_C = SC_BT + (size_t)NCHT * 4 * 16384;
constexpr size_t SC_CB = SC_C + (size_t)NCHT * 4 * 16384;
constexpr size_t SC_VEC = SC_CB + (size_t)NCHT * 4 * 8192;
constexpr size_t SC_XS = SC_VEC + (size_t)NCHT * 32 * 1024;
constexpr size_t SC_SSD_END = SC_XS + (size_t)256 * 8192;
static_assert(SC_SSD_END <= (size_t)16777216 * 4, "scratch must fit the y_prompt region");
__device__ __forceinline__ int qperm(int s) { return (s & ~31) | (((s >> 2) & 3) << 3) | (((s >> 4) & 1) << 2) | (s & 3); }
__device__ __forceinline__ int qnat(int q) { return (q & ~31) | (((q >> 2) & 1) << 4) | (((q >> 3) & 3) << 2) | (q & 3); }
__device__ __forceinline__ bf16x8 pack8(f32x4 a, f32x4 b) {
    u32x4 w; w.x = cvt_pk_bf16(a[0], a[1]); w.y = cvt_pk_bf16(a[2], a[3]); w.z = cvt_pk_bf16(b[0], b[1]); w.w = cvt_pk_bf16(b[2], b[3]);
    return __builtin_bit_cast(bf16x8, w);
}
__device__ __forceinline__ void chunk_of(int cgi, int& seq, int& c) { if (cgi < 258) { seq = cgi / 129; c = cgi % 129; } else { seq = 2 + (cgi - 258); c = 0; } }
__device__ __forceinline__ int cgi_of(int seq, int c) { return seq < 2 ? seq * 129 + c : 258 + (seq - 2); }
struct XTile { bf16_t* p; int stride; };
__device__ __forceinline__ XTile ssd_xtile(const Frame& F, int seq, int c, int head) {
    XTile t;
    if (seq < 2) { t.p = F.proj + (size_t)(seq * TPP + 64 * c) * LDP + 2048 + head * 64; t.stride = LDP; }
    else { t.p = (bf16_t*)((unsigned char*)F.out + SC_XS) + (size_t)((seq - 2) * 32 + head) * 4096; t.stride = 64; }
    return t;
}

template <bool DRY>
__device__ void phase_ssd_prep(const Frame& F0, int j) {
    const Frame F = relaunder(F0);
    bf16_t* Bs = (bf16_t*)F.lds;
    bf16_t* Cs = Bs + 64 * 136;
    unsigned char* sc = (unsigned char*)F.out;
    const float* conv_w = F.inp(9) + (size_t)j * 4 * SSD_CONV; const float* conv_b = F.inp(10) + (size_t)j * SSD_CONV;
    const int i16 = F.lane & 15, g4 = F.lane >> 4;
    for (int task = F.bid; task < NCHT * 4; task += F.G) {
        const int cgi = task >> 2, grp = task & 3; int seq, c; chunk_of(cgi, seq, c);
        const int base = seq_base(seq), t0 = 64 * c - PADF;
        __syncthreads();
        {
            const int hl = F.tid >> 6, p = F.tid & 63, head = grp * 8 + hl, cidx = head * 64 + p;
            const float w0 = conv_w[cidx], w1 = conv_w[SSD_CONV + cidx], w2 = conv_w[2 * SSD_CONV + cidx], w3 = conv_w[3 * SSD_CONV + cidx], cb = conv_b[cidx];
            float r3 = 0.f, r2 = 0.f, r1 = 0.f;
            if (seq < 2 && c > 0) { const bf16_t* tp = F.tails + (size_t)(cgi - 1) * 3 * 4096 + cidx; r3 = bf2f(tp[0]); r2 = bf2f(tp[4096]); r1 = bf2f(tp[2 * 4096]); }
            else if (seq >= 2) { const float* cst = F.inp(3) + (((size_t)j * 8 + (seq - 2)) * 3) * SSD_CONV + cidx; r3 = cst[0]; r2 = cst[SSD_CONV]; r1 = cst[2 * SSD_CONV]; }
            const bf16_t* xcol = F.proj + 2048 + cidx;
            bf16_t* xrow = (bf16_t*)F.lds + F.tid * 72;
#pragma unroll 1
            for (int s8 = 0; s8 < 8; ++s8) {
                float o[8];
#pragma unroll
                for (int h = 0; h < 8; ++h) {
                    const int t = t0 + 8 * s8 + h;
                    const float v = (t >= 0) ? bf2f(xcol[(size_t)(base + (t > 0 ? t : 0)) * LDP]) : 0.f;
                    o[h] = silu_f(cb + w0 * r3 + w1 * r2 + w2 * r1 + w3 * v);
                    if (t >= 0) { r3 = r2; r2 = r1; r1 = v; }
                }
                u32x4 w; w.x = cvt_pk_bf16(o[0], o[1]); w.y = cvt_pk_bf16(o[2], o[3]); w.z = cvt_pk_bf16(o[4], o[5]); w.w = cvt_pk_bf16(o[6], o[7]);
                *(u32x4*)(xrow + 8 * s8) = w;
            }
            __syncthreads();
            const XTile xt = ssd_xtile(F, seq, c, head);
#pragma unroll
            for (int q = 0; q < 8; ++q) { const u32x4 w = *(const u32x4*)(xrow + 8 * q);
                if (!DRY) *(u32x4*)(xt.p + (size_t)p * xt.stride + 8 * q) = w; else KEEP(w); }
        }
        __syncthreads();
        {
            const int ch = F.tid & 255, half = F.tid >> 8, isC = ch >> 7, n = ch & 127;
            const int cidx = 2048 + isC * 512 + grp * 128 + n;
            const float w0 = conv_w[cidx], w1 = conv_w[SSD_CONV + cidx], w2 = conv_w[2 * SSD_CONV + cidx], w3 = conv_w[3 * SSD_CONV + cidx], cb = conv_b[cidx];
            const float* cst = (seq >= 2) ? F.inp(3) + (((size_t)j * 8 + (seq - 2)) * 3) * SSD_CONV : nullptr;
            bf16_t* dst = (isC ? Cs : Bs) + n;
            float r3, r2, r1;
            {   float rv[3];
#pragma unroll
                for (int q = 0; q < 3; ++q) { const int t = t0 + half * 32 - 3 + q; float v = 0.f;
                    if (t >= 0) v = bf2f(F.proj[(size_t)(base + t) * LDP + 2048 + cidx]); else if (t >= -3 && cst) v = cst[(3 + t) * SSD_CONV + cidx];
                    rv[q] = v; }
                r3 = rv[0]; r2 = rv[1]; r1 = rv[2]; }
            for (int ii = 0; ii < 32; ++ii) {
                const int p = half * 32 + ii, t = t0 + p; float v = 0.f;
                if (t >= 0) v = bf2f(F.proj[(size_t)(base + t) * LDP + 2048 + cidx]); else if (t >= -3 && cst) v = cst[(3 + t) * SSD_CONV + cidx];
                const float o = silu_f(cb + w0 * r3 + w1 * r2 + w2 * r1 + w3 * v);
                r3 = r2; r2 = r1; r1 = v;
                dst[p * 136] = f2bf(o);
            }
        }
        __syncthreads();
        {
            bf16_t* BT = (bf16_t*)(sc + SC_BT) + (size_t)(cgi * 4 + grp) * 8192;
            const int n = F.tid >> 2, qg = (F.tid & 3) * 16;
#pragma unroll
            for (int u = 0; u < 2; ++u) {
                const int q0 = qg + 8 * u; unsigned short e[8];
#pragma unroll
                for (int jj = 0; jj < 8; ++jj) e[jj] = Bs[qnat(q0 + jj) * 136 + n];
                u32x4 w; w.x = e[0] | ((unsigned)e[1] << 16); w.y = e[2] | ((unsigned)e[3] << 16); w.z = e[4] | ((unsigned)e[5] << 16); w.w = e[6] | ((unsigned)e[7] << 16);
                if (!DRY) *(u32x4*)(BT + n * 64 + q0) = w; else KEEP(w);
            }
            bf16_t* Cg = (bf16_t*)(sc + SC_C) + (size_t)(cgi * 4 + grp) * 8192;
#pragma unroll
            for (int u = 0; u < 2; ++u) {
                const int idx = F.tid + 512 * u, l = idx >> 4, qg8 = idx & 15, kk = qg8 >> 2, gg = qg8 & 3;
                const u32x2 a = *(const u32x2*)(Cs + l * 136 + 32 * kk + 4 * gg), b = *(const u32x2*)(Cs + l * 136 + 32 * kk + 16 + 4 * gg);
                u32x4 w; w.x = a.x; w.y = a.y; w.z = b.x; w.w = b.y;
                if (!DRY) *(u32x4*)(Cg + l * 128 + 8 * qg8) = w; else KEEP(w);
            }
        }
        {
            bf16_t* CB = (bf16_t*)(sc + SC_CB) + (size_t)(cgi * 4 + grp) * 4096;
            const int m = F.wave >> 1;
#pragma unroll
            for (int u = 0; u < 2; ++u) {
                const int st = 2 * (F.wave & 1) + u; f32x4 acc = (f32x4){0.f, 0.f, 0.f, 0.f};
#pragma unroll
                for (int kk = 0; kk < 4; ++kk) {
                    const bf16x8 a = *(const bf16x8*)(Cs + (16 * m + i16) * 136 + 32 * kk + 8 * g4);
                    const bf16x8 b = *(const bf16x8*)(Bs + (16 * st + i16) * 136 + 32 * kk + 8 * g4);
                    acc = __builtin_amdgcn_mfma_f32_16x16x32_bf16(a, b, acc, 0, 0, 0);
                }
                const int qs = qperm(16 * st + i16);
#pragma unroll
                for (int jj = 0; jj < 4; ++jj) { if (!DRY) CB[(16 * m + 4 * g4 + jj) * 64 + qs] = f2bf(acc[jj]); else KEEP(acc[jj]); }
            }
        }
        {
            const int head = grp * 8 + F.wave, t = t0 + F.lane;
            const float a = -__expf(F.inp(12)[j * SSD_HEADS + head]);
            float dt = 0.f;
            if (t >= 0) dt = softplus_f(F.dtb[(size_t)(base + t) * 32 + head] + F.inp(11)[j * SSD_HEADS + head]);
            float cs = dt * a;
#pragma unroll
            for (int o = 1; o < 64; o <<= 1) { const float y = __shfl_up(cs, o); if (F.lane >= o) cs += y; }
            const float cs_last = __shfl(cs, 63), cs_be = __shfl(cs, F.lane | 3);
            float* vp = (float*)(sc + SC_VEC) + (size_t)(cgi * 32 + head) * 256;
            const float v1 = __expf(cs_be - cs) * dt, v2 = dt * __expf(cs_last - cs), v3 = __expf(cs);
            if (!DRY) { vp[F.lane] = cs; vp[64 + F.lane] = v1; vp[128 + F.lane] = v2; vp[192 + F.lane] = v3; } else { KEEP(v1); KEEP(v2); KEEP(v3); }
        }
    }
}

constexpr int SL_C = 0, SL_BT = 16384, SL_M = 32768, SL_XT = 40960, SL_VEC = 49152, SL_SIZE = 50176;
#define PD(d) P[11 + ((d) >> 2)][(d) & 3]
__device__ __forceinline__ void ssd_stage_load(u32x4 (&P)[15], const Frame& F, const unsigned char* sc, int lt, int seq, int head, int c) {
    const int cgi = cgi_of(seq, c), grp = head >> 3;
    const bf16_t* Cp = (const bf16_t*)(sc + SC_C) + (size_t)(cgi * 4 + grp) * 8192;
    const bf16_t* BTp = (const bf16_t*)(sc + SC_BT) + (size_t)(cgi * 4 + grp) * 8192;
    const bf16_t* CBp = (const bf16_t*)(sc + SC_CB) + (size_t)(cgi * 4 + grp) * 4096;
    const float* vp = (const float*)(sc + SC_VEC) + (size_t)(cgi * 32 + head) * 256;
    const XTile xt = ssd_xtile(F, seq, c, head);
#pragma unroll
    for (int r = 0; r < 4; ++r) { const int k = lt + 256 * r; P[r] = *(const u32x4*)(Cp + k * 8); P[4 + r] = *(const u32x4*)(BTp + k * 8); }
#pragma unroll
    for (int r = 0; r < 2; ++r) { const int k = lt + 256 * r, l = k >> 3, ch = k & 7, sa = 32 * (ch >> 2) + 4 * (ch & 3);
        P[8 + r] = *(const u32x4*)(CBp + k * 8); PD(3 * r) = __float_as_uint(vp[l]); PD(3 * r + 1) = __float_as_uint(vp[sa + 3]); PD(3 * r + 2) = __float_as_uint(vp[sa + 19]);
        P[13 + r] = *(const u32x4*)(xt.p + (size_t)l * xt.stride + ch * 8); }
    P[10] = *(const u32x4*)(vp + 64 + 4 * (lt < 48 ? lt : 0));
}
__device__ __forceinline__ void ssd_stage_write(const u32x4 (&P)[15], unsigned char* img, int lt) {
#pragma unroll
    for (int r = 0; r < 4; ++r) { const int k = lt + 256 * r;
        { const int row = k >> 4, ch = k & 15; *(u32x4*)(img + SL_C + (row * 16 + (ch ^ (row & 15))) * 16) = P[r]; }
        { const int row = k >> 3, ch = k & 7; *(u32x4*)(img + SL_BT + (row * 8 + (ch ^ ((row >> 1) & 7))) * 16) = P[4 + r]; } }
#pragma unroll
    for (int r = 0; r < 2; ++r) {
        const int k = lt + 256 * r, l = k >> 3, ch = k & 7, sa = 32 * (ch >> 2) + 4 * (ch & 3), sb = sa + 16;
        const float csl = __uint_as_float(PD(3 * r)), e1a = __expf(csl - __uint_as_float(PD(3 * r + 1))), e1b = __expf(csl - __uint_as_float(PD(3 * r + 2)));
        const u32x4 cbw = P[8 + r]; f32x4 va, vb;
        va[0] = (sa + 0 <= l) ? __uint_as_float(cbw.x << 16) * e1a : 0.f; va[1] = (sa + 1 <= l) ? __uint_as_float(cbw.x & 0xffff0000u) * e1a : 0.f;
        va[2] = (sa + 2 <= l) ? __uint_as_float(cbw.y << 16) * e1a : 0.f; va[3] = (sa + 3 <= l) ? __uint_as_float(cbw.y & 0xffff0000u) * e1a : 0.f;
        vb[0] = (sb + 0 <= l) ? __uint_as_float(cbw.z << 16) * e1b : 0.f; vb[1] = (sb + 1 <= l) ? __uint_as_float(cbw.z & 0xffff0000u) * e1b : 0.f;
        vb[2] = (sb + 2 <= l) ? __uint_as_float(cbw.w << 16) * e1b : 0.f; vb[3] = (sb + 3 <= l) ? __uint_as_float(cbw.w & 0xffff0000u) * e1b : 0.f;
        u32x4 w; w.x = cvt_pk_bf16(va[0], va[1]); w.y = cvt_pk_bf16(va[2], va[3]); w.z = cvt_pk_bf16(vb[0], vb[1]); w.w = cvt_pk_bf16(vb[2], vb[3]);
        const int slot = l * 8 + (ch ^ ((l >> 1) & 7));
        *(u32x4*)(img + SL_M + slot * 16) = w;
        *(u32x4*)(img + SL_XT + slot * 16) = P[13 + r];
    }
    if (lt < 48) *(u32x4*)(img + SL_VEC + 16 * lt) = P[10];
}
template <bool DRY>
__device__ __forceinline__ void ssd_ytile_out(const unsigned char* img, const XTile& xt, int lt) {
#pragma unroll
    for (int r = 0; r < 2; ++r) { const int k = lt + 256 * r, p = k >> 3, ch = k & 7;
        const u32x4 w = *(const u32x4*)(img + SL_XT + (p * 8 + (ch ^ ((p >> 1) & 7))) * 16);
        if (!DRY) *(u32x4*)(xt.p + (size_t)p * xt.stride + ch * 8) = w; else KEEP(w); }
}
template <bool DRY>
__device__ void phase_ssd_chain(const Frame& F0, int j) {
    const Frame F = relaunder(F0);
    const unsigned char* sc = (const unsigned char*)F.out;
    const bool loader = F.wave >= 4; const int lt = F.tid - 256, ps = F.wave & 3;
    for (int sh = F.bid; sh < 320; sh += F.G) {
        const int seq = sh < 64 ? (sh >> 5) : 2 + ((sh - 64) >> 5), head = sh & 31;
        const int nch = seq_chunks(seq);
        const float dsk = F.inp(13)[j * SSD_HEADS + head];
        u32x4 P[15];
#pragma unroll
        for (int q = 0; q < 15; ++q) P[q] = (u32x4){0u, 0u, 0u, 0u};
        if (!loader && seq >= 2) {
            const int i = F.lane & 15, g = F.lane >> 4;
            const float* st = F.inp(2) + ((((size_t)j * 8 + (seq - 2)) * SSD_HEADS + head) * SSD_P + ps * 16 + i) * SSD_N + 4 * g;
#pragma unroll
            for (int m8 = 0; m8 < 8; ++m8) P[m8] = *(const u32x4*)(st + 16 * m8);
        }
        __syncthreads();
        if (loader) { ssd_stage_load(P, F, sc, lt, seq, head, 0); ssd_stage_write(P, F.lds, lt); if (nch > 1) ssd_stage_load(P, F, sc, lt, seq, head, 1); }
        __syncthreads();
        for (int c = 0; c < nch; ++c) {
            int cur = (c & 1) * SL_SIZE, nxt = ((c + 1) & 1) * SL_SIZE, lane_ = F.lane, lt_ = lt;
            asm volatile("" : "+s"(cur), "+s"(nxt), "+v"(lane_), "+v"(lt_));
            unsigned char* img = F.lds + cur;
            if (loader) {
                if (c > 0) ssd_ytile_out<DRY>(F.lds + nxt, ssd_xtile(F, seq, c - 1, head), lt_);
                if (c + 1 < nch) ssd_stage_write(P, F.lds + nxt, lt_);
                if (c + 2 < nch) ssd_stage_load(P, F, sc, lt_, seq, head, c + 2);
            } else {
                const int i = lane_ & 15, g = lane_ >> 4, prow = ps * 16 + i, psw = (prow >> 1) & 7;
                const unsigned char* pc[4]; const unsigned char* pm[2];
#pragma unroll
                for (int kk = 0; kk < 4; ++kk) pc[kk] = img + SL_C + i * 256 + (((4 * kk + g) ^ i) * 16);
#pragma unroll
                for (int k2 = 0; k2 < 2; ++k2) pm[k2] = img + i * 128 + (((4 * k2 + g) ^ (i >> 1)) * 16);
                f32x4 e24[4], w4[4], ecs4[4];
#pragma unroll
                for (int m = 0; m < 4; ++m) { e24[m] = *(const f32x4*)(img + SL_VEC + (16 * m + 4 * g) * 4); w4[m] = *(const f32x4*)(img + SL_VEC + 256 + (16 * m + 4 * g) * 4); ecs4[m] = *(const f32x4*)(img + SL_VEC + 512 + (16 * m + 4 * g) * 4); }
                const float ecl = *(const float*)(img + SL_VEC + 512 + 63 * 4);
                bf16x8 Hf[4];
#pragma unroll
                for (int kk = 0; kk < 4; ++kk) Hf[kk] = pack8(__builtin_bit_cast(f32x4, P[2 * kk]), __builtin_bit_cast(f32x4, P[2 * kk + 1]));
                f32x4 Y[4];
#pragma unroll
                for (int m = 0; m < 4; ++m) {
                    f32x4 acc = (f32x4){0.f, 0.f, 0.f, 0.f};
#pragma unroll
                    for (int kk = 0; kk < 4; ++kk) { const bf16x8 cf = *(const bf16x8*)(pc[kk] + m * 4096); acc = __builtin_amdgcn_mfma_f32_16x16x32_bf16(cf, Hf[kk], acc, 0, 0, 0); }
                    Y[m] = acc * ecs4[m];
                }
                f32x4 xv[4];
                unsigned char* xrow = img + SL_XT + prow * 128 + 8 * (g & 1);
#pragma unroll
                for (int m = 0; m < 4; ++m) {
                    const u32x2 xw = *(const u32x2*)(xrow + ((2 * m + (g >> 1)) ^ psw) * 16);
                    xv[m][0] = __uint_as_float(xw.x << 16); xv[m][1] = __uint_as_float(xw.x & 0xffff0000u); xv[m][2] = __uint_as_float(xw.y << 16); xv[m][3] = __uint_as_float(xw.y & 0xffff0000u);
                }
                bf16x8 xsf[2], xwf[2];
#pragma unroll
                for (int k2 = 0; k2 < 2; ++k2) { xsf[k2] = pack8(xv[2 * k2] * e24[2 * k2], xv[2 * k2 + 1] * e24[2 * k2 + 1]); xwf[k2] = pack8(xv[2 * k2] * w4[2 * k2], xv[2 * k2 + 1] * w4[2 * k2 + 1]); }
#pragma unroll
                for (int m = 0; m < 4; ++m)
#pragma unroll
                    for (int k2 = 0; k2 < 2; ++k2) { const bf16x8 mf = *(const bf16x8*)(pm[k2] + SL_M + m * 2048); Y[m] = __builtin_amdgcn_mfma_f32_16x16x32_bf16(mf, xsf[k2], Y[m], 0, 0, 0); }
#pragma unroll
                for (int m8 = 0; m8 < 8; ++m8) {
                    f32x4 acc = __builtin_bit_cast(f32x4, P[m8]) * ecl;
#pragma unroll
                    for (int k2 = 0; k2 < 2; ++k2) { const bf16x8 bf = *(const bf16x8*)(pm[k2] + SL_BT + m8 * 2048); acc = __builtin_amdgcn_mfma_f32_16x16x32_bf16(bf, xwf[k2], acc, 0, 0, 0); }
                    P[m8] = __builtin_bit_cast(u32x4, acc);
                }
#pragma unroll
                for (int m = 0; m < 4; ++m) {
                    const f32x4 y = Y[m] + xv[m] * dsk; u32x2 w; w.x = cvt_pk_bf16(y[0], y[1]); w.y = cvt_pk_bf16(y[2], y[3]);
                    *(u32x2*)(xrow + ((2 * m + (g >> 1)) ^ psw) * 16) = w;
                }
            }
            __syncthreads();
        }
        if (loader) ssd_ytile_out<DRY>(F.lds + ((nch - 1) & 1) * SL_SIZE, ssd_xtile(F, seq, nch - 1, head), lt);
        else {
            const int i = F.lane & 15, g = F.lane >> 4;
            float* so = (seq < 2) ? F.out + O_PSSD + ((((size_t)j * 2 + seq) * SSD_HEADS + head) * SSD_P + ps * 16 + i) * SSD_N + 4 * g
                                  : F.out + O_SSSD + ((((size_t)j * 8 + (seq - 2)) * SSD_HEADS + head) * SSD_P + ps * 16 + i) * SSD_N + 4 * g;
#pragma unroll
            for (int m8 = 0; m8 < 8; ++m8) { if (!DRY) *(u32x4*)(so + 16 * m8) = P[m8]; else KEEP(P[m8]); }
        }
    }
}

__device__ void phase_ssd_post(const Frame& F0, int j) {
    const Frame F = relaunder(F0);
    constexpr int RS = 68;
    bf16_t* YT = (bf16_t*)F.lds;
    for (int task = F.bid; task < NCHT * 4; task += F.G) {
        const int cgi = task >> 2, grp = task & 3; int seq, c; chunk_of(cgi, seq, c);
        const int base = seq_base(seq), t0 = 64 * c - PADF;
        __syncthreads();
#pragma unroll
        for (int r = 0; r < 8; ++r) {
            const int k = F.tid + 512 * r, hl = k >> 9, p = (k >> 3) & 63, ch = k & 7;
            const XTile xt = ssd_xtile(F, seq, c, grp * 8 + hl);
            const u32x4 w = *(const u32x4*)(xt.p + (size_t)p * xt.stride + ch * 8);
            u32x2* d = (u32x2*)(YT + (hl * 64 + p) * RS + ch * 8); u32x2 a, b; a.x = w.x; a.y = w.y; b.x = w.z; b.y = w.w; d[0] = a; d[1] = b;
        }
        __syncthreads();
        for (int q = 0; q < 8; ++q) {
            const int l = F.wave + 8 * q, t = t0 + l;
            if (t < 0 && seq >= 2) continue;
            const int row = seq < 2 ? seq * TPP + 64 * c + l : base + t;
            bf16_t* zrow = F.proj + (size_t)row * LDP + grp * 512 + F.lane;
            float yg[8]; float ss = 0.f;
#pragma unroll
            for (int e = 0; e < 8; ++e) { const float y = bf2f(YT[(e * 64 + F.lane) * RS + l]), z = bf2f(zrow[64 * e]); yg[e] = y * silu_f(z); ss += yg[e] * yg[e]; }
            ss = wave_sum(ss);
            const float rs = rsqrtf(ss * (1.0f / 512.0f) + EPS);
#pragma unroll
            for (int e = 0; e < 8; ++e) zrow[64 * e] = f2bf(yg[e] * rs);
        }
    }
    for (int e = F.bid * NTHREADS + F.tid; e < NSEQ * 3 * SSD_CONV; e += F.G * NTHREADS) {
        const int s = e / (3 * SSD_CONV), r = (e / SSD_CONV) % 3, c = e % SSD_CONV;
        const int row = seq_base(s) + seq_len(s) - 3 + r;
        float v;
        if (s < 2 && c < 2048) v = bf2f(F.tails[((size_t)(s * 129 + 128) * 3 + r) * 4096 + c]);
        else v = bf2f(F.proj[(size_t)row * LDP + 2048 + c]);
        if (s < 2) F.out[O_PSSDC + (((size_t)j * 2 + s) * 3 + r) * SSD_CONV + c] = v;
        else F.out[O_SSSDC + (((size_t)j * 8 + (s - 2)) * 3 + r) * SSD_CONV + c] = v;
    }
}

constexpr size_t SG_W = 0;
constexpr size_t SG_QK = SG_W + (size_t)NCHT * 8 * 16384;
constexpr size_t SG_VEC = SG_QK + (size_t)NCHT * 8 * 8192;
constexpr size_t SG_PART = SG_VEC + (size_t)NCHT * 8 * 1024;
constexpr size_t SG_SIDE = SG_PART + (size_t)M_TOT * 128 * 2;
constexpr size_t SG_END = SG_SIDE + (size_t)64 * 65536;
static_assert(SG_END <= (size_t)16777216 * 4, "scratch must fit the y_prompt region");
struct GTile { bf16_t* q; bf16_t* k; bf16_t* v; int sq, sk, sv; };
__device__ __forceinline__ GTile gdn_tile(const Frame& F, int seq, int c, int head) {
    GTile t;
    if (seq < 2) { bf16_t* r0 = F.proj + (size_t)(seq * TPP + 64 * c) * LDP; t.q = r0 + head * 128; t.k = r0 + 1024 + head * 128; t.v = r0 + 2048 + head * 256; t.sq = LDP; t.sk = LDP; t.sv = LDP; }
    else { bf16_t* b = (bf16_t*)((unsigned char*)F.out + SG_SIDE) + (size_t)((seq - 2) * 8 + head) * 32768; t.q = b; t.k = b + 8192; t.v = b + 16384; t.sq = 128; t.sk = 128; t.sv = 256; }
    return t;
}

template <bool DRY>
__device__ void phase_gdn_prep(const Frame& F0, int j) {
    const Frame F = relaunder(F0);
    float* Am = (float*)F.lds;
    float* vgc = Am + 64 * 68;
    float* vbe = vgc + 64;
    float* vnq = vbe + 64;
    float* vnk = vnq + 64;
    bf16_t* qs = (bf16_t*)(vnk + 64);
    bf16_t* ks = qs + 64 * 136;
    bf16_t* kT = ks + 64 * 136;
    bf16_t* vT = kT + 128 * 72;
    bf16_t* Tb = vT + 256 * 72;
    unsigned char* sc = (unsigned char*)F.out;
    const float* conv_w = F.inp(18) + (size_t)j * 4 * GDN_CONV;
    const int i16 = F.lane & 15, g4 = F.lane >> 4;
    constexpr float CQ = 0.08838834764831845f;
    for (int task = F.bid; task < NCHT * 8; task += F.G) {
        const int cgi = task >> 3, head = task & 7; int seq, c; chunk_of(cgi, seq, c);
        const int base = seq_base(seq), t0 = 64 * c - PADF;
        const GTile tl = gdn_tile(F, seq, c, head);
        __syncthreads();
        if (F.wave == 0) {
            const int t = t0 + F.lane; float gg = 0.f, be = 0.f;
            if (t >= 0) { const float* dp = F.dtb + (size_t)(base + t) * 32; gg = -__expf(F.inp(20)[j * GDN_HEADS + head]) * softplus_f(dp[head] + F.inp(19)[j * GDN_HEADS + head]); be = 1.0f / (1.0f + __expf(-dp[8 + head])); }
#pragma unroll
            for (int o = 1; o < 64; o <<= 1) { const float y = __shfl_up(gg, o); if (F.lane >= o) gg += y; }
            vgc[F.lane] = gg; vbe[F.lane] = be;
        }
        __syncthreads();
        {
            const int ch = F.tid;
            const int cidx = ch < 128 ? head * 128 + ch : (ch < 256 ? 1024 + head * 128 + (ch - 128) : 2048 + head * 256 + (ch - 256));
            const float w0 = conv_w[cidx], w1 = conv_w[GDN_CONV + cidx], w2 = conv_w[2 * GDN_CONV + cidx], w3 = conv_w[3 * GDN_CONV + cidx];
            const float* cst = (seq >= 2) ? F.inp(5) + (((size_t)j * 8 + (seq - 2)) * 3) * GDN_CONV + cidx : nullptr;
            const bf16_t* tailp = (seq < 2 && c > 0) ? F.tails + (size_t)(cgi - 1) * 3 * 4096 + cidx : nullptr;
            float r3 = 0.f, r2 = 0.f, r1 = 0.f;
            if (tailp) { r3 = bf2f(tailp[0]); r2 = bf2f(tailp[4096]); r1 = bf2f(tailp[2 * 4096]); }
            for (int p = 0; p < 64; ++p) {
                const int t = t0 + p; float x = 0.f;
                if (t >= 0) x = bf2f(F.proj[(size_t)(base + t) * LDP + cidx]); else if (t >= -3 && cst) x = cst[(3 + t) * GDN_CONV];
                const float o = silu_f(w0 * r3 + w1 * r2 + w2 * r1 + w3 * x);
                r3 = r2; r2 = r1; r1 = x;
                if (ch < 128) qs[p * 136 + ch] = f2bf(o);
                else if (ch < 256) { const bf16_t b = f2bf(o); ks[p * 136 + (ch - 128)] = b; kT[(ch - 128) * 72 + p] = b; }
                else vT[(ch - 256) * 72 + p] = f2bf(o * vbe[p]);
            }
        }
        __syncthreads();
        if (F.tid < 128) {
            const int l = F.tid & 63; const bf16_t* rowp = (F.tid < 64 ? qs : ks) + l * 136; float ss = 0.f;
#pragma unroll
            for (int q = 0; q < 16; ++q) { const u32x4 v = *(const u32x4*)(rowp + 8 * q);
                const float a0 = __uint_as_float(v.x << 16), a1 = __uint_as_float(v.x & 0xffff0000u), a2 = __uint_as_float(v.y << 16), a3 = __uint_as_float(v.y & 0xffff0000u);
                const float a4 = __uint_as_float(v.z << 16), a5 = __uint_as_float(v.z & 0xffff0000u), a6 = __uint_as_float(v.w << 16), a7 = __uint_as_float(v.w & 0xffff0000u);
                ss += ((a0 * a0 + a1 * a1) + (a2 * a2 + a3 * a3)) + ((a4 * a4 + a5 * a5) + (a6 * a6 + a7 * a7)); }
            (F.tid < 64 ? vnq : vnk)[l] = rsqrtf(ss + EPS);
        }
        __syncthreads();
        {
            bf16_t* QKg = (bf16_t*)(sc + SG_QK) + (size_t)task * 4096;
            const int m = F.wave >> 1;
#pragma unroll
            for (int u = 0; u < 2; ++u) {
                const int st = 2 * (F.wave & 1) + u; f32x4 aK = (f32x4){0.f, 0.f, 0.f, 0.f}, aQ = (f32x4){0.f, 0.f, 0.f, 0.f};
#pragma unroll
                for (int kk = 0; kk < 4; ++kk) {
                    const bf16x8 ak = *(const bf16x8*)(ks + (16 * m + i16) * 136 + 32 * kk + 8 * g4);
                    const bf16x8 aq = *(const bf16x8*)(qs + (16 * m + i16) * 136 + 32 * kk + 8 * g4);
                    const bf16x8 b = *(const bf16x8*)(ks + (16 * st + i16) * 136 + 32 * kk + 8 * g4);
                    aK = __builtin_amdgcn_mfma_f32_16x16x32_bf16(ak, b, aK, 0, 0, 0);
                    aQ = __builtin_amdgcn_mfma_f32_16x16x32_bf16(aq, b, aQ, 0, 0, 0);
                }
                const int s_ = 16 * st + i16; const float gs = vgc[s_], nks = vnk[s_]; const int qs_ = qperm(s_);
#pragma unroll
                for (int jj = 0; jj < 4; ++jj) {
                    const int l = 16 * m + 4 * g4 + jj;
                    const float dec = (s_ <= l) ? __expf(vgc[l] - gs) : 0.f;
                    Am[l * 68 + s_] = (s_ < l) ? vbe[l] * vnk[l] * nks * aK[jj] * dec : 0.f;
                    { const float r = CQ * vnq[l] * nks * aQ[jj] * dec; if (!DRY) QKg[l * 64 + qs_] = f2bf(r); else KEEP(r); }
                }
            }
        }
        __syncthreads();
        if (F.wave == 0) {
            int cc = F.lane; asm volatile("" : "+v"(cc));
            float x[64];
#pragma unroll
            for (int l = 0; l < 64; ++l) {
                float a0 = (l == cc) ? 1.f : 0.f, a1 = 0.f, a2 = 0.f, a3 = 0.f;
#pragma unroll
                for (int s4 = 0; s4 + 4 <= l; s4 += 4) { const f32x4 av = *(const f32x4*)(Am + l * 68 + s4); a0 -= av[0] * x[s4]; a1 -= av[1] * x[s4 + 1]; a2 -= av[2] * x[s4 + 2]; a3 -= av[3] * x[s4 + 3]; }
                if (l & 3) { const f32x4 av = *(const f32x4*)(Am + l * 68 + (l & ~3));
                    a0 -= av[0] * x[l & ~3]; if ((l & 3) > 1) a1 -= av[1] * x[(l & ~3) + 1]; if ((l & 3) > 2) a2 -= av[2] * x[(l & ~3) + 2]; }
                x[l] = (a0 + a1) + (a2 + a3);
            }
            const float csc = vbe[cc] * __expf(vgc[cc]) * vnk[cc];
#pragma unroll
            for (int l = 0; l < 64; ++l) { Tb[l * 72 + cc] = f2bf(x[l]); Tb[64 * 72 + l * 72 + cc] = f2bf(x[l] * csc); }
        } else {
            const int t7 = F.tid - 64;
            for (int idx = t7; idx < 1024; idx += 448) {
                const int l = idx >> 4, qg8 = idx & 15, kk = qg8 >> 2, gg = qg8 & 3;
                const u32x2 a = *(const u32x2*)(qs + l * 136 + 32 * kk + 4 * gg), b = *(const u32x2*)(qs + l * 136 + 32 * kk + 16 + 4 * gg);
                u32x4 w; w.x = a.x; w.y = a.y; w.z = b.x; w.w = b.y;
                if (!DRY) *(u32x4*)(tl.q + (size_t)l * tl.sq + 8 * qg8) = w; else KEEP(w);
            }
            for (int idx = t7; idx < 1024; idx += 448) {
                const int kd = idx >> 3, pg = idx & 7, kk2 = pg >> 2, gg = pg & 3;
                const u32x2 a = *(const u32x2*)(kT + kd * 72 + 32 * kk2 + 4 * gg), b = *(const u32x2*)(kT + kd * 72 + 32 * kk2 + 16 + 4 * gg);
                u32x4 w; w.x = a.x; w.y = a.y; w.z = b.x; w.w = b.y;
                if (!DRY) *(u32x4*)(tl.k + (size_t)(kd >> 1) * tl.sk + (kd & 1) * 64 + 8 * pg) = w; else KEEP(w);
            }
            if (t7 < 64) {
                float* vp = (float*)(sc + SG_VEC) + (size_t)task * 256; const float gl = vgc[63];
                const float v0 = __expf(vgc[t7]) * CQ * vnq[t7], v1 = vnk[t7] * __expf(gl - vgc[t7]), v2 = __expf(gl);
                if (!DRY) { vp[t7] = v0; vp[64 + t7] = v1; vp[128 + t7] = v2; vp[192 + t7] = 0.f; } else { KEEP(v0); KEEP(v1); KEEP(v2); }
            }
        }
        __syncthreads();
        {
            bf16_t* Wg = (bf16_t*)(sc + SG_W) + (size_t)task * 8192;
            bf16x8 bk[2];
#pragma unroll
            for (int k2 = 0; k2 < 2; ++k2) bk[k2] = *(const bf16x8*)(kT + (16 * F.wave + i16) * 72 + 32 * k2 + 8 * g4);
            const int qkd = qperm(16 * F.wave + i16);
#pragma unroll
            for (int m = 0; m < 4; ++m) {
                f32x4 acc = (f32x4){0.f, 0.f, 0.f, 0.f};
#pragma unroll
                for (int k2 = 0; k2 < 2; ++k2) { const bf16x8 a = *(const bf16x8*)(Tb + 64 * 72 + (16 * m + i16) * 72 + 32 * k2 + 8 * g4); acc = __builtin_amdgcn_mfma_f32_16x16x32_bf16(a, bk[k2], acc, 0, 0, 0); }
#pragma unroll
                for (int jj = 0; jj < 4; ++jj) { if (!DRY) Wg[(16 * m + 4 * g4 + jj) * 128 + qkd] = f2bf(acc[jj]); else KEEP(acc[jj]); }
            }
#pragma unroll
            for (int u = 0; u < 2; ++u) {
                const int v = 16 * (2 * F.wave + u) + i16;
                bf16x8 bv[2];
#pragma unroll
                for (int k2 = 0; k2 < 2; ++k2) bv[k2] = *(const bf16x8*)(vT + v * 72 + 32 * k2 + 8 * g4);
#pragma unroll
                for (int m = 0; m < 4; ++m) {
                    f32x4 acc = (f32x4){0.f, 0.f, 0.f, 0.f};
#pragma unroll
                    for (int k2 = 0; k2 < 2; ++k2) { const bf16x8 a = *(const bf16x8*)(Tb + (16 * m + i16) * 72 + 32 * k2 + 8 * g4); acc = __builtin_amdgcn_mfma_f32_16x16x32_bf16(a, bv[k2], acc, 0, 0, 0); }
                    u32x2 w; w.x = cvt_pk_bf16(acc[0], acc[1]); w.y = cvt_pk_bf16(acc[2], acc[3]);
                    if (!DRY) *(u32x2*)(tl.v + (size_t)(v >> 2) * tl.sv + (v & 3) * 64 + 16 * m + 4 * g4) = w; else KEEP(w);
                }
            }
        }
    }
}

constexpr int GL_W = 0, GL_Q = 16384, GL_KT = 32768, GL_QK = 49152, GL_U = 57344, GL_VEC = 65536, GL_SIZE = 66560;
__device__ __forceinline__ bf16_t* gdn_urow(const GTile& tl, int v) { return tl.v + (size_t)(v >> 2) * tl.sv + (v & 3) * 64; }
__device__ __forceinline__ void gdn_stage_load(u32x4 (&P)[17], const Frame& F, const unsigned char* sc, int lt, int seq, int head, int vq, int c) {
    const int task = cgi_of(seq, c) * 8 + head;
    const GTile tl = gdn_tile(F, seq, c, head);
    const bf16_t* Wp = (const bf16_t*)(sc + SG_W) + (size_t)task * 8192;
    const bf16_t* QKp = (const bf16_t*)(sc + SG_QK) + (size_t)task * 4096;
    const float* vp = (const float*)(sc + SG_VEC) + (size_t)task * 256;
#pragma unroll
    for (int r = 0; r < 4; ++r) { const int k = lt + 256 * r;
        P[r] = *(const u32x4*)(Wp + k * 8);
        P[4 + r] = *(const u32x4*)(tl.q + (size_t)(k >> 4) * tl.sq + (k & 15) * 8);
        { const int kd = k >> 3; P[8 + r] = *(const u32x4*)(tl.k + (size_t)(kd >> 1) * tl.sk + (kd & 1) * 64 + (k & 7) * 8); } }
#pragma unroll
    for (int r = 0; r < 2; ++r) { const int k = lt + 256 * r;
        P[12 + r] = *(const u32x4*)(QKp + k * 8);
        P[14 + r] = *(const u32x4*)(gdn_urow(tl, vq * 64 + (k >> 3)) + (k & 7) * 8); }
    P[16] = *(const u32x4*)(vp + 4 * (lt < 48 ? lt : 0));
}
__device__ __forceinline__ void gdn_stage_write(const u32x4 (&P)[17], unsigned char* img, int lt) {
#pragma unroll
    for (int r = 0; r < 4; ++r) { const int k = lt + 256 * r;
        { const int row = k >> 4, ch = k & 15, slot = row * 16 + (ch ^ (row & 15)); *(u32x4*)(img + GL_W + slot * 16) = P[r]; *(u32x4*)(img + GL_Q + slot * 16) = P[4 + r]; }
        { const int row = k >> 3, ch = k & 7; *(u32x4*)(img + GL_KT + (row * 8 + (ch ^ ((row >> 1) & 7))) * 16) = P[8 + r]; } }
#pragma unroll
    for (int r = 0; r < 2; ++r) { const int k = lt + 256 * r, row = k >> 3, ch = k & 7, slot = row * 8 + (ch ^ ((row >> 1) & 7));
        *(u32x4*)(img + GL_QK + slot * 16) = P[12 + r]; *(u32x4*)(img + GL_U + slot * 16) = P[14 + r]; }
    if (lt < 48) *(u32x4*)(img + GL_VEC + 16 * lt) = P[16];
}
template <bool DRY>
__device__ __forceinline__ void gdn_otile_out(const unsigned char* img, const GTile& tl, int vq, int lt) {
#pragma unroll
    for (int r = 0; r < 2; ++r) { const int k = lt + 256 * r, row = k >> 3, ch = k & 7;
        const u32x4 w = *(const u32x4*)(img + GL_U + (row * 8 + (ch ^ ((row >> 1) & 7))) * 16);
        if (!DRY) *(u32x4*)(gdn_urow(tl, vq * 64 + row) + ch * 8) = w; else KEEP(w); }
}
template <bool DRY>
__device__ void phase_gdn_chain(const Frame& F0, int j) {
    const Frame F = relaunder(F0);
    const unsigned char* sc = (const unsigned char*)F.out;
    const bool loader = F.wave >= 4; const int lt = F.tid - 256, w4 = F.wave & 3;
    for (int sh = F.bid; sh < 320; sh += F.G) {
        const int seq = sh < 64 ? (sh >> 5) : 2 + ((sh - 64) >> 5), head = (sh >> 2) & 7, vq = sh & 3;
        const int nch = seq_chunks(seq);
        u32x4 P[17];
#pragma unroll
        for (int q = 0; q < 17; ++q) P[q] = (u32x4){0u, 0u, 0u, 0u};
        if (!loader && seq >= 2) {
            const int i = F.lane & 15, g = F.lane >> 4;
            const float* st = F.inp(4) + (((size_t)j * 8 + (seq - 2)) * GDN_HEADS + head) * GDN_DK * GDN_DV + vq * 64 + w4 * 16 + i;
#pragma unroll
            for (int m8 = 0; m8 < 8; ++m8)
#pragma unroll
                for (int jj = 0; jj < 4; ++jj) P[m8][jj] = __float_as_uint(st[(size_t)(16 * m8 + 4 * g + jj) * GDN_DV]);
        }
        __syncthreads();
        if (loader) { gdn_stage_load(P, F, sc, lt, seq, head, vq, 0); gdn_stage_write(P, F.lds, lt); if (nch > 1) gdn_stage_load(P, F, sc, lt, seq, head, vq, 1); }
        __syncthreads();
        for (int c = 0; c < nch; ++c) {
            int cur = (c & 1) * GL_SIZE, nxt = ((c + 1) & 1) * GL_SIZE, lane_ = F.lane, lt_ = lt;
            asm volatile("" : "+s"(cur), "+s"(nxt), "+v"(lane_), "+v"(lt_));
            unsigned char* img = F.lds + cur;
            if (loader) {
                if (c > 0) gdn_otile_out<DRY>(F.lds + nxt, gdn_tile(F, seq, c - 1, head), vq, lt_);
                if (c + 1 < nch) gdn_stage_write(P, F.lds + nxt, lt_);
                if (c + 2 < nch) gdn_stage_load(P, F, sc, lt_, seq, head, vq, c + 2);
            } else {
                const int i = lane_ & 15, g = lane_ >> 4, vrow = w4 * 16 + i, vsw = (vrow >> 1) & 7;
                const unsigned char* pw[4]; const unsigned char* pk[2];
#pragma unroll
                for (int kk = 0; kk < 4; ++kk) pw[kk] = img + i * 256 + (((4 * kk + g) ^ i) * 16);
#pragma unroll
                for (int k2 = 0; k2 < 2; ++k2) pk[k2] = img + i * 128 + (((4 * k2 + g) ^ (i >> 1)) * 16);
                f32x4 rsc[4], vsc[4];
#pragma unroll
                for (int m = 0; m < 4; ++m) { rsc[m] = *(const f32x4*)(img + GL_VEC + (16 * m + 4 * g) * 4); vsc[m] = *(const f32x4*)(img + GL_VEC + 256 + (16 * m + 4 * g) * 4); }
                const float egl = *(const float*)(img + GL_VEC + 512);
                bf16x8 Sf[4];
#pragma unroll
                for (int kk = 0; kk < 4; ++kk) Sf[kk] = pack8(__builtin_bit_cast(f32x4, P[2 * kk]), __builtin_bit_cast(f32x4, P[2 * kk + 1]));
                unsigned char* urow = img + GL_U + vrow * 128 + 8 * (g & 1);
                f32x4 vn[4], O[4];
#pragma unroll
                for (int m = 0; m < 4; ++m) {
                    f32x4 a1 = (f32x4){0.f, 0.f, 0.f, 0.f}, a2 = (f32x4){0.f, 0.f, 0.f, 0.f};
#pragma unroll
                    for (int kk = 0; kk < 4; ++kk) {
                        const bf16x8 wf = *(const bf16x8*)(pw[kk] + GL_W + m * 4096), qf = *(const bf16x8*)(pw[kk] + GL_Q + m * 4096);
                        a1 = __builtin_amdgcn_mfma_f32_16x16x32_bf16(wf, Sf[kk], a1, 0, 0, 0);
                        a2 = __builtin_amdgcn_mfma_f32_16x16x32_bf16(qf, Sf[kk], a2, 0, 0, 0);
                    }
                    const u32x2 uw = *(const u32x2*)(urow + ((2 * m + (g >> 1)) ^ vsw) * 16);
                    vn[m][0] = __uint_as_float(uw.x << 16) - a1[0]; vn[m][1] = __uint_as_float(uw.x & 0xffff0000u) - a1[1];
                    vn[m][2] = __uint_as_float(uw.y << 16) - a1[2]; vn[m][3] = __uint_as_float(uw.y & 0xffff0000u) - a1[3];
                    O[m] = a2 * rsc[m];
                }
                bf16x8 Vf[2], Vsf[2];
#pragma unroll
                for (int k2 = 0; k2 < 2; ++k2) { Vf[k2] = pack8(vn[2 * k2], vn[2 * k2 + 1]); Vsf[k2] = pack8(vn[2 * k2] * vsc[2 * k2], vn[2 * k2 + 1] * vsc[2 * k2 + 1]); }
#pragma unroll
                for (int m = 0; m < 4; ++m)
#pragma unroll
                    for (int k2 = 0; k2 < 2; ++k2) { const bf16x8 qk = *(const bf16x8*)(pk[k2] + GL_QK + m * 2048); O[m] = __builtin_amdgcn_mfma_f32_16x16x32_bf16(qk, Vf[k2], O[m], 0, 0, 0); }
#pragma unroll
                for (int m8 = 0; m8 < 8; ++m8) {
                    f32x4 acc = __builtin_bit_cast(f32x4, P[m8]) * egl;
#pragma unroll
                    for (int k2 = 0; k2 < 2; ++k2) { const bf16x8 kf = *(const bf16x8*)(pk[k2] + GL_KT + m8 * 2048); acc = __builtin_amdgcn_mfma_f32_16x16x32_bf16(kf, Vsf[k2], acc, 0, 0, 0); }
                    P[m8] = __builtin_bit_cast(u32x4, acc);
                }
#pragma unroll
                for (int m = 0; m < 4; ++m) { u32x2 w; w.x = cvt_pk_bf16(O[m][0], O[m][1]); w.y = cvt_pk_bf16(O[m][2], O[m][3]); *(u32x2*)(urow + ((2 * m + (g >> 1)) ^ vsw) * 16) = w; }
            }
            __syncthreads();
        }
        if (loader) gdn_otile_out<DRY>(F.lds + ((nch - 1) & 1) * GL_SIZE, gdn_tile(F, seq, nch - 1, head), vq, lt);
        else {
            const int i = F.lane & 15, g = F.lane >> 4, vcol = vq * 64 + w4 * 16 + i;
            float* so = (seq < 2) ? F.out + O_PGDN + (((size_t)j * 2 + seq) * GDN_HEADS + head) * GDN_DK * GDN_DV + vcol
                                  : F.out + O_SGDN + (((size_t)j * 8 + (seq - 2)) * GDN_HEADS + head) * GDN_DK * GDN_DV + vcol;
#pragma unroll
            for (int m8 = 0; m8 < 8; ++m8)
#pragma unroll
                for (int jj = 0; jj < 4; ++jj) { if (!DRY) so[(size_t)(16 * m8 + 4 * g + jj) * GDN_DV] = __uint_as_float(P[m8][jj]); else KEEP(P[m8][jj]); }
        }
    }
}

__device__ void phase_gdn_post2(const Frame& F0, int j) {
    const Frame F = relaunder(F0);
    constexpr int RS = 68;
    bf16_t* OT = (bf16_t*)F.lds;
    for (int task = F.bid; task < NCHT * 8; task += F.G) {
        const int cgi = task >> 3, head = task & 7; int seq, c; chunk_of(cgi, seq, c);
        const int base = seq_base(seq), t0 = 64 * c - PADF;
        const GTile tl = gdn_tile(F, seq, c, head);
        __syncthreads();
#pragma unroll
        for (int r = 0; r < 4; ++r) {
            const int k = F.tid + 512 * r, v = k >> 3, ch = k & 7;
            const u32x4 w = *(const u32x4*)(gdn_urow(tl, v) + ch * 8);
            u32x2* d = (u32x2*)(OT + v * RS + ch * 8); u32x2 a, b; a.x = w.x; a.y = w.y; b.x = w.z; b.y = w.w; d[0] = a; d[1] = b;
        }
        __syncthreads();
        for (int q = 0; q < 8; ++q) {
            const int l = F.wave + 8 * q, t = t0 + l;
            if (t < 0 && seq >= 2) continue;
            const int row = seq < 2 ? seq * TPP + 64 * c + l : base + t;
            bf16_t* zrow = F.proj + (size_t)row * LDP + 4096 + head * 256 + F.lane;
            float o[4]; float ss = 0.f;
#pragma unroll
            for (int e = 0; e < 4; ++e) { o[e] = bf2f(OT[(64 * e + F.lane) * RS + l]); ss += o[e] * o[e]; }
            ss = wave_sum(ss);
            const float rs = rsqrtf(ss * (1.0f / 256.0f) + EPS);
#pragma unroll
            for (int e = 0; e < 4; ++e) { const float z = bf2f(zrow[64 * e]); zrow[64 * e] = f2bf(o[e] * rs * silu_f(z)); }
        }
    }
    for (int e = F.bid * NTHREADS + F.tid; e < NSEQ * 3 * GDN_CONV; e += F.G * NTHREADS) {
        const int s = e / (3 * GDN_CONV), r = (e / GDN_CONV) % 3, c = e % GDN_CONV;
        if (s < 2) F.out[O_PGDNC + (((size_t)j * 2 + s) * 3 + r) * GDN_CONV + c] = bf2f(F.tails[((size_t)(s * 129 + 128) * 3 + r) * 4096 + c]);
        else F.out[O_SGDNC + (((size_t)j * 8 + (s - 2)) * 3 + r) * GDN_CONV + c] = bf2f(F.proj[(size_t)(seq_base(s) + 13 + r) * LDP + c]);
    }
}

__device__ void phase_final(const Frame& F0) {
    const Frame F = relaunder(F0);
    const float* fw = F.inp(23);
    for (int it = F.bid * 8 + F.wave; it < 2 * SEQ + 128; it += F.G * 8) {
        int row; float* dst;
        if (it < 2 * SEQ) { const int b = it / SEQ, t = it % SEQ; row = b * TPP + 64 + t; dst = F.out + O_YP + (size_t)it * D; }
        else { row = ROW_S0 + (it - 2 * SEQ); dst = F.out + O_YS + (size_t)(it - 2 * SEQ) * D; }
        float x[16]; float ss = 0.f;
#pragma unroll
        for (int i = 0; i < 4; ++i) {
            const u32x2 v = *(const u32x2*)(F.hb + (size_t)row * D + (F.lane + 64 * i) * 4);
            x[4 * i + 0] = __uint_as_float(v.x << 16); x[4 * i + 1] = __uint_as_float(v.x & 0xffff0000u); x[4 * i + 2] = __uint_as_float(v.y << 16); x[4 * i + 3] = __uint_as_float(v.y & 0xffff0000u);
            ss += (x[4 * i] * x[4 * i] + x[4 * i + 1] * x[4 * i + 1]) + (x[4 * i + 2] * x[4 * i + 2] + x[4 * i + 3] * x[4 * i + 3]);
        }
        ss = wave_sum(ss);
        const float rs = rsqrtf(ss * (1.0f / 1024.0f) + EPS);
#pragma unroll
        for (int i = 0; i < 4; ++i) {
            const int c = (F.lane + 64 * i) * 4; const f32x4 w = *(const f32x4*)(fw + c);
            f32x4 o; o[0] = x[4 * i] * rs * w[0]; o[1] = x[4 * i + 1] * rs * w[1]; o[2] = x[4 * i + 2] * rs * w[2]; o[3] = x[4 * i + 3] * rs * w[3];
            *(f32x4*)(dst + c) = o;
        }
    }
}

constexpr int N_PHASES = 22;
#ifndef REP_INPROJ
#define REP_INPROJ 1
#endif
#ifndef REP_SSD_PREP
#define REP_SSD_PREP 1
#endif
#ifndef REP_SSD_CHAIN
#define REP_SSD_CHAIN 1
#endif
#ifndef REP_GDN_PREP
#define REP_GDN_PREP 1
#endif
#ifndef REP_GDN_CHAIN
#define REP_GDN_CHAIN 1
#endif
#ifndef MK_ONE_LAUNCH
#define MK_ONE_LAUNCH 1
#endif
__global__ void __launch_bounds__(NTHREADS, 2) hybrid_fwd(Args args) {
    extern __shared__ __attribute__((aligned(16))) unsigned char lds[];
    volatile LAS unsigned* bst = (volatile LAS unsigned*)((LAS unsigned char*)lds + LDS_BYTES - 16);
    if (threadIdx.x < 4) bst[threadIdx.x] = 0u;
    __syncthreads();
    XcdBarrier bar; bar.bar = (unsigned*)(args.ws + WS_CTL); bar.x = 0; bar.st = bst;
    if (args.ph_hi - args.ph_lo > 1) bar = xcd_barrier_post((unsigned*)(args.ws + WS_CTL), bst);
    for (int ph = args.ph_lo; ph < args.ph_hi; ++ph) {
        int tid_ = threadIdx.x; asm volatile("" : "+v"(tid_));
        Frame F;
        F.ap = &args;
        F.out = args.out; F.ws = args.ws; F.lds = lds; F.ldsl = (LAS unsigned char*)lds;
        F.tid = tid_; F.lane = F.tid & 63; F.wave = __builtin_amdgcn_readfirstlane(F.tid >> 6); F.G = gridDim.x; F.bid = blockIdx.x;
        F.hb = nullptr; F.win = nullptr; F.wout = nullptr; F.dtb = nullptr; F.rss = nullptr; F.proj = nullptr; F.tails = nullptr;
        if (ph == 0) { phase_init_h(F); phase_wprep_in(F, 0); }
        else if (ph == N_PHASES - 1) phase_final(F);
        else {
            const int L = (ph - 1) / 5, sub = (ph - 1) % 5, j = L >> 1;
            if (sub == 0) { for (int r = 0; r < REP_INPROJ; ++r) phase_inproj(F, L); }
            else if (sub == 1) {
                if (L & 1) { for (int r = 1; r < REP_GDN_PREP; ++r) phase_gdn_prep<true>(F, j); phase_gdn_prep<false>(F, j); }
                else { for (int r = 1; r < REP_SSD_PREP; ++r) phase_ssd_prep<true>(F, j); phase_ssd_prep<false>(F, j); }
                phase_wprep_out(F, L); }
            else if (sub == 2) {
                if (L & 1) { for (int r = 1; r < REP_GDN_CHAIN; ++r) phase_gdn_chain<true>(F, j); phase_gdn_chain<false>(F, j); }
                else { for (int r = 1; r < REP_SSD_CHAIN; ++r) phase_ssd_chain<true>(F, j); phase_ssd_chain<false>(F, j); } }
            else if (sub == 3) { if (L & 1) phase_gdn_post2(F, j); else phase_ssd_post(F, j); if (L < 3) phase_wprep_in(F, L + 1); }
            else phase_outproj(F, L);
        }
        if (ph + 1 < args.ph_hi) {
            if (ph == args.ph_lo) { __threadfence(); cg::this_grid().sync(); }
            else xcd_barrier(bar);
        }
    }
}

extern "C" void kernel_launch(void* const* d_in, const int* in_sizes, int n_in, void* d_out, int out_size, void* d_ws, size_t ws_size, hipStream_t stream) {
    static int grid = 0;
    if (grid == 0) {
        if (n_in != 24 || ws_size < WS_END) { fprintf(stderr, "kernel_launch: unexpected n_in %d / ws %zu (need %zu)\n", n_in, ws_size, (size_t)WS_END); grid = -1; return; }
        int dev = 0, cus = 0, per_cu = 0;
        if (hipGetDevice(&dev) != hipSuccess || hipDeviceGetAttribute(&cus, hipDeviceAttributeMultiprocessorCount, dev) != hipSuccess) { grid = -1; return; }
        if (hipFuncSetAttribute((const void*)hybrid_fwd, hipFuncAttributeMaxDynamicSharedMemorySize, LDS_BYTES) != hipSuccess) { fprintf(stderr, "kernel_launch: hipFuncSetAttribute failed\n"); grid = -1; return; }
        if (hipOccupancyMaxActiveBlocksPerMultiprocessor(&per_cu, (const void*)hybrid_fwd, NTHREADS, LDS_BYTES) != hipSuccess || per_cu < 1) { fprintf(stderr, "kernel_launch: occupancy query says %d blocks per CU\n", per_cu); grid = -1; return; }
        (void)hipGetLastError();
        grid = cus;
    }
    if (grid < 0) return;
    Args a{};
    for (int i = 0; i < 24; ++i) a.in[i] = (const float*)d_in[i];
    a.out = (float*)d_out; a.ws = (unsigned char*)d_ws;
#if MK_ONE_LAUNCH
    (void)hipMemsetAsync((char*)d_ws + WS_CTL, 0, 16384, stream);
    a.ph_lo = 0; a.ph_hi = N_PHASES;
    void* kargs[] = {&a};
    hipError_t e = hipLaunchCooperativeKernel((const void*)hybrid_fwd, dim3(grid), dim3(NTHREADS), kargs, LDS_BYTES, stream);
    if (e != hipSuccess) fprintf(stderr, "kernel_launch: cooperative launch failed: %s (grid %d)\n", hipGetErrorString(e), grid);
#else
    for (int ph = 0; ph < N_PHASES; ++ph) {
        a.ph_lo = ph; a.ph_hi = ph + 1;
        hipLaunchKernelGGL(hybrid_fwd, dim3(grid), dim3(NTHREADS), LDS_BYTES, stream, a);
    }
#endif
}
```

```cpp
#include <hip/hip_runtime.h>
#include <hip/hip_cooperative_groups.h>
#include <cstdio>
#include <cstdint>
namespace cg = cooperative_groups;

#define LAS __attribute__((address_space(3)))
typedef unsigned short bf16_t;
typedef short bf16x8 __attribute__((ext_vector_type(8)));
typedef float f32x4 __attribute__((ext_vector_type(4)));
typedef unsigned u32x4 __attribute__((ext_vector_type(4)));
typedef unsigned u32x2 __attribute__((ext_vector_type(2)));

constexpr int D = 1024;
constexpr int SEQ = 8192, NMETA = 16, PADF = 48;
constexpr int TPP = 8256;
constexpr int ROW_S0 = 2 * TPP;
constexpr int M_TOT = ROW_S0 + 128;
constexpr int NSEQ = 10;
constexpr float EPS = 1e-6f;
constexpr int LDP = 6144;
constexpr int SSD_INNER = 2048, SSD_HEADS = 32, SSD_P = 64, SSD_N = 128, SSD_CONV = 3072, SSD_IN = 5152, SSD_IN_PAD = 5376;
constexpr int GDN_HEADS = 8, GDN_DK = 128, GDN_DV = 256, GDN_CONV = 4096, GDN_VAL = 2048, GDN_IN = 6160, GDN_IN_PAD = 6400;

constexpr size_t O_YP = 0, O_YS = 16777216, O_PSSD = 16908288, O_PSSDC = 17956864, O_PGDN = 17993728, O_PGDNC = 19042304,
                 O_SSSD = 19091456, O_SSSDC = 23285760, O_SGDN = 23433216, O_SGDNC = 27627520;

constexpr size_t WS_CTL = 0;
constexpr size_t WS_HB = 65536;
constexpr size_t WS_WIN = WS_HB + (size_t)M_TOT * D * 2;
constexpr size_t WS_WOUT = WS_WIN + (size_t)GDN_IN_PAD * D * 2;
constexpr size_t WS_TAIL = WS_WOUT + (size_t)1024 * 2048 * 2;
constexpr size_t WS_DTB = WS_TAIL + (size_t)258 * 3 * 4096 * 2;
constexpr size_t WS_RSS = WS_DTB + (size_t)M_TOT * 32 * 4;
constexpr size_t WS_PROJ = WS_RSS + (size_t)M_TOT * 16 * 4;
constexpr size_t WS_END = WS_PROJ + (size_t)M_TOT * LDP * 2;

constexpr int NTHREADS = 512;
constexpr int LDS_BYTES = 147456;

__device__ __forceinline__ float bf2f(bf16_t b) { return __uint_as_float(((unsigned)b) << 16); }
__device__ __forceinline__ bf16_t f2bf(float f) { unsigned u = __float_as_uint(f); u += 0x7FFFu + ((u >> 16) & 1u); return (bf16_t)(u >> 16); }
typedef __bf16 bf16v2_t __attribute__((ext_vector_type(2)));
typedef float f32x2_t __attribute__((ext_vector_type(2)));
__device__ __forceinline__ unsigned cvt_pk_bf16(float lo, float hi) { const bf16v2_t r = __builtin_convertvector((f32x2_t){lo, hi}, bf16v2_t); return __builtin_bit_cast(unsigned, r); }
__device__ __forceinline__ float silu_f(float x) { return x / (1.0f + __expf(-x)); }
__device__ __forceinline__ float softplus_f(float x) { return x > 20.f ? x : log1pf(__expf(x)); }
__device__ __forceinline__ float wave_sum(float v) {
#pragma unroll
    for (int o = 32; o >= 1; o >>= 1) v += __shfl_xor(v, o);
    return v;
}
#define KEEP(x) asm volatile("" :: "v"(x))
__device__ __forceinline__ int seq_base(int s) { return s < 2 ? s * TPP + 64 - NMETA : ROW_S0 + 16 * (s - 2); }
__device__ __forceinline__ int seq_len(int s) { return s < 2 ? SEQ + NMETA : 16; }
__device__ __forceinline__ int seq_chunks(int s) { return s < 2 ? 129 : 1; }

namespace pg8 {
constexpr int BM = 256, BK = 64, HALF = 128, HTB = HALF * BK * 2, STAGE_BYTES = 8 * HTB, NXCD = 8, WGM = 8;
__device__ __forceinline__ int lds_byte(int r, int c) { const int st = (r >> 4) * 2 + (c >> 5), rr = r & 15, cc = c & 31, ob = rr * 64 + cc * 2; return st * 1024 + (ob ^ (((ob >> 9) & 1) << 5)); }
__device__ __forceinline__ void stage_rc(int b, int& R, int& C) { const int st = b / 1024, sb = b % 1024, swz = sb ^ (((sb >> 9) & 1) << 5); R = (st >> 1) * 16 + swz / 64; C = (st & 1) * 32 + (swz % 64) / 2; }
__device__ __forceinline__ int perm32(int rho) { const int n = rho >> 4, i = rho & 15; return 8 * (i >> 2) + 4 * n + (i & 3); }
struct Unit { int pm, pn; };
struct Gemm { const bf16_t* A; const bf16_t* Bt; int M, N, K, lda, ldb; };
struct StaticOrder {
    int nM, nN, nwg, G, c;
    __device__ void init(int M, int N, int G_, int c_) { nM = M / BM; nN = N / BM; nwg = nM * nN; G = G_; c = c_; }
    __device__ bool next(int i, Unit& u) const {
        const long L = (long)i * G + c; if (L >= nwg) return false;
        int wgid = (int)L; { const int q = nwg / NXCD, r = nwg % NXCD, xcd = wgid % NXCD, off = wgid / NXCD; wgid = (xcd < r ? xcd * (q + 1) : r * (q + 1) + (xcd - r) * q) + off; }
        const int nig = WGM * nN, gid = wgid / nig, fm = gid * WGM, gsz = (nM - fm) < WGM ? (nM - fm) : WGM;
        u.pm = fm + ((wgid % nig) % gsz); u.pn = (wgid % nig) / gsz; return true;
    }
};

template <class Epi>
__device__ __forceinline__ void gemm_phase(LAS unsigned char* lds, const Gemm g, const StaticOrder& S, const Epi& E, const int tid) {
    const int wid = __builtin_amdgcn_readfirstlane(tid >> 6), lane = tid & 63, wr = wid >> 2, wc = wid & 3, fr = lane & 15, fq = lane >> 4;
    const int K = g.K, nt = K / BK;
    unsigned voffA[2], voffB[2];
#pragma unroll
    for (int i = 0; i < 2; ++i) { int R, C; stage_rc(tid * 16 + i * 8192, R, C); const int Rb = Epi::PERM ? ((R & ~31) + perm32(R & 31)) : R;
        voffA[i] = (unsigned)(R * g.lda + C) * 2u; voffB[i] = (unsigned)(Rb * g.ldb + C) * 2u; }
    const size_t kstep = (size_t)(BK * 2);
    const size_t hstepA = (size_t)HALF * g.lda * 2, hstepB = (size_t)HALF * g.ldb * 2;
    const size_t tstepA = 2 * hstepA, tstepB = 2 * hstepB;
    const unsigned ldsw = (unsigned)wid * 1024u;
    const int aoff = lds_byte(wr * 64 + fr, fq * 8), boff = lds_byte(wc * 32 + fr, fq * 8);
#define PG8_SA(b, h) (((b) * 2 + (h)) * HTB)
#define PG8_SB(b, h) ((4 + (b) * 2 + (h)) * HTB)
#define PG8_STAGE(bufoff, gbase, voff) do { _Pragma("unroll") for (int _i = 0; _i < 2; ++_i) \
        __builtin_amdgcn_global_load_lds((const unsigned*)((const char*)(gbase) + (voff)[_i]), (LAS unsigned*)(lds + (bufoff) + ldsw + _i * 8192), 16, 0, 0); } while (0)
#define PG8_LDA(dst, b, h) do { _Pragma("unroll") for (int m = 0; m < 4; ++m) _Pragma("unroll") for (int k = 0; k < 2; ++k) dst[m][k] = *(const LAS bf16x8*)(lds + PG8_SA(b, h) + aoff + m * 2048 + k * 1024); } while (0)
#define PG8_LDB(dst, b, h) do { _Pragma("unroll") for (int n = 0; n < 2; ++n) _Pragma("unroll") for (int k = 0; k < 2; ++k) dst[n][k] = *(const LAS bf16x8*)(lds + PG8_SB(b, h) + boff + n * 2048 + k * 1024); } while (0)
#define PG8_MMA(ai, bj, At, Bt) do { __builtin_amdgcn_s_setprio(1); _Pragma("unroll") for (int m = 0; m < 4; ++m) _Pragma("unroll") for (int n = 0; n < 2; ++n) _Pragma("unroll") for (int k = 0; k < 2; ++k) \
        acc[ai][bj][m][n] = __builtin_amdgcn_mfma_f32_16x16x32_bf16(Bt[n][k], At[m][k], acc[ai][bj][m][n], 0, 0, 0); __builtin_amdgcn_s_setprio(0); } while (0)
#define PG8_WAIT_V(n) asm volatile("s_waitcnt vmcnt(" #n ")" ::: "memory")
#define PG8_WAIT_L(n) asm volatile("s_waitcnt lgkmcnt(" #n ")" ::: "memory")
#define PG8_BAR __builtin_amdgcn_s_barrier()
#define PG8_SCHED __builtin_amdgcn_sched_barrier(0)
    Unit cur, nxt; int ui = 0;
    if (!S.next(0, cur)) return;
    f32x4 acc[2][2][4][2];
#pragma unroll
    for (int a = 0; a < 2; ++a)
#pragma unroll
        for (int b = 0; b < 2; ++b)
#pragma unroll
            for (int m = 0; m < 4; ++m)
#pragma unroll
                for (int n = 0; n < 2; ++n) acc[a][b][m][n] = (f32x4){0.f, 0.f, 0.f, 0.f};
    bf16x8 At[4][2], B0[2][2], B1[2][2];
    const char* cA = (const char*)g.A + (size_t)cur.pm * tstepA; const char* cB = (const char*)g.Bt + (size_t)cur.pn * tstepB;
    PG8_STAGE(PG8_SB(0, 0), cB, voffB); PG8_STAGE(PG8_SA(0, 0), cA, voffA); PG8_STAGE(PG8_SB(0, 1), cB + hstepB, voffB); PG8_STAGE(PG8_SA(0, 1), cA + hstepA, voffA);
    if (wr == 1) PG8_BAR;
    PG8_WAIT_V(4); PG8_BAR;
    PG8_STAGE(PG8_SB(1, 0), cB + kstep, voffB); PG8_STAGE(PG8_SA(1, 0), cA + kstep, voffA); PG8_STAGE(PG8_SB(1, 1), cB + hstepB + kstep, voffB);
    PG8_WAIT_V(6); PG8_BAR;
    for (;;) {
        const bool has_next = S.next(ui + 1, nxt);
        const char* nA = has_next ? (const char*)g.A + (size_t)nxt.pm * tstepA : cA; const char* nB = has_next ? (const char*)g.Bt + (size_t)nxt.pn * tstepB : cB;
        for (int t = 0; t < nt; t += 2) {
            const bool last = (t == nt - 2);
            const char* a1 = cA + (size_t)(t + 1) * kstep;
            const char* a2 = last ? nA : cA + (size_t)(t + 2) * kstep; const char* b2 = last ? nB : cB + (size_t)(t + 2) * kstep;
            const char* a3 = a2 + kstep; const char* b3 = b2 + kstep;
            PG8_LDB(B0, 0, 0); PG8_SCHED; PG8_LDA(At, 0, 0); PG8_STAGE(PG8_SA(1, 1), a1 + hstepA, voffA);
            PG8_WAIT_L(8); PG8_BAR; PG8_WAIT_L(0); PG8_MMA(0, 0, At, B0); PG8_BAR; PG8_SCHED;
            PG8_LDB(B1, 0, 1); PG8_STAGE(PG8_SB(0, 0), b2, voffB);
            PG8_BAR; PG8_WAIT_L(0); PG8_MMA(0, 1, At, B1); PG8_BAR;
            PG8_LDA(At, 0, 1); PG8_STAGE(PG8_SA(0, 0), a2, voffA);
            PG8_BAR; PG8_WAIT_L(0); PG8_MMA(1, 0, At, B0); PG8_BAR; PG8_SCHED;
            PG8_STAGE(PG8_SB(0, 1), b2 + hstepB, voffB);
            PG8_WAIT_V(6); PG8_BAR; PG8_MMA(1, 1, At, B1); PG8_BAR;
            PG8_LDB(B0, 1, 0); PG8_SCHED; PG8_LDA(At, 1, 0); PG8_STAGE(PG8_SA(0, 1), a2 + hstepA, voffA);
            PG8_WAIT_L(8); PG8_BAR; PG8_WAIT_L(0); PG8_MMA(0, 0, At, B0); PG8_BAR; PG8_SCHED;
            PG8_LDB(B1, 1, 1); PG8_STAGE(PG8_SB(1, 0), b3, voffB);
            PG8_BAR; PG8_WAIT_L(0); PG8_MMA(0, 1, At, B1); PG8_BAR;
            PG8_LDA(At, 1, 1); PG8_STAGE(PG8_SA(1, 0), a3, voffA);
            PG8_BAR; PG8_WAIT_L(0); PG8_MMA(1, 0, At, B0); PG8_BAR; PG8_SCHED;
            PG8_STAGE(PG8_SB(1, 1), b3 + hstepB, voffB);
            PG8_WAIT_V(6); PG8_BAR; PG8_MMA(1, 1, At, B1); PG8_BAR;
        }
        E(acc, cur, wr, wc, fr, fq);
        if (!has_next) break;
#pragma unroll
        for (int a = 0; a < 2; ++a)
#pragma unroll
            for (int b = 0; b < 2; ++b)
#pragma unroll
                for (int m = 0; m < 4; ++m)
#pragma unroll
                    for (int n = 0; n < 2; ++n) acc[a][b][m][n] = (f32x4){0.f, 0.f, 0.f, 0.f};
        cur = nxt; cA = nA; cB = nB; ++ui;
    }
    PG8_WAIT_V(0);
    if (wr == 0) PG8_BAR;
    PG8_BAR;
#undef PG8_SA
#undef PG8_SB
#undef PG8_STAGE
#undef PG8_LDA
#undef PG8_LDB
#undef PG8_MMA
#undef PG8_WAIT_V
#undef PG8_WAIT_L
#undef PG8_BAR
#undef PG8_SCHED
}

struct EpiInProj {
    static constexpr bool PERM = true;
    bf16_t* proj; float* dtb; const float* rowss; int nt_main; bf16_t* tails; int tl_lo, tl_hi;
    __device__ __forceinline__ void operator()(const f32x4 (&acc)[2][2][4][2], const Unit& u, int wr, int wc, int fr, int fq) const {
        const int row0 = u.pm * BM + wr * 64 + fr;
#pragma unroll
        for (int ai = 0; ai < 2; ++ai)
#pragma unroll
            for (int m = 0; m < 4; ++m) {
                const int r = row0 + ai * HALF + m * 16;
                const f32x4* rp = (const f32x4*)(rowss + (size_t)r * 16);
                const f32x4 p0 = rp[0], p1 = rp[1], p2 = rp[2], p3 = rp[3];
                const float ss = ((p0[0] + p0[1]) + (p0[2] + p0[3])) + ((p1[0] + p1[1]) + (p1[2] + p1[3])) + ((p2[0] + p2[1]) + (p2[2] + p2[3])) + ((p3[0] + p3[1]) + (p3[2] + p3[3]));
                const float rstd = rsqrtf(ss * (1.0f / 1024.0f) + EPS);
                if (u.pn < nt_main) {
                    bf16_t* rowp = proj + (size_t)r * LDP + u.pn * BM + wc * 32 + 8 * fq;
#pragma unroll
                    for (int bj = 0; bj < 2; ++bj) { const f32x4 v0 = acc[ai][bj][m][0] * rstd, v1 = acc[ai][bj][m][1] * rstd;
                        u32x4 w; w.x = cvt_pk_bf16(v0[0], v0[1]); w.y = cvt_pk_bf16(v0[2], v0[3]); w.z = cvt_pk_bf16(v1[0], v1[1]); w.w = cvt_pk_bf16(v1[2], v1[3]);
                        *(u32x4*)(rowp + bj * HALF) = w;
                        if (u.pn >= tl_lo && u.pn < tl_hi && r < ROW_S0 && (r & 63) >= 61) *(u32x4*)(tails + ((size_t)(r >> 6) * 3 + ((r & 63) - 61)) * 4096 + (u.pn - tl_lo) * BM + wc * 32 + 8 * fq + bj * HALF) = w; }
                } else if (wc == 0) {
                    float* dp = dtb + (size_t)r * 32 + 8 * fq;
                    *(f32x4*)(dp) = acc[ai][0][m][0] * rstd; *(f32x4*)(dp + 4) = acc[ai][0][m][1] * rstd;
                }
            }
    }
};
struct EpiOutProj {
    static constexpr bool PERM = false;
    bf16_t* hb; float* rowss;
    __device__ __forceinline__ void operator()(const f32x4 (&acc)[2][2][4][2], const Unit& u, int wr, int wc, int fr, int fq) const {
        const int row0 = u.pm * BM + wr * 64 + fr, col0 = u.pn * BM + wc * 32 + 4 * fq;
#pragma unroll
        for (int ai = 0; ai < 2; ++ai)
#pragma unroll
            for (int m = 0; m < 4; ++m) {
                const int r = row0 + ai * HALF + m * 16; float ss = 0.f;
                bf16_t* rowp = hb + (size_t)r * D + col0;
#pragma unroll
                for (int bj = 0; bj < 2; ++bj)
#pragma unroll
                    for (int n = 0; n < 2; ++n) {
                        u32x2* p = (u32x2*)(rowp + bj * HALF + n * 16); const u32x2 o = *p;
                        const f32x4 a = acc[ai][bj][m][n];
                        const float h0 = __uint_as_float(o.x << 16) + a[0], h1 = __uint_as_float(o.x & 0xffff0000u) + a[1];
                        const float h2 = __uint_as_float(o.y << 16) + a[2], h3 = __uint_as_float(o.y & 0xffff0000u) + a[3];
                        ss += (h0 * h0 + h1 * h1) + (h2 * h2 + h3 * h3);
                        u32x2 w; w.x = cvt_pk_bf16(h0, h1); w.y = cvt_pk_bf16(h2, h3); *p = w;
                    }
                ss += __shfl_xor(ss, 16); ss += __shfl_xor(ss, 32);
                if (fq == 0) rowss[(size_t)r * 16 + u.pn * 4 + wc] = ss;
            }
    }
};
}

#define XB_TMO      128
#define XB_XCNT(j)  (256  + 64 * (j))
#define XB_XSUB(j)  (1280 + 64 * (j))
#define XB_XGEN(j)  (2304 + 64 * (j))
#define XB_TOP      3328
#define XB_TOPGEN   3392
#define XCD_BAR_WORDS 3456
#define XB_SPIN_CAP (1u << 24)
__device__ __forceinline__ unsigned xb_ld(unsigned* p)              { return __hip_atomic_load(p, __ATOMIC_RELAXED, __HIP_MEMORY_SCOPE_AGENT); }
__device__ __forceinline__ unsigned xb_add(unsigned* p, unsigned v) { return __hip_atomic_fetch_add(p, v, __ATOMIC_RELAXED, __HIP_MEMORY_SCOPE_AGENT); }
__device__ __forceinline__ unsigned xb_xcc_id() { return (unsigned)__builtin_amdgcn_s_getreg((3 << 11) | 20) & 0xFu; }
#define XB_SPIN(cond, bar) do { unsigned _sp = 0; while (cond) { __builtin_amdgcn_s_sleep(1); \
    if ((++_sp & 255u) == 0u) { if (xb_ld(&(bar)[XB_TMO])) break; if (_sp > XB_SPIN_CAP) { atomicAdd(&(bar)[XB_TMO], 1u); break; } } } } while (0)
struct XcdBarrier { unsigned* bar; unsigned x; volatile LAS unsigned* st; };
__device__ __forceinline__ XcdBarrier xcd_barrier_post(unsigned* bar, volatile LAS unsigned* st) {
    XcdBarrier b; b.bar = bar; b.x = xb_xcc_id(); b.st = st;
    if (threadIdx.x == 0) (void)xb_add(&bar[XB_XCNT(b.x)], 1u);
    return b;
}
__device__ __forceinline__ void xcd_barrier_complete(unsigned* bar, unsigned x, unsigned& nloc, unsigned& nx) {
    const unsigned G = gridDim.x * gridDim.y * gridDim.z;
    unsigned sum, cnt, mine, sp = 0u;
    for (;;) {
        sum = 0u; cnt = 0u; mine = 0u;
#pragma unroll
        for (unsigned j = 0; j < 16; ++j) { const unsigned c = xb_ld(&bar[XB_XCNT(j)]); sum += c; cnt += (c > 0u) ? 1u : 0u; mine = (j == x) ? c : mine; }
        if (sum == G) break;
        __builtin_amdgcn_s_sleep(1);
        if ((++sp & 255u) == 0u) { if (xb_ld(&bar[XB_TMO])) break; if (sp > XB_SPIN_CAP) { atomicAdd(&bar[XB_TMO], 1u); break; } }
    }
    nloc = mine > 0u ? mine : 1u; nx = cnt > 0u ? cnt : 1u;
}
__device__ __forceinline__ void xcd_barrier(const XcdBarrier& b) {
    asm volatile("s_waitcnt vmcnt(0)" ::: "memory");
    __syncthreads();
    if (threadIdx.x == 0) {
        unsigned* bar = b.bar;
        __builtin_amdgcn_s_waitcnt(0);
        unsigned nloc = b.st[0], nx = b.st[1];
        if (nloc == 0u) { xcd_barrier_complete(bar, b.x, nloc, nx); b.st[0] = nloc; b.st[1] = nx; }
        const unsigned old = xb_add(&bar[XB_XSUB(b.x)], 1u);
        const unsigned gen = old / nloc;
        if (old + 1u == (gen + 1u) * nloc) {
            __builtin_amdgcn_fence(__ATOMIC_RELEASE, "agent");
            asm volatile("s_waitcnt vmcnt(0)" ::: "memory");
            const unsigned og = xb_add(&bar[XB_TOP], 1u);
            const unsigned tg = og / nx;
            if (og + 1u == (tg + 1u) * nx) xb_add(&bar[XB_TOPGEN], 1u);
            else XB_SPIN(xb_ld(&bar[XB_TOPGEN]) == tg, bar);
            __builtin_amdgcn_fence(__ATOMIC_ACQUIRE, "agent");
            xb_add(&bar[XB_XGEN(b.x)], 1u);
            asm volatile("s_waitcnt vmcnt(0)" ::: "memory");
        } else {
            XB_SPIN(xb_ld(&bar[XB_XGEN(b.x)]) == gen, bar);
            __builtin_amdgcn_fence(__ATOMIC_ACQUIRE, "agent");
            asm volatile("s_waitcnt vmcnt(0)" ::: "memory");
        }
    }
    __syncthreads();
}

struct Args { const float* in[24]; float* out; unsigned char* ws; int ph_lo, ph_hi; };

struct Frame {
    const Args* ap; float* out; unsigned char* ws;
    __device__ __forceinline__ const float* inp(int i) const { asm volatile("" : "+s"(i)); return ap->in[i]; }
    unsigned char* lds; LAS unsigned char* ldsl;
    int tid, lane, wave, G, bid;
    bf16_t* hb; bf16_t* win; bf16_t* wout; float* dtb; float* rss; bf16_t* proj; bf16_t* tails;
};

__device__ __forceinline__ Frame relaunder(Frame F) {
    int t = F.tid; asm volatile("" : "+v"(t));
    F.tid = t; F.lane = t & 63; F.wave = __builtin_amdgcn_readfirstlane(t >> 6);
    unsigned char* w = F.ws; asm volatile("" : "+s"(w));
    F.ws = w; F.hb = (bf16_t*)(w + WS_HB); F.win = (bf16_t*)(w + WS_WIN); F.wout = (bf16_t*)(w + WS_WOUT);
    F.dtb = (float*)(w + WS_DTB); F.rss = (float*)(w + WS_RSS); F.proj = (bf16_t*)(w + WS_PROJ); F.tails = (bf16_t*)(w + WS_TAIL);
    return F;
}
__device__ void phase_init_h(const Frame& F0) {
    const Frame F = relaunder(F0);
    const float* xp = F.inp(0); const float* xs = F.inp(1); const float* meta = F.inp(6);
    for (int row = F.bid * 8 + F.wave; row < M_TOT; row += F.G * 8) {
        const float* src = nullptr;
        if (row < ROW_S0) { const int b = row / TPP, r = row % TPP; if (r >= 64) src = xp + ((size_t)b * SEQ + (r - 64)) * D; else if (r >= PADF) src = meta + (size_t)(r - PADF) * D; }
        else src = xs + (size_t)(row - ROW_S0) * D;
        float ss = 0.f;
#pragma unroll
        for (int i = 0; i < 4; ++i) {
            f32x4 v = (f32x4){0.f, 0.f, 0.f, 0.f};
            if (src) v = *(const f32x4*)(src + (F.lane + 64 * i) * 4);
            ss += (v[0] * v[0] + v[1] * v[1]) + (v[2] * v[2] + v[3] * v[3]);
            u32x2 w; w.x = cvt_pk_bf16(v[0], v[1]); w.y = cvt_pk_bf16(v[2], v[3]);
            *(u32x2*)(F.hb + (size_t)row * D + (F.lane + 64 * i) * 4) = w;
        }
        ss = wave_sum(ss);
        if (F.lane < 16) F.rss[(size_t)row * 16 + F.lane] = (F.lane == 0) ? ss : 0.f;
    }
}

__device__ void transpose_convert(const Frame& F, const float* src, int K, int N, int Npad, bf16_t* dst, const float* scale, int smod) {
    float* tile = (float*)F.lds;
    const int ntk = K / 64, ntn = Npad / 64, ntile = ntk * ntn;
    __syncthreads();
    for (int ti = F.bid; ti < ntile; ti += F.G) {
        const int kt = ti % ntk, nt_ = ti / ntk, k0 = kt * 64, n0 = nt_ * 64;
        const int kk = F.tid >> 4, n4 = (F.tid & 15) * 4;
#pragma unroll
        for (int h = 0; h < 2; ++h) {
            const int k = k0 + kk + 32 * h, n = n0 + n4;
            f32x4 v = (f32x4){0.f, 0.f, 0.f, 0.f};
            if (n < N) v = *(const f32x4*)(src + (size_t)k * N + n);
            const float s = scale[k % smod];
            float* tp = tile + (kk + 32 * h) * 65 + n4;
            tp[0] = v[0] * s; tp[1] = v[1] * s; tp[2] = v[2] * s; tp[3] = v[3] * s;
        }
        __syncthreads();
        const int nn = F.tid >> 3, kg = (F.tid & 7) * 8;
        float x[8];
#pragma unroll
        for (int j = 0; j < 8; ++j) x[j] = tile[(kg + j) * 65 + nn];
        u32x4 w; w.x = cvt_pk_bf16(x[0], x[1]); w.y = cvt_pk_bf16(x[2], x[3]); w.z = cvt_pk_bf16(x[4], x[5]); w.w = cvt_pk_bf16(x[6], x[7]);
        *(u32x4*)(dst + (size_t)(n0 + nn) * K + k0 + kg) = w;
        __syncthreads();
    }
}
__device__ void phase_wprep_in(const Frame& F0, int L) {
    const Frame F = relaunder(F0);
    const int j = L >> 1;
    if ((L & 1) == 0) transpose_convert(F, F.inp(8) + (size_t)j * D * SSD_IN, D, SSD_IN, SSD_IN_PAD, F.win, F.inp(7) + j * D, D);
    else transpose_convert(F, F.inp(17) + (size_t)j * D * GDN_IN, D, GDN_IN, GDN_IN_PAD, F.win, F.inp(16) + j * D, D);
}
__device__ void phase_wprep_out(const Frame& F0, int L) {
    const Frame F = relaunder(F0);
    const int j = L >> 1;
    if ((L & 1) == 0) transpose_convert(F, F.inp(15) + (size_t)j * SSD_INNER * D, SSD_INNER, D, D, F.wout, F.inp(14) + j * SSD_INNER, SSD_INNER);
    else transpose_convert(F, F.inp(22) + (size_t)j * GDN_VAL * D, GDN_VAL, D, D, F.wout, F.inp(21) + j * GDN_DV, GDN_DV);
}

__device__ void phase_inproj(const Frame& F0, int L) {
    const Frame F = relaunder(F0);
    const int npad = (L & 1) ? GDN_IN_PAD : SSD_IN_PAD;
    pg8::Gemm g{F.hb, F.win, M_TOT, npad, D, D, D};
    pg8::StaticOrder S; S.init(M_TOT, npad, F.G, F.bid);
    pg8::EpiInProj E{F.proj, F.dtb, F.rss, npad / 256 - 1, F.tails, (L & 1) ? 0 : 8, 16};
    pg8::gemm_phase<pg8::EpiInProj>(F.ldsl, g, S, E, F.tid);
}
__device__ void phase_outproj(const Frame& F0, int L) {
    const Frame F = relaunder(F0);
    const bf16_t* A = F.proj + ((L & 1) ? 4096 : 0);
    pg8::Gemm g{A, F.wout, M_TOT, D, 2048, LDP, 2048};
    pg8::StaticOrder S; S.init(M_TOT, D, F.G, F.bid);
    pg8::EpiOutProj E{F.hb, F.rss};
    pg8::gemm_phase<pg8::EpiOutProj>(F.ldsl, g, S, E, F.tid);
}

__device__ void phase_ssd_naive(const Frame& F0, int j) {
    const Frame F = relaunder(F0);
    float* xs = (float*)F.lds;
    float* Bs = xs + 64 * 64;
    float* Cs = Bs + 64 * 128;
    float* dts = Cs + 64 * 128;
    float* das = dts + 64;
    const float* conv_w = F.inp(9) + (size_t)j * 4 * SSD_CONV; const float* conv_b = F.inp(10) + (size_t)j * SSD_CONV;
    const int p = F.tid >> 3, nq = F.tid & 7;
    for (int task = F.bid; task < NSEQ * SSD_HEADS; task += F.G) {
        const int s = task / SSD_HEADS, head = task % SSD_HEADS, grp = head >> 3;
        const int base = seq_base(s), nch = seq_chunks(s);
        const float dt_bias = F.inp(11)[j * SSD_HEADS + head], a = -__expf(F.inp(12)[j * SSD_HEADS + head]), dsk = F.inp(13)[j * SSD_HEADS + head];
        float h[16];
        if (s < 2) {
#pragma unroll
            for (int n = 0; n < 16; ++n) h[n] = 0.f;
        } else {
            const float* st = F.inp(2) + ((((size_t)j * 8 + (s - 2)) * SSD_HEADS + head) * SSD_P + p) * SSD_N + nq * 16;
#pragma unroll
            for (int n = 0; n < 16; ++n) h[n] = st[n];
        }
        int cidx = -1;
        if (F.tid < 64) cidx = head * 64 + F.tid; else if (F.tid < 192) cidx = 2048 + grp * 128 + (F.tid - 64); else if (F.tid < 320) cidx = 2560 + grp * 128 + (F.tid - 192);
        float w0 = 0, w1 = 0, w2 = 0, w3 = 0, cb = 0;
        if (cidx >= 0) { w0 = conv_w[cidx]; w1 = conv_w[SSD_CONV + cidx]; w2 = conv_w[2 * SSD_CONV + cidx]; w3 = conv_w[3 * SSD_CONV + cidx]; cb = conv_b[cidx]; }
        const float* cst = (s >= 2) ? F.inp(3) + (((size_t)j * 8 + (s - 2)) * 3) * SSD_CONV : nullptr;
        for (int c = 0; c < nch; ++c) {
            const int t0 = 64 * c - PADF;
            __syncthreads();
            if (cidx >= 0) {
                float r3, r2, r1;
                {   float rv[3];
#pragma unroll
                    for (int q = 0; q < 3; ++q) { const int t = t0 - 3 + q; float v = 0.f;
                        if (t >= 0) v = bf2f(F.proj[(size_t)(base + t) * LDP + 2048 + cidx]); else if (t >= -3 && cst) v = cst[(3 + t) * SSD_CONV + cidx];
                        rv[q] = v; }
                    r3 = rv[0]; r2 = rv[1]; r1 = rv[2]; }
                for (int i = 0; i < 64; ++i) {
                    const int t = t0 + i; float v = 0.f;
                    if (t >= 0) v = bf2f(F.proj[(size_t)(base + t) * LDP + 2048 + cidx]); else if (t >= -3 && cst) v = cst[(3 + t) * SSD_CONV + cidx];
                    const float o = silu_f(cb + w0 * r3 + w1 * r2 + w2 * r1 + w3 * v);
                    r3 = r2; r2 = r1; r1 = v;
                    if (F.tid < 64) xs[i * 64 + F.tid] = o; else if (F.tid < 192) Bs[i * 128 + (F.tid - 64)] = o; else Cs[i * 128 + (F.tid - 192)] = o;
                }
            } else if (F.tid >= 448) {
                const int i = F.tid - 448, t = t0 + i;
                float dt = 0.f, da = 1.f;
                if (t >= 0) { dt = softplus_f(F.dtb[(size_t)(base + t) * 32 + head] + dt_bias); da = __expf(dt * a); }
                dts[i] = dt; das[i] = da;
            }
            __syncthreads();
            for (int i = 0; i < 64; ++i) {
                const int t = t0 + i;
                const float dt = dts[i], da = das[i], xv = xs[i * 64 + p], dx = dt * xv;
                const float* bp = Bs + i * 128 + nq * 16; const float* cp = Cs + i * 128 + nq * 16;
                float accv = 0.f;
#pragma unroll
                for (int n = 0; n < 16; ++n) { h[n] = h[n] * da + dx * bp[n]; accv += cp[n] * h[n]; }
                accv += __shfl_xor(accv, 1); accv += __shfl_xor(accv, 2); accv += __shfl_xor(accv, 4);
                if (nq == 0 && t >= 0) {
                    bf16_t* zp = F.proj + (size_t)(base + t) * LDP + head * 64 + p;
                    const float z = bf2f(*zp);
                    *zp = f2bf((accv + dsk * xv) * silu_f(z));
                }
            }
        }
        float* so = (s < 2) ? F.out + O_PSSD + ((((size_t)j * 2 + s) * SSD_HEADS + head) * SSD_P + p) * SSD_N + nq * 16
                            : F.out + O_SSSD + ((((size_t)j * 8 + (s - 2)) * SSD_HEADS + head) * SSD_P + p) * SSD_N + nq * 16;
#pragma unroll
        for (int n = 0; n < 16; ++n) so[n] = h[n];
    }
}


constexpr int NCHT = 266;
constexpr size_t SC_BT = 0;
constexpr size_t SC_C = SC_BT + (size_t)NCHT * 4 * 16384;
constexpr size_t SC_CB = SC_C + (size_t)NCHT * 4 * 16384;
constexpr size_t SC_VEC = SC_CB + (size_t)NCHT * 4 * 8192;
constexpr size_t SC_XS = SC_VEC + (size_t)NCHT * 32 * 1024;
constexpr size_t SC_SSD_END = SC_XS + (size_t)256 * 8192;
static_assert(SC_SSD_END <= (size_t)16777216 * 4, "scratch must fit the y_prompt region");
__device__ __forceinline__ int qperm(int s) { return (s & ~31) | (((s >> 2) & 3) << 3) | (((s >> 4) & 1) << 2) | (s & 3); }
__device__ __forceinline__ int qnat(int q) { return (q & ~31) | (((q >> 2) & 1) << 4) | (((q >> 3) & 3) << 2) | (q & 3); }
__device__ __forceinline__ bf16x8 pack8(f32x4 a, f32x4 b) {
    u32x4 w; w.x = cvt_pk_bf16(a[0], a[1]); w.y = cvt_pk_bf16(a[2], a[3]); w.z = cvt_pk_bf16(b[0], b[1]); w.w = cvt_pk_bf16(b[2], b[3]);
    return __builtin_bit_cast(bf16x8, w);
}
__device__ __forceinline__ void chunk_of(int cgi, int& seq, int& c) { if (cgi < 258) { seq = cgi / 129; c = cgi % 129; } else { seq = 2 + (cgi - 258); c = 0; } }
__device__ __forceinline__ int cgi_of(int seq, int c) { return seq < 2 ? seq * 129 + c : 258 + (seq - 2); }
struct XTile { bf16_t* p; int stride; };
__device__ __forceinline__ XTile ssd_xtile(const Frame& F, int seq, int c, int head) {
    XTile t;
    if (seq < 2) { t.p = F.proj + (size_t)(seq * TPP + 64 * c) * LDP + 2048 + head * 64; t.stride = LDP; }
    else { t.p = (bf16_t*)((unsigned char*)F.out + SC_XS) + (size_t)((seq - 2) * 32 + head) * 4096; t.stride = 64; }
    return t;
}

template <bool DRY>
__device__ void phase_ssd_prep(const Frame& F0, int j) {
    const Frame F = relaunder(F0);
    bf16_t* Bs = (bf16_t*)F.lds;
    bf16_t* Cs = Bs + 64 * 136;
    unsigned char* sc = (unsigned char*)F.out;
    const float* conv_w = F.inp(9) + (size_t)j * 4 * SSD_CONV; const float* conv_b = F.inp(10) + (size_t)j * SSD_CONV;
    const int i16 = F.lane & 15, g4 = F.lane >> 4;
    for (int task = F.bid; task < NCHT * 4; task += F.G) {
        const int cgi = task >> 2, grp = task & 3; int seq, c; chunk_of(cgi, seq, c);
        const int base = seq_base(seq), t0 = 64 * c - PADF;
        __syncthreads();
        {
            const int hl = F.tid >> 6, p = F.tid & 63, head = grp * 8 + hl, cidx = head * 64 + p;
            const float w0 = conv_w[cidx], w1 = conv_w[SSD_CONV + cidx], w2 = conv_w[2 * SSD_CONV + cidx], w3 = conv_w[3 * SSD_CONV + cidx], cb = conv_b[cidx];
            float r3 = 0.f, r2 = 0.f, r1 = 0.f;
            if (seq < 2 && c > 0) { const bf16_t* tp = F.tails + (size_t)(cgi - 1) * 3 * 4096 + cidx; r3 = bf2f(tp[0]); r2 = bf2f(tp[4096]); r1 = bf2f(tp[2 * 4096]); }
            else if (seq >= 2) { const float* cst = F.inp(3) + (((size_t)j * 8 + (seq - 2)) * 3) * SSD_CONV + cidx; r3 = cst[0]; r2 = cst[SSD_CONV]; r1 = cst[2 * SSD_CONV]; }
            const bf16_t* xcol = F.proj + 2048 + cidx;
            bf16_t* xrow = (bf16_t*)F.lds + F.tid * 72;
#pragma unroll 1
            for (int s8 = 0; s8 < 8; ++s8) {
                float o[8];
#pragma unroll
                for (int h = 0; h < 8; ++h) {
                    const int t = t0 + 8 * s8 + h;
                    const float v = (t >= 0) ? bf2f(xcol[(size_t)(base + (t > 0 ? t : 0)) * LDP]) : 0.f;
                    o[h] = silu_f(cb + w0 * r3 + w1 * r2 + w2 * r1 + w3 * v);
                    if (t >= 0) { r3 = r2; r2 = r1; r1 = v; }
                }
                u32x4 w; w.x = cvt_pk_bf16(o[0], o[1]); w.y = cvt_pk_bf16(o[2], o[3]); w.z = cvt_pk_bf16(o[4], o[5]); w.w = cvt_pk_bf16(o[6], o[7]);
                *(u32x4*)(xrow + 8 * s8) = w;
            }
            __syncthreads();
            const XTile xt = ssd_xtile(F, seq, c, head);
#pragma unroll
            for (int q = 0; q < 8; ++q) { const u32x4 w = *(const u32x4*)(xrow + 8 * q);
                if (!DRY) *(u32x4*)(xt.p + (size_t)p * xt.stride + 8 * q) = w; else KEEP(w); }
        }
        __syncthreads();
        {
            const int ch = F.tid & 255, half = F.tid >> 8, isC = ch >> 7, n = ch & 127;
            const int cidx = 2048 + isC * 512 + grp * 128 + n;
            const float w0 = conv_w[cidx], w1 = conv_w[SSD_CONV + cidx], w2 = conv_w[2 * SSD_CONV + cidx], w3 = conv_w[3 * SSD_CONV + cidx], cb = conv_b[cidx];
            const float* cst = (seq >= 2) ? F.inp(3) + (((size_t)j * 8 + (seq - 2)) * 3) * SSD_CONV : nullptr;
            bf16_t* dst = (isC ? Cs : Bs) + n;
            const bf16_t* col = F.proj + 2048 + cidx;
            unsigned short raw[35];
#pragma unroll
            for (int e = 0; e < 35; ++e) { const int t = t0 + half * 32 - 3 + e; raw[e] = col[(size_t)(base + (t > 0 ? t : 0)) * LDP]; }
            float r3, r2, r1;
            {   float rv[3];
#pragma unroll
                for (int q = 0; q < 3; ++q) { const int t = t0 + half * 32 - 3 + q; float v = 0.f;
                    if (t >= 0) v = bf2f(raw[q]); else if (t >= -3 && cst) v = cst[(3 + t) * SSD_CONV + cidx];
                    rv[q] = v; }
                r3 = rv[0]; r2 = rv[1]; r1 = rv[2]; }
#pragma unroll
            for (int ii = 0; ii < 32; ++ii) {
                const int p = half * 32 + ii, t = t0 + p; float v = 0.f;
                if (t >= 0) v = bf2f(raw[ii + 3]); else if (t >= -3 && cst) v = cst[(3 + t) * SSD_CONV + cidx];
                const float o = silu_f(cb + w0 * r3 + w1 * r2 + w2 * r1 + w3 * v);
                r3 = r2; r2 = r1; r1 = v;
                dst[p * 136] = f2bf(o);
            }
        }
        __syncthreads();
        {
            bf16_t* BT = (bf16_t*)(sc + SC_BT) + (size_t)(cgi * 4 + grp) * 8192;
            const int n = F.tid >> 2, qg = (F.tid & 3) * 16;
#pragma unroll
            for (int u = 0; u < 2; ++u) {
                const int q0 = qg + 8 * u; unsigned short e[8];
#pragma unroll
                for (int jj = 0; jj < 8; ++jj) e[jj] = Bs[qnat(q0 + jj) * 136 + n];
                u32x4 w; w.x = e[0] | ((unsigned)e[1] << 16); w.y = e[2] | ((unsigned)e[3] << 16); w.z = e[4] | ((unsigned)e[5] << 16); w.w = e[6] | ((unsigned)e[7] << 16);
                if (!DRY) *(u32x4*)(BT + n * 64 + q0) = w; else KEEP(w);
            }
            bf16_t* Cg = (bf16_t*)(sc + SC_C) + (size_t)(cgi * 4 + grp) * 8192;
#pragma unroll
            for (int u = 0; u < 2; ++u) {
                const int idx = F.tid + 512 * u, l = idx >> 4, qg8 = idx & 15, kk = qg8 >> 2, gg = qg8 & 3;
                const u32x2 a = *(const u32x2*)(Cs + l * 136 + 32 * kk + 4 * gg), b = *(const u32x2*)(Cs + l * 136 + 32 * kk + 16 + 4 * gg);
                u32x4 w; w.x = a.x; w.y = a.y; w.z = b.x; w.w = b.y;
                if (!DRY) *(u32x4*)(Cg + l * 128 + 8 * qg8) = w; else KEEP(w);
            }
        }
        {
            bf16_t* CB = (bf16_t*)(sc + SC_CB) + (size_t)(cgi * 4 + grp) * 4096;
            const int m = F.wave >> 1;
#pragma unroll
            for (int u = 0; u < 2; ++u) {
                const int st = 2 * (F.wave & 1) + u; f32x4 acc = (f32x4){0.f, 0.f, 0.f, 0.f};
#pragma unroll
                for (int kk = 0; kk < 4; ++kk) {
                    const bf16x8 a = *(const bf16x8*)(Cs + (16 * m + i16) * 136 + 32 * kk + 8 * g4);
                    const bf16x8 b = *(const bf16x8*)(Bs + (16 * st + i16) * 136 + 32 * kk + 8 * g4);
                    acc = __builtin_amdgcn_mfma_f32_16x16x32_bf16(a, b, acc, 0, 0, 0);
                }
                const int qs = qperm(16 * st + i16);
#pragma unroll
                for (int jj = 0; jj < 4; ++jj) { if (!DRY) CB[(16 * m + 4 * g4 + jj) * 64 + qs] = f2bf(acc[jj]); else KEEP(acc[jj]); }
            }
        }
        {
            const int head = grp * 8 + F.wave, t = t0 + F.lane;
            const float a = -__expf(F.inp(12)[j * SSD_HEADS + head]);
            float dt = 0.f;
            if (t >= 0) dt = softplus_f(F.dtb[(size_t)(base + t) * 32 + head] + F.inp(11)[j * SSD_HEADS + head]);
            float cs = dt * a;
#pragma unroll
            for (int o = 1; o < 64; o <<= 1) { const float y = __shfl_up(cs, o); if (F.lane >= o) cs += y; }
            const float cs_last = __shfl(cs, 63), cs_be = __shfl(cs, F.lane | 3);
            float* vp = (float*)(sc + SC_VEC) + (size_t)(cgi * 32 + head) * 256;
            const float v1 = __expf(cs_be - cs) * dt, v2 = dt * __expf(cs_last - cs), v3 = __expf(cs);
            if (!DRY) { vp[F.lane] = cs; vp[64 + F.lane] = v1; vp[128 + F.lane] = v2; vp[192 + F.lane] = v3; } else { KEEP(v1); KEEP(v2); KEEP(v3); }
        }
    }
}

constexpr int SL_C = 0, SL_BT = 16384, SL_M = 32768, SL_XT = 40960, SL_VEC = 49152, SL_SIZE = 50176;
#define PD(d) P[11 + ((d) >> 2)][(d) & 3]
__device__ __forceinline__ void ssd_stage_load(u32x4 (&P)[15], const Frame& F, const unsigned char* sc, int lt, int seq, int head, int c) {
    const int cgi = cgi_of(seq, c), grp = head >> 3;
    const bf16_t* Cp = (const bf16_t*)(sc + SC_C) + (size_t)(cgi * 4 + grp) * 8192;
    const bf16_t* BTp = (const bf16_t*)(sc + SC_BT) + (size_t)(cgi * 4 + grp) * 8192;
    const bf16_t* CBp = (const bf16_t*)(sc + SC_CB) + (size_t)(cgi * 4 + grp) * 4096;
    const float* vp = (const float*)(sc + SC_VEC) + (size_t)(cgi * 32 + head) * 256;
    const XTile xt = ssd_xtile(F, seq, c, head);
#pragma unroll
    for (int r = 0; r < 4; ++r) { const int k = lt + 256 * r; P[r] = *(const u32x4*)(Cp + k * 8); P[4 + r] = *(const u32x4*)(BTp + k * 8); }
#pragma unroll
    for (int r = 0; r < 2; ++r) { const int k = lt + 256 * r, l = k >> 3, ch = k & 7, sa = 32 * (ch >> 2) + 4 * (ch & 3);
        P[8 + r] = *(const u32x4*)(CBp + k * 8); PD(3 * r) = __float_as_uint(vp[l]); PD(3 * r + 1) = __float_as_uint(vp[sa + 3]); PD(3 * r + 2) = __float_as_uint(vp[sa + 19]);
        P[13 + r] = *(const u32x4*)(xt.p + (size_t)l * xt.stride + ch * 8); }
    P[10] = *(const u32x4*)(vp + 64 + 4 * (lt < 48 ? lt : 0));
}
__device__ __forceinline__ void ssd_stage_write(const u32x4 (&P)[15], LAS unsigned char* img, int lt) {
#pragma unroll
    for (int r = 0; r < 4; ++r) { const int k = lt + 256 * r;
        { const int row = k >> 4, ch = k & 15; *(LAS u32x4*)(img + SL_C + (row * 16 + (ch ^ (row & 15))) * 16) = P[r]; }
        { const int row = k >> 3, ch = k & 7; *(LAS u32x4*)(img + SL_BT + (row * 8 + (ch ^ ((row >> 1) & 7))) * 16) = P[4 + r]; } }
#pragma unroll
    for (int r = 0; r < 2; ++r) {
        const int k = lt + 256 * r, l = k >> 3, ch = k & 7, sa = 32 * (ch >> 2) + 4 * (ch & 3), sb = sa + 16;
        const float csl = __uint_as_float(PD(3 * r)), e1a = __expf(csl - __uint_as_float(PD(3 * r + 1))), e1b = __expf(csl - __uint_as_float(PD(3 * r + 2)));
        const u32x4 cbw = P[8 + r]; f32x4 va, vb;
        va[0] = (sa + 0 <= l) ? __uint_as_float(cbw.x << 16) * e1a : 0.f; va[1] = (sa + 1 <= l) ? __uint_as_float(cbw.x & 0xffff0000u) * e1a : 0.f;
        va[2] = (sa + 2 <= l) ? __uint_as_float(cbw.y << 16) * e1a : 0.f; va[3] = (sa + 3 <= l) ? __uint_as_float(cbw.y & 0xffff0000u) * e1a : 0.f;
        vb[0] = (sb + 0 <= l) ? __uint_as_float(cbw.z << 16) * e1b : 0.f; vb[1] = (sb + 1 <= l) ? __uint_as_float(cbw.z & 0xffff0000u) * e1b : 0.f;
        vb[2] = (sb + 2 <= l) ? __uint_as_float(cbw.w << 16) * e1b : 0.f; vb[3] = (sb + 3 <= l) ? __uint_as_float(cbw.w & 0xffff0000u) * e1b : 0.f;
        u32x4 w; w.x = cvt_pk_bf16(va[0], va[1]); w.y = cvt_pk_bf16(va[2], va[3]); w.z = cvt_pk_bf16(vb[0], vb[1]); w.w = cvt_pk_bf16(vb[2], vb[3]);
        const int slot = l * 8 + (ch ^ ((l >> 1) & 7));
        *(LAS u32x4*)(img + SL_M + slot * 16) = w;
        *(LAS u32x4*)(img + SL_XT + slot * 16) = P[13 + r];
    }
    if (lt < 48) *(LAS u32x4*)(img + SL_VEC + 16 * lt) = P[10];
}
template <bool DRY>
__device__ __forceinline__ void ssd_ytile_out(const LAS unsigned char* img, const XTile& xt, int lt) {
#pragma unroll
    for (int r = 0; r < 2; ++r) { const int k = lt + 256 * r, p = k >> 3, ch = k & 7;
        const u32x4 w = *(const LAS u32x4*)(img + SL_XT + (p * 8 + (ch ^ ((p >> 1) & 7))) * 16);
        if (!DRY) *(u32x4*)(xt.p + (size_t)p * xt.stride + ch * 8) = w; else KEEP(w); }
}
template <bool DRY>
__device__ void phase_ssd_chain(const Frame& F0, int j) {
    const Frame F = relaunder(F0);
    const unsigned char* sc = (const unsigned char*)F.out;
    const bool loader = F.wave >= 4; const int lt = F.tid - 256, ps = F.wave & 3;
    for (int sh = F.bid; sh < 320; sh += F.G) {
        const int seq = sh < 64 ? (sh >> 5) : 2 + ((sh - 64) >> 5), head = sh & 31;
        const int nch = seq_chunks(seq);
        const float dsk = F.inp(13)[j * SSD_HEADS + head];
        __syncthreads();
        if (loader) {
            u32x4 A[15], B[15];
            ssd_stage_load(A, F, sc, lt, seq, head, 0); ssd_stage_write(A, F.ldsl, lt);
            if (nch > 1) ssd_stage_load(B, F, sc, lt, seq, head, 1);
            if (nch > 2) ssd_stage_load(A, F, sc, lt, seq, head, 2);
            __syncthreads();
#define SSD_LOADER_STEP(CC, ST) { const int cc_ = (CC); int nxt = ((cc_ + 1) & 1) * SL_SIZE, lt_ = lt; asm volatile("" : "+s"(nxt), "+v"(lt_)); \
                if (cc_ > 0) ssd_ytile_out<DRY>(F.ldsl + nxt, ssd_xtile(F, seq, cc_ - 1, head), lt_); \
                if (cc_ + 1 < nch) ssd_stage_write(ST, F.ldsl + nxt, lt_); \
                if (cc_ + 3 < nch) ssd_stage_load(ST, F, sc, lt_, seq, head, cc_ + 3); \
                __syncthreads(); }
            for (int c = 0; c < nch; c += 2) {
                SSD_LOADER_STEP(c, B)
                if (c + 1 < nch) SSD_LOADER_STEP(c + 1, A)
            }
#undef SSD_LOADER_STEP
            ssd_ytile_out<DRY>(F.ldsl + ((nch - 1) & 1) * SL_SIZE, ssd_xtile(F, seq, nch - 1, head), lt);
        } else {
            f32x4 HT[8];
#pragma unroll
            for (int m8 = 0; m8 < 8; ++m8) HT[m8] = (f32x4){0.f, 0.f, 0.f, 0.f};
            if (seq >= 2) {
                const int i = F.lane & 15, g = F.lane >> 4;
                const float* st = F.inp(2) + ((((size_t)j * 8 + (seq - 2)) * SSD_HEADS + head) * SSD_P + ps * 16 + i) * SSD_N + 4 * g;
#pragma unroll
                for (int m8 = 0; m8 < 8; ++m8) HT[m8] = *(const f32x4*)(st + 16 * m8);
            }
            __syncthreads();
            for (int c = 0; c < nch; ++c) {
                int cur = (c & 1) * SL_SIZE, lane_ = F.lane;
                asm volatile("" : "+s"(cur), "+v"(lane_));
                LAS unsigned char* img = F.ldsl + cur;
                const int i = lane_ & 15, g = lane_ >> 4, prow = ps * 16 + i, psw = (prow >> 1) & 7;
                const LAS unsigned char* pc[4]; const LAS unsigned char* pm[2];
#pragma unroll
                for (int kk = 0; kk < 4; ++kk) pc[kk] = img + SL_C + i * 256 + (((4 * kk + g) ^ i) * 16);
#pragma unroll
                for (int k2 = 0; k2 < 2; ++k2) pm[k2] = img + i * 128 + (((4 * k2 + g) ^ (i >> 1)) * 16);
                f32x4 e24[4], w4[4], ecs4[4];
#pragma unroll
                for (int m = 0; m < 4; ++m) { e24[m] = *(const LAS f32x4*)(img + SL_VEC + (16 * m + 4 * g) * 4); w4[m] = *(const LAS f32x4*)(img + SL_VEC + 256 + (16 * m + 4 * g) * 4); ecs4[m] = *(const LAS f32x4*)(img + SL_VEC + 512 + (16 * m + 4 * g) * 4); }
                const float ecl = *(const LAS float*)(img + SL_VEC + 512 + 63 * 4);
                bf16x8 Hf[4];
#pragma unroll
                for (int kk = 0; kk < 4; ++kk) Hf[kk] = pack8(HT[2 * kk], HT[2 * kk + 1]);
                f32x4 Y[4];
#pragma unroll
                for (int m = 0; m < 4; ++m) {
                    f32x4 acc = (f32x4){0.f, 0.f, 0.f, 0.f};
#pragma unroll
                    for (int kk = 0; kk < 4; ++kk) { const bf16x8 cf = *(const LAS bf16x8*)(pc[kk] + m * 4096); acc = __builtin_amdgcn_mfma_f32_16x16x32_bf16(cf, Hf[kk], acc, 0, 0, 0); }
                    Y[m] = acc * ecs4[m];
                }
                f32x4 xv[4];
                LAS unsigned char* xrow = img + SL_XT + prow * 128 + 8 * (g & 1);
#pragma unroll
                for (int m = 0; m < 4; ++m) {
                    const u32x2 xw = *(const LAS u32x2*)(xrow + ((2 * m + (g >> 1)) ^ psw) * 16);
                    xv[m][0] = __uint_as_float(xw.x << 16); xv[m][1] = __uint_as_float(xw.x & 0xffff0000u); xv[m][2] = __uint_as_float(xw.y << 16); xv[m][3] = __uint_as_float(xw.y & 0xffff0000u);
                }
                bf16x8 xsf[2], xwf[2];
#pragma unroll
                for (int k2 = 0; k2 < 2; ++k2) { xsf[k2] = pack8(xv[2 * k2] * e24[2 * k2], xv[2 * k2 + 1] * e24[2 * k2 + 1]); xwf[k2] = pack8(xv[2 * k2] * w4[2 * k2], xv[2 * k2 + 1] * w4[2 * k2 + 1]); }
#pragma unroll
                for (int m = 0; m < 4; ++m)
#pragma unroll
                    for (int k2 = 0; k2 < 2; ++k2) { const bf16x8 mf = *(const LAS bf16x8*)(pm[k2] + SL_M + m * 2048); Y[m] = __builtin_amdgcn_mfma_f32_16x16x32_bf16(mf, xsf[k2], Y[m], 0, 0, 0); }
#pragma unroll
                for (int m8 = 0; m8 < 8; ++m8) {
                    f32x4 acc = HT[m8] * ecl;
#pragma unroll
                    for (int k2 = 0; k2 < 2; ++k2) { const bf16x8 bf = *(const LAS bf16x8*)(pm[k2] + SL_BT + m8 * 2048); acc = __builtin_amdgcn_mfma_f32_16x16x32_bf16(bf, xwf[k2], acc, 0, 0, 0); }
                    HT[m8] = acc;
                }
#pragma unroll
                for (int m = 0; m < 4; ++m) {
                    const f32x4 y = Y[m] + xv[m] * dsk; u32x2 w; w.x = cvt_pk_bf16(y[0], y[1]); w.y = cvt_pk_bf16(y[2], y[3]);
                    *(LAS u32x2*)(xrow + ((2 * m + (g >> 1)) ^ psw) * 16) = w;
                }
                __syncthreads();
            }
            const int i = F.lane & 15, g = F.lane >> 4;
            float* so = (seq < 2) ? F.out + O_PSSD + ((((size_t)j * 2 + seq) * SSD_HEADS + head) * SSD_P + ps * 16 + i) * SSD_N + 4 * g
                                  : F.out + O_SSSD + ((((size_t)j * 8 + (seq - 2)) * SSD_HEADS + head) * SSD_P + ps * 16 + i) * SSD_N + 4 * g;
#pragma unroll
            for (int m8 = 0; m8 < 8; ++m8) { if (!DRY) *(f32x4*)(so + 16 * m8) = HT[m8]; else KEEP(HT[m8]); }
        }
    }
}

__device__ void phase_ssd_post(const Frame& F0, int j) {
    const Frame F = relaunder(F0);
    constexpr int RS = 68;
    bf16_t* YT = (bf16_t*)F.lds;
    for (int task = F.bid; task < NCHT * 4; task += F.G) {
        const int cgi = task >> 2, grp = task & 3; int seq, c; chunk_of(cgi, seq, c);
        const int base = seq_base(seq), t0 = 64 * c - PADF;
        __syncthreads();
#pragma unroll
        for (int r = 0; r < 8; ++r) {
            const int k = F.tid + 512 * r, hl = k >> 9, p = (k >> 3) & 63, ch = k & 7;
            const XTile xt = ssd_xtile(F, seq, c, grp * 8 + hl);
            const u32x4 w = *(const u32x4*)(xt.p + (size_t)p * xt.stride + ch * 8);
            u32x2* d = (u32x2*)(YT + (hl * 64 + p) * RS + ch * 8); u32x2 a, b; a.x = w.x; a.y = w.y; b.x = w.z; b.y = w.w; d[0] = a; d[1] = b;
        }
        __syncthreads();
        for (int q = 0; q < 8; ++q) {
            const int l = F.wave + 8 * q, t = t0 + l;
            if (t < 0 && seq >= 2) continue;
            const int row = seq < 2 ? seq * TPP + 64 * c + l : base + t;
            bf16_t* zrow = F.proj + (size_t)row * LDP + grp * 512 + F.lane;
            float yg[8]; float ss = 0.f;
#pragma unroll
            for (int e = 0; e < 8; ++e) { const float y = bf2f(YT[(e * 64 + F.lane) * RS + l]), z = bf2f(zrow[64 * e]); yg[e] = y * silu_f(z); ss += yg[e] * yg[e]; }
            ss = wave_sum(ss);
            const float rs = rsqrtf(ss * (1.0f / 512.0f) + EPS);
#pragma unroll
            for (int e = 0; e < 8; ++e) zrow[64 * e] = f2bf(yg[e] * rs);
        }
    }
    for (int e = F.bid * NTHREADS + F.tid; e < NSEQ * 3 * SSD_CONV; e += F.G * NTHREADS) {
        const int s = e / (3 * SSD_CONV), r = (e / SSD_CONV) % 3, c = e % SSD_CONV;
        const int row = seq_base(s) + seq_len(s) - 3 + r;
        float v;
        if (s < 2 && c < 2048) v = bf2f(F.tails[((size_t)(s * 129 + 128) * 3 + r) * 4096 + c]);
        else v = bf2f(F.proj[(size_t)row * LDP + 2048 + c]);
        if (s < 2) F.out[O_PSSDC + (((size_t)j * 2 + s) * 3 + r) * SSD_CONV + c] = v;
        else F.out[O_SSSDC + (((size_t)j * 8 + (s - 2)) * 3 + r) * SSD_CONV + c] = v;
    }
}

constexpr size_t SG_W = 0;
constexpr size_t SG_QK = SG_W + (size_t)NCHT * 8 * 16384;
constexpr size_t SG_VEC = SG_QK + (size_t)NCHT * 8 * 8192;
constexpr size_t SG_PART = SG_VEC + (size_t)NCHT * 8 * 1024;
constexpr size_t SG_SIDE = SG_PART + (size_t)M_TOT * 128 * 2;
constexpr size_t SG_END = SG_SIDE + (size_t)64 * 65536;
static_assert(SG_END <= (size_t)16777216 * 4, "scratch must fit the y_prompt region");
struct GTile { bf16_t* q; bf16_t* k; bf16_t* v; int sq, sk, sv; };
__device__ __forceinline__ GTile gdn_tile(const Frame& F, int seq, int c, int head) {
    GTile t;
    if (seq < 2) { bf16_t* r0 = F.proj + (size_t)(seq * TPP + 64 * c) * LDP; t.q = r0 + head * 128; t.k = r0 + 1024 + head * 128; t.v = r0 + 2048 + head * 256; t.sq = LDP; t.sk = LDP; t.sv = LDP; }
    else { bf16_t* b = (bf16_t*)((unsigned char*)F.out + SG_SIDE) + (size_t)((seq - 2) * 8 + head) * 32768; t.q = b; t.k = b + 8192; t.v = b + 16384; t.sq = 128; t.sk = 128; t.sv = 256; }
    return t;
}

template <bool DRY>
__device__ void phase_gdn_prep(const Frame& F0, int j) {
    const Frame F = relaunder(F0);
    float* Am = (float*)F.lds;
    float* vgc = Am + 64 * 68;
    float* vbe = vgc + 64;
    float* vnq = vbe + 64;
    float* vnk = vnq + 64;
    bf16_t* qs = (bf16_t*)(vnk + 64);
    bf16_t* ks = qs + 64 * 136;
    bf16_t* kT = ks + 64 * 136;
    bf16_t* vT = kT + 128 * 72;
    bf16_t* Tb = vT + 256 * 72;
    unsigned char* sc = (unsigned char*)F.out;
    const float* conv_w = F.inp(18) + (size_t)j * 4 * GDN_CONV;
    const int i16 = F.lane & 15, g4 = F.lane >> 4;
    constexpr float CQ = 0.08838834764831845f;
    for (int task = F.bid; task < NCHT * 8; task += F.G) {
        const int cgi = task >> 3, head = task & 7; int seq, c; chunk_of(cgi, seq, c);
        const int base = seq_base(seq), t0 = 64 * c - PADF;
        const GTile tl = gdn_tile(F, seq, c, head);
        __syncthreads();
        if (F.wave == 0) {
            const int t = t0 + F.lane; float gg = 0.f, be = 0.f;
            if (t >= 0) { const float* dp = F.dtb + (size_t)(base + t) * 32; gg = -__expf(F.inp(20)[j * GDN_HEADS + head]) * softplus_f(dp[head] + F.inp(19)[j * GDN_HEADS + head]); be = 1.0f / (1.0f + __expf(-dp[8 + head])); }
#pragma unroll
            for (int o = 1; o < 64; o <<= 1) { const float y = __shfl_up(gg, o); if (F.lane >= o) gg += y; }
            vgc[F.lane] = gg; vbe[F.lane] = be;
        }
        __syncthreads();
        {
            const int ch = F.tid;
            const int cidx = ch < 128 ? head * 128 + ch : (ch < 256 ? 1024 + head * 128 + (ch - 128) : 2048 + head * 256 + (ch - 256));
            const float w0 = conv_w[cidx], w1 = conv_w[GDN_CONV + cidx], w2 = conv_w[2 * GDN_CONV + cidx], w3 = conv_w[3 * GDN_CONV + cidx];
            const float* cst = (seq >= 2) ? F.inp(5) + (((size_t)j * 8 + (seq - 2)) * 3) * GDN_CONV + cidx : nullptr;
            const bf16_t* tailp = (seq < 2 && c > 0) ? F.tails + (size_t)(cgi - 1) * 3 * 4096 + cidx : nullptr;
            float r3 = 0.f, r2 = 0.f, r1 = 0.f;
            if (tailp) { r3 = bf2f(tailp[0]); r2 = bf2f(tailp[4096]); r1 = bf2f(tailp[2 * 4096]); }
            else if (cst) { r3 = cst[0]; r2 = cst[GDN_CONV]; r1 = cst[2 * GDN_CONV]; }
            const bf16_t* col = F.proj + cidx;
#pragma unroll 1
            for (int pg = 0; pg < 2; ++pg) {
                unsigned short raw[32];
#pragma unroll
                for (int e = 0; e < 32; ++e) { const int t = t0 + 32 * pg + e; raw[e] = col[(size_t)(base + (t > 0 ? t : 0)) * LDP]; }
#pragma unroll
                for (int e = 0; e < 32; ++e) {
                    const int p = 32 * pg + e, t = t0 + p;
                    const float x = (t >= 0) ? bf2f(raw[e]) : 0.f;
                    const float o = silu_f(w0 * r3 + w1 * r2 + w2 * r1 + w3 * x);
                    if (t >= 0) { r3 = r2; r2 = r1; r1 = x; }
                    if (ch < 128) qs[p * 136 + ch] = f2bf(o);
                    else if (ch < 256) { const bf16_t b = f2bf(o); ks[p * 136 + (ch - 128)] = b; kT[(ch - 128) * 72 + p] = b; }
                    else vT[(ch - 256) * 72 + p] = f2bf(o * vbe[p]);
                }
            }
        }
        __syncthreads();
        if (F.tid < 128) {
            const int l = F.tid & 63; const bf16_t* rowp = (F.tid < 64 ? qs : ks) + l * 136; float ss = 0.f;
#pragma unroll
            for (int q = 0; q < 16; ++q) { const u32x4 v = *(const u32x4*)(rowp + 8 * q);
                const float a0 = __uint_as_float(v.x << 16), a1 = __uint_as_float(v.x & 0xffff0000u), a2 = __uint_as_float(v.y << 16), a3 = __uint_as_float(v.y & 0xffff0000u);
                const float a4 = __uint_as_float(v.z << 16), a5 = __uint_as_float(v.z & 0xffff0000u), a6 = __uint_as_float(v.w << 16), a7 = __uint_as_float(v.w & 0xffff0000u);
                ss += ((a0 * a0 + a1 * a1) + (a2 * a2 + a3 * a3)) + ((a4 * a4 + a5 * a5) + (a6 * a6 + a7 * a7)); }
            (F.tid < 64 ? vnq : vnk)[l] = rsqrtf(ss + EPS);
        }
        __syncthreads();
        {
            bf16_t* QKg = (bf16_t*)(sc + SG_QK) + (size_t)task * 4096;
            const int m = F.wave >> 1;
#pragma unroll
            for (int u = 0; u < 2; ++u) {
                const int st = 2 * (F.wave & 1) + u; f32x4 aK = (f32x4){0.f, 0.f, 0.f, 0.f}, aQ = (f32x4){0.f, 0.f, 0.f, 0.f};
#pragma unroll
                for (int kk = 0; kk < 4; ++kk) {
                    const bf16x8 ak = *(const bf16x8*)(ks + (16 * m + i16) * 136 + 32 * kk + 8 * g4);
                    const bf16x8 aq = *(const bf16x8*)(qs + (16 * m + i16) * 136 + 32 * kk + 8 * g4);
                    const bf16x8 b = *(const bf16x8*)(ks + (16 * st + i16) * 136 + 32 * kk + 8 * g4);
                    aK = __builtin_amdgcn_mfma_f32_16x16x32_bf16(ak, b, aK, 0, 0, 0);
                    aQ = __builtin_amdgcn_mfma_f32_16x16x32_bf16(aq, b, aQ, 0, 0, 0);
                }
                const int s_ = 16 * st + i16; const float gs = vgc[s_], nks = vnk[s_]; const int qs_ = qperm(s_);
#pragma unroll
                for (int jj = 0; jj < 4; ++jj) {
                    const int l = 16 * m + 4 * g4 + jj;
                    const float dec = (s_ <= l) ? __expf(vgc[l] - gs) : 0.f;
                    Am[l * 68 + s_] = (s_ < l) ? vbe[l] * vnk[l] * nks * aK[jj] * dec : 0.f;
                    { const float r = CQ * vnq[l] * nks * aQ[jj] * dec; if (!DRY) QKg[l * 64 + qs_] = f2bf(r); else KEEP(r); }
                }
            }
        }
        __syncthreads();
        if (F.wave == 0) {
            int cc = F.lane; asm volatile("" : "+v"(cc));
            float x[64];
#pragma unroll
            for (int l = 0; l < 64; ++l) {
                float a0 = (l == cc) ? 1.f : 0.f, a1 = 0.f, a2 = 0.f, a3 = 0.f;
#pragma unroll
                for (int s4 = 0; s4 + 4 <= l; s4 += 4) { const f32x4 av = *(const f32x4*)(Am + l * 68 + s4); a0 -= av[0] * x[s4]; a1 -= av[1] * x[s4 + 1]; a2 -= av[2] * x[s4 + 2]; a3 -= av[3] * x[s4 + 3]; }
                if (l & 3) { const f32x4 av = *(const f32x4*)(Am + l * 68 + (l & ~3));
                    a0 -= av[0] * x[l & ~3]; if ((l & 3) > 1) a1 -= av[1] * x[(l & ~3) + 1]; if ((l & 3) > 2) a2 -= av[2] * x[(l & ~3) + 2]; }
                x[l] = (a0 + a1) + (a2 + a3);
            }
            const float csc = vbe[cc] * __expf(vgc[cc]) * vnk[cc];
#pragma unroll
            for (int l = 0; l < 64; ++l) { Tb[l * 72 + cc] = f2bf(x[l]); Tb[64 * 72 + l * 72 + cc] = f2bf(x[l] * csc); }
        } else {
            const int t7 = F.tid - 64;
            for (int idx = t7; idx < 1024; idx += 448) {
                const int l = idx >> 4, qg8 = idx & 15, kk = qg8 >> 2, gg = qg8 & 3;
                const u32x2 a = *(const u32x2*)(qs + l * 136 + 32 * kk + 4 * gg), b = *(const u32x2*)(qs + l * 136 + 32 * kk + 16 + 4 * gg);
                u32x4 w; w.x = a.x; w.y = a.y; w.z = b.x; w.w = b.y;
                if (!DRY) *(u32x4*)(tl.q + (size_t)l * tl.sq + 8 * qg8) = w; else KEEP(w);
            }
            for (int idx = t7; idx < 1024; idx += 448) {
                const int kd = idx >> 3, pg = idx & 7, kk2 = pg >> 2, gg = pg & 3;
                const u32x2 a = *(const u32x2*)(kT + kd * 72 + 32 * kk2 + 4 * gg), b = *(const u32x2*)(kT + kd * 72 + 32 * kk2 + 16 + 4 * gg);
                u32x4 w; w.x = a.x; w.y = a.y; w.z = b.x; w.w = b.y;
                if (!DRY) *(u32x4*)(tl.k + (size_t)(kd >> 1) * tl.sk + (kd & 1) * 64 + 8 * pg) = w; else KEEP(w);
            }
            if (t7 < 64) {
                float* vp = (float*)(sc + SG_VEC) + (size_t)task * 256; const float gl = vgc[63];
                const float v0 = __expf(vgc[t7]) * CQ * vnq[t7], v1 = vnk[t7] * __expf(gl - vgc[t7]), v2 = __expf(gl);
                if (!DRY) { vp[t7] = v0; vp[64 + t7] = v1; vp[128 + t7] = v2; vp[192 + t7] = 0.f; } else { KEEP(v0); KEEP(v1); KEEP(v2); }
            }
        }
        __syncthreads();
        {
            bf16_t* Wg = (bf16_t*)(sc + SG_W) + (size_t)task * 8192;
            bf16x8 bk[2];
#pragma unroll
            for (int k2 = 0; k2 < 2; ++k2) bk[k2] = *(const bf16x8*)(kT + (16 * F.wave + i16) * 72 + 32 * k2 + 8 * g4);
            const int qkd = qperm(16 * F.wave + i16);
#pragma unroll
            for (int m = 0; m < 4; ++m) {
                f32x4 acc = (f32x4){0.f, 0.f, 0.f, 0.f};
#pragma unroll
                for (int k2 = 0; k2 < 2; ++k2) { const bf16x8 a = *(const bf16x8*)(Tb + 64 * 72 + (16 * m + i16) * 72 + 32 * k2 + 8 * g4); acc = __builtin_amdgcn_mfma_f32_16x16x32_bf16(a, bk[k2], acc, 0, 0, 0); }
#pragma unroll
                for (int jj = 0; jj < 4; ++jj) { if (!DRY) Wg[(16 * m + 4 * g4 + jj) * 128 + qkd] = f2bf(acc[jj]); else KEEP(acc[jj]); }
            }
#pragma unroll
            for (int u = 0; u < 2; ++u) {
                const int v = 16 * (2 * F.wave + u) + i16;
                bf16x8 bv[2];
#pragma unroll
                for (int k2 = 0; k2 < 2; ++k2) bv[k2] = *(const bf16x8*)(vT + v * 72 + 32 * k2 + 8 * g4);
#pragma unroll
                for (int m = 0; m < 4; ++m) {
                    f32x4 acc = (f32x4){0.f, 0.f, 0.f, 0.f};
#pragma unroll
                    for (int k2 = 0; k2 < 2; ++k2) { const bf16x8 a = *(const bf16x8*)(Tb + (16 * m + i16) * 72 + 32 * k2 + 8 * g4); acc = __builtin_amdgcn_mfma_f32_16x16x32_bf16(a, bv[k2], acc, 0, 0, 0); }
                    u32x2 w; w.x = cvt_pk_bf16(acc[0], acc[1]); w.y = cvt_pk_bf16(acc[2], acc[3]);
                    if (!DRY) *(u32x2*)(tl.v + (size_t)(v >> 2) * tl.sv + (v & 3) * 64 + 16 * m + 4 * g4) = w; else KEEP(w);
                }
            }
        }
    }
}

constexpr int GL_W = 0, GL_Q = 16384, GL_KT = 32768, GL_QK = 49152, GL_U = 57344, GL_VEC = 65536, GL_SIZE = 66560;
__device__ __forceinline__ bf16_t* gdn_urow(const GTile& tl, int v) { return tl.v + (size_t)(v >> 2) * tl.sv + (v & 3) * 64; }
__device__ __forceinline__ void gdn_stage_load(u32x4 (&P)[17], const Frame& F, const unsigned char* sc, int lt, int seq, int head, int vq, int c) {
    const int task = cgi_of(seq, c) * 8 + head;
    const GTile tl = gdn_tile(F, seq, c, head);
    const bf16_t* Wp = (const bf16_t*)(sc + SG_W) + (size_t)task * 8192;
    const bf16_t* QKp = (const bf16_t*)(sc + SG_QK) + (size_t)task * 4096;
    const float* vp = (const float*)(sc + SG_VEC) + (size_t)task * 256;
#pragma unroll
    for (int r = 0; r < 4; ++r) { const int k = lt + 256 * r;
        P[r] = *(const u32x4*)(Wp + k * 8);
        P[4 + r] = *(const u32x4*)(tl.q + (size_t)(k >> 4) * tl.sq + (k & 15) * 8);
        { const int kd = k >> 3; P[8 + r] = *(const u32x4*)(tl.k + (size_t)(kd >> 1) * tl.sk + (kd & 1) * 64 + (k & 7) * 8); } }
#pragma unroll
    for (int r = 0; r < 2; ++r) { const int k = lt + 256 * r;
        P[12 + r] = *(const u32x4*)(QKp + k * 8);
        P[14 + r] = *(const u32x4*)(gdn_urow(tl, vq * 64 + (k >> 3)) + (k & 7) * 8); }
    P[16] = *(const u32x4*)(vp + 4 * (lt < 48 ? lt : 0));
}
__device__ __forceinline__ void gdn_stage_write(const u32x4 (&P)[17], LAS unsigned char* img, int lt) {
#pragma unroll
    for (int r = 0; r < 4; ++r) { const int k = lt + 256 * r;
        { const int row = k >> 4, ch = k & 15, slot = row * 16 + (ch ^ (row & 15)); *(LAS u32x4*)(img + GL_W + slot * 16) = P[r]; *(LAS u32x4*)(img + GL_Q + slot * 16) = P[4 + r]; }
        { const int row = k >> 3, ch = k & 7; *(LAS u32x4*)(img + GL_KT + (row * 8 + (ch ^ ((row >> 1) & 7))) * 16) = P[8 + r]; } }
#pragma unroll
    for (int r = 0; r < 2; ++r) { const int k = lt + 256 * r, row = k >> 3, ch = k & 7, slot = row * 8 + (ch ^ ((row >> 1) & 7));
        *(LAS u32x4*)(img + GL_QK + slot * 16) = P[12 + r]; *(LAS u32x4*)(img + GL_U + slot * 16) = P[14 + r]; }
    if (lt < 48) *(LAS u32x4*)(img + GL_VEC + 16 * lt) = P[16];
}
template <bool DRY>
__device__ __forceinline__ void gdn_otile_out(const LAS unsigned char* img, const GTile& tl, int vq, int lt) {
#pragma unroll
    for (int r = 0; r < 2; ++r) { const int k = lt + 256 * r, row = k >> 3, ch = k & 7;
        const u32x4 w = *(const LAS u32x4*)(img + GL_U + (row * 8 + (ch ^ ((row >> 1) & 7))) * 16);
        if (!DRY) *(u32x4*)(gdn_urow(tl, vq * 64 + row) + ch * 8) = w; else KEEP(w); }
}
template <bool DRY>
__device__ void phase_gdn_chain(const Frame& F0, int j) {
    const Frame F = relaunder(F0);
    const unsigned char* sc = (const unsigned char*)F.out;
    const bool loader = F.wave >= 4; const int lt = F.tid - 256, w4 = F.wave & 3;
    for (int sh = F.bid; sh < 320; sh += F.G) {
        const int seq = sh < 64 ? (sh >> 5) : 2 + ((sh - 64) >> 5), head = (sh >> 2) & 7, vq = sh & 3;
        const int nch = seq_chunks(seq);
        __syncthreads();
        if (loader) {
            u32x4 A[17], B[17];
            gdn_stage_load(A, F, sc, lt, seq, head, vq, 0); gdn_stage_write(A, F.ldsl, lt);
            if (nch > 1) gdn_stage_load(B, F, sc, lt, seq, head, vq, 1);
            if (nch > 2) gdn_stage_load(A, F, sc, lt, seq, head, vq, 2);
            __syncthreads();
#define GDN_LOADER_STEP(CC, ST) { const int cc_ = (CC); int nxt = ((cc_ + 1) & 1) * GL_SIZE, lt_ = lt; asm volatile("" : "+s"(nxt), "+v"(lt_)); \
                if (cc_ > 0) gdn_otile_out<DRY>(F.ldsl + nxt, gdn_tile(F, seq, cc_ - 1, head), vq, lt_); \
                if (cc_ + 1 < nch) gdn_stage_write(ST, F.ldsl + nxt, lt_); \
                if (cc_ + 3 < nch) gdn_stage_load(ST, F, sc, lt_, seq, head, vq, cc_ + 3); \
                __syncthreads(); }
            for (int c = 0; c < nch; c += 2) {
                GDN_LOADER_STEP(c, B)
                if (c + 1 < nch) GDN_LOADER_STEP(c + 1, A)
            }
#undef GDN_LOADER_STEP
            gdn_otile_out<DRY>(F.ldsl + ((nch - 1) & 1) * GL_SIZE, gdn_tile(F, seq, nch - 1, head), vq, lt);
        } else {
            f32x4 S[8];
#pragma unroll
            for (int m8 = 0; m8 < 8; ++m8) S[m8] = (f32x4){0.f, 0.f, 0.f, 0.f};
            if (seq >= 2) {
                const int i = F.lane & 15, g = F.lane >> 4;
                const float* st = F.inp(4) + (((size_t)j * 8 + (seq - 2)) * GDN_HEADS + head) * GDN_DK * GDN_DV + vq * 64 + w4 * 16 + i;
#pragma unroll
                for (int m8 = 0; m8 < 8; ++m8)
#pragma unroll
                    for (int jj = 0; jj < 4; ++jj) S[m8][jj] = st[(size_t)(16 * m8 + 4 * g + jj) * GDN_DV];
            }
            __syncthreads();
            for (int c = 0; c < nch; ++c) {
                int cur = (c & 1) * GL_SIZE, lane_ = F.lane;
                asm volatile("" : "+s"(cur), "+v"(lane_));
                LAS unsigned char* img = F.ldsl + cur;
                const int i = lane_ & 15, g = lane_ >> 4, vrow = w4 * 16 + i, vsw = (vrow >> 1) & 7;
                const LAS unsigned char* pw[4]; const LAS unsigned char* pk[2];
#pragma unroll
                for (int kk = 0; kk < 4; ++kk) pw[kk] = img + i * 256 + (((4 * kk + g) ^ i) * 16);
#pragma unroll
                for (int k2 = 0; k2 < 2; ++k2) pk[k2] = img + i * 128 + (((4 * k2 + g) ^ (i >> 1)) * 16);
                f32x4 rsc[4], vsc[4];
#pragma unroll
                for (int m = 0; m < 4; ++m) { rsc[m] = *(const LAS f32x4*)(img + GL_VEC + (16 * m + 4 * g) * 4); vsc[m] = *(const LAS f32x4*)(img + GL_VEC + 256 + (16 * m + 4 * g) * 4); }
                const float egl = *(const LAS float*)(img + GL_VEC + 512);
                bf16x8 Sf[4];
#pragma unroll
                for (int kk = 0; kk < 4; ++kk) Sf[kk] = pack8(S[2 * kk], S[2 * kk + 1]);
                LAS unsigned char* urow = img + GL_U + vrow * 128 + 8 * (g & 1);
                f32x4 vn[4], O[4];
#pragma unroll
                for (int m = 0; m < 4; ++m) {
                    f32x4 a1 = (f32x4){0.f, 0.f, 0.f, 0.f}, a2 = (f32x4){0.f, 0.f, 0.f, 0.f};
#pragma unroll
                    for (int kk = 0; kk < 4; ++kk) {
                        const bf16x8 wf = *(const LAS bf16x8*)(pw[kk] + GL_W + m * 4096), qf = *(const LAS bf16x8*)(pw[kk] + GL_Q + m * 4096);
                        a1 = __builtin_amdgcn_mfma_f32_16x16x32_bf16(wf, Sf[kk], a1, 0, 0, 0);
                        a2 = __builtin_amdgcn_mfma_f32_16x16x32_bf16(qf, Sf[kk], a2, 0, 0, 0);
                    }
                    const u32x2 uw = *(const LAS u32x2*)(urow + ((2 * m + (g >> 1)) ^ vsw) * 16);
                    vn[m][0] = __uint_as_float(uw.x << 16) - a1[0]; vn[m][1] = __uint_as_float(uw.x & 0xffff0000u) - a1[1];
                    vn[m][2] = __uint_as_float(uw.y << 16) - a1[2]; vn[m][3] = __uint_as_float(uw.y & 0xffff0000u) - a1[3];
                    O[m] = a2 * rsc[m];
                }
                bf16x8 Vf[2], Vsf[2];
#pragma unroll
                for (int k2 = 0; k2 < 2; ++k2) { Vf[k2] = pack8(vn[2 * k2], vn[2 * k2 + 1]); Vsf[k2] = pack8(vn[2 * k2] * vsc[2 * k2], vn[2 * k2 + 1] * vsc[2 * k2 + 1]); }
#pragma unroll
                for (int m = 0; m < 4; ++m)
#pragma unroll
                    for (int k2 = 0; k2 < 2; ++k2) { const bf16x8 qk = *(const LAS bf16x8*)(pk[k2] + GL_QK + m * 2048); O[m] = __builtin_amdgcn_mfma_f32_16x16x32_bf16(qk, Vf[k2], O[m], 0, 0, 0); }
#pragma unroll
                for (int m8 = 0; m8 < 8; ++m8) {
                    f32x4 acc = S[m8] * egl;
#pragma unroll
                    for (int k2 = 0; k2 < 2; ++k2) { const bf16x8 kf = *(const LAS bf16x8*)(pk[k2] + GL_KT + m8 * 2048); acc = __builtin_amdgcn_mfma_f32_16x16x32_bf16(kf, Vsf[k2], acc, 0, 0, 0); }
                    S[m8] = acc;
                }
#pragma unroll
                for (int m = 0; m < 4; ++m) { u32x2 w; w.x = cvt_pk_bf16(O[m][0], O[m][1]); w.y = cvt_pk_bf16(O[m][2], O[m][3]); *(LAS u32x2*)(urow + ((2 * m + (g >> 1)) ^ vsw) * 16) = w; }
                __syncthreads();
            }
            const int i = F.lane & 15, g = F.lane >> 4, vcol = vq * 64 + w4 * 16 + i;
            float* so = (seq < 2) ? F.out + O_PGDN + (((size_t)j * 2 + seq) * GDN_HEADS + head) * GDN_DK * GDN_DV + vcol
                                  : F.out + O_SGDN + (((size_t)j * 8 + (seq - 2)) * GDN_HEADS + head) * GDN_DK * GDN_DV + vcol;
#pragma unroll
            for (int m8 = 0; m8 < 8; ++m8)
#pragma unroll
                for (int jj = 0; jj < 4; ++jj) { if (!DRY) so[(size_t)(16 * m8 + 4 * g + jj) * GDN_DV] = S[m8][jj]; else KEEP(S[m8][jj]); }
        }
    }
}

__device__ void phase_gdn_post2(const Frame& F0, int j) {
    const Frame F = relaunder(F0);
    constexpr int RS = 68;
    bf16_t* OT = (bf16_t*)F.lds;
    for (int task = F.bid; task < NCHT * 8; task += F.G) {
        const int cgi = task >> 3, head = task & 7; int seq, c; chunk_of(cgi, seq, c);
        const int base = seq_base(seq), t0 = 64 * c - PADF;
        const GTile tl = gdn_tile(F, seq, c, head);
        __syncthreads();
#pragma unroll
        for (int r = 0; r < 4; ++r) {
            const int k = F.tid + 512 * r, v = k >> 3, ch = k & 7;
            const u32x4 w = *(const u32x4*)(gdn_urow(tl, v) + ch * 8);
            u32x2* d = (u32x2*)(OT + v * RS + ch * 8); u32x2 a, b; a.x = w.x; a.y = w.y; b.x = w.z; b.y = w.w; d[0] = a; d[1] = b;
        }
        __syncthreads();
        for (int q = 0; q < 8; ++q) {
            const int l = F.wave + 8 * q, t = t0 + l;
            if (t < 0 && seq >= 2) continue;
            const int row = seq < 2 ? seq * TPP + 64 * c + l : base + t;
            bf16_t* zrow = F.proj + (size_t)row * LDP + 4096 + head * 256 + F.lane;
            float o[4]; float ss = 0.f;
#pragma unroll
            for (int e = 0; e < 4; ++e) { o[e] = bf2f(OT[(64 * e + F.lane) * RS + l]); ss += o[e] * o[e]; }
            ss = wave_sum(ss);
            const float rs = rsqrtf(ss * (1.0f / 256.0f) + EPS);
#pragma unroll
            for (int e = 0; e < 4; ++e) { const float z = bf2f(zrow[64 * e]); zrow[64 * e] = f2bf(o[e] * rs * silu_f(z)); }
        }
    }
    for (int e = F.bid * NTHREADS + F.tid; e < NSEQ * 3 * GDN_CONV; e += F.G * NTHREADS) {
        const int s = e / (3 * GDN_CONV), r = (e / GDN_CONV) % 3, c = e % GDN_CONV;
        if (s < 2) F.out[O_PGDNC + (((size_t)j * 2 + s) * 3 + r) * GDN_CONV + c] = bf2f(F.tails[((size_t)(s * 129 + 128) * 3 + r) * 4096 + c]);
        else F.out[O_SGDNC + (((size_t)j * 8 + (s - 2)) * 3 + r) * GDN_CONV + c] = bf2f(F.proj[(size_t)(seq_base(s) + 13 + r) * LDP + c]);
    }
}

__device__ void phase_final(const Frame& F0) {
    const Frame F = relaunder(F0);
    const float* fw = F.inp(23);
    for (int it = F.bid * 8 + F.wave; it < 2 * SEQ + 128; it += F.G * 8) {
        int row; float* dst;
        if (it < 2 * SEQ) { const int b = it / SEQ, t = it % SEQ; row = b * TPP + 64 + t; dst = F.out + O_YP + (size_t)it * D; }
        else { row = ROW_S0 + (it - 2 * SEQ); dst = F.out + O_YS + (size_t)(it - 2 * SEQ) * D; }
        float x[16]; float ss = 0.f;
#pragma unroll
        for (int i = 0; i < 4; ++i) {
            const u32x2 v = *(const u32x2*)(F.hb + (size_t)row * D + (F.lane + 64 * i) * 4);
            x[4 * i + 0] = __uint_as_float(v.x << 16); x[4 * i + 1] = __uint_as_float(v.x & 0xffff0000u); x[4 * i + 2] = __uint_as_float(v.y << 16); x[4 * i + 3] = __uint_as_float(v.y & 0xffff0000u);
            ss += (x[4 * i] * x[4 * i] + x[4 * i + 1] * x[4 * i + 1]) + (x[4 * i + 2] * x[4 * i + 2] + x[4 * i + 3] * x[4 * i + 3]);
        }
        ss = wave_sum(ss);
        const float rs = rsqrtf(ss * (1.0f / 1024.0f) + EPS);
#pragma unroll
        for (int i = 0; i < 4; ++i) {
            const int c = (F.lane + 64 * i) * 4; const f32x4 w = *(const f32x4*)(fw + c);
            f32x4 o; o[0] = x[4 * i] * rs * w[0]; o[1] = x[4 * i + 1] * rs * w[1]; o[2] = x[4 * i + 2] * rs * w[2]; o[3] = x[4 * i + 3] * rs * w[3];
            *(f32x4*)(dst + c) = o;
        }
    }
}

constexpr int N_PHASES = 22;
#ifndef REP_INPROJ
#define REP_INPROJ 1
#endif
#ifndef REP_SSD_PREP
#define REP_SSD_PREP 1
#endif
#ifndef REP_SSD_CHAIN
#define REP_SSD_CHAIN 1
#endif
#ifndef REP_GDN_PREP
#define REP_GDN_PREP 1
#endif
#ifndef REP_GDN_CHAIN
#define REP_GDN_CHAIN 1
#endif
#ifndef REP_WPREP
#define REP_WPREP 1
#endif
#ifndef REP_FINAL
#define REP_FINAL 1
#endif
#ifndef MK_ONE_LAUNCH
#define MK_ONE_LAUNCH 1
#endif
__global__ void __launch_bounds__(NTHREADS, 2) hybrid_fwd(Args args) {
    extern __shared__ __attribute__((aligned(16))) unsigned char lds[];
    volatile LAS unsigned* bst = (volatile LAS unsigned*)((LAS unsigned char*)lds + LDS_BYTES - 16);
    if (threadIdx.x < 4) bst[threadIdx.x] = 0u;
    __syncthreads();
    XcdBarrier bar; bar.bar = (unsigned*)(args.ws + WS_CTL); bar.x = 0; bar.st = bst;
    if (args.ph_hi - args.ph_lo > 1) bar = xcd_barrier_post((unsigned*)(args.ws + WS_CTL), bst);
    for (int ph = args.ph_lo; ph < args.ph_hi; ++ph) {
        int tid_ = threadIdx.x; asm volatile("" : "+v"(tid_));
        Frame F;
        F.ap = &args;
        F.out = args.out; F.ws = args.ws; F.lds = lds; F.ldsl = (LAS unsigned char*)lds;
        F.tid = tid_; F.lane = F.tid & 63; F.wave = __builtin_amdgcn_readfirstlane(F.tid >> 6); F.G = gridDim.x; F.bid = blockIdx.x;
        F.hb = nullptr; F.win = nullptr; F.wout = nullptr; F.dtb = nullptr; F.rss = nullptr; F.proj = nullptr; F.tails = nullptr;
        if (ph == 0) { phase_init_h(F); phase_wprep_in(F, 0); }
        else if (ph == N_PHASES - 1) { for (int r = 0; r < REP_FINAL; ++r) phase_final(F); }
        else {
            const int L = (ph - 1) / 5, sub = (ph - 1) % 5, j = L >> 1;
            if (sub == 0) { for (int r = 0; r < REP_INPROJ; ++r) phase_inproj(F, L); }
            else if (sub == 1) {
                if (L & 1) { for (int r = 1; r < REP_GDN_PREP; ++r) phase_gdn_prep<true>(F, j); phase_gdn_prep<false>(F, j); }
                else { for (int r = 1; r < REP_SSD_PREP; ++r) phase_ssd_prep<true>(F, j); phase_ssd_prep<false>(F, j); }
                for (int r = 0; r < REP_WPREP; ++r) phase_wprep_out(F, L); }
            else if (sub == 2) {
                if (L & 1) { for (int r = 1; r < REP_GDN_CHAIN; ++r) phase_gdn_chain<true>(F, j); phase_gdn_chain<false>(F, j); }
                else { for (int r = 1; r < REP_SSD_CHAIN; ++r) phase_ssd_chain<true>(F, j); phase_ssd_chain<false>(F, j); } }
            else if (sub == 3) { if (L & 1) phase_gdn_post2(F, j); else phase_ssd_post(F, j); if (L < 3) { for (int r = 0; r < REP_WPREP; ++r) phase_wprep_in(F, L + 1); } }
            else phase_outproj(F, L);
        }
        if (ph + 1 < args.ph_hi) {
            if (ph == args.ph_lo) { __threadfence(); cg::this_grid().sync(); }
            else xcd_barrier(bar);
        }
    }
}

extern "C" void kernel_launch(void* const* d_in, const int* in_sizes, int n_in, void* d_out, int out_size, void* d_ws, size_t ws_size, hipStream_t stream) {
    static int grid = 0;
    if (grid == 0) {
        if (n_in != 24 || ws_size < WS_END) { fprintf(stderr, "kernel_launch: unexpected n_in %d / ws %zu (need %zu)\n", n_in, ws_size, (size_t)WS_END); grid = -1; return; }
        int dev = 0, cus = 0, per_cu = 0;
        if (hipGetDevice(&dev) != hipSuccess || hipDeviceGetAttribute(&cus, hipDeviceAttributeMultiprocessorCount, dev) != hipSuccess) { grid = -1; return; }
        if (hipFuncSetAttribute((const void*)hybrid_fwd, hipFuncAttributeMaxDynamicSharedMemorySize, LDS_BYTES) != hipSuccess) { fprintf(stderr, "kernel_launch: hipFuncSetAttribute failed\n"); grid = -1; return; }
        if (hipOccupancyMaxActiveBlocksPerMultiprocessor(&per_cu, (const void*)hybrid_fwd, NTHREADS, LDS_BYTES) != hipSuccess || per_cu < 1) { fprintf(stderr, "kernel_launch: occupancy query says %d blocks per CU\n", per_cu); grid = -1; return; }
        (void)hipGetLastError();
        grid = cus;
    }
    if (grid < 0) return;
    Args a{};
    for (int i = 0; i < 24; ++i) a.in[i] = (const float*)d_in[i];
    a.out = (float*)d_out; a.ws = (unsigned char*)d_ws;
#if MK_ONE_LAUNCH
    (void)hipMemsetAsync((char*)d_ws + WS_CTL, 0, 16384, stream);
    a.ph_lo = 0; a.ph_hi = N_PHASES;
    void* kargs[] = {&a};
    hipError_t e = hipLaunchCooperativeKernel((const void*)hybrid_fwd, dim3(grid), dim3(NTHREADS), kargs, LDS_BYTES, stream);
    if (e != hipSuccess) fprintf(stderr, "kernel_launch: cooperative launch failed: %s (grid %d)\n", hipGetErrorString(e), grid);
#else
    for (int ph = 0; ph < N_PHASES; ++ph) {
        a.ph_lo = ph; a.ph_hi = ph + 1;
        hipLaunchKernelGGL(hybrid_fwd, dim3(grid), dim3(NTHREADS), LDS_BYTES, stream, a);
    }
#endif
}
```

```cpp
#include <hip/hip_runtime.h>
#include <hip/hip_cooperative_groups.h>
#include <cstdio>
#include <cstdint>
namespace cg = cooperative_groups;

#define LAS __attribute__((address_space(3)))
typedef unsigned short bf16_t;
typedef short bf16x8 __attribute__((ext_vector_type(8)));
typedef float f32x4 __attribute__((ext_vector_type(4)));
typedef unsigned u32x4 __attribute__((ext_vector_type(4)));
typedef unsigned u32x2 __attribute__((ext_vector_type(2)));

constexpr int D = 1024;
constexpr int SEQ = 8192, NMETA = 16, PADF = 48;
constexpr int TPP = 8256;
constexpr int ROW_S0 = 2 * TPP;
constexpr int M_TOT = ROW_S0 + 128;
constexpr int NSEQ = 10;
constexpr float EPS = 1e-6f;
constexpr int LDP = 6144;
constexpr int SSD_INNER = 2048, SSD_HEADS = 32, SSD_P = 64, SSD_N = 128, SSD_CONV = 3072, SSD_IN = 5152, SSD_IN_PAD = 5376;
constexpr int GDN_HEADS = 8, GDN_DK = 128, GDN_DV = 256, GDN_CONV = 4096, GDN_VAL = 2048, GDN_IN = 6160, GDN_IN_PAD = 6400;

constexpr size_t O_YP = 0, O_YS = 16777216, O_PSSD = 16908288, O_PSSDC = 17956864, O_PGDN = 17993728, O_PGDNC = 19042304,
                 O_SSSD = 19091456, O_SSSDC = 23285760, O_SGDN = 23433216, O_SGDNC = 27627520;

constexpr size_t WS_CTL = 0;
constexpr size_t WS_HB = 65536;
constexpr size_t WS_WIN = WS_HB + (size_t)M_TOT * D * 2;
constexpr size_t WS_WOUT = WS_WIN + (size_t)GDN_IN_PAD * D * 2;
constexpr size_t WS_TAIL = WS_WOUT + (size_t)1024 * 2048 * 2;
constexpr size_t WS_DTB = WS_TAIL + (size_t)258 * 3 * 4096 * 2;
constexpr size_t WS_RSS = WS_DTB + (size_t)M_TOT * 32 * 4;
constexpr size_t WS_PROJ = WS_RSS + (size_t)M_TOT * 16 * 4;
constexpr size_t WS_END = WS_PROJ + (size_t)M_TOT * LDP * 2;

constexpr int NTHREADS = 512;
constexpr int LDS_BYTES = 147456;

#define KEEP(x) asm volatile("" :: "v"(x))
#ifndef REP_INPROJ
#define REP_INPROJ 1
#endif
#ifndef REP_SSD_PREP
#define REP_SSD_PREP 1
#endif
#ifndef REP_SSD_CHAIN
#define REP_SSD_CHAIN 1
#endif
#ifndef REP_GDN_PREP
#define REP_GDN_PREP 1
#endif
#ifndef REP_GDN_CHAIN
#define REP_GDN_CHAIN 1
#endif
#ifndef REP_WPREP
#define REP_WPREP 1
#endif
#ifndef REP_OUTPROJ
#define REP_OUTPROJ 1
#endif
#ifndef REP_SSD_POST
#define REP_SSD_POST 1
#endif
#ifndef REP_GDN_POST
#define REP_GDN_POST 1
#endif
#ifndef REP_SUBST
#define REP_SUBST 1
#endif
#ifndef REP_BARRIER
#define REP_BARRIER 1
#endif
#ifndef REP_FINAL
#define REP_FINAL 1
#endif
#ifndef MK_ONE_LAUNCH
#define MK_ONE_LAUNCH 1
#endif
__device__ __forceinline__ float bf2f(bf16_t b) { return __uint_as_float(((unsigned)b) << 16); }
__device__ __forceinline__ bf16_t f2bf(float f) { unsigned u = __float_as_uint(f); u += 0x7FFFu + ((u >> 16) & 1u); return (bf16_t)(u >> 16); }
typedef __bf16 bf16v2_t __attribute__((ext_vector_type(2)));
typedef float f32x2_t __attribute__((ext_vector_type(2)));
__device__ __forceinline__ unsigned cvt_pk_bf16(float lo, float hi) { const bf16v2_t r = __builtin_convertvector((f32x2_t){lo, hi}, bf16v2_t); return __builtin_bit_cast(unsigned, r); }
__device__ __forceinline__ float silu_f(float x) { return x / (1.0f + __expf(-x)); }
__device__ __forceinline__ float softplus_f(float x) { return x > 20.f ? x : log1pf(__expf(x)); }
__device__ __forceinline__ float wave_sum(float v) {
#pragma unroll
    for (int o = 32; o >= 1; o >>= 1) v += __shfl_xor(v, o);
    return v;
}
__device__ __forceinline__ int seq_base(int s) { return s < 2 ? s * TPP + 64 - NMETA : ROW_S0 + 16 * (s - 2); }
__device__ __forceinline__ int seq_len(int s) { return s < 2 ? SEQ + NMETA : 16; }
__device__ __forceinline__ int seq_chunks(int s) { return s < 2 ? 129 : 1; }

namespace pg8 {
constexpr int BM = 256, BK = 64, HALF = 128, HTB = HALF * BK * 2, STAGE_BYTES = 8 * HTB, NXCD = 8, WGM = 8;
__device__ __forceinline__ int lds_byte(int r, int c) { const int st = (r >> 4) * 2 + (c >> 5), rr = r & 15, cc = c & 31, ob = rr * 64 + cc * 2; return st * 1024 + (ob ^ (((ob >> 9) & 1) << 5)); }
__device__ __forceinline__ void stage_rc(int b, int& R, int& C) { const int st = b / 1024, sb = b % 1024, swz = sb ^ (((sb >> 9) & 1) << 5); R = (st >> 1) * 16 + swz / 64; C = (st & 1) * 32 + (swz % 64) / 2; }
__device__ __forceinline__ int perm32(int rho) { const int n = rho >> 4, i = rho & 15; return 8 * (i >> 2) + 4 * n + (i & 3); }
struct Unit { int pm, pn; };
struct Gemm { const bf16_t* A; const bf16_t* Bt; int M, N, K, lda, ldb; };
struct StaticOrder {
    int nM, nN, nwg, G, c;
    __device__ void init(int M, int N, int G_, int c_) { nM = M / BM; nN = N / BM; nwg = nM * nN; G = G_; c = c_; }
    __device__ bool next(int i, Unit& u) const {
        const long L = (long)i * G + c; if (L >= nwg) return false;
        int wgid = (int)L; { const int q = nwg / NXCD, r = nwg % NXCD, xcd = wgid % NXCD, off = wgid / NXCD; wgid = (xcd < r ? xcd * (q + 1) : r * (q + 1) + (xcd - r) * q) + off; }
        const int nig = WGM * nN, gid = wgid / nig, fm = gid * WGM, gsz = (nM - fm) < WGM ? (nM - fm) : WGM;
        u.pm = fm + ((wgid % nig) % gsz); u.pn = (wgid % nig) / gsz; return true;
    }
};

template <class Epi>
__device__ __forceinline__ void gemm_phase(LAS unsigned char* lds, const Gemm g, const StaticOrder& S, const Epi& E, const int tid) {
    const int wid = __builtin_amdgcn_readfirstlane(tid >> 6), lane = tid & 63, wr = wid >> 2, wc = wid & 3, fr = lane & 15, fq = lane >> 4;
    const int K = g.K, nt = K / BK;
    unsigned voffA[2], voffB[2];
#pragma unroll
    for (int i = 0; i < 2; ++i) { int R, C; stage_rc(tid * 16 + i * 8192, R, C); const int Rb = Epi::PERM ? ((R & ~31) + perm32(R & 31)) : R;
        voffA[i] = (unsigned)(R * g.lda + C) * 2u; voffB[i] = (unsigned)(Rb * g.ldb + C) * 2u; }
    const size_t kstep = (size_t)(BK * 2);
    const size_t hstepA = (size_t)HALF * g.lda * 2, hstepB = (size_t)HALF * g.ldb * 2;
    const size_t tstepA = 2 * hstepA, tstepB = 2 * hstepB;
    const unsigned ldsw = (unsigned)wid * 1024u;
    const int aoff = lds_byte(wr * 64 + fr, fq * 8), boff = lds_byte(wc * 32 + fr, fq * 8);
#define PG8_SA(b, h) (((b) * 2 + (h)) * HTB)
#define PG8_SB(b, h) ((4 + (b) * 2 + (h)) * HTB)
#define PG8_STAGE(bufoff, gbase, voff) do { _Pragma("unroll") for (int _i = 0; _i < 2; ++_i) \
        __builtin_amdgcn_global_load_lds((const unsigned*)((const char*)(gbase) + (voff)[_i]), (LAS unsigned*)(lds + (bufoff) + ldsw + _i * 8192), 16, 0, 0); } while (0)
#define PG8_LDA(dst, b, h) do { _Pragma("unroll") for (int m = 0; m < 4; ++m) _Pragma("unroll") for (int k = 0; k < 2; ++k) dst[m][k] = *(const LAS bf16x8*)(lds + PG8_SA(b, h) + aoff + m * 2048 + k * 1024); } while (0)
#define PG8_LDB(dst, b, h) do { _Pragma("unroll") for (int n = 0; n < 2; ++n) _Pragma("unroll") for (int k = 0; k < 2; ++k) dst[n][k] = *(const LAS bf16x8*)(lds + PG8_SB(b, h) + boff + n * 2048 + k * 1024); } while (0)
#define PG8_MMA(ai, bj, At, Bt) do { __builtin_amdgcn_s_setprio(1); _Pragma("unroll") for (int m = 0; m < 4; ++m) _Pragma("unroll") for (int n = 0; n < 2; ++n) _Pragma("unroll") for (int k = 0; k < 2; ++k) \
        acc[ai][bj][m][n] = __builtin_amdgcn_mfma_f32_16x16x32_bf16(Bt[n][k], At[m][k], acc[ai][bj][m][n], 0, 0, 0); __builtin_amdgcn_s_setprio(0); } while (0)
#define PG8_WAIT_V(n) asm volatile("s_waitcnt vmcnt(" #n ")" ::: "memory")
#define PG8_WAIT_L(n) asm volatile("s_waitcnt lgkmcnt(" #n ")" ::: "memory")
#define PG8_BAR __builtin_amdgcn_s_barrier()
#define PG8_SCHED __builtin_amdgcn_sched_barrier(0)
    Unit cur, nxt; int ui = 0;
    if (!S.next(0, cur)) return;
    f32x4 acc[2][2][4][2];
#pragma unroll
    for (int a = 0; a < 2; ++a)
#pragma unroll
        for (int b = 0; b < 2; ++b)
#pragma unroll
            for (int m = 0; m < 4; ++m)
#pragma unroll
                for (int n = 0; n < 2; ++n) acc[a][b][m][n] = (f32x4){0.f, 0.f, 0.f, 0.f};
    bf16x8 At[4][2], B0[2][2], B1[2][2];
    const char* cA = (const char*)g.A + (size_t)cur.pm * tstepA; const char* cB = (const char*)g.Bt + (size_t)cur.pn * tstepB;
    PG8_STAGE(PG8_SB(0, 0), cB, voffB); PG8_STAGE(PG8_SA(0, 0), cA, voffA); PG8_STAGE(PG8_SB(0, 1), cB + hstepB, voffB); PG8_STAGE(PG8_SA(0, 1), cA + hstepA, voffA);
    if (wr == 1) PG8_BAR;
    PG8_WAIT_V(4); PG8_BAR;
    PG8_STAGE(PG8_SB(1, 0), cB + kstep, voffB); PG8_STAGE(PG8_SA(1, 0), cA + kstep, voffA); PG8_STAGE(PG8_SB(1, 1), cB + hstepB + kstep, voffB);
    PG8_WAIT_V(6); PG8_BAR;
    for (;;) {
        const bool has_next = S.next(ui + 1, nxt);
        const char* nA = has_next ? (const char*)g.A + (size_t)nxt.pm * tstepA : cA; const char* nB = has_next ? (const char*)g.Bt + (size_t)nxt.pn * tstepB : cB;
        for (int t = 0; t < nt; t += 2) {
            const bool last = (t == nt - 2);
            const char* a1 = cA + (size_t)(t + 1) * kstep;
            const char* a2 = last ? nA : cA + (size_t)(t + 2) * kstep; const char* b2 = last ? nB : cB + (size_t)(t + 2) * kstep;
            const char* a3 = a2 + kstep; const char* b3 = b2 + kstep;
            PG8_LDB(B0, 0, 0); PG8_SCHED; PG8_LDA(At, 0, 0); PG8_STAGE(PG8_SA(1, 1), a1 + hstepA, voffA);
            PG8_WAIT_L(8); PG8_BAR; PG8_WAIT_L(0); PG8_MMA(0, 0, At, B0); PG8_BAR; PG8_SCHED;
            PG8_LDB(B1, 0, 1); PG8_STAGE(PG8_SB(0, 0), b2, voffB);
            PG8_BAR; PG8_WAIT_L(0); PG8_MMA(0, 1, At, B1); PG8_BAR;
            PG8_LDA(At, 0, 1); PG8_STAGE(PG8_SA(0, 0), a2, voffA);
            PG8_BAR; PG8_WAIT_L(0); PG8_MMA(1, 0, At, B0); PG8_BAR; PG8_SCHED;
            PG8_STAGE(PG8_SB(0, 1), b2 + hstepB, voffB);
            PG8_WAIT_V(6); PG8_BAR; PG8_MMA(1, 1, At, B1); PG8_BAR;
            PG8_LDB(B0, 1, 0); PG8_SCHED; PG8_LDA(At, 1, 0); PG8_STAGE(PG8_SA(0, 1), a2 + hstepA, voffA);
            PG8_WAIT_L(8); PG8_BAR; PG8_WAIT_L(0); PG8_MMA(0, 0, At, B0); PG8_BAR; PG8_SCHED;
            PG8_LDB(B1, 1, 1); PG8_STAGE(PG8_SB(1, 0), b3, voffB);
            PG8_BAR; PG8_WAIT_L(0); PG8_MMA(0, 1, At, B1); PG8_BAR;
            PG8_LDA(At, 1, 1); PG8_STAGE(PG8_SA(1, 0), a3, voffA);
            PG8_BAR; PG8_WAIT_L(0); PG8_MMA(1, 0, At, B0); PG8_BAR; PG8_SCHED;
            PG8_STAGE(PG8_SB(1, 1), b3 + hstepB, voffB);
            PG8_WAIT_V(6); PG8_BAR; PG8_MMA(1, 1, At, B1); PG8_BAR;
        }
        E(acc, cur, wr, wc, fr, fq);
        if (!has_next) break;
#pragma unroll
        for (int a = 0; a < 2; ++a)
#pragma unroll
            for (int b = 0; b < 2; ++b)
#pragma unroll
                for (int m = 0; m < 4; ++m)
#pragma unroll
                    for (int n = 0; n < 2; ++n) acc[a][b][m][n] = (f32x4){0.f, 0.f, 0.f, 0.f};
        cur = nxt; cA = nA; cB = nB; ++ui;
    }
    PG8_WAIT_V(0);
    if (wr == 0) PG8_BAR;
    PG8_BAR;
#undef PG8_SA
#undef PG8_SB
#undef PG8_STAGE
#undef PG8_LDA
#undef PG8_LDB
#undef PG8_MMA
#undef PG8_WAIT_V
#undef PG8_WAIT_L
#undef PG8_BAR
#undef PG8_SCHED
}

struct EpiInProj {
    static constexpr bool PERM = true;
    bf16_t* proj; float* dtb; const float* rowss; int nt_main; bf16_t* tails; int tl_lo, tl_hi;
    __device__ __forceinline__ void operator()(const f32x4 (&acc)[2][2][4][2], const Unit& u, int wr, int wc, int fr, int fq) const {
        const int row0 = u.pm * BM + wr * 64 + fr;
#pragma unroll
        for (int ai = 0; ai < 2; ++ai)
#pragma unroll
            for (int m = 0; m < 4; ++m) {
                const int r = row0 + ai * HALF + m * 16;
                const f32x4* rp = (const f32x4*)(rowss + (size_t)r * 16);
                const f32x4 p0 = rp[0], p1 = rp[1], p2 = rp[2], p3 = rp[3];
                const float ss = ((p0[0] + p0[1]) + (p0[2] + p0[3])) + ((p1[0] + p1[1]) + (p1[2] + p1[3])) + ((p2[0] + p2[1]) + (p2[2] + p2[3])) + ((p3[0] + p3[1]) + (p3[2] + p3[3]));
                const float rstd = rsqrtf(ss * (1.0f / 1024.0f) + EPS);
                if (u.pn < nt_main) {
                    bf16_t* rowp = proj + (size_t)r * LDP + u.pn * BM + wc * 32 + 8 * fq;
#pragma unroll
                    for (int bj = 0; bj < 2; ++bj) { const f32x4 v0 = acc[ai][bj][m][0] * rstd, v1 = acc[ai][bj][m][1] * rstd;
                        u32x4 w; w.x = cvt_pk_bf16(v0[0], v0[1]); w.y = cvt_pk_bf16(v0[2], v0[3]); w.z = cvt_pk_bf16(v1[0], v1[1]); w.w = cvt_pk_bf16(v1[2], v1[3]);
                        *(u32x4*)(rowp + bj * HALF) = w;
                        if (u.pn >= tl_lo && u.pn < tl_hi && r < ROW_S0 && (r & 63) >= 61) *(u32x4*)(tails + ((size_t)(r >> 6) * 3 + ((r & 63) - 61)) * 4096 + (u.pn - tl_lo) * BM + wc * 32 + 8 * fq + bj * HALF) = w; }
                } else if (wc == 0) {
                    float* dp = dtb + (size_t)r * 32 + 8 * fq;
                    *(f32x4*)(dp) = acc[ai][0][m][0] * rstd; *(f32x4*)(dp + 4) = acc[ai][0][m][1] * rstd;
                }
            }
    }
};
struct EpiOutProj {
    static constexpr bool PERM = false;
    bf16_t* hb; float* rowss; bool dry;
    __device__ __forceinline__ void operator()(const f32x4 (&acc)[2][2][4][2], const Unit& u, int wr, int wc, int fr, int fq) const {
        const int row0 = u.pm * BM + wr * 64 + fr, col0 = u.pn * BM + wc * 32 + 4 * fq;
#pragma unroll
        for (int ai = 0; ai < 2; ++ai)
#pragma unroll
            for (int m = 0; m < 4; ++m) {
                const int r = row0 + ai * HALF + m * 16; float ss = 0.f;
                bf16_t* rowp = hb + (size_t)r * D + col0;
#pragma unroll
                for (int bj = 0; bj < 2; ++bj)
#pragma unroll
                    for (int n = 0; n < 2; ++n) {
                        u32x2* p = (u32x2*)(rowp + bj * HALF + n * 16); const u32x2 o = *p;
                        const f32x4 a = acc[ai][bj][m][n];
                        const float h0 = __uint_as_float(o.x << 16) + a[0], h1 = __uint_as_float(o.x & 0xffff0000u) + a[1];
                        const float h2 = __uint_as_float(o.y << 16) + a[2], h3 = __uint_as_float(o.y & 0xffff0000u) + a[3];
                        ss += (h0 * h0 + h1 * h1) + (h2 * h2 + h3 * h3);
                        u32x2 w; w.x = cvt_pk_bf16(h0, h1); w.y = cvt_pk_bf16(h2, h3); if (!dry) *p = w; else KEEP(w);
                    }
                ss += __shfl_xor(ss, 16); ss += __shfl_xor(ss, 32);
                if (fq == 0) { if (!dry) rowss[(size_t)r * 16 + u.pn * 4 + wc] = ss; else KEEP(ss); }
            }
    }
};
}

#define XB_TMO      128
#define XB_XCNT(j)  (256  + 64 * (j))
#define XB_XSUB(j)  (1280 + 64 * (j))
#define XB_XGEN(j)  (2304 + 64 * (j))
#define XB_TOP      3328
#define XB_TOPGEN   3392
#define XCD_BAR_WORDS 3456
#define XB_SPIN_CAP (1u << 24)
__device__ __forceinline__ unsigned xb_ld(unsigned* p)              { return __hip_atomic_load(p, __ATOMIC_RELAXED, __HIP_MEMORY_SCOPE_AGENT); }
__device__ __forceinline__ unsigned xb_add(unsigned* p, unsigned v) { return __hip_atomic_fetch_add(p, v, __ATOMIC_RELAXED, __HIP_MEMORY_SCOPE_AGENT); }
__device__ __forceinline__ unsigned xb_xcc_id() { return (unsigned)__builtin_amdgcn_s_getreg((3 << 11) | 20) & 0xFu; }
#define XB_SPIN(cond, bar) do { unsigned _sp = 0; while (cond) { __builtin_amdgcn_s_sleep(1); \
    if ((++_sp & 255u) == 0u) { if (xb_ld(&(bar)[XB_TMO])) break; if (_sp > XB_SPIN_CAP) { atomicAdd(&(bar)[XB_TMO], 1u); break; } } } } while (0)
struct XcdBarrier { unsigned* bar; unsigned x; volatile LAS unsigned* st; };
__device__ __forceinline__ XcdBarrier xcd_barrier_post(unsigned* bar, volatile LAS unsigned* st) {
    XcdBarrier b; b.bar = bar; b.x = xb_xcc_id(); b.st = st;
    if (threadIdx.x == 0) (void)xb_add(&bar[XB_XCNT(b.x)], 1u);
    return b;
}
__device__ __forceinline__ void xcd_barrier_complete(unsigned* bar, unsigned x, unsigned& nloc, unsigned& nx) {
    const unsigned G = gridDim.x * gridDim.y * gridDim.z;
    unsigned sum, cnt, mine, sp = 0u;
    for (;;) {
        sum = 0u; cnt = 0u; mine = 0u;
#pragma unroll
        for (unsigned j = 0; j < 16; ++j) { const unsigned c = xb_ld(&bar[XB_XCNT(j)]); sum += c; cnt += (c > 0u) ? 1u : 0u; mine = (j == x) ? c : mine; }
        if (sum == G) break;
        __builtin_amdgcn_s_sleep(1);
        if ((++sp & 255u) == 0u) { if (xb_ld(&bar[XB_TMO])) break; if (sp > XB_SPIN_CAP) { atomicAdd(&bar[XB_TMO], 1u); break; } }
    }
    nloc = mine > 0u ? mine : 1u; nx = cnt > 0u ? cnt : 1u;
}
__device__ __forceinline__ void xcd_barrier(const XcdBarrier& b) {
    asm volatile("s_waitcnt vmcnt(0)" ::: "memory");
    __syncthreads();
    if (threadIdx.x == 0) {
        unsigned* bar = b.bar;
        __builtin_amdgcn_s_waitcnt(0);
        unsigned nloc = b.st[0], nx = b.st[1];
        if (nloc == 0u) { xcd_barrier_complete(bar, b.x, nloc, nx); b.st[0] = nloc; b.st[1] = nx; }
        const unsigned old = xb_add(&bar[XB_XSUB(b.x)], 1u);
        const unsigned gen = old / nloc;
        if (old + 1u == (gen + 1u) * nloc) {
            __builtin_amdgcn_fence(__ATOMIC_RELEASE, "agent");
            asm volatile("s_waitcnt vmcnt(0)" ::: "memory");
            const unsigned og = xb_add(&bar[XB_TOP], 1u);
            const unsigned tg = og / nx;
            if (og + 1u == (tg + 1u) * nx) xb_add(&bar[XB_TOPGEN], 1u);
            else XB_SPIN(xb_ld(&bar[XB_TOPGEN]) == tg, bar);
            __builtin_amdgcn_fence(__ATOMIC_ACQUIRE, "agent");
            xb_add(&bar[XB_XGEN(b.x)], 1u);
            asm volatile("s_waitcnt vmcnt(0)" ::: "memory");
        } else {
            XB_SPIN(xb_ld(&bar[XB_XGEN(b.x)]) == gen, bar);
            __builtin_amdgcn_fence(__ATOMIC_ACQUIRE, "agent");
            asm volatile("s_waitcnt vmcnt(0)" ::: "memory");
        }
    }
    __syncthreads();
}

struct Args { const float* in[24]; float* out; unsigned char* ws; int ph_lo, ph_hi; };

struct Frame {
    const Args* ap; float* out; unsigned char* ws;
    __device__ __forceinline__ const float* inp(int i) const { asm volatile("" : "+s"(i)); return ap->in[i]; }
    unsigned char* lds; LAS unsigned char* ldsl;
    int tid, lane, wave, G, bid;
    bf16_t* hb; bf16_t* win; bf16_t* wout; float* dtb; float* rss; bf16_t* proj; bf16_t* tails;
};

__device__ __forceinline__ Frame relaunder(Frame F) {
    int t = F.tid; asm volatile("" : "+v"(t));
    F.tid = t; F.lane = t & 63; F.wave = __builtin_amdgcn_readfirstlane(t >> 6);
    unsigned char* w = F.ws; asm volatile("" : "+s"(w));
    F.ws = w; F.hb = (bf16_t*)(w + WS_HB); F.win = (bf16_t*)(w + WS_WIN); F.wout = (bf16_t*)(w + WS_WOUT);
    F.dtb = (float*)(w + WS_DTB); F.rss = (float*)(w + WS_RSS); F.proj = (bf16_t*)(w + WS_PROJ); F.tails = (bf16_t*)(w + WS_TAIL);
    return F;
}
__device__ void phase_init_h(const Frame& F0) {
    const Frame F = relaunder(F0);
    const float* xp = F.inp(0); const float* xs = F.inp(1); const float* meta = F.inp(6);
    for (int row = F.bid * 8 + F.wave; row < M_TOT; row += F.G * 8) {
        const float* src = nullptr;
        if (row < ROW_S0) { const int b = row / TPP, r = row % TPP; if (r >= 64) src = xp + ((size_t)b * SEQ + (r - 64)) * D; else if (r >= PADF) src = meta + (size_t)(r - PADF) * D; }
        else src = xs + (size_t)(row - ROW_S0) * D;
        float ss = 0.f;
#pragma unroll
        for (int i = 0; i < 4; ++i) {
            f32x4 v = (f32x4){0.f, 0.f, 0.f, 0.f};
            if (src) v = *(const f32x4*)(src + (F.lane + 64 * i) * 4);
            ss += (v[0] * v[0] + v[1] * v[1]) + (v[2] * v[2] + v[3] * v[3]);
            u32x2 w; w.x = cvt_pk_bf16(v[0], v[1]); w.y = cvt_pk_bf16(v[2], v[3]);
            *(u32x2*)(F.hb + (size_t)row * D + (F.lane + 64 * i) * 4) = w;
        }
        ss = wave_sum(ss);
        if (F.lane < 16) F.rss[(size_t)row * 16 + F.lane] = (F.lane == 0) ? ss : 0.f;
    }
}

__device__ void transpose_convert(const Frame& F, const float* src, int K, int N, int Npad, bf16_t* dst, const float* scale, int smod) {
    float* tile = (float*)F.lds;
    const int ntk = K / 64, ntn = Npad / 64, ntile = ntk * ntn;
    __syncthreads();
    for (int ti = F.bid; ti < ntile; ti += F.G) {
        const int kt = ti % ntk, nt_ = ti / ntk, k0 = kt * 64, n0 = nt_ * 64;
        const int kk = F.tid >> 4, n4 = (F.tid & 15) * 4;
#pragma unroll
        for (int h = 0; h < 2; ++h) {
            const int k = k0 + kk + 32 * h, n = n0 + n4;
            f32x4 v = (f32x4){0.f, 0.f, 0.f, 0.f};
            if (n < N) v = *(const f32x4*)(src + (size_t)k * N + n);
            const float s = scale[k % smod];
            float* tp = tile + (kk + 32 * h) * 65 + n4;
            tp[0] = v[0] * s; tp[1] = v[1] * s; tp[2] = v[2] * s; tp[3] = v[3] * s;
        }
        __syncthreads();
        const int nn = F.tid >> 3, kg = (F.tid & 7) * 8;
        float x[8];
#pragma unroll
        for (int j = 0; j < 8; ++j) x[j] = tile[(kg + j) * 65 + nn];
        u32x4 w; w.x = cvt_pk_bf16(x[0], x[1]); w.y = cvt_pk_bf16(x[2], x[3]); w.z = cvt_pk_bf16(x[4], x[5]); w.w = cvt_pk_bf16(x[6], x[7]);
        *(u32x4*)(dst + (size_t)(n0 + nn) * K + k0 + kg) = w;
        __syncthreads();
    }
}
__device__ void phase_wprep_in(const Frame& F0, int L) {
    const Frame F = relaunder(F0);
    const int j = L >> 1;
    if ((L & 1) == 0) transpose_convert(F, F.inp(8) + (size_t)j * D * SSD_IN, D, SSD_IN, SSD_IN_PAD, F.win, F.inp(7) + j * D, D);
    else transpose_convert(F, F.inp(17) + (size_t)j * D * GDN_IN, D, GDN_IN, GDN_IN_PAD, F.win, F.inp(16) + j * D, D);
}
__device__ void phase_wprep_out(const Frame& F0, int L) {
    const Frame F = relaunder(F0);
    const int j = L >> 1;
    if ((L & 1) == 0) transpose_convert(F, F.inp(15) + (size_t)j * SSD_INNER * D, SSD_INNER, D, D, F.wout, F.inp(14) + j * SSD_INNER, SSD_INNER);
    else transpose_convert(F, F.inp(22) + (size_t)j * GDN_VAL * D, GDN_VAL, D, D, F.wout, F.inp(21) + j * GDN_DV, GDN_DV);
}

__device__ void phase_inproj(const Frame& F0, int L) {
    const Frame F = relaunder(F0);
    const int npad = (L & 1) ? GDN_IN_PAD : SSD_IN_PAD;
    pg8::Gemm g{F.hb, F.win, M_TOT, npad, D, D, D};
    pg8::StaticOrder S; S.init(M_TOT, npad, F.G, F.bid);
    pg8::EpiInProj E{F.proj, F.dtb, F.rss, npad / 256 - 1, F.tails, (L & 1) ? 0 : 8, 16};
    pg8::gemm_phase<pg8::EpiInProj>(F.ldsl, g, S, E, F.tid);
}
__device__ void phase_outproj(const Frame& F0, int L, bool dry) {
    const Frame F = relaunder(F0);
    const bf16_t* A = F.proj + ((L & 1) ? 4096 : 0);
    pg8::Gemm g{A, F.wout, M_TOT, D, 2048, LDP, 2048};
    pg8::StaticOrder S; S.init(M_TOT, D, F.G, F.bid);
    pg8::EpiOutProj E{F.hb, F.rss, dry};
    pg8::gemm_phase<pg8::EpiOutProj>(F.ldsl, g, S, E, F.tid);
}

__device__ void phase_ssd_naive(const Frame& F0, int j) {
    const Frame F = relaunder(F0);
    float* xs = (float*)F.lds;
    float* Bs = xs + 64 * 64;
    float* Cs = Bs + 64 * 128;
    float* dts = Cs + 64 * 128;
    float* das = dts + 64;
    const float* conv_w = F.inp(9) + (size_t)j * 4 * SSD_CONV; const float* conv_b = F.inp(10) + (size_t)j * SSD_CONV;
    const int p = F.tid >> 3, nq = F.tid & 7;
    for (int task = F.bid; task < NSEQ * SSD_HEADS; task += F.G) {
        const int s = task / SSD_HEADS, head = task % SSD_HEADS, grp = head >> 3;
        const int base = seq_base(s), nch = seq_chunks(s);
        const float dt_bias = F.inp(11)[j * SSD_HEADS + head], a = -__expf(F.inp(12)[j * SSD_HEADS + head]), dsk = F.inp(13)[j * SSD_HEADS + head];
        float h[16];
        if (s < 2) {
#pragma unroll
            for (int n = 0; n < 16; ++n) h[n] = 0.f;
        } else {
            const float* st = F.inp(2) + ((((size_t)j * 8 + (s - 2)) * SSD_HEADS + head) * SSD_P + p) * SSD_N + nq * 16;
#pragma unroll
            for (int n = 0; n < 16; ++n) h[n] = st[n];
        }
        int cidx = -1;
        if (F.tid < 64) cidx = head * 64 + F.tid; else if (F.tid < 192) cidx = 2048 + grp * 128 + (F.tid - 64); else if (F.tid < 320) cidx = 2560 + grp * 128 + (F.tid - 192);
        float w0 = 0, w1 = 0, w2 = 0, w3 = 0, cb = 0;
        if (cidx >= 0) { w0 = conv_w[cidx]; w1 = conv_w[SSD_CONV + cidx]; w2 = conv_w[2 * SSD_CONV + cidx]; w3 = conv_w[3 * SSD_CONV + cidx]; cb = conv_b[cidx]; }
        const float* cst = (s >= 2) ? F.inp(3) + (((size_t)j * 8 + (s - 2)) * 3) * SSD_CONV : nullptr;
        for (int c = 0; c < nch; ++c) {
            const int t0 = 64 * c - PADF;
            __syncthreads();
            if (cidx >= 0) {
                float r3, r2, r1;
                {   float rv[3];
#pragma unroll
                    for (int q = 0; q < 3; ++q) { const int t = t0 - 3 + q; float v = 0.f;
                        if (t >= 0) v = bf2f(F.proj[(size_t)(base + t) * LDP + 2048 + cidx]); else if (t >= -3 && cst) v = cst[(3 + t) * SSD_CONV + cidx];
                        rv[q] = v; }
                    r3 = rv[0]; r2 = rv[1]; r1 = rv[2]; }
                for (int i = 0; i < 64; ++i) {
                    const int t = t0 + i; float v = 0.f;
                    if (t >= 0) v = bf2f(F.proj[(size_t)(base + t) * LDP + 2048 + cidx]); else if (t >= -3 && cst) v = cst[(3 + t) * SSD_CONV + cidx];
                    const float o = silu_f(cb + w0 * r3 + w1 * r2 + w2 * r1 + w3 * v);
                    r3 = r2; r2 = r1; r1 = v;
                    if (F.tid < 64) xs[i * 64 + F.tid] = o; else if (F.tid < 192) Bs[i * 128 + (F.tid - 64)] = o; else Cs[i * 128 + (F.tid - 192)] = o;
                }
            } else if (F.tid >= 448) {
                const int i = F.tid - 448, t = t0 + i;
                float dt = 0.f, da = 1.f;
                if (t >= 0) { dt = softplus_f(F.dtb[(size_t)(base + t) * 32 + head] + dt_bias); da = __expf(dt * a); }
                dts[i] = dt; das[i] = da;
            }
            __syncthreads();
            for (int i = 0; i < 64; ++i) {
                const int t = t0 + i;
                const float dt = dts[i], da = das[i], xv = xs[i * 64 + p], dx = dt * xv;
                const float* bp = Bs + i * 128 + nq * 16; const float* cp = Cs + i * 128 + nq * 16;
                float accv = 0.f;
#pragma unroll
                for (int n = 0; n < 16; ++n) { h[n] = h[n] * da + dx * bp[n]; accv += cp[n] * h[n]; }
                accv += __shfl_xor(accv, 1); accv += __shfl_xor(accv, 2); accv += __shfl_xor(accv, 4);
                if (nq == 0 && t >= 0) {
                    bf16_t* zp = F.proj + (size_t)(base + t) * LDP + head * 64 + p;
                    const float z = bf2f(*zp);
                    *zp = f2bf((accv + dsk * xv) * silu_f(z));
                }
            }
        }
        float* so = (s < 2) ? F.out + O_PSSD + ((((size_t)j * 2 + s) * SSD_HEADS + head) * SSD_P + p) * SSD_N + nq * 16
                            : F.out + O_SSSD + ((((size_t)j * 8 + (s - 2)) * SSD_HEADS + head) * SSD_P + p) * SSD_N + nq * 16;
#pragma unroll
        for (int n = 0; n < 16; ++n) so[n] = h[n];
    }
}


constexpr int NCHT = 266;
constexpr size_t SC_BT = 0;
constexpr size_t SC_C = SC_BT + (size_t)NCHT * 4 * 16384;
constexpr size_t SC_CB = SC_C + (size_t)NCHT * 4 * 16384;
constexpr size_t SC_VEC = SC_CB + (size_t)NCHT * 4 * 8192;
constexpr size_t SC_XS = SC_VEC + (size_t)NCHT * 32 * 1024;
constexpr size_t SC_SSD_END = SC_XS + (size_t)256 * 8192;
static_assert(SC_SSD_END <= (size_t)16777216 * 4, "scratch must fit the y_prompt region");
__device__ __forceinline__ int qperm(int s) { return (s & ~31) | (((s >> 2) & 3) << 3) | (((s >> 4) & 1) << 2) | (s & 3); }
__device__ __forceinline__ int qnat(int q) { return (q & ~31) | (((q >> 2) & 1) << 4) | (((q >> 3) & 3) << 2) | (q & 3); }
__device__ __forceinline__ bf16x8 pack8(f32x4 a, f32x4 b) {
    u32x4 w; w.x = cvt_pk_bf16(a[0], a[1]); w.y = cvt_pk_bf16(a[2], a[3]); w.z = cvt_pk_bf16(b[0], b[1]); w.w = cvt_pk_bf16(b[2], b[3]);
    return __builtin_bit_cast(bf16x8, w);
}
__device__ __forceinline__ void chunk_of(int cgi, int& seq, int& c) { if (cgi < 258) { seq = cgi / 129; c = cgi % 129; } else { seq = 2 + (cgi - 258); c = 0; } }
__device__ __forceinline__ int cgi_of(int seq, int c) { return seq < 2 ? seq * 129 + c : 258 + (seq - 2); }
struct XTile { bf16_t* p; int stride; };
__device__ __forceinline__ XTile ssd_xtile(const Frame& F, int seq, int c, int head) {
    XTile t;
    if (seq < 2) { t.p = F.proj + (size_t)(seq * TPP + 64 * c) * LDP + 2048 + head * 64; t.stride = LDP; }
    else { t.p = (bf16_t*)((unsigned char*)F.out + SC_XS) + (size_t)((seq - 2) * 32 + head) * 4096; t.stride = 64; }
    return t;
}

template <bool DRY>
__device__ void phase_ssd_prep(const Frame& F0, int j) {
    const Frame F = relaunder(F0);
    bf16_t* Bs = (bf16_t*)F.lds;
    bf16_t* Cs = Bs + 64 * 136;
    unsigned char* sc = (unsigned char*)F.out;
    const float* conv_w = F.inp(9) + (size_t)j * 4 * SSD_CONV; const float* conv_b = F.inp(10) + (size_t)j * SSD_CONV;
    const int i16 = F.lane & 15, g4 = F.lane >> 4;
    for (int task = F.bid; task < NCHT * 4; task += F.G) {
        const int cgi = task >> 2, grp = task & 3; int seq, c; chunk_of(cgi, seq, c);
        const int base = seq_base(seq), t0 = 64 * c - PADF;
        __syncthreads();
        {
            const int hl = F.tid >> 6, p = F.tid & 63, head = grp * 8 + hl, cidx = head * 64 + p;
            const float w0 = conv_w[cidx], w1 = conv_w[SSD_CONV + cidx], w2 = conv_w[2 * SSD_CONV + cidx], w3 = conv_w[3 * SSD_CONV + cidx], cb = conv_b[cidx];
            float r3 = 0.f, r2 = 0.f, r1 = 0.f;
            if (seq < 2 && c > 0) { const bf16_t* tp = F.tails + (size_t)(cgi - 1) * 3 * 4096 + cidx; r3 = bf2f(tp[0]); r2 = bf2f(tp[4096]); r1 = bf2f(tp[2 * 4096]); }
            else if (seq >= 2) { const float* cst = F.inp(3) + (((size_t)j * 8 + (seq - 2)) * 3) * SSD_CONV + cidx; r3 = cst[0]; r2 = cst[SSD_CONV]; r1 = cst[2 * SSD_CONV]; }
            const bf16_t* xcol = F.proj + 2048 + cidx;
            bf16_t* xrow = (bf16_t*)F.lds + F.tid * 72;
#pragma unroll 1
            for (int s8 = 0; s8 < 8; ++s8) {
                float o[8];
#pragma unroll
                for (int h = 0; h < 8; ++h) {
                    const int t = t0 + 8 * s8 + h;
                    const float v = (t >= 0) ? bf2f(xcol[(size_t)(base + (t > 0 ? t : 0)) * LDP]) : 0.f;
                    o[h] = silu_f(cb + w0 * r3 + w1 * r2 + w2 * r1 + w3 * v);
                    if (t >= 0) { r3 = r2; r2 = r1; r1 = v; }
                }
                u32x4 w; w.x = cvt_pk_bf16(o[0], o[1]); w.y = cvt_pk_bf16(o[2], o[3]); w.z = cvt_pk_bf16(o[4], o[5]); w.w = cvt_pk_bf16(o[6], o[7]);
                *(u32x4*)(xrow + 8 * s8) = w;
            }
            __syncthreads();
            const XTile xt = ssd_xtile(F, seq, c, head);
#pragma unroll
            for (int q = 0; q < 8; ++q) { const u32x4 w = *(const u32x4*)(xrow + 8 * q);
                if (!DRY) *(u32x4*)(xt.p + (size_t)p * xt.stride + 8 * q) = w; else KEEP(w); }
        }
        __syncthreads();
        {
            const int ch = F.tid & 255, half = F.tid >> 8, isC = ch >> 7, n = ch & 127;
            const int cidx = 2048 + isC * 512 + grp * 128 + n;
            const float w0 = conv_w[cidx], w1 = conv_w[SSD_CONV + cidx], w2 = conv_w[2 * SSD_CONV + cidx], w3 = conv_w[3 * SSD_CONV + cidx], cb = conv_b[cidx];
            const float* cst = (seq >= 2) ? F.inp(3) + (((size_t)j * 8 + (seq - 2)) * 3) * SSD_CONV : nullptr;
            bf16_t* dst = (isC ? Cs : Bs) + n;
            const bf16_t* col = F.proj + 2048 + cidx;
            unsigned short raw[35];
#pragma unroll
            for (int e = 0; e < 35; ++e) { const int t = t0 + half * 32 - 3 + e; raw[e] = col[(size_t)(base + (t > 0 ? t : 0)) * LDP]; }
            float r3, r2, r1;
            {   float rv[3];
#pragma unroll
                for (int q = 0; q < 3; ++q) { const int t = t0 + half * 32 - 3 + q; float v = 0.f;
                    if (t >= 0) v = bf2f(raw[q]); else if (t >= -3 && cst) v = cst[(3 + t) * SSD_CONV + cidx];
                    rv[q] = v; }
                r3 = rv[0]; r2 = rv[1]; r1 = rv[2]; }
#pragma unroll
            for (int ii = 0; ii < 32; ++ii) {
                const int p = half * 32 + ii, t = t0 + p; float v = 0.f;
                if (t >= 0) v = bf2f(raw[ii + 3]); else if (t >= -3 && cst) v = cst[(3 + t) * SSD_CONV + cidx];
                const float o = silu_f(cb + w0 * r3 + w1 * r2 + w2 * r1 + w3 * v);
                r3 = r2; r2 = r1; r1 = v;
                dst[p * 136] = f2bf(o);
            }
        }
        __syncthreads();
        {
            bf16_t* BT = (bf16_t*)(sc + SC_BT) + (size_t)(cgi * 4 + grp) * 8192;
            const int n = F.tid >> 2, qg = (F.tid & 3) * 16;
#pragma unroll
            for (int u = 0; u < 2; ++u) {
                const int q0 = qg + 8 * u; unsigned short e[8];
#pragma unroll
                for (int jj = 0; jj < 8; ++jj) e[jj] = Bs[qnat(q0 + jj) * 136 + n];
                u32x4 w; w.x = e[0] | ((unsigned)e[1] << 16); w.y = e[2] | ((unsigned)e[3] << 16); w.z = e[4] | ((unsigned)e[5] << 16); w.w = e[6] | ((unsigned)e[7] << 16);
                if (!DRY) *(u32x4*)(BT + n * 64 + q0) = w; else KEEP(w);
            }
            bf16_t* Cg = (bf16_t*)(sc + SC_C) + (size_t)(cgi * 4 + grp) * 8192;
#pragma unroll
            for (int u = 0; u < 2; ++u) {
                const int idx = F.tid + 512 * u, l = idx >> 4, qg8 = idx & 15, kk = qg8 >> 2, gg = qg8 & 3;
                const u32x2 a = *(const u32x2*)(Cs + l * 136 + 32 * kk + 4 * gg), b = *(const u32x2*)(Cs + l * 136 + 32 * kk + 16 + 4 * gg);
                u32x4 w; w.x = a.x; w.y = a.y; w.z = b.x; w.w = b.y;
                if (!DRY) *(u32x4*)(Cg + l * 128 + 8 * qg8) = w; else KEEP(w);
            }
        }
        {
            bf16_t* CB = (bf16_t*)(sc + SC_CB) + (size_t)(cgi * 4 + grp) * 4096;
            const int m = F.wave >> 1;
#pragma unroll
            for (int u = 0; u < 2; ++u) {
                const int st = 2 * (F.wave & 1) + u; f32x4 acc = (f32x4){0.f, 0.f, 0.f, 0.f};
#pragma unroll
                for (int kk = 0; kk < 4; ++kk) {
                    const bf16x8 a = *(const bf16x8*)(Cs + (16 * m + i16) * 136 + 32 * kk + 8 * g4);
                    const bf16x8 b = *(const bf16x8*)(Bs + (16 * st + i16) * 136 + 32 * kk + 8 * g4);
                    acc = __builtin_amdgcn_mfma_f32_16x16x32_bf16(a, b, acc, 0, 0, 0);
                }
                const int qs = qperm(16 * st + i16);
#pragma unroll
                for (int jj = 0; jj < 4; ++jj) { if (!DRY) CB[(16 * m + 4 * g4 + jj) * 64 + qs] = f2bf(acc[jj]); else KEEP(acc[jj]); }
            }
        }
        {
            const int head = grp * 8 + F.wave, t = t0 + F.lane;
            const float a = -__expf(F.inp(12)[j * SSD_HEADS + head]);
            float dt = 0.f;
            if (t >= 0) dt = softplus_f(F.dtb[(size_t)(base + t) * 32 + head] + F.inp(11)[j * SSD_HEADS + head]);
            float cs = dt * a;
#pragma unroll
            for (int o = 1; o < 64; o <<= 1) { const float y = __shfl_up(cs, o); if (F.lane >= o) cs += y; }
            const float cs_last = __shfl(cs, 63), cs_be = __shfl(cs, F.lane | 3);
            float* vp = (float*)(sc + SC_VEC) + (size_t)(cgi * 32 + head) * 256;
            const float v1 = __expf(cs_be - cs) * dt, v2 = dt * __expf(cs_last - cs), v3 = __expf(cs);
            if (!DRY) { vp[F.lane] = cs; vp[64 + F.lane] = v1; vp[128 + F.lane] = v2; vp[192 + F.lane] = v3; } else { KEEP(v1); KEEP(v2); KEEP(v3); }
        }
    }
}

constexpr int SL_C = 0, SL_BT = 16384, SL_M = 32768, SL_XT = 40960, SL_VEC = 49152, SL_SIZE = 50176;
#define PD(d) P[11 + ((d) >> 2)][(d) & 3]
__device__ __forceinline__ void ssd_stage_load(u32x4 (&P)[15], const Frame& F, const unsigned char* sc, int lt, int seq, int head, int c) {
    const int cgi = cgi_of(seq, c), grp = head >> 3;
    const bf16_t* Cp = (const bf16_t*)(sc + SC_C) + (size_t)(cgi * 4 + grp) * 8192;
    const bf16_t* BTp = (const bf16_t*)(sc + SC_BT) + (size_t)(cgi * 4 + grp) * 8192;
    const bf16_t* CBp = (const bf16_t*)(sc + SC_CB) + (size_t)(cgi * 4 + grp) * 4096;
    const float* vp = (const float*)(sc + SC_VEC) + (size_t)(cgi * 32 + head) * 256;
    const XTile xt = ssd_xtile(F, seq, c, head);
#pragma unroll
    for (int r = 0; r < 4; ++r) { const int k = lt + 256 * r; P[r] = *(const u32x4*)(Cp + k * 8); P[4 + r] = *(const u32x4*)(BTp + k * 8); }
#pragma unroll
    for (int r = 0; r < 2; ++r) { const int k = lt + 256 * r, l = k >> 3, ch = k & 7, sa = 32 * (ch >> 2) + 4 * (ch & 3);
        P[8 + r] = *(const u32x4*)(CBp + k * 8); PD(3 * r) = __float_as_uint(vp[l]); PD(3 * r + 1) = __float_as_uint(vp[sa + 3]); PD(3 * r + 2) = __float_as_uint(vp[sa + 19]);
        P[13 + r] = *(const u32x4*)(xt.p + (size_t)l * xt.stride + ch * 8); }
    P[10] = *(const u32x4*)(vp + 64 + 4 * (lt < 48 ? lt : 0));
}
__device__ __forceinline__ void ssd_stage_write(const u32x4 (&P)[15], LAS unsigned char* img, int lt) {
#pragma unroll
    for (int r = 0; r < 4; ++r) { const int k = lt + 256 * r;
        { const int row = k >> 4, ch = k & 15; *(LAS u32x4*)(img + SL_C + (row * 16 + (ch ^ (row & 15))) * 16) = P[r]; }
        { const int row = k >> 3, ch = k & 7; *(LAS u32x4*)(img + SL_BT + (row * 8 + (ch ^ ((row >> 1) & 7))) * 16) = P[4 + r]; } }
#pragma unroll
    for (int r = 0; r < 2; ++r) {
        const int k = lt + 256 * r, l = k >> 3, ch = k & 7, sa = 32 * (ch >> 2) + 4 * (ch & 3), sb = sa + 16;
        const float csl = __uint_as_float(PD(3 * r)), e1a = __expf(csl - __uint_as_float(PD(3 * r + 1))), e1b = __expf(csl - __uint_as_float(PD(3 * r + 2)));
        const u32x4 cbw = P[8 + r]; f32x4 va, vb;
        va[0] = (sa + 0 <= l) ? __uint_as_float(cbw.x << 16) * e1a : 0.f; va[1] = (sa + 1 <= l) ? __uint_as_float(cbw.x & 0xffff0000u) * e1a : 0.f;
        va[2] = (sa + 2 <= l) ? __uint_as_float(cbw.y << 16) * e1a : 0.f; va[3] = (sa + 3 <= l) ? __uint_as_float(cbw.y & 0xffff0000u) * e1a : 0.f;
        vb[0] = (sb + 0 <= l) ? __uint_as_float(cbw.z << 16) * e1b : 0.f; vb[1] = (sb + 1 <= l) ? __uint_as_float(cbw.z & 0xffff0000u) * e1b : 0.f;
        vb[2] = (sb + 2 <= l) ? __uint_as_float(cbw.w << 16) * e1b : 0.f; vb[3] = (sb + 3 <= l) ? __uint_as_float(cbw.w & 0xffff0000u) * e1b : 0.f;
        u32x4 w; w.x = cvt_pk_bf16(va[0], va[1]); w.y = cvt_pk_bf16(va[2], va[3]); w.z = cvt_pk_bf16(vb[0], vb[1]); w.w = cvt_pk_bf16(vb[2], vb[3]);
        const int slot = l * 8 + (ch ^ ((l >> 1) & 7));
        *(LAS u32x4*)(img + SL_M + slot * 16) = w;
        *(LAS u32x4*)(img + SL_XT + slot * 16) = P[13 + r];
    }
    if (lt < 48) *(LAS u32x4*)(img + SL_VEC + 16 * lt) = P[10];
}
template <bool DRY>
__device__ __forceinline__ void ssd_ytile_out(const LAS unsigned char* img, const XTile& xt, int lt) {
#pragma unroll
    for (int r = 0; r < 2; ++r) { const int k = lt + 256 * r, p = k >> 3, ch = k & 7;
        const u32x4 w = *(const LAS u32x4*)(img + SL_XT + (p * 8 + (ch ^ ((p >> 1) & 7))) * 16);
        if (!DRY) *(u32x4*)(xt.p + (size_t)p * xt.stride + ch * 8) = w; else KEEP(w); }
}
template <bool DRY>
__device__ void phase_ssd_chain(const Frame& F0, int j) {
    const Frame F = relaunder(F0);
    const unsigned char* sc = (const unsigned char*)F.out;
    const bool loader = F.wave >= 4; const int lt = F.tid - 256, ps = F.wave & 3;
    for (int sh = F.bid; sh < 320; sh += F.G) {
        const int seq = sh < 64 ? (sh >> 5) : 2 + ((sh - 64) >> 5), head = sh & 31;
        const int nch = seq_chunks(seq);
        const float dsk = F.inp(13)[j * SSD_HEADS + head];
        __syncthreads();
        if (loader) {
            u32x4 A[15], B[15];
            ssd_stage_load(A, F, sc, lt, seq, head, 0); ssd_stage_write(A, F.ldsl, lt);
            if (nch > 1) ssd_stage_load(B, F, sc, lt, seq, head, 1);
            if (nch > 2) ssd_stage_load(A, F, sc, lt, seq, head, 2);
            __syncthreads();
#define SSD_LOADER_STEP(CC, ST) { const int cc_ = (CC); int nxt = ((cc_ + 1) & 1) * SL_SIZE, lt_ = lt; asm volatile("" : "+s"(nxt), "+v"(lt_)); \
                if (cc_ > 0) ssd_ytile_out<DRY>(F.ldsl + nxt, ssd_xtile(F, seq, cc_ - 1, head), lt_); \
                if (cc_ + 1 < nch) ssd_stage_write(ST, F.ldsl + nxt, lt_); \
                if (cc_ + 3 < nch) ssd_stage_load(ST, F, sc, lt_, seq, head, cc_ + 3); \
                __syncthreads(); }
            for (int c = 0; c < nch; c += 2) {
                SSD_LOADER_STEP(c, B)
                if (c + 1 < nch) SSD_LOADER_STEP(c + 1, A)
            }
#undef SSD_LOADER_STEP
            ssd_ytile_out<DRY>(F.ldsl + ((nch - 1) & 1) * SL_SIZE, ssd_xtile(F, seq, nch - 1, head), lt);
        } else {
            f32x4 HT[8];
#pragma unroll
            for (int m8 = 0; m8 < 8; ++m8) HT[m8] = (f32x4){0.f, 0.f, 0.f, 0.f};
            if (seq >= 2) {
                const int i = F.lane & 15, g = F.lane >> 4;
                const float* st = F.inp(2) + ((((size_t)j * 8 + (seq - 2)) * SSD_HEADS + head) * SSD_P + ps * 16 + i) * SSD_N + 4 * g;
#pragma unroll
                for (int m8 = 0; m8 < 8; ++m8) HT[m8] = *(const f32x4*)(st + 16 * m8);
            }
            __syncthreads();
            for (int c = 0; c < nch; ++c) {
                int cur = (c & 1) * SL_SIZE, lane_ = F.lane;
                asm volatile("" : "+s"(cur), "+v"(lane_));
                LAS unsigned char* img = F.ldsl + cur;
                const int i = lane_ & 15, g = lane_ >> 4, prow = ps * 16 + i, psw = (prow >> 1) & 7;
                const LAS unsigned char* pc[4]; const LAS unsigned char* pm[2];
#pragma unroll
                for (int kk = 0; kk < 4; ++kk) pc[kk] = img + SL_C + i * 256 + (((4 * kk + g) ^ i) * 16);
#pragma unroll
                for (int k2 = 0; k2 < 2; ++k2) pm[k2] = img + i * 128 + (((4 * k2 + g) ^ (i >> 1)) * 16);
                f32x4 e24[4], w4[4], ecs4[4];
#pragma unroll
                for (int m = 0; m < 4; ++m) { e24[m] = *(const LAS f32x4*)(img + SL_VEC + (16 * m + 4 * g) * 4); w4[m] = *(const LAS f32x4*)(img + SL_VEC + 256 + (16 * m + 4 * g) * 4); ecs4[m] = *(const LAS f32x4*)(img + SL_VEC + 512 + (16 * m + 4 * g) * 4); }
                const float ecl = *(const LAS float*)(img + SL_VEC + 512 + 63 * 4);
                bf16x8 Hf[4];
#pragma unroll
                for (int kk = 0; kk < 4; ++kk) Hf[kk] = pack8(HT[2 * kk], HT[2 * kk + 1]);
                f32x4 Y[4];
#pragma unroll
                for (int m = 0; m < 4; ++m) {
                    f32x4 acc = (f32x4){0.f, 0.f, 0.f, 0.f};
#pragma unroll
                    for (int kk = 0; kk < 4; ++kk) { const bf16x8 cf = *(const LAS bf16x8*)(pc[kk] + m * 4096); acc = __builtin_amdgcn_mfma_f32_16x16x32_bf16(cf, Hf[kk], acc, 0, 0, 0); }
                    Y[m] = acc * ecs4[m];
                }
                f32x4 xv[4];
                LAS unsigned char* xrow = img + SL_XT + prow * 128 + 8 * (g & 1);
#pragma unroll
                for (int m = 0; m < 4; ++m) {
                    const u32x2 xw = *(const LAS u32x2*)(xrow + ((2 * m + (g >> 1)) ^ psw) * 16);
                    xv[m][0] = __uint_as_float(xw.x << 16); xv[m][1] = __uint_as_float(xw.x & 0xffff0000u); xv[m][2] = __uint_as_float(xw.y << 16); xv[m][3] = __uint_as_float(xw.y & 0xffff0000u);
                }
                bf16x8 xsf[2], xwf[2];
#pragma unroll
                for (int k2 = 0; k2 < 2; ++k2) { xsf[k2] = pack8(xv[2 * k2] * e24[2 * k2], xv[2 * k2 + 1] * e24[2 * k2 + 1]); xwf[k2] = pack8(xv[2 * k2] * w4[2 * k2], xv[2 * k2 + 1] * w4[2 * k2 + 1]); }
#pragma unroll
                for (int m = 0; m < 4; ++m)
#pragma unroll
                    for (int k2 = 0; k2 < 2; ++k2) { const bf16x8 mf = *(const LAS bf16x8*)(pm[k2] + SL_M + m * 2048); Y[m] = __builtin_amdgcn_mfma_f32_16x16x32_bf16(mf, xsf[k2], Y[m], 0, 0, 0); }
#pragma unroll
                for (int m8 = 0; m8 < 8; ++m8) {
                    f32x4 acc = HT[m8] * ecl;
#pragma unroll
                    for (int k2 = 0; k2 < 2; ++k2) { const bf16x8 bf = *(const LAS bf16x8*)(pm[k2] + SL_BT + m8 * 2048); acc = __builtin_amdgcn_mfma_f32_16x16x32_bf16(bf, xwf[k2], acc, 0, 0, 0); }
                    HT[m8] = acc;
                }
#pragma unroll
                for (int m = 0; m < 4; ++m) {
                    const f32x4 y = Y[m] + xv[m] * dsk; u32x2 w; w.x = cvt_pk_bf16(y[0], y[1]); w.y = cvt_pk_bf16(y[2], y[3]);
                    *(LAS u32x2*)(xrow + ((2 * m + (g >> 1)) ^ psw) * 16) = w;
                }
                __syncthreads();
            }
            const int i = F.lane & 15, g = F.lane >> 4;
            float* so = (seq < 2) ? F.out + O_PSSD + ((((size_t)j * 2 + seq) * SSD_HEADS + head) * SSD_P + ps * 16 + i) * SSD_N + 4 * g
                                  : F.out + O_SSSD + ((((size_t)j * 8 + (seq - 2)) * SSD_HEADS + head) * SSD_P + ps * 16 + i) * SSD_N + 4 * g;
#pragma unroll
            for (int m8 = 0; m8 < 8; ++m8) { if (!DRY) *(f32x4*)(so + 16 * m8) = HT[m8]; else KEEP(HT[m8]); }
        }
    }
}

template <bool DRY>
__device__ void phase_ssd_post(const Frame& F0, int j) {
    const Frame F = relaunder(F0);
    constexpr int RS = 68;
    bf16_t* YT = (bf16_t*)F.lds;
    for (int task = F.bid; task < NCHT * 4; task += F.G) {
        const int cgi = task >> 2, grp = task & 3; int seq, c; chunk_of(cgi, seq, c);
        const int base = seq_base(seq), t0 = 64 * c - PADF;
        __syncthreads();
#pragma unroll
        for (int r = 0; r < 8; ++r) {
            const int k = F.tid + 512 * r, hl = k >> 9, p = (k >> 3) & 63, ch = k & 7;
            const XTile xt = ssd_xtile(F, seq, c, grp * 8 + hl);
            const u32x4 w = *(const u32x4*)(xt.p + (size_t)p * xt.stride + ch * 8);
            u32x2* d = (u32x2*)(YT + (hl * 64 + p) * RS + ch * 8); u32x2 a, b; a.x = w.x; a.y = w.y; b.x = w.z; b.y = w.w; d[0] = a; d[1] = b;
        }
        __syncthreads();
        for (int q = 0; q < 8; ++q) {
            const int l = F.wave + 8 * q, t = t0 + l;
            if (t < 0 && seq >= 2) continue;
            const int row = seq < 2 ? seq * TPP + 64 * c + l : base + t;
            bf16_t* zrow = F.proj + (size_t)row * LDP + grp * 512 + F.lane;
            float yg[8]; float ss = 0.f;
#pragma unroll
            for (int e = 0; e < 8; ++e) { const float y = bf2f(YT[(e * 64 + F.lane) * RS + l]), z = bf2f(zrow[64 * e]); yg[e] = y * silu_f(z); ss += yg[e] * yg[e]; }
            ss = wave_sum(ss);
            const float rs = rsqrtf(ss * (1.0f / 512.0f) + EPS);
#pragma unroll
            for (int e = 0; e < 8; ++e) { if (!DRY) zrow[64 * e] = f2bf(yg[e] * rs); else KEEP(yg[e] * rs); }
        }
    }
    for (int e = F.bid * NTHREADS + F.tid; e < NSEQ * 3 * SSD_CONV; e += F.G * NTHREADS) {
        const int s = e / (3 * SSD_CONV), r = (e / SSD_CONV) % 3, c = e % SSD_CONV;
        const int row = seq_base(s) + seq_len(s) - 3 + r;
        float v;
        if (s < 2 && c < 2048) v = bf2f(F.tails[((size_t)(s * 129 + 128) * 3 + r) * 4096 + c]);
        else v = bf2f(F.proj[(size_t)row * LDP + 2048 + c]);
        if (s < 2) F.out[O_PSSDC + (((size_t)j * 2 + s) * 3 + r) * SSD_CONV + c] = v;
        else F.out[O_SSSDC + (((size_t)j * 8 + (s - 2)) * 3 + r) * SSD_CONV + c] = v;
    }
}

constexpr size_t SG_W = 0;
constexpr size_t SG_QK = SG_W + (size_t)NCHT * 8 * 16384;
constexpr size_t SG_VEC = SG_QK + (size_t)NCHT * 8 * 8192;
constexpr size_t SG_PART = SG_VEC + (size_t)NCHT * 8 * 1024;
constexpr size_t SG_SIDE = SG_PART + (size_t)M_TOT * 128 * 2;
constexpr size_t SG_END = SG_SIDE + (size_t)64 * 65536;
static_assert(SG_END <= (size_t)16777216 * 4, "scratch must fit the y_prompt region");
struct GTile { bf16_t* q; bf16_t* k; bf16_t* v; int sq, sk, sv; };
__device__ __forceinline__ GTile gdn_tile(const Frame& F, int seq, int c, int head) {
    GTile t;
    if (seq < 2) { bf16_t* r0 = F.proj + (size_t)(seq * TPP + 64 * c) * LDP; t.q = r0 + head * 128; t.k = r0 + 1024 + head * 128; t.v = r0 + 2048 + head * 256; t.sq = LDP; t.sk = LDP; t.sv = LDP; }
    else { bf16_t* b = (bf16_t*)((unsigned char*)F.out + SG_SIDE) + (size_t)((seq - 2) * 8 + head) * 32768; t.q = b; t.k = b + 8192; t.v = b + 16384; t.sq = 128; t.sk = 128; t.sv = 256; }
    return t;
}

template <bool DRY>
__device__ void phase_gdn_prep(const Frame& F0, int j) {
    const Frame F = relaunder(F0);
    float* Am = (float*)F.lds;
    float* vgc = Am + 64 * 68;
    float* vbe = vgc + 64;
    float* vnq = vbe + 64;
    float* vnk = vnq + 64;
    bf16_t* qs = (bf16_t*)(vnk + 64);
    bf16_t* ks = qs + 64 * 136;
    bf16_t* kT = ks + 64 * 136;
    bf16_t* vT = kT + 128 * 72;
    bf16_t* Tb = vT + 256 * 72;
    bf16_t* TT = Tb + 2 * 64 * 72;
    bf16_t* TD = TT + 64 * 72;
    bf16_t* YT = TD + 2 * 4 * 16 * 24;
    unsigned char* sc = (unsigned char*)F.out;
    const float* conv_w = F.inp(18) + (size_t)j * 4 * GDN_CONV;
    const int i16 = F.lane & 15, g4 = F.lane >> 4;
    constexpr float CQ = 0.08838834764831845f;
    for (int task = F.bid; task < NCHT * 8; task += F.G) {
        const int cgi = task >> 3, head = task & 7; int seq, c; chunk_of(cgi, seq, c);
        const int base = seq_base(seq), t0 = 64 * c - PADF;
        const GTile tl = gdn_tile(F, seq, c, head);
        __syncthreads();
        for (int q = F.tid; q < (3 * 64 * 72 + 64 * 24) / 8; q += NTHREADS) { bf16_t* z0 = (q < 3 * 64 * 72 / 8) ? Tb + 8 * q : YT + 8 * (q - 3 * 64 * 72 / 8); *(u32x4*)z0 = (u32x4){0u, 0u, 0u, 0u}; }
        if (F.wave == 0) {
            const int t = t0 + F.lane; float gg = 0.f, be = 0.f;
            if (t >= 0) { const float* dp = F.dtb + (size_t)(base + t) * 32; gg = -__expf(F.inp(20)[j * GDN_HEADS + head]) * softplus_f(dp[head] + F.inp(19)[j * GDN_HEADS + head]); be = 1.0f / (1.0f + __expf(-dp[8 + head])); }
#pragma unroll
            for (int o = 1; o < 64; o <<= 1) { const float y = __shfl_up(gg, o); if (F.lane >= o) gg += y; }
            vgc[F.lane] = gg; vbe[F.lane] = be;
        }
        __syncthreads();
        {
            const int ch = F.tid;
            const int cidx = ch < 128 ? head * 128 + ch : (ch < 256 ? 1024 + head * 128 + (ch - 128) : 2048 + head * 256 + (ch - 256));
            const float w0 = conv_w[cidx], w1 = conv_w[GDN_CONV + cidx], w2 = conv_w[2 * GDN_CONV + cidx], w3 = conv_w[3 * GDN_CONV + cidx];
            const float* cst = (seq >= 2) ? F.inp(5) + (((size_t)j * 8 + (seq - 2)) * 3) * GDN_CONV + cidx : nullptr;
            const bf16_t* tailp = (seq < 2 && c > 0) ? F.tails + (size_t)(cgi - 1) * 3 * 4096 + cidx : nullptr;
            float r3 = 0.f, r2 = 0.f, r1 = 0.f;
            if (tailp) { r3 = bf2f(tailp[0]); r2 = bf2f(tailp[4096]); r1 = bf2f(tailp[2 * 4096]); }
            else if (cst) { r3 = cst[0]; r2 = cst[GDN_CONV]; r1 = cst[2 * GDN_CONV]; }
            const bf16_t* col = F.proj + cidx;
#pragma unroll 1
            for (int pg = 0; pg < 2; ++pg) {
                unsigned short raw[32];
#pragma unroll
                for (int e = 0; e < 32; ++e) { const int t = t0 + 32 * pg + e; raw[e] = col[(size_t)(base + (t > 0 ? t : 0)) * LDP]; }
#pragma unroll
                for (int e = 0; e < 32; ++e) {
                    const int p = 32 * pg + e, t = t0 + p;
                    const float x = (t >= 0) ? bf2f(raw[e]) : 0.f;
                    const float o = silu_f(w0 * r3 + w1 * r2 + w2 * r1 + w3 * x);
                    if (t >= 0) { r3 = r2; r2 = r1; r1 = x; }
                    if (ch < 128) qs[p * 136 + ch] = f2bf(o);
                    else if (ch < 256) { const bf16_t b = f2bf(o); ks[p * 136 + (ch - 128)] = b; kT[(ch - 128) * 72 + p] = b; }
                    else vT[(ch - 256) * 72 + p] = f2bf(o * vbe[p]);
                }
            }
        }
        __syncthreads();
        if (F.tid < 128) {
            const int l = F.tid & 63; const bf16_t* rowp = (F.tid < 64 ? qs : ks) + l * 136; float ss = 0.f;
#pragma unroll
            for (int q = 0; q < 16; ++q) { const u32x4 v = *(const u32x4*)(rowp + 8 * q);
                const float a0 = __uint_as_float(v.x << 16), a1 = __uint_as_float(v.x & 0xffff0000u), a2 = __uint_as_float(v.y << 16), a3 = __uint_as_float(v.y & 0xffff0000u);
                const float a4 = __uint_as_float(v.z << 16), a5 = __uint_as_float(v.z & 0xffff0000u), a6 = __uint_as_float(v.w << 16), a7 = __uint_as_float(v.w & 0xffff0000u);
                ss += ((a0 * a0 + a1 * a1) + (a2 * a2 + a3 * a3)) + ((a4 * a4 + a5 * a5) + (a6 * a6 + a7 * a7)); }
            (F.tid < 64 ? vnq : vnk)[l] = rsqrtf(ss + EPS);
        }
        __syncthreads();
        {
            bf16_t* QKg = (bf16_t*)(sc + SG_QK) + (size_t)task * 4096;
            const int m = F.wave >> 1;
#pragma unroll
            for (int u = 0; u < 2; ++u) {
                const int st = 2 * (F.wave & 1) + u; f32x4 aK = (f32x4){0.f, 0.f, 0.f, 0.f}, aQ = (f32x4){0.f, 0.f, 0.f, 0.f};
#pragma unroll
                for (int kk = 0; kk < 4; ++kk) {
                    const bf16x8 ak = *(const bf16x8*)(ks + (16 * m + i16) * 136 + 32 * kk + 8 * g4);
                    const bf16x8 aq = *(const bf16x8*)(qs + (16 * m + i16) * 136 + 32 * kk + 8 * g4);
                    const bf16x8 b = *(const bf16x8*)(ks + (16 * st + i16) * 136 + 32 * kk + 8 * g4);
                    aK = __builtin_amdgcn_mfma_f32_16x16x32_bf16(ak, b, aK, 0, 0, 0);
                    aQ = __builtin_amdgcn_mfma_f32_16x16x32_bf16(aq, b, aQ, 0, 0, 0);
                }
                const int s_ = 16 * st + i16; const float gs = vgc[s_], nks = vnk[s_]; const int qs_ = qperm(s_);
#pragma unroll
                for (int jj = 0; jj < 4; ++jj) {
                    const int l = 16 * m + 4 * g4 + jj;
                    const float dec = (s_ <= l) ? __expf(vgc[l] - gs) : 0.f;
                    Am[l * 68 + s_] = (s_ < l) ? vbe[l] * vnk[l] * nks * aK[jj] * dec : 0.f;
                    { const float r = CQ * vnq[l] * nks * aQ[jj] * dec; if (!DRY) QKg[l * 64 + qs_] = f2bf(r); else KEEP(r); }
                }
            }
        }
        __syncthreads();
        if (F.wave == 0) for (int rep = 0; rep < REP_SUBST; ++rep) {
            int ln = F.lane; asm volatile("" : "+v"(ln));
            const int i = ln & 15, g = ln >> 4;
            {   const int b = g, cc = i; float x[16];
#pragma unroll
                for (int r = 0; r < 16; ++r) {
                    float a0 = (r == cc) ? 1.f : 0.f, a1 = 0.f;
#pragma unroll
                    for (int s2 = 0; s2 < r; ++s2) { const float av = Am[(16 * b + r) * 68 + 16 * b + s2]; if (s2 & 1) a1 -= av * x[s2]; else a0 -= av * x[s2]; }
                    x[r] = a0 + a1;
                }
                const int cg = 16 * b + cc; const float csc = vbe[cg] * __expf(vgc[cg]) * vnk[cg];
#pragma unroll
                for (int r = 0; r < 16; ++r) {
                    const bf16_t hi = f2bf(x[r]); const int lg = 16 * b + r;
                    Tb[lg * 72 + cg] = hi; Tb[64 * 72 + lg * 72 + cg] = f2bf(x[r] * csc); TT[cg * 72 + lg] = hi;
                    TD[(b * 16 + r) * 24 + cc] = hi; TD[4 * 16 * 24 + (b * 16 + r) * 24 + cc] = f2bf(x[r] - bf2f(hi));
                }
            }
#pragma unroll
            for (int bi = 1; bi < 4; ++bi) {
#pragma unroll
                for (int nt = 0; nt < bi; ++nt) {
                    f32x4 acc = (f32x4){0.f, 0.f, 0.f, 0.f};
#pragma unroll
                    for (int ks = 0; ks < (16 * bi + 31) / 32; ++ks) {
                        const int k0 = 32 * ks + 8 * g;
                        f32x4 alo4 = (f32x4){0.f, 0.f, 0.f, 0.f}, ahi4 = (f32x4){0.f, 0.f, 0.f, 0.f};
                        if (k0 < 16 * bi) { alo4 = *(const f32x4*)(Am + (16 * bi + i) * 68 + k0); ahi4 = *(const f32x4*)(Am + (16 * bi + i) * 68 + k0 + 4); }
                        const bf16x8 ah = pack8(alo4, ahi4);
                        const u32x4 ahw = __builtin_bit_cast(u32x4, ah);
                        f32x4 r0, r1;
                        r0[0] = alo4[0] - __uint_as_float(ahw.x << 16); r0[1] = alo4[1] - __uint_as_float(ahw.x & 0xffff0000u); r0[2] = alo4[2] - __uint_as_float(ahw.y << 16); r0[3] = alo4[3] - __uint_as_float(ahw.y & 0xffff0000u);
                        r1[0] = ahi4[0] - __uint_as_float(ahw.z << 16); r1[1] = ahi4[1] - __uint_as_float(ahw.z & 0xffff0000u); r1[2] = ahi4[2] - __uint_as_float(ahw.w << 16); r1[3] = ahi4[3] - __uint_as_float(ahw.w & 0xffff0000u);
                        const bf16x8 al = pack8(r0, r1);
                        const bf16x8 bt = *(const bf16x8*)(TT + (16 * nt + i) * 72 + k0);
                        acc = __builtin_amdgcn_mfma_f32_16x16x32_bf16(ah, bt, acc, 0, 0, 0);
                        acc = __builtin_amdgcn_mfma_f32_16x16x32_bf16(al, bt, acc, 0, 0, 0);
                    }
                    u32x2 w; w.x = cvt_pk_bf16(acc[0], acc[1]); w.y = cvt_pk_bf16(acc[2], acc[3]);
                    *(u32x2*)(YT + (16 * nt + i) * 24 + 4 * g) = w;
                }
                bf16x8 th = __builtin_bit_cast(bf16x8, (u32x4){0u, 0u, 0u, 0u}), tlo = th;
                if (g < 2) { th = *(const bf16x8*)(TD + (bi * 16 + i) * 24 + 8 * g); tlo = *(const bf16x8*)(TD + 4 * 16 * 24 + (bi * 16 + i) * 24 + 8 * g); }
#pragma unroll
                for (int nt = 0; nt < bi; ++nt) {
                    bf16x8 yb = __builtin_bit_cast(bf16x8, (u32x4){0u, 0u, 0u, 0u});
                    if (g < 2) yb = *(const bf16x8*)(YT + (16 * nt + i) * 24 + 8 * g);
                    f32x4 acc = (f32x4){0.f, 0.f, 0.f, 0.f};
                    acc = __builtin_amdgcn_mfma_f32_16x16x32_bf16(th, yb, acc, 0, 0, 0);
                    acc = __builtin_amdgcn_mfma_f32_16x16x32_bf16(tlo, yb, acc, 0, 0, 0);
                    const int cg = 16 * nt + i; const float csc = vbe[cg] * __expf(vgc[cg]) * vnk[cg];
                    u32x2 w; w.x = cvt_pk_bf16(-acc[0], -acc[1]); w.y = cvt_pk_bf16(-acc[2], -acc[3]);
                    *(u32x2*)(TT + cg * 72 + 16 * bi + 4 * g) = w;
#pragma unroll
                    for (int jj = 0; jj < 4; ++jj) { const int lg = 16 * bi + 4 * g + jj; Tb[lg * 72 + cg] = f2bf(-acc[jj]); Tb[64 * 72 + lg * 72 + cg] = f2bf(-acc[jj] * csc); }
                }
            }
        } else {
            const int t7 = F.tid - 64;
            for (int idx = t7; idx < 1024; idx += 448) {
                const int l = idx >> 4, qg8 = idx & 15, kk = qg8 >> 2, gg = qg8 & 3;
                const u32x2 a = *(const u32x2*)(qs + l * 136 + 32 * kk + 4 * gg), b = *(const u32x2*)(qs + l * 136 + 32 * kk + 16 + 4 * gg);
                u32x4 w; w.x = a.x; w.y = a.y; w.z = b.x; w.w = b.y;
                if (!DRY) *(u32x4*)(tl.q + (size_t)l * tl.sq + 8 * qg8) = w; else KEEP(w);
            }
            for (int idx = t7; idx < 1024; idx += 448) {
                const int kd = idx >> 3, pg = idx & 7, kk2 = pg >> 2, gg = pg & 3;
                const u32x2 a = *(const u32x2*)(kT + kd * 72 + 32 * kk2 + 4 * gg), b = *(const u32x2*)(kT + kd * 72 + 32 * kk2 + 16 + 4 * gg);
                u32x4 w; w.x = a.x; w.y = a.y; w.z = b.x; w.w = b.y;
                if (!DRY) *(u32x4*)(tl.k + (size_t)(kd >> 1) * tl.sk + (kd & 1) * 64 + 8 * pg) = w; else KEEP(w);
            }
            if (t7 < 64) {
                float* vp = (float*)(sc + SG_VEC) + (size_t)task * 256; const float gl = vgc[63];
                const float v0 = __expf(vgc[t7]) * CQ * vnq[t7], v1 = vnk[t7] * __expf(gl - vgc[t7]), v2 = __expf(gl);
                if (!DRY) { vp[t7] = v0; vp[64 + t7] = v1; vp[128 + t7] = v2; vp[192 + t7] = 0.f; } else { KEEP(v0); KEEP(v1); KEEP(v2); }
            }
        }
        __syncthreads();
        {
            bf16_t* Wg = (bf16_t*)(sc + SG_W) + (size_t)task * 8192;
            bf16x8 bk[2];
#pragma unroll
            for (int k2 = 0; k2 < 2; ++k2) bk[k2] = *(const bf16x8*)(kT + (16 * F.wave + i16) * 72 + 32 * k2 + 8 * g4);
            const int qkd = qperm(16 * F.wave + i16);
#pragma unroll
            for (int m = 0; m < 4; ++m) {
                f32x4 acc = (f32x4){0.f, 0.f, 0.f, 0.f};
#pragma unroll
                for (int k2 = 0; k2 < 2; ++k2) { const bf16x8 a = *(const bf16x8*)(Tb + 64 * 72 + (16 * m + i16) * 72 + 32 * k2 + 8 * g4); acc = __builtin_amdgcn_mfma_f32_16x16x32_bf16(a, bk[k2], acc, 0, 0, 0); }
#pragma unroll
                for (int jj = 0; jj < 4; ++jj) { if (!DRY) Wg[(16 * m + 4 * g4 + jj) * 128 + qkd] = f2bf(acc[jj]); else KEEP(acc[jj]); }
            }
#pragma unroll
            for (int u = 0; u < 2; ++u) {
                const int v = 16 * (2 * F.wave + u) + i16;
                bf16x8 bv[2];
#pragma unroll
                for (int k2 = 0; k2 < 2; ++k2) bv[k2] = *(const bf16x8*)(vT + v * 72 + 32 * k2 + 8 * g4);
#pragma unroll
                for (int m = 0; m < 4; ++m) {
                    f32x4 acc = (f32x4){0.f, 0.f, 0.f, 0.f};
#pragma unroll
                    for (int k2 = 0; k2 < 2; ++k2) { const bf16x8 a = *(const bf16x8*)(Tb + (16 * m + i16) * 72 + 32 * k2 + 8 * g4); acc = __builtin_amdgcn_mfma_f32_16x16x32_bf16(a, bv[k2], acc, 0, 0, 0); }
                    u32x2 w; w.x = cvt_pk_bf16(acc[0], acc[1]); w.y = cvt_pk_bf16(acc[2], acc[3]);
                    if (!DRY) *(u32x2*)(tl.v + (size_t)(v >> 2) * tl.sv + (v & 3) * 64 + 16 * m + 4 * g4) = w; else KEEP(w);
                }
            }
        }
    }
}

constexpr int GL_W = 0, GL_Q = 16384, GL_KT = 32768, GL_QK = 49152, GL_U = 57344, GL_VEC = 65536, GL_SIZE = 66560;
__device__ __forceinline__ bf16_t* gdn_urow(const GTile& tl, int v) { return tl.v + (size_t)(v >> 2) * tl.sv + (v & 3) * 64; }
__device__ __forceinline__ void gdn_stage_load(u32x4 (&P)[17], const Frame& F, const unsigned char* sc, int lt, int seq, int head, int vq, int c) {
    const int task = cgi_of(seq, c) * 8 + head;
    const GTile tl = gdn_tile(F, seq, c, head);
    const bf16_t* Wp = (const bf16_t*)(sc + SG_W) + (size_t)task * 8192;
    const bf16_t* QKp = (const bf16_t*)(sc + SG_QK) + (size_t)task * 4096;
    const float* vp = (const float*)(sc + SG_VEC) + (size_t)task * 256;
#pragma unroll
    for (int r = 0; r < 4; ++r) { const int k = lt + 256 * r;
        P[r] = *(const u32x4*)(Wp + k * 8);
        P[4 + r] = *(const u32x4*)(tl.q + (size_t)(k >> 4) * tl.sq + (k & 15) * 8);
        { const int kd = k >> 3; P[8 + r] = *(const u32x4*)(tl.k + (size_t)(kd >> 1) * tl.sk + (kd & 1) * 64 + (k & 7) * 8); } }
#pragma unroll
    for (int r = 0; r < 2; ++r) { const int k = lt + 256 * r;
        P[12 + r] = *(const u32x4*)(QKp + k * 8);
        P[14 + r] = *(const u32x4*)(gdn_urow(tl, vq * 64 + (k >> 3)) + (k & 7) * 8); }
    P[16] = *(const u32x4*)(vp + 4 * (lt < 48 ? lt : 0));
}
__device__ __forceinline__ void gdn_stage_write(const u32x4 (&P)[17], LAS unsigned char* img, int lt) {
#pragma unroll
    for (int r = 0; r < 4; ++r) { const int k = lt + 256 * r;
        { const int row = k >> 4, ch = k & 15, slot = row * 16 + (ch ^ (row & 15)); *(LAS u32x4*)(img + GL_W + slot * 16) = P[r]; *(LAS u32x4*)(img + GL_Q + slot * 16) = P[4 + r]; }
        { const int row = k >> 3, ch = k & 7; *(LAS u32x4*)(img + GL_KT + (row * 8 + (ch ^ ((row >> 1) & 7))) * 16) = P[8 + r]; } }
#pragma unroll
    for (int r = 0; r < 2; ++r) { const int k = lt + 256 * r, row = k >> 3, ch = k & 7, slot = row * 8 + (ch ^ ((row >> 1) & 7));
        *(LAS u32x4*)(img + GL_QK + slot * 16) = P[12 + r]; *(LAS u32x4*)(img + GL_U + slot * 16) = P[14 + r]; }
    if (lt < 48) *(LAS u32x4*)(img + GL_VEC + 16 * lt) = P[16];
}
template <bool DRY>
__device__ __forceinline__ void gdn_otile_out(const LAS unsigned char* img, const GTile& tl, int vq, int lt) {
#pragma unroll
    for (int r = 0; r < 2; ++r) { const int k = lt + 256 * r, row = k >> 3, ch = k & 7;
        const u32x4 w = *(const LAS u32x4*)(img + GL_U + (row * 8 + (ch ^ ((row >> 1) & 7))) * 16);
        if (!DRY) *(u32x4*)(gdn_urow(tl, vq * 64 + row) + ch * 8) = w; else KEEP(w); }
}
template <bool DRY>
__device__ void phase_gdn_chain(const Frame& F0, int j) {
    const Frame F = relaunder(F0);
    const unsigned char* sc = (const unsigned char*)F.out;
    const bool loader = F.wave >= 4; const int lt = F.tid - 256, w4 = F.wave & 3;
    for (int sh = F.bid; sh < 320; sh += F.G) {
        const int seq = sh < 64 ? (sh >> 5) : 2 + ((sh - 64) >> 5), head = (sh >> 2) & 7, vq = sh & 3;
        const int nch = seq_chunks(seq);
        __syncthreads();
        if (loader) {
            u32x4 A[17], B[17];
            gdn_stage_load(A, F, sc, lt, seq, head, vq, 0); gdn_stage_write(A, F.ldsl, lt);
            if (nch > 1) gdn_stage_load(B, F, sc, lt, seq, head, vq, 1);
            if (nch > 2) gdn_stage_load(A, F, sc, lt, seq, head, vq, 2);
            __syncthreads();
#define GDN_LOADER_STEP(CC, ST) { const int cc_ = (CC); int nxt = ((cc_ + 1) & 1) * GL_SIZE, lt_ = lt; asm volatile("" : "+s"(nxt), "+v"(lt_)); \
                if (cc_ > 0) gdn_otile_out<DRY>(F.ldsl + nxt, gdn_tile(F, seq, cc_ - 1, head), vq, lt_); \
                if (cc_ + 1 < nch) gdn_stage_write(ST, F.ldsl + nxt, lt_); \
                if (cc_ + 3 < nch) gdn_stage_load(ST, F, sc, lt_, seq, head, vq, cc_ + 3); \
                __syncthreads(); }
            for (int c = 0; c < nch; c += 2) {
                GDN_LOADER_STEP(c, B)
                if (c + 1 < nch) GDN_LOADER_STEP(c + 1, A)
            }
#undef GDN_LOADER_STEP
            gdn_otile_out<DRY>(F.ldsl + ((nch - 1) & 1) * GL_SIZE, gdn_tile(F, seq, nch - 1, head), vq, lt);
        } else {
            f32x4 S[8];
#pragma unroll
            for (int m8 = 0; m8 < 8; ++m8) S[m8] = (f32x4){0.f, 0.f, 0.f, 0.f};
            if (seq >= 2) {
                const int i = F.lane & 15, g = F.lane >> 4;
                const float* st = F.inp(4) + (((size_t)j * 8 + (seq - 2)) * GDN_HEADS + head) * GDN_DK * GDN_DV + vq * 64 + w4 * 16 + i;
#pragma unroll
                for (int m8 = 0; m8 < 8; ++m8)
#pragma unroll
                    for (int jj = 0; jj < 4; ++jj) S[m8][jj] = st[(size_t)(16 * m8 + 4 * g + jj) * GDN_DV];
            }
            __syncthreads();
            for (int c = 0; c < nch; ++c) {
                int cur = (c & 1) * GL_SIZE, lane_ = F.lane;
                asm volatile("" : "+s"(cur), "+v"(lane_));
                LAS unsigned char* img = F.ldsl + cur;
                const int i = lane_ & 15, g = lane_ >> 4, vrow = w4 * 16 + i, vsw = (vrow >> 1) & 7;
                const LAS unsigned char* pw[4]; const LAS unsigned char* pk[2];
#pragma unroll
                for (int kk = 0; kk < 4; ++kk) pw[kk] = img + i * 256 + (((4 * kk + g) ^ i) * 16);
#pragma unroll
                for (int k2 = 0; k2 < 2; ++k2) pk[k2] = img + i * 128 + (((4 * k2 + g) ^ (i >> 1)) * 16);
                f32x4 rsc[4], vsc[4];
#pragma unroll
                for (int m = 0; m < 4; ++m) { rsc[m] = *(const LAS f32x4*)(img + GL_VEC + (16 * m + 4 * g) * 4); vsc[m] = *(const LAS f32x4*)(img + GL_VEC + 256 + (16 * m + 4 * g) * 4); }
                const float egl = *(const LAS float*)(img + GL_VEC + 512);
                bf16x8 Sf[4];
#pragma unroll
                for (int kk = 0; kk < 4; ++kk) Sf[kk] = pack8(S[2 * kk], S[2 * kk + 1]);
                LAS unsigned char* urow = img + GL_U + vrow * 128 + 8 * (g & 1);
                f32x4 vn[4], O[4];
#pragma unroll
                for (int m = 0; m < 4; ++m) {
                    f32x4 a1 = (f32x4){0.f, 0.f, 0.f, 0.f}, a2 = (f32x4){0.f, 0.f, 0.f, 0.f};
#pragma unroll
                    for (int kk = 0; kk < 4; ++kk) {
                        const bf16x8 wf = *(const LAS bf16x8*)(pw[kk] + GL_W + m * 4096), qf = *(const LAS bf16x8*)(pw[kk] + GL_Q + m * 4096);
                        a1 = __builtin_amdgcn_mfma_f32_16x16x32_bf16(wf, Sf[kk], a1, 0, 0, 0);
                        a2 = __builtin_amdgcn_mfma_f32_16x16x32_bf16(qf, Sf[kk], a2, 0, 0, 0);
                    }
                    const u32x2 uw = *(const LAS u32x2*)(urow + ((2 * m + (g >> 1)) ^ vsw) * 16);
                    vn[m][0] = __uint_as_float(uw.x << 16) - a1[0]; vn[m][1] = __uint_as_float(uw.x & 0xffff0000u) - a1[1];
                    vn[m][2] = __uint_as_float(uw.y << 16) - a1[2]; vn[m][3] = __uint_as_float(uw.y & 0xffff0000u) - a1[3];
                    O[m] = a2 * rsc[m];
                }
                bf16x8 Vf[2], Vsf[2];
#pragma unroll
                for (int k2 = 0; k2 < 2; ++k2) { Vf[k2] = pack8(vn[2 * k2], vn[2 * k2 + 1]); Vsf[k2] = pack8(vn[2 * k2] * vsc[2 * k2], vn[2 * k2 + 1] * vsc[2 * k2 + 1]); }
#pragma unroll
                for (int m = 0; m < 4; ++m)
#pragma unroll
                    for (int k2 = 0; k2 < 2; ++k2) { const bf16x8 qk = *(const LAS bf16x8*)(pk[k2] + GL_QK + m * 2048); O[m] = __builtin_amdgcn_mfma_f32_16x16x32_bf16(qk, Vf[k2], O[m], 0, 0, 0); }
#pragma unroll
                for (int m8 = 0; m8 < 8; ++m8) {
                    f32x4 acc = S[m8] * egl;
#pragma unroll
                    for (int k2 = 0; k2 < 2; ++k2) { const bf16x8 kf = *(const LAS bf16x8*)(pk[k2] + GL_KT + m8 * 2048); acc = __builtin_amdgcn_mfma_f32_16x16x32_bf16(kf, Vsf[k2], acc, 0, 0, 0); }
                    S[m8] = acc;
                }
#pragma unroll
                for (int m = 0; m < 4; ++m) { u32x2 w; w.x = cvt_pk_bf16(O[m][0], O[m][1]); w.y = cvt_pk_bf16(O[m][2], O[m][3]); *(LAS u32x2*)(urow + ((2 * m + (g >> 1)) ^ vsw) * 16) = w; }
                __syncthreads();
            }
            const int i = F.lane & 15, g = F.lane >> 4, vcol = vq * 64 + w4 * 16 + i;
            float* so = (seq < 2) ? F.out + O_PGDN + (((size_t)j * 2 + seq) * GDN_HEADS + head) * GDN_DK * GDN_DV + vcol
                                  : F.out + O_SGDN + (((size_t)j * 8 + (seq - 2)) * GDN_HEADS + head) * GDN_DK * GDN_DV + vcol;
#pragma unroll
            for (int m8 = 0; m8 < 8; ++m8)
#pragma unroll
                for (int jj = 0; jj < 4; ++jj) { if (!DRY) so[(size_t)(16 * m8 + 4 * g + jj) * GDN_DV] = S[m8][jj]; else KEEP(S[m8][jj]); }
        }
    }
}

template <bool DRY>
__device__ void phase_gdn_post2(const Frame& F0, int j) {
    const Frame F = relaunder(F0);
    constexpr int RS = 68;
    bf16_t* OT = (bf16_t*)F.lds;
    for (int task = F.bid; task < NCHT * 8; task += F.G) {
        const int cgi = task >> 3, head = task & 7; int seq, c; chunk_of(cgi, seq, c);
        const int base = seq_base(seq), t0 = 64 * c - PADF;
        const GTile tl = gdn_tile(F, seq, c, head);
        __syncthreads();
#pragma unroll
        for (int r = 0; r < 4; ++r) {
            const int k = F.tid + 512 * r, v = k >> 3, ch = k & 7;
            const u32x4 w = *(const u32x4*)(gdn_urow(tl, v) + ch * 8);
            u32x2* d = (u32x2*)(OT + v * RS + ch * 8); u32x2 a, b; a.x = w.x; a.y = w.y; b.x = w.z; b.y = w.w; d[0] = a; d[1] = b;
        }
        __syncthreads();
        for (int q = 0; q < 8; ++q) {
            const int l = F.wave + 8 * q, t = t0 + l;
            if (t < 0 && seq >= 2) continue;
            const int row = seq < 2 ? seq * TPP + 64 * c + l : base + t;
            bf16_t* zrow = F.proj + (size_t)row * LDP + 4096 + head * 256 + F.lane;
            float o[4]; float ss = 0.f;
#pragma unroll
            for (int e = 0; e < 4; ++e) { o[e] = bf2f(OT[(64 * e + F.lane) * RS + l]); ss += o[e] * o[e]; }
            ss = wave_sum(ss);
            const float rs = rsqrtf(ss * (1.0f / 256.0f) + EPS);
#pragma unroll
            for (int e = 0; e < 4; ++e) { const float z = bf2f(zrow[64 * e]); const float r = o[e] * rs * silu_f(z); if (!DRY) zrow[64 * e] = f2bf(r); else KEEP(r); }
        }
    }
    for (int e = F.bid * NTHREADS + F.tid; e < NSEQ * 3 * GDN_CONV; e += F.G * NTHREADS) {
        const int s = e / (3 * GDN_CONV), r = (e / GDN_CONV) % 3, c = e % GDN_CONV;
        if (s < 2) F.out[O_PGDNC + (((size_t)j * 2 + s) * 3 + r) * GDN_CONV + c] = bf2f(F.tails[((size_t)(s * 129 + 128) * 3 + r) * 4096 + c]);
        else F.out[O_SGDNC + (((size_t)j * 8 + (s - 2)) * 3 + r) * GDN_CONV + c] = bf2f(F.proj[(size_t)(seq_base(s) + 13 + r) * LDP + c]);
    }
}

__device__ void phase_final(const Frame& F0) {
    const Frame F = relaunder(F0);
    const float* fw = F.inp(23);
    for (int it = F.bid * 8 + F.wave; it < 2 * SEQ + 128; it += F.G * 8) {
        int row; float* dst;
        if (it < 2 * SEQ) { const int b = it / SEQ, t = it % SEQ; row = b * TPP + 64 + t; dst = F.out + O_YP + (size_t)it * D; }
        else { row = ROW_S0 + (it - 2 * SEQ); dst = F.out + O_YS + (size_t)(it - 2 * SEQ) * D; }
        float x[16]; float ss = 0.f;
#pragma unroll
        for (int i = 0; i < 4; ++i) {
            const u32x2 v = *(const u32x2*)(F.hb + (size_t)row * D + (F.lane + 64 * i) * 4);
            x[4 * i + 0] = __uint_as_float(v.x << 16); x[4 * i + 1] = __uint_as_float(v.x & 0xffff0000u); x[4 * i + 2] = __uint_as_float(v.y << 16); x[4 * i + 3] = __uint_as_float(v.y & 0xffff0000u);
            ss += (x[4 * i] * x[4 * i] + x[4 * i + 1] * x[4 * i + 1]) + (x[4 * i + 2] * x[4 * i + 2] + x[4 * i + 3] * x[4 * i + 3]);
        }
        ss = wave_sum(ss);
        const float rs = rsqrtf(ss * (1.0f / 1024.0f) + EPS);
#pragma unroll
        for (int i = 0; i < 4; ++i) {
            const int c = (F.lane + 64 * i) * 4; const f32x4 w = *(const f32x4*)(fw + c);
            f32x4 o; o[0] = x[4 * i] * rs * w[0]; o[1] = x[4 * i + 1] * rs * w[1]; o[2] = x[4 * i + 2] * rs * w[2]; o[3] = x[4 * i + 3] * rs * w[3];
            *(f32x4*)(dst + c) = o;
        }
    }
}

constexpr int N_PHASES = 22;
__global__ void __launch_bounds__(NTHREADS, 2) hybrid_fwd(Args args) {
    extern __shared__ __attribute__((aligned(16))) unsigned char lds[];
    volatile LAS unsigned* bst = (volatile LAS unsigned*)((LAS unsigned char*)lds + LDS_BYTES - 16);
    if (threadIdx.x < 4) bst[threadIdx.x] = 0u;
    __syncthreads();
    XcdBarrier bar; bar.bar = (unsigned*)(args.ws + WS_CTL); bar.x = 0; bar.st = bst;
    if (args.ph_hi - args.ph_lo > 1) bar = xcd_barrier_post((unsigned*)(args.ws + WS_CTL), bst);
    for (int ph = args.ph_lo; ph < args.ph_hi; ++ph) {
        int tid_ = threadIdx.x; asm volatile("" : "+v"(tid_));
        Frame F;
        F.ap = &args;
        F.out = args.out; F.ws = args.ws; F.lds = lds; F.ldsl = (LAS unsigned char*)lds;
        F.tid = tid_; F.lane = F.tid & 63; F.wave = __builtin_amdgcn_readfirstlane(F.tid >> 6); F.G = gridDim.x; F.bid = blockIdx.x;
        F.hb = nullptr; F.win = nullptr; F.wout = nullptr; F.dtb = nullptr; F.rss = nullptr; F.proj = nullptr; F.tails = nullptr;
        if (ph == 0) { phase_init_h(F); phase_wprep_in(F, 0); }
        else if (ph == N_PHASES - 1) { for (int r = 0; r < REP_FINAL; ++r) phase_final(F); }
        else {
            const int L = (ph - 1) / 5, sub = (ph - 1) % 5, j = L >> 1;
            if (sub == 0) { for (int r = 0; r < REP_INPROJ; ++r) phase_inproj(F, L); }
            else if (sub == 1) {
                if (L & 1) { for (int r = 1; r < REP_GDN_PREP; ++r) phase_gdn_prep<true>(F, j); phase_gdn_prep<false>(F, j); }
                else { for (int r = 1; r < REP_SSD_PREP; ++r) phase_ssd_prep<true>(F, j); phase_ssd_prep<false>(F, j); }
                for (int r = 0; r < REP_WPREP; ++r) phase_wprep_out(F, L); }
            else if (sub == 2) {
                if (L & 1) { for (int r = 1; r < REP_GDN_CHAIN; ++r) phase_gdn_chain<true>(F, j); phase_gdn_chain<false>(F, j); }
                else { for (int r = 1; r < REP_SSD_CHAIN; ++r) phase_ssd_chain<true>(F, j); phase_ssd_chain<false>(F, j); } }
            else if (sub == 3) {
                if (L & 1) { for (int r = 1; r < REP_GDN_POST; ++r) phase_gdn_post2<true>(F, j); phase_gdn_post2<false>(F, j); }
                else { for (int r = 1; r < REP_SSD_POST; ++r) phase_ssd_post<true>(F, j); phase_ssd_post<false>(F, j); }
                if (L < 3) { for (int r = 0; r < REP_WPREP; ++r) phase_wprep_in(F, L + 1); } }
            else { for (int r = 1; r < REP_OUTPROJ; ++r) phase_outproj(F, L, true); phase_outproj(F, L, false); }
        }
        if (ph + 1 < args.ph_hi) {
            if (ph == args.ph_lo) { __threadfence(); cg::this_grid().sync(); }
            else { for (int r = 0; r < REP_BARRIER; ++r) xcd_barrier(bar); }
        }
    }
}

extern "C" void kernel_launch(void* const* d_in, const int* in_sizes, int n_in, void* d_out, int out_size, void* d_ws, size_t ws_size, hipStream_t stream) {
    static int grid = 0;
    if (grid == 0) {
        if (n_in != 24 || ws_size < WS_END) { fprintf(stderr, "kernel_launch: unexpected n_in %d / ws %zu (need %zu)\n", n_in, ws_size, (size_t)WS_END); grid = -1; return; }
        int dev = 0, cus = 0, per_cu = 0;
        if (hipGetDevice(&dev) != hipSuccess || hipDeviceGetAttribute(&cus, hipDeviceAttributeMultiprocessorCount, dev) != hipSuccess) { grid = -1; return; }
        if (hipFuncSetAttribute((const void*)hybrid_fwd, hipFuncAttributeMaxDynamicSharedMemorySize, LDS_BYTES) != hipSuccess) { fprintf(stderr, "kernel_launch: hipFuncSetAttribute failed\n"); grid = -1; return; }
        if (hipOccupancyMaxActiveBlocksPerMultiprocessor(&per_cu, (const void*)hybrid_fwd, NTHREADS, LDS_BYTES) != hipSuccess || per_cu < 1) { fprintf(stderr, "kernel_launch: occupancy query says %d blocks per CU\n", per_cu); grid = -1; return; }
        (void)hipGetLastError();
        grid = cus;
    }
    if (grid < 0) return;
    Args a{};
    for (int i = 0; i < 24; ++i) a.in[i] = (const float*)d_in[i];
    a.out = (float*)d_out; a.ws = (unsigned char*)d_ws;
#if MK_ONE_LAUNCH
    (void)hipMemsetAsync((char*)d_ws + WS_CTL, 0, 16384, stream);
    a.ph_lo = 0; a.ph_hi = N_PHASES;
    void* kargs[] = {&a};
    hipError_t e = hipLaunchCooperativeKernel((const void*)hybrid_fwd, dim3(grid), dim3(NTHREADS), kargs, LDS_BYTES, stream);
    if (e != hipSuccess) fprintf(stderr, "kernel_launch: cooperative launch failed: %s (grid %d)\n", hipGetErrorString(e), grid);
#else
    for (int ph = 0; ph < N_PHASES; ++ph) {
        a.ph_lo = ph; a.ph_hi = ph + 1;
        hipLaunchKernelGGL(hybrid_fwd, dim3(grid), dim3(NTHREADS), LDS_BYTES, stream, a);
    }
#endif
}
```

```cpp
#include <hip/hip_runtime.h>
#include <hip/hip_cooperative_groups.h>
#include <cstdio>
#include <cstdint>
namespace cg = cooperative_groups;

#define LAS __attribute__((address_space(3)))
typedef unsigned short bf16_t;
typedef short bf16x8 __attribute__((ext_vector_type(8)));
typedef float f32x4 __attribute__((ext_vector_type(4)));
typedef unsigned u32x4 __attribute__((ext_vector_type(4)));
typedef unsigned u32x2 __attribute__((ext_vector_type(2)));

constexpr int D = 1024;
constexpr int SEQ = 8192, NMETA = 16, PADF = 48;
constexpr int TPP = 8256;
constexpr int ROW_S0 = 2 * TPP;
constexpr int M_TOT = ROW_S0 + 128;
constexpr int NSEQ = 10;
constexpr float EPS = 1e-6f;
constexpr int LDP = 6144;
constexpr int SSD_INNER = 2048, SSD_HEADS = 32, SSD_P = 64, SSD_N = 128, SSD_CONV = 3072, SSD_IN = 5152, SSD_IN_PAD = 5376;
constexpr int GDN_HEADS = 8, GDN_DK = 128, GDN_DV = 256, GDN_CONV = 4096, GDN_VAL = 2048, GDN_IN = 6160, GDN_IN_PAD = 6400;

constexpr size_t O_YP = 0, O_YS = 16777216, O_PSSD = 16908288, O_PSSDC = 17956864, O_PGDN = 17993728, O_PGDNC = 19042304,
                 O_SSSD = 19091456, O_SSSDC = 23285760, O_SGDN = 23433216, O_SGDNC = 27627520;

constexpr size_t WS_CTL = 0;
constexpr size_t WS_HB = 65536;
constexpr size_t WS_WIN = WS_HB + (size_t)M_TOT * D * 2;
constexpr size_t WS_WOUT = WS_WIN + (size_t)GDN_IN_PAD * D * 2;
constexpr size_t WS_TAIL = WS_WOUT + (size_t)1024 * 2048 * 2;
constexpr size_t WS_DTB = WS_TAIL + (size_t)258 * 3 * 4096 * 2;
constexpr size_t WS_RSS = WS_DTB + (size_t)M_TOT * 32 * 4;
constexpr size_t WS_PROJ = WS_RSS + (size_t)M_TOT * 16 * 4;
constexpr size_t WS_END = WS_PROJ + (size_t)M_TOT * LDP * 2;

constexpr int NTHREADS = 512;
constexpr int LDS_BYTES = 147456;

#define KEEP(x) asm volatile("" :: "v"(x))
#ifndef REP_INPROJ
#define REP_INPROJ 1
#endif
#ifndef REP_SSD_PREP
#define REP_SSD_PREP 1
#endif
#ifndef REP_SSD_CHAIN
#define REP_SSD_CHAIN 1
#endif
#ifndef REP_GDN_PREP
#define REP_GDN_PREP 1
#endif
#ifndef REP_GDN_CHAIN
#define REP_GDN_CHAIN 1
#endif
#ifndef REP_WPREP
#define REP_WPREP 1
#endif
#ifndef REP_OUTPROJ
#define REP_OUTPROJ 1
#endif
#ifndef REP_SSD_POST
#define REP_SSD_POST 1
#endif
#ifndef REP_GDN_POST
#define REP_GDN_POST 1
#endif
#ifndef REP_SUBST
#define REP_SUBST 1
#endif
#ifndef REP_BARRIER
#define REP_BARRIER 1
#endif
#ifndef REP_FINAL
#define REP_FINAL 1
#endif
#ifndef MK_ONE_LAUNCH
#define MK_ONE_LAUNCH 1
#endif
__device__ __forceinline__ float bf2f(bf16_t b) { return __uint_as_float(((unsigned)b) << 16); }
__device__ __forceinline__ bf16_t f2bf(float f) { unsigned u = __float_as_uint(f); u += 0x7FFFu + ((u >> 16) & 1u); return (bf16_t)(u >> 16); }
typedef __bf16 bf16v2_t __attribute__((ext_vector_type(2)));
typedef float f32x2_t __attribute__((ext_vector_type(2)));
__device__ __forceinline__ unsigned cvt_pk_bf16(float lo, float hi) { const bf16v2_t r = __builtin_convertvector((f32x2_t){lo, hi}, bf16v2_t); return __builtin_bit_cast(unsigned, r); }
__device__ __forceinline__ float silu_f(float x) { return x / (1.0f + __expf(-x)); }
__device__ __forceinline__ float softplus_f(float x) { return x > 20.f ? x : log1pf(__expf(x)); }
__device__ __forceinline__ float wave_sum(float v) {
#pragma unroll
    for (int o = 32; o >= 1; o >>= 1) v += __shfl_xor(v, o);
    return v;
}
__device__ __forceinline__ int seq_base(int s) { return s < 2 ? s * TPP + 64 - NMETA : ROW_S0 + 16 * (s - 2); }
__device__ __forceinline__ int seq_len(int s) { return s < 2 ? SEQ + NMETA : 16; }
__device__ __forceinline__ int seq_chunks(int s) { return s < 2 ? 129 : 1; }

namespace pg8 {
constexpr int BM = 256, BK = 64, HALF = 128, HTB = HALF * BK * 2, STAGE_BYTES = 8 * HTB, NXCD = 8, WGM = 8;
__device__ __forceinline__ int lds_byte(int r, int c) { const int st = (r >> 4) * 2 + (c >> 5), rr = r & 15, cc = c & 31, ob = rr * 64 + cc * 2; return st * 1024 + (ob ^ (((ob >> 9) & 1) << 5)); }
__device__ __forceinline__ void stage_rc(int b, int& R, int& C) { const int st = b / 1024, sb = b % 1024, swz = sb ^ (((sb >> 9) & 1) << 5); R = (st >> 1) * 16 + swz / 64; C = (st & 1) * 32 + (swz % 64) / 2; }
__device__ __forceinline__ int perm32(int rho) { const int n = rho >> 4, i = rho & 15; return 8 * (i >> 2) + 4 * n + (i & 3); }
struct Unit { int pm, pn; };
struct Gemm { const bf16_t* A; const bf16_t* Bt; int M, N, K, lda, ldb; };
struct StaticOrder {
    int nM, nN, nwg, G, c;
    __device__ void init(int M, int N, int G_, int c_) { nM = M / BM; nN = N / BM; nwg = nM * nN; G = G_; c = c_; }
    __device__ bool next(int i, Unit& u) const {
        const long L = (long)i * G + c; if (L >= nwg) return false;
        int wgid = (int)L; { const int q = nwg / NXCD, r = nwg % NXCD, xcd = wgid % NXCD, off = wgid / NXCD; wgid = (xcd < r ? xcd * (q + 1) : r * (q + 1) + (xcd - r) * q) + off; }
        const int nig = WGM * nN, gid = wgid / nig, fm = gid * WGM, gsz = (nM - fm) < WGM ? (nM - fm) : WGM;
        u.pm = fm + ((wgid % nig) % gsz); u.pn = (wgid % nig) / gsz; return true;
    }
};

template <class Epi>
__device__ __forceinline__ void gemm_phase(LAS unsigned char* lds, const Gemm g, const StaticOrder& S, const Epi& E, const int tid) {
    const int wid = __builtin_amdgcn_readfirstlane(tid >> 6), lane = tid & 63, wr = wid >> 2, wc = wid & 3, fr = lane & 15, fq = lane >> 4;
    const int K = g.K, nt = K / BK;
    unsigned voffA[2], voffB[2];
#pragma unroll
    for (int i = 0; i < 2; ++i) { int R, C; stage_rc(tid * 16 + i * 8192, R, C); const int Rb = Epi::PERM ? ((R & ~31) + perm32(R & 31)) : R;
        voffA[i] = (unsigned)(R * g.lda + C) * 2u; voffB[i] = (unsigned)(Rb * g.ldb + C) * 2u; }
    const size_t kstep = (size_t)(BK * 2);
    const size_t hstepA = (size_t)HALF * g.lda * 2, hstepB = (size_t)HALF * g.ldb * 2;
    const size_t tstepA = 2 * hstepA, tstepB = 2 * hstepB;
    const unsigned ldsw = (unsigned)wid * 1024u;
    const int aoff = lds_byte(wr * 64 + fr, fq * 8), boff = lds_byte(wc * 32 + fr, fq * 8);
#define PG8_SA(b, h) (((b) * 2 + (h)) * HTB)
#define PG8_SB(b, h) ((4 + (b) * 2 + (h)) * HTB)
#define PG8_STAGE(bufoff, gbase, voff) do { _Pragma("unroll") for (int _i = 0; _i < 2; ++_i) \
        __builtin_amdgcn_global_load_lds((const unsigned*)((const char*)(gbase) + (voff)[_i]), (LAS unsigned*)(lds + (bufoff) + ldsw + _i * 8192), 16, 0, 0); } while (0)
#define PG8_LDA(dst, b, h) do { _Pragma("unroll") for (int m = 0; m < 4; ++m) _Pragma("unroll") for (int k = 0; k < 2; ++k) dst[m][k] = *(const LAS bf16x8*)(lds + PG8_SA(b, h) + aoff + m * 2048 + k * 1024); } while (0)
#define PG8_LDB(dst, b, h) do { _Pragma("unroll") for (int n = 0; n < 2; ++n) _Pragma("unroll") for (int k = 0; k < 2; ++k) dst[n][k] = *(const LAS bf16x8*)(lds + PG8_SB(b, h) + boff + n * 2048 + k * 1024); } while (0)
#define PG8_MMA(ai, bj, At, Bt) do { __builtin_amdgcn_s_setprio(1); _Pragma("unroll") for (int m = 0; m < 4; ++m) _Pragma("unroll") for (int n = 0; n < 2; ++n) _Pragma("unroll") for (int k = 0; k < 2; ++k) \
        acc[ai][bj][m][n] = __builtin_amdgcn_mfma_f32_16x16x32_bf16(Bt[n][k], At[m][k], acc[ai][bj][m][n], 0, 0, 0); __builtin_amdgcn_s_setprio(0); } while (0)
#define PG8_WAIT_V(n) asm volatile("s_waitcnt vmcnt(" #n ")" ::: "memory")
#define PG8_WAIT_L(n) asm volatile("s_waitcnt lgkmcnt(" #n ")" ::: "memory")
#define PG8_BAR __builtin_amdgcn_s_barrier()
#define PG8_SCHED __builtin_amdgcn_sched_barrier(0)
    Unit cur, nxt; int ui = 0;
    if (!S.next(0, cur)) return;
    f32x4 acc[2][2][4][2];
#pragma unroll
    for (int a = 0; a < 2; ++a)
#pragma unroll
        for (int b = 0; b < 2; ++b)
#pragma unroll
            for (int m = 0; m < 4; ++m)
#pragma unroll
                for (int n = 0; n < 2; ++n) acc[a][b][m][n] = (f32x4){0.f, 0.f, 0.f, 0.f};
    bf16x8 At[4][2], B0[2][2], B1[2][2];
    const char* cA = (const char*)g.A + (size_t)cur.pm * tstepA; const char* cB = (const char*)g.Bt + (size_t)cur.pn * tstepB;
    PG8_STAGE(PG8_SB(0, 0), cB, voffB); PG8_STAGE(PG8_SA(0, 0), cA, voffA); PG8_STAGE(PG8_SB(0, 1), cB + hstepB, voffB); PG8_STAGE(PG8_SA(0, 1), cA + hstepA, voffA);
    if (wr == 1) PG8_BAR;
    PG8_WAIT_V(4); PG8_BAR;
    PG8_STAGE(PG8_SB(1, 0), cB + kstep, voffB); PG8_STAGE(PG8_SA(1, 0), cA + kstep, voffA); PG8_STAGE(PG8_SB(1, 1), cB + hstepB + kstep, voffB);
    PG8_WAIT_V(6); PG8_BAR;
    for (;;) {
        const bool has_next = S.next(ui + 1, nxt);
        const char* nA = has_next ? (const char*)g.A + (size_t)nxt.pm * tstepA : cA; const char* nB = has_next ? (const char*)g.Bt + (size_t)nxt.pn * tstepB : cB;
        for (int t = 0; t < nt; t += 2) {
            const bool last = (t == nt - 2);
            const char* a1 = cA + (size_t)(t + 1) * kstep;
            const char* a2 = last ? nA : cA + (size_t)(t + 2) * kstep; const char* b2 = last ? nB : cB + (size_t)(t + 2) * kstep;
            const char* a3 = a2 + kstep; const char* b3 = b2 + kstep;
            PG8_LDB(B0, 0, 0); PG8_SCHED; PG8_LDA(At, 0, 0); PG8_STAGE(PG8_SA(1, 1), a1 + hstepA, voffA);
            PG8_WAIT_L(8); PG8_BAR; PG8_WAIT_L(0); PG8_MMA(0, 0, At, B0); PG8_BAR; PG8_SCHED;
            PG8_LDB(B1, 0, 1); PG8_STAGE(PG8_SB(0, 0), b2, voffB);
            PG8_BAR; PG8_WAIT_L(0); PG8_MMA(0, 1, At, B1); PG8_BAR;
            PG8_LDA(At, 0, 1); PG8_STAGE(PG8_SA(0, 0), a2, voffA);
            PG8_BAR; PG8_WAIT_L(0); PG8_MMA(1, 0, At, B0); PG8_BAR; PG8_SCHED;
            PG8_STAGE(PG8_SB(0, 1), b2 + hstepB, voffB);
            PG8_WAIT_V(6); PG8_BAR; PG8_MMA(1, 1, At, B1); PG8_BAR;
            PG8_LDB(B0, 1, 0); PG8_SCHED; PG8_LDA(At, 1, 0); PG8_STAGE(PG8_SA(0, 1), a2 + hstepA, voffA);
            PG8_WAIT_L(8); PG8_BAR; PG8_WAIT_L(0); PG8_MMA(0, 0, At, B0); PG8_BAR; PG8_SCHED;
            PG8_LDB(B1, 1, 1); PG8_STAGE(PG8_SB(1, 0), b3, voffB);
            PG8_BAR; PG8_WAIT_L(0); PG8_MMA(0, 1, At, B1); PG8_BAR;
            PG8_LDA(At, 1, 1); PG8_STAGE(PG8_SA(1, 0), a3, voffA);
            PG8_BAR; PG8_WAIT_L(0); PG8_MMA(1, 0, At, B0); PG8_BAR; PG8_SCHED;
            PG8_STAGE(PG8_SB(1, 1), b3 + hstepB, voffB);
            PG8_WAIT_V(6); PG8_BAR; PG8_MMA(1, 1, At, B1); PG8_BAR;
        }
        E(acc, cur, wr, wc, fr, fq);
        if (!has_next) break;
#pragma unroll
        for (int a = 0; a < 2; ++a)
#pragma unroll
            for (int b = 0; b < 2; ++b)
#pragma unroll
                for (int m = 0; m < 4; ++m)
#pragma unroll
                    for (int n = 0; n < 2; ++n) acc[a][b][m][n] = (f32x4){0.f, 0.f, 0.f, 0.f};
        cur = nxt; cA = nA; cB = nB; ++ui;
    }
    PG8_WAIT_V(0);
    if (wr == 0) PG8_BAR;
    PG8_BAR;
#undef PG8_SA
#undef PG8_SB
#undef PG8_STAGE
#undef PG8_LDA
#undef PG8_LDB
#undef PG8_MMA
#undef PG8_WAIT_V
#undef PG8_WAIT_L
#undef PG8_BAR
#undef PG8_SCHED
}

struct EpiInProj {
    static constexpr bool PERM = true;
    bf16_t* proj; float* dtb; const float* rowss; int nt_main; bf16_t* tails; int tl_lo, tl_hi;
    __device__ __forceinline__ void operator()(const f32x4 (&acc)[2][2][4][2], const Unit& u, int wr, int wc, int fr, int fq) const {
        const int row0 = u.pm * BM + wr * 64 + fr;
#pragma unroll
        for (int ai = 0; ai < 2; ++ai)
#pragma unroll
            for (int m = 0; m < 4; ++m) {
                const int r = row0 + ai * HALF + m * 16;
                const f32x4* rp = (const f32x4*)(rowss + (size_t)r * 16);
                const f32x4 p0 = rp[0], p1 = rp[1], p2 = rp[2], p3 = rp[3];
                const float ss = ((p0[0] + p0[1]) + (p0[2] + p0[3])) + ((p1[0] + p1[1]) + (p1[2] + p1[3])) + ((p2[0] + p2[1]) + (p2[2] + p2[3])) + ((p3[0] + p3[1]) + (p3[2] + p3[3]));
                const float rstd = rsqrtf(ss * (1.0f / 1024.0f) + EPS);
                if (u.pn < nt_main) {
                    bf16_t* rowp = proj + (size_t)r * LDP + u.pn * BM + wc * 32 + 8 * fq;
#pragma unroll
                    for (int bj = 0; bj < 2; ++bj) { const f32x4 v0 = acc[ai][bj][m][0] * rstd, v1 = acc[ai][bj][m][1] * rstd;
                        u32x4 w; w.x = cvt_pk_bf16(v0[0], v0[1]); w.y = cvt_pk_bf16(v0[2], v0[3]); w.z = cvt_pk_bf16(v1[0], v1[1]); w.w = cvt_pk_bf16(v1[2], v1[3]);
                        *(u32x4*)(rowp + bj * HALF) = w;
                        if (u.pn >= tl_lo && u.pn < tl_hi && r < ROW_S0 && (r & 63) >= 61) *(u32x4*)(tails + ((size_t)(r >> 6) * 3 + ((r & 63) - 61)) * 4096 + (u.pn - tl_lo) * BM + wc * 32 + 8 * fq + bj * HALF) = w; }
                } else if (wc == 0) {
                    float* dp = dtb + (size_t)r * 32 + 8 * fq;
                    *(f32x4*)(dp) = acc[ai][0][m][0] * rstd; *(f32x4*)(dp + 4) = acc[ai][0][m][1] * rstd;
                }
            }
    }
};
struct EpiOutProj {
    static constexpr bool PERM = false;
    bf16_t* hb; float* rowss; bool dry;
    __device__ __forceinline__ void operator()(const f32x4 (&acc)[2][2][4][2], const Unit& u, int wr, int wc, int fr, int fq) const {
        const int row0 = u.pm * BM + wr * 64 + fr, col0 = u.pn * BM + wc * 32 + 4 * fq;
#pragma unroll
        for (int ai = 0; ai < 2; ++ai)
#pragma unroll
            for (int m = 0; m < 4; ++m) {
                const int r = row0 + ai * HALF + m * 16; float ss = 0.f;
                bf16_t* rowp = hb + (size_t)r * D + col0;
#pragma unroll
                for (int bj = 0; bj < 2; ++bj)
#pragma unroll
                    for (int n = 0; n < 2; ++n) {
                        u32x2* p = (u32x2*)(rowp + bj * HALF + n * 16); const u32x2 o = *p;
                        const f32x4 a = acc[ai][bj][m][n];
                        const float h0 = __uint_as_float(o.x << 16) + a[0], h1 = __uint_as_float(o.x & 0xffff0000u) + a[1];
                        const float h2 = __uint_as_float(o.y << 16) + a[2], h3 = __uint_as_float(o.y & 0xffff0000u) + a[3];
                        ss += (h0 * h0 + h1 * h1) + (h2 * h2 + h3 * h3);
                        u32x2 w; w.x = cvt_pk_bf16(h0, h1); w.y = cvt_pk_bf16(h2, h3); if (!dry) *p = w; else KEEP(w);
                    }
                ss += __shfl_xor(ss, 16); ss += __shfl_xor(ss, 32);
                if (fq == 0) { if (!dry) rowss[(size_t)r * 16 + u.pn * 4 + wc] = ss; else KEEP(ss); }
            }
    }
};
}

#define XB_TMO      128
#define XB_XCNT(j)  (256  + 64 * (j))
#define XB_XSUB(j)  (1280 + 64 * (j))
#define XB_XGEN(j)  (2304 + 64 * (j))
#define XB_TOP      3328
#define XB_TOPGEN   3392
#define XCD_BAR_WORDS 3456
#define XB_SPIN_CAP (1u << 24)
__device__ __forceinline__ unsigned xb_ld(unsigned* p)              { return __hip_atomic_load(p, __ATOMIC_RELAXED, __HIP_MEMORY_SCOPE_AGENT); }
__device__ __forceinline__ unsigned xb_add(unsigned* p, unsigned v) { return __hip_atomic_fetch_add(p, v, __ATOMIC_RELAXED, __HIP_MEMORY_SCOPE_AGENT); }
__device__ __forceinline__ unsigned xb_xcc_id() { return (unsigned)__builtin_amdgcn_s_getreg((3 << 11) | 20) & 0xFu; }
#define XB_SPIN(cond, bar) do { unsigned _sp = 0; while (cond) { __builtin_amdgcn_s_sleep(1); \
    if ((++_sp & 255u) == 0u) { if (xb_ld(&(bar)[XB_TMO])) break; if (_sp > XB_SPIN_CAP) { atomicAdd(&(bar)[XB_TMO], 1u); break; } } } } while (0)
struct XcdBarrier { unsigned* bar; unsigned x; volatile LAS unsigned* st; };
__device__ __forceinline__ XcdBarrier xcd_barrier_post(unsigned* bar, volatile LAS unsigned* st) {
    XcdBarrier b; b.bar = bar; b.x = xb_xcc_id(); b.st = st;
    if (threadIdx.x == 0) (void)xb_add(&bar[XB_XCNT(b.x)], 1u);
    return b;
}
__device__ __forceinline__ void xcd_barrier_complete(unsigned* bar, unsigned x, unsigned& nloc, unsigned& nx) {
    const unsigned G = gridDim.x * gridDim.y * gridDim.z;
    unsigned sum, cnt, mine, sp = 0u;
    for (;;) {
        sum = 0u; cnt = 0u; mine = 0u;
#pragma unroll
        for (unsigned j = 0; j < 16; ++j) { const unsigned c = xb_ld(&bar[XB_XCNT(j)]); sum += c; cnt += (c > 0u) ? 1u : 0u; mine = (j == x) ? c : mine; }
        if (sum == G) break;
        __builtin_amdgcn_s_sleep(1);
        if ((++sp & 255u) == 0u) { if (xb_ld(&bar[XB_TMO])) break; if (sp > XB_SPIN_CAP) { atomicAdd(&bar[XB_TMO], 1u); break; } }
    }
    nloc = mine > 0u ? mine : 1u; nx = cnt > 0u ? cnt : 1u;
}
__device__ __forceinline__ void xcd_barrier(const XcdBarrier& b) {
    asm volatile("s_waitcnt vmcnt(0)" ::: "memory");
    __syncthreads();
    if (threadIdx.x == 0) {
        unsigned* bar = b.bar;
        __builtin_amdgcn_s_waitcnt(0);
        unsigned nloc = b.st[0], nx = b.st[1];
        if (nloc == 0u) { xcd_barrier_complete(bar, b.x, nloc, nx); b.st[0] = nloc; b.st[1] = nx; }
        const unsigned old = xb_add(&bar[XB_XSUB(b.x)], 1u);
        const unsigned gen = old / nloc;
        if (old + 1u == (gen + 1u) * nloc) {
            __builtin_amdgcn_fence(__ATOMIC_RELEASE, "agent");
            asm volatile("s_waitcnt vmcnt(0)" ::: "memory");
            const unsigned og = xb_add(&bar[XB_TOP], 1u);
            const unsigned tg = og / nx;
            if (og + 1u == (tg + 1u) * nx) xb_add(&bar[XB_TOPGEN], 1u);
            else XB_SPIN(xb_ld(&bar[XB_TOPGEN]) == tg, bar);
            __builtin_amdgcn_fence(__ATOMIC_ACQUIRE, "agent");
            xb_add(&bar[XB_XGEN(b.x)], 1u);
            asm volatile("s_waitcnt vmcnt(0)" ::: "memory");
        } else {
            XB_SPIN(xb_ld(&bar[XB_XGEN(b.x)]) == gen, bar);
            __builtin_amdgcn_fence(__ATOMIC_ACQUIRE, "agent");
            asm volatile("s_waitcnt vmcnt(0)" ::: "memory");
        }
    }
    __syncthreads();
}

struct Args { const float* in[24]; float* out; unsigned char* ws; int ph_lo, ph_hi; };

struct Frame {
    const Args* ap; float* out; unsigned char* ws;
    __device__ __forceinline__ const float* inp(int i) const { asm volatile("" : "+s"(i)); return ap->in[i]; }
    unsigned char* lds; LAS unsigned char* ldsl;
    int tid, lane, wave, G, bid;
    bf16_t* hb; bf16_t* win; bf16_t* wout; float* dtb; float* rss; bf16_t* proj; bf16_t* tails;
};

__device__ __forceinline__ Frame relaunder(Frame F) {
    int t = F.tid; asm volatile("" : "+v"(t));
    F.tid = t; F.lane = t & 63; F.wave = __builtin_amdgcn_readfirstlane(t >> 6);
    unsigned char* w = F.ws; asm volatile("" : "+s"(w));
    F.ws = w; F.hb = (bf16_t*)(w + WS_HB); F.win = (bf16_t*)(w + WS_WIN); F.wout = (bf16_t*)(w + WS_WOUT);
    F.dtb = (float*)(w + WS_DTB); F.rss = (float*)(w + WS_RSS); F.proj = (bf16_t*)(w + WS_PROJ); F.tails = (bf16_t*)(w + WS_TAIL);
    return F;
}
__device__ void phase_init_h(const Frame& F0) {
    const Frame F = relaunder(F0);
    const float* xp = F.inp(0); const float* xs = F.inp(1); const float* meta = F.inp(6);
    for (int row = F.bid * 8 + F.wave; row < M_TOT; row += F.G * 8) {
        const float* src = nullptr;
        if (row < ROW_S0) { const int b = row / TPP, r = row % TPP; if (r >= 64) src = xp + ((size_t)b * SEQ + (r - 64)) * D; else if (r >= PADF) src = meta + (size_t)(r - PADF) * D; }
        else src = xs + (size_t)(row - ROW_S0) * D;
        float ss = 0.f;
#pragma unroll
        for (int i = 0; i < 4; ++i) {
            f32x4 v = (f32x4){0.f, 0.f, 0.f, 0.f};
            if (src) v = *(const f32x4*)(src + (F.lane + 64 * i) * 4);
            ss += (v[0] * v[0] + v[1] * v[1]) + (v[2] * v[2] + v[3] * v[3]);
            u32x2 w; w.x = cvt_pk_bf16(v[0], v[1]); w.y = cvt_pk_bf16(v[2], v[3]);
            *(u32x2*)(F.hb + (size_t)row * D + (F.lane + 64 * i) * 4) = w;
        }
        ss = wave_sum(ss);
        if (F.lane < 16) F.rss[(size_t)row * 16 + F.lane] = (F.lane == 0) ? ss : 0.f;
    }
}

__device__ void transpose_convert(const Frame& F, const float* src, int K, int N, int Npad, bf16_t* dst, const float* scale, int smod) {
    float* tile = (float*)F.lds;
    const int ntk = K / 64, ntn = Npad / 64, ntile = ntk * ntn;
    __syncthreads();
    for (int ti = F.bid; ti < ntile; ti += F.G) {
        const int kt = ti % ntk, nt_ = ti / ntk, k0 = kt * 64, n0 = nt_ * 64;
        const int kk = F.tid >> 4, n4 = (F.tid & 15) * 4;
#pragma unroll
        for (int h = 0; h < 2; ++h) {
            const int k = k0 + kk + 32 * h, n = n0 + n4;
            f32x4 v = (f32x4){0.f, 0.f, 0.f, 0.f};
            if (n < N) v = *(const f32x4*)(src + (size_t)k * N + n);
            const float s = scale[k % smod];
            float* tp = tile + (kk + 32 * h) * 65 + n4;
            tp[0] = v[0] * s; tp[1] = v[1] * s; tp[2] = v[2] * s; tp[3] = v[3] * s;
        }
        __syncthreads();
        const int nn = F.tid >> 3, kg = (F.tid & 7) * 8;
        float x[8];
#pragma unroll
        for (int j = 0; j < 8; ++j) x[j] = tile[(kg + j) * 65 + nn];
        u32x4 w; w.x = cvt_pk_bf16(x[0], x[1]); w.y = cvt_pk_bf16(x[2], x[3]); w.z = cvt_pk_bf16(x[4], x[5]); w.w = cvt_pk_bf16(x[6], x[7]);
        *(u32x4*)(dst + (size_t)(n0 + nn) * K + k0 + kg) = w;
        __syncthreads();
    }
}
__device__ void phase_wprep_in(const Frame& F0, int L) {
    const Frame F = relaunder(F0);
    const int j = L >> 1;
    if ((L & 1) == 0) transpose_convert(F, F.inp(8) + (size_t)j * D * SSD_IN, D, SSD_IN, SSD_IN_PAD, F.win, F.inp(7) + j * D, D);
    else transpose_convert(F, F.inp(17) + (size_t)j * D * GDN_IN, D, GDN_IN, GDN_IN_PAD, F.win, F.inp(16) + j * D, D);
}
__device__ void phase_wprep_out(const Frame& F0, int L) {
    const Frame F = relaunder(F0);
    const int j = L >> 1;
    if ((L & 1) == 0) transpose_convert(F, F.inp(15) + (size_t)j * SSD_INNER * D, SSD_INNER, D, D, F.wout, F.inp(14) + j * SSD_INNER, SSD_INNER);
    else transpose_convert(F, F.inp(22) + (size_t)j * GDN_VAL * D, GDN_VAL, D, D, F.wout, F.inp(21) + j * GDN_DV, GDN_DV);
}

__device__ void phase_inproj(const Frame& F0, int L) {
    const Frame F = relaunder(F0);
    const int npad = (L & 1) ? GDN_IN_PAD : SSD_IN_PAD;
    pg8::Gemm g{F.hb, F.win, M_TOT, npad, D, D, D};
    pg8::StaticOrder S; S.init(M_TOT, npad, F.G, F.bid);
    pg8::EpiInProj E{F.proj, F.dtb, F.rss, npad / 256 - 1, F.tails, (L & 1) ? 0 : 8, 16};
    pg8::gemm_phase<pg8::EpiInProj>(F.ldsl, g, S, E, F.tid);
}
__device__ void phase_outproj(const Frame& F0, int L, bool dry) {
    const Frame F = relaunder(F0);
    const bf16_t* A = F.proj + ((L & 1) ? 4096 : 0);
    pg8::Gemm g{A, F.wout, M_TOT, D, 2048, LDP, 2048};
    pg8::StaticOrder S; S.init(M_TOT, D, F.G, F.bid);
    pg8::EpiOutProj E{F.hb, F.rss, dry};
    pg8::gemm_phase<pg8::EpiOutProj>(F.ldsl, g, S, E, F.tid);
}

__device__ void phase_ssd_naive(const Frame& F0, int j) {
    const Frame F = relaunder(F0);
    float* xs = (float*)F.lds;
    float* Bs = xs + 64 * 64;
    float* Cs = Bs + 64 * 128;
    float* dts = Cs + 64 * 128;
    float* das = dts + 64;
    const float* conv_w = F.inp(9) + (size_t)j * 4 * SSD_CONV; const float* conv_b = F.inp(10) + (size_t)j * SSD_CONV;
    const int p = F.tid >> 3, nq = F.tid & 7;
    for (int task = F.bid; task < NSEQ * SSD_HEADS; task += F.G) {
        const int s = task / SSD_HEADS, head = task % SSD_HEADS, grp = head >> 3;
        const int base = seq_base(s), nch = seq_chunks(s);
        const float dt_bias = F.inp(11)[j * SSD_HEADS + head], a = -__expf(F.inp(12)[j * SSD_HEADS + head]), dsk = F.inp(13)[j * SSD_HEADS + head];
        float h[16];
        if (s < 2) {
#pragma unroll
            for (int n = 0; n < 16; ++n) h[n] = 0.f;
        } else {
            const float* st = F.inp(2) + ((((size_t)j * 8 + (s - 2)) * SSD_HEADS + head) * SSD_P + p) * SSD_N + nq * 16;
#pragma unroll
            for (int n = 0; n < 16; ++n) h[n] = st[n];
        }
        int cidx = -1;
        if (F.tid < 64) cidx = head * 64 + F.tid; else if (F.tid < 192) cidx = 2048 + grp * 128 + (F.tid - 64); else if (F.tid < 320) cidx = 2560 + grp * 128 + (F.tid - 192);
        float w0 = 0, w1 = 0, w2 = 0, w3 = 0, cb = 0;
        if (cidx >= 0) { w0 = conv_w[cidx]; w1 = conv_w[SSD_CONV + cidx]; w2 = conv_w[2 * SSD_CONV + cidx]; w3 = conv_w[3 * SSD_CONV + cidx]; cb = conv_b[cidx]; }
        const float* cst = (s >= 2) ? F.inp(3) + (((size_t)j * 8 + (s - 2)) * 3) * SSD_CONV : nullptr;
        for (int c = 0; c < nch; ++c) {
            const int t0 = 64 * c - PADF;
            __syncthreads();
            if (cidx >= 0) {
                float r3, r2, r1;
                {   float rv[3];
#pragma unroll
                    for (int q = 0; q < 3; ++q) { const int t = t0 - 3 + q; float v = 0.f;
                        if (t >= 0) v = bf2f(F.proj[(size_t)(base + t) * LDP + 2048 + cidx]); else if (t >= -3 && cst) v = cst[(3 + t) * SSD_CONV + cidx];
                        rv[q] = v; }
                    r3 = rv[0]; r2 = rv[1]; r1 = rv[2]; }
                for (int i = 0; i < 64; ++i) {
                    const int t = t0 + i; float v = 0.f;
                    if (t >= 0) v = bf2f(F.proj[(size_t)(base + t) * LDP + 2048 + cidx]); else if (t >= -3 && cst) v = cst[(3 + t) * SSD_CONV + cidx];
                    const float o = silu_f(cb + w0 * r3 + w1 * r2 + w2 * r1 + w3 * v);
                    r3 = r2; r2 = r1; r1 = v;
                    if (F.tid < 64) xs[i * 64 + F.tid] = o; else if (F.tid < 192) Bs[i * 128 + (F.tid - 64)] = o; else Cs[i * 128 + (F.tid - 192)] = o;
                }
            } else if (F.tid >= 448) {
                const int i = F.tid - 448, t = t0 + i;
                float dt = 0.f, da = 1.f;
                if (t >= 0) { dt = softplus_f(F.dtb[(size_t)(base + t) * 32 + head] + dt_bias); da = __expf(dt * a); }
                dts[i] = dt; das[i] = da;
            }
            __syncthreads();
            for (int i = 0; i < 64; ++i) {
                const int t = t0 + i;
                const float dt = dts[i], da = das[i], xv = xs[i * 64 + p], dx = dt * xv;
                const float* bp = Bs + i * 128 + nq * 16; const float* cp = Cs + i * 128 + nq * 16;
                float accv = 0.f;
#pragma unroll
                for (int n = 0; n < 16; ++n) { h[n] = h[n] * da + dx * bp[n]; accv += cp[n] * h[n]; }
                accv += __shfl_xor(accv, 1); accv += __shfl_xor(accv, 2); accv += __shfl_xor(accv, 4);
                if (nq == 0 && t >= 0) {
                    bf16_t* zp = F.proj + (size_t)(base + t) * LDP + head * 64 + p;
                    const float z = bf2f(*zp);
                    *zp = f2bf((accv + dsk * xv) * silu_f(z));
                }
            }
        }
        float* so = (s < 2) ? F.out + O_PSSD + ((((size_t)j * 2 + s) * SSD_HEADS + head) * SSD_P + p) * SSD_N + nq * 16
                            : F.out + O_SSSD + ((((size_t)j * 8 + (s - 2)) * SSD_HEADS + head) * SSD_P + p) * SSD_N + nq * 16;
#pragma unroll
        for (int n = 0; n < 16; ++n) so[n] = h[n];
    }
}


constexpr int NCHT = 266;
constexpr size_t SC_BT = 0;
constexpr size_t SC_C = SC_BT + (size_t)NCHT * 4 * 16384;
constexpr size_t SC_CB = SC_C + (size_t)NCHT * 4 * 16384;
constexpr size_t SC_VEC = SC_CB + (size_t)NCHT * 4 * 8192;
constexpr size_t SC_XS = SC_VEC + (size_t)NCHT * 32 * 1024;
constexpr size_t SC_SSD_END = SC_XS + (size_t)256 * 8192;
static_assert(SC_SSD_END <= (size_t)16777216 * 4, "scratch must fit the y_prompt region");
__device__ __forceinline__ int qperm(int s) { return (s & ~31) | (((s >> 2) & 3) << 3) | (((s >> 4) & 1) << 2) | (s & 3); }
__device__ __forceinline__ int qnat(int q) { return (q & ~31) | (((q >> 2) & 1) << 4) | (((q >> 3) & 3) << 2) | (q & 3); }
__device__ __forceinline__ bf16x8 pack8(f32x4 a, f32x4 b) {
    u32x4 w; w.x = cvt_pk_bf16(a[0], a[1]); w.y = cvt_pk_bf16(a[2], a[3]); w.z = cvt_pk_bf16(b[0], b[1]); w.w = cvt_pk_bf16(b[2], b[3]);
    return __builtin_bit_cast(bf16x8, w);
}
__device__ __forceinline__ void chunk_of(int cgi, int& seq, int& c) { if (cgi < 258) { seq = cgi / 129; c = cgi % 129; } else { seq = 2 + (cgi - 258); c = 0; } }
__device__ __forceinline__ int cgi_of(int seq, int c) { return seq < 2 ? seq * 129 + c : 258 + (seq - 2); }
struct XTile { bf16_t* p; int stride; };
__device__ __forceinline__ XTile ssd_xtile(const Frame& F, int seq, int c, int head) {
    XTile t;
    if (seq < 2) { t.p = F.proj + (size_t)(seq * TPP + 64 * c) * LDP + 2048 + head * 64; t.stride = LDP; }
    else { t.p = (bf16_t*)((unsigned char*)F.out + SC_XS) + (size_t)((seq - 2) * 32 + head) * 4096; t.stride = 64; }
    return t;
}

template <bool DRY>
__device__ void phase_ssd_prep(const Frame& F0, int j) {
    const Frame F = relaunder(F0);
    bf16_t* Bs = (bf16_t*)F.lds;
    bf16_t* Cs = Bs + 64 * 136;
    unsigned char* sc = (unsigned char*)F.out;
    const float* conv_w = F.inp(9) + (size_t)j * 4 * SSD_CONV; const float* conv_b = F.inp(10) + (size_t)j * SSD_CONV;
    const int i16 = F.lane & 15, g4 = F.lane >> 4;
    for (int task = F.bid; task < NCHT * 4; task += F.G) {
        const int cgi = task >> 2, grp = task & 3; int seq, c; chunk_of(cgi, seq, c);
        const int base = seq_base(seq), t0 = 64 * c - PADF;
        __syncthreads();
        {
            const int hl = F.tid >> 6, p = F.tid & 63, head = grp * 8 + hl, cidx = head * 64 + p;
            const float w0 = conv_w[cidx], w1 = conv_w[SSD_CONV + cidx], w2 = conv_w[2 * SSD_CONV + cidx], w3 = conv_w[3 * SSD_CONV + cidx], cb = conv_b[cidx];
            float r3 = 0.f, r2 = 0.f, r1 = 0.f;
            if (seq < 2 && c > 0) { const bf16_t* tp = F.tails + (size_t)(cgi - 1) * 3 * 4096 + cidx; r3 = bf2f(tp[0]); r2 = bf2f(tp[4096]); r1 = bf2f(tp[2 * 4096]); }
            else if (seq >= 2) { const float* cst = F.inp(3) + (((size_t)j * 8 + (seq - 2)) * 3) * SSD_CONV + cidx; r3 = cst[0]; r2 = cst[SSD_CONV]; r1 = cst[2 * SSD_CONV]; }
            const bf16_t* xcol = F.proj + 2048 + cidx;
            bf16_t* xrow = (bf16_t*)F.lds + F.tid * 72;
#pragma unroll 1
            for (int pg = 0; pg < 2; ++pg) {
                unsigned short raw[32];
#pragma unroll
                for (int e = 0; e < 32; ++e) { const int t = t0 + 32 * pg + e; raw[e] = xcol[(size_t)(base + (t > 0 ? t : 0)) * LDP]; }
#pragma unroll
                for (int e8 = 0; e8 < 4; ++e8) {
                    float o[8];
#pragma unroll
                    for (int h = 0; h < 8; ++h) {
                        const int t = t0 + 32 * pg + 8 * e8 + h;
                        const float v = (t >= 0) ? bf2f(raw[8 * e8 + h]) : 0.f;
                        o[h] = silu_f(cb + w0 * r3 + w1 * r2 + w2 * r1 + w3 * v);
                        if (t >= 0) { r3 = r2; r2 = r1; r1 = v; }
                    }
                    u32x4 w; w.x = cvt_pk_bf16(o[0], o[1]); w.y = cvt_pk_bf16(o[2], o[3]); w.z = cvt_pk_bf16(o[4], o[5]); w.w = cvt_pk_bf16(o[6], o[7]);
                    *(u32x4*)(xrow + 32 * pg + 8 * e8) = w;
                }
            }
            __syncthreads();
            const XTile xt = ssd_xtile(F, seq, c, head);
#pragma unroll
            for (int q = 0; q < 8; ++q) { const u32x4 w = *(const u32x4*)(xrow + 8 * q);
                if (!DRY) *(u32x4*)(xt.p + (size_t)p * xt.stride + 8 * q) = w; else KEEP(w); }
        }
        __syncthreads();
        {
            const int ch = F.tid & 255, half = F.tid >> 8, isC = ch >> 7, n = ch & 127;
            const int cidx = 2048 + isC * 512 + grp * 128 + n;
            const float w0 = conv_w[cidx], w1 = conv_w[SSD_CONV + cidx], w2 = conv_w[2 * SSD_CONV + cidx], w3 = conv_w[3 * SSD_CONV + cidx], cb = conv_b[cidx];
            const float* cst = (seq >= 2) ? F.inp(3) + (((size_t)j * 8 + (seq - 2)) * 3) * SSD_CONV : nullptr;
            bf16_t* dst = (isC ? Cs : Bs) + n;
            const bf16_t* col = F.proj + 2048 + cidx;
            unsigned short raw[35];
#pragma unroll
            for (int e = 0; e < 35; ++e) { const int t = t0 + half * 32 - 3 + e; raw[e] = col[(size_t)(base + (t > 0 ? t : 0)) * LDP]; }
            float r3, r2, r1;
            {   float rv[3];
#pragma unroll
                for (int q = 0; q < 3; ++q) { const int t = t0 + half * 32 - 3 + q; float v = 0.f;
                    if (t >= 0) v = bf2f(raw[q]); else if (t >= -3 && cst) v = cst[(3 + t) * SSD_CONV + cidx];
                    rv[q] = v; }
                r3 = rv[0]; r2 = rv[1]; r1 = rv[2]; }
#pragma unroll
            for (int ii = 0; ii < 32; ++ii) {
                const int p = half * 32 + ii, t = t0 + p; float v = 0.f;
                if (t >= 0) v = bf2f(raw[ii + 3]); else if (t >= -3 && cst) v = cst[(3 + t) * SSD_CONV + cidx];
                const float o = silu_f(cb + w0 * r3 + w1 * r2 + w2 * r1 + w3 * v);
                r3 = r2; r2 = r1; r1 = v;
                dst[p * 136] = f2bf(o);
            }
        }
        __syncthreads();
        {
            bf16_t* BT = (bf16_t*)(sc + SC_BT) + (size_t)(cgi * 4 + grp) * 8192;
            const int n = F.tid >> 2, qg = (F.tid & 3) * 16;
#pragma unroll
            for (int u = 0; u < 2; ++u) {
                const int q0 = qg + 8 * u; unsigned short e[8];
#pragma unroll
                for (int jj = 0; jj < 8; ++jj) e[jj] = Bs[qnat(q0 + jj) * 136 + n];
                u32x4 w; w.x = e[0] | ((unsigned)e[1] << 16); w.y = e[2] | ((unsigned)e[3] << 16); w.z = e[4] | ((unsigned)e[5] << 16); w.w = e[6] | ((unsigned)e[7] << 16);
                if (!DRY) *(u32x4*)(BT + n * 64 + q0) = w; else KEEP(w);
            }
            bf16_t* Cg = (bf16_t*)(sc + SC_C) + (size_t)(cgi * 4 + grp) * 8192;
#pragma unroll
            for (int u = 0; u < 2; ++u) {
                const int idx = F.tid + 512 * u, l = idx >> 4, qg8 = idx & 15, kk = qg8 >> 2, gg = qg8 & 3;
                const u32x2 a = *(const u32x2*)(Cs + l * 136 + 32 * kk + 4 * gg), b = *(const u32x2*)(Cs + l * 136 + 32 * kk + 16 + 4 * gg);
                u32x4 w; w.x = a.x; w.y = a.y; w.z = b.x; w.w = b.y;
                if (!DRY) *(u32x4*)(Cg + l * 128 + 8 * qg8) = w; else KEEP(w);
            }
        }
        {
            bf16_t* CB = (bf16_t*)(sc + SC_CB) + (size_t)(cgi * 4 + grp) * 4096;
            const int m = F.wave >> 1;
#pragma unroll
            for (int u = 0; u < 2; ++u) {
                const int st = 2 * (F.wave & 1) + u; f32x4 acc = (f32x4){0.f, 0.f, 0.f, 0.f};
#pragma unroll
                for (int kk = 0; kk < 4; ++kk) {
                    const bf16x8 a = *(const bf16x8*)(Cs + (16 * m + i16) * 136 + 32 * kk + 8 * g4);
                    const bf16x8 b = *(const bf16x8*)(Bs + (16 * st + i16) * 136 + 32 * kk + 8 * g4);
                    acc = __builtin_amdgcn_mfma_f32_16x16x32_bf16(a, b, acc, 0, 0, 0);
                }
                const int qs = qperm(16 * st + i16);
#pragma unroll
                for (int jj = 0; jj < 4; ++jj) { if (!DRY) CB[(16 * m + 4 * g4 + jj) * 64 + qs] = f2bf(acc[jj]); else KEEP(acc[jj]); }
            }
        }
        {
            const int head = grp * 8 + F.wave, t = t0 + F.lane;
            const float a = -__expf(F.inp(12)[j * SSD_HEADS + head]);
            float dt = 0.f;
            if (t >= 0) dt = softplus_f(F.dtb[(size_t)(base + t) * 32 + head] + F.inp(11)[j * SSD_HEADS + head]);
            float cs = dt * a;
#pragma unroll
            for (int o = 1; o < 64; o <<= 1) { const float y = __shfl_up(cs, o); if (F.lane >= o) cs += y; }
            const float cs_last = __shfl(cs, 63), cs_be = __shfl(cs, F.lane | 3);
            float* vp = (float*)(sc + SC_VEC) + (size_t)(cgi * 32 + head) * 256;
            const float v1 = __expf(cs_be - cs) * dt, v2 = dt * __expf(cs_last - cs), v3 = __expf(cs);
            if (!DRY) { vp[F.lane] = cs; vp[64 + F.lane] = v1; vp[128 + F.lane] = v2; vp[192 + F.lane] = v3; } else { KEEP(v1); KEEP(v2); KEEP(v3); }
        }
    }
}

constexpr int SL_C = 0, SL_BT = 16384, SL_M = 32768, SL_XT = 40960, SL_VEC = 49152, SL_SIZE = 50176;
#define PD(d) P[11 + ((d) >> 2)][(d) & 3]
__device__ __forceinline__ void ssd_stage_load(u32x4 (&P)[15], const Frame& F, const unsigned char* sc, int lt, int seq, int head, int c) {
    const int cgi = cgi_of(seq, c), grp = head >> 3;
    const bf16_t* Cp = (const bf16_t*)(sc + SC_C) + (size_t)(cgi * 4 + grp) * 8192;
    const bf16_t* BTp = (const bf16_t*)(sc + SC_BT) + (size_t)(cgi * 4 + grp) * 8192;
    const bf16_t* CBp = (const bf16_t*)(sc + SC_CB) + (size_t)(cgi * 4 + grp) * 4096;
    const float* vp = (const float*)(sc + SC_VEC) + (size_t)(cgi * 32 + head) * 256;
    const XTile xt = ssd_xtile(F, seq, c, head);
#pragma unroll
    for (int r = 0; r < 4; ++r) { const int k = lt + 256 * r; P[r] = *(const u32x4*)(Cp + k * 8); P[4 + r] = *(const u32x4*)(BTp + k * 8); }
#pragma unroll
    for (int r = 0; r < 2; ++r) { const int k = lt + 256 * r, l = k >> 3, ch = k & 7, sa = 32 * (ch >> 2) + 4 * (ch & 3);
        P[8 + r] = *(const u32x4*)(CBp + k * 8); PD(3 * r) = __float_as_uint(vp[l]); PD(3 * r + 1) = __float_as_uint(vp[sa + 3]); PD(3 * r + 2) = __float_as_uint(vp[sa + 19]);
        P[13 + r] = *(const u32x4*)(xt.p + (size_t)l * xt.stride + ch * 8); }
    P[10] = *(const u32x4*)(vp + 64 + 4 * (lt < 48 ? lt : 0));
}
__device__ __forceinline__ void ssd_stage_write(const u32x4 (&P)[15], LAS unsigned char* img, int lt) {
#pragma unroll
    for (int r = 0; r < 4; ++r) { const int k = lt + 256 * r;
        { const int row = k >> 4, ch = k & 15; *(LAS u32x4*)(img + SL_C + (row * 16 + (ch ^ (row & 15))) * 16) = P[r]; }
        { const int row = k >> 3, ch = k & 7; *(LAS u32x4*)(img + SL_BT + (row * 8 + (ch ^ ((row >> 1) & 7))) * 16) = P[4 + r]; } }
#pragma unroll
    for (int r = 0; r < 2; ++r) {
        const int k = lt + 256 * r, l = k >> 3, ch = k & 7, sa = 32 * (ch >> 2) + 4 * (ch & 3), sb = sa + 16;
        const float csl = __uint_as_float(PD(3 * r)), e1a = __expf(csl - __uint_as_float(PD(3 * r + 1))), e1b = __expf(csl - __uint_as_float(PD(3 * r + 2)));
        const u32x4 cbw = P[8 + r]; f32x4 va, vb;
        va[0] = (sa + 0 <= l) ? __uint_as_float(cbw.x << 16) * e1a : 0.f; va[1] = (sa + 1 <= l) ? __uint_as_float(cbw.x & 0xffff0000u) * e1a : 0.f;
        va[2] = (sa + 2 <= l) ? __uint_as_float(cbw.y << 16) * e1a : 0.f; va[3] = (sa + 3 <= l) ? __uint_as_float(cbw.y & 0xffff0000u) * e1a : 0.f;
        vb[0] = (sb + 0 <= l) ? __uint_as_float(cbw.z << 16) * e1b : 0.f; vb[1] = (sb + 1 <= l) ? __uint_as_float(cbw.z & 0xffff0000u) * e1b : 0.f;
        vb[2] = (sb + 2 <= l) ? __uint_as_float(cbw.w << 16) * e1b : 0.f; vb[3] = (sb + 3 <= l) ? __uint_as_float(cbw.w & 0xffff0000u) * e1b : 0.f;
        u32x4 w; w.x = cvt_pk_bf16(va[0], va[1]); w.y = cvt_pk_bf16(va[2], va[3]); w.z = cvt_pk_bf16(vb[0], vb[1]); w.w = cvt_pk_bf16(vb[2], vb[3]);
        const int slot = l * 8 + (ch ^ ((l >> 1) & 7));
        *(LAS u32x4*)(img + SL_M + slot * 16) = w;
        *(LAS u32x4*)(img + SL_XT + slot * 16) = P[13 + r];
    }
    if (lt < 48) *(LAS u32x4*)(img + SL_VEC + 16 * lt) = P[10];
}
template <bool DRY>
__device__ __forceinline__ void ssd_ytile_out(const LAS unsigned char* img, const XTile& xt, int lt) {
#pragma unroll
    for (int r = 0; r < 2; ++r) { const int k = lt + 256 * r, p = k >> 3, ch = k & 7;
        const u32x4 w = *(const LAS u32x4*)(img + SL_XT + (p * 8 + (ch ^ ((p >> 1) & 7))) * 16);
        if (!DRY) *(u32x4*)(xt.p + (size_t)p * xt.stride + ch * 8) = w; else KEEP(w); }
}
template <bool DRY>
__device__ void phase_ssd_chain(const Frame& F0, int j) {
    const Frame F = relaunder(F0);
    const unsigned char* sc = (const unsigned char*)F.out;
    const bool loader = F.wave >= 4; const int lt = F.tid - 256, ps = F.wave & 3;
    for (int sh = F.bid; sh < 320; sh += F.G) {
        const int seq = sh < 64 ? (sh >> 5) : 2 + ((sh - 64) >> 5), head = sh & 31;
        const int nch = seq_chunks(seq);
        const float dsk = F.inp(13)[j * SSD_HEADS + head];
        __syncthreads();
        if (loader) {
            u32x4 A[15], B[15];
            ssd_stage_load(A, F, sc, lt, seq, head, 0); ssd_stage_write(A, F.ldsl, lt);
            if (nch > 1) ssd_stage_load(B, F, sc, lt, seq, head, 1);
            if (nch > 2) ssd_stage_load(A, F, sc, lt, seq, head, 2);
            __syncthreads();
#define SSD_LOADER_STEP(CC, ST) { const int cc_ = (CC); int nxt = ((cc_ + 1) & 1) * SL_SIZE, lt_ = lt; asm volatile("" : "+s"(nxt), "+v"(lt_)); \
                if (cc_ > 0) ssd_ytile_out<DRY>(F.ldsl + nxt, ssd_xtile(F, seq, cc_ - 1, head), lt_); \
                if (cc_ + 1 < nch) ssd_stage_write(ST, F.ldsl + nxt, lt_); \
                if (cc_ + 3 < nch) ssd_stage_load(ST, F, sc, lt_, seq, head, cc_ + 3); \
                __syncthreads(); }
            for (int c = 0; c < nch; c += 2) {
                SSD_LOADER_STEP(c, B)
                if (c + 1 < nch) SSD_LOADER_STEP(c + 1, A)
            }
#undef SSD_LOADER_STEP
            ssd_ytile_out<DRY>(F.ldsl + ((nch - 1) & 1) * SL_SIZE, ssd_xtile(F, seq, nch - 1, head), lt);
        } else {
            f32x4 HT[8];
#pragma unroll
            for (int m8 = 0; m8 < 8; ++m8) HT[m8] = (f32x4){0.f, 0.f, 0.f, 0.f};
            if (seq >= 2) {
                const int i = F.lane & 15, g = F.lane >> 4;
                const float* st = F.inp(2) + ((((size_t)j * 8 + (seq - 2)) * SSD_HEADS + head) * SSD_P + ps * 16 + i) * SSD_N + 4 * g;
#pragma unroll
                for (int m8 = 0; m8 < 8; ++m8) HT[m8] = *(const f32x4*)(st + 16 * m8);
            }
            __syncthreads();
            for (int c = 0; c < nch; ++c) {
                int cur = (c & 1) * SL_SIZE, lane_ = F.lane;
                asm volatile("" : "+s"(cur), "+v"(lane_));
                LAS unsigned char* img = F.ldsl + cur;
                const int i = lane_ & 15, g = lane_ >> 4, prow = ps * 16 + i, psw = (prow >> 1) & 7;
                const LAS unsigned char* pc[4]; const LAS unsigned char* pm[2];
#pragma unroll
                for (int kk = 0; kk < 4; ++kk) pc[kk] = img + SL_C + i * 256 + (((4 * kk + g) ^ i) * 16);
#pragma unroll
                for (int k2 = 0; k2 < 2; ++k2) pm[k2] = img + i * 128 + (((4 * k2 + g) ^ (i >> 1)) * 16);
                f32x4 e24[4], w4[4], ecs4[4];
#pragma unroll
                for (int m = 0; m < 4; ++m) { e24[m] = *(const LAS f32x4*)(img + SL_VEC + (16 * m + 4 * g) * 4); w4[m] = *(const LAS f32x4*)(img + SL_VEC + 256 + (16 * m + 4 * g) * 4); ecs4[m] = *(const LAS f32x4*)(img + SL_VEC + 512 + (16 * m + 4 * g) * 4); }
                const float ecl = *(const LAS float*)(img + SL_VEC + 512 + 63 * 4);
                bf16x8 Hf[4];
#pragma unroll
                for (int kk = 0; kk < 4; ++kk) Hf[kk] = pack8(HT[2 * kk], HT[2 * kk + 1]);
                f32x4 Y[4];
#pragma unroll
                for (int m = 0; m < 4; ++m) {
                    f32x4 acc = (f32x4){0.f, 0.f, 0.f, 0.f};
#pragma unroll
                    for (int kk = 0; kk < 4; ++kk) { const bf16x8 cf = *(const LAS bf16x8*)(pc[kk] + m * 4096); acc = __builtin_amdgcn_mfma_f32_16x16x32_bf16(cf, Hf[kk], acc, 0, 0, 0); }
                    Y[m] = acc * ecs4[m];
                }
                f32x4 xv[4];
                LAS unsigned char* xrow = img + SL_XT + prow * 128 + 8 * (g & 1);
#pragma unroll
                for (int m = 0; m < 4; ++m) {
                    const u32x2 xw = *(const LAS u32x2*)(xrow + ((2 * m + (g >> 1)) ^ psw) * 16);
                    xv[m][0] = __uint_as_float(xw.x << 16); xv[m][1] = __uint_as_float(xw.x & 0xffff0000u); xv[m][2] = __uint_as_float(xw.y << 16); xv[m][3] = __uint_as_float(xw.y & 0xffff0000u);
                }
                bf16x8 xsf[2], xwf[2];
#pragma unroll
                for (int k2 = 0; k2 < 2; ++k2) { xsf[k2] = pack8(xv[2 * k2] * e24[2 * k2], xv[2 * k2 + 1] * e24[2 * k2 + 1]); xwf[k2] = pack8(xv[2 * k2] * w4[2 * k2], xv[2 * k2 + 1] * w4[2 * k2 + 1]); }
#pragma unroll
                for (int m = 0; m < 4; ++m)
#pragma unroll
                    for (int k2 = 0; k2 < 2; ++k2) { const bf16x8 mf = *(const LAS bf16x8*)(pm[k2] + SL_M + m * 2048); Y[m] = __builtin_amdgcn_mfma_f32_16x16x32_bf16(mf, xsf[k2], Y[m], 0, 0, 0); }
#pragma unroll
                for (int m8 = 0; m8 < 8; ++m8) {
                    f32x4 acc = HT[m8] * ecl;
#pragma unroll
                    for (int k2 = 0; k2 < 2; ++k2) { const bf16x8 bf = *(const LAS bf16x8*)(pm[k2] + SL_BT + m8 * 2048); acc = __builtin_amdgcn_mfma_f32_16x16x32_bf16(bf, xwf[k2], acc, 0, 0, 0); }
                    HT[m8] = acc;
                }
#pragma unroll
                for (int m = 0; m < 4; ++m) {
                    const f32x4 y = Y[m] + xv[m] * dsk; u32x2 w; w.x = cvt_pk_bf16(y[0], y[1]); w.y = cvt_pk_bf16(y[2], y[3]);
                    *(LAS u32x2*)(xrow + ((2 * m + (g >> 1)) ^ psw) * 16) = w;
                }
                __syncthreads();
            }
            const int i = F.lane & 15, g = F.lane >> 4;
            float* so = (seq < 2) ? F.out + O_PSSD + ((((size_t)j * 2 + seq) * SSD_HEADS + head) * SSD_P + ps * 16 + i) * SSD_N + 4 * g
                                  : F.out + O_SSSD + ((((size_t)j * 8 + (seq - 2)) * SSD_HEADS + head) * SSD_P + ps * 16 + i) * SSD_N + 4 * g;
#pragma unroll
            for (int m8 = 0; m8 < 8; ++m8) { if (!DRY) *(f32x4*)(so + 16 * m8) = HT[m8]; else KEEP(HT[m8]); }
        }
    }
}

template <bool DRY>
__device__ void phase_ssd_post(const Frame& F0, int j) {
    const Frame F = relaunder(F0);
    constexpr int RL = 524;
    bf16_t* YL = (bf16_t*)F.lds;
    for (int task = F.bid; task < NCHT * 4; task += F.G) {
        const int cgi = task >> 2, grp = task & 3; int seq, c; chunk_of(cgi, seq, c);
        const int base = seq_base(seq), t0 = 64 * c - PADF;
        u32x4 zr[8];
#pragma unroll
        for (int q = 0; q < 8; ++q) { const int l = F.wave + 8 * q, t = t0 + l; const int row = seq < 2 ? seq * TPP + 64 * c + l : base + (t > 0 ? t : 0);
            zr[q] = *(const u32x4*)(F.proj + (size_t)row * LDP + grp * 512 + 8 * F.lane); }
        __syncthreads();
#pragma unroll
        for (int r = 0; r < 8; ++r) {
            const int k = F.tid + 512 * r, hl = k >> 9, p = (k >> 3) & 63, ch = k & 7;
            const XTile xt = ssd_xtile(F, seq, c, grp * 8 + hl);
            const u32x4 w = *(const u32x4*)(xt.p + (size_t)p * xt.stride + ch * 8);
            bf16_t* d = YL + (8 * ch) * RL + hl * 64 + p;
            d[0] = (bf16_t)w.x; d[RL] = (bf16_t)(w.x >> 16); d[2 * RL] = (bf16_t)w.y; d[3 * RL] = (bf16_t)(w.y >> 16);
            d[4 * RL] = (bf16_t)w.z; d[5 * RL] = (bf16_t)(w.z >> 16); d[6 * RL] = (bf16_t)w.w; d[7 * RL] = (bf16_t)(w.w >> 16);
        }
        __syncthreads();
#pragma unroll
        for (int q = 0; q < 8; ++q) {
            const int l = F.wave + 8 * q, t = t0 + l;
            if (t < 0 && seq >= 2) continue;
            const int row = seq < 2 ? seq * TPP + 64 * c + l : base + t;
            const u32x2 y0 = *(const u32x2*)(YL + l * RL + 8 * F.lane), y1 = *(const u32x2*)(YL + l * RL + 8 * F.lane + 4);
            const unsigned yw[4] = {y0.x, y0.y, y1.x, y1.y}; const unsigned zw[4] = {zr[q].x, zr[q].y, zr[q].z, zr[q].w};
            float yg[8]; float ss = 0.f;
#pragma unroll
            for (int e = 0; e < 4; ++e) {
                yg[2 * e] = __uint_as_float(yw[e] << 16) * silu_f(__uint_as_float(zw[e] << 16)); yg[2 * e + 1] = __uint_as_float(yw[e] & 0xffff0000u) * silu_f(__uint_as_float(zw[e] & 0xffff0000u));
                ss += yg[2 * e] * yg[2 * e] + yg[2 * e + 1] * yg[2 * e + 1]; }
            ss = wave_sum(ss);
            const float rs = rsqrtf(ss * (1.0f / 512.0f) + EPS);
            u32x4 w; w.x = cvt_pk_bf16(yg[0] * rs, yg[1] * rs); w.y = cvt_pk_bf16(yg[2] * rs, yg[3] * rs); w.z = cvt_pk_bf16(yg[4] * rs, yg[5] * rs); w.w = cvt_pk_bf16(yg[6] * rs, yg[7] * rs);
            if (!DRY) *(u32x4*)(F.proj + (size_t)row * LDP + grp * 512 + 8 * F.lane) = w; else KEEP(w);
        }
    }
    for (int e = F.bid * NTHREADS + F.tid; e < NSEQ * 3 * SSD_CONV; e += F.G * NTHREADS) {
        const int s = e / (3 * SSD_CONV), r = (e / SSD_CONV) % 3, c = e % SSD_CONV;
        const int row = seq_base(s) + seq_len(s) - 3 + r;
        float v;
        if (s < 2 && c < 2048) v = bf2f(F.tails[((size_t)(s * 129 + 128) * 3 + r) * 4096 + c]);
        else v = bf2f(F.proj[(size_t)row * LDP + 2048 + c]);
        if (s < 2) F.out[O_PSSDC + (((size_t)j * 2 + s) * 3 + r) * SSD_CONV + c] = v;
        else F.out[O_SSSDC + (((size_t)j * 8 + (s - 2)) * 3 + r) * SSD_CONV + c] = v;
    }
}

constexpr size_t SG_W = 0;
constexpr size_t SG_QK = SG_W + (size_t)NCHT * 8 * 16384;
constexpr size_t SG_VEC = SG_QK + (size_t)NCHT * 8 * 8192;
constexpr size_t SG_PART = SG_VEC + (size_t)NCHT * 8 * 1024;
constexpr size_t SG_SIDE = SG_PART + (size_t)M_TOT * 128 * 2;
constexpr size_t SG_END = SG_SIDE + (size_t)64 * 65536;
static_assert(SG_END <= (size_t)16777216 * 4, "scratch must fit the y_prompt region");
struct GTile { bf16_t* q; bf16_t* k; bf16_t* v; int sq, sk, sv; };
__device__ __forceinline__ GTile gdn_tile(const Frame& F, int seq, int c, int head) {
    GTile t;
    if (seq < 2) { bf16_t* r0 = F.proj + (size_t)(seq * TPP + 64 * c) * LDP; t.q = r0 + head * 128; t.k = r0 + 1024 + head * 128; t.v = r0 + 2048 + head * 256; t.sq = LDP; t.sk = LDP; t.sv = LDP; }
    else { bf16_t* b = (bf16_t*)((unsigned char*)F.out + SG_SIDE) + (size_t)((seq - 2) * 8 + head) * 32768; t.q = b; t.k = b + 8192; t.v = b + 16384; t.sq = 128; t.sk = 128; t.sv = 256; }
    return t;
}

template <bool DRY>
__device__ void phase_gdn_prep(const Frame& F0, int j) {
    const Frame F = relaunder(F0);
    float* Am = (float*)F.lds;
    float* vgc = Am + 64 * 68;
    float* vbe = vgc + 64;
    float* vnq = vbe + 64;
    float* vnk = vnq + 64;
    bf16_t* qs = (bf16_t*)(vnk + 64);
    bf16_t* ks = qs + 64 * 136;
    bf16_t* kT = ks + 64 * 136;
    bf16_t* vT = kT + 128 * 72;
    bf16_t* Tb = vT + 256 * 72;
    bf16_t* TT = Tb + 2 * 64 * 72;
    bf16_t* TD = TT + 64 * 72;
    bf16_t* YT = TD + 2 * 4 * 16 * 24;
    unsigned char* sc = (unsigned char*)F.out;
    const float* conv_w = F.inp(18) + (size_t)j * 4 * GDN_CONV;
    const int i16 = F.lane & 15, g4 = F.lane >> 4;
    constexpr float CQ = 0.08838834764831845f;
    for (int task = F.bid; task < NCHT * 8; task += F.G) {
        const int cgi = task >> 3, head = task & 7; int seq, c; chunk_of(cgi, seq, c);
        const int base = seq_base(seq), t0 = 64 * c - PADF;
        const GTile tl = gdn_tile(F, seq, c, head);
        __syncthreads();
        for (int q = F.tid; q < (3 * 64 * 72 + 64 * 24) / 8; q += NTHREADS) { bf16_t* z0 = (q < 3 * 64 * 72 / 8) ? Tb + 8 * q : YT + 8 * (q - 3 * 64 * 72 / 8); *(u32x4*)z0 = (u32x4){0u, 0u, 0u, 0u}; }
        if (F.wave == 0) {
            const int t = t0 + F.lane; float gg = 0.f, be = 0.f;
            if (t >= 0) { const float* dp = F.dtb + (size_t)(base + t) * 32; gg = -__expf(F.inp(20)[j * GDN_HEADS + head]) * softplus_f(dp[head] + F.inp(19)[j * GDN_HEADS + head]); be = 1.0f / (1.0f + __expf(-dp[8 + head])); }
#pragma unroll
            for (int o = 1; o < 64; o <<= 1) { const float y = __shfl_up(gg, o); if (F.lane >= o) gg += y; }
            vgc[F.lane] = gg; vbe[F.lane] = be;
        }
        __syncthreads();
        {
            const int ch = F.tid;
            const int cidx = ch < 128 ? head * 128 + ch : (ch < 256 ? 1024 + head * 128 + (ch - 128) : 2048 + head * 256 + (ch - 256));
            const float w0 = conv_w[cidx], w1 = conv_w[GDN_CONV + cidx], w2 = conv_w[2 * GDN_CONV + cidx], w3 = conv_w[3 * GDN_CONV + cidx];
            const float* cst = (seq >= 2) ? F.inp(5) + (((size_t)j * 8 + (seq - 2)) * 3) * GDN_CONV + cidx : nullptr;
            const bf16_t* tailp = (seq < 2 && c > 0) ? F.tails + (size_t)(cgi - 1) * 3 * 4096 + cidx : nullptr;
            float r3 = 0.f, r2 = 0.f, r1 = 0.f;
            if (tailp) { r3 = bf2f(tailp[0]); r2 = bf2f(tailp[4096]); r1 = bf2f(tailp[2 * 4096]); }
            else if (cst) { r3 = cst[0]; r2 = cst[GDN_CONV]; r1 = cst[2 * GDN_CONV]; }
            const bf16_t* col = F.proj + cidx;
#pragma unroll 1
            for (int pg = 0; pg < 2; ++pg) {
                unsigned short raw[32];
#pragma unroll
                for (int e = 0; e < 32; ++e) { const int t = t0 + 32 * pg + e; raw[e] = col[(size_t)(base + (t > 0 ? t : 0)) * LDP]; }
#pragma unroll
                for (int e8 = 0; e8 < 4; ++e8) {
                    float o[8];
#pragma unroll
                    for (int h = 0; h < 8; ++h) {
                        const int e = 8 * e8 + h, p = 32 * pg + e, t = t0 + p;
                        const float x = (t >= 0) ? bf2f(raw[e]) : 0.f;
                        o[h] = silu_f(w0 * r3 + w1 * r2 + w2 * r1 + w3 * x);
                        if (t >= 0) { r3 = r2; r2 = r1; r1 = x; }
                        if (ch < 128) qs[p * 136 + ch] = f2bf(o[h]);
                        else if (ch < 256) ks[p * 136 + (ch - 128)] = f2bf(o[h]);
                        else o[h] *= vbe[p];
                    }
                    if (ch >= 128) { u32x4 w; w.x = cvt_pk_bf16(o[0], o[1]); w.y = cvt_pk_bf16(o[2], o[3]); w.z = cvt_pk_bf16(o[4], o[5]); w.w = cvt_pk_bf16(o[6], o[7]);
                        bf16_t* d = (ch < 256 ? kT + (ch - 128) * 72 : vT + (ch - 256) * 72) + 32 * pg + 8 * e8; *(u32x4*)d = w; }
                }
            }
        }
        __syncthreads();
        if (F.tid < 128) {
            const int l = F.tid & 63; const bf16_t* rowp = (F.tid < 64 ? qs : ks) + l * 136; float ss = 0.f;
#pragma unroll
            for (int q = 0; q < 16; ++q) { const u32x4 v = *(const u32x4*)(rowp + 8 * q);
                const float a0 = __uint_as_float(v.x << 16), a1 = __uint_as_float(v.x & 0xffff0000u), a2 = __uint_as_float(v.y << 16), a3 = __uint_as_float(v.y & 0xffff0000u);
                const float a4 = __uint_as_float(v.z << 16), a5 = __uint_as_float(v.z & 0xffff0000u), a6 = __uint_as_float(v.w << 16), a7 = __uint_as_float(v.w & 0xffff0000u);
                ss += ((a0 * a0 + a1 * a1) + (a2 * a2 + a3 * a3)) + ((a4 * a4 + a5 * a5) + (a6 * a6 + a7 * a7)); }
            (F.tid < 64 ? vnq : vnk)[l] = rsqrtf(ss + EPS);
        }
        __syncthreads();
        {
            bf16_t* QKg = (bf16_t*)(sc + SG_QK) + (size_t)task * 4096;
            const int m = F.wave >> 1;
#pragma unroll
            for (int u = 0; u < 2; ++u) {
                const int st = 2 * (F.wave & 1) + u; f32x4 aK = (f32x4){0.f, 0.f, 0.f, 0.f}, aQ = (f32x4){0.f, 0.f, 0.f, 0.f};
#pragma unroll
                for (int kk = 0; kk < 4; ++kk) {
                    const bf16x8 ak = *(const bf16x8*)(ks + (16 * m + i16) * 136 + 32 * kk + 8 * g4);
                    const bf16x8 aq = *(const bf16x8*)(qs + (16 * m + i16) * 136 + 32 * kk + 8 * g4);
                    const bf16x8 b = *(const bf16x8*)(ks + (16 * st + i16) * 136 + 32 * kk + 8 * g4);
                    aK = __builtin_amdgcn_mfma_f32_16x16x32_bf16(ak, b, aK, 0, 0, 0);
                    aQ = __builtin_amdgcn_mfma_f32_16x16x32_bf16(aq, b, aQ, 0, 0, 0);
                }
                const int s_ = 16 * st + i16; const float gs = vgc[s_], nks = vnk[s_]; const int qs_ = qperm(s_);
#pragma unroll
                for (int jj = 0; jj < 4; ++jj) {
                    const int l = 16 * m + 4 * g4 + jj;
                    const float dec = (s_ <= l) ? __expf(vgc[l] - gs) : 0.f;
                    Am[l * 68 + s_] = (s_ < l) ? vbe[l] * vnk[l] * nks * aK[jj] * dec : 0.f;
                    { const float r = CQ * vnq[l] * nks * aQ[jj] * dec; if (!DRY) QKg[l * 64 + qs_] = f2bf(r); else KEEP(r); }
                }
            }
        }
        __syncthreads();
        if (F.wave == 0) for (int rep = 0; rep < REP_SUBST; ++rep) {
            int ln = F.lane; asm volatile("" : "+v"(ln));
            const int i = ln & 15, g = ln >> 4;
            {   const int b = g, cc = i; float x[16];
#pragma unroll
                for (int r = 0; r < 16; ++r) {
                    float a0 = (r == cc) ? 1.f : 0.f, a1 = 0.f;
#pragma unroll
                    for (int s2 = 0; s2 < r; ++s2) { const float av = Am[(16 * b + r) * 68 + 16 * b + s2]; if (s2 & 1) a1 -= av * x[s2]; else a0 -= av * x[s2]; }
                    x[r] = a0 + a1;
                }
                const int cg = 16 * b + cc; const float csc = vbe[cg] * __expf(vgc[cg]) * vnk[cg];
#pragma unroll
                for (int r = 0; r < 16; ++r) {
                    const bf16_t hi = f2bf(x[r]); const int lg = 16 * b + r;
                    Tb[lg * 72 + cg] = hi; Tb[64 * 72 + lg * 72 + cg] = f2bf(x[r] * csc); TT[cg * 72 + lg] = hi;
                    TD[(b * 16 + r) * 24 + cc] = hi; TD[4 * 16 * 24 + (b * 16 + r) * 24 + cc] = f2bf(x[r] - bf2f(hi));
                }
            }
#pragma unroll
            for (int bi = 1; bi < 4; ++bi) {
#pragma unroll
                for (int nt = 0; nt < bi; ++nt) {
                    f32x4 acc = (f32x4){0.f, 0.f, 0.f, 0.f};
#pragma unroll
                    for (int ks = 0; ks < (16 * bi + 31) / 32; ++ks) {
                        const int k0 = 32 * ks + 8 * g;
                        f32x4 alo4 = (f32x4){0.f, 0.f, 0.f, 0.f}, ahi4 = (f32x4){0.f, 0.f, 0.f, 0.f};
                        if (k0 < 16 * bi) { alo4 = *(const f32x4*)(Am + (16 * bi + i) * 68 + k0); ahi4 = *(const f32x4*)(Am + (16 * bi + i) * 68 + k0 + 4); }
                        const bf16x8 ah = pack8(alo4, ahi4);
                        const u32x4 ahw = __builtin_bit_cast(u32x4, ah);
                        f32x4 r0, r1;
                        r0[0] = alo4[0] - __uint_as_float(ahw.x << 16); r0[1] = alo4[1] - __uint_as_float(ahw.x & 0xffff0000u); r0[2] = alo4[2] - __uint_as_float(ahw.y << 16); r0[3] = alo4[3] - __uint_as_float(ahw.y & 0xffff0000u);
                        r1[0] = ahi4[0] - __uint_as_float(ahw.z << 16); r1[1] = ahi4[1] - __uint_as_float(ahw.z & 0xffff0000u); r1[2] = ahi4[2] - __uint_as_float(ahw.w << 16); r1[3] = ahi4[3] - __uint_as_float(ahw.w & 0xffff0000u);
                        const bf16x8 al = pack8(r0, r1);
                        const bf16x8 bt = *(const bf16x8*)(TT + (16 * nt + i) * 72 + k0);
                        acc = __builtin_amdgcn_mfma_f32_16x16x32_bf16(ah, bt, acc, 0, 0, 0);
                        acc = __builtin_amdgcn_mfma_f32_16x16x32_bf16(al, bt, acc, 0, 0, 0);
                    }
                    u32x2 w; w.x = cvt_pk_bf16(acc[0], acc[1]); w.y = cvt_pk_bf16(acc[2], acc[3]);
                    *(u32x2*)(YT + (16 * nt + i) * 24 + 4 * g) = w;
                }
                bf16x8 th = __builtin_bit_cast(bf16x8, (u32x4){0u, 0u, 0u, 0u}), tlo = th;
                if (g < 2) { th = *(const bf16x8*)(TD + (bi * 16 + i) * 24 + 8 * g); tlo = *(const bf16x8*)(TD + 4 * 16 * 24 + (bi * 16 + i) * 24 + 8 * g); }
#pragma unroll
                for (int nt = 0; nt < bi; ++nt) {
                    bf16x8 yb = __builtin_bit_cast(bf16x8, (u32x4){0u, 0u, 0u, 0u});
                    if (g < 2) yb = *(const bf16x8*)(YT + (16 * nt + i) * 24 + 8 * g);
                    f32x4 acc = (f32x4){0.f, 0.f, 0.f, 0.f};
                    acc = __builtin_amdgcn_mfma_f32_16x16x32_bf16(th, yb, acc, 0, 0, 0);
                    acc = __builtin_amdgcn_mfma_f32_16x16x32_bf16(tlo, yb, acc, 0, 0, 0);
                    const int cg = 16 * nt + i; const float csc = vbe[cg] * __expf(vgc[cg]) * vnk[cg];
                    u32x2 w; w.x = cvt_pk_bf16(-acc[0], -acc[1]); w.y = cvt_pk_bf16(-acc[2], -acc[3]);
                    *(u32x2*)(TT + cg * 72 + 16 * bi + 4 * g) = w;
#pragma unroll
                    for (int jj = 0; jj < 4; ++jj) { const int lg = 16 * bi + 4 * g + jj; Tb[lg * 72 + cg] = f2bf(-acc[jj]); Tb[64 * 72 + lg * 72 + cg] = f2bf(-acc[jj] * csc); }
                }
            }
        } else {
            const int t7 = F.tid - 64;
            for (int idx = t7; idx < 1024; idx += 448) {
                const int l = idx >> 4, qg8 = idx & 15, kk = qg8 >> 2, gg = qg8 & 3;
                const u32x2 a = *(const u32x2*)(qs + l * 136 + 32 * kk + 4 * gg), b = *(const u32x2*)(qs + l * 136 + 32 * kk + 16 + 4 * gg);
                u32x4 w; w.x = a.x; w.y = a.y; w.z = b.x; w.w = b.y;
                if (!DRY) *(u32x4*)(tl.q + (size_t)l * tl.sq + 8 * qg8) = w; else KEEP(w);
            }
            for (int idx = t7; idx < 1024; idx += 448) {
                const int kd = idx >> 3, pg = idx & 7, kk2 = pg >> 2, gg = pg & 3;
                const u32x2 a = *(const u32x2*)(kT + kd * 72 + 32 * kk2 + 4 * gg), b = *(const u32x2*)(kT + kd * 72 + 32 * kk2 + 16 + 4 * gg);
                u32x4 w; w.x = a.x; w.y = a.y; w.z = b.x; w.w = b.y;
                if (!DRY) *(u32x4*)(tl.k + (size_t)(kd >> 1) * tl.sk + (kd & 1) * 64 + 8 * pg) = w; else KEEP(w);
            }
            if (t7 < 64) {
                float* vp = (float*)(sc + SG_VEC) + (size_t)task * 256; const float gl = vgc[63];
                const float v0 = __expf(vgc[t7]) * CQ * vnq[t7], v1 = vnk[t7] * __expf(gl - vgc[t7]), v2 = __expf(gl);
                if (!DRY) { vp[t7] = v0; vp[64 + t7] = v1; vp[128 + t7] = v2; vp[192 + t7] = 0.f; } else { KEEP(v0); KEEP(v1); KEEP(v2); }
            }
        }
        __syncthreads();
        {
            bf16_t* Wg = (bf16_t*)(sc + SG_W) + (size_t)task * 8192;
            bf16x8 bk[2];
#pragma unroll
            for (int k2 = 0; k2 < 2; ++k2) bk[k2] = *(const bf16x8*)(kT + (16 * F.wave + i16) * 72 + 32 * k2 + 8 * g4);
            const int qkd = qperm(16 * F.wave + i16);
#pragma unroll
            for (int m = 0; m < 4; ++m) {
                f32x4 acc = (f32x4){0.f, 0.f, 0.f, 0.f};
#pragma unroll
                for (int k2 = 0; k2 < 2; ++k2) { const bf16x8 a = *(const bf16x8*)(Tb + 64 * 72 + (16 * m + i16) * 72 + 32 * k2 + 8 * g4); acc = __builtin_amdgcn_mfma_f32_16x16x32_bf16(a, bk[k2], acc, 0, 0, 0); }
#pragma unroll
                for (int jj = 0; jj < 4; ++jj) { if (!DRY) Wg[(16 * m + 4 * g4 + jj) * 128 + qkd] = f2bf(acc[jj]); else KEEP(acc[jj]); }
            }
#pragma unroll
            for (int u = 0; u < 2; ++u) {
                const int v = 16 * (2 * F.wave + u) + i16;
                bf16x8 bv[2];
#pragma unroll
                for (int k2 = 0; k2 < 2; ++k2) bv[k2] = *(const bf16x8*)(vT + v * 72 + 32 * k2 + 8 * g4);
#pragma unroll
                for (int m = 0; m < 4; ++m) {
                    f32x4 acc = (f32x4){0.f, 0.f, 0.f, 0.f};
#pragma unroll
                    for (int k2 = 0; k2 < 2; ++k2) { const bf16x8 a = *(const bf16x8*)(Tb + (16 * m + i16) * 72 + 32 * k2 + 8 * g4); acc = __builtin_amdgcn_mfma_f32_16x16x32_bf16(a, bv[k2], acc, 0, 0, 0); }
                    u32x2 w; w.x = cvt_pk_bf16(acc[0], acc[1]); w.y = cvt_pk_bf16(acc[2], acc[3]);
                    if (!DRY) *(u32x2*)(tl.v + (size_t)(v >> 2) * tl.sv + (v & 3) * 64 + 16 * m + 4 * g4) = w; else KEEP(w);
                }
            }
        }
    }
}

constexpr int GL_W = 0, GL_Q = 16384, GL_KT = 32768, GL_QK = 49152, GL_U = 57344, GL_VEC = 65536, GL_SIZE = 66560;
__device__ __forceinline__ bf16_t* gdn_urow(const GTile& tl, int v) { return tl.v + (size_t)(v >> 2) * tl.sv + (v & 3) * 64; }
__device__ __forceinline__ void gdn_stage_load(u32x4 (&P)[17], const Frame& F, const unsigned char* sc, int lt, int seq, int head, int vq, int c) {
    const int task = cgi_of(seq, c) * 8 + head;
    const GTile tl = gdn_tile(F, seq, c, head);
    const bf16_t* Wp = (const bf16_t*)(sc + SG_W) + (size_t)task * 8192;
    const bf16_t* QKp = (const bf16_t*)(sc + SG_QK) + (size_t)task * 4096;
    const float* vp = (const float*)(sc + SG_VEC) + (size_t)task * 256;
#pragma unroll
    for (int r = 0; r < 4; ++r) { const int k = lt + 256 * r;
        P[r] = *(const u32x4*)(Wp + k * 8);
        P[4 + r] = *(const u32x4*)(tl.q + (size_t)(k >> 4) * tl.sq + (k & 15) * 8);
        { const int kd = k >> 3; P[8 + r] = *(const u32x4*)(tl.k + (size_t)(kd >> 1) * tl.sk + (kd & 1) * 64 + (k & 7) * 8); } }
#pragma unroll
    for (int r = 0; r < 2; ++r) { const int k = lt + 256 * r;
        P[12 + r] = *(const u32x4*)(QKp + k * 8);
        P[14 + r] = *(const u32x4*)(gdn_urow(tl, vq * 64 + (k >> 3)) + (k & 7) * 8); }
    P[16] = *(const u32x4*)(vp + 4 * (lt < 48 ? lt : 0));
}
__device__ __forceinline__ void gdn_stage_write(const u32x4 (&P)[17], LAS unsigned char* img, int lt) {
#pragma unroll
    for (int r = 0; r < 4; ++r) { const int k = lt + 256 * r;
        { const int row = k >> 4, ch = k & 15, slot = row * 16 + (ch ^ (row & 15)); *(LAS u32x4*)(img + GL_W + slot * 16) = P[r]; *(LAS u32x4*)(img + GL_Q + slot * 16) = P[4 + r]; }
        { const int row = k >> 3, ch = k & 7; *(LAS u32x4*)(img + GL_KT + (row * 8 + (ch ^ ((row >> 1) & 7))) * 16) = P[8 + r]; } }
#pragma unroll
    for (int r = 0; r < 2; ++r) { const int k = lt + 256 * r, row = k >> 3, ch = k & 7, slot = row * 8 + (ch ^ ((row >> 1) & 7));
        *(LAS u32x4*)(img + GL_QK + slot * 16) = P[12 + r]; *(LAS u32x4*)(img + GL_U + slot * 16) = P[14 + r]; }
    if (lt < 48) *(LAS u32x4*)(img + GL_VEC + 16 * lt) = P[16];
}
template <bool DRY>
__device__ __forceinline__ void gdn_otile_out(const LAS unsigned char* img, const GTile& tl, int vq, int lt) {
#pragma unroll
    for (int r = 0; r < 2; ++r) { const int k = lt + 256 * r, row = k >> 3, ch = k & 7;
        const u32x4 w = *(const LAS u32x4*)(img + GL_U + (row * 8 + (ch ^ ((row >> 1) & 7))) * 16);
        if (!DRY) *(u32x4*)(gdn_urow(tl, vq * 64 + row) + ch * 8) = w; else KEEP(w); }
}
template <bool DRY>
__device__ void phase_gdn_chain(const Frame& F0, int j) {
    const Frame F = relaunder(F0);
    const unsigned char* sc = (const unsigned char*)F.out;
    const bool loader = F.wave >= 4; const int lt = F.tid - 256, w4 = F.wave & 3;
    for (int sh = F.bid; sh < 320; sh += F.G) {
        const int seq = sh < 64 ? (sh >> 5) : 2 + ((sh - 64) >> 5), head = (sh >> 2) & 7, vq = sh & 3;
        const int nch = seq_chunks(seq);
        __syncthreads();
        if (loader) {
            u32x4 A[17], B[17];
            gdn_stage_load(A, F, sc, lt, seq, head, vq, 0); gdn_stage_write(A, F.ldsl, lt);
            if (nch > 1) gdn_stage_load(B, F, sc, lt, seq, head, vq, 1);
            if (nch > 2) gdn_stage_load(A, F, sc, lt, seq, head, vq, 2);
            __syncthreads();
#define GDN_LOADER_STEP(CC, ST) { const int cc_ = (CC); int nxt = ((cc_ + 1) & 1) * GL_SIZE, lt_ = lt; asm volatile("" : "+s"(nxt), "+v"(lt_)); \
                if (cc_ > 0) gdn_otile_out<DRY>(F.ldsl + nxt, gdn_tile(F, seq, cc_ - 1, head), vq, lt_); \
                if (cc_ + 1 < nch) gdn_stage_write(ST, F.ldsl + nxt, lt_); \
                if (cc_ + 3 < nch) gdn_stage_load(ST, F, sc, lt_, seq, head, vq, cc_ + 3); \
                __syncthreads(); }
            for (int c = 0; c < nch; c += 2) {
                GDN_LOADER_STEP(c, B)
                if (c + 1 < nch) GDN_LOADER_STEP(c + 1, A)
            }
#undef GDN_LOADER_STEP
            gdn_otile_out<DRY>(F.ldsl + ((nch - 1) & 1) * GL_SIZE, gdn_tile(F, seq, nch - 1, head), vq, lt);
        } else {
            f32x4 S[8];
#pragma unroll
            for (int m8 = 0; m8 < 8; ++m8) S[m8] = (f32x4){0.f, 0.f, 0.f, 0.f};
            if (seq >= 2) {
                const int i = F.lane & 15, g = F.lane >> 4;
                const float* st = F.inp(4) + (((size_t)j * 8 + (seq - 2)) * GDN_HEADS + head) * GDN_DK * GDN_DV + vq * 64 + w4 * 16 + i;
#pragma unroll
                for (int m8 = 0; m8 < 8; ++m8)
#pragma unroll
                    for (int jj = 0; jj < 4; ++jj) S[m8][jj] = st[(size_t)(16 * m8 + 4 * g + jj) * GDN_DV];
            }
            __syncthreads();
            for (int c = 0; c < nch; ++c) {
                int cur = (c & 1) * GL_SIZE, lane_ = F.lane;
                asm volatile("" : "+s"(cur), "+v"(lane_));
                LAS unsigned char* img = F.ldsl + cur;
                const int i = lane_ & 15, g = lane_ >> 4, vrow = w4 * 16 + i, vsw = (vrow >> 1) & 7;
                const LAS unsigned char* pw[4]; const LAS unsigned char* pk[2];
#pragma unroll
                for (int kk = 0; kk < 4; ++kk) pw[kk] = img + i * 256 + (((4 * kk + g) ^ i) * 16);
#pragma unroll
                for (int k2 = 0; k2 < 2; ++k2) pk[k2] = img + i * 128 + (((4 * k2 + g) ^ (i >> 1)) * 16);
                f32x4 rsc[4], vsc[4];
#pragma unroll
                for (int m = 0; m < 4; ++m) { rsc[m] = *(const LAS f32x4*)(img + GL_VEC + (16 * m + 4 * g) * 4); vsc[m] = *(const LAS f32x4*)(img + GL_VEC + 256 + (16 * m + 4 * g) * 4); }
                const float egl = *(const LAS float*)(img + GL_VEC + 512);
                bf16x8 Sf[4];
#pragma unroll
                for (int kk = 0; kk < 4; ++kk) Sf[kk] = pack8(S[2 * kk], S[2 * kk + 1]);
                LAS unsigned char* urow = img + GL_U + vrow * 128 + 8 * (g & 1);
                f32x4 vn[4], O[4];
#pragma unroll
                for (int m = 0; m < 4; ++m) {
                    f32x4 a1 = (f32x4){0.f, 0.f, 0.f, 0.f}, a2 = (f32x4){0.f, 0.f, 0.f, 0.f};
#pragma unroll
                    for (int kk = 0; kk < 4; ++kk) {
                        const bf16x8 wf = *(const LAS bf16x8*)(pw[kk] + GL_W + m * 4096), qf = *(const LAS bf16x8*)(pw[kk] + GL_Q + m * 4096);
                        a1 = __builtin_amdgcn_mfma_f32_16x16x32_bf16(wf, Sf[kk], a1, 0, 0, 0);
                        a2 = __builtin_amdgcn_mfma_f32_16x16x32_bf16(qf, Sf[kk], a2, 0, 0, 0);
                    }
                    const u32x2 uw = *(const LAS u32x2*)(urow + ((2 * m + (g >> 1)) ^ vsw) * 16);
                    vn[m][0] = __uint_as_float(uw.x << 16) - a1[0]; vn[m][1] = __uint_as_float(uw.x & 0xffff0000u) - a1[1];
                    vn[m][2] = __uint_as_float(uw.y << 16) - a1[2]; vn[m][3] = __uint_as_float(uw.y & 0xffff0000u) - a1[3];
                    O[m] = a2 * rsc[m];
                }
                bf16x8 Vf[2], Vsf[2];
#pragma unroll
                for (int k2 = 0; k2 < 2; ++k2) { Vf[k2] = pack8(vn[2 * k2], vn[2 * k2 + 1]); Vsf[k2] = pack8(vn[2 * k2] * vsc[2 * k2], vn[2 * k2 + 1] * vsc[2 * k2 + 1]); }
#pragma unroll
                for (int m = 0; m < 4; ++m)
#pragma unroll
                    for (int k2 = 0; k2 < 2; ++k2) { const bf16x8 qk = *(const LAS bf16x8*)(pk[k2] + GL_QK + m * 2048); O[m] = __builtin_amdgcn_mfma_f32_16x16x32_bf16(qk, Vf[k2], O[m], 0, 0, 0); }
#pragma unroll
                for (int m8 = 0; m8 < 8; ++m8) {
                    f32x4 acc = S[m8] * egl;
#pragma unroll
                    for (int k2 = 0; k2 < 2; ++k2) { const bf16x8 kf = *(const LAS bf16x8*)(pk[k2] + GL_KT + m8 * 2048); acc = __builtin_amdgcn_mfma_f32_16x16x32_bf16(kf, Vsf[k2], acc, 0, 0, 0); }
                    S[m8] = acc;
                }
#pragma unroll
                for (int m = 0; m < 4; ++m) { u32x2 w; w.x = cvt_pk_bf16(O[m][0], O[m][1]); w.y = cvt_pk_bf16(O[m][2], O[m][3]); *(LAS u32x2*)(urow + ((2 * m + (g >> 1)) ^ vsw) * 16) = w; }
                __syncthreads();
            }
            const int i = F.lane & 15, g = F.lane >> 4, vcol = vq * 64 + w4 * 16 + i;
            float* so = (seq < 2) ? F.out + O_PGDN + (((size_t)j * 2 + seq) * GDN_HEADS + head) * GDN_DK * GDN_DV + vcol
                                  : F.out + O_SGDN + (((size_t)j * 8 + (seq - 2)) * GDN_HEADS + head) * GDN_DK * GDN_DV + vcol;
#pragma unroll
            for (int m8 = 0; m8 < 8; ++m8)
#pragma unroll
                for (int jj = 0; jj < 4; ++jj) { if (!DRY) so[(size_t)(16 * m8 + 4 * g + jj) * GDN_DV] = S[m8][jj]; else KEEP(S[m8][jj]); }
        }
    }
}

template <bool DRY>
__device__ void phase_gdn_post2(const Frame& F0, int j) {
    const Frame F = relaunder(F0);
    constexpr int RL = 260;
    bf16_t* OL = (bf16_t*)F.lds;
    for (int task = F.bid; task < NCHT * 8; task += F.G) {
        const int cgi = task >> 3, head = task & 7; int seq, c; chunk_of(cgi, seq, c);
        const int base = seq_base(seq), t0 = 64 * c - PADF;
        const GTile tl = gdn_tile(F, seq, c, head);
        u32x2 zr[8];
#pragma unroll
        for (int q = 0; q < 8; ++q) { const int l = F.wave + 8 * q, t = t0 + l; const int row = seq < 2 ? seq * TPP + 64 * c + l : base + (t > 0 ? t : 0);
            zr[q] = *(const u32x2*)(F.proj + (size_t)row * LDP + 4096 + head * 256 + 4 * F.lane); }
        __syncthreads();
#pragma unroll
        for (int r = 0; r < 4; ++r) {
            const int k = F.tid + 512 * r, v = k >> 3, ch = k & 7;
            const u32x4 w = *(const u32x4*)(gdn_urow(tl, v) + ch * 8);
            bf16_t* d = OL + (8 * ch) * RL + v;
            d[0] = (bf16_t)w.x; d[RL] = (bf16_t)(w.x >> 16); d[2 * RL] = (bf16_t)w.y; d[3 * RL] = (bf16_t)(w.y >> 16);
            d[4 * RL] = (bf16_t)w.z; d[5 * RL] = (bf16_t)(w.z >> 16); d[6 * RL] = (bf16_t)w.w; d[7 * RL] = (bf16_t)(w.w >> 16);
        }
        __syncthreads();
#pragma unroll
        for (int q = 0; q < 8; ++q) {
            const int l = F.wave + 8 * q, t = t0 + l;
            if (t < 0 && seq >= 2) continue;
            const int row = seq < 2 ? seq * TPP + 64 * c + l : base + t;
            const u32x2 ow = *(const u32x2*)(OL + l * RL + 4 * F.lane);
            const float o0 = __uint_as_float(ow.x << 16), o1 = __uint_as_float(ow.x & 0xffff0000u), o2 = __uint_as_float(ow.y << 16), o3 = __uint_as_float(ow.y & 0xffff0000u);
            float ss = (o0 * o0 + o1 * o1) + (o2 * o2 + o3 * o3);
            ss = wave_sum(ss);
            const float rs = rsqrtf(ss * (1.0f / 256.0f) + EPS);
            const float z0 = __uint_as_float(zr[q].x << 16), z1 = __uint_as_float(zr[q].x & 0xffff0000u), z2 = __uint_as_float(zr[q].y << 16), z3 = __uint_as_float(zr[q].y & 0xffff0000u);
            u32x2 w; w.x = cvt_pk_bf16(o0 * rs * silu_f(z0), o1 * rs * silu_f(z1)); w.y = cvt_pk_bf16(o2 * rs * silu_f(z2), o3 * rs * silu_f(z3));
            if (!DRY) *(u32x2*)(F.proj + (size_t)row * LDP + 4096 + head * 256 + 4 * F.lane) = w; else KEEP(w);
        }
    }
    for (int e = F.bid * NTHREADS + F.tid; e < NSEQ * 3 * GDN_CONV; e += F.G * NTHREADS) {
        const int s = e / (3 * GDN_CONV), r = (e / GDN_CONV) % 3, c = e % GDN_CONV;
        if (s < 2) F.out[O_PGDNC + (((size_t)j * 2 + s) * 3 + r) * GDN_CONV + c] = bf2f(F.tails[((size_t)(s * 129 + 128) * 3 + r) * 4096 + c]);
        else F.out[O_SGDNC + (((size_t)j * 8 + (s - 2)) * 3 + r) * GDN_CONV + c] = bf2f(F.proj[(size_t)(seq_base(s) + 13 + r) * LDP + c]);
    }
}

__device__ void phase_final(const Frame& F0) {
    const Frame F = relaunder(F0);
    const float* fw = F.inp(23);
    for (int it = F.bid * 8 + F.wave; it < 2 * SEQ + 128; it += F.G * 8) {
        int row; float* dst;
        if (it < 2 * SEQ) { const int b = it / SEQ, t = it % SEQ; row = b * TPP + 64 + t; dst = F.out + O_YP + (size_t)it * D; }
        else { row = ROW_S0 + (it - 2 * SEQ); dst = F.out + O_YS + (size_t)(it - 2 * SEQ) * D; }
        float x[16]; float ss = 0.f;
#pragma unroll
        for (int i = 0; i < 4; ++i) {
            const u32x2 v = *(const u32x2*)(F.hb + (size_t)row * D + (F.lane + 64 * i) * 4);
            x[4 * i + 0] = __uint_as_float(v.x << 16); x[4 * i + 1] = __uint_as_float(v.x & 0xffff0000u); x[4 * i + 2] = __uint_as_float(v.y << 16); x[4 * i + 3] = __uint_as_float(v.y & 0xffff0000u);
            ss += (x[4 * i] * x[4 * i] + x[4 * i + 1] * x[4 * i + 1]) + (x[4 * i + 2] * x[4 * i + 2] + x[4 * i + 3] * x[4 * i + 3]);
        }
        ss = wave_sum(ss);
        const float rs = rsqrtf(ss * (1.0f / 1024.0f) + EPS);
#pragma unroll
        for (int i = 0; i < 4; ++i) {
            const int c = (F.lane + 64 * i) * 4; const f32x4 w = *(const f32x4*)(fw + c);
            f32x4 o; o[0] = x[4 * i] * rs * w[0]; o[1] = x[4 * i + 1] * rs * w[1]; o[2] = x[4 * i + 2] * rs * w[2]; o[3] = x[4 * i + 3] * rs * w[3];
            *(f32x4*)(dst + c) = o;
        }
    }
}

constexpr int N_PHASES = 22;
__global__ void __launch_bounds__(NTHREADS, 2) hybrid_fwd(Args args) {
    extern __shared__ __attribute__((aligned(16))) unsigned char lds[];
    volatile LAS unsigned* bst = (volatile LAS unsigned*)((LAS unsigned char*)lds + LDS_BYTES - 16);
    if (threadIdx.x < 4) bst[threadIdx.x] = 0u;
    __syncthreads();
    XcdBarrier bar; bar.bar = (unsigned*)(args.ws + WS_CTL); bar.x = 0; bar.st = bst;
    if (args.ph_hi - args.ph_lo > 1) bar = xcd_barrier_post((unsigned*)(args.ws + WS_CTL), bst);
    for (int ph = args.ph_lo; ph < args.ph_hi; ++ph) {
        int tid_ = threadIdx.x; asm volatile("" : "+v"(tid_));
        Frame F;
        F.ap = &args;
        F.out = args.out; F.ws = args.ws; F.lds = lds; F.ldsl = (LAS unsigned char*)lds;
        F.tid = tid_; F.lane = F.tid & 63; F.wave = __builtin_amdgcn_readfirstlane(F.tid >> 6); F.G = gridDim.x; F.bid = blockIdx.x;
        F.hb = nullptr; F.win = nullptr; F.wout = nullptr; F.dtb = nullptr; F.rss = nullptr; F.proj = nullptr; F.tails = nullptr;
        if (ph == 0) { phase_init_h(F); phase_wprep_in(F, 0); }
        else if (ph == N_PHASES - 1) { for (int r = 0; r < REP_FINAL; ++r) phase_final(F); }
        else {
            const int L = (ph - 1) / 5, sub = (ph - 1) % 5, j = L >> 1;
            if (sub == 0) { for (int r = 0; r < REP_INPROJ; ++r) phase_inproj(F, L); }
            else if (sub == 1) {
                if (L & 1) { for (int r = 1; r < REP_GDN_PREP; ++r) phase_gdn_prep<true>(F, j); phase_gdn_prep<false>(F, j); }
                else { for (int r = 1; r < REP_SSD_PREP; ++r) phase_ssd_prep<true>(F, j); phase_ssd_prep<false>(F, j); }
                for (int r = 0; r < REP_WPREP; ++r) phase_wprep_out(F, L); }
            else if (sub == 2) {
                if (L & 1) { for (int r = 1; r < REP_GDN_CHAIN; ++r) phase_gdn_chain<true>(F, j); phase_gdn_chain<false>(F, j); }
                else { for (int r = 1; r < REP_SSD_CHAIN; ++r) phase_ssd_chain<true>(F, j); phase_ssd_chain<false>(F, j); } }
            else if (sub == 3) {
                if (L & 1) { for (int r = 1; r < REP_GDN_POST; ++r) phase_gdn_post2<true>(F, j); phase_gdn_post2<false>(F, j); }
                else { for (int r = 1; r < REP_SSD_POST; ++r) phase_ssd_post<true>(F, j); phase_ssd_post<false>(F, j); }
                if (L < 3) { for (int r = 0; r < REP_WPREP; ++r) phase_wprep_in(F, L + 1); } }
            else { for (int r = 1; r < REP_OUTPROJ; ++r) phase_outproj(F, L, true); phase_outproj(F, L, false); }
        }
        if (ph + 1 < args.ph_hi) {
            if (ph == args.ph_lo) { __threadfence(); cg::this_grid().sync(); }
            else { for (int r = 0; r < REP_BARRIER; ++r) xcd_barrier(bar); }
        }
    }
}

extern "C" void kernel_launch(void* const* d_in, const int* in_sizes, int n_in, void* d_out, int out_size, void* d_ws, size_t ws_size, hipStream_t stream) {
    static int grid = 0;
    if (grid == 0) {
        if (n_in != 24 || ws_size < WS_END) { fprintf(stderr, "kernel_launch: unexpected n_in %d / ws %zu (need %zu)\n", n_in, ws_size, (size_t)WS_END); grid = -1; return; }
        int dev = 0, cus = 0, per_cu = 0;
        if (hipGetDevice(&dev) != hipSuccess || hipDeviceGetAttribute(&cus, hipDeviceAttributeMultiprocessorCount, dev) != hipSuccess) { grid = -1; return; }
        if (hipFuncSetAttribute((const void*)hybrid_fwd, hipFuncAttributeMaxDynamicSharedMemorySize, LDS_BYTES) != hipSuccess) { fprintf(stderr, "kernel_launch: hipFuncSetAttribute failed\n"); grid = -1; return; }
        if (hipOccupancyMaxActiveBlocksPerMultiprocessor(&per_cu, (const void*)hybrid_fwd, NTHREADS, LDS_BYTES) != hipSuccess || per_cu < 1) { fprintf(stderr, "kernel_launch: occupancy query says %d blocks per CU\n", per_cu); grid = -1; return; }
        (void)hipGetLastError();
        grid = cus;
    }
    if (grid < 0) return;
    Args a{};
    for (int i = 0; i < 24; ++i) a.in[i] = (const float*)d_in[i];
    a.out = (float*)d_out; a.ws = (unsigned char*)d_ws;
#if MK_ONE_LAUNCH
    (void)hipMemsetAsync((char*)d_ws + WS_CTL, 0, 16384, stream);
    a.ph_lo = 0; a.ph_hi = N_PHASES;
    void* kargs[] = {&a};
    hipError_t e = hipLaunchCooperativeKernel((const void*)hybrid_fwd, dim3(grid), dim3(NTHREADS), kargs, LDS_BYTES, stream);
    if (e != hipSuccess) fprintf(stderr, "kernel_launch: cooperative launch failed: %s (grid %d)\n", hipGetErrorString(e), grid);
#else
    for (int ph = 0; ph < N_PHASES; ++ph) {
        a.ph_lo = ph; a.ph_hi = ph + 1;
        hipLaunchKernelGGL(hybrid_fwd, dim3(grid), dim3(NTHREADS), LDS_BYTES, stream, a);
    }
#endif
}
```

```cpp
#include <hip/hip_runtime.h>
#include <hip/hip_cooperative_groups.h>
#include <cstdio>
#include <cstdint>
namespace cg = cooperative_groups;

#define LAS __attribute__((address_space(3)))
typedef unsigned short bf16_t;
typedef short bf16x8 __attribute__((ext_vector_type(8)));
typedef float f32x4 __attribute__((ext_vector_type(4)));
typedef unsigned u32x4 __attribute__((ext_vector_type(4)));
typedef unsigned u32x2 __attribute__((ext_vector_type(2)));

constexpr int D = 1024;
constexpr int SEQ = 8192, NMETA = 16, PADF = 48;
constexpr int TPP = 8256;
constexpr int ROW_S0 = 2 * TPP;
constexpr int M_TOT = ROW_S0 + 128;
constexpr int NSEQ = 10;
constexpr float EPS = 1e-6f;
constexpr int LDP = 6144;
constexpr int SSD_INNER = 2048, SSD_HEADS = 32, SSD_P = 64, SSD_N = 128, SSD_CONV = 3072, SSD_IN = 5152, SSD_IN_PAD = 5376;
constexpr int GDN_HEADS = 8, GDN_DK = 128, GDN_DV = 256, GDN_CONV = 4096, GDN_VAL = 2048, GDN_IN = 6160, GDN_IN_PAD = 6400;

constexpr size_t O_YP = 0, O_YS = 16777216, O_PSSD = 16908288, O_PSSDC = 17956864, O_PGDN = 17993728, O_PGDNC = 19042304,
                 O_SSSD = 19091456, O_SSSDC = 23285760, O_SGDN = 23433216, O_SGDNC = 27627520;

constexpr size_t WS_CTL = 0;
constexpr size_t WS_PROG = 16384;
constexpr size_t WS_HB = 65536;
constexpr size_t WS_WIN = WS_HB + (size_t)M_TOT * D * 2;
constexpr size_t WS_WOUT = WS_WIN + (size_t)GDN_IN_PAD * D * 2;
constexpr size_t WS_TAIL = WS_WOUT + (size_t)1024 * 2048 * 2;
constexpr size_t WS_DTB = WS_TAIL + (size_t)258 * 3 * 4096 * 2;
constexpr size_t WS_RSS = WS_DTB + (size_t)M_TOT * 32 * 4;
constexpr size_t WS_PROJ = WS_RSS + (size_t)M_TOT * 16 * 4;
constexpr size_t WS_END = WS_PROJ + (size_t)M_TOT * LDP * 2;

constexpr int NTHREADS = 512;
constexpr int LDS_BYTES = 147456;

#define KEEP(x) asm volatile("" :: "v"(x))
#ifndef REP_INPROJ
#define REP_INPROJ 1
#endif
#ifndef REP_SSD_PREP
#define REP_SSD_PREP 1
#endif
#ifndef REP_SSD_CHAIN
#define REP_SSD_CHAIN 1
#endif
#ifndef REP_GDN_PREP
#define REP_GDN_PREP 1
#endif
#ifndef REP_GDN_CHAIN
#define REP_GDN_CHAIN 1
#endif
#ifndef REP_WPREP
#define REP_WPREP 1
#endif
#ifndef PROBE_CHAIN_MODE
#define PROBE_CHAIN_MODE 1
#endif
#ifndef REP_OUTPROJ
#define REP_OUTPROJ 1
#endif
#ifndef REP_SSD_POST
#define REP_SSD_POST 1
#endif
#ifndef REP_GDN_POST
#define REP_GDN_POST 1
#endif
#ifndef REP_SUBST
#define REP_SUBST 1
#endif
#ifndef REP_BARRIER
#define REP_BARRIER 1
#endif
#ifndef REP_FINAL
#define REP_FINAL 1
#endif
#ifndef MK_ONE_LAUNCH
#define MK_ONE_LAUNCH 1
#endif
__device__ __forceinline__ float bf2f(bf16_t b) { return __uint_as_float(((unsigned)b) << 16); }
__device__ __forceinline__ bf16_t f2bf(float f) { unsigned u = __float_as_uint(f); u += 0x7FFFu + ((u >> 16) & 1u); return (bf16_t)(u >> 16); }
typedef __bf16 bf16v2_t __attribute__((ext_vector_type(2)));
typedef float f32x2_t __attribute__((ext_vector_type(2)));
__device__ __forceinline__ unsigned cvt_pk_bf16(float lo, float hi) { const bf16v2_t r = __builtin_convertvector((f32x2_t){lo, hi}, bf16v2_t); return __builtin_bit_cast(unsigned, r); }
__device__ __forceinline__ float silu_f(float x) { return x / (1.0f + __expf(-x)); }
__device__ __forceinline__ float softplus_f(float x) { return x > 20.f ? x : log1pf(__expf(x)); }
__device__ __forceinline__ float wave_sum(float v) {
#pragma unroll
    for (int o = 32; o >= 1; o >>= 1) v += __shfl_xor(v, o);
    return v;
}
__device__ __forceinline__ int seq_base(int s) { return s < 2 ? s * TPP + 64 - NMETA : ROW_S0 + 16 * (s - 2); }
__device__ __forceinline__ int seq_len(int s) { return s < 2 ? SEQ + NMETA : 16; }
__device__ __forceinline__ int seq_chunks(int s) { return s < 2 ? 129 : 1; }

namespace pg8 {
constexpr int BM = 256, BK = 64, HALF = 128, HTB = HALF * BK * 2, STAGE_BYTES = 8 * HTB, NXCD = 8, WGM = 8;
__device__ __forceinline__ int lds_byte(int r, int c) { const int st = (r >> 4) * 2 + (c >> 5), rr = r & 15, cc = c & 31, ob = rr * 64 + cc * 2; return st * 1024 + (ob ^ (((ob >> 9) & 1) << 5)); }
__device__ __forceinline__ void stage_rc(int b, int& R, int& C) { const int st = b / 1024, sb = b % 1024, swz = sb ^ (((sb >> 9) & 1) << 5); R = (st >> 1) * 16 + swz / 64; C = (st & 1) * 32 + (swz % 64) / 2; }
__device__ __forceinline__ int perm32(int rho) { const int n = rho >> 4, i = rho & 15; return 8 * (i >> 2) + 4 * n + (i & 3); }
struct Unit { int pm, pn; };
struct Gemm { const bf16_t* A; const bf16_t* Bt; int M, N, K, lda, ldb; };
struct StaticOrder {
    int nM, nN, nwg, G, c;
    __device__ void init(int M, int N, int G_, int c_) { nM = M / BM; nN = N / BM; nwg = nM * nN; G = G_; c = c_; }
    __device__ bool next(int i, Unit& u) const {
        const long L = (long)i * G + c; if (L >= nwg) return false;
        int wgid = (int)L; { const int q = nwg / NXCD, r = nwg % NXCD, xcd = wgid % NXCD, off = wgid / NXCD; wgid = (xcd < r ? xcd * (q + 1) : r * (q + 1) + (xcd - r) * q) + off; }
        const int nig = WGM * nN, gid = wgid / nig, fm = gid * WGM, gsz = (nM - fm) < WGM ? (nM - fm) : WGM;
        u.pm = fm + ((wgid % nig) % gsz); u.pn = (wgid % nig) / gsz; return true;
    }
};

template <class Epi>
__device__ __forceinline__ void gemm_phase(LAS unsigned char* lds, const Gemm g, const StaticOrder& S, const Epi& E, const int tid) {
    const int wid = __builtin_amdgcn_readfirstlane(tid >> 6), lane = tid & 63, wr = wid >> 2, wc = wid & 3, fr = lane & 15, fq = lane >> 4;
    const int K = g.K, nt = K / BK;
    unsigned voffA[2], voffB[2];
#pragma unroll
    for (int i = 0; i < 2; ++i) { int R, C; stage_rc(tid * 16 + i * 8192, R, C); const int Rb = Epi::PERM ? ((R & ~31) + perm32(R & 31)) : R;
        voffA[i] = (unsigned)(R * g.lda + C) * 2u; voffB[i] = (unsigned)(Rb * g.ldb + C) * 2u; }
    const size_t kstep = (size_t)(BK * 2);
    const size_t hstepA = (size_t)HALF * g.lda * 2, hstepB = (size_t)HALF * g.ldb * 2;
    const size_t tstepA = 2 * hstepA, tstepB = 2 * hstepB;
    const unsigned ldsw = (unsigned)wid * 1024u;
    const int aoff = lds_byte(wr * 64 + fr, fq * 8), boff = lds_byte(wc * 32 + fr, fq * 8);
#define PG8_SA(b, h) (((b) * 2 + (h)) * HTB)
#define PG8_SB(b, h) ((4 + (b) * 2 + (h)) * HTB)
#define PG8_STAGE(bufoff, gbase, voff) do { _Pragma("unroll") for (int _i = 0; _i < 2; ++_i) \
        __builtin_amdgcn_global_load_lds((const unsigned*)((const char*)(gbase) + (voff)[_i]), (LAS unsigned*)(lds + (bufoff) + ldsw + _i * 8192), 16, 0, 0); } while (0)
#define PG8_LDA(dst, b, h) do { _Pragma("unroll") for (int m = 0; m < 4; ++m) _Pragma("unroll") for (int k = 0; k < 2; ++k) dst[m][k] = *(const LAS bf16x8*)(lds + PG8_SA(b, h) + aoff + m * 2048 + k * 1024); } while (0)
#define PG8_LDB(dst, b, h) do { _Pragma("unroll") for (int n = 0; n < 2; ++n) _Pragma("unroll") for (int k = 0; k < 2; ++k) dst[n][k] = *(const LAS bf16x8*)(lds + PG8_SB(b, h) + boff + n * 2048 + k * 1024); } while (0)
#define PG8_MMA(ai, bj, At, Bt) do { __builtin_amdgcn_s_setprio(1); _Pragma("unroll") for (int m = 0; m < 4; ++m) _Pragma("unroll") for (int n = 0; n < 2; ++n) _Pragma("unroll") for (int k = 0; k < 2; ++k) \
        acc[ai][bj][m][n] = __builtin_amdgcn_mfma_f32_16x16x32_bf16(Bt[n][k], At[m][k], acc[ai][bj][m][n], 0, 0, 0); __builtin_amdgcn_s_setprio(0); } while (0)
#define PG8_WAIT_V(n) asm volatile("s_waitcnt vmcnt(" #n ")" ::: "memory")
#define PG8_WAIT_L(n) asm volatile("s_waitcnt lgkmcnt(" #n ")" ::: "memory")
#define PG8_BAR __builtin_amdgcn_s_barrier()
#define PG8_SCHED __builtin_amdgcn_sched_barrier(0)
    Unit cur, nxt; int ui = 0;
    if (!S.next(0, cur)) return;
    f32x4 acc[2][2][4][2];
#pragma unroll
    for (int a = 0; a < 2; ++a)
#pragma unroll
        for (int b = 0; b < 2; ++b)
#pragma unroll
            for (int m = 0; m < 4; ++m)
#pragma unroll
                for (int n = 0; n < 2; ++n) acc[a][b][m][n] = (f32x4){0.f, 0.f, 0.f, 0.f};
    bf16x8 At[4][2], B0[2][2], B1[2][2];
    const char* cA = (const char*)g.A + (size_t)cur.pm * tstepA; const char* cB = (const char*)g.Bt + (size_t)cur.pn * tstepB;
    PG8_STAGE(PG8_SB(0, 0), cB, voffB); PG8_STAGE(PG8_SA(0, 0), cA, voffA); PG8_STAGE(PG8_SB(0, 1), cB + hstepB, voffB); PG8_STAGE(PG8_SA(0, 1), cA + hstepA, voffA);
    if (wr == 1) PG8_BAR;
    PG8_WAIT_V(4); PG8_BAR;
    PG8_STAGE(PG8_SB(1, 0), cB + kstep, voffB); PG8_STAGE(PG8_SA(1, 0), cA + kstep, voffA); PG8_STAGE(PG8_SB(1, 1), cB + hstepB + kstep, voffB);
    PG8_WAIT_V(6); PG8_BAR;
    for (;;) {
        const bool has_next = S.next(ui + 1, nxt);
        const char* nA = has_next ? (const char*)g.A + (size_t)nxt.pm * tstepA : cA; const char* nB = has_next ? (const char*)g.Bt + (size_t)nxt.pn * tstepB : cB;
        for (int t = 0; t < nt; t += 2) {
            const bool last = (t == nt - 2);
            const char* a1 = cA + (size_t)(t + 1) * kstep;
            const char* a2 = last ? nA : cA + (size_t)(t + 2) * kstep; const char* b2 = last ? nB : cB + (size_t)(t + 2) * kstep;
            const char* a3 = a2 + kstep; const char* b3 = b2 + kstep;
            PG8_LDB(B0, 0, 0); PG8_SCHED; PG8_LDA(At, 0, 0); PG8_STAGE(PG8_SA(1, 1), a1 + hstepA, voffA);
            PG8_WAIT_L(8); PG8_BAR; PG8_WAIT_L(0); PG8_MMA(0, 0, At, B0); PG8_BAR; PG8_SCHED;
            PG8_LDB(B1, 0, 1); PG8_STAGE(PG8_SB(0, 0), b2, voffB);
            PG8_BAR; PG8_WAIT_L(0); PG8_MMA(0, 1, At, B1); PG8_BAR;
            PG8_LDA(At, 0, 1); PG8_STAGE(PG8_SA(0, 0), a2, voffA);
            PG8_BAR; PG8_WAIT_L(0); PG8_MMA(1, 0, At, B0); PG8_BAR; PG8_SCHED;
            PG8_STAGE(PG8_SB(0, 1), b2 + hstepB, voffB);
            PG8_WAIT_V(6); PG8_BAR; PG8_MMA(1, 1, At, B1); PG8_BAR;
            PG8_LDB(B0, 1, 0); PG8_SCHED; PG8_LDA(At, 1, 0); PG8_STAGE(PG8_SA(0, 1), a2 + hstepA, voffA);
            PG8_WAIT_L(8); PG8_BAR; PG8_WAIT_L(0); PG8_MMA(0, 0, At, B0); PG8_BAR; PG8_SCHED;
            PG8_LDB(B1, 1, 1); PG8_STAGE(PG8_SB(1, 0), b3, voffB);
            PG8_BAR; PG8_WAIT_L(0); PG8_MMA(0, 1, At, B1); PG8_BAR;
            PG8_LDA(At, 1, 1); PG8_STAGE(PG8_SA(1, 0), a3, voffA);
            PG8_BAR; PG8_WAIT_L(0); PG8_MMA(1, 0, At, B0); PG8_BAR; PG8_SCHED;
            PG8_STAGE(PG8_SB(1, 1), b3 + hstepB, voffB);
            PG8_WAIT_V(6); PG8_BAR; PG8_MMA(1, 1, At, B1); PG8_BAR;
        }
        E(acc, cur, wr, wc, fr, fq);
        if (!has_next) break;
#pragma unroll
        for (int a = 0; a < 2; ++a)
#pragma unroll
            for (int b = 0; b < 2; ++b)
#pragma unroll
                for (int m = 0; m < 4; ++m)
#pragma unroll
                    for (int n = 0; n < 2; ++n) acc[a][b][m][n] = (f32x4){0.f, 0.f, 0.f, 0.f};
        cur = nxt; cA = nA; cB = nB; ++ui;
    }
    PG8_WAIT_V(0);
    if (wr == 0) PG8_BAR;
    PG8_BAR;
#undef PG8_SA
#undef PG8_SB
#undef PG8_STAGE
#undef PG8_LDA
#undef PG8_LDB
#undef PG8_MMA
#undef PG8_WAIT_V
#undef PG8_WAIT_L
#undef PG8_BAR
#undef PG8_SCHED
}

struct EpiInProj {
    static constexpr bool PERM = true;
    bf16_t* proj; float* dtb; const float* rowss; int nt_main; bf16_t* tails; int tl_lo, tl_hi;
    __device__ __forceinline__ void operator()(const f32x4 (&acc)[2][2][4][2], const Unit& u, int wr, int wc, int fr, int fq) const {
        const int row0 = u.pm * BM + wr * 64 + fr;
#pragma unroll
        for (int ai = 0; ai < 2; ++ai)
#pragma unroll
            for (int m = 0; m < 4; ++m) {
                const int r = row0 + ai * HALF + m * 16;
                const f32x4* rp = (const f32x4*)(rowss + (size_t)r * 16);
                const f32x4 p0 = rp[0], p1 = rp[1], p2 = rp[2], p3 = rp[3];
                const float ss = ((p0[0] + p0[1]) + (p0[2] + p0[3])) + ((p1[0] + p1[1]) + (p1[2] + p1[3])) + ((p2[0] + p2[1]) + (p2[2] + p2[3])) + ((p3[0] + p3[1]) + (p3[2] + p3[3]));
                const float rstd = rsqrtf(ss * (1.0f / 1024.0f) + EPS);
                if (u.pn < nt_main) {
                    bf16_t* rowp = proj + (size_t)r * LDP + u.pn * BM + wc * 32 + 8 * fq;
#pragma unroll
                    for (int bj = 0; bj < 2; ++bj) { const f32x4 v0 = acc[ai][bj][m][0] * rstd, v1 = acc[ai][bj][m][1] * rstd;
                        u32x4 w; w.x = cvt_pk_bf16(v0[0], v0[1]); w.y = cvt_pk_bf16(v0[2], v0[3]); w.z = cvt_pk_bf16(v1[0], v1[1]); w.w = cvt_pk_bf16(v1[2], v1[3]);
                        *(u32x4*)(rowp + bj * HALF) = w;
                        if (u.pn >= tl_lo && u.pn < tl_hi && r < ROW_S0 && (r & 63) >= 61) *(u32x4*)(tails + ((size_t)(r >> 6) * 3 + ((r & 63) - 61)) * 4096 + (u.pn - tl_lo) * BM + wc * 32 + 8 * fq + bj * HALF) = w; }
                } else if (wc == 0) {
                    float* dp = dtb + (size_t)r * 32 + 8 * fq;
                    *(f32x4*)(dp) = acc[ai][0][m][0] * rstd; *(f32x4*)(dp + 4) = acc[ai][0][m][1] * rstd;
                }
            }
    }
};
struct EpiOutProj {
    static constexpr bool PERM = false;
    bf16_t* hb; float* rowss; bool dry;
    __device__ __forceinline__ void operator()(const f32x4 (&acc)[2][2][4][2], const Unit& u, int wr, int wc, int fr, int fq) const {
        const int row0 = u.pm * BM + wr * 64 + fr, col0 = u.pn * BM + wc * 32 + 4 * fq;
#pragma unroll
        for (int ai = 0; ai < 2; ++ai)
#pragma unroll
            for (int m = 0; m < 4; ++m) {
                const int r = row0 + ai * HALF + m * 16; float ss = 0.f;
                bf16_t* rowp = hb + (size_t)r * D + col0;
#pragma unroll
                for (int bj = 0; bj < 2; ++bj)
#pragma unroll
                    for (int n = 0; n < 2; ++n) {
                        u32x2* p = (u32x2*)(rowp + bj * HALF + n * 16); const u32x2 o = *p;
                        const f32x4 a = acc[ai][bj][m][n];
                        const float h0 = __uint_as_float(o.x << 16) + a[0], h1 = __uint_as_float(o.x & 0xffff0000u) + a[1];
                        const float h2 = __uint_as_float(o.y << 16) + a[2], h3 = __uint_as_float(o.y & 0xffff0000u) + a[3];
                        ss += (h0 * h0 + h1 * h1) + (h2 * h2 + h3 * h3);
                        u32x2 w; w.x = cvt_pk_bf16(h0, h1); w.y = cvt_pk_bf16(h2, h3); if (!dry) *p = w; else KEEP(w);
                    }
                ss += __shfl_xor(ss, 16); ss += __shfl_xor(ss, 32);
                if (fq == 0) { if (!dry) rowss[(size_t)r * 16 + u.pn * 4 + wc] = ss; else KEEP(ss); }
            }
    }
};
}

#define XB_TMO      128
#define XB_XCNT(j)  (256  + 64 * (j))
#define XB_XSUB(j)  (1280 + 64 * (j))
#define XB_XGEN(j)  (2304 + 64 * (j))
#define XB_TOP      3328
#define XB_TOPGEN   3392
#define XCD_BAR_WORDS 3456
#define XB_SPIN_CAP (1u << 24)
__device__ __forceinline__ unsigned xb_ld(unsigned* p)              { return __hip_atomic_load(p, __ATOMIC_RELAXED, __HIP_MEMORY_SCOPE_AGENT); }
__device__ __forceinline__ unsigned xb_add(unsigned* p, unsigned v) { return __hip_atomic_fetch_add(p, v, __ATOMIC_RELAXED, __HIP_MEMORY_SCOPE_AGENT); }
__device__ __forceinline__ unsigned xb_xcc_id() { return (unsigned)__builtin_amdgcn_s_getreg((3 << 11) | 20) & 0xFu; }
#define XB_SPIN(cond, bar) do { unsigned _sp = 0; while (cond) { __builtin_amdgcn_s_sleep(1); \
    if ((++_sp & 255u) == 0u) { if (xb_ld(&(bar)[XB_TMO])) break; if (_sp > XB_SPIN_CAP) { atomicAdd(&(bar)[XB_TMO], 1u); break; } } } } while (0)
struct XcdBarrier { unsigned* bar; unsigned x; volatile LAS unsigned* st; };
__device__ __forceinline__ XcdBarrier xcd_barrier_post(unsigned* bar, volatile LAS unsigned* st) {
    XcdBarrier b; b.bar = bar; b.x = xb_xcc_id(); b.st = st;
    if (threadIdx.x == 0) (void)xb_add(&bar[XB_XCNT(b.x)], 1u);
    return b;
}
__device__ __forceinline__ void xcd_barrier_complete(unsigned* bar, unsigned x, unsigned& nloc, unsigned& nx) {
    const unsigned G = gridDim.x * gridDim.y * gridDim.z;
    unsigned sum, cnt, mine, sp = 0u;
    for (;;) {
        sum = 0u; cnt = 0u; mine = 0u;
#pragma unroll
        for (unsigned j = 0; j < 16; ++j) { const unsigned c = xb_ld(&bar[XB_XCNT(j)]); sum += c; cnt += (c > 0u) ? 1u : 0u; mine = (j == x) ? c : mine; }
        if (sum == G) break;
        __builtin_amdgcn_s_sleep(1);
        if ((++sp & 255u) == 0u) { if (xb_ld(&bar[XB_TMO])) break; if (sp > XB_SPIN_CAP) { atomicAdd(&bar[XB_TMO], 1u); break; } }
    }
    nloc = mine > 0u ? mine : 1u; nx = cnt > 0u ? cnt : 1u;
}
__device__ __forceinline__ void xcd_barrier(const XcdBarrier& b) {
    asm volatile("s_waitcnt vmcnt(0)" ::: "memory");
    __syncthreads();
    if (threadIdx.x == 0) {
        unsigned* bar = b.bar;
        __builtin_amdgcn_s_waitcnt(0);
        unsigned nloc = b.st[0], nx = b.st[1];
        if (nloc == 0u) { xcd_barrier_complete(bar, b.x, nloc, nx); b.st[0] = nloc; b.st[1] = nx; }
        const unsigned old = xb_add(&bar[XB_XSUB(b.x)], 1u);
        const unsigned gen = old / nloc;
        if (old + 1u == (gen + 1u) * nloc) {
            __builtin_amdgcn_fence(__ATOMIC_RELEASE, "agent");
            asm volatile("s_waitcnt vmcnt(0)" ::: "memory");
            const unsigned og = xb_add(&bar[XB_TOP], 1u);
            const unsigned tg = og / nx;
            if (og + 1u == (tg + 1u) * nx) xb_add(&bar[XB_TOPGEN], 1u);
            else XB_SPIN(xb_ld(&bar[XB_TOPGEN]) == tg, bar);
            __builtin_amdgcn_fence(__ATOMIC_ACQUIRE, "agent");
            xb_add(&bar[XB_XGEN(b.x)], 1u);
            asm volatile("s_waitcnt vmcnt(0)" ::: "memory");
        } else {
            XB_SPIN(xb_ld(&bar[XB_XGEN(b.x)]) == gen, bar);
            __builtin_amdgcn_fence(__ATOMIC_ACQUIRE, "agent");
            asm volatile("s_waitcnt vmcnt(0)" ::: "memory");
        }
    }
    __syncthreads();
}

struct Args { const float* in[24]; float* out; unsigned char* ws; int ph_lo, ph_hi; };

struct Frame {
    const Args* ap; float* out; unsigned char* ws;
    __device__ __forceinline__ const float* inp(int i) const { asm volatile("" : "+s"(i)); return ap->in[i]; }
    unsigned char* lds; LAS unsigned char* ldsl;
    int tid, lane, wave, G, bid;
    bf16_t* hb; bf16_t* win; bf16_t* wout; float* dtb; float* rss; bf16_t* proj; bf16_t* tails;
};

__device__ __forceinline__ Frame relaunder(Frame F) {
    int t = F.tid; asm volatile("" : "+v"(t));
    F.tid = t; F.lane = t & 63; F.wave = __builtin_amdgcn_readfirstlane(t >> 6);
    unsigned char* w = F.ws; asm volatile("" : "+s"(w));
    F.ws = w; F.hb = (bf16_t*)(w + WS_HB); F.win = (bf16_t*)(w + WS_WIN); F.wout = (bf16_t*)(w + WS_WOUT);
    F.dtb = (float*)(w + WS_DTB); F.rss = (float*)(w + WS_RSS); F.proj = (bf16_t*)(w + WS_PROJ); F.tails = (bf16_t*)(w + WS_TAIL);
    return F;
}
__device__ void phase_init_h(const Frame& F0) {
    const Frame F = relaunder(F0);
    const float* xp = F.inp(0); const float* xs = F.inp(1); const float* meta = F.inp(6);
    for (int row = F.bid * 8 + F.wave; row < M_TOT; row += F.G * 8) {
        const float* src = nullptr;
        if (row < ROW_S0) { const int b = row / TPP, r = row % TPP; if (r >= 64) src = xp + ((size_t)b * SEQ + (r - 64)) * D; else if (r >= PADF) src = meta + (size_t)(r - PADF) * D; }
        else src = xs + (size_t)(row - ROW_S0) * D;
        float ss = 0.f;
#pragma unroll
        for (int i = 0; i < 4; ++i) {
            f32x4 v = (f32x4){0.f, 0.f, 0.f, 0.f};
            if (src) v = *(const f32x4*)(src + (F.lane + 64 * i) * 4);
            ss += (v[0] * v[0] + v[1] * v[1]) + (v[2] * v[2] + v[3] * v[3]);
            u32x2 w; w.x = cvt_pk_bf16(v[0], v[1]); w.y = cvt_pk_bf16(v[2], v[3]);
            *(u32x2*)(F.hb + (size_t)row * D + (F.lane + 64 * i) * 4) = w;
        }
        ss = wave_sum(ss);
        if (F.lane < 16) F.rss[(size_t)row * 16 + F.lane] = (F.lane == 0) ? ss : 0.f;
    }
}

__device__ void transpose_convert(const Frame& F, const float* src, int K, int N, int Npad, bf16_t* dst, const float* scale, int smod) {
    float* tile = (float*)F.lds;
    const int ntk = K / 64, ntn = Npad / 64, ntile = ntk * ntn;
    __syncthreads();
    for (int ti = F.bid; ti < ntile; ti += F.G) {
        const int kt = ti % ntk, nt_ = ti / ntk, k0 = kt * 64, n0 = nt_ * 64;
        const int kk = F.tid >> 4, n4 = (F.tid & 15) * 4;
#pragma unroll
        for (int h = 0; h < 2; ++h) {
            const int k = k0 + kk + 32 * h, n = n0 + n4;
            f32x4 v = (f32x4){0.f, 0.f, 0.f, 0.f};
            if (n < N) v = *(const f32x4*)(src + (size_t)k * N + n);
            const float s = scale[k % smod];
            float* tp = tile + (kk + 32 * h) * 65 + n4;
            tp[0] = v[0] * s; tp[1] = v[1] * s; tp[2] = v[2] * s; tp[3] = v[3] * s;
        }
        __syncthreads();
        const int nn = F.tid >> 3, kg = (F.tid & 7) * 8;
        float x[8];
#pragma unroll
        for (int j = 0; j < 8; ++j) x[j] = tile[(kg + j) * 65 + nn];
        u32x4 w; w.x = cvt_pk_bf16(x[0], x[1]); w.y = cvt_pk_bf16(x[2], x[3]); w.z = cvt_pk_bf16(x[4], x[5]); w.w = cvt_pk_bf16(x[6], x[7]);
        *(u32x4*)(dst + (size_t)(n0 + nn) * K + k0 + kg) = w;
        __syncthreads();
    }
}
__device__ void phase_wprep_in(const Frame& F0, int L) {
    const Frame F = relaunder(F0);
    const int j = L >> 1;
    if ((L & 1) == 0) transpose_convert(F, F.inp(8) + (size_t)j * D * SSD_IN, D, SSD_IN, SSD_IN_PAD, F.win, F.inp(7) + j * D, D);
    else transpose_convert(F, F.inp(17) + (size_t)j * D * GDN_IN, D, GDN_IN, GDN_IN_PAD, F.win, F.inp(16) + j * D, D);
}
__device__ void phase_wprep_out(const Frame& F0, int L) {
    const Frame F = relaunder(F0);
    const int j = L >> 1;
    if ((L & 1) == 0) transpose_convert(F, F.inp(15) + (size_t)j * SSD_INNER * D, SSD_INNER, D, D, F.wout, F.inp(14) + j * SSD_INNER, SSD_INNER);
    else transpose_convert(F, F.inp(22) + (size_t)j * GDN_VAL * D, GDN_VAL, D, D, F.wout, F.inp(21) + j * GDN_DV, GDN_DV);
}

__device__ void phase_inproj(const Frame& F0, int L) {
    const Frame F = relaunder(F0);
    const int npad = (L & 1) ? GDN_IN_PAD : SSD_IN_PAD;
    pg8::Gemm g{F.hb, F.win, M_TOT, npad, D, D, D};
    pg8::StaticOrder S; S.init(M_TOT, npad, F.G, F.bid);
    pg8::EpiInProj E{F.proj, F.dtb, F.rss, npad / 256 - 1, F.tails, (L & 1) ? 0 : 8, 16};
    pg8::gemm_phase<pg8::EpiInProj>(F.ldsl, g, S, E, F.tid);
}
__device__ void phase_outproj(const Frame& F0, int L, bool dry) {
    const Frame F = relaunder(F0);
    const bf16_t* A = F.proj + ((L & 1) ? 4096 : 0);
    pg8::Gemm g{A, F.wout, M_TOT, D, 2048, LDP, 2048};
    pg8::StaticOrder S; S.init(M_TOT, D, F.G, F.bid);
    pg8::EpiOutProj E{F.hb, F.rss, dry};
    pg8::gemm_phase<pg8::EpiOutProj>(F.ldsl, g, S, E, F.tid);
}

__device__ void phase_ssd_naive(const Frame& F0, int j) {
    const Frame F = relaunder(F0);
    float* xs = (float*)F.lds;
    float* Bs = xs + 64 * 64;
    float* Cs = Bs + 64 * 128;
    float* dts = Cs + 64 * 128;
    float* das = dts + 64;
    const float* conv_w = F.inp(9) + (size_t)j * 4 * SSD_CONV; const float* conv_b = F.inp(10) + (size_t)j * SSD_CONV;
    const int p = F.tid >> 3, nq = F.tid & 7;
    for (int task = F.bid; task < NSEQ * SSD_HEADS; task += F.G) {
        const int s = task / SSD_HEADS, head = task % SSD_HEADS, grp = head >> 3;
        const int base = seq_base(s), nch = seq_chunks(s);
        const float dt_bias = F.inp(11)[j * SSD_HEADS + head], a = -__expf(F.inp(12)[j * SSD_HEADS + head]), dsk = F.inp(13)[j * SSD_HEADS + head];
        float h[16];
        if (s < 2) {
#pragma unroll
            for (int n = 0; n < 16; ++n) h[n] = 0.f;
        } else {
            const float* st = F.inp(2) + ((((size_t)j * 8 + (s - 2)) * SSD_HEADS + head) * SSD_P + p) * SSD_N + nq * 16;
#pragma unroll
            for (int n = 0; n < 16; ++n) h[n] = st[n];
        }
        int cidx = -1;
        if (F.tid < 64) cidx = head * 64 + F.tid; else if (F.tid < 192) cidx = 2048 + grp * 128 + (F.tid - 64); else if (F.tid < 320) cidx = 2560 + grp * 128 + (F.tid - 192);
        float w0 = 0, w1 = 0, w2 = 0, w3 = 0, cb = 0;
        if (cidx >= 0) { w0 = conv_w[cidx]; w1 = conv_w[SSD_CONV + cidx]; w2 = conv_w[2 * SSD_CONV + cidx]; w3 = conv_w[3 * SSD_CONV + cidx]; cb = conv_b[cidx]; }
        const float* cst = (s >= 2) ? F.inp(3) + (((size_t)j * 8 + (s - 2)) * 3) * SSD_CONV : nullptr;
        for (int c = 0; c < nch; ++c) {
            const int t0 = 64 * c - PADF;
            __syncthreads();
            if (cidx >= 0) {
                float r3, r2, r1;
                {   float rv[3];
#pragma unroll
                    for (int q = 0; q < 3; ++q) { const int t = t0 - 3 + q; float v = 0.f;
                        if (t >= 0) v = bf2f(F.proj[(size_t)(base + t) * LDP + 2048 + cidx]); else if (t >= -3 && cst) v = cst[(3 + t) * SSD_CONV + cidx];
                        rv[q] = v; }
                    r3 = rv[0]; r2 = rv[1]; r1 = rv[2]; }
                for (int i = 0; i < 64; ++i) {
                    const int t = t0 + i; float v = 0.f;
                    if (t >= 0) v = bf2f(F.proj[(size_t)(base + t) * LDP + 2048 + cidx]); else if (t >= -3 && cst) v = cst[(3 + t) * SSD_CONV + cidx];
                    const float o = silu_f(cb + w0 * r3 + w1 * r2 + w2 * r1 + w3 * v);
                    r3 = r2; r2 = r1; r1 = v;
                    if (F.tid < 64) xs[i * 64 + F.tid] = o; else if (F.tid < 192) Bs[i * 128 + (F.tid - 64)] = o; else Cs[i * 128 + (F.tid - 192)] = o;
                }
            } else if (F.tid >= 448) {
                const int i = F.tid - 448, t = t0 + i;
                float dt = 0.f, da = 1.f;
                if (t >= 0) { dt = softplus_f(F.dtb[(size_t)(base + t) * 32 + head] + dt_bias); da = __expf(dt * a); }
                dts[i] = dt; das[i] = da;
            }
            __syncthreads();
            for (int i = 0; i < 64; ++i) {
                const int t = t0 + i;
                const float dt = dts[i], da = das[i], xv = xs[i * 64 + p], dx = dt * xv;
                const float* bp = Bs + i * 128 + nq * 16; const float* cp = Cs + i * 128 + nq * 16;
                float accv = 0.f;
#pragma unroll
                for (int n = 0; n < 16; ++n) { h[n] = h[n] * da + dx * bp[n]; accv += cp[n] * h[n]; }
                accv += __shfl_xor(accv, 1); accv += __shfl_xor(accv, 2); accv += __shfl_xor(accv, 4);
                if (nq == 0 && t >= 0) {
                    bf16_t* zp = F.proj + (size_t)(base + t) * LDP + head * 64 + p;
                    const float z = bf2f(*zp);
                    *zp = f2bf((accv + dsk * xv) * silu_f(z));
                }
            }
        }
        float* so = (s < 2) ? F.out + O_PSSD + ((((size_t)j * 2 + s) * SSD_HEADS + head) * SSD_P + p) * SSD_N + nq * 16
                            : F.out + O_SSSD + ((((size_t)j * 8 + (s - 2)) * SSD_HEADS + head) * SSD_P + p) * SSD_N + nq * 16;
#pragma unroll
        for (int n = 0; n < 16; ++n) so[n] = h[n];
    }
}


__device__ __forceinline__ int* prog_ptr(const Frame& F, int L, int seq, int head) { return (int*)(F.ws + WS_PROG) + (L * 10 + seq) * 32 + head; }
__device__ __forceinline__ void store16_wt(const void* base, unsigned bytes, unsigned off, u32x4 w) {
    const __amdgpu_buffer_rsrc_t rs = __builtin_amdgcn_make_buffer_rsrc((void*)base, 0, bytes, 0x00020000);
    __builtin_amdgcn_raw_buffer_store_b128(w, rs, off, 0, 16);
}
__device__ __forceinline__ void wait_tiles(const Frame& F, int* p, int n, int target) {
    if (F.tid < n) {
        unsigned spins = 0;
        while (__hip_atomic_load(p + F.tid, __ATOMIC_RELAXED, __HIP_MEMORY_SCOPE_AGENT) < target) { __builtin_amdgcn_s_sleep(32); if (++spins > (1u << 16)) break; }
    }
    if (F.tid < 64) { __builtin_amdgcn_fence(__ATOMIC_ACQUIRE, "agent"); asm volatile("s_waitcnt vmcnt(0)" ::: "memory"); }
    __syncthreads();
}

template <bool DRY> __device__ __forceinline__ void ssd_post_task(const Frame& F, int cgi, int grp);
template <bool DRY> __device__ __forceinline__ void gdn_post_task(const Frame& F, int cgi, int head);

constexpr int NCHT = 266;
constexpr size_t SC_BT = 0;
constexpr size_t SC_C = SC_BT + (size_t)NCHT * 4 * 16384;
constexpr size_t SC_CB = SC_C + (size_t)NCHT * 4 * 16384;
constexpr size_t SC_VEC = SC_CB + (size_t)NCHT * 4 * 8192;
constexpr size_t SC_XS = SC_VEC + (size_t)NCHT * 32 * 1024;
constexpr size_t SC_SSD_END = SC_XS + (size_t)256 * 8192;
static_assert(SC_SSD_END <= (size_t)16777216 * 4, "scratch must fit the y_prompt region");
__device__ __forceinline__ int qperm(int s) { return (s & ~31) | (((s >> 2) & 3) << 3) | (((s >> 4) & 1) << 2) | (s & 3); }
__device__ __forceinline__ int qnat(int q) { return (q & ~31) | (((q >> 2) & 1) << 4) | (((q >> 3) & 3) << 2) | (q & 3); }
__device__ __forceinline__ bf16x8 pack8(f32x4 a, f32x4 b) {
    u32x4 w; w.x = cvt_pk_bf16(a[0], a[1]); w.y = cvt_pk_bf16(a[2], a[3]); w.z = cvt_pk_bf16(b[0], b[1]); w.w = cvt_pk_bf16(b[2], b[3]);
    return __builtin_bit_cast(bf16x8, w);
}
__device__ __forceinline__ void chunk_of(int cgi, int& seq, int& c) { if (cgi < 258) { seq = cgi / 129; c = cgi % 129; } else { seq = 2 + (cgi - 258); c = 0; } }
__device__ __forceinline__ int cgi_of(int seq, int c) { return seq < 2 ? seq * 129 + c : 258 + (seq - 2); }
struct XTile { bf16_t* p; int stride; };
__device__ __forceinline__ XTile ssd_xtile(const Frame& F, int seq, int c, int head) {
    XTile t;
    if (seq < 2) { t.p = F.proj + (size_t)(seq * TPP + 64 * c) * LDP + 2048 + head * 64; t.stride = LDP; }
    else { t.p = (bf16_t*)((unsigned char*)F.out + SC_XS) + (size_t)((seq - 2) * 32 + head) * 4096; t.stride = 64; }
    return t;
}

template <bool DRY>
__device__ void phase_ssd_prep(const Frame& F0, int j) {
    const Frame F = relaunder(F0);
    bf16_t* Bs = (bf16_t*)F.lds;
    bf16_t* Cs = Bs + 64 * 136;
    unsigned char* sc = (unsigned char*)F.out;
    const float* conv_w = F.inp(9) + (size_t)j * 4 * SSD_CONV; const float* conv_b = F.inp(10) + (size_t)j * SSD_CONV;
    const int i16 = F.lane & 15, g4 = F.lane >> 4;
    for (int task = F.bid; task < NCHT * 4; task += F.G) {
        const int cgi = task >> 2, grp = task & 3; int seq, c; chunk_of(cgi, seq, c);
        const int base = seq_base(seq), t0 = 64 * c - PADF;
        __syncthreads();
        {
            const int hl = F.tid >> 6, p = F.tid & 63, head = grp * 8 + hl, cidx = head * 64 + p;
            const float w0 = conv_w[cidx], w1 = conv_w[SSD_CONV + cidx], w2 = conv_w[2 * SSD_CONV + cidx], w3 = conv_w[3 * SSD_CONV + cidx], cb = conv_b[cidx];
            float r3 = 0.f, r2 = 0.f, r1 = 0.f;
            if (seq < 2 && c > 0) { const bf16_t* tp = F.tails + (size_t)(cgi - 1) * 3 * 4096 + cidx; r3 = bf2f(tp[0]); r2 = bf2f(tp[4096]); r1 = bf2f(tp[2 * 4096]); }
            else if (seq >= 2) { const float* cst = F.inp(3) + (((size_t)j * 8 + (seq - 2)) * 3) * SSD_CONV + cidx; r3 = cst[0]; r2 = cst[SSD_CONV]; r1 = cst[2 * SSD_CONV]; }
            const bf16_t* xcol = F.proj + 2048 + cidx;
            bf16_t* xrow = (bf16_t*)F.lds + F.tid * 72;
#pragma unroll 1
            for (int pg = 0; pg < 2; ++pg) {
                unsigned short raw[32];
#pragma unroll
                for (int e = 0; e < 32; ++e) { const int t = t0 + 32 * pg + e; raw[e] = xcol[(size_t)(base + (t > 0 ? t : 0)) * LDP]; }
#pragma unroll
                for (int e8 = 0; e8 < 4; ++e8) {
                    float o[8];
#pragma unroll
                    for (int h = 0; h < 8; ++h) {
                        const int t = t0 + 32 * pg + 8 * e8 + h;
                        const float v = (t >= 0) ? bf2f(raw[8 * e8 + h]) : 0.f;
                        o[h] = silu_f(cb + w0 * r3 + w1 * r2 + w2 * r1 + w3 * v);
                        if (t >= 0) { r3 = r2; r2 = r1; r1 = v; }
                    }
                    u32x4 w; w.x = cvt_pk_bf16(o[0], o[1]); w.y = cvt_pk_bf16(o[2], o[3]); w.z = cvt_pk_bf16(o[4], o[5]); w.w = cvt_pk_bf16(o[6], o[7]);
                    *(u32x4*)(xrow + 32 * pg + 8 * e8) = w;
                }
            }
            __syncthreads();
            const XTile xt = ssd_xtile(F, seq, c, head);
#pragma unroll
            for (int q = 0; q < 8; ++q) { const u32x4 w = *(const u32x4*)(xrow + 8 * q);
                if (!DRY) *(u32x4*)(xt.p + (size_t)p * xt.stride + 8 * q) = w; else KEEP(w); }
        }
        __syncthreads();
        {
            const int ch = F.tid & 255, half = F.tid >> 8, isC = ch >> 7, n = ch & 127;
            const int cidx = 2048 + isC * 512 + grp * 128 + n;
            const float w0 = conv_w[cidx], w1 = conv_w[SSD_CONV + cidx], w2 = conv_w[2 * SSD_CONV + cidx], w3 = conv_w[3 * SSD_CONV + cidx], cb = conv_b[cidx];
            const float* cst = (seq >= 2) ? F.inp(3) + (((size_t)j * 8 + (seq - 2)) * 3) * SSD_CONV : nullptr;
            bf16_t* dst = (isC ? Cs : Bs) + n;
            const bf16_t* col = F.proj + 2048 + cidx;
            unsigned short raw[35];
#pragma unroll
            for (int e = 0; e < 35; ++e) { const int t = t0 + half * 32 - 3 + e; raw[e] = col[(size_t)(base + (t > 0 ? t : 0)) * LDP]; }
            float r3, r2, r1;
            {   float rv[3];
#pragma unroll
                for (int q = 0; q < 3; ++q) { const int t = t0 + half * 32 - 3 + q; float v = 0.f;
                    if (t >= 0) v = bf2f(raw[q]); else if (t >= -3 && cst) v = cst[(3 + t) * SSD_CONV + cidx];
                    rv[q] = v; }
                r3 = rv[0]; r2 = rv[1]; r1 = rv[2]; }
#pragma unroll
            for (int ii = 0; ii < 32; ++ii) {
                const int p = half * 32 + ii, t = t0 + p; float v = 0.f;
                if (t >= 0) v = bf2f(raw[ii + 3]); else if (t >= -3 && cst) v = cst[(3 + t) * SSD_CONV + cidx];
                const float o = silu_f(cb + w0 * r3 + w1 * r2 + w2 * r1 + w3 * v);
                r3 = r2; r2 = r1; r1 = v;
                dst[p * 136] = f2bf(o);
            }
        }
        __syncthreads();
        {
            bf16_t* BT = (bf16_t*)(sc + SC_BT) + (size_t)(cgi * 4 + grp) * 8192;
            const int n = F.tid >> 2, qg = (F.tid & 3) * 16;
#pragma unroll
            for (int u = 0; u < 2; ++u) {
                const int q0 = qg + 8 * u; unsigned short e[8];
#pragma unroll
                for (int jj = 0; jj < 8; ++jj) e[jj] = Bs[qnat(q0 + jj) * 136 + n];
                u32x4 w; w.x = e[0] | ((unsigned)e[1] << 16); w.y = e[2] | ((unsigned)e[3] << 16); w.z = e[4] | ((unsigned)e[5] << 16); w.w = e[6] | ((unsigned)e[7] << 16);
                if (!DRY) *(u32x4*)(BT + n * 64 + q0) = w; else KEEP(w);
            }
            bf16_t* Cg = (bf16_t*)(sc + SC_C) + (size_t)(cgi * 4 + grp) * 8192;
#pragma unroll
            for (int u = 0; u < 2; ++u) {
                const int idx = F.tid + 512 * u, l = idx >> 4, qg8 = idx & 15, kk = qg8 >> 2, gg = qg8 & 3;
                const u32x2 a = *(const u32x2*)(Cs + l * 136 + 32 * kk + 4 * gg), b = *(const u32x2*)(Cs + l * 136 + 32 * kk + 16 + 4 * gg);
                u32x4 w; w.x = a.x; w.y = a.y; w.z = b.x; w.w = b.y;
                if (!DRY) *(u32x4*)(Cg + l * 128 + 8 * qg8) = w; else KEEP(w);
            }
        }
        {
            bf16_t* CB = (bf16_t*)(sc + SC_CB) + (size_t)(cgi * 4 + grp) * 4096;
            const int m = F.wave >> 1;
#pragma unroll
            for (int u = 0; u < 2; ++u) {
                const int st = 2 * (F.wave & 1) + u; f32x4 acc = (f32x4){0.f, 0.f, 0.f, 0.f};
#pragma unroll
                for (int kk = 0; kk < 4; ++kk) {
                    const bf16x8 a = *(const bf16x8*)(Cs + (16 * m + i16) * 136 + 32 * kk + 8 * g4);
                    const bf16x8 b = *(const bf16x8*)(Bs + (16 * st + i16) * 136 + 32 * kk + 8 * g4);
                    acc = __builtin_amdgcn_mfma_f32_16x16x32_bf16(a, b, acc, 0, 0, 0);
                }
                const int qs = qperm(16 * st + i16);
#pragma unroll
                for (int jj = 0; jj < 4; ++jj) { if (!DRY) CB[(16 * m + 4 * g4 + jj) * 64 + qs] = f2bf(acc[jj]); else KEEP(acc[jj]); }
            }
        }
        {
            const int head = grp * 8 + F.wave, t = t0 + F.lane;
            const float a = -__expf(F.inp(12)[j * SSD_HEADS + head]);
            float dt = 0.f;
            if (t >= 0) dt = softplus_f(F.dtb[(size_t)(base + t) * 32 + head] + F.inp(11)[j * SSD_HEADS + head]);
            float cs = dt * a;
#pragma unroll
            for (int o = 1; o < 64; o <<= 1) { const float y = __shfl_up(cs, o); if (F.lane >= o) cs += y; }
            const float cs_last = __shfl(cs, 63), cs_be = __shfl(cs, F.lane | 3);
            float* vp = (float*)(sc + SC_VEC) + (size_t)(cgi * 32 + head) * 256;
            const float v1 = __expf(cs_be - cs) * dt, v2 = dt * __expf(cs_last - cs), v3 = __expf(cs);
            if (!DRY) { vp[F.lane] = cs; vp[64 + F.lane] = v1; vp[128 + F.lane] = v2; vp[192 + F.lane] = v3; } else { KEEP(v1); KEEP(v2); KEEP(v3); }
        }
    }
}

constexpr int SL_C = 0, SL_BT = 16384, SL_M = 32768, SL_XT = 40960, SL_VEC = 49152, SL_SIZE = 50176;
#define PD(d) P[11 + ((d) >> 2)][(d) & 3]
__device__ __forceinline__ void ssd_stage_load(u32x4 (&P)[15], const Frame& F, const unsigned char* sc, int lt, int seq, int head, int c) {
    const int cgi = cgi_of(seq, c), grp = head >> 3;
    const bf16_t* Cp = (const bf16_t*)(sc + SC_C) + (size_t)(cgi * 4 + grp) * 8192;
    const bf16_t* BTp = (const bf16_t*)(sc + SC_BT) + (size_t)(cgi * 4 + grp) * 8192;
    const bf16_t* CBp = (const bf16_t*)(sc + SC_CB) + (size_t)(cgi * 4 + grp) * 4096;
    const float* vp = (const float*)(sc + SC_VEC) + (size_t)(cgi * 32 + head) * 256;
    const XTile xt = ssd_xtile(F, seq, c, head);
#pragma unroll
    for (int r = 0; r < 4; ++r) { const int k = lt + 256 * r; P[r] = *(const u32x4*)(Cp + k * 8); P[4 + r] = *(const u32x4*)(BTp + k * 8); }
#pragma unroll
    for (int r = 0; r < 2; ++r) { const int k = lt + 256 * r, l = k >> 3, ch = k & 7, sa = 32 * (ch >> 2) + 4 * (ch & 3);
        P[8 + r] = *(const u32x4*)(CBp + k * 8); PD(3 * r) = __float_as_uint(vp[l]); PD(3 * r + 1) = __float_as_uint(vp[sa + 3]); PD(3 * r + 2) = __float_as_uint(vp[sa + 19]);
        P[13 + r] = *(const u32x4*)(xt.p + (size_t)l * xt.stride + ch * 8); }
    P[10] = *(const u32x4*)(vp + 64 + 4 * (lt < 48 ? lt : 0));
}
__device__ __forceinline__ void ssd_stage_write(const u32x4 (&P)[15], LAS unsigned char* img, int lt) {
#pragma unroll
    for (int r = 0; r < 4; ++r) { const int k = lt + 256 * r;
        { const int row = k >> 4, ch = k & 15; *(LAS u32x4*)(img + SL_C + (row * 16 + (ch ^ (row & 15))) * 16) = P[r]; }
        { const int row = k >> 3, ch = k & 7; *(LAS u32x4*)(img + SL_BT + (row * 8 + (ch ^ ((row >> 1) & 7))) * 16) = P[4 + r]; } }
#pragma unroll
    for (int r = 0; r < 2; ++r) {
        const int k = lt + 256 * r, l = k >> 3, ch = k & 7, sa = 32 * (ch >> 2) + 4 * (ch & 3), sb = sa + 16;
        const float csl = __uint_as_float(PD(3 * r)), e1a = __expf(csl - __uint_as_float(PD(3 * r + 1))), e1b = __expf(csl - __uint_as_float(PD(3 * r + 2)));
        const u32x4 cbw = P[8 + r]; f32x4 va, vb;
        va[0] = (sa + 0 <= l) ? __uint_as_float(cbw.x << 16) * e1a : 0.f; va[1] = (sa + 1 <= l) ? __uint_as_float(cbw.x & 0xffff0000u) * e1a : 0.f;
        va[2] = (sa + 2 <= l) ? __uint_as_float(cbw.y << 16) * e1a : 0.f; va[3] = (sa + 3 <= l) ? __uint_as_float(cbw.y & 0xffff0000u) * e1a : 0.f;
        vb[0] = (sb + 0 <= l) ? __uint_as_float(cbw.z << 16) * e1b : 0.f; vb[1] = (sb + 1 <= l) ? __uint_as_float(cbw.z & 0xffff0000u) * e1b : 0.f;
        vb[2] = (sb + 2 <= l) ? __uint_as_float(cbw.w << 16) * e1b : 0.f; vb[3] = (sb + 3 <= l) ? __uint_as_float(cbw.w & 0xffff0000u) * e1b : 0.f;
        u32x4 w; w.x = cvt_pk_bf16(va[0], va[1]); w.y = cvt_pk_bf16(va[2], va[3]); w.z = cvt_pk_bf16(vb[0], vb[1]); w.w = cvt_pk_bf16(vb[2], vb[3]);
        const int slot = l * 8 + (ch ^ ((l >> 1) & 7));
        *(LAS u32x4*)(img + SL_M + slot * 16) = w;
        *(LAS u32x4*)(img + SL_XT + slot * 16) = P[13 + r];
    }
    if (lt < 48) *(LAS u32x4*)(img + SL_VEC + 16 * lt) = P[10];
}
template <bool DRY>
__device__ __forceinline__ void ssd_ytile_out(const LAS unsigned char* img, const XTile& xt, int lt) {
#pragma unroll
    for (int r = 0; r < 2; ++r) { const int k = lt + 256 * r, p = k >> 3, ch = k & 7;
        const u32x4 w = *(const LAS u32x4*)(img + SL_XT + (p * 8 + (ch ^ ((p >> 1) & 7))) * 16);
        if (!DRY) store16_wt(xt.p, 64u * xt.stride * 2u, (unsigned)(p * xt.stride + ch * 8) * 2u, w); else KEEP(w); }
}
template <bool DRY>
__device__ void phase_ssd_chain(const Frame& F0, int j) {
    const Frame F = relaunder(F0);
    const unsigned char* sc = (const unsigned char*)F.out;
    const bool loader = F.wave >= 4; const int lt = F.tid - 256, ps = F.wave & 3;
    for (int sh = F.bid; sh < 320; sh += (F.bid < 64 && F.G > 64) ? 320 : (F.G > 64 ? F.G - 64 : F.G)) {
        const int seq = sh < 64 ? (sh >> 5) : 2 + ((sh - 64) >> 5), head = sh & 31;
        const int nch = seq_chunks(seq);
        const float dsk = F.inp(13)[j * SSD_HEADS + head];
        int* prog = prog_ptr(F, 2 * j, seq, head);
        __syncthreads();
        if (loader) {
            u32x4 A[15], B[15];
            ssd_stage_load(A, F, sc, lt, seq, head, 0); ssd_stage_write(A, F.ldsl, lt);
            if (nch > 1) ssd_stage_load(B, F, sc, lt, seq, head, 1);
            if (nch > 2) ssd_stage_load(A, F, sc, lt, seq, head, 2);
            __syncthreads();
#define SSD_LOADER_STEP(CC, ST) { const int cc_ = (CC); int nxt = ((cc_ + 1) & 1) * SL_SIZE, lt_ = lt; asm volatile("" : "+s"(nxt), "+v"(lt_)); \
                if (cc_ + 1 < nch) ssd_stage_write(ST, F.ldsl + nxt, lt_); \
                if (cc_ + 3 < nch) ssd_stage_load(ST, F, sc, lt_, seq, head, cc_ + 3); \
                __syncthreads(); }
            for (int c = 0; c < nch; c += 2) {
                SSD_LOADER_STEP(c, B)
                if (c + 1 < nch) SSD_LOADER_STEP(c + 1, A)
            }
#undef SSD_LOADER_STEP
        } else {
            f32x4 HT[8];
#pragma unroll
            for (int m8 = 0; m8 < 8; ++m8) HT[m8] = (f32x4){0.f, 0.f, 0.f, 0.f};
            if (seq >= 2) {
                const int i = F.lane & 15, g = F.lane >> 4;
                const float* st = F.inp(2) + ((((size_t)j * 8 + (seq - 2)) * SSD_HEADS + head) * SSD_P + ps * 16 + i) * SSD_N + 4 * g;
#pragma unroll
                for (int m8 = 0; m8 < 8; ++m8) HT[m8] = *(const f32x4*)(st + 16 * m8);
            }
            __syncthreads();
            for (int c = 0; c < nch; ++c) {
                int cur = (c & 1) * SL_SIZE, lane_ = F.lane;
                asm volatile("" : "+s"(cur), "+v"(lane_));
                LAS unsigned char* img = F.ldsl + cur;
                const int i = lane_ & 15, g = lane_ >> 4, prow = ps * 16 + i, psw = (prow >> 1) & 7;
                const LAS unsigned char* pc[4]; const LAS unsigned char* pm[2];
#pragma unroll
                for (int kk = 0; kk < 4; ++kk) pc[kk] = img + SL_C + i * 256 + (((4 * kk + g) ^ i) * 16);
#pragma unroll
                for (int k2 = 0; k2 < 2; ++k2) pm[k2] = img + i * 128 + (((4 * k2 + g) ^ (i >> 1)) * 16);
                const float ecl = *(const LAS float*)(img + SL_VEC + 512 + 63 * 4);
                bf16x8 Hf[4];
#pragma unroll
                for (int kk = 0; kk < 4; ++kk) Hf[kk] = pack8(HT[2 * kk], HT[2 * kk + 1]);
                f32x4 Y[4];
                bf16x8 cf[2][4]; u32x2 xw[4];
#pragma unroll
                for (int kk = 0; kk < 4; ++kk) cf[0][kk] = *(const LAS bf16x8*)(pc[kk]);
                LAS unsigned char* xrow = img + SL_XT + prow * 128 + 8 * (g & 1);
#pragma unroll
                for (int m = 0; m < 4; ++m) xw[m] = *(const LAS u32x2*)(xrow + ((2 * m + (g >> 1)) ^ psw) * 16);
#pragma unroll
                for (int m = 0; m < 4; ++m) {
                    if (m < 3) {
#pragma unroll
                        for (int kk = 0; kk < 4; ++kk) cf[(m + 1) & 1][kk] = *(const LAS bf16x8*)(pc[kk] + (m + 1) * 4096);
                    }
                    f32x4 acc = (f32x4){0.f, 0.f, 0.f, 0.f};
#pragma unroll
                    for (int kk = 0; kk < 4; ++kk) acc = __builtin_amdgcn_mfma_f32_16x16x32_bf16(cf[m & 1][kk], Hf[kk], acc, 0, 0, 0);
                    Y[m] = acc * *(const LAS f32x4*)(img + SL_VEC + 512 + (16 * m + 4 * g) * 4);
                }
                f32x4 xv[4];
#pragma unroll
                for (int m = 0; m < 4; ++m) { xv[m][0] = __uint_as_float(xw[m].x << 16); xv[m][1] = __uint_as_float(xw[m].x & 0xffff0000u); xv[m][2] = __uint_as_float(xw[m].y << 16); xv[m][3] = __uint_as_float(xw[m].y & 0xffff0000u); }
                bf16x8 xsf[2], xwf[2];
#pragma unroll
                for (int k2 = 0; k2 < 2; ++k2) {
                    const f32x4 ea = *(const LAS f32x4*)(img + SL_VEC + (32 * k2 + 4 * g) * 4), eb = *(const LAS f32x4*)(img + SL_VEC + (32 * k2 + 16 + 4 * g) * 4);
                    const f32x4 wa = *(const LAS f32x4*)(img + SL_VEC + 256 + (32 * k2 + 4 * g) * 4), wb = *(const LAS f32x4*)(img + SL_VEC + 256 + (32 * k2 + 16 + 4 * g) * 4);
                    xsf[k2] = pack8(xv[2 * k2] * ea, xv[2 * k2 + 1] * eb); xwf[k2] = pack8(xv[2 * k2] * wa, xv[2 * k2 + 1] * wb); }
                bf16x8 mf[2][2][2];
#pragma unroll
                for (int q = 0; q < 2; ++q)
#pragma unroll
                    for (int k2 = 0; k2 < 2; ++k2) mf[0][q][k2] = *(const LAS bf16x8*)(pm[k2] + SL_M + q * 2048);
                bf16x8 bf[2][2][2];
#pragma unroll
                for (int h = 0; h < 2; ++h) {
                    if (h == 0) {
#pragma unroll
                        for (int q = 0; q < 2; ++q)
#pragma unroll
                            for (int k2 = 0; k2 < 2; ++k2) mf[1][q][k2] = *(const LAS bf16x8*)(pm[k2] + SL_M + (2 + q) * 2048);
                    } else {
#pragma unroll
                        for (int q = 0; q < 2; ++q)
#pragma unroll
                            for (int k2 = 0; k2 < 2; ++k2) bf[0][q][k2] = *(const LAS bf16x8*)(pm[k2] + SL_BT + q * 2048);
                    }
#pragma unroll
                    for (int q = 0; q < 2; ++q)
#pragma unroll
                        for (int k2 = 0; k2 < 2; ++k2) Y[2 * h + q] = __builtin_amdgcn_mfma_f32_16x16x32_bf16(mf[h][q][k2], xsf[k2], Y[2 * h + q], 0, 0, 0);
                }
#pragma unroll
                for (int h = 0; h < 4; ++h) {
                    if (h < 3) {
#pragma unroll
                        for (int q = 0; q < 2; ++q)
#pragma unroll
                            for (int k2 = 0; k2 < 2; ++k2) bf[(h + 1) & 1][q][k2] = *(const LAS bf16x8*)(pm[k2] + SL_BT + (2 * (h + 1) + q) * 2048);
                    }
#pragma unroll
                    for (int q = 0; q < 2; ++q) {
                        const int m8 = 2 * h + q;
                        f32x4 acc = HT[m8] * ecl;
#pragma unroll
                        for (int k2 = 0; k2 < 2; ++k2) acc = __builtin_amdgcn_mfma_f32_16x16x32_bf16(bf[h & 1][q][k2], xwf[k2], acc, 0, 0, 0);
                        HT[m8] = acc;
                    }
                }
                {
                    const XTile xt = ssd_xtile(F, seq, c, head);
                    u32x2 yw[4];
#pragma unroll
                    for (int m = 0; m < 4; ++m) { const f32x4 y = Y[m] + xv[m] * dsk; yw[m].x = cvt_pk_bf16(y[0], y[1]); yw[m].y = cvt_pk_bf16(y[2], y[3]); }
#pragma unroll
                    for (int q = 0; q < 2; ++q) {
                        const u32x2 snd = (g & 1) ? yw[2 * q] : yw[2 * q + 1];
                        u32x2 rcv; rcv.x = __shfl_xor(snd.x, 16); rcv.y = __shfl_xor(snd.y, 16);
                        u32x4 w; int l0;
                        if (g & 1) { w.x = rcv.x; w.y = rcv.y; w.z = yw[2 * q + 1].x; w.w = yw[2 * q + 1].y; l0 = 32 * q + 16 + 4 * (g - 1); }
                        else { w.x = yw[2 * q].x; w.y = yw[2 * q].y; w.z = rcv.x; w.w = rcv.y; l0 = 32 * q + 4 * g; }
                        if (!DRY) store16_wt(xt.p, 64u * xt.stride * 2u, (unsigned)(prow * xt.stride + l0) * 2u, w); else KEEP(w);
                    }
                    if (!DRY && c >= 2) { asm volatile("s_waitcnt vmcnt(6)" ::: "memory"); if (lane_ == 0) __hip_atomic_fetch_add(prog, 1, __ATOMIC_RELAXED, __HIP_MEMORY_SCOPE_AGENT); }
                }
                __syncthreads();
            }
            if (!DRY) { asm volatile("s_waitcnt vmcnt(0)" ::: "memory"); if (F.lane == 0) __hip_atomic_fetch_add(prog, nch < 2 ? nch : 2, __ATOMIC_RELAXED, __HIP_MEMORY_SCOPE_AGENT); }
            const int i = F.lane & 15, g = F.lane >> 4;
            float* so = (seq < 2) ? F.out + O_PSSD + ((((size_t)j * 2 + seq) * SSD_HEADS + head) * SSD_P + ps * 16 + i) * SSD_N + 4 * g
                                  : F.out + O_SSSD + ((((size_t)j * 8 + (seq - 2)) * SSD_HEADS + head) * SSD_P + ps * 16 + i) * SSD_N + 4 * g;
#pragma unroll
            for (int m8 = 0; m8 < 8; ++m8) { if (!DRY) *(f32x4*)(so + 16 * m8) = HT[m8]; else KEEP(HT[m8]); }
        }
    }
    if (!DRY && F.G > 64 && F.bid >= 64) {
        for (int t = F.bid - 64; t < NCHT * 4; t += F.G - 64) {
            int seq, c, grp;
            if (t < 32) { seq = 2 + (t >> 2); c = 0; grp = t & 3; } else { const int u = t - 32; c = u >> 3; seq = (u >> 2) & 1; grp = u & 3; }
            wait_tiles(F, prog_ptr(F, 2 * j, seq, grp * 8), 8, 4 * (c + 1));
            ssd_post_task<false>(F, cgi_of(seq, c), grp);
        }
    }
}

template <bool DRY>
__device__ __forceinline__ void ssd_post_task(const Frame& F, int cgi, int grp) {
    constexpr int RL = 524;
    bf16_t* YL = (bf16_t*)F.lds;
    {
        int seq, c; chunk_of(cgi, seq, c);
        const int base = seq_base(seq), t0 = 64 * c - PADF;
        u32x4 zr[8];
#pragma unroll
        for (int q = 0; q < 8; ++q) { const int l = F.wave + 8 * q, t = t0 + l; const int row = seq < 2 ? seq * TPP + 64 * c + l : base + (t > 0 ? t : 0);
            zr[q] = *(const u32x4*)(F.proj + (size_t)row * LDP + grp * 512 + 8 * F.lane); }
        __syncthreads();
#pragma unroll
        for (int r = 0; r < 8; ++r) {
            const int k = F.tid + 512 * r, hl = k >> 9, p = (k >> 3) & 63, ch = k & 7;
            const XTile xt = ssd_xtile(F, seq, c, grp * 8 + hl);
            const u32x4 w = *(const u32x4*)(xt.p + (size_t)p * xt.stride + ch * 8);
            bf16_t* d = YL + (8 * ch) * RL + hl * 64 + p;
            d[0] = (bf16_t)w.x; d[RL] = (bf16_t)(w.x >> 16); d[2 * RL] = (bf16_t)w.y; d[3 * RL] = (bf16_t)(w.y >> 16);
            d[4 * RL] = (bf16_t)w.z; d[5 * RL] = (bf16_t)(w.z >> 16); d[6 * RL] = (bf16_t)w.w; d[7 * RL] = (bf16_t)(w.w >> 16);
        }
        __syncthreads();
#pragma unroll
        for (int q = 0; q < 8; ++q) {
            const int l = F.wave + 8 * q, t = t0 + l;
            if (t < 0 && seq >= 2) continue;
            const int row = seq < 2 ? seq * TPP + 64 * c + l : base + t;
            const u32x2 y0 = *(const u32x2*)(YL + l * RL + 8 * F.lane), y1 = *(const u32x2*)(YL + l * RL + 8 * F.lane + 4);
            const unsigned yw[4] = {y0.x, y0.y, y1.x, y1.y}; const unsigned zw[4] = {zr[q].x, zr[q].y, zr[q].z, zr[q].w};
            float yg[8]; float ss = 0.f;
#pragma unroll
            for (int e = 0; e < 4; ++e) {
                yg[2 * e] = __uint_as_float(yw[e] << 16) * silu_f(__uint_as_float(zw[e] << 16)); yg[2 * e + 1] = __uint_as_float(yw[e] & 0xffff0000u) * silu_f(__uint_as_float(zw[e] & 0xffff0000u));
                ss += yg[2 * e] * yg[2 * e] + yg[2 * e + 1] * yg[2 * e + 1]; }
            ss = wave_sum(ss);
            const float rs = rsqrtf(ss * (1.0f / 512.0f) + EPS);
            u32x4 w; w.x = cvt_pk_bf16(yg[0] * rs, yg[1] * rs); w.y = cvt_pk_bf16(yg[2] * rs, yg[3] * rs); w.z = cvt_pk_bf16(yg[4] * rs, yg[5] * rs); w.w = cvt_pk_bf16(yg[6] * rs, yg[7] * rs);
            if (!DRY) *(u32x4*)(F.proj + (size_t)row * LDP + grp * 512 + 8 * F.lane) = w; else KEEP(w);
        }
    }
}
template <bool DRY>
__device__ void phase_ssd_post(const Frame& F0, int j) {
    const Frame F = relaunder(F0);
    if (DRY || F.G <= 64) for (int task = F.bid; task < NCHT * 4; task += F.G) ssd_post_task<DRY>(F, task >> 2, task & 3);
    if (DRY) return;
    for (int e = F.bid * NTHREADS + F.tid; e < NSEQ * 3 * SSD_CONV; e += F.G * NTHREADS) {
        const int s = e / (3 * SSD_CONV), r = (e / SSD_CONV) % 3, c = e % SSD_CONV;
        const int row = seq_base(s) + seq_len(s) - 3 + r;
        float v;
        if (s < 2 && c < 2048) v = bf2f(F.tails[((size_t)(s * 129 + 128) * 3 + r) * 4096 + c]);
        else v = bf2f(F.proj[(size_t)row * LDP + 2048 + c]);
        if (s < 2) F.out[O_PSSDC + (((size_t)j * 2 + s) * 3 + r) * SSD_CONV + c] = v;
        else F.out[O_SSSDC + (((size_t)j * 8 + (s - 2)) * 3 + r) * SSD_CONV + c] = v;
    }
}

constexpr size_t SG_W = 0;
constexpr size_t SG_QK = SG_W + (size_t)NCHT * 8 * 16384;
constexpr size_t SG_VEC = SG_QK + (size_t)NCHT * 8 * 8192;
constexpr size_t SG_PART = SG_VEC + (size_t)NCHT * 8 * 1024;
constexpr size_t SG_SIDE = SG_PART + (size_t)M_TOT * 128 * 2;
constexpr size_t SG_END = SG_SIDE + (size_t)64 * 65536;
static_assert(SG_END <= (size_t)16777216 * 4, "scratch must fit the y_prompt region");
struct GTile { bf16_t* q; bf16_t* k; bf16_t* v; int sq, sk, sv; };
__device__ __forceinline__ GTile gdn_tile(const Frame& F, int seq, int c, int head) {
    GTile t;
    if (seq < 2) { bf16_t* r0 = F.proj + (size_t)(seq * TPP + 64 * c) * LDP; t.q = r0 + head * 128; t.k = r0 + 1024 + head * 128; t.v = r0 + 2048 + head * 256; t.sq = LDP; t.sk = LDP; t.sv = LDP; }
    else { bf16_t* b = (bf16_t*)((unsigned char*)F.out + SG_SIDE) + (size_t)((seq - 2) * 8 + head) * 32768; t.q = b; t.k = b + 8192; t.v = b + 16384; t.sq = 128; t.sk = 128; t.sv = 256; }
    return t;
}

template <bool DRY>
__device__ void phase_gdn_prep(const Frame& F0, int j) {
    const Frame F = relaunder(F0);
    float* Am = (float*)F.lds;
    float* vgc = Am + 64 * 68;
    float* vbe = vgc + 64;
    float* vnq = vbe + 64;
    float* vnk = vnq + 64;
    bf16_t* qs = (bf16_t*)(vnk + 64);
    bf16_t* ks = qs + 64 * 136;
    bf16_t* kT = ks + 64 * 136;
    bf16_t* vT = kT + 128 * 72;
    bf16_t* Tb = vT + 256 * 72;
    bf16_t* TT = Tb + 2 * 64 * 72;
    bf16_t* TD = TT + 64 * 72;
    bf16_t* YT = TD + 2 * 4 * 16 * 24;
    unsigned char* sc = (unsigned char*)F.out;
    const float* conv_w = F.inp(18) + (size_t)j * 4 * GDN_CONV;
    const int i16 = F.lane & 15, g4 = F.lane >> 4;
    constexpr float CQ = 0.08838834764831845f;
    for (int task = F.bid; task < NCHT * 8; task += F.G) {
        const int cgi = task >> 3, head = task & 7; int seq, c; chunk_of(cgi, seq, c);
        const int base = seq_base(seq), t0 = 64 * c - PADF;
        const GTile tl = gdn_tile(F, seq, c, head);
        __syncthreads();
        for (int q = F.tid; q < (3 * 64 * 72 + 64 * 24) / 8; q += NTHREADS) { bf16_t* z0 = (q < 3 * 64 * 72 / 8) ? Tb + 8 * q : YT + 8 * (q - 3 * 64 * 72 / 8); *(u32x4*)z0 = (u32x4){0u, 0u, 0u, 0u}; }
        if (F.wave == 0) {
            const int t = t0 + F.lane; float gg = 0.f, be = 0.f;
            if (t >= 0) { const float* dp = F.dtb + (size_t)(base + t) * 32; gg = -__expf(F.inp(20)[j * GDN_HEADS + head]) * softplus_f(dp[head] + F.inp(19)[j * GDN_HEADS + head]); be = 1.0f / (1.0f + __expf(-dp[8 + head])); }
#pragma unroll
            for (int o = 1; o < 64; o <<= 1) { const float y = __shfl_up(gg, o); if (F.lane >= o) gg += y; }
            vgc[F.lane] = gg; vbe[F.lane] = be;
        }
        __syncthreads();
        {
            const int ch = F.tid;
            const int cidx = ch < 128 ? head * 128 + ch : (ch < 256 ? 1024 + head * 128 + (ch - 128) : 2048 + head * 256 + (ch - 256));
            const float w0 = conv_w[cidx], w1 = conv_w[GDN_CONV + cidx], w2 = conv_w[2 * GDN_CONV + cidx], w3 = conv_w[3 * GDN_CONV + cidx];
            const float* cst = (seq >= 2) ? F.inp(5) + (((size_t)j * 8 + (seq - 2)) * 3) * GDN_CONV + cidx : nullptr;
            const bf16_t* tailp = (seq < 2 && c > 0) ? F.tails + (size_t)(cgi - 1) * 3 * 4096 + cidx : nullptr;
            float r3 = 0.f, r2 = 0.f, r1 = 0.f;
            if (tailp) { r3 = bf2f(tailp[0]); r2 = bf2f(tailp[4096]); r1 = bf2f(tailp[2 * 4096]); }
            else if (cst) { r3 = cst[0]; r2 = cst[GDN_CONV]; r1 = cst[2 * GDN_CONV]; }
            const bf16_t* col = F.proj + cidx;
#pragma unroll 1
            for (int pg = 0; pg < 2; ++pg) {
                unsigned short raw[32];
#pragma unroll
                for (int e = 0; e < 32; ++e) { const int t = t0 + 32 * pg + e; raw[e] = col[(size_t)(base + (t > 0 ? t : 0)) * LDP]; }
#pragma unroll
                for (int e8 = 0; e8 < 4; ++e8) {
                    float o[8];
#pragma unroll
                    for (int h = 0; h < 8; ++h) {
                        const int e = 8 * e8 + h, p = 32 * pg + e, t = t0 + p;
                        const float x = (t >= 0) ? bf2f(raw[e]) : 0.f;
                        o[h] = silu_f(w0 * r3 + w1 * r2 + w2 * r1 + w3 * x);
                        if (t >= 0) { r3 = r2; r2 = r1; r1 = x; }
                        if (ch < 128) qs[p * 136 + ch] = f2bf(o[h]);
                        else if (ch < 256) ks[p * 136 + (ch - 128)] = f2bf(o[h]);
                        else o[h] *= vbe[p];
                    }
                    if (ch >= 128) { u32x4 w; w.x = cvt_pk_bf16(o[0], o[1]); w.y = cvt_pk_bf16(o[2], o[3]); w.z = cvt_pk_bf16(o[4], o[5]); w.w = cvt_pk_bf16(o[6], o[7]);
                        bf16_t* d = (ch < 256 ? kT + (ch - 128) * 72 : vT + (ch - 256) * 72) + 32 * pg + 8 * e8; *(u32x4*)d = w; }
                }
            }
        }
        __syncthreads();
        if (F.tid < 128) {
            const int l = F.tid & 63; const bf16_t* rowp = (F.tid < 64 ? qs : ks) + l * 136; float ss = 0.f;
#pragma unroll
            for (int q = 0; q < 16; ++q) { const u32x4 v = *(const u32x4*)(rowp + 8 * q);
                const float a0 = __uint_as_float(v.x << 16), a1 = __uint_as_float(v.x & 0xffff0000u), a2 = __uint_as_float(v.y << 16), a3 = __uint_as_float(v.y & 0xffff0000u);
                const float a4 = __uint_as_float(v.z << 16), a5 = __uint_as_float(v.z & 0xffff0000u), a6 = __uint_as_float(v.w << 16), a7 = __uint_as_float(v.w & 0xffff0000u);
                ss += ((a0 * a0 + a1 * a1) + (a2 * a2 + a3 * a3)) + ((a4 * a4 + a5 * a5) + (a6 * a6 + a7 * a7)); }
            (F.tid < 64 ? vnq : vnk)[l] = rsqrtf(ss + EPS);
        }
        __syncthreads();
        {
            bf16_t* QKg = (bf16_t*)(sc + SG_QK) + (size_t)task * 4096;
            const int m = F.wave >> 1;
#pragma unroll
            for (int u = 0; u < 2; ++u) {
                const int st = 2 * (F.wave & 1) + u; f32x4 aK = (f32x4){0.f, 0.f, 0.f, 0.f}, aQ = (f32x4){0.f, 0.f, 0.f, 0.f};
#pragma unroll
                for (int kk = 0; kk < 4; ++kk) {
                    const bf16x8 ak = *(const bf16x8*)(ks + (16 * m + i16) * 136 + 32 * kk + 8 * g4);
                    const bf16x8 aq = *(const bf16x8*)(qs + (16 * m + i16) * 136 + 32 * kk + 8 * g4);
                    const bf16x8 b = *(const bf16x8*)(ks + (16 * st + i16) * 136 + 32 * kk + 8 * g4);
                    aK = __builtin_amdgcn_mfma_f32_16x16x32_bf16(ak, b, aK, 0, 0, 0);
                    aQ = __builtin_amdgcn_mfma_f32_16x16x32_bf16(aq, b, aQ, 0, 0, 0);
                }
                const int s_ = 16 * st + i16; const float gs = vgc[s_], nks = vnk[s_]; const int qs_ = qperm(s_);
#pragma unroll
                for (int jj = 0; jj < 4; ++jj) {
                    const int l = 16 * m + 4 * g4 + jj;
                    const float dec = (s_ <= l) ? __expf(vgc[l] - gs) : 0.f;
                    Am[l * 68 + s_] = (s_ < l) ? vbe[l] * vnk[l] * nks * aK[jj] * dec : 0.f;
                    { const float r = CQ * vnq[l] * nks * aQ[jj] * dec; if (!DRY) QKg[l * 64 + qs_] = f2bf(r); else KEEP(r); }
                }
            }
        }
        __syncthreads();
        if (F.wave == 0) for (int rep = 0; rep < REP_SUBST; ++rep) {
            int ln = F.lane; asm volatile("" : "+v"(ln));
            const int i = ln & 15, g = ln >> 4;
            {   const int b = g, cc = i; float x[16];
#pragma unroll
                for (int r = 0; r < 16; ++r) {
                    float a0 = (r == cc) ? 1.f : 0.f, a1 = 0.f;
#pragma unroll
                    for (int s2 = 0; s2 < r; ++s2) { const float av = Am[(16 * b + r) * 68 + 16 * b + s2]; if (s2 & 1) a1 -= av * x[s2]; else a0 -= av * x[s2]; }
                    x[r] = a0 + a1;
                }
                const int cg = 16 * b + cc; const float csc = vbe[cg] * __expf(vgc[cg]) * vnk[cg];
#pragma unroll
                for (int r = 0; r < 16; ++r) {
                    const bf16_t hi = f2bf(x[r]); const int lg = 16 * b + r;
                    Tb[lg * 72 + cg] = hi; Tb[64 * 72 + lg * 72 + cg] = f2bf(x[r] * csc); TT[cg * 72 + lg] = hi;
                    TD[(b * 16 + r) * 24 + cc] = hi; TD[4 * 16 * 24 + (b * 16 + r) * 24 + cc] = f2bf(x[r] - bf2f(hi));
                }
            }
#pragma unroll
            for (int bi = 1; bi < 4; ++bi) {
#pragma unroll
                for (int nt = 0; nt < bi; ++nt) {
                    f32x4 acc = (f32x4){0.f, 0.f, 0.f, 0.f};
#pragma unroll
                    for (int ks = 0; ks < (16 * bi + 31) / 32; ++ks) {
                        const int k0 = 32 * ks + 8 * g;
                        f32x4 alo4 = (f32x4){0.f, 0.f, 0.f, 0.f}, ahi4 = (f32x4){0.f, 0.f, 0.f, 0.f};
                        if (k0 < 16 * bi) { alo4 = *(const f32x4*)(Am + (16 * bi + i) * 68 + k0); ahi4 = *(const f32x4*)(Am + (16 * bi + i) * 68 + k0 + 4); }
                        const bf16x8 ah = pack8(alo4, ahi4);
                        const u32x4 ahw = __builtin_bit_cast(u32x4, ah);
                        f32x4 r0, r1;
                        r0[0] = alo4[0] - __uint_as_float(ahw.x << 16); r0[1] = alo4[1] - __uint_as_float(ahw.x & 0xffff0000u); r0[2] = alo4[2] - __uint_as_float(ahw.y << 16); r0[3] = alo4[3] - __uint_as_float(ahw.y & 0xffff0000u);
                        r1[0] = ahi4[0] - __uint_as_float(ahw.z << 16); r1[1] = ahi4[1] - __uint_as_float(ahw.z & 0xffff0000u); r1[2] = ahi4[2] - __uint_as_float(ahw.w << 16); r1[3] = ahi4[3] - __uint_as_float(ahw.w & 0xffff0000u);
                        const bf16x8 al = pack8(r0, r1);
                        const bf16x8 bt = *(const bf16x8*)(TT + (16 * nt + i) * 72 + k0);
                        acc = __builtin_amdgcn_mfma_f32_16x16x32_bf16(ah, bt, acc, 0, 0, 0);
                        acc = __builtin_amdgcn_mfma_f32_16x16x32_bf16(al, bt, acc, 0, 0, 0);
                    }
                    u32x2 w; w.x = cvt_pk_bf16(acc[0], acc[1]); w.y = cvt_pk_bf16(acc[2], acc[3]);
                    *(u32x2*)(YT + (16 * nt + i) * 24 + 4 * g) = w;
                }
                bf16x8 th = __builtin_bit_cast(bf16x8, (u32x4){0u, 0u, 0u, 0u}), tlo = th;
                if (g < 2) { th = *(const bf16x8*)(TD + (bi * 16 + i) * 24 + 8 * g); tlo = *(const bf16x8*)(TD + 4 * 16 * 24 + (bi * 16 + i) * 24 + 8 * g); }
#pragma unroll
                for (int nt = 0; nt < bi; ++nt) {
                    bf16x8 yb = __builtin_bit_cast(bf16x8, (u32x4){0u, 0u, 0u, 0u});
                    if (g < 2) yb = *(const bf16x8*)(YT + (16 * nt + i) * 24 + 8 * g);
                    f32x4 acc = (f32x4){0.f, 0.f, 0.f, 0.f};
                    acc = __builtin_amdgcn_mfma_f32_16x16x32_bf16(th, yb, acc, 0, 0, 0);
                    acc = __builtin_amdgcn_mfma_f32_16x16x32_bf16(tlo, yb, acc, 0, 0, 0);
                    const int cg = 16 * nt + i; const float csc = vbe[cg] * __expf(vgc[cg]) * vnk[cg];
                    u32x2 w; w.x = cvt_pk_bf16(-acc[0], -acc[1]); w.y = cvt_pk_bf16(-acc[2], -acc[3]);
                    *(u32x2*)(TT + cg * 72 + 16 * bi + 4 * g) = w;
#pragma unroll
                    for (int jj = 0; jj < 4; ++jj) { const int lg = 16 * bi + 4 * g + jj; Tb[lg * 72 + cg] = f2bf(-acc[jj]); Tb[64 * 72 + lg * 72 + cg] = f2bf(-acc[jj] * csc); }
                }
            }
        } else {
            const int t7 = F.tid - 64;
            const float gl_ = vgc[63];
            for (int idx = t7; idx < 1024; idx += 448) {
                const int l = idx >> 4, qg8 = idx & 15, kk = qg8 >> 2, gg = qg8 & 3;
                const u32x2 a = *(const u32x2*)(qs + l * 136 + 32 * kk + 4 * gg), b = *(const u32x2*)(qs + l * 136 + 32 * kk + 16 + 4 * gg);
                const float sc_ = __expf(vgc[l]) * CQ * vnq[l];
                u32x4 w; w.x = cvt_pk_bf16(__uint_as_float(a.x << 16) * sc_, __uint_as_float(a.x & 0xffff0000u) * sc_); w.y = cvt_pk_bf16(__uint_as_float(a.y << 16) * sc_, __uint_as_float(a.y & 0xffff0000u) * sc_);
                w.z = cvt_pk_bf16(__uint_as_float(b.x << 16) * sc_, __uint_as_float(b.x & 0xffff0000u) * sc_); w.w = cvt_pk_bf16(__uint_as_float(b.y << 16) * sc_, __uint_as_float(b.y & 0xffff0000u) * sc_);
                if (!DRY) *(u32x4*)(tl.q + (size_t)l * tl.sq + 8 * qg8) = w; else KEEP(w);
            }
            for (int idx = t7; idx < 1024; idx += 448) {
                const int kd = idx >> 3, pg = idx & 7, kk2 = pg >> 2, gg = pg & 3, la = 32 * kk2 + 4 * gg, lb = la + 16;
                const u32x2 a = *(const u32x2*)(kT + kd * 72 + la), b = *(const u32x2*)(kT + kd * 72 + lb);
                const f32x4 ga = *(const f32x4*)(vgc + la), gb = *(const f32x4*)(vgc + lb), na = *(const f32x4*)(vnk + la), nb = *(const f32x4*)(vnk + lb);
                u32x4 w;
                w.x = cvt_pk_bf16(__uint_as_float(a.x << 16) * na[0] * __expf(gl_ - ga[0]), __uint_as_float(a.x & 0xffff0000u) * na[1] * __expf(gl_ - ga[1]));
                w.y = cvt_pk_bf16(__uint_as_float(a.y << 16) * na[2] * __expf(gl_ - ga[2]), __uint_as_float(a.y & 0xffff0000u) * na[3] * __expf(gl_ - ga[3]));
                w.z = cvt_pk_bf16(__uint_as_float(b.x << 16) * nb[0] * __expf(gl_ - gb[0]), __uint_as_float(b.x & 0xffff0000u) * nb[1] * __expf(gl_ - gb[1]));
                w.w = cvt_pk_bf16(__uint_as_float(b.y << 16) * nb[2] * __expf(gl_ - gb[2]), __uint_as_float(b.y & 0xffff0000u) * nb[3] * __expf(gl_ - gb[3]));
                if (!DRY) *(u32x4*)(tl.k + (size_t)(kd >> 1) * tl.sk + (kd & 1) * 64 + 8 * pg) = w; else KEEP(w);
            }
            if (t7 < 64) {
                float* vp = (float*)(sc + SG_VEC) + (size_t)task * 256; const float gl = vgc[63];
                const float v0 = __expf(vgc[t7]) * CQ * vnq[t7], v1 = vnk[t7] * __expf(gl - vgc[t7]), v2 = __expf(gl);
                if (!DRY) { vp[t7] = v0; vp[64 + t7] = v1; vp[128 + t7] = v2; vp[192 + t7] = 0.f; } else { KEEP(v0); KEEP(v1); KEEP(v2); }
            }
        }
        __syncthreads();
        {
            bf16_t* Wg = (bf16_t*)(sc + SG_W) + (size_t)task * 8192;
            bf16x8 bk[2];
#pragma unroll
            for (int k2 = 0; k2 < 2; ++k2) bk[k2] = *(const bf16x8*)(kT + (16 * F.wave + i16) * 72 + 32 * k2 + 8 * g4);
            const int qkd = qperm(16 * F.wave + i16);
#pragma unroll
            for (int m = 0; m < 4; ++m) {
                f32x4 acc = (f32x4){0.f, 0.f, 0.f, 0.f};
#pragma unroll
                for (int k2 = 0; k2 < 2; ++k2) { const bf16x8 a = *(const bf16x8*)(Tb + 64 * 72 + (16 * m + i16) * 72 + 32 * k2 + 8 * g4); acc = __builtin_amdgcn_mfma_f32_16x16x32_bf16(a, bk[k2], acc, 0, 0, 0); }
#pragma unroll
                for (int jj = 0; jj < 4; ++jj) { if (!DRY) Wg[(16 * m + 4 * g4 + jj) * 128 + qkd] = f2bf(-acc[jj]); else KEEP(acc[jj]); }
            }
#pragma unroll
            for (int u = 0; u < 2; ++u) {
                const int v = 16 * (2 * F.wave + u) + i16;
                bf16x8 bv[2];
#pragma unroll
                for (int k2 = 0; k2 < 2; ++k2) bv[k2] = *(const bf16x8*)(vT + v * 72 + 32 * k2 + 8 * g4);
#pragma unroll
                for (int m = 0; m < 4; ++m) {
                    f32x4 acc = (f32x4){0.f, 0.f, 0.f, 0.f};
#pragma unroll
                    for (int k2 = 0; k2 < 2; ++k2) { const bf16x8 a = *(const bf16x8*)(Tb + (16 * m + i16) * 72 + 32 * k2 + 8 * g4); acc = __builtin_amdgcn_mfma_f32_16x16x32_bf16(a, bv[k2], acc, 0, 0, 0); }
                    u32x2 w; w.x = cvt_pk_bf16(acc[0], acc[1]); w.y = cvt_pk_bf16(acc[2], acc[3]);
                    if (!DRY) *(u32x2*)(tl.v + (size_t)(v >> 2) * tl.sv + (v & 3) * 64 + 16 * m + 4 * g4) = w; else KEEP(w);
                }
            }
        }
    }
}

constexpr int GL_W = 0, GL_Q = 16384, GL_KT = 32768, GL_QK = 49152, GL_U = 57344, GL_VEC = 65536, GL_SIZE = 66560;
__device__ __forceinline__ bf16_t* gdn_urow(const GTile& tl, int v) { return tl.v + (size_t)(v >> 2) * tl.sv + (v & 3) * 64; }
__device__ __forceinline__ void gdn_stage_load(u32x4 (&P)[17], const Frame& F, const unsigned char* sc, int lt, int seq, int head, int vq, int c) {
    const int task = cgi_of(seq, c) * 8 + head;
    const GTile tl = gdn_tile(F, seq, c, head);
    const bf16_t* Wp = (const bf16_t*)(sc + SG_W) + (size_t)task * 8192;
    const bf16_t* QKp = (const bf16_t*)(sc + SG_QK) + (size_t)task * 4096;
    const float* vp = (const float*)(sc + SG_VEC) + (size_t)task * 256;
#pragma unroll
    for (int r = 0; r < 4; ++r) { const int k = lt + 256 * r;
        P[r] = *(const u32x4*)(Wp + k * 8);
        P[4 + r] = *(const u32x4*)(tl.q + (size_t)(k >> 4) * tl.sq + (k & 15) * 8);
        { const int kd = k >> 3; P[8 + r] = *(const u32x4*)(tl.k + (size_t)(kd >> 1) * tl.sk + (kd & 1) * 64 + (k & 7) * 8); } }
#pragma unroll
    for (int r = 0; r < 2; ++r) { const int k = lt + 256 * r;
        P[12 + r] = *(const u32x4*)(QKp + k * 8);
        P[14 + r] = *(const u32x4*)(gdn_urow(tl, vq * 64 + (k >> 3)) + (k & 7) * 8); }
    P[16] = *(const u32x4*)(vp + 4 * (lt < 48 ? lt : 0));
}
__device__ __forceinline__ void gdn_stage_write(const u32x4 (&P)[17], LAS unsigned char* img, int lt) {
#pragma unroll
    for (int r = 0; r < 4; ++r) { const int k = lt + 256 * r;
        { const int row = k >> 4, ch = k & 15, slot = row * 16 + (ch ^ (row & 15)); *(LAS u32x4*)(img + GL_W + slot * 16) = P[r]; *(LAS u32x4*)(img + GL_Q + slot * 16) = P[4 + r]; }
        { const int row = k >> 3, ch = k & 7; *(LAS u32x4*)(img + GL_KT + (row * 8 + (ch ^ ((row >> 1) & 7))) * 16) = P[8 + r]; } }
#pragma unroll
    for (int r = 0; r < 2; ++r) { const int k = lt + 256 * r, row = k >> 3, ch = k & 7, slot = row * 8 + (ch ^ ((row >> 1) & 7));
        *(LAS u32x4*)(img + GL_QK + slot * 16) = P[12 + r]; *(LAS u32x4*)(img + GL_U + slot * 16) = P[14 + r]; }
    if (lt < 48) *(LAS u32x4*)(img + GL_VEC + 16 * lt) = P[16];
}
template <bool DRY>
__device__ __forceinline__ void gdn_otile_out(const LAS unsigned char* img, const GTile& tl, int vq, int lt) {
#pragma unroll
    for (int r = 0; r < 2; ++r) { const int k = lt + 256 * r, row = k >> 3, ch = k & 7;
        const u32x4 w = *(const LAS u32x4*)(img + GL_U + (row * 8 + (ch ^ ((row >> 1) & 7))) * 16);
        { const int v = vq * 64 + row; if (!DRY) store16_wt(tl.v, 64u * tl.sv * 2u, (unsigned)((v >> 2) * tl.sv + (v & 3) * 64 + ch * 8) * 2u, w); else KEEP(w); } }
}
template <int MODE>
__device__ void phase_gdn_chain(const Frame& F0, int j) {
    constexpr bool DRY = MODE != 0;
    const Frame F = relaunder(F0);
    const unsigned char* sc = (const unsigned char*)F.out;
    const bool loader = F.wave >= 4; const int lt = F.tid - 256, w4 = F.wave & 3;
    for (int sh = F.bid; sh < 320; sh += (F.bid < 64 && F.G > 64) ? 320 : (F.G > 64 ? F.G - 64 : F.G)) {
        const int seq = sh < 64 ? (sh >> 5) : 2 + ((sh - 64) >> 5), head = (sh >> 2) & 7, vq = sh & 3;
        const int nch = seq_chunks(seq);
        int* prog = prog_ptr(F, 2 * j + 1, seq, head * 4 + vq);
        __syncthreads();
        if (loader) {
            u32x4 A[17], B[17];
            gdn_stage_load(A, F, sc, lt, seq, head, vq, 0); gdn_stage_write(A, F.ldsl, lt);
            if (nch > 1) gdn_stage_load(B, F, sc, lt, seq, head, vq, 1);
            if (nch > 2) gdn_stage_load(A, F, sc, lt, seq, head, vq, 2);
            __syncthreads();
#define GDN_LOADER_STEP(CC, ST) { const int cc_ = (CC); int nxt = ((cc_ + 1) & 1) * GL_SIZE, lt_ = lt; asm volatile("" : "+s"(nxt), "+v"(lt_)); \
                if (MODE != 2) { \
                if (cc_ + 1 < nch) gdn_stage_write(ST, F.ldsl + nxt, lt_); \
                if (cc_ + 3 < nch) gdn_stage_load(ST, F, sc, lt_, seq, head, vq, cc_ + 3); } \
                __syncthreads(); }
            for (int c = 0; c < nch; c += 2) {
                GDN_LOADER_STEP(c, B)
                if (c + 1 < nch) GDN_LOADER_STEP(c + 1, A)
            }
#undef GDN_LOADER_STEP
        } else {
            f32x4 S[8];
#pragma unroll
            for (int m8 = 0; m8 < 8; ++m8) S[m8] = (f32x4){0.f, 0.f, 0.f, 0.f};
            if (seq >= 2) {
                const int i = F.lane & 15, g = F.lane >> 4;
                const float* st = F.inp(4) + (((size_t)j * 8 + (seq - 2)) * GDN_HEADS + head) * GDN_DK * GDN_DV + vq * 64 + w4 * 16 + i;
#pragma unroll
                for (int m8 = 0; m8 < 8; ++m8)
#pragma unroll
                    for (int jj = 0; jj < 4; ++jj) S[m8][jj] = st[(size_t)(16 * m8 + 4 * g + jj) * GDN_DV];
            }
            __syncthreads();
            for (int c = 0; c < nch; ++c) {
                if (MODE == 3) { __syncthreads(); continue; }
                int cur = (c & 1) * GL_SIZE, lane_ = F.lane;
                asm volatile("" : "+s"(cur), "+v"(lane_));
                LAS unsigned char* img = F.ldsl + cur;
                const int i = lane_ & 15, g = lane_ >> 4, vrow = w4 * 16 + i, vsw = (vrow >> 1) & 7;
                const LAS unsigned char* pw[4]; const LAS unsigned char* pk[2];
#pragma unroll
                for (int kk = 0; kk < 4; ++kk) pw[kk] = img + i * 256 + (((4 * kk + g) ^ i) * 16);
#pragma unroll
                for (int k2 = 0; k2 < 2; ++k2) pk[k2] = img + i * 128 + (((4 * k2 + g) ^ (i >> 1)) * 16);
                const float egl = *(const LAS float*)(img + GL_VEC + 512);
                bf16x8 Sf[4];
#pragma unroll
                for (int kk = 0; kk < 4; ++kk) Sf[kk] = pack8(S[2 * kk], S[2 * kk + 1]);
                LAS unsigned char* urow = img + GL_U + vrow * 128 + 8 * (g & 1);
                f32x4 vn[4], O[4];
                bf16x8 wf[2][4], qf[2][4]; u32x2 uw[4];
#pragma unroll
                for (int kk = 0; kk < 4; ++kk) { wf[0][kk] = *(const LAS bf16x8*)(pw[kk] + GL_W); qf[0][kk] = *(const LAS bf16x8*)(pw[kk] + GL_Q); }
#pragma unroll
                for (int m = 0; m < 4; ++m) uw[m] = *(const LAS u32x2*)(urow + ((2 * m + (g >> 1)) ^ vsw) * 16);
#pragma unroll
                for (int m = 0; m < 4; ++m) {
                    if (m < 3) {
#pragma unroll
                        for (int kk = 0; kk < 4; ++kk) { wf[(m + 1) & 1][kk] = *(const LAS bf16x8*)(pw[kk] + GL_W + (m + 1) * 4096); qf[(m + 1) & 1][kk] = *(const LAS bf16x8*)(pw[kk] + GL_Q + (m + 1) * 4096); }
                    }
                    f32x4 a1, a2 = (f32x4){0.f, 0.f, 0.f, 0.f};
                    a1[0] = __uint_as_float(uw[m].x << 16); a1[1] = __uint_as_float(uw[m].x & 0xffff0000u); a1[2] = __uint_as_float(uw[m].y << 16); a1[3] = __uint_as_float(uw[m].y & 0xffff0000u);
#pragma unroll
                    for (int kk = 0; kk < 4; ++kk) {
                        a1 = __builtin_amdgcn_mfma_f32_16x16x32_bf16(wf[m & 1][kk], Sf[kk], a1, 0, 0, 0);
                        a2 = __builtin_amdgcn_mfma_f32_16x16x32_bf16(qf[m & 1][kk], Sf[kk], a2, 0, 0, 0);
                    }
                    vn[m] = a1; O[m] = a2;
                }
                bf16x8 Vf[2];
#pragma unroll
                for (int k2 = 0; k2 < 2; ++k2) Vf[k2] = pack8(vn[2 * k2], vn[2 * k2 + 1]);
                bf16x8 qkf[2][2][2];
#pragma unroll
                for (int q = 0; q < 2; ++q)
#pragma unroll
                    for (int k2 = 0; k2 < 2; ++k2) qkf[0][q][k2] = *(const LAS bf16x8*)(pk[k2] + GL_QK + q * 2048);
                bf16x8 kf[2][2][2];
#pragma unroll
                for (int h = 0; h < 2; ++h) {
                    if (h == 0) {
#pragma unroll
                        for (int q = 0; q < 2; ++q)
#pragma unroll
                            for (int k2 = 0; k2 < 2; ++k2) qkf[1][q][k2] = *(const LAS bf16x8*)(pk[k2] + GL_QK + (2 + q) * 2048);
                    } else {
#pragma unroll
                        for (int q = 0; q < 2; ++q)
#pragma unroll
                            for (int k2 = 0; k2 < 2; ++k2) kf[0][q][k2] = *(const LAS bf16x8*)(pk[k2] + GL_KT + q * 2048);
                    }
#pragma unroll
                    for (int q = 0; q < 2; ++q)
#pragma unroll
                        for (int k2 = 0; k2 < 2; ++k2) O[2 * h + q] = __builtin_amdgcn_mfma_f32_16x16x32_bf16(qkf[h][q][k2], Vf[k2], O[2 * h + q], 0, 0, 0);
                }
#pragma unroll
                for (int h = 0; h < 4; ++h) {
                    if (h < 3) {
#pragma unroll
                        for (int q = 0; q < 2; ++q)
#pragma unroll
                            for (int k2 = 0; k2 < 2; ++k2) kf[(h + 1) & 1][q][k2] = *(const LAS bf16x8*)(pk[k2] + GL_KT + (2 * (h + 1) + q) * 2048);
                    }
#pragma unroll
                    for (int q = 0; q < 2; ++q) {
                        const int m8 = 2 * h + q;
                        f32x4 acc = S[m8] * egl;
#pragma unroll
                        for (int k2 = 0; k2 < 2; ++k2) acc = __builtin_amdgcn_mfma_f32_16x16x32_bf16(kf[h & 1][q][k2], Vf[k2], acc, 0, 0, 0);
                        S[m8] = acc;
                    }
                }
                {
                    const GTile tl = gdn_tile(F, seq, c, head);
                    const int v = vq * 64 + vrow;
                    u32x2 ow[4];
#pragma unroll
                    for (int m = 0; m < 4; ++m) { ow[m].x = cvt_pk_bf16(O[m][0], O[m][1]); ow[m].y = cvt_pk_bf16(O[m][2], O[m][3]); }
#pragma unroll
                    for (int q = 0; q < 2; ++q) {
                        const u32x2 snd = (g & 1) ? ow[2 * q] : ow[2 * q + 1];
                        u32x2 rcv; rcv.x = __shfl_xor(snd.x, 16); rcv.y = __shfl_xor(snd.y, 16);
                        u32x4 w; int l0;
                        if (g & 1) { w.x = rcv.x; w.y = rcv.y; w.z = ow[2 * q + 1].x; w.w = ow[2 * q + 1].y; l0 = 32 * q + 16 + 4 * (g - 1); }
                        else { w.x = ow[2 * q].x; w.y = ow[2 * q].y; w.z = rcv.x; w.w = rcv.y; l0 = 32 * q + 4 * g; }
                        if (!DRY) store16_wt(tl.v, 64u * tl.sv * 2u, (unsigned)((v >> 2) * tl.sv + (v & 3) * 64 + l0) * 2u, w); else KEEP(w);
                    }
                    if (!DRY && c >= 2) { asm volatile("s_waitcnt vmcnt(6)" ::: "memory"); if (lane_ == 0) __hip_atomic_fetch_add(prog, 1, __ATOMIC_RELAXED, __HIP_MEMORY_SCOPE_AGENT); }
                }
                __syncthreads();
            }
            if (!DRY) { asm volatile("s_waitcnt vmcnt(0)" ::: "memory"); if (F.lane == 0) __hip_atomic_fetch_add(prog, nch < 2 ? nch : 2, __ATOMIC_RELAXED, __HIP_MEMORY_SCOPE_AGENT); }
            const int i = F.lane & 15, g = F.lane >> 4, vcol = vq * 64 + w4 * 16 + i;
            float* so = (seq < 2) ? F.out + O_PGDN + (((size_t)j * 2 + seq) * GDN_HEADS + head) * GDN_DK * GDN_DV + vcol
                                  : F.out + O_SGDN + (((size_t)j * 8 + (seq - 2)) * GDN_HEADS + head) * GDN_DK * GDN_DV + vcol;
#pragma unroll
            for (int m8 = 0; m8 < 8; ++m8)
#pragma unroll
                for (int jj = 0; jj < 4; ++jj) { if (!DRY) so[(size_t)(16 * m8 + 4 * g + jj) * GDN_DV] = S[m8][jj]; else KEEP(S[m8][jj]); }
        }
    }
    if (!DRY && F.G > 64 && F.bid >= 64) {
        for (int t = F.bid - 64; t < NCHT * 8; t += F.G - 64) {
            int seq, c, head;
            if (t < 64) { seq = 2 + (t >> 3); c = 0; head = t & 7; } else { const int u = t - 64; c = u >> 4; seq = (u >> 3) & 1; head = u & 7; }
            wait_tiles(F, prog_ptr(F, 2 * j + 1, seq, head * 4), 4, 4 * (c + 1));
            gdn_post_task<false>(F, cgi_of(seq, c), head);
        }
    }
}

template <bool DRY>
__device__ __forceinline__ void gdn_post_task(const Frame& F, int cgi, int head) {
    constexpr int RL = 260;
    bf16_t* OL = (bf16_t*)F.lds;
    {
        int seq, c; chunk_of(cgi, seq, c);
        const int base = seq_base(seq), t0 = 64 * c - PADF;
        const GTile tl = gdn_tile(F, seq, c, head);
        u32x2 zr[8];
#pragma unroll
        for (int q = 0; q < 8; ++q) { const int l = F.wave + 8 * q, t = t0 + l; const int row = seq < 2 ? seq * TPP + 64 * c + l : base + (t > 0 ? t : 0);
            zr[q] = *(const u32x2*)(F.proj + (size_t)row * LDP + 4096 + head * 256 + 4 * F.lane); }
        __syncthreads();
#pragma unroll
        for (int r = 0; r < 4; ++r) {
            const int k = F.tid + 512 * r, v = k >> 3, ch = k & 7;
            const u32x4 w = *(const u32x4*)(gdn_urow(tl, v) + ch * 8);
            bf16_t* d = OL + (8 * ch) * RL + v;
            d[0] = (bf16_t)w.x; d[RL] = (bf16_t)(w.x >> 16); d[2 * RL] = (bf16_t)w.y; d[3 * RL] = (bf16_t)(w.y >> 16);
            d[4 * RL] = (bf16_t)w.z; d[5 * RL] = (bf16_t)(w.z >> 16); d[6 * RL] = (bf16_t)w.w; d[7 * RL] = (bf16_t)(w.w >> 16);
        }
        __syncthreads();
#pragma unroll
        for (int q = 0; q < 8; ++q) {
            const int l = F.wave + 8 * q, t = t0 + l;
            if (t < 0 && seq >= 2) continue;
            const int row = seq < 2 ? seq * TPP + 64 * c + l : base + t;
            const u32x2 ow = *(const u32x2*)(OL + l * RL + 4 * F.lane);
            const float o0 = __uint_as_float(ow.x << 16), o1 = __uint_as_float(ow.x & 0xffff0000u), o2 = __uint_as_float(ow.y << 16), o3 = __uint_as_float(ow.y & 0xffff0000u);
            float ss = (o0 * o0 + o1 * o1) + (o2 * o2 + o3 * o3);
            ss = wave_sum(ss);
            const float rs = rsqrtf(ss * (1.0f / 256.0f) + EPS);
            const float z0 = __uint_as_float(zr[q].x << 16), z1 = __uint_as_float(zr[q].x & 0xffff0000u), z2 = __uint_as_float(zr[q].y << 16), z3 = __uint_as_float(zr[q].y & 0xffff0000u);
            u32x2 w; w.x = cvt_pk_bf16(o0 * rs * silu_f(z0), o1 * rs * silu_f(z1)); w.y = cvt_pk_bf16(o2 * rs * silu_f(z2), o3 * rs * silu_f(z3));
            if (!DRY) *(u32x2*)(F.proj + (size_t)row * LDP + 4096 + head * 256 + 4 * F.lane) = w; else KEEP(w);
        }
    }
}
template <bool DRY>
__device__ void phase_gdn_post2(const Frame& F0, int j) {
    const Frame F = relaunder(F0);
    if (DRY || F.G <= 64) for (int task = F.bid; task < NCHT * 8; task += F.G) gdn_post_task<DRY>(F, task >> 3, task & 7);
    if (DRY) return;
    for (int e = F.bid * NTHREADS + F.tid; e < NSEQ * 3 * GDN_CONV; e += F.G * NTHREADS) {
        const int s = e / (3 * GDN_CONV), r = (e / GDN_CONV) % 3, c = e % GDN_CONV;
        if (s < 2) F.out[O_PGDNC + (((size_t)j * 2 + s) * 3 + r) * GDN_CONV + c] = bf2f(F.tails[((size_t)(s * 129 + 128) * 3 + r) * 4096 + c]);
        else F.out[O_SGDNC + (((size_t)j * 8 + (s - 2)) * 3 + r) * GDN_CONV + c] = bf2f(F.proj[(size_t)(seq_base(s) + 13 + r) * LDP + c]);
    }
}

__device__ void phase_final(const Frame& F0) {
    const Frame F = relaunder(F0);
    const float* fw = F.inp(23);
    for (int it = F.bid * 8 + F.wave; it < 2 * SEQ + 128; it += F.G * 8) {
        int row; float* dst;
        if (it < 2 * SEQ) { const int b = it / SEQ, t = it % SEQ; row = b * TPP + 64 + t; dst = F.out + O_YP + (size_t)it * D; }
        else { row = ROW_S0 + (it - 2 * SEQ); dst = F.out + O_YS + (size_t)(it - 2 * SEQ) * D; }
        float x[16]; float ss = 0.f;
#pragma unroll
        for (int i = 0; i < 4; ++i) {
            const u32x2 v = *(const u32x2*)(F.hb + (size_t)row * D + (F.lane + 64 * i) * 4);
            x[4 * i + 0] = __uint_as_float(v.x << 16); x[4 * i + 1] = __uint_as_float(v.x & 0xffff0000u); x[4 * i + 2] = __uint_as_float(v.y << 16); x[4 * i + 3] = __uint_as_float(v.y & 0xffff0000u);
            ss += (x[4 * i] * x[4 * i] + x[4 * i + 1] * x[4 * i + 1]) + (x[4 * i + 2] * x[4 * i + 2] + x[4 * i + 3] * x[4 * i + 3]);
        }
        ss = wave_sum(ss);
        const float rs = rsqrtf(ss * (1.0f / 1024.0f) + EPS);
#pragma unroll
        for (int i = 0; i < 4; ++i) {
            const int c = (F.lane + 64 * i) * 4; const f32x4 w = *(const f32x4*)(fw + c);
            f32x4 o; o[0] = x[4 * i] * rs * w[0]; o[1] = x[4 * i + 1] * rs * w[1]; o[2] = x[4 * i + 2] * rs * w[2]; o[3] = x[4 * i + 3] * rs * w[3];
            *(f32x4*)(dst + c) = o;
        }
    }
}

constexpr int N_PHASES = 22;
__global__ void __launch_bounds__(NTHREADS, 2) hybrid_fwd(Args args) {
    extern __shared__ __attribute__((aligned(16))) unsigned char lds[];
    volatile LAS unsigned* bst = (volatile LAS unsigned*)((LAS unsigned char*)lds + LDS_BYTES - 16);
    if (threadIdx.x < 4) bst[threadIdx.x] = 0u;
    __syncthreads();
    XcdBarrier bar; bar.bar = (unsigned*)(args.ws + WS_CTL); bar.x = 0; bar.st = bst;
    if (args.ph_hi - args.ph_lo > 1) bar = xcd_barrier_post((unsigned*)(args.ws + WS_CTL), bst);
    for (int ph = args.ph_lo; ph < args.ph_hi; ++ph) {
        int tid_ = threadIdx.x; asm volatile("" : "+v"(tid_));
        Frame F;
        F.ap = &args;
        F.out = args.out; F.ws = args.ws; F.lds = lds; F.ldsl = (LAS unsigned char*)lds;
        F.tid = tid_; F.lane = F.tid & 63; F.wave = __builtin_amdgcn_readfirstlane(F.tid >> 6); F.G = gridDim.x; F.bid = blockIdx.x;
        F.hb = nullptr; F.win = nullptr; F.wout = nullptr; F.dtb = nullptr; F.rss = nullptr; F.proj = nullptr; F.tails = nullptr;
        if (ph == 0) { phase_init_h(F); phase_wprep_in(F, 0); }
        else if (ph == N_PHASES - 1) { for (int r = 0; r < REP_FINAL; ++r) phase_final(F); }
        else {
            const int L = (ph - 1) / 5, sub = (ph - 1) % 5, j = L >> 1;
            if (sub == 0) { for (int r = 0; r < REP_INPROJ; ++r) phase_inproj(F, L); }
            else if (sub == 1) {
                if (L & 1) { for (int r = 1; r < REP_GDN_PREP; ++r) phase_gdn_prep<true>(F, j); phase_gdn_prep<false>(F, j); }
                else { for (int r = 1; r < REP_SSD_PREP; ++r) phase_ssd_prep<true>(F, j); phase_ssd_prep<false>(F, j); }
                for (int r = 0; r < REP_WPREP; ++r) phase_wprep_out(F, L); }
            else if (sub == 2) {
                if (L & 1) { for (int r = 1; r < REP_GDN_CHAIN; ++r) phase_gdn_chain<PROBE_CHAIN_MODE>(F, j); phase_gdn_chain<0>(F, j); }
                else { for (int r = 1; r < REP_SSD_CHAIN; ++r) phase_ssd_chain<true>(F, j); phase_ssd_chain<false>(F, j); } }
            else if (sub == 3) {
                if (L & 1) { for (int r = 1; r < REP_GDN_POST; ++r) phase_gdn_post2<true>(F, j); phase_gdn_post2<false>(F, j); }
                else { for (int r = 1; r < REP_SSD_POST; ++r) phase_ssd_post<true>(F, j); phase_ssd_post<false>(F, j); }
                if (L < 3) { for (int r = 0; r < REP_WPREP; ++r) phase_wprep_in(F, L + 1); } }
            else { for (int r = 1; r < REP_OUTPROJ; ++r) phase_outproj(F, L, true); phase_outproj(F, L, false); }
        }
        if (ph + 1 < args.ph_hi) {
            if (ph == args.ph_lo) { __threadfence(); cg::this_grid().sync(); }
            else { for (int r = 0; r < REP_BARRIER; ++r) xcd_barrier(bar); }
        }
    }
}

extern "C" void kernel_launch(void* const* d_in, const int* in_sizes, int n_in, void* d_out, int out_size, void* d_ws, size_t ws_size, hipStream_t stream) {
    static int grid = 0;
    if (grid == 0) {
        if (n_in != 24 || ws_size < WS_END) { fprintf(stderr, "kernel_launch: unexpected n_in %d / ws %zu (need %zu)\n", n_in, ws_size, (size_t)WS_END); grid = -1; return; }
        int dev = 0, cus = 0, per_cu = 0;
        if (hipGetDevice(&dev) != hipSuccess || hipDeviceGetAttribute(&cus, hipDeviceAttributeMultiprocessorCount, dev) != hipSuccess) { grid = -1; return; }
        if (hipFuncSetAttribute((const void*)hybrid_fwd, hipFuncAttributeMaxDynamicSharedMemorySize, LDS_BYTES) != hipSuccess) { fprintf(stderr, "kernel_launch: hipFuncSetAttribute failed\n"); grid = -1; return; }
        if (hipOccupancyMaxActiveBlocksPerMultiprocessor(&per_cu, (const void*)hybrid_fwd, NTHREADS, LDS_BYTES) != hipSuccess || per_cu < 1) { fprintf(stderr, "kernel_launch: occupancy query says %d blocks per CU\n", per_cu); grid = -1; return; }
        (void)hipGetLastError();
        grid = cus;
    }
    if (grid < 0) return;
    Args a{};
    for (int i = 0; i < 24; ++i) a.in[i] = (const float*)d_in[i];
    a.out = (float*)d_out; a.ws = (unsigned char*)d_ws;
#if MK_ONE_LAUNCH
    (void)hipMemsetAsync((char*)d_ws + WS_CTL, 0, 32768, stream);
    a.ph_lo = 0; a.ph_hi = N_PHASES;
    void* kargs[] = {&a};
    hipError_t e = hipLaunchCooperativeKernel((const void*)hybrid_fwd, dim3(grid), dim3(NTHREADS), kargs, LDS_BYTES, stream);
    if (e != hipSuccess) fprintf(stderr, "kernel_launch: cooperative launch failed: %s (grid %d)\n", hipGetErrorString(e), grid);
#else
    for (int ph = 0; ph < N_PHASES; ++ph) {
        a.ph_lo = ph; a.ph_hi = ph + 1;
        hipLaunchKernelGGL(hybrid_fwd, dim3(grid), dim3(NTHREADS), LDS_BYTES, stream, a);
    }
#endif
}
```

```cpp
#include <hip/hip_runtime.h>
#include <hip/hip_cooperative_groups.h>
#include <cstdio>
#include <cstdint>
namespace cg = cooperative_groups;

#define LAS __attribute__((address_space(3)))
typedef unsigned short bf16_t;
typedef short bf16x8 __attribute__((ext_vector_type(8)));
typedef float f32x4 __attribute__((ext_vector_type(4)));
typedef unsigned u32x4 __attribute__((ext_vector_type(4)));
typedef unsigned u32x2 __attribute__((ext_vector_type(2)));

constexpr int D = 1024;
constexpr int SEQ = 8192, NMETA = 16, PADF = 48;
constexpr int TPP = 8256;
constexpr int ROW_S0 = 2 * TPP;
constexpr int M_TOT = ROW_S0 + 128;
constexpr int NSEQ = 10;
constexpr float EPS = 1e-6f;
constexpr int LDP = 6144;
constexpr int SSD_INNER = 2048, SSD_HEADS = 32, SSD_P = 64, SSD_N = 128, SSD_CONV = 3072, SSD_IN = 5152, SSD_IN_PAD = 5376;
constexpr int GDN_HEADS = 8, GDN_DK = 128, GDN_DV = 256, GDN_CONV = 4096, GDN_VAL = 2048, GDN_IN = 6160, GDN_IN_PAD = 6400;

constexpr size_t O_YP = 0, O_YS = 16777216, O_PSSD = 16908288, O_PSSDC = 17956864, O_PGDN = 17993728, O_PGDNC = 19042304,
                 O_SSSD = 19091456, O_SSSDC = 23285760, O_SGDN = 23433216, O_SGDNC = 27627520;

constexpr size_t WS_CTL = 0;
constexpr size_t WS_HB = 65536;
constexpr size_t WS_WIN = WS_HB + (size_t)M_TOT * D * 2;
constexpr size_t WS_WOUT = WS_WIN + (size_t)GDN_IN_PAD * D * 2;
constexpr size_t WS_TAIL = WS_WOUT + (size_t)1024 * 2048 * 2;
constexpr size_t WS_DTB = WS_TAIL + (size_t)258 * 3 * 4096 * 2;
constexpr size_t WS_RSS = WS_DTB + (size_t)M_TOT * 32 * 4;
constexpr size_t WS_PROJ = WS_RSS + (size_t)M_TOT * 16 * 4;
constexpr size_t WS_END = WS_PROJ + (size_t)M_TOT * LDP * 2;

constexpr int NTHREADS = 512;
constexpr int LDS_BYTES = 147456;

#define KEEP(x) asm volatile("" :: "v"(x))
#ifndef REP_INPROJ
#define REP_INPROJ 1
#endif
#ifndef REP_SSD_PREP
#define REP_SSD_PREP 1
#endif
#ifndef REP_SSD_CHAIN
#define REP_SSD_CHAIN 1
#endif
#ifndef REP_GDN_PREP
#define REP_GDN_PREP 1
#endif
#ifndef REP_GDN_CHAIN
#define REP_GDN_CHAIN 1
#endif
#ifndef REP_WPREP
#define REP_WPREP 1
#endif
#ifndef PROBE_SPAN_SUB
#define PROBE_SPAN_SUB -1
#endif
#ifndef PROBE_BUSY
#define PROBE_BUSY 0
#endif
#define BUSY_T0(id) unsigned long long bz_t0 = 0ull; if (PROBE_BUSY == (id) && blockIdx.x == 0) bz_t0 = __builtin_amdgcn_s_memrealtime();
#define BUSY_T0B(id) if (PROBE_BUSY == (id) && blockIdx.x == 0) bz_t0 = __builtin_amdgcn_s_memrealtime();
#define BUSY_T1(id, wv) if (PROBE_BUSY == (id) && blockIdx.x == 0 && threadIdx.x == 64 * (wv)) atomicAdd((unsigned long long*)(F.ws + 49152), __builtin_amdgcn_s_memrealtime() - bz_t0);
#ifndef PROBE_SPAN_PAR
#define PROBE_SPAN_PAR 0
#endif
#ifndef PROBE_SPAN_MODE
#define PROBE_SPAN_MODE 0
#endif
#ifndef PROBE_INPROJ_K
#define PROBE_INPROJ_K 1024
#endif
#ifndef REP_OUTPROJ
#define REP_OUTPROJ 1
#endif
#ifndef REP_SSD_POST
#define REP_SSD_POST 1
#endif
#ifndef REP_GDN_POST
#define REP_GDN_POST 1
#endif
#ifndef REP_SUBST
#define REP_SUBST 1
#endif
#ifndef REP_BARRIER
#define REP_BARRIER 1
#endif
#ifndef REP_FINAL
#define REP_FINAL 1
#endif
#ifndef MK_ONE_LAUNCH
#define MK_ONE_LAUNCH 1
#endif
__device__ __forceinline__ float bf2f(bf16_t b) { return __uint_as_float(((unsigned)b) << 16); }
typedef __bf16 bf16v2_t __attribute__((ext_vector_type(2)));
typedef float f32x2_t __attribute__((ext_vector_type(2)));
__device__ __forceinline__ unsigned cvt_pk_bf16(float lo, float hi) { const bf16v2_t r = __builtin_convertvector((f32x2_t){lo, hi}, bf16v2_t); return __builtin_bit_cast(unsigned, r); }
__device__ __forceinline__ bf16_t f2bf(float f) { return (bf16_t)(cvt_pk_bf16(f, f) & 0xffffu); }
__device__ __forceinline__ float silu_f(float x) { return x * __builtin_amdgcn_rcpf(1.0f + __expf(-x)); }
__device__ __forceinline__ float softplus_f(float x) { return x > 20.f ? x : __logf(1.0f + __expf(x)); }
__device__ __forceinline__ float wave_sum(float v) {
#pragma unroll
    for (int o = 32; o >= 1; o >>= 1) v += __shfl_xor(v, o);
    return v;
}
__device__ __forceinline__ int seq_base(int s) { return s < 2 ? s * TPP + 64 - NMETA : ROW_S0 + 16 * (s - 2); }
__device__ __forceinline__ int seq_len(int s) { return s < 2 ? SEQ + NMETA : 16; }
__device__ __forceinline__ int seq_chunks(int s) { return s < 2 ? 129 : 1; }

namespace pg8 {
constexpr int BM = 256, BK = 64, HALF = 128, HTB = HALF * BK * 2, STAGE_BYTES = 8 * HTB, NXCD = 8, WGM = 8;
__device__ __forceinline__ int lds_byte(int r, int c) { const int st = (r >> 4) * 2 + (c >> 5), rr = r & 15, cc = c & 31, ob = rr * 64 + cc * 2; return st * 1024 + (ob ^ (((ob >> 9) & 1) << 5)); }
__device__ __forceinline__ void stage_rc(int b, int& R, int& C) { const int st = b / 1024, sb = b % 1024, swz = sb ^ (((sb >> 9) & 1) << 5); R = (st >> 1) * 16 + swz / 64; C = (st & 1) * 32 + (swz % 64) / 2; }
__device__ __forceinline__ int perm32(int rho) { const int n = rho >> 4, i = rho & 15; return 8 * (i >> 2) + 4 * n + (i & 3); }
struct Unit { int pm, pn; };
struct Gemm { const bf16_t* A; const bf16_t* Bt; int M, N, K, lda, ldb; };
struct StaticOrder {
    int nM, nN, nwg, G, c, imax, xpm, xpn;
    __device__ void init(int M, int N, int G_, int c_) { nM = M / BM; nN = N / BM; nwg = nM * nN; G = G_; c = c_; imax = 1 << 30; xpm = -1; xpn = 0; }
    __device__ bool main_unit(int i, int cc, Unit& u) const {
        const long L = (long)i * G + cc; if (L >= nwg) return false;
        int wgid = (int)L; { const int q = nwg / NXCD, r = nwg % NXCD, xcd = wgid % NXCD, off = wgid / NXCD; wgid = (xcd < r ? xcd * (q + 1) : r * (q + 1) + (xcd - r) * q) + off; }
        const int nig = WGM * nN, gid = wgid / nig, fm = gid * WGM, gsz = (nM - fm) < WGM ? (nM - fm) : WGM;
        u.pm = fm + ((wgid % nig) % gsz); u.pn = (wgid % nig) / gsz; return true;
    }
    __device__ int count_main() const { int n = 0; while ((long)n * G + c < nwg) ++n; return n; }
    __device__ bool next(int i, Unit& u) const {
        if (i < imax) { if (main_unit(i, c, u)) return true; if (xpm < 0 || i != count_main()) return false; u.pm = xpm; u.pn = xpn; return true; }
        if (i == imax && xpm >= 0) { u.pm = xpm; u.pn = xpn; return true; }
        return false;
    }
};


template <class Epi>
__device__ __forceinline__ void gemm_phase(LAS unsigned char* lds, const Gemm g, const StaticOrder& S, const Epi& E, const int tid) {
    const int wid = __builtin_amdgcn_readfirstlane(tid >> 6), lane = tid & 63, wr = wid >> 2, wc = wid & 3, fr = lane & 15, fq = lane >> 4;
    const int K = g.K, nt = K / BK;
    unsigned voffA[2], voffB[2];
#pragma unroll
    for (int i = 0; i < 2; ++i) { int R, C; stage_rc(tid * 16 + i * 8192, R, C); const int Rb = Epi::PERM ? ((R & ~31) + perm32(R & 31)) : R;
        voffA[i] = (unsigned)(R * g.lda + C) * 2u; voffB[i] = (unsigned)(Rb * g.ldb + C) * 2u; }
    const size_t kstep = (size_t)(BK * 2);
    const size_t hstepA = (size_t)HALF * g.lda * 2, hstepB = (size_t)HALF * g.ldb * 2;
    const size_t tstepA = 2 * hstepA, tstepB = 2 * hstepB;
    const unsigned ldsw = (unsigned)wid * 1024u;
    const int aoff = lds_byte(wr * 64 + fr, fq * 8), boff = lds_byte(wc * 32 + fr, fq * 8);
#define PG8_SA(b, h) (((b) * 2 + (h)) * HTB)
#define PG8_SB(b, h) ((4 + (b) * 2 + (h)) * HTB)
#define PG8_STAGE(bufoff, gbase, voff) do { _Pragma("unroll") for (int _i = 0; _i < 2; ++_i) \
        __builtin_amdgcn_global_load_lds((const unsigned*)((const char*)(gbase) + (voff)[_i]), (LAS unsigned*)(lds + (bufoff) + ldsw + _i * 8192), 16, 0, 0); } while (0)
#define PG8_LDA(dst, b, h) do { _Pragma("unroll") for (int m = 0; m < 4; ++m) _Pragma("unroll") for (int k = 0; k < 2; ++k) dst[m][k] = *(const LAS bf16x8*)(lds + PG8_SA(b, h) + aoff + m * 2048 + k * 1024); } while (0)
#define PG8_LDB(dst, b, h) do { _Pragma("unroll") for (int n = 0; n < 2; ++n) _Pragma("unroll") for (int k = 0; k < 2; ++k) dst[n][k] = *(const LAS bf16x8*)(lds + PG8_SB(b, h) + boff + n * 2048 + k * 1024); } while (0)
#define PG8_MMA(ai, bj, At, Bt) do { __builtin_amdgcn_s_setprio(1); _Pragma("unroll") for (int m = 0; m < 4; ++m) _Pragma("unroll") for (int n = 0; n < 2; ++n) _Pragma("unroll") for (int k = 0; k < 2; ++k) \
        acc[ai][bj][m][n] = __builtin_amdgcn_mfma_f32_16x16x32_bf16(Bt[n][k], At[m][k], acc[ai][bj][m][n], 0, 0, 0); __builtin_amdgcn_s_setprio(0); } while (0)
#define PG8_WAIT_V(n) asm volatile("s_waitcnt vmcnt(" #n ")" ::: "memory")
#define PG8_WAIT_L(n) asm volatile("s_waitcnt lgkmcnt(" #n ")" ::: "memory")
#define PG8_BAR __builtin_amdgcn_s_barrier()
#define PG8_SCHED __builtin_amdgcn_sched_barrier(0)
    Unit cur, nxt; int ui = 0;
    if (!S.next(0, cur)) return;
    f32x4 acc[2][2][4][2];
#pragma unroll
    for (int a = 0; a < 2; ++a)
#pragma unroll
        for (int b = 0; b < 2; ++b)
#pragma unroll
            for (int m = 0; m < 4; ++m)
#pragma unroll
                for (int n = 0; n < 2; ++n) acc[a][b][m][n] = (f32x4){0.f, 0.f, 0.f, 0.f};
    bf16x8 At[4][2], B0[2][2], B1[2][2];
    const char* cA = (const char*)g.A + (size_t)cur.pm * tstepA; const char* cB = (const char*)g.Bt + (size_t)cur.pn * tstepB;
    PG8_STAGE(PG8_SB(0, 0), cB, voffB); PG8_STAGE(PG8_SA(0, 0), cA, voffA); PG8_STAGE(PG8_SB(0, 1), cB + hstepB, voffB); PG8_STAGE(PG8_SA(0, 1), cA + hstepA, voffA);
    if (wr == 1) PG8_BAR;
    PG8_WAIT_V(4); PG8_BAR;
    PG8_STAGE(PG8_SB(1, 0), cB + kstep, voffB); PG8_STAGE(PG8_SA(1, 0), cA + kstep, voffA); PG8_STAGE(PG8_SB(1, 1), cB + hstepB + kstep, voffB);
    PG8_WAIT_V(6); PG8_BAR;
    for (;;) {
        const bool has_next = S.next(ui + 1, nxt);
        const char* nA = has_next ? (const char*)g.A + (size_t)nxt.pm * tstepA : cA; const char* nB = has_next ? (const char*)g.Bt + (size_t)nxt.pn * tstepB : cB;
        for (int t = 0; t < nt; t += 2) {
            const bool last = (t == nt - 2);
            const char* a1 = cA + (size_t)(t + 1) * kstep;
            const char* a2 = last ? nA : cA + (size_t)(t + 2) * kstep; const char* b2 = last ? nB : cB + (size_t)(t + 2) * kstep;
            const char* a3 = a2 + kstep; const char* b3 = b2 + kstep;
            PG8_LDB(B0, 0, 0); PG8_SCHED; PG8_LDA(At, 0, 0); PG8_STAGE(PG8_SA(1, 1), a1 + hstepA, voffA);
            PG8_WAIT_L(8); PG8_BAR; PG8_WAIT_L(0); PG8_MMA(0, 0, At, B0); PG8_BAR; PG8_SCHED;
            PG8_LDB(B1, 0, 1); PG8_STAGE(PG8_SB(0, 0), b2, voffB);
            PG8_BAR; PG8_WAIT_L(0); PG8_MMA(0, 1, At, B1); PG8_BAR;
            PG8_LDA(At, 0, 1); PG8_STAGE(PG8_SA(0, 0), a2, voffA);
            PG8_BAR; PG8_WAIT_L(0); PG8_MMA(1, 0, At, B0); PG8_BAR; PG8_SCHED;
            PG8_STAGE(PG8_SB(0, 1), b2 + hstepB, voffB);
            PG8_WAIT_V(6); PG8_BAR; PG8_MMA(1, 1, At, B1); PG8_BAR;
            PG8_LDB(B0, 1, 0); PG8_SCHED; PG8_LDA(At, 1, 0); PG8_STAGE(PG8_SA(0, 1), a2 + hstepA, voffA);
            PG8_WAIT_L(8); PG8_BAR; PG8_WAIT_L(0); PG8_MMA(0, 0, At, B0); PG8_BAR; PG8_SCHED;
            PG8_LDB(B1, 1, 1); PG8_STAGE(PG8_SB(1, 0), b3, voffB);
            PG8_BAR; PG8_WAIT_L(0); PG8_MMA(0, 1, At, B1); PG8_BAR;
            PG8_LDA(At, 1, 1); PG8_STAGE(PG8_SA(1, 0), a3, voffA);
            PG8_BAR; PG8_WAIT_L(0); PG8_MMA(1, 0, At, B0); PG8_BAR; PG8_SCHED;
            PG8_STAGE(PG8_SB(1, 1), b3 + hstepB, voffB);
            PG8_WAIT_V(6); PG8_BAR; PG8_MMA(1, 1, At, B1); PG8_BAR;
        }
        E(acc, cur, wr, wc, fr, fq);
        if (!has_next) break;
#pragma unroll
        for (int a = 0; a < 2; ++a)
#pragma unroll
            for (int b = 0; b < 2; ++b)
#pragma unroll
                for (int m = 0; m < 4; ++m)
#pragma unroll
                    for (int n = 0; n < 2; ++n) acc[a][b][m][n] = (f32x4){0.f, 0.f, 0.f, 0.f};
        cur = nxt; cA = nA; cB = nB; ++ui;
    }
    PG8_WAIT_V(0);
    if (wr == 0) PG8_BAR;
    PG8_BAR;
#undef PG8_SA
#undef PG8_SB
#undef PG8_STAGE
#undef PG8_LDA
#undef PG8_LDB
#undef PG8_MMA
#undef PG8_WAIT_V
#undef PG8_WAIT_L
#undef PG8_BAR
#undef PG8_SCHED
}

struct EpiInProj {
    static constexpr bool PERM = true;
    bf16_t* proj; float* dtb; const float* rowss; int nt_main; bf16_t* tails; int tl_lo, tl_hi; bool dry;
    __device__ __forceinline__ void operator()(const f32x4 (&acc)[2][2][4][2], const Unit& u, int wr, int wc, int fr, int fq) const {
        const int row0 = u.pm * BM + wr * 64 + fr;
#pragma unroll
        for (int ai = 0; ai < 2; ++ai)
#pragma unroll
            for (int m = 0; m < 4; ++m) {
                const int r = row0 + ai * HALF + m * 16;
                const f32x4* rp = (const f32x4*)(rowss + (size_t)r * 16);
                const f32x4 p0 = rp[0], p1 = rp[1], p2 = rp[2], p3 = rp[3];
                const float ss = ((p0[0] + p0[1]) + (p0[2] + p0[3])) + ((p1[0] + p1[1]) + (p1[2] + p1[3])) + ((p2[0] + p2[1]) + (p2[2] + p2[3])) + ((p3[0] + p3[1]) + (p3[2] + p3[3]));
                const float rstd = rsqrtf(ss * (1.0f / 1024.0f) + EPS);
                if (u.pn < nt_main) {
                    bf16_t* rowp = proj + (size_t)r * LDP + u.pn * BM + wc * 32 + 8 * fq;
#pragma unroll
                    for (int bj = 0; bj < 2; ++bj) { const f32x4 v0 = acc[ai][bj][m][0] * rstd, v1 = acc[ai][bj][m][1] * rstd;
                        u32x4 w; w.x = cvt_pk_bf16(v0[0], v0[1]); w.y = cvt_pk_bf16(v0[2], v0[3]); w.z = cvt_pk_bf16(v1[0], v1[1]); w.w = cvt_pk_bf16(v1[2], v1[3]);
                        if (dry) { KEEP(w); continue; }
                        *(u32x4*)(rowp + bj * HALF) = w;
                        if (u.pn >= tl_lo && u.pn < tl_hi && r < ROW_S0 && (r & 63) >= 61) *(u32x4*)(tails + ((size_t)(r >> 6) * 3 + ((r & 63) - 61)) * 4096 + (u.pn - tl_lo) * BM + wc * 32 + 8 * fq + bj * HALF) = w; }
                } else if (wc == 0) {
                    float* dp = dtb + (size_t)r * 32 + 8 * fq;
                    if (!dry) { *(f32x4*)(dp) = acc[ai][0][m][0] * rstd; *(f32x4*)(dp + 4) = acc[ai][0][m][1] * rstd; }
                }
            }
    }
};
struct EpiOutProj {
    static constexpr bool PERM = false;
    bf16_t* hb; float* rowss; bool dry; bool wt;
    __device__ __forceinline__ void operator()(const f32x4 (&acc)[2][2][4][2], const Unit& u, int wr, int wc, int fr, int fq) const {
        const int row0 = u.pm * BM + wr * 64 + fr, col0 = u.pn * BM + wc * 32 + 4 * fq;
#pragma unroll
        for (int ai = 0; ai < 2; ++ai)
#pragma unroll
            for (int m = 0; m < 4; ++m) {
                const int r = row0 + ai * HALF + m * 16; float ss = 0.f;
                bf16_t* rowp = hb + (size_t)r * D + col0;
#pragma unroll
                for (int bj = 0; bj < 2; ++bj)
#pragma unroll
                    for (int n = 0; n < 2; ++n) {
                        u32x2* p = (u32x2*)(rowp + bj * HALF + n * 16); const u32x2 o = *p;
                        const f32x4 a = acc[ai][bj][m][n];
                        const float h0 = __uint_as_float(o.x << 16) + a[0], h1 = __uint_as_float(o.x & 0xffff0000u) + a[1];
                        const float h2 = __uint_as_float(o.y << 16) + a[2], h3 = __uint_as_float(o.y & 0xffff0000u) + a[3];
                        ss += (h0 * h0 + h1 * h1) + (h2 * h2 + h3 * h3);
                        u32x2 w; w.x = cvt_pk_bf16(h0, h1); w.y = cvt_pk_bf16(h2, h3);
                        if (dry) KEEP(w); else if (wt) __hip_atomic_store((unsigned long long*)p, ((unsigned long long)w.y << 32) | w.x, __ATOMIC_RELAXED, __HIP_MEMORY_SCOPE_AGENT); else *p = w;
                    }
                ss += __shfl_xor(ss, 16); ss += __shfl_xor(ss, 32);
                if (fq == 0) { if (dry) KEEP(ss); else if (wt) __hip_atomic_store(rowss + (size_t)r * 16 + u.pn * 4 + wc, ss, __ATOMIC_RELAXED, __HIP_MEMORY_SCOPE_AGENT); else rowss[(size_t)r * 16 + u.pn * 4 + wc] = ss; }
            }
    }
};
}

#define XB_TMO      128
#define XB_XCNT(j)  (256  + 64 * (j))
#define XB_XSUB(j)  (1280 + 64 * (j))
#define XB_XGEN(j)  (2304 + 64 * (j))
#define XB_TOP      3328
#define XB_TOPGEN   3392
#define XCD_BAR_WORDS 3456
#define XB_SPIN_CAP (1u << 24)
__device__ __forceinline__ unsigned xb_ld(unsigned* p)              { return __hip_atomic_load(p, __ATOMIC_RELAXED, __HIP_MEMORY_SCOPE_AGENT); }
__device__ __forceinline__ unsigned xb_add(unsigned* p, unsigned v) { return __hip_atomic_fetch_add(p, v, __ATOMIC_RELAXED, __HIP_MEMORY_SCOPE_AGENT); }
__device__ __forceinline__ unsigned xb_xcc_id() { return (unsigned)__builtin_amdgcn_s_getreg((3 << 11) | 20) & 0xFu; }
#define XB_SPIN(cond, bar) do { unsigned _sp = 0; while (cond) { __builtin_amdgcn_s_sleep(1); \
    if ((++_sp & 255u) == 0u) { if (xb_ld(&(bar)[XB_TMO])) break; if (_sp > XB_SPIN_CAP) { atomicAdd(&(bar)[XB_TMO], 1u); break; } } } } while (0)
struct XcdBarrier { unsigned* bar; unsigned x; volatile LAS unsigned* st; };
__device__ __forceinline__ XcdBarrier xcd_barrier_post(unsigned* bar, volatile LAS unsigned* st) {
    XcdBarrier b; b.bar = bar; b.x = xb_xcc_id(); b.st = st;
    if (threadIdx.x == 0) (void)xb_add(&bar[XB_XCNT(b.x)], 1u);
    return b;
}
__device__ __forceinline__ void xcd_barrier_complete(unsigned* bar, unsigned x, unsigned& nloc, unsigned& nx) {
    const unsigned G = gridDim.x * gridDim.y * gridDim.z;
    unsigned sum, cnt, mine, sp = 0u;
    for (;;) {
        sum = 0u; cnt = 0u; mine = 0u;
#pragma unroll
        for (unsigned j = 0; j < 16; ++j) { const unsigned c = xb_ld(&bar[XB_XCNT(j)]); sum += c; cnt += (c > 0u) ? 1u : 0u; mine = (j == x) ? c : mine; }
        if (sum == G) break;
        __builtin_amdgcn_s_sleep(1);
        if ((++sp & 255u) == 0u) { if (xb_ld(&bar[XB_TMO])) break; if (sp > XB_SPIN_CAP) { atomicAdd(&bar[XB_TMO], 1u); break; } }
    }
    nloc = mine > 0u ? mine : 1u; nx = cnt > 0u ? cnt : 1u;
}
__device__ __forceinline__ void xcd_barrier(const XcdBarrier& b) {
    asm volatile("s_waitcnt vmcnt(0)" ::: "memory");
    __syncthreads();
    if (threadIdx.x == 0) {
        unsigned* bar = b.bar;
        __builtin_amdgcn_s_waitcnt(0);
        unsigned nloc = b.st[0], nx = b.st[1];
        if (nloc == 0u) { xcd_barrier_complete(bar, b.x, nloc, nx); b.st[0] = nloc; b.st[1] = nx; }
        const unsigned old = xb_add(&bar[XB_XSUB(b.x)], 1u);
        const unsigned gen = old / nloc;
        if (old + 1u == (gen + 1u) * nloc) {
            __builtin_amdgcn_fence(__ATOMIC_RELEASE, "agent");
            asm volatile("s_waitcnt vmcnt(0)" ::: "memory");
            const unsigned og = xb_add(&bar[XB_TOP], 1u);
            const unsigned tg = og / nx;
            if (og + 1u == (tg + 1u) * nx) xb_add(&bar[XB_TOPGEN], 1u);
            else XB_SPIN(xb_ld(&bar[XB_TOPGEN]) == tg, bar);
            __builtin_amdgcn_fence(__ATOMIC_ACQUIRE, "agent");
            xb_add(&bar[XB_XGEN(b.x)], 1u);
            asm volatile("s_waitcnt vmcnt(0)" ::: "memory");
        } else {
            XB_SPIN(xb_ld(&bar[XB_XGEN(b.x)]) == gen, bar);
            __builtin_amdgcn_fence(__ATOMIC_ACQUIRE, "agent");
            asm volatile("s_waitcnt vmcnt(0)" ::: "memory");
        }
    }
    __syncthreads();
}

struct Args { const float* in[24]; float* out; unsigned char* ws; int ph_lo, ph_hi; };

struct Frame {
    const Args* ap; float* out; unsigned char* ws;
    __device__ __forceinline__ const float* inp(int i) const { asm volatile("" : "+s"(i)); return ap->in[i]; }
    unsigned char* lds; LAS unsigned char* ldsl;
    int tid, lane, wave, G, bid;
    bf16_t* hb; bf16_t* win; bf16_t* wout; float* dtb; float* rss; bf16_t* proj; bf16_t* tails;
};

__device__ __forceinline__ Frame relaunder(Frame F) {
    int t = F.tid; asm volatile("" : "+v"(t));
    F.tid = t; F.lane = t & 63; F.wave = __builtin_amdgcn_readfirstlane(t >> 6);
    unsigned wlo = __builtin_amdgcn_readfirstlane((unsigned)(unsigned long long)F.ws), whi = __builtin_amdgcn_readfirstlane((unsigned)((unsigned long long)F.ws >> 32));
    asm volatile("" : "+s"(wlo), "+s"(whi));
    unsigned char* w = (unsigned char*)(__attribute__((address_space(1))) unsigned char*)(((unsigned long long)whi << 32) | wlo);
    F.ws = w; F.hb = (bf16_t*)(w + WS_HB); F.win = (bf16_t*)(w + WS_WIN); F.wout = (bf16_t*)(w + WS_WOUT);
    F.dtb = (float*)(w + WS_DTB); F.rss = (float*)(w + WS_RSS); F.proj = (bf16_t*)(w + WS_PROJ); F.tails = (bf16_t*)(w + WS_TAIL);
    return F;
}
__device__ __forceinline__ void phase_init_h(const Frame& F0) {
    const Frame F = relaunder(F0);
    const float* xp = F.inp(0); const float* xs = F.inp(1); const float* meta = F.inp(6);
    for (int row = F.bid * 8 + F.wave; row < M_TOT; row += F.G * 8) {
        const float* src = nullptr;
        if (row < ROW_S0) { const int b = row / TPP, r = row % TPP; if (r >= 64) src = xp + ((size_t)b * SEQ + (r - 64)) * D; else if (r >= PADF) src = meta + (size_t)(r - PADF) * D; }
        else src = xs + (size_t)(row - ROW_S0) * D;
        float ss = 0.f;
#pragma unroll
        for (int i = 0; i < 4; ++i) {
            f32x4 v = (f32x4){0.f, 0.f, 0.f, 0.f};
            if (src) v = *(const f32x4*)(src + (F.lane + 64 * i) * 4);
            ss += (v[0] * v[0] + v[1] * v[1]) + (v[2] * v[2] + v[3] * v[3]);
            u32x2 w; w.x = cvt_pk_bf16(v[0], v[1]); w.y = cvt_pk_bf16(v[2], v[3]);
            *(u32x2*)(F.hb + (size_t)row * D + (F.lane + 64 * i) * 4) = w;
        }
        ss = wave_sum(ss);
        if (F.lane < 16) F.rss[(size_t)row * 16 + F.lane] = (F.lane == 0) ? ss : 0.f;
    }
}

__device__ void transpose_convert(const Frame& F, const float* src, int K, int N, int Npad, bf16_t* dst, const float* scale, int smod) {
    float* tile = (float*)F.lds;
    const int ntk = K / 64, ntn = Npad / 64, ntile = ntk * ntn;
    __syncthreads();
    for (int ti = F.bid; ti < ntile; ti += F.G) {
        const int kt = ti % ntk, nt_ = ti / ntk, k0 = kt * 64, n0 = nt_ * 64;
        const int kk = F.tid >> 4, n4 = (F.tid & 15) * 4;
#pragma unroll
        for (int h = 0; h < 2; ++h) {
            const int k = k0 + kk + 32 * h, n = n0 + n4;
            f32x4 v = (f32x4){0.f, 0.f, 0.f, 0.f};
            if (n < N) v = *(const f32x4*)(src + (size_t)k * N + n);
            const float s = scale[k % smod];
            float* tp = tile + (kk + 32 * h) * 65 + n4;
            tp[0] = v[0] * s; tp[1] = v[1] * s; tp[2] = v[2] * s; tp[3] = v[3] * s;
        }
        __syncthreads();
        const int nn = F.tid >> 3, kg = (F.tid & 7) * 8;
        float x[8];
#pragma unroll
        for (int j = 0; j < 8; ++j) x[j] = tile[(kg + j) * 65 + nn];
        u32x4 w; w.x = cvt_pk_bf16(x[0], x[1]); w.y = cvt_pk_bf16(x[2], x[3]); w.z = cvt_pk_bf16(x[4], x[5]); w.w = cvt_pk_bf16(x[6], x[7]);
        *(u32x4*)(dst + (size_t)(n0 + nn) * K + k0 + kg) = w;
        __syncthreads();
    }
}
__device__ __forceinline__ void phase_wprep_in(const Frame& F0, int L) {
    const Frame F = relaunder(F0);
    const int j = L >> 1;
    if ((L & 1) == 0) transpose_convert(F, F.inp(8) + (size_t)j * D * SSD_IN, D, SSD_IN, SSD_IN_PAD, F.win, F.inp(7) + j * D, D);
    else transpose_convert(F, F.inp(17) + (size_t)j * D * GDN_IN, D, GDN_IN, GDN_IN_PAD, F.win, F.inp(16) + j * D, D);
}
__device__ __forceinline__ void phase_wprep_out(const Frame& F0, int L) {
    const Frame F = relaunder(F0);
    const int j = L >> 1;
    if ((L & 1) == 0) transpose_convert(F, F.inp(15) + (size_t)j * SSD_INNER * D, SSD_INNER, D, D, F.wout, F.inp(14) + j * SSD_INNER, SSD_INNER);
    else transpose_convert(F, F.inp(22) + (size_t)j * GDN_VAL * D, GDN_VAL, D, D, F.wout, F.inp(21) + j * GDN_DV, GDN_DV);
}

constexpr size_t WS_READY = 40960;
__device__ __forceinline__ void phase_inproj(const Frame& F0, int L) {
    const Frame F = relaunder(F0);
    const int npad = (L & 1) ? GDN_IN_PAD : SSD_IN_PAD, nN = npad / 256;
    const bool gated = (F.G == 256) && L >= 1;
    unsigned* ready = (unsigned*)(F.ws + WS_READY) + L;
    pg8::Gemm g{F.hb, F.win, M_TOT, npad, D, D, D};
    pg8::EpiInProj E{F.proj, F.dtb, F.rss, nN - 1, F.tails, (L & 1) ? 0 : 8, 16, false};
    for (int pass = 0; pass < (gated ? 2 : 1); ++pass) {
        pg8::StaticOrder S;
        if (!gated) S.init(M_TOT, npad, F.G, F.bid);
        else if (pass == 0) {
            S.init(64 * 256, npad, F.G, F.bid);
            const int n = S.count_main();
            if (F.bid >= 252) S.imax = n - 2;
            else if (F.bid >= 64 + nN && F.bid < 72 + nN) {
                const int k = F.bid - 64 - nN; pg8::StaticOrder D2 = S; D2.c = 252 + (k & 3); pg8::Unit u; if (D2.main_unit(D2.count_main() - 1 - (k >> 2), D2.c, u)) { S.xpm = u.pm; S.xpn = u.pn; } }
        } else {
            if (F.bid < 64 || F.bid >= 64 + nN) break;
            if (F.tid < 64) {
                unsigned spins = 0;
                while ((unsigned)__builtin_amdgcn_readfirstlane(__hip_atomic_load(ready, __ATOMIC_RELAXED, __HIP_MEMORY_SCOPE_AGENT)) < 32u) { __builtin_amdgcn_s_sleep(4); if (++spins > (1u << 22)) break; }
                __builtin_amdgcn_fence(__ATOMIC_ACQUIRE, "agent");
                asm volatile("s_waitcnt vmcnt(0)" ::: "memory");
            }
            __syncthreads();
            S.init(64 * 256, npad, F.G, F.bid); S.imax = 0; S.xpm = 64; S.xpn = F.bid - 64;
        }
        pg8::gemm_phase<pg8::EpiInProj>(F.ldsl, g, S, E, F.tid);
    }
}
__device__ __forceinline__ void phase_outproj(const Frame& F0, int L, bool leftover) {
    const Frame F = relaunder(F0);
    const bf16_t* A = F.proj + ((L & 1) ? 4096 : 0);
    const bool split = (F.G == 256) && L < 3;
    if (leftover && (!split || F.bid < 252)) return;
    pg8::Gemm g{A, F.wout, M_TOT, D, 2048, LDP, 2048};
    pg8::StaticOrder S;
    if (leftover) { S.init(M_TOT, D, F.G, F.bid); S.imax = 0; S.xpm = 64; S.xpn = F.bid - 252; }
    else S.init(split ? 64 * 256 : M_TOT, D, F.G, F.bid);
    pg8::EpiOutProj E{F.hb, F.rss, false, leftover};
    pg8::gemm_phase<pg8::EpiOutProj>(F.ldsl, g, S, E, F.tid);
    if (leftover) {
        asm volatile("s_waitcnt vmcnt(0)" ::: "memory");
        if (F.lane == 0) __hip_atomic_fetch_add((unsigned*)(F.ws + WS_READY) + L + 1, 1u, __ATOMIC_RELAXED, __HIP_MEMORY_SCOPE_AGENT);
        __syncthreads();
    }
}

constexpr int NCHT = 266;
constexpr size_t SC_BT = 0;
constexpr size_t SC_C = SC_BT + (size_t)NCHT * 4 * 16384;
constexpr size_t SC_CB = SC_C + (size_t)NCHT * 4 * 16384;
constexpr size_t SC_VEC = SC_CB + (size_t)NCHT * 4 * 8192;
constexpr size_t SC_XS = SC_VEC + (size_t)NCHT * 32 * 1024;
constexpr size_t SC_HSEG = SC_XS + (size_t)256 * 8192;
constexpr size_t SC_CUM = SC_HSEG + (size_t)256 * 8192 * 4;
constexpr size_t SC_SSD_END = SC_CUM + (size_t)258 * 32 * 4;
constexpr int SEGL = 33;
static_assert(SC_SSD_END <= (size_t)16777216 * 4, "scratch must fit the y_prompt region");
__device__ __forceinline__ int qperm(int s) { return (s & ~31) | (((s >> 2) & 3) << 3) | (((s >> 4) & 1) << 2) | (s & 3); }
__device__ __forceinline__ int qnat(int q) { return (q & ~31) | (((q >> 2) & 1) << 4) | (((q >> 3) & 3) << 2) | (q & 3); }
__device__ __forceinline__ bf16x8 pack8(f32x4 a, f32x4 b) {
    u32x4 w; w.x = cvt_pk_bf16(a[0], a[1]); w.y = cvt_pk_bf16(a[2], a[3]); w.z = cvt_pk_bf16(b[0], b[1]); w.w = cvt_pk_bf16(b[2], b[3]);
    return __builtin_bit_cast(bf16x8, w);
}
__device__ __forceinline__ void chunk_of(int cgi, int& seq, int& c) { if (cgi < 258) { seq = cgi / 129; c = cgi % 129; } else { seq = 2 + (cgi - 258); c = 0; } }
__device__ __forceinline__ int cgi_of(int seq, int c) { return seq < 2 ? seq * 129 + c : 258 + (seq - 2); }
struct XTile { bf16_t* p; int stride; };
__device__ __forceinline__ XTile ssd_xtile(const Frame& F, int seq, int c, int head) {
    XTile t;
    if (seq < 2) { t.p = F.proj + (size_t)(seq * TPP + 64 * c) * LDP + 2048 + head * 64; t.stride = LDP; }
    else { t.p = (bf16_t*)((unsigned char*)F.out + SC_XS) + (size_t)((seq - 2) * 32 + head) * 4096; t.stride = 64; }
    return t;
}

__device__ __forceinline__ void ssd_xraw_load(unsigned short (&raw)[32], const Frame& F, int task, int pg) {
    const int cgi = task >> 2, grp = task & 3; int seq, c; chunk_of(cgi, seq, c);
    const int base = seq_base(seq), t0 = 64 * c - PADF + 32 * pg;
    const bf16_t* xcol = F.proj + 2048 + (grp * 8 + (F.tid >> 6)) * 64 + (F.tid & 63);
#pragma unroll
    for (int e = 0; e < 32; ++e) { const int t = t0 + e; raw[e] = xcol[(size_t)(base + (t > 0 ? t : 0)) * LDP]; }
}
__device__ __forceinline__ void ssd_aux_load(float (&aux)[4], const Frame& F, int j, int task) {
    const int cgi = task >> 2, grp = task & 3; int seq, c; chunk_of(cgi, seq, c);
    const int cidx = (grp * 8 + (F.tid >> 6)) * 64 + (F.tid & 63);
    aux[0] = 0.f; aux[1] = 0.f; aux[2] = 0.f; aux[3] = 0.f;
    if (seq < 2 && c > 0) { const bf16_t* tp = F.tails + (size_t)(cgi - 1) * 3 * 4096 + cidx; aux[0] = bf2f(tp[0]); aux[1] = bf2f(tp[4096]); aux[2] = bf2f(tp[2 * 4096]); }
    else if (seq >= 2) { const float* cst = F.inp(3) + (((size_t)j * 8 + (seq - 2)) * 3) * SSD_CONV + cidx; aux[0] = cst[0]; aux[1] = cst[SSD_CONV]; aux[2] = cst[2 * SSD_CONV]; }
    { const int t = 64 * c - PADF + F.lane; if (t >= 0) aux[3] = F.dtb[(size_t)(seq_base(seq) + t) * 32 + grp * 8 + F.wave]; }
}
__device__ __forceinline__ void ssd_xconv32(const unsigned short (&raw)[32], bf16_t* xrow32, int tb, float w0, float w1, float w2, float w3, float cb, float& r3, float& r2, float& r1) {
#pragma unroll
    for (int e8 = 0; e8 < 4; ++e8) {
        float o[8];
#pragma unroll
        for (int h = 0; h < 8; ++h) {
            const int t = tb + 8 * e8 + h;
            const float v = (t >= 0) ? bf2f(raw[8 * e8 + h]) : 0.f;
            o[h] = silu_f(cb + w0 * r3 + w1 * r2 + w2 * r1 + w3 * v);
            if (t >= 0) { r3 = r2; r2 = r1; r1 = v; }
        }
        u32x4 w; w.x = cvt_pk_bf16(o[0], o[1]); w.y = cvt_pk_bf16(o[2], o[3]); w.z = cvt_pk_bf16(o[4], o[5]); w.w = cvt_pk_bf16(o[6], o[7]);
        *(u32x4*)(xrow32 + 8 * e8) = w;
    }
}
template <bool DRY>
__device__ __forceinline__ void phase_ssd_prep(const Frame& F0, int j) {
    const Frame F = relaunder(F0);
    bf16_t* Bs = (bf16_t*)F.lds + 512 * 72;
    bf16_t* Cs = Bs + 64 * 136;
    unsigned char* sc = (unsigned char*)F.out;
    const float* conv_w = F.inp(9) + (size_t)j * 4 * SSD_CONV; const float* conv_b = F.inp(10) + (size_t)j * SSD_CONV;
    const int i16 = F.lane & 15, g4 = F.lane >> 4;
    unsigned long long bz_t0 = 0ull;
    unsigned short rawA[32]; float aux[4];
    if (F.bid < NCHT * 4) { ssd_xraw_load(rawA, F, F.bid, 0); ssd_aux_load(aux, F, j, F.bid); }
    int wgrp = -1; float xw0 = 0.f, xw1 = 0.f, xw2 = 0.f, xw3 = 0.f, xcb = 0.f, bw0 = 0.f, bw1 = 0.f, bw2 = 0.f, bw3 = 0.f, bcb = 0.f, negA = 0.f, dtbias = 0.f;
    for (int task = F.bid; task < NCHT * 4; task += F.G) {
        const int cgi = task >> 2, grp = task & 3; int seq, c; chunk_of(cgi, seq, c);
        const int base = seq_base(seq), t0 = 64 * c - PADF;
        const int bch = F.tid & 255, half = F.tid >> 8, isC = bch >> 7, bn = bch & 127, bidx = 2048 + isC * 512 + grp * 128 + bn;
        if (grp != wgrp) {
            wgrp = grp;
            const int cidx = (grp * 8 + (F.tid >> 6)) * 64 + (F.tid & 63);
            xw0 = conv_w[cidx]; xw1 = conv_w[SSD_CONV + cidx]; xw2 = conv_w[2 * SSD_CONV + cidx]; xw3 = conv_w[3 * SSD_CONV + cidx]; xcb = conv_b[cidx];
            bw0 = conv_w[bidx]; bw1 = conv_w[SSD_CONV + bidx]; bw2 = conv_w[2 * SSD_CONV + bidx]; bw3 = conv_w[3 * SSD_CONV + bidx]; bcb = conv_b[bidx];
            negA = -__expf(F.inp(12)[j * SSD_HEADS + grp * 8 + F.wave]); dtbias = F.inp(11)[j * SSD_HEADS + grp * 8 + F.wave];
        }
        const float dtraw = aux[3];
        __syncthreads();
        if (task != F.bid) { BUSY_T1(13, 0) } BUSY_T0B(11)
        unsigned short rawC[35];
        {
            const int hl = F.tid >> 6, p = F.tid & 63, head = grp * 8 + hl;
            float r3 = aux[0], r2 = aux[1], r1 = aux[2];
            bf16_t* xrow = (bf16_t*)F.lds + F.tid * 72;
            unsigned short rawB[32];
            ssd_xraw_load(rawB, F, task, 1);
            ssd_xconv32(rawA, xrow, t0, xw0, xw1, xw2, xw3, xcb, r3, r2, r1);
            {   const bf16_t* col = F.proj + 2048 + bidx;
#pragma unroll
                for (int e = 0; e < 35; ++e) { const int t = t0 + half * 32 - 3 + e; rawC[e] = col[(size_t)(base + (t > 0 ? t : 0)) * LDP]; } }
            ssd_xconv32(rawB, xrow + 32, t0 + 32, xw0, xw1, xw2, xw3, xcb, r3, r2, r1);
            const XTile xt = ssd_xtile(F, seq, c, head);
#pragma unroll
            for (int q = 0; q < 8; ++q) { const u32x4 w = *(const u32x4*)(xrow + 8 * q);
                if (!DRY) *(u32x4*)(xt.p + (size_t)p * xt.stride + 8 * q) = w; else KEEP(w); }
        }
        BUSY_T1(11, 0) BUSY_T0B(12)
        {
            const float* cst = (seq >= 2) ? F.inp(3) + (((size_t)j * 8 + (seq - 2)) * 3) * SSD_CONV : nullptr;
            bf16_t* dst = (isC ? Cs : Bs) + bn;
            float r3, r2, r1;
            {   float rv[3];
#pragma unroll
                for (int q = 0; q < 3; ++q) { const int t = t0 + half * 32 - 3 + q; float v = 0.f;
                    if (t >= 0) v = bf2f(rawC[q]); else if (t >= -3 && cst) v = cst[(3 + t) * SSD_CONV + bidx];
                    rv[q] = v; }
                r3 = rv[0]; r2 = rv[1]; r1 = rv[2]; }
#pragma unroll
            for (int ii = 0; ii < 32; ++ii) {
                const int p = half * 32 + ii, t = t0 + p; float v = 0.f;
                if (t >= 0) v = bf2f(rawC[ii + 3]); else if (t >= -3 && cst) v = cst[(3 + t) * SSD_CONV + bidx];
                const float o = silu_f(bcb + bw0 * r3 + bw1 * r2 + bw2 * r1 + bw3 * v);
                r3 = r2; r2 = r1; r1 = v;
                dst[p * 136] = f2bf(o);
            }
        }
        if (task + F.G < NCHT * 4) { ssd_xraw_load(rawA, F, task + F.G, 0); ssd_aux_load(aux, F, j, task + F.G); }
        __syncthreads();
        BUSY_T1(12, 0) BUSY_T0B(13)
        {
            bf16_t* BT = (bf16_t*)(sc + SC_BT) + (size_t)(cgi * 4 + grp) * 8192;
            const int n = F.tid >> 2, qg = (F.tid & 3) * 16;
#pragma unroll
            for (int u = 0; u < 2; ++u) {
                const int q0 = qg + 8 * u; unsigned short e[8];
#pragma unroll
                for (int jj = 0; jj < 8; ++jj) e[jj] = Bs[qnat(q0 + jj) * 136 + n];
                u32x4 w; w.x = e[0] | ((unsigned)e[1] << 16); w.y = e[2] | ((unsigned)e[3] << 16); w.z = e[4] | ((unsigned)e[5] << 16); w.w = e[6] | ((unsigned)e[7] << 16);
                if (!DRY) *(u32x4*)(BT + n * 64 + q0) = w; else KEEP(w);
            }
            bf16_t* Cg = (bf16_t*)(sc + SC_C) + (size_t)(cgi * 4 + grp) * 8192;
#pragma unroll
            for (int u = 0; u < 2; ++u) {
                const int idx = F.tid + 512 * u, l = idx >> 4, qg8 = idx & 15, kk = qg8 >> 2, gg = qg8 & 3;
                const u32x2 a = *(const u32x2*)(Cs + l * 136 + 32 * kk + 4 * gg), b = *(const u32x2*)(Cs + l * 136 + 32 * kk + 16 + 4 * gg);
                u32x4 w; w.x = a.x; w.y = a.y; w.z = b.x; w.w = b.y;
                if (!DRY) *(u32x4*)(Cg + l * 128 + 8 * qg8) = w; else KEEP(w);
            }
        }
        {
            bf16_t* CB = (bf16_t*)(sc + SC_CB) + (size_t)(cgi * 4 + grp) * 4096;
            const int m = F.wave >> 1;
#pragma unroll
            for (int u = 0; u < 2; ++u) {
                const int st = 2 * (F.wave & 1) + u; f32x4 acc = (f32x4){0.f, 0.f, 0.f, 0.f};
#pragma unroll
                for (int kk = 0; kk < 4; ++kk) {
                    const bf16x8 a = *(const bf16x8*)(Cs + (16 * m + i16) * 136 + 32 * kk + 8 * g4);
                    const bf16x8 b = *(const bf16x8*)(Bs + (16 * st + i16) * 136 + 32 * kk + 8 * g4);
                    acc = __builtin_amdgcn_mfma_f32_16x16x32_bf16(a, b, acc, 0, 0, 0);
                }
                const int qs = qperm(16 * st + i16);
#pragma unroll
                for (int jj = 0; jj < 4; ++jj) { if (!DRY) CB[(16 * m + 4 * g4 + jj) * 64 + qs] = f2bf(acc[jj]); else KEEP(acc[jj]); }
            }
        }
        {
            const int head = grp * 8 + F.wave, t = t0 + F.lane;
            float dt = 0.f;
            if (t >= 0) dt = softplus_f(dtraw + dtbias);
            float cs = dt * negA;
#pragma unroll
            for (int o = 1; o < 64; o <<= 1) { const float y = __shfl_up(cs, o); if (F.lane >= o) cs += y; }
            const float cs_last = __int_as_float(__builtin_amdgcn_readlane(__float_as_int(cs), 63)), cs_be = __int_as_float(__builtin_amdgcn_ds_bpermute((F.lane | 3) << 2, __float_as_int(cs)));
            float* vp = (float*)(sc + SC_VEC) + (size_t)(cgi * 32 + head) * 256;
            const float v1 = __expf(cs_be - cs) * dt, v2 = dt * __expf(cs_last - cs), v3 = __expf(cs);
            if (!DRY) { vp[F.lane] = cs; vp[64 + F.lane] = v1; vp[128 + F.lane] = v2; vp[192 + F.lane] = v3; } else { KEEP(v1); KEEP(v2); KEEP(v3); }
        }
    }
}

constexpr int SL_C = 0, SL_BT = 16384, SL_M = 32768, SL_XT = 40960, SL_VEC = 49152, SL_SIZE = 50176;
struct SsdLdOff { unsigned o16, xt[2], cs[2][3], vec; };
__device__ __forceinline__ SsdLdOff ssd_ld_offsets(int lt, int xstride) {
    SsdLdOff o; o.o16 = (unsigned)lt * 16u; o.vec = (unsigned)(64 + 4 * (lt < 48 ? lt : 0)) * 4u;
#pragma unroll
    for (int r = 0; r < 2; ++r) { const int k = lt + 256 * r, l = k >> 3, ch = k & 7, sa = 32 * (ch >> 2) + 4 * (ch & 3);
        o.xt[r] = (unsigned)(l * xstride + ch * 8) * 2u; o.cs[r][0] = (unsigned)l * 4u; o.cs[r][1] = (unsigned)(sa + 3) * 4u; o.cs[r][2] = (unsigned)(sa + 19) * 4u; }
    return o;
}
__device__ __forceinline__ void ssd_stage_load(u32x4 (&P)[15], unsigned (&D)[4], const Frame& F, const unsigned char* sc, const SsdLdOff& o, int seq, int head, int c) {
    const int cgi = cgi_of(seq, c), grp = head >> 3;
    const char* Cp = (const char*)(sc + SC_C) + (size_t)(cgi * 4 + grp) * 16384;
    const char* BTp = (const char*)(sc + SC_BT) + (size_t)(cgi * 4 + grp) * 16384;
    const char* CBp = (const char*)(sc + SC_CB) + (size_t)(cgi * 4 + grp) * 8192;
    const char* vp = (const char*)(sc + SC_VEC) + (size_t)(cgi * 32 + head) * 1024;
    const char* xp = (const char*)ssd_xtile(F, seq, c, head).p;
#pragma unroll
    for (int r = 0; r < 4; ++r) { P[r] = *(const u32x4*)(Cp + 4096 * r + o.o16); P[4 + r] = *(const u32x4*)(BTp + 4096 * r + o.o16); }
#pragma unroll
    for (int r = 0; r < 2; ++r) {
        P[8 + r] = *(const u32x4*)(CBp + 4096 * r + o.o16);
        D[r] = *(const unsigned*)(vp + o.cs[r][0]);
        P[13 + r] = *(const u32x4*)(xp + o.xt[r]); }
    D[2] = *(const unsigned*)(vp + o.cs[0][1]); D[3] = *(const unsigned*)(vp + o.cs[0][2]);
    P[10] = *(const u32x4*)(vp + o.vec);
}
__device__ __forceinline__ void ssd_stage_write(const u32x4 (&P)[15], const unsigned (&D)[4], LAS unsigned char* img, int lt) {
#pragma unroll
    for (int r = 0; r < 4; ++r) { const int k = lt + 256 * r;
        { const int row = k >> 4, ch = k & 15; *(LAS u32x4*)(img + SL_C + (row * 16 + (ch ^ (row & 15))) * 16) = P[r]; }
        { const int row = k >> 3, ch = k & 7; *(LAS u32x4*)(img + SL_BT + (row * 8 + (ch ^ ((row >> 1) & 7))) * 16) = P[4 + r]; } }
#pragma unroll
    for (int r = 0; r < 2; ++r) {
        const int k = lt + 256 * r, l = k >> 3, ch = k & 7, sa = 32 * (ch >> 2) + 4 * (ch & 3), sb = sa + 16;
        const float csl = __uint_as_float(D[r]), e1a = __expf(csl - __uint_as_float(D[2])), e1b = __expf(csl - __uint_as_float(D[3]));
        const u32x4 cbw = P[8 + r]; f32x4 va, vb;
        va[0] = (sa + 0 <= l) ? __uint_as_float(cbw.x << 16) * e1a : 0.f; va[1] = (sa + 1 <= l) ? __uint_as_float(cbw.x & 0xffff0000u) * e1a : 0.f;
        va[2] = (sa + 2 <= l) ? __uint_as_float(cbw.y << 16) * e1a : 0.f; va[3] = (sa + 3 <= l) ? __uint_as_float(cbw.y & 0xffff0000u) * e1a : 0.f;
        vb[0] = (sb + 0 <= l) ? __uint_as_float(cbw.z << 16) * e1b : 0.f; vb[1] = (sb + 1 <= l) ? __uint_as_float(cbw.z & 0xffff0000u) * e1b : 0.f;
        vb[2] = (sb + 2 <= l) ? __uint_as_float(cbw.w << 16) * e1b : 0.f; vb[3] = (sb + 3 <= l) ? __uint_as_float(cbw.w & 0xffff0000u) * e1b : 0.f;
        u32x4 w; w.x = cvt_pk_bf16(va[0], va[1]); w.y = cvt_pk_bf16(va[2], va[3]); w.z = cvt_pk_bf16(vb[0], vb[1]); w.w = cvt_pk_bf16(vb[2], vb[3]);
        const int slot = l * 8 + (ch ^ ((l >> 1) & 7));
        *(LAS u32x4*)(img + SL_M + slot * 16) = w;
        *(LAS u32x4*)(img + SL_XT + slot * 16) = P[13 + r];
    }
    if (lt < 48) *(LAS u32x4*)(img + SL_VEC + 16 * lt) = P[10];
}
template <bool DRY>
__device__ __forceinline__ void phase_ssd_chain(const Frame& F0, int j) {
    const Frame F = relaunder(F0);
    const unsigned char* sc = (const unsigned char*)F.out;
    const bool loader = F.wave >= 4; const int lt = F.tid - 256, ps = F.wave & 3;
    for (int sh = F.bid; sh < 512; sh += F.G) {
        int seq, head, seg = 0, c0 = 0, nch = 1;
        if (sh < 256) { const int k = sh >> 3, s_ = ((k >> 3) << 3) | (sh & 7); seq = s_ >> 4; head = ((s_ >> 2) & 3) * 8 + (k & 7); seg = s_ & 3; c0 = SEGL * seg; nch = seg == 3 ? 129 - 3 * SEGL : SEGL; }
        else { seq = 2 + ((sh - 256) >> 5); head = sh & 31; }
        const float dsk = F.inp(13)[j * SSD_HEADS + head];
        __syncthreads();
        if (loader) {
            u32x4 A[15], B[15]; unsigned DA[4], DB[4];
            const SsdLdOff lo = ssd_ld_offsets(lt, ssd_xtile(F, seq, 0, head).stride);
            ssd_stage_load(A, DA, F, sc, lo, seq, head, c0); ssd_stage_write(A, DA, F.ldsl, lt);
            if (nch > 1) ssd_stage_load(B, DB, F, sc, lo, seq, head, c0 + 1);
            if (nch > 2) ssd_stage_load(A, DA, F, sc, lo, seq, head, c0 + 2);
            __syncthreads();
#define SSD_LOADER_STEP(CC, ST, DT) { BUSY_T0(2) const int cc_ = (CC); int nxt = ((cc_ + 1) & 1) * SL_SIZE, lt_ = lt; asm volatile("" : "+s"(nxt), "+v"(lt_)); \
                { BUSY_T0(5) if (cc_ + 1 < nch) ssd_stage_write(ST, DT, F.ldsl + nxt, lt_); BUSY_T1(5, 4) } \
                { BUSY_T0(6) if (cc_ + 3 < nch) ssd_stage_load(ST, DT, F, sc, lo, seq, head, c0 + cc_ + 3); BUSY_T1(6, 4) } \
                BUSY_T1(2, 4) \
                __syncthreads(); }
            for (int c = 0; c < nch; c += 2) {
                SSD_LOADER_STEP(c, B, DB)
                if (c + 1 < nch) SSD_LOADER_STEP(c + 1, A, DA)
            }
#undef SSD_LOADER_STEP
        } else {
            f32x4 HT[8];
#pragma unroll
            for (int m8 = 0; m8 < 8; ++m8) HT[m8] = (f32x4){0.f, 0.f, 0.f, 0.f};
            if (seq >= 2) {
                const int i = F.lane & 15, g = F.lane >> 4;
                const float* st = F.inp(2) + ((((size_t)j * 8 + (seq - 2)) * SSD_HEADS + head) * SSD_P + ps * 16 + i) * SSD_N + 4 * g;
#pragma unroll
                for (int m8 = 0; m8 < 8; ++m8) HT[m8] = *(const f32x4*)(st + 16 * m8);
            }
            __syncthreads();
            for (int c = 0; c < nch; ++c) {
                BUSY_T0(1)
                int cur = (c & 1) * SL_SIZE, lane_ = F.lane;
                asm volatile("" : "+s"(cur), "+v"(lane_));
                LAS unsigned char* img = F.ldsl + cur;
                const int i = lane_ & 15, g = lane_ >> 4, prow = ps * 16 + i, psw = (prow >> 1) & 7;
                const LAS unsigned char* pc[4]; const LAS unsigned char* pm[2];
#pragma unroll
                for (int kk = 0; kk < 4; ++kk) pc[kk] = img + SL_C + i * 256 + (((4 * kk + g) ^ i) * 16);
#pragma unroll
                for (int k2 = 0; k2 < 2; ++k2) pm[k2] = img + i * 128 + (((4 * k2 + g) ^ (i >> 1)) * 16);
                const float ecl = *(const LAS float*)(img + SL_VEC + 512 + 63 * 4);
                bf16x8 Hf[4];
#pragma unroll
                for (int kk = 0; kk < 4; ++kk) Hf[kk] = pack8(HT[2 * kk], HT[2 * kk + 1]);
                f32x4 Y[4];
                bf16x8 fr[2][4]; u32x2 xw[4]; f32x4 yf[4]; bf16x8 xsf[2], xwf[2];
                LAS unsigned char* xrow = img + SL_XT + prow * 128 + 8 * (g & 1);
#define SSB() __builtin_amdgcn_sched_barrier(0)
#define SLD_C(SET, M) { _Pragma("unroll") for (int kk = 0; kk < 4; ++kk) fr[SET][kk] = *(const LAS bf16x8*)(pc[kk] + (M) * 4096); }
#define SLD_M(SET, QH) { _Pragma("unroll") for (int q = 0; q < 2; ++q) { _Pragma("unroll") for (int k2 = 0; k2 < 2; ++k2) fr[SET][2 * q + k2] = *(const LAS bf16x8*)(pm[k2] + SL_M + (2 * (QH) + q) * 2048); } }
#define SLD_B(SET, H) { _Pragma("unroll") for (int q = 0; q < 2; ++q) { _Pragma("unroll") for (int k2 = 0; k2 < 2; ++k2) fr[SET][2 * q + k2] = *(const LAS bf16x8*)(pm[k2] + SL_BT + (2 * (H) + q) * 2048); } }
#define SLD_YF(M) yf[M] = *(const LAS f32x4*)(img + SL_VEC + 512 + (16 * (M) + 4 * g) * 4);
#define SMM_C(SET, M) { f32x4 acc = (f32x4){0.f, 0.f, 0.f, 0.f}; \
                    _Pragma("unroll") for (int kk = 0; kk < 4; ++kk) acc = __builtin_amdgcn_mfma_f32_16x16x32_bf16(fr[SET][kk], Hf[kk], acc, 0, 0, 0); \
                    Y[M] = acc * yf[M]; }
#define SMM_M(SET, QH) { _Pragma("unroll") for (int k2 = 0; k2 < 2; ++k2) { _Pragma("unroll") for (int q = 0; q < 2; ++q) Y[2 * (QH) + q] = __builtin_amdgcn_mfma_f32_16x16x32_bf16(fr[SET][2 * q + k2], xsf[k2], Y[2 * (QH) + q], 0, 0, 0); } }
#define SMM_B(SET, H) { f32x4 ac0 = HT[2 * (H)] * ecl, ac1 = HT[2 * (H) + 1] * ecl; \
                    _Pragma("unroll") for (int k2 = 0; k2 < 2; ++k2) { ac0 = __builtin_amdgcn_mfma_f32_16x16x32_bf16(fr[SET][k2], xwf[k2], ac0, 0, 0, 0); ac1 = __builtin_amdgcn_mfma_f32_16x16x32_bf16(fr[SET][2 + k2], xwf[k2], ac1, 0, 0, 0); } \
                    HT[2 * (H)] = ac0; HT[2 * (H) + 1] = ac1; }
#define SXPREP(K2) { const f32x4 ea = *(const LAS f32x4*)(img + SL_VEC + (32 * (K2) + 4 * g) * 4), eb = *(const LAS f32x4*)(img + SL_VEC + (32 * (K2) + 16 + 4 * g) * 4); \
                    const f32x4 wa = *(const LAS f32x4*)(img + SL_VEC + 256 + (32 * (K2) + 4 * g) * 4), wb = *(const LAS f32x4*)(img + SL_VEC + 256 + (32 * (K2) + 16 + 4 * g) * 4); \
                    f32x4 xa, xb; xa[0] = __uint_as_float(xw[2 * (K2)].x << 16); xa[1] = __uint_as_float(xw[2 * (K2)].x & 0xffff0000u); xa[2] = __uint_as_float(xw[2 * (K2)].y << 16); xa[3] = __uint_as_float(xw[2 * (K2)].y & 0xffff0000u); \
                    xb[0] = __uint_as_float(xw[2 * (K2) + 1].x << 16); xb[1] = __uint_as_float(xw[2 * (K2) + 1].x & 0xffff0000u); xb[2] = __uint_as_float(xw[2 * (K2) + 1].y << 16); xb[3] = __uint_as_float(xw[2 * (K2) + 1].y & 0xffff0000u); \
                    xsf[K2] = pack8(xa * ea, xb * eb); xwf[K2] = pack8(xa * wa, xb * wb); }
                SLD_C(0, 0)
#pragma unroll
                for (int m = 0; m < 4; ++m) xw[m] = *(const LAS u32x2*)(xrow + ((2 * m + (g >> 1)) ^ psw) * 16);
                SLD_YF(0) SSB();
                SLD_C(1, 1) SLD_YF(1) SSB(); SMM_C(0, 0) SSB();
                SXPREP(0) SSB();
                SLD_C(0, 2) SLD_YF(2) SSB(); SMM_C(1, 1) SSB();
                SXPREP(1) SSB();
                SLD_C(1, 3) SLD_YF(3) SSB(); SMM_C(0, 2) SSB();
                SLD_M(0, 0) SSB(); SMM_C(1, 3) SSB();
                SLD_M(1, 1) SSB(); SMM_M(0, 0) SSB();
                SLD_B(0, 0) SSB(); SMM_M(1, 1) SSB();
                SLD_B(1, 1) SSB(); SMM_B(0, 0) SSB();
                SLD_B(0, 2) SSB(); SMM_B(1, 1) SSB();
                SLD_B(1, 3) SSB(); SMM_B(0, 2) SSB();
                SMM_B(1, 3)
#undef SSB
#undef SLD_C
#undef SLD_M
#undef SLD_B
#undef SLD_YF
#undef SMM_C
#undef SMM_M
#undef SMM_B
#undef SXPREP
                {
                    const XTile xt = ssd_xtile(F, seq, c0 + c, head);
                    u32x2 yw[4];
#pragma unroll
                    for (int m = 0; m < 4; ++m) { f32x4 xv; xv[0] = __uint_as_float(xw[m].x << 16); xv[1] = __uint_as_float(xw[m].x & 0xffff0000u); xv[2] = __uint_as_float(xw[m].y << 16); xv[3] = __uint_as_float(xw[m].y & 0xffff0000u);
                        const f32x4 y = Y[m] + xv * dsk; yw[m].x = cvt_pk_bf16(y[0], y[1]); yw[m].y = cvt_pk_bf16(y[2], y[3]); }
#pragma unroll
                    for (int q = 0; q < 2; ++q) {
                        const u32x2 snd = (g & 1) ? yw[2 * q] : yw[2 * q + 1];
                        u32x2 rcv; rcv.x = __shfl_xor(snd.x, 16); rcv.y = __shfl_xor(snd.y, 16);
                        u32x4 w; int l0;
                        if (g & 1) { w.x = rcv.x; w.y = rcv.y; w.z = yw[2 * q + 1].x; w.w = yw[2 * q + 1].y; l0 = 32 * q + 16 + 4 * (g - 1); }
                        else { w.x = yw[2 * q].x; w.y = yw[2 * q].y; w.z = rcv.x; w.w = rcv.y; l0 = 32 * q + 4 * g; }
                        if (!DRY) *(u32x4*)(xt.p + (size_t)prow * xt.stride + l0) = w; else KEEP(w);
                    }
                }
                BUSY_T1(1, 0)
                __syncthreads();
            }
            const int i = F.lane & 15, g = F.lane >> 4;
            float* so = (seq < 2) ? (float*)((unsigned char*)F.out + SC_HSEG) + ((size_t)((seq * 32 + head) * 4 + seg) * SSD_P + ps * 16 + i) * SSD_N + 4 * g
                                  : F.out + O_SSSD + ((((size_t)j * 8 + (seq - 2)) * SSD_HEADS + head) * SSD_P + ps * 16 + i) * SSD_N + 4 * g;
#pragma unroll
            for (int m8 = 0; m8 < 8; ++m8) { if (!DRY) *(f32x4*)(so + 16 * m8) = HT[m8]; else KEEP(HT[m8]); }
        }
    }
}


__device__ __forceinline__ void phase_ssd_combine(const Frame& F0, int j) {
    const Frame F = relaunder(F0);
    unsigned char* sc = (unsigned char*)F.out;
    float* dlog = (float*)F.lds;
    for (int t = F.bid; t < 64; t += F.G) {
        const int seq = t >> 5, head = t & 31;
        __syncthreads();
        if (F.wave < 4) {
            const int seg = F.wave, c0 = SEGL * seg, n = seg == 3 ? 129 - 3 * SEGL : SEGL;
            const int cgi = cgi_of(seq, c0 + (F.lane < n ? F.lane : 0));
            const float v = (F.lane < n) ? ((const float*)(sc + SC_VEC))[(size_t)(cgi * 32 + head) * 256 + 63] : 0.f;
            float inc = v;
#pragma unroll
            for (int o = 1; o < 64; o <<= 1) { const float y = __shfl_up(inc, o); if (F.lane >= o) inc += y; }
            if (F.lane < n) ((float*)(sc + SC_CUM))[cgi * 32 + head] = inc - v;
            if (F.lane == 63) dlog[seg] = inc;
        }
        __syncthreads();
        const float D1 = __expf(dlog[1]), D2 = __expf(dlog[2]), D3 = __expf(dlog[3]);
        float* H = (float*)(sc + SC_HSEG) + (size_t)((seq * 32 + head) * 4) * 8192 + F.tid * 16;
        float* po = F.out + O_PSSD + (((size_t)j * 2 + seq) * SSD_HEADS + head) * 8192 + F.tid * 16;
#pragma unroll
        for (int q = 0; q < 4; ++q) {
            const f32x4 h1 = *(const f32x4*)(H + 4 * q), H1 = *(const f32x4*)(H + 8192 + 4 * q), H2 = *(const f32x4*)(H + 2 * 8192 + 4 * q), H3 = *(const f32x4*)(H + 3 * 8192 + 4 * q);
            const f32x4 h2 = h1 * D1 + H1, h3 = h2 * D2 + H2, fin = h3 * D3 + H3;
            *(f32x4*)(H + 8192 + 4 * q) = h2; *(f32x4*)(H + 2 * 8192 + 4 * q) = h3; *(f32x4*)(po + 4 * q) = fin;
        }
    }
}

template <bool DRY>
__device__ __forceinline__ void phase_ssd_post(const Frame& F0, int j) {
    const Frame F = relaunder(F0);
    constexpr int RL = 524;
    bf16_t* YL = (bf16_t*)F.lds;
    for (int task = F.bid; task < NCHT * 4; task += F.G) {
        const int cgi = task >> 2, grp = task & 3; int seq, c; chunk_of(cgi, seq, c);
        const int base = seq_base(seq), t0 = 64 * c - PADF;
        u32x4 zr[8];
#pragma unroll
        for (int q = 0; q < 8; ++q) { const int l = F.wave + 8 * q, t = t0 + l; const int row = seq < 2 ? seq * TPP + 64 * c + l : base + (t > 0 ? t : 0);
            zr[q] = *(const u32x4*)(F.proj + (size_t)row * LDP + grp * 512 + 8 * F.lane); }
        __syncthreads();
#pragma unroll
        for (int r = 0; r < 8; ++r) {
            const int k = F.tid + 512 * r, hl = k >> 9, p = (k >> 3) & 63, ch = k & 7;
            const XTile xt = ssd_xtile(F, seq, c, grp * 8 + hl);
            const u32x4 w = *(const u32x4*)(xt.p + (size_t)p * xt.stride + ch * 8);
            bf16_t* d = YL + (8 * ch) * RL + hl * 64 + p;
            d[0] = (bf16_t)w.x; d[RL] = (bf16_t)(w.x >> 16); d[2 * RL] = (bf16_t)w.y; d[3 * RL] = (bf16_t)(w.y >> 16);
            d[4 * RL] = (bf16_t)w.z; d[5 * RL] = (bf16_t)(w.z >> 16); d[6 * RL] = (bf16_t)w.w; d[7 * RL] = (bf16_t)(w.w >> 16);
        }
        const bool corr = seq < 2 && c >= SEGL;
        if (corr) {
            const unsigned char* sc = (const unsigned char*)F.out;
            const int head = grp * 8 + F.wave, seg = c / SEGL, i = F.lane & 15, g = F.lane >> 4;
            const float* hk = (const float*)(sc + SC_HSEG) + (size_t)((seq * 32 + head) * 4 + (seg - 1)) * 8192;
            const bf16_t* Cp = (const bf16_t*)(sc + SC_C) + (size_t)(cgi * 4 + grp) * 8192;
            const float* vp = (const float*)(sc + SC_VEC) + (size_t)(cgi * 32 + head) * 256;
            const float cum = ((const float*)(sc + SC_CUM))[cgi * 32 + head];
            bf16_t* CL = YL + 64 * RL;
            bf16x8 cf[4][4];
#pragma unroll
            for (int lt = 0; lt < 4; ++lt)
#pragma unroll
                for (int kk = 0; kk < 4; ++kk) cf[lt][kk] = *(const bf16x8*)(Cp + (16 * lt + i) * 128 + 32 * kk + 8 * g);
            f32x4 fac[4];
#pragma unroll
            for (int lt = 0; lt < 4; ++lt) { const f32x4 cs = *(const f32x4*)(vp + 16 * lt + 4 * g); fac[lt][0] = __expf(cum + cs[0]); fac[lt][1] = __expf(cum + cs[1]); fac[lt][2] = __expf(cum + cs[2]); fac[lt][3] = __expf(cum + cs[3]); }
#pragma unroll
            for (int pt = 0; pt < 4; ++pt) {
                bf16x8 hf[4];
#pragma unroll
                for (int kk = 0; kk < 4; ++kk) { const float* hp = hk + (16 * pt + i) * 128 + 32 * kk + 4 * g; hf[kk] = pack8(*(const f32x4*)hp, *(const f32x4*)(hp + 16)); }
#pragma unroll
                for (int lt = 0; lt < 4; ++lt) {
                    f32x4 acc = (f32x4){0.f, 0.f, 0.f, 0.f};
#pragma unroll
                    for (int kk = 0; kk < 4; ++kk) acc = __builtin_amdgcn_mfma_f32_16x16x32_bf16(cf[lt][kk], hf[kk], acc, 0, 0, 0);
#pragma unroll
                    for (int jj = 0; jj < 4; ++jj) CL[(16 * lt + 4 * g + jj) * RL + F.wave * 64 + 16 * pt + i] = f2bf(acc[jj] * fac[lt][jj]);
                }
            }
        }
        __syncthreads();
#pragma unroll
        for (int q = 0; q < 8; ++q) {
            const int l = F.wave + 8 * q, t = t0 + l;
            if (t < 0 && seq >= 2) continue;
            const int row = seq < 2 ? seq * TPP + 64 * c + l : base + t;
            const u32x2 y0 = *(const u32x2*)(YL + l * RL + 8 * F.lane), y1 = *(const u32x2*)(YL + l * RL + 8 * F.lane + 4);
            u32x2 c0_ = (u32x2){0u, 0u}, c1_ = c0_;
            if (corr) { c0_ = *(const u32x2*)(YL + (64 + l) * RL + 8 * F.lane); c1_ = *(const u32x2*)(YL + (64 + l) * RL + 8 * F.lane + 4); }
            const unsigned yw[4] = {y0.x, y0.y, y1.x, y1.y}; const unsigned cw[4] = {c0_.x, c0_.y, c1_.x, c1_.y}; const unsigned zw[4] = {zr[q].x, zr[q].y, zr[q].z, zr[q].w};
            float yg[8]; float ss = 0.f;
#pragma unroll
            for (int e = 0; e < 4; ++e) {
                yg[2 * e] = (__uint_as_float(yw[e] << 16) + __uint_as_float(cw[e] << 16)) * silu_f(__uint_as_float(zw[e] << 16)); yg[2 * e + 1] = (__uint_as_float(yw[e] & 0xffff0000u) + __uint_as_float(cw[e] & 0xffff0000u)) * silu_f(__uint_as_float(zw[e] & 0xffff0000u));
                ss += yg[2 * e] * yg[2 * e] + yg[2 * e + 1] * yg[2 * e + 1]; }
            ss = wave_sum(ss);
            const float rs = rsqrtf(ss * (1.0f / 512.0f) + EPS);
            u32x4 w; w.x = cvt_pk_bf16(yg[0] * rs, yg[1] * rs); w.y = cvt_pk_bf16(yg[2] * rs, yg[3] * rs); w.z = cvt_pk_bf16(yg[4] * rs, yg[5] * rs); w.w = cvt_pk_bf16(yg[6] * rs, yg[7] * rs);
            if (!DRY) *(u32x4*)(F.proj + (size_t)row * LDP + grp * 512 + 8 * F.lane) = w; else KEEP(w);
        }
    }
    for (int e = F.bid * NTHREADS + F.tid; e < NSEQ * 3 * SSD_CONV; e += F.G * NTHREADS) {
        const int s = e / (3 * SSD_CONV), r = (e / SSD_CONV) % 3, c = e % SSD_CONV;
        const int row = seq_base(s) + seq_len(s) - 3 + r;
        float v;
        if (s < 2 && c < 2048) v = bf2f(F.tails[((size_t)(s * 129 + 128) * 3 + r) * 4096 + c]);
        else v = bf2f(F.proj[(size_t)row * LDP + 2048 + c]);
        if (s < 2) F.out[O_PSSDC + (((size_t)j * 2 + s) * 3 + r) * SSD_CONV + c] = v;
        else F.out[O_SSSDC + (((size_t)j * 8 + (s - 2)) * 3 + r) * SSD_CONV + c] = v;
    }
}

constexpr size_t SG_W = 0;
constexpr size_t SG_QK = SG_W + (size_t)NCHT * 8 * 16384;
constexpr size_t SG_VEC = SG_QK + (size_t)NCHT * 8 * 8192;
constexpr size_t SG_SIDE = SG_VEC + (size_t)NCHT * 8 * 1024;
constexpr size_t SG_END = SG_SIDE + (size_t)64 * 65536;
static_assert(SG_END <= (size_t)16777216 * 4, "scratch must fit the y_prompt region");
struct GTile { bf16_t* q; bf16_t* k; bf16_t* v; int sq, sk, sv; };
__device__ __forceinline__ GTile gdn_tile(const Frame& F, int seq, int c, int head) {
    GTile t;
    if (seq < 2) { bf16_t* r0 = F.proj + (size_t)(seq * TPP + 64 * c) * LDP; t.q = r0 + head * 128; t.k = r0 + 1024 + head * 128; t.v = r0 + 2048 + head * 256; t.sq = LDP; t.sk = LDP; t.sv = LDP; }
    else { bf16_t* b = (bf16_t*)((unsigned char*)F.out + SG_SIDE) + (size_t)((seq - 2) * 8 + head) * 32768; t.q = b; t.k = b + 8192; t.v = b + 16384; t.sq = 128; t.sk = 128; t.sv = 256; }
    return t;
}

__device__ __forceinline__ void gdn_raw_load(unsigned short (&raw)[64], const Frame& F, int task) {
    const int cgi = task >> 3, head = task & 7; int seq, c; chunk_of(cgi, seq, c);
    const int base = seq_base(seq), t0 = 64 * c - PADF;
    const int cch = F.tid < 128 ? head * 128 + F.tid : (F.tid < 256 ? 1024 + head * 128 + (F.tid - 128) : 2048 + head * 256 + (F.tid - 256));
    const bf16_t* col = F.proj + cch;
#pragma unroll
    for (int e = 0; e < 64; ++e) { const int t = t0 + e; raw[e] = col[(size_t)(base + (t > 0 ? t : 0)) * LDP]; }
}
__device__ __forceinline__ void gdn_aux_load(float (&aux)[5], const Frame& F, int j, int task) {
    const int cgi = task >> 3, head = task & 7; int seq, c; chunk_of(cgi, seq, c);
    const int cidx = F.tid < 128 ? head * 128 + F.tid : (F.tid < 256 ? 1024 + head * 128 + (F.tid - 128) : 2048 + head * 256 + (F.tid - 256));
    aux[0] = 0.f; aux[1] = 0.f; aux[2] = 0.f; aux[3] = 0.f; aux[4] = 0.f;
    if (seq < 2 && c > 0) { const bf16_t* tailp = F.tails + (size_t)(cgi - 1) * 3 * 4096 + cidx; aux[0] = bf2f(tailp[0]); aux[1] = bf2f(tailp[4096]); aux[2] = bf2f(tailp[2 * 4096]); }
    else if (seq >= 2) { const float* cst = F.inp(5) + (((size_t)j * 8 + (seq - 2)) * 3) * GDN_CONV + cidx; aux[0] = cst[0]; aux[1] = cst[GDN_CONV]; aux[2] = cst[2 * GDN_CONV]; }
    if (F.wave == 0) { const int t = 64 * c - PADF + F.lane; if (t >= 0) { const float* dp = F.dtb + (size_t)(seq_base(seq) + t) * 32; aux[3] = dp[head]; aux[4] = dp[8 + head]; } }
}
template <bool DRY>
__device__ __forceinline__ void phase_gdn_prep(const Frame& F0, int j) {
    const Frame F = relaunder(F0);
    unsigned long long bz_t0 = 0ull;
    float* Am = (float*)F.lds;
    float* vgc = Am + 64 * 68;
    float* vbe = vgc + 64;
    float* vnq = vbe + 64;
    float* vnk = vnq + 64;
    bf16_t* qs = (bf16_t*)(vnk + 64);
    bf16_t* ks = qs + 64 * 136;
    bf16_t* kT = ks + 64 * 136;
    bf16_t* vT = kT + 128 * 72;
    bf16_t* Tb = vT + 256 * 72;
    bf16_t* TT = Tb + 2 * 64 * 72;
    bf16_t* TD = TT + 64 * 72;
    bf16_t* YT = TD + 2 * 4 * 16 * 24;
    unsigned char* sc = (unsigned char*)F.out;
    const float* conv_w = F.inp(18) + (size_t)j * 4 * GDN_CONV;
    const int i16 = F.lane & 15, g4 = F.lane >> 4;
    constexpr float CQ = 0.08838834764831845f;
    unsigned short raw[64]; float aux[5];
    if (F.bid < NCHT * 8) { gdn_raw_load(raw, F, F.bid); gdn_aux_load(aux, F, j, F.bid); }
    int whead = -1; float w0 = 0.f, w1 = 0.f, w2 = 0.f, w3 = 0.f, negA = 0.f, dtbias = 0.f;
    for (int task = F.bid; task < NCHT * 8; task += F.G) {
        const int cgi = task >> 3, head = task & 7; int seq, c; chunk_of(cgi, seq, c);
        const int t0 = 64 * c - PADF;
        const GTile tl = gdn_tile(F, seq, c, head);
        if (head != whead) {
            whead = head;
            const int cidx = F.tid < 128 ? head * 128 + F.tid : (F.tid < 256 ? 1024 + head * 128 + (F.tid - 128) : 2048 + head * 256 + (F.tid - 256));
            w0 = conv_w[cidx]; w1 = conv_w[GDN_CONV + cidx]; w2 = conv_w[2 * GDN_CONV + cidx]; w3 = conv_w[3 * GDN_CONV + cidx];
            negA = -__expf(F.inp(20)[j * GDN_HEADS + head]); dtbias = F.inp(19)[j * GDN_HEADS + head];
        }
        __syncthreads();
        BUSY_T1(10, 0) BUSY_T0B(7)
        for (int q = F.tid; q < (3 * 64 * 72 + 64 * 24) / 8; q += NTHREADS) { bf16_t* z0 = (q < 3 * 64 * 72 / 8) ? Tb + 8 * q : YT + 8 * (q - 3 * 64 * 72 / 8); *(u32x4*)z0 = (u32x4){0u, 0u, 0u, 0u}; }
        if (F.wave == 0) {
            const int t = t0 + F.lane; float gg = 0.f, be = 0.f;
            if (t >= 0) { gg = negA * softplus_f(aux[3] + dtbias); be = 1.0f / (1.0f + __expf(-aux[4])); }
#pragma unroll
            for (int o = 1; o < 64; o <<= 1) { const float y = __shfl_up(gg, o); if (F.lane >= o) gg += y; }
            vgc[F.lane] = gg; vbe[F.lane] = be;
        }
        __syncthreads();
        {
            const int ch = F.tid;
            float r3 = aux[0], r2 = aux[1], r1 = aux[2];
#pragma unroll
            for (int e8 = 0; e8 < 8; ++e8) {
                float o[8];
#pragma unroll
                for (int h = 0; h < 8; ++h) {
                    const int p = 8 * e8 + h, t = t0 + p;
                    const float x = (t >= 0) ? bf2f(raw[p]) : 0.f;
                    o[h] = silu_f(w0 * r3 + w1 * r2 + w2 * r1 + w3 * x);
                    if (t >= 0) { r3 = r2; r2 = r1; r1 = x; }
                    if (ch < 128) qs[p * 136 + ch] = f2bf(o[h]);
                    else if (ch < 256) ks[p * 136 + (ch - 128)] = f2bf(o[h]);
                    else o[h] *= vbe[p];
                }
                if (ch >= 128) { u32x4 w; w.x = cvt_pk_bf16(o[0], o[1]); w.y = cvt_pk_bf16(o[2], o[3]); w.z = cvt_pk_bf16(o[4], o[5]); w.w = cvt_pk_bf16(o[6], o[7]);
                    bf16_t* d = (ch < 256 ? kT + (ch - 128) * 72 : vT + (ch - 256) * 72) + 8 * e8; *(u32x4*)d = w; }
            }
        }
        if (task + F.G < NCHT * 8) { gdn_raw_load(raw, F, task + F.G); gdn_aux_load(aux, F, j, task + F.G); }
        __syncthreads();
        BUSY_T1(7, 0) BUSY_T0B(8)
        if (F.tid < 128) {
            const int l = F.tid & 63; const bf16_t* rowp = (F.tid < 64 ? qs : ks) + l * 136; float ss = 0.f;
#pragma unroll
            for (int q = 0; q < 16; ++q) { const u32x4 v = *(const u32x4*)(rowp + 8 * q);
                const float a0 = __uint_as_float(v.x << 16), a1 = __uint_as_float(v.x & 0xffff0000u), a2 = __uint_as_float(v.y << 16), a3 = __uint_as_float(v.y & 0xffff0000u);
                const float a4 = __uint_as_float(v.z << 16), a5 = __uint_as_float(v.z & 0xffff0000u), a6 = __uint_as_float(v.w << 16), a7 = __uint_as_float(v.w & 0xffff0000u);
                ss += ((a0 * a0 + a1 * a1) + (a2 * a2 + a3 * a3)) + ((a4 * a4 + a5 * a5) + (a6 * a6 + a7 * a7)); }
            (F.tid < 64 ? vnq : vnk)[l] = rsqrtf(ss + EPS);
        }
        __syncthreads();
        {
            bf16_t* QKg = (bf16_t*)(sc + SG_QK) + (size_t)task * 4096;
            const int m = F.wave >> 1;
#pragma unroll
            for (int u = 0; u < 2; ++u) {
                const int st = 2 * (F.wave & 1) + u; f32x4 aK = (f32x4){0.f, 0.f, 0.f, 0.f}, aQ = (f32x4){0.f, 0.f, 0.f, 0.f};
#pragma unroll
                for (int kk = 0; kk < 4; ++kk) {
                    const bf16x8 ak = *(const bf16x8*)(ks + (16 * m + i16) * 136 + 32 * kk + 8 * g4);
                    const bf16x8 aq = *(const bf16x8*)(qs + (16 * m + i16) * 136 + 32 * kk + 8 * g4);
                    const bf16x8 b = *(const bf16x8*)(ks + (16 * st + i16) * 136 + 32 * kk + 8 * g4);
                    aK = __builtin_amdgcn_mfma_f32_16x16x32_bf16(ak, b, aK, 0, 0, 0);
                    aQ = __builtin_amdgcn_mfma_f32_16x16x32_bf16(aq, b, aQ, 0, 0, 0);
                }
                const int s_ = 16 * st + i16; const float gs = vgc[s_], nks = vnk[s_]; const int qs_ = qperm(s_);
#pragma unroll
                for (int jj = 0; jj < 4; ++jj) {
                    const int l = 16 * m + 4 * g4 + jj;
                    const float dec = (s_ <= l) ? __expf(vgc[l] - gs) : 0.f;
                    Am[l * 68 + s_] = (s_ < l) ? vbe[l] * vnk[l] * nks * aK[jj] * dec : 0.f;
                    { const float r = CQ * vnq[l] * nks * aQ[jj] * dec; if (!DRY) QKg[l * 64 + qs_] = f2bf(r); else KEEP(r); }
                }
            }
        }
        __syncthreads();
        BUSY_T1(8, 0) BUSY_T0B(9)
        if (F.wave == 0) for (int rep = 0; rep < REP_SUBST; ++rep) {
            int ln = F.lane; asm volatile("" : "+v"(ln));
            const int i = ln & 15, g = ln >> 4;
            {   const int b = g, cc = i; float x[16];
#pragma unroll
                for (int r = 0; r < 16; ++r) {
                    float a0 = (r == cc) ? 1.f : 0.f, a1 = 0.f;
#pragma unroll
                    for (int s2 = 0; s2 < r; ++s2) { const float av = Am[(16 * b + r) * 68 + 16 * b + s2]; if (s2 & 1) a1 -= av * x[s2]; else a0 -= av * x[s2]; }
                    x[r] = a0 + a1;
                }
                const int cg = 16 * b + cc; const float csc = vbe[cg] * __expf(vgc[cg]) * vnk[cg];
#pragma unroll
                for (int r = 0; r < 16; ++r) {
                    const bf16_t hi = f2bf(x[r]); const int lg = 16 * b + r;
                    Tb[lg * 72 + cg] = hi; Tb[64 * 72 + lg * 72 + cg] = f2bf(x[r] * csc); TT[cg * 72 + lg] = hi;
                    TD[(b * 16 + r) * 24 + cc] = hi; TD[4 * 16 * 24 + (b * 16 + r) * 24 + cc] = f2bf(x[r] - bf2f(hi));
                }
            }
#pragma unroll
            for (int bi = 1; bi < 4; ++bi) {
#pragma unroll
                for (int nt = 0; nt < bi; ++nt) {
                    f32x4 acc = (f32x4){0.f, 0.f, 0.f, 0.f};
#pragma unroll
                    for (int ks = 0; ks < (16 * bi + 31) / 32; ++ks) {
                        const int k0 = 32 * ks + 8 * g;
                        f32x4 alo4 = (f32x4){0.f, 0.f, 0.f, 0.f}, ahi4 = (f32x4){0.f, 0.f, 0.f, 0.f};
                        if (k0 < 16 * bi) { alo4 = *(const f32x4*)(Am + (16 * bi + i) * 68 + k0); ahi4 = *(const f32x4*)(Am + (16 * bi + i) * 68 + k0 + 4); }
                        const bf16x8 ah = pack8(alo4, ahi4);
                        const u32x4 ahw = __builtin_bit_cast(u32x4, ah);
                        f32x4 r0, r1;
                        r0[0] = alo4[0] - __uint_as_float(ahw.x << 16); r0[1] = alo4[1] - __uint_as_float(ahw.x & 0xffff0000u); r0[2] = alo4[2] - __uint_as_float(ahw.y << 16); r0[3] = alo4[3] - __uint_as_float(ahw.y & 0xffff0000u);
                        r1[0] = ahi4[0] - __uint_as_float(ahw.z << 16); r1[1] = ahi4[1] - __uint_as_float(ahw.z & 0xffff0000u); r1[2] = ahi4[2] - __uint_as_float(ahw.w << 16); r1[3] = ahi4[3] - __uint_as_float(ahw.w & 0xffff0000u);
                        const bf16x8 al = pack8(r0, r1);
                        const bf16x8 bt = *(const bf16x8*)(TT + (16 * nt + i) * 72 + k0);
                        acc = __builtin_amdgcn_mfma_f32_16x16x32_bf16(ah, bt, acc, 0, 0, 0);
                        acc = __builtin_amdgcn_mfma_f32_16x16x32_bf16(al, bt, acc, 0, 0, 0);
                    }
                    u32x2 w; w.x = cvt_pk_bf16(acc[0], acc[1]); w.y = cvt_pk_bf16(acc[2], acc[3]);
                    *(u32x2*)(YT + (16 * nt + i) * 24 + 4 * g) = w;
                }
                bf16x8 th = __builtin_bit_cast(bf16x8, (u32x4){0u, 0u, 0u, 0u}), tlo = th;
                if (g < 2) { th = *(const bf16x8*)(TD + (bi * 16 + i) * 24 + 8 * g); tlo = *(const bf16x8*)(TD + 4 * 16 * 24 + (bi * 16 + i) * 24 + 8 * g); }
#pragma unroll
                for (int nt = 0; nt < bi; ++nt) {
                    bf16x8 yb = __builtin_bit_cast(bf16x8, (u32x4){0u, 0u, 0u, 0u});
                    if (g < 2) yb = *(const bf16x8*)(YT + (16 * nt + i) * 24 + 8 * g);
                    f32x4 acc = (f32x4){0.f, 0.f, 0.f, 0.f};
                    acc = __builtin_amdgcn_mfma_f32_16x16x32_bf16(th, yb, acc, 0, 0, 0);
                    acc = __builtin_amdgcn_mfma_f32_16x16x32_bf16(tlo, yb, acc, 0, 0, 0);
                    const int cg = 16 * nt + i; const float csc = vbe[cg] * __expf(vgc[cg]) * vnk[cg];
                    u32x2 w; w.x = cvt_pk_bf16(-acc[0], -acc[1]); w.y = cvt_pk_bf16(-acc[2], -acc[3]);
                    *(u32x2*)(TT + cg * 72 + 16 * bi + 4 * g) = w;
#pragma unroll
                    for (int jj = 0; jj < 4; ++jj) { const int lg = 16 * bi + 4 * g + jj; Tb[lg * 72 + cg] = f2bf(-acc[jj]); Tb[64 * 72 + lg * 72 + cg] = f2bf(-acc[jj] * csc); }
                }
            }
        } else {
            const int t7 = F.tid - 64;
            const float gl_ = vgc[63];
            for (int idx = t7; idx < 1024; idx += 448) {
                const int l = idx >> 4, qg8 = idx & 15, kk = qg8 >> 2, gg = qg8 & 3;
                const u32x2 a = *(const u32x2*)(qs + l * 136 + 32 * kk + 4 * gg), b = *(const u32x2*)(qs + l * 136 + 32 * kk + 16 + 4 * gg);
                const float sc_ = __expf(vgc[l]) * CQ * vnq[l];
                u32x4 w; w.x = cvt_pk_bf16(__uint_as_float(a.x << 16) * sc_, __uint_as_float(a.x & 0xffff0000u) * sc_); w.y = cvt_pk_bf16(__uint_as_float(a.y << 16) * sc_, __uint_as_float(a.y & 0xffff0000u) * sc_);
                w.z = cvt_pk_bf16(__uint_as_float(b.x << 16) * sc_, __uint_as_float(b.x & 0xffff0000u) * sc_); w.w = cvt_pk_bf16(__uint_as_float(b.y << 16) * sc_, __uint_as_float(b.y & 0xffff0000u) * sc_);
                if (!DRY) *(u32x4*)(tl.q + (size_t)l * tl.sq + 8 * qg8) = w; else KEEP(w);
            }
            for (int idx = t7; idx < 1024; idx += 448) {
                const int kd = idx >> 3, pg = idx & 7, kk2 = pg >> 2, gg = pg & 3, la = 32 * kk2 + 4 * gg, lb = la + 16;
                const u32x2 a = *(const u32x2*)(kT + kd * 72 + la), b = *(const u32x2*)(kT + kd * 72 + lb);
                const f32x4 ga = *(const f32x4*)(vgc + la), gb = *(const f32x4*)(vgc + lb), na = *(const f32x4*)(vnk + la), nb = *(const f32x4*)(vnk + lb);
                u32x4 w;
                w.x = cvt_pk_bf16(__uint_as_float(a.x << 16) * na[0] * __expf(gl_ - ga[0]), __uint_as_float(a.x & 0xffff0000u) * na[1] * __expf(gl_ - ga[1]));
                w.y = cvt_pk_bf16(__uint_as_float(a.y << 16) * na[2] * __expf(gl_ - ga[2]), __uint_as_float(a.y & 0xffff0000u) * na[3] * __expf(gl_ - ga[3]));
                w.z = cvt_pk_bf16(__uint_as_float(b.x << 16) * nb[0] * __expf(gl_ - gb[0]), __uint_as_float(b.x & 0xffff0000u) * nb[1] * __expf(gl_ - gb[1]));
                w.w = cvt_pk_bf16(__uint_as_float(b.y << 16) * nb[2] * __expf(gl_ - gb[2]), __uint_as_float(b.y & 0xffff0000u) * nb[3] * __expf(gl_ - gb[3]));
                if (!DRY) *(u32x4*)(tl.k + (size_t)(kd >> 1) * tl.sk + (kd & 1) * 64 + 8 * pg) = w; else KEEP(w);
            }
            if (t7 < 64) {
                float* vp = (float*)(sc + SG_VEC) + (size_t)task * 256; const float gl = vgc[63];
                const float v0 = __expf(vgc[t7]) * CQ * vnq[t7], v1 = vnk[t7] * __expf(gl - vgc[t7]), v2 = __expf(gl);
                if (!DRY) { vp[t7] = v0; vp[64 + t7] = v1; vp[128 + t7] = v2; vp[192 + t7] = 0.f; } else { KEEP(v0); KEEP(v1); KEEP(v2); }
            }
        }
        __syncthreads();
        BUSY_T1(9, 0) BUSY_T0B(10)
        {
            bf16_t* Wg = (bf16_t*)(sc + SG_W) + (size_t)task * 8192;
            bf16x8 bk[2];
#pragma unroll
            for (int k2 = 0; k2 < 2; ++k2) bk[k2] = *(const bf16x8*)(kT + (16 * F.wave + i16) * 72 + 32 * k2 + 8 * g4);
            const int qkd = qperm(16 * F.wave + i16);
#pragma unroll
            for (int m = 0; m < 4; ++m) {
                f32x4 acc = (f32x4){0.f, 0.f, 0.f, 0.f};
#pragma unroll
                for (int k2 = 0; k2 < 2; ++k2) { const bf16x8 a = *(const bf16x8*)(Tb + 64 * 72 + (16 * m + i16) * 72 + 32 * k2 + 8 * g4); acc = __builtin_amdgcn_mfma_f32_16x16x32_bf16(a, bk[k2], acc, 0, 0, 0); }
#pragma unroll
                for (int jj = 0; jj < 4; ++jj) { if (!DRY) Wg[(16 * m + 4 * g4 + jj) * 128 + qkd] = f2bf(-acc[jj]); else KEEP(acc[jj]); }
            }
#pragma unroll
            for (int u = 0; u < 2; ++u) {
                const int v = 16 * (2 * F.wave + u) + i16;
                bf16x8 bv[2];
#pragma unroll
                for (int k2 = 0; k2 < 2; ++k2) bv[k2] = *(const bf16x8*)(vT + v * 72 + 32 * k2 + 8 * g4);
#pragma unroll
                for (int m = 0; m < 4; ++m) {
                    f32x4 acc = (f32x4){0.f, 0.f, 0.f, 0.f};
#pragma unroll
                    for (int k2 = 0; k2 < 2; ++k2) { const bf16x8 a = *(const bf16x8*)(Tb + (16 * m + i16) * 72 + 32 * k2 + 8 * g4); acc = __builtin_amdgcn_mfma_f32_16x16x32_bf16(a, bv[k2], acc, 0, 0, 0); }
                    u32x2 w; w.x = cvt_pk_bf16(acc[0], acc[1]); w.y = cvt_pk_bf16(acc[2], acc[3]);
                    if (!DRY) *(u32x2*)(tl.v + (size_t)(v >> 2) * tl.sv + (v & 3) * 64 + 16 * m + 4 * g4) = w; else KEEP(w);
                }
            }
        }
    }
}

constexpr int GL_W = 0, GL_Q = 16384, GL_KT = 32768, GL_QK = 49152, GL_U = 57344, GL_VEC = 65536, GL_SIZE = 66560;
__device__ __forceinline__ bf16_t* gdn_urow(const GTile& tl, int v) { return tl.v + (size_t)(v >> 2) * tl.sv + (v & 3) * 64; }
struct GdnLdOff { unsigned o16, q, k, u, vec; };
__device__ __forceinline__ GdnLdOff gdn_ld_offsets(int lt, const GTile& tl) {
    GdnLdOff o; o.o16 = (unsigned)lt * 16u; o.vec = (unsigned)(lt < 48 ? lt : 0) * 16u;
    o.q = (unsigned)((lt >> 4) * tl.sq + (lt & 15) * 8) * 2u;
    o.k = (unsigned)((lt >> 4) * tl.sk + ((lt >> 3) & 1) * 64 + (lt & 7) * 8) * 2u;
    o.u = (unsigned)((lt >> 5) * tl.sv + ((lt >> 3) & 3) * 64 + (lt & 7) * 8) * 2u;
    return o;
}
__device__ __forceinline__ void gdn_stage_load(u32x4 (&P)[17], const Frame& F, const unsigned char* sc, const GdnLdOff& o, int seq, int head, int vq, int c) {
    const int task = cgi_of(seq, c) * 8 + head;
    const GTile tl = gdn_tile(F, seq, c, head);
    const char* Wp = (const char*)(sc + SG_W) + (size_t)task * 16384;
    const char* QKp = (const char*)(sc + SG_QK) + (size_t)task * 8192;
    const char* vp = (const char*)(sc + SG_VEC) + (size_t)task * 1024;
    const char* qp = (const char*)tl.q; const char* kp = (const char*)tl.k; const char* up = (const char*)tl.v + (size_t)(vq * 8) * tl.sv * 2;
#pragma unroll
    for (int r = 0; r < 4; ++r) {
        P[r] = *(const u32x4*)(Wp + 4096 * r + o.o16);
        P[4 + r] = *(const u32x4*)(qp + (size_t)(32 * r) * tl.sq + o.q);
        P[8 + r] = *(const u32x4*)(kp + (size_t)(32 * r) * tl.sk + o.k); }
#pragma unroll
    for (int r = 0; r < 2; ++r) P[12 + r] = *(const u32x4*)(QKp + 4096 * r + o.o16);
    P[14] = *(const u32x4*)(up + o.u);
    P[16] = *(const u32x4*)(vp + o.vec);
}
__device__ __forceinline__ void gdn_stage_write(const u32x4 (&P)[17], LAS unsigned char* img, int lt) {
#pragma unroll
    for (int r = 0; r < 4; ++r) { const int k = lt + 256 * r;
        { const int row = k >> 4, ch = k & 15, slot = row * 16 + (ch ^ (row & 15)); *(LAS u32x4*)(img + GL_W + slot * 16) = P[r]; *(LAS u32x4*)(img + GL_Q + slot * 16) = P[4 + r]; }
        { const int row = k >> 3, ch = k & 7; *(LAS u32x4*)(img + GL_KT + (row * 8 + (ch ^ ((row >> 1) & 7))) * 16) = P[8 + r]; } }
#pragma unroll
    for (int r = 0; r < 2; ++r) { const int k = lt + 256 * r, row = k >> 3, ch = k & 7, slot = row * 8 + (ch ^ ((row >> 1) & 7));
        *(LAS u32x4*)(img + GL_QK + slot * 16) = P[12 + r]; if (r == 0) *(LAS u32x4*)(img + GL_U + slot * 16) = P[14]; }
    if (lt < 48) *(LAS u32x4*)(img + GL_VEC + 16 * lt) = P[16];
}
template <bool DRY>
__device__ __forceinline__ void phase_gdn_chain(const Frame& F0, int j) {
    const Frame F = relaunder(F0);
    const unsigned char* sc = (const unsigned char*)F.out;
    const bool loader = (F.wave & 2) != 0, idle = F.wave == 4 || F.wave == 5;
    const int lt = (((F.wave >> 2) << 1) | (F.wave & 1)) * 64 + F.lane, w4 = F.wave & 1;
    for (int sh = F.bid; sh < 640; sh += (F.bid < 128 && F.G > 128) ? 640 : (F.G > 128 ? F.G - 128 : F.G)) {
        const int seq = sh < 128 ? (sh >> 6) : 2 + ((sh - 128) >> 6), head = sh & 7, vq = (sh >> 3) & 7;
        const int nch = seq_chunks(seq);
        __syncthreads();
        if (loader) {
            u32x4 A[17], B[17];
            const GdnLdOff lo = gdn_ld_offsets(lt, gdn_tile(F, seq, 0, head));
            gdn_stage_load(A, F, sc, lo, seq, head, vq, 0); gdn_stage_write(A, F.ldsl, lt);
            if (nch > 1) gdn_stage_load(B, F, sc, lo, seq, head, vq, 1);
            if (nch > 2) gdn_stage_load(A, F, sc, lo, seq, head, vq, 2);
            __syncthreads();
#define GDN_LOADER_STEP(CC, ST) { BUSY_T0(4) const int cc_ = (CC); int nxt = ((cc_ + 1) & 1) * GL_SIZE, lt_ = lt; asm volatile("" : "+s"(nxt), "+v"(lt_)); \
                if (cc_ + 1 < nch) gdn_stage_write(ST, F.ldsl + nxt, lt_); \
                if (cc_ + 3 < nch) gdn_stage_load(ST, F, sc, lo, seq, head, vq, cc_ + 3); \
                BUSY_T1(4, 2) \
                __syncthreads(); }
            for (int c = 0; c < nch; c += 2) {
                GDN_LOADER_STEP(c, B)
                if (c + 1 < nch) GDN_LOADER_STEP(c + 1, A)
            }
#undef GDN_LOADER_STEP
        } else if (idle) {
            __syncthreads();
            for (int c = 0; c < nch; ++c) __syncthreads();
        } else {
            f32x4 S[8];
#pragma unroll
            for (int m8 = 0; m8 < 8; ++m8) S[m8] = (f32x4){0.f, 0.f, 0.f, 0.f};
            if (seq >= 2) {
                const int i = F.lane & 15, g = F.lane >> 4;
                const float* st = F.inp(4) + (((size_t)j * 8 + (seq - 2)) * GDN_HEADS + head) * GDN_DK * GDN_DV + vq * 32 + w4 * 16 + i;
#pragma unroll
                for (int m8 = 0; m8 < 8; ++m8)
#pragma unroll
                    for (int jj = 0; jj < 4; ++jj) S[m8][jj] = st[(size_t)(16 * m8 + 4 * g + jj) * GDN_DV];
            }
            __syncthreads();
            __builtin_amdgcn_s_setprio(2);
            for (int c = 0; c < nch; ++c) {
                BUSY_T0(3) BUSY_T0B(21)
                int cur = (c & 1) * GL_SIZE, lane_ = F.lane;
                asm volatile("" : "+s"(cur), "+v"(lane_));
                LAS unsigned char* img = F.ldsl + cur;
                const int i = lane_ & 15, g = lane_ >> 4, vrow = w4 * 16 + i, vsw = (vrow >> 1) & 7;
                const LAS unsigned char* pw[4]; const LAS unsigned char* pk[2];
#pragma unroll
                for (int kk = 0; kk < 4; ++kk) pw[kk] = img + i * 256 + (((4 * kk + g) ^ i) * 16);
#pragma unroll
                for (int k2 = 0; k2 < 2; ++k2) pk[k2] = img + i * 128 + (((4 * k2 + g) ^ (i >> 1)) * 16);
                const float egl = *(const LAS float*)(img + GL_VEC + 512);
                bf16x8 Sf[4];
#pragma unroll
                for (int kk = 0; kk < 4; ++kk) Sf[kk] = pack8(S[2 * kk], S[2 * kk + 1]);
                LAS unsigned char* urow = img + GL_U + vrow * 128 + 8 * (g & 1);
                f32x4 vn[4], O[4];
                bf16x8 fr[3][4]; u32x2 uw[4];
#define GSB() __builtin_amdgcn_sched_barrier(0)
#define GLD_WQ(SET, M, KH) { _Pragma("unroll") for (int kk = 0; kk < 2; ++kk) { fr[SET][2 * kk] = *(const LAS bf16x8*)(pw[2 * (KH) + kk] + GL_W + (M) * 4096); fr[SET][2 * kk + 1] = *(const LAS bf16x8*)(pw[2 * (KH) + kk] + GL_Q + (M) * 4096); } }
#define GLD_QK(SET, QH) { _Pragma("unroll") for (int q = 0; q < 2; ++q) { _Pragma("unroll") for (int k2 = 0; k2 < 2; ++k2) fr[SET][2 * q + k2] = *(const LAS bf16x8*)(pk[k2] + GL_QK + (2 * (QH) + q) * 2048); } }
#define GLD_KT(SET, H) { _Pragma("unroll") for (int q = 0; q < 2; ++q) { _Pragma("unroll") for (int k2 = 0; k2 < 2; ++k2) fr[SET][2 * q + k2] = *(const LAS bf16x8*)(pk[k2] + GL_KT + (2 * (H) + q) * 2048); } }
#define GMM_WQ(SET, M, KH) { if ((KH) == 0) { O[M] = (f32x4){0.f, 0.f, 0.f, 0.f}; \
                        vn[M][0] = __uint_as_float(uw[M].x << 16); vn[M][1] = __uint_as_float(uw[M].x & 0xffff0000u); vn[M][2] = __uint_as_float(uw[M].y << 16); vn[M][3] = __uint_as_float(uw[M].y & 0xffff0000u); } \
                    _Pragma("unroll") for (int kk = 0; kk < 2; ++kk) { \
                        vn[M] = __builtin_amdgcn_mfma_f32_16x16x32_bf16(fr[SET][2 * kk], Sf[2 * (KH) + kk], vn[M], 0, 0, 0); \
                        O[M] = __builtin_amdgcn_mfma_f32_16x16x32_bf16(fr[SET][2 * kk + 1], Sf[2 * (KH) + kk], O[M], 0, 0, 0); } }
#define GMM_QK(SET, QH) { _Pragma("unroll") for (int k2 = 0; k2 < 2; ++k2) { _Pragma("unroll") for (int q = 0; q < 2; ++q) O[2 * (QH) + q] = __builtin_amdgcn_mfma_f32_16x16x32_bf16(fr[SET][2 * q + k2], Vf[k2], O[2 * (QH) + q], 0, 0, 0); } }
#define GMM_KT(SET, H) { f32x4 ac0 = S[2 * (H)] * egl, ac1 = S[2 * (H) + 1] * egl; \
                    _Pragma("unroll") for (int k2 = 0; k2 < 2; ++k2) { ac0 = __builtin_amdgcn_mfma_f32_16x16x32_bf16(fr[SET][k2], Vf[k2], ac0, 0, 0, 0); ac1 = __builtin_amdgcn_mfma_f32_16x16x32_bf16(fr[SET][2 + k2], Vf[k2], ac1, 0, 0, 0); } \
                    S[2 * (H)] = ac0; S[2 * (H) + 1] = ac1; }
                GLD_WQ(0, 0, 0)
#pragma unroll
                for (int m = 0; m < 4; ++m) uw[m] = *(const LAS u32x2*)(urow + ((2 * m + (g >> 1)) ^ vsw) * 16);
                GLD_WQ(1, 0, 1) GSB();
                BUSY_T1(21, 0) BUSY_T0B(22) GSB();
                GLD_WQ(2, 1, 0) GSB(); GMM_WQ(0, 0, 0) GSB();
                GLD_WQ(0, 1, 1) GSB(); GMM_WQ(1, 0, 1) GSB();
                GLD_WQ(1, 2, 0) GSB(); GMM_WQ(2, 1, 0) GSB();
                GLD_WQ(2, 2, 1) GSB(); GMM_WQ(0, 1, 1) GSB();
                GLD_WQ(0, 3, 0) GSB(); GMM_WQ(1, 2, 0) GSB();
                GLD_WQ(1, 3, 1) GSB(); GMM_WQ(2, 2, 1) GSB();
                GLD_QK(2, 0) GSB(); GMM_WQ(0, 3, 0) GSB();
                GLD_QK(0, 1) GSB(); GMM_WQ(1, 3, 1) GSB();
                bf16x8 Vf[2];
#pragma unroll
                for (int k2 = 0; k2 < 2; ++k2) Vf[k2] = pack8(vn[2 * k2], vn[2 * k2 + 1]);
                GLD_KT(1, 0) GSB(); GMM_QK(2, 0) GSB();
                GLD_KT(2, 1) GSB(); GMM_QK(0, 1) GSB();
                GLD_KT(0, 2) GSB(); GMM_KT(1, 0) GSB();
                GLD_KT(1, 3) GSB(); GMM_KT(2, 1) GSB();
                GMM_KT(0, 2) GSB();
                GMM_KT(1, 3)
                GSB(); BUSY_T1(22, 0) BUSY_T0B(23) GSB();
#undef GMM_QK
#undef GSB
#undef GLD_WQ
#undef GLD_QK
#undef GLD_KT
#undef GMM_WQ
#undef GMM_KT
                {
                    const GTile tl = gdn_tile(F, seq, c, head);
                    bf16_t* orow = gdn_urow(tl, vq * 32 + vrow);
                    u32x2 ow[4];
#pragma unroll
                    for (int m = 0; m < 4; ++m) { ow[m].x = cvt_pk_bf16(O[m][0], O[m][1]); ow[m].y = cvt_pk_bf16(O[m][2], O[m][3]); }
#pragma unroll
                    for (int q = 0; q < 2; ++q) {
                        const u32x2 snd = (g & 1) ? ow[2 * q] : ow[2 * q + 1];
                        u32x2 rcv; rcv.x = __shfl_xor(snd.x, 16); rcv.y = __shfl_xor(snd.y, 16);
                        u32x4 w; int l0;
                        if (g & 1) { w.x = rcv.x; w.y = rcv.y; w.z = ow[2 * q + 1].x; w.w = ow[2 * q + 1].y; l0 = 32 * q + 16 + 4 * (g - 1); }
                        else { w.x = ow[2 * q].x; w.y = ow[2 * q].y; w.z = rcv.x; w.w = rcv.y; l0 = 32 * q + 4 * g; }
                        if (!DRY) *(u32x4*)(orow + l0) = w; else KEEP(w);
                    }
                }
                BUSY_T1(3, 0) BUSY_T1(23, 0) BUSY_T0B(24)
                __syncthreads();
                BUSY_T1(24, 0)
            }
            __builtin_amdgcn_s_setprio(0);
            const int i = F.lane & 15, g = F.lane >> 4, vcol = vq * 32 + w4 * 16 + i;
            float* so = (seq < 2) ? F.out + O_PGDN + (((size_t)j * 2 + seq) * GDN_HEADS + head) * GDN_DK * GDN_DV + vcol
                                  : F.out + O_SGDN + (((size_t)j * 8 + (seq - 2)) * GDN_HEADS + head) * GDN_DK * GDN_DV + vcol;
#pragma unroll
            for (int m8 = 0; m8 < 8; ++m8)
#pragma unroll
                for (int jj = 0; jj < 4; ++jj) { if (!DRY) so[(size_t)(16 * m8 + 4 * g + jj) * GDN_DV] = S[m8][jj]; else KEEP(S[m8][jj]); }
        }
    }
}

template <bool DRY>
__device__ __forceinline__ void phase_gdn_post2(const Frame& F0, int j) {
    const Frame F = relaunder(F0);
    constexpr int RL = 260;
    bf16_t* OL = (bf16_t*)F.lds;
    for (int task = F.bid; task < NCHT * 8; task += F.G) {
        const int cgi = task >> 3, head = task & 7; int seq, c; chunk_of(cgi, seq, c);
        const int base = seq_base(seq), t0 = 64 * c - PADF;
        const GTile tl = gdn_tile(F, seq, c, head);
        u32x2 zr[8];
#pragma unroll
        for (int q = 0; q < 8; ++q) { const int l = F.wave + 8 * q, t = t0 + l; const int row = seq < 2 ? seq * TPP + 64 * c + l : base + (t > 0 ? t : 0);
            zr[q] = *(const u32x2*)(F.proj + (size_t)row * LDP + 4096 + head * 256 + 4 * F.lane); }
        __syncthreads();
#pragma unroll
        for (int r = 0; r < 4; ++r) {
            const int k = F.tid + 512 * r, v = k >> 3, ch = k & 7;
            const u32x4 w = *(const u32x4*)(gdn_urow(tl, v) + ch * 8);
            bf16_t* d = OL + (8 * ch) * RL + v;
            d[0] = (bf16_t)w.x; d[RL] = (bf16_t)(w.x >> 16); d[2 * RL] = (bf16_t)w.y; d[3 * RL] = (bf16_t)(w.y >> 16);
            d[4 * RL] = (bf16_t)w.z; d[5 * RL] = (bf16_t)(w.z >> 16); d[6 * RL] = (bf16_t)w.w; d[7 * RL] = (bf16_t)(w.w >> 16);
        }
        __syncthreads();
#pragma unroll
        for (int q = 0; q < 8; ++q) {
            const int l = F.wave + 8 * q, t = t0 + l;
            if (t < 0 && seq >= 2) continue;
            const int row = seq < 2 ? seq * TPP + 64 * c + l : base + t;
            const u32x2 ow = *(const u32x2*)(OL + l * RL + 4 * F.lane);
            const float o0 = __uint_as_float(ow.x << 16), o1 = __uint_as_float(ow.x & 0xffff0000u), o2 = __uint_as_float(ow.y << 16), o3 = __uint_as_float(ow.y & 0xffff0000u);
            float ss = (o0 * o0 + o1 * o1) + (o2 * o2 + o3 * o3);
            ss = wave_sum(ss);
            const float rs = rsqrtf(ss * (1.0f / 256.0f) + EPS);
            const float z0 = __uint_as_float(zr[q].x << 16), z1 = __uint_as_float(zr[q].x & 0xffff0000u), z2 = __uint_as_float(zr[q].y << 16), z3 = __uint_as_float(zr[q].y & 0xffff0000u);
            u32x2 w; w.x = cvt_pk_bf16(o0 * rs * silu_f(z0), o1 * rs * silu_f(z1)); w.y = cvt_pk_bf16(o2 * rs * silu_f(z2), o3 * rs * silu_f(z3));
            if (!DRY) *(u32x2*)(F.proj + (size_t)row * LDP + 4096 + head * 256 + 4 * F.lane) = w; else KEEP(w);
        }
    }
    for (int e = F.bid * NTHREADS + F.tid; e < NSEQ * 3 * GDN_CONV; e += F.G * NTHREADS) {
        const int s = e / (3 * GDN_CONV), r = (e / GDN_CONV) % 3, c = e % GDN_CONV;
        if (s < 2) F.out[O_PGDNC + (((size_t)j * 2 + s) * 3 + r) * GDN_CONV + c] = bf2f(F.tails[((size_t)(s * 129 + 128) * 3 + r) * 4096 + c]);
        else F.out[O_SGDNC + (((size_t)j * 8 + (s - 2)) * 3 + r) * GDN_CONV + c] = bf2f(F.proj[(size_t)(seq_base(s) + 13 + r) * LDP + c]);
    }
}

__device__ __forceinline__ void phase_final(const Frame& F0) {
    const Frame F = relaunder(F0);
    const float* fw = F.inp(23);
    for (int it = F.bid * 8 + F.wave; it < 2 * SEQ + 128; it += F.G * 8) {
        int row; float* dst;
        if (it < 2 * SEQ) { const int b = it / SEQ, t = it % SEQ; row = b * TPP + 64 + t; dst = F.out + O_YP + (size_t)it * D; }
        else { row = ROW_S0 + (it - 2 * SEQ); dst = F.out + O_YS + (size_t)(it - 2 * SEQ) * D; }
        float x[16]; float ss = 0.f;
#pragma unroll
        for (int i = 0; i < 4; ++i) {
            const u32x2 v = *(const u32x2*)(F.hb + (size_t)row * D + (F.lane + 64 * i) * 4);
            x[4 * i + 0] = __uint_as_float(v.x << 16); x[4 * i + 1] = __uint_as_float(v.x & 0xffff0000u); x[4 * i + 2] = __uint_as_float(v.y << 16); x[4 * i + 3] = __uint_as_float(v.y & 0xffff0000u);
            ss += (x[4 * i] * x[4 * i] + x[4 * i + 1] * x[4 * i + 1]) + (x[4 * i + 2] * x[4 * i + 2] + x[4 * i + 3] * x[4 * i + 3]);
        }
        ss = wave_sum(ss);
        const float rs = rsqrtf(ss * (1.0f / 1024.0f) + EPS);
#pragma unroll
        for (int i = 0; i < 4; ++i) {
            const int c = (F.lane + 64 * i) * 4; const f32x4 w = *(const f32x4*)(fw + c);
            f32x4 o; o[0] = x[4 * i] * rs * w[0]; o[1] = x[4 * i + 1] * rs * w[1]; o[2] = x[4 * i + 2] * rs * w[2]; o[3] = x[4 * i + 3] * rs * w[3];
            *(f32x4*)(dst + c) = o;
        }
    }
}

constexpr int N_PHASES = 26;
__global__ void __launch_bounds__(NTHREADS, 2) hybrid_fwd(Args args) {
    extern __shared__ __attribute__((aligned(16))) unsigned char lds[];
    volatile LAS unsigned* bst = (volatile LAS unsigned*)((LAS unsigned char*)lds + LDS_BYTES - 16);
    if (threadIdx.x < 4) bst[threadIdx.x] = 0u;
    __syncthreads();
    XcdBarrier bar; bar.bar = (unsigned*)(args.ws + WS_CTL); bar.x = 0; bar.st = bst;
    if (args.ph_hi - args.ph_lo > 1) bar = xcd_barrier_post((unsigned*)(args.ws + WS_CTL), bst);
    unsigned long long probe_acc = 0ull;
    for (int ph = args.ph_lo; ph < args.ph_hi; ++ph) {
        if (ph > 0 && ph < N_PHASES - 1 && ((ph - 1) % 6) == 3 && ((((ph - 1) / 6) & 1) == 1)) continue;
        const bool probe_this = PROBE_SPAN_SUB >= 0 && ph > 0 && ph < N_PHASES - 1 && ((ph - 1) % 6) == PROBE_SPAN_SUB && ((((ph - 1) / 6) & 1) == PROBE_SPAN_PAR);
        unsigned long long probe_t0 = 0ull; if (probe_this && blockIdx.x == 0) probe_t0 = __builtin_amdgcn_s_memrealtime();
        int tid_ = threadIdx.x; asm volatile("" : "+v"(tid_));
        Frame F;
        F.ap = &args;
        F.out = args.out; F.ws = args.ws; F.lds = lds; F.ldsl = (LAS unsigned char*)lds;
        F.tid = tid_; F.lane = F.tid & 63; F.wave = __builtin_amdgcn_readfirstlane(F.tid >> 6); F.G = gridDim.x; F.bid = blockIdx.x;
        F.hb = nullptr; F.win = nullptr; F.wout = nullptr; F.dtb = nullptr; F.rss = nullptr; F.proj = nullptr; F.tails = nullptr;
        if (ph == 0) { phase_init_h(F); phase_wprep_in(F, 0); }
        else if (ph == N_PHASES - 1) { for (int r = 0; r < REP_FINAL; ++r) phase_final(F); }
        else {
            const int L = (ph - 1) / 6, sub = (ph - 1) % 6, j = L >> 1;
            if (sub == 0 || sub == 5) {
                if (sub == 5 || L >= 1) phase_outproj(F, sub == 5 ? L : L - 1, sub == 0);
                if (sub == 0) phase_inproj(F, L);
            }
            else if (sub == 1) {
                if (L & 1) { for (int r = 1; r < REP_GDN_PREP; ++r) phase_gdn_prep<true>(F, j); phase_gdn_prep<false>(F, j); }
                else { for (int r = 1; r < REP_SSD_PREP; ++r) phase_ssd_prep<true>(F, j); phase_ssd_prep<false>(F, j); }
                for (int r = 0; r < REP_WPREP; ++r) phase_wprep_out(F, L); }
            else if (sub == 2) {
                if (L & 1) { for (int r = 1; r < REP_GDN_CHAIN; ++r) phase_gdn_chain<true>(F, j); phase_gdn_chain<false>(F, j); }
                else { for (int r = 1; r < REP_SSD_CHAIN; ++r) phase_ssd_chain<true>(F, j); phase_ssd_chain<false>(F, j); } }
            else if (sub == 3) { if (!(L & 1)) phase_ssd_combine(F, j); }
            else if (sub == 4) {
                if (L & 1) { for (int r = 1; r < REP_GDN_POST; ++r) phase_gdn_post2<true>(F, j); phase_gdn_post2<false>(F, j); }
                else { for (int r = 1; r < REP_SSD_POST; ++r) phase_ssd_post<true>(F, j); phase_ssd_post<false>(F, j); }
                if (L < 3) { for (int r = 0; r < REP_WPREP; ++r) phase_wprep_in(F, L + 1); } }
        }
        if (probe_this && blockIdx.x == 0 && PROBE_SPAN_MODE != 0) { __syncthreads(); const unsigned long long tn = __builtin_amdgcn_s_memrealtime(); if (PROBE_SPAN_MODE == 2) probe_acc += tn - probe_t0; probe_t0 = tn; }
        if (ph + 1 < args.ph_hi) {
            if (ph == args.ph_lo) { __threadfence(); cg::this_grid().sync(); }
            else { for (int r = 0; r < REP_BARRIER; ++r) xcd_barrier(bar); }
        }
        if (probe_this && blockIdx.x == 0 && PROBE_SPAN_MODE != 2) probe_acc += __builtin_amdgcn_s_memrealtime() - probe_t0;
    }
    if (PROBE_BUSY > 0 && blockIdx.x == 0) { __syncthreads(); const unsigned long long acc_ = __hip_atomic_load((unsigned long long*)(args.ws + 49152), __ATOMIC_RELAXED, __HIP_MEMORY_SCOPE_AGENT); const unsigned long long t1 = __builtin_amdgcn_s_memrealtime(); while (__builtin_amdgcn_s_memrealtime() - t1 < acc_ * 8ull) __builtin_amdgcn_s_sleep(16); }
    if (PROBE_SPAN_SUB >= 0 && blockIdx.x == 0) { const unsigned long long t1 = __builtin_amdgcn_s_memrealtime(); while (__builtin_amdgcn_s_memrealtime() - t1 < probe_acc * 8ull) __builtin_amdgcn_s_sleep(16); }
}

extern "C" void kernel_launch(void* const* d_in, const int* in_sizes, int n_in, void* d_out, int out_size, void* d_ws, size_t ws_size, hipStream_t stream) {
    static int grid = 0;
    if (grid == 0) {
        if (n_in != 24 || ws_size < WS_END) { fprintf(stderr, "kernel_launch: unexpected n_in %d / ws %zu (need %zu)\n", n_in, ws_size, (size_t)WS_END); grid = -1; return; }
        int dev = 0, cus = 0, per_cu = 0;
        if (hipGetDevice(&dev) != hipSuccess || hipDeviceGetAttribute(&cus, hipDeviceAttributeMultiprocessorCount, dev) != hipSuccess) { grid = -1; return; }
        if (hipFuncSetAttribute((const void*)hybrid_fwd, hipFuncAttributeMaxDynamicSharedMemorySize, LDS_BYTES) != hipSuccess) { fprintf(stderr, "kernel_launch: hipFuncSetAttribute failed\n"); grid = -1; return; }
        if (hipOccupancyMaxActiveBlocksPerMultiprocessor(&per_cu, (const void*)hybrid_fwd, NTHREADS, LDS_BYTES) != hipSuccess || per_cu < 1) { fprintf(stderr, "kernel_launch: occupancy query says %d blocks per CU\n", per_cu); grid = -1; return; }
        (void)hipGetLastError();
        grid = cus;
    }
    if (grid < 0) return;
    Args a{};
    for (int i = 0; i < 24; ++i) a.in[i] = (const float*)d_in[i];
    a.out = (float*)d_out; a.ws = (unsigned char*)d_ws;
#if MK_ONE_LAUNCH
    (void)hipMemsetAsync((char*)d_ws + WS_CTL, 0, 65536, stream);
    a.ph_lo = 0; a.ph_hi = N_PHASES;
    void* kargs[] = {&a};
    hipError_t e = hipLaunchCooperativeKernel((const void*)hybrid_fwd, dim3(grid), dim3(NTHREADS), kargs, LDS_BYTES, stream);
    if (e != hipSuccess) fprintf(stderr, "kernel_launch: cooperative launch failed: %s (grid %d)\n", hipGetErrorString(e), grid);
#else
    for (int ph = 0; ph < N_PHASES; ++ph) {
        a.ph_lo = ph; a.ph_hi = ph + 1;
        hipLaunchKernelGGL(hybrid_fwd, dim3(grid), dim3(NTHREADS), LDS_BYTES, stream, a);
    }
#endif
}
```

```cpp
#include <hip/hip_runtime.h>
#include <hip/hip_cooperative_groups.h>
#include <cstdio>
#include <cstdint>
namespace cg = cooperative_groups;

#define LAS __attribute__((address_space(3)))
typedef unsigned short bf16_t;
typedef short bf16x8 __attribute__((ext_vector_type(8)));
typedef float f32x4 __attribute__((ext_vector_type(4)));
typedef unsigned u32x4 __attribute__((ext_vector_type(4)));
typedef unsigned u32x2 __attribute__((ext_vector_type(2)));

constexpr int D = 1024;
constexpr int SEQ = 8192, NMETA = 16, PADF = 48;
constexpr int TPP = 8256;
constexpr int ROW_S0 = 2 * TPP;
constexpr int M_TOT = ROW_S0 + 128;
constexpr int NSEQ = 10;
constexpr float EPS = 1e-6f;
constexpr int LDP = 6144;
constexpr int SSD_INNER = 2048, SSD_HEADS = 32, SSD_P = 64, SSD_N = 128, SSD_CONV = 3072, SSD_IN = 5152, SSD_IN_PAD = 5376;
constexpr int GDN_HEADS = 8, GDN_DK = 128, GDN_DV = 256, GDN_CONV = 4096, GDN_VAL = 2048, GDN_IN = 6160, GDN_IN_PAD = 6400;

constexpr size_t O_YP = 0, O_YS = 16777216, O_PSSD = 16908288, O_PSSDC = 17956864, O_PGDN = 17993728, O_PGDNC = 19042304,
                 O_SSSD = 19091456, O_SSSDC = 23285760, O_SGDN = 23433216, O_SGDNC = 27627520;

constexpr size_t WS_CTL = 0;
constexpr size_t WS_HB = 65536;
constexpr size_t WS_WIN = WS_HB + (size_t)M_TOT * D * 2;
constexpr size_t WS_WOUT = WS_WIN + (size_t)GDN_IN_PAD * D * 2;
constexpr size_t WS_TAIL = WS_WOUT + (size_t)1024 * 2048 * 2;
constexpr size_t WS_DTB = WS_TAIL + (size_t)258 * 3 * 4096 * 2;
constexpr size_t WS_RSS = WS_DTB + (size_t)M_TOT * 32 * 4;
constexpr size_t WS_PROJ = WS_RSS + (size_t)M_TOT * 16 * 4;
constexpr size_t WS_END = WS_PROJ + (size_t)M_TOT * LDP * 2;

constexpr int NTHREADS = 512;
constexpr int LDS_BYTES = 147456;

#define KEEP(x) asm volatile("" :: "v"(x))
#ifndef REP_INPROJ
#define REP_INPROJ 1
#endif
#ifndef REP_SSD_PREP
#define REP_SSD_PREP 1
#endif
#ifndef REP_SSD_CHAIN
#define REP_SSD_CHAIN 1
#endif
#ifndef REP_GDN_PREP
#define REP_GDN_PREP 1
#endif
#ifndef REP_GDN_CHAIN
#define REP_GDN_CHAIN 1
#endif
#ifndef REP_WPREP
#define REP_WPREP 1
#endif
#ifndef PROBE_SPAN_SUB
#define PROBE_SPAN_SUB -1
#endif
#ifndef PROBE_BUSY
#define PROBE_BUSY 0
#endif
#define BUSY_T0(id) unsigned long long bz_t0 = 0ull; if (PROBE_BUSY == (id) && blockIdx.x == 0) bz_t0 = __builtin_amdgcn_s_memrealtime();
#define BUSY_T0B(id) if (PROBE_BUSY == (id) && blockIdx.x == 0) bz_t0 = __builtin_amdgcn_s_memrealtime();
#define BUSY_T1(id, wv) if (PROBE_BUSY == (id) && blockIdx.x == 0 && threadIdx.x == 64 * (wv)) atomicAdd((unsigned long long*)(F.ws + 49152), __builtin_amdgcn_s_memrealtime() - bz_t0);
#ifndef PROBE_SPAN_PAR
#define PROBE_SPAN_PAR 0
#endif
#ifndef PROBE_SPAN_MODE
#define PROBE_SPAN_MODE 0
#endif
#ifndef PROBE_INPROJ_K
#define PROBE_INPROJ_K 1024
#endif
#ifndef REP_OUTPROJ
#define REP_OUTPROJ 1
#endif
#ifndef REP_SSD_POST
#define REP_SSD_POST 1
#endif
#ifndef REP_GDN_POST
#define REP_GDN_POST 1
#endif
#ifndef REP_SUBST
#define REP_SUBST 1
#endif
#ifndef REP_BARRIER
#define REP_BARRIER 1
#endif
#ifndef REP_FINAL
#define REP_FINAL 1
#endif
#ifndef MK_ONE_LAUNCH
#define MK_ONE_LAUNCH 1
#endif
__device__ __forceinline__ float bf2f(bf16_t b) { return __uint_as_float(((unsigned)b) << 16); }
typedef __bf16 bf16v2_t __attribute__((ext_vector_type(2)));
typedef float f32x2_t __attribute__((ext_vector_type(2)));
__device__ __forceinline__ unsigned cvt_pk_bf16(float lo, float hi) { const bf16v2_t r = __builtin_convertvector((f32x2_t){lo, hi}, bf16v2_t); return __builtin_bit_cast(unsigned, r); }
__device__ __forceinline__ bf16_t f2bf(float f) { return (bf16_t)(cvt_pk_bf16(f, f) & 0xffffu); }
__device__ __forceinline__ float silu_f(float x) { return x * __builtin_amdgcn_rcpf(1.0f + __expf(-x)); }
__device__ __forceinline__ float softplus_f(float x) { return x > 20.f ? x : __logf(1.0f + __expf(x)); }
__device__ __forceinline__ float dpp_add(float v, int ctrl_is) {
    int r;
    switch (ctrl_is) {
        case 0: r = __builtin_amdgcn_update_dpp(0, __float_as_int(v), 0xB1, 0xF, 0xF, false); break;
        case 1: r = __builtin_amdgcn_update_dpp(0, __float_as_int(v), 0x4E, 0xF, 0xF, false); break;
        case 2: r = __builtin_amdgcn_update_dpp(0, __float_as_int(v), 0x141, 0xF, 0xF, false); break;
        default: r = __builtin_amdgcn_update_dpp(0, __float_as_int(v), 0x140, 0xF, 0xF, false); break;
    }
    return v + __int_as_float(r);
}
__device__ __forceinline__ float wave_scan_incl(float v, int lane) {
    v += __int_as_float(__builtin_amdgcn_update_dpp(0, __float_as_int(v), 0x111, 0xF, 0xF, true));
    v += __int_as_float(__builtin_amdgcn_update_dpp(0, __float_as_int(v), 0x112, 0xF, 0xF, true));
    v += __int_as_float(__builtin_amdgcn_update_dpp(0, __float_as_int(v), 0x114, 0xF, 0xF, true));
    v += __int_as_float(__builtin_amdgcn_update_dpp(0, __float_as_int(v), 0x118, 0xF, 0xF, true));
    const float t0 = __int_as_float(__builtin_amdgcn_readlane(__float_as_int(v), 15)), t1 = __int_as_float(__builtin_amdgcn_readlane(__float_as_int(v), 31)), t2 = __int_as_float(__builtin_amdgcn_readlane(__float_as_int(v), 47));
    const float add = (lane >= 48) ? (t0 + t1) + t2 : (lane >= 32) ? t0 + t1 : (lane >= 16) ? t0 : 0.f;
    return v + add;
}
__device__ __forceinline__ float wave_sum(float v) {
    v = dpp_add(v, 0); v = dpp_add(v, 1); v = dpp_add(v, 2); v = dpp_add(v, 3);
    typedef unsigned u2_t __attribute__((ext_vector_type(2)));
    { const u2_t r = __builtin_amdgcn_permlane16_swap(__float_as_uint(v), __float_as_uint(v), false, false); v = __uint_as_float(r.x) + __uint_as_float(r.y); }
    { const u2_t r = __builtin_amdgcn_permlane32_swap(__float_as_uint(v), __float_as_uint(v), false, false); v = __uint_as_float(r.x) + __uint_as_float(r.y); }
    return v;
}
__device__ __forceinline__ int seq_base(int s) { return s < 2 ? s * TPP + 64 - NMETA : ROW_S0 + 16 * (s - 2); }
__device__ __forceinline__ int seq_len(int s) { return s < 2 ? SEQ + NMETA : 16; }
__device__ __forceinline__ int seq_chunks(int s) { return s < 2 ? 129 : 1; }

namespace pg8 {
constexpr int BM = 256, BK = 64, HALF = 128, HTB = HALF * BK * 2, STAGE_BYTES = 8 * HTB, NXCD = 8, WGM = 8;
__device__ __forceinline__ int lds_byte(int r, int c) { const int st = (r >> 4) * 2 + (c >> 5), rr = r & 15, cc = c & 31, ob = rr * 64 + cc * 2; return st * 1024 + (ob ^ (((ob >> 9) & 1) << 5)); }
__device__ __forceinline__ void stage_rc(int b, int& R, int& C) { const int st = b / 1024, sb = b % 1024, swz = sb ^ (((sb >> 9) & 1) << 5); R = (st >> 1) * 16 + swz / 64; C = (st & 1) * 32 + (swz % 64) / 2; }
__device__ __forceinline__ int perm32(int rho) { const int n = rho >> 4, i = rho & 15; return 8 * (i >> 2) + 4 * n + (i & 3); }
struct Unit { int pm, pn; };
struct Gemm { const bf16_t* A; const bf16_t* Bt; int M, N, K, lda, ldb; };
struct StaticOrder {
    int nM, nN, nwg, G, c, imax, xpm, xpn;
    int poff, psplit, ptail;
    __device__ void init(int M, int N, int G_, int c_) { nM = M / BM; nN = N / BM; nwg = nM * nN; G = G_; c = c_; imax = 1 << 30; xpm = -1; xpn = 0; poff = 0; psplit = -1; ptail = 0; }
    __device__ bool main_unit(int i, int cc, Unit& u) const {
        const long L = (long)i * G + cc; if (L >= nwg) return false;
        int wgid = (int)L; { const int q = nwg / NXCD, r = nwg % NXCD, xcd = wgid % NXCD, off = wgid / NXCD; wgid = (xcd < r ? xcd * (q + 1) : r * (q + 1) + (xcd - r) * q) + off; }
        const int nig = WGM * nN, gid = wgid / nig, fm = gid * WGM, gsz = (nM - fm) < WGM ? (nM - fm) : WGM;
        u.pm = fm + ((wgid % nig) % gsz); u.pn = (wgid % nig) / gsz; u.pn = (u.pn == psplit) ? ptail : u.pn + poff; return true;
    }
    __device__ int count_main() const { int n = 0; while ((long)n * G + c < nwg) ++n; return n; }
    __device__ bool next(int i, Unit& u) const {
        if (i < imax) { if (main_unit(i, c, u)) return true; if (xpm < 0 || i != count_main()) return false; u.pm = xpm; u.pn = xpn; return true; }
        if (i == imax && xpm >= 0) { u.pm = xpm; u.pn = xpn; return true; }
        return false;
    }
};


template <class Epi>
__device__ __forceinline__ void gemm_phase(LAS unsigned char* lds, const Gemm g, const StaticOrder& S, const Epi& E, const int tid) {
    const int wid = __builtin_amdgcn_readfirstlane(tid >> 6), lane = tid & 63, wr = wid >> 2, wc = wid & 3, fr = lane & 15, fq = lane >> 4;
    const int K = g.K, nt = K / BK;
    unsigned voffA[2], voffB[2];
#pragma unroll
    for (int i = 0; i < 2; ++i) { int R, C; stage_rc(tid * 16 + i * 8192, R, C); const int Rb = Epi::PERM ? ((R & ~31) + perm32(R & 31)) : R;
        voffA[i] = (unsigned)(R * g.lda + C) * 2u; voffB[i] = (unsigned)(Rb * g.ldb + C) * 2u; }
    const size_t kstep = (size_t)(BK * 2);
    const size_t hstepA = (size_t)HALF * g.lda * 2, hstepB = (size_t)HALF * g.ldb * 2;
    const size_t tstepA = 2 * hstepA, tstepB = 2 * hstepB;
    const unsigned ldsw = (unsigned)wid * 1024u;
    const int aoff = lds_byte(wr * 64 + fr, fq * 8), boff = lds_byte(wc * 32 + fr, fq * 8);
#define PG8_SA(b, h) (((b) * 2 + (h)) * HTB)
#define PG8_SB(b, h) ((4 + (b) * 2 + (h)) * HTB)
#define PG8_STAGE(bufoff, gbase, voff) do { _Pragma("unroll") for (int _i = 0; _i < 2; ++_i) \
        __builtin_amdgcn_global_load_lds((const unsigned*)((const char*)(gbase) + (voff)[_i]), (LAS unsigned*)(lds + (bufoff) + ldsw + _i * 8192), 16, 0, 0); } while (0)
#define PG8_LDA(dst, b, h) do { _Pragma("unroll") for (int m = 0; m < 4; ++m) _Pragma("unroll") for (int k = 0; k < 2; ++k) dst[m][k] = *(const LAS bf16x8*)(lds + PG8_SA(b, h) + aoff + m * 2048 + k * 1024); } while (0)
#define PG8_LDB(dst, b, h) do { _Pragma("unroll") for (int n = 0; n < 2; ++n) _Pragma("unroll") for (int k = 0; k < 2; ++k) dst[n][k] = *(const LAS bf16x8*)(lds + PG8_SB(b, h) + boff + n * 2048 + k * 1024); } while (0)
#define PG8_MMA(ai, bj, At, Bt) do { __builtin_amdgcn_s_setprio(1); _Pragma("unroll") for (int m = 0; m < 4; ++m) _Pragma("unroll") for (int n = 0; n < 2; ++n) _Pragma("unroll") for (int k = 0; k < 2; ++k) \
        acc[ai][bj][m][n] = __builtin_amdgcn_mfma_f32_16x16x32_bf16(Bt[n][k], At[m][k], acc[ai][bj][m][n], 0, 0, 0); __builtin_amdgcn_s_setprio(0); } while (0)
#define PG8_WAIT_V(n) asm volatile("s_waitcnt vmcnt(" #n ")" ::: "memory")
#define PG8_WAIT_L(n) asm volatile("s_waitcnt lgkmcnt(" #n ")" ::: "memory")
#define PG8_BAR __builtin_amdgcn_s_barrier()
#define PG8_SCHED __builtin_amdgcn_sched_barrier(0)
    Unit cur, nxt; int ui = 0;
    if (!S.next(0, cur)) return;
    f32x4 acc[2][2][4][2];
#pragma unroll
    for (int a = 0; a < 2; ++a)
#pragma unroll
        for (int b = 0; b < 2; ++b)
#pragma unroll
            for (int m = 0; m < 4; ++m)
#pragma unroll
                for (int n = 0; n < 2; ++n) acc[a][b][m][n] = (f32x4){0.f, 0.f, 0.f, 0.f};
    bf16x8 At[4][2], B0[2][2], B1[2][2];
    const char* cA = (const char*)g.A + (size_t)cur.pm * tstepA; const char* cB = (const char*)g.Bt + (size_t)cur.pn * tstepB;
    PG8_STAGE(PG8_SB(0, 0), cB, voffB); PG8_STAGE(PG8_SA(0, 0), cA, voffA); PG8_STAGE(PG8_SB(0, 1), cB + hstepB, voffB); PG8_STAGE(PG8_SA(0, 1), cA + hstepA, voffA);
    if (wr == 1) PG8_BAR;
    PG8_WAIT_V(4); PG8_BAR;
    PG8_STAGE(PG8_SB(1, 0), cB + kstep, voffB); PG8_STAGE(PG8_SA(1, 0), cA + kstep, voffA); PG8_STAGE(PG8_SB(1, 1), cB + hstepB + kstep, voffB);
    PG8_WAIT_V(6); PG8_BAR;
    for (;;) {
        const bool has_next = S.next(ui + 1, nxt);
        const char* nA = has_next ? (const char*)g.A + (size_t)nxt.pm * tstepA : cA; const char* nB = has_next ? (const char*)g.Bt + (size_t)nxt.pn * tstepB : cB;
        for (int t = 0; t < nt; t += 2) {
            const bool last = (t == nt - 2);
            const char* a1 = cA + (size_t)(t + 1) * kstep;
            const char* a2 = last ? nA : cA + (size_t)(t + 2) * kstep; const char* b2 = last ? nB : cB + (size_t)(t + 2) * kstep;
            const char* a3 = a2 + kstep; const char* b3 = b2 + kstep;
            PG8_LDB(B0, 0, 0); PG8_SCHED; PG8_LDA(At, 0, 0); PG8_STAGE(PG8_SA(1, 1), a1 + hstepA, voffA);
            PG8_WAIT_L(8); PG8_BAR; PG8_WAIT_L(0); PG8_MMA(0, 0, At, B0); PG8_BAR; PG8_SCHED;
            PG8_LDB(B1, 0, 1); PG8_STAGE(PG8_SB(0, 0), b2, voffB);
            PG8_BAR; PG8_WAIT_L(0); PG8_MMA(0, 1, At, B1); PG8_BAR;
            PG8_LDA(At, 0, 1); PG8_STAGE(PG8_SA(0, 0), a2, voffA);
            PG8_BAR; PG8_WAIT_L(0); PG8_MMA(1, 0, At, B0); PG8_BAR; PG8_SCHED;
            PG8_STAGE(PG8_SB(0, 1), b2 + hstepB, voffB);
            PG8_WAIT_V(6); PG8_BAR; PG8_MMA(1, 1, At, B1); PG8_BAR;
            PG8_LDB(B0, 1, 0); PG8_SCHED; PG8_LDA(At, 1, 0); PG8_STAGE(PG8_SA(0, 1), a2 + hstepA, voffA);
            PG8_WAIT_L(8); PG8_BAR; PG8_WAIT_L(0); PG8_MMA(0, 0, At, B0); PG8_BAR; PG8_SCHED;
            PG8_LDB(B1, 1, 1); PG8_STAGE(PG8_SB(1, 0), b3, voffB);
            PG8_BAR; PG8_WAIT_L(0); PG8_MMA(0, 1, At, B1); PG8_BAR;
            PG8_LDA(At, 1, 1); PG8_STAGE(PG8_SA(1, 0), a3, voffA);
            PG8_BAR; PG8_WAIT_L(0); PG8_MMA(1, 0, At, B0); PG8_BAR; PG8_SCHED;
            PG8_STAGE(PG8_SB(1, 1), b3 + hstepB, voffB);
            PG8_WAIT_V(6); PG8_BAR; PG8_MMA(1, 1, At, B1); PG8_BAR;
        }
        E(acc, cur, wr, wc, fr, fq);
        if (!has_next) break;
#pragma unroll
        for (int a = 0; a < 2; ++a)
#pragma unroll
            for (int b = 0; b < 2; ++b)
#pragma unroll
                for (int m = 0; m < 4; ++m)
#pragma unroll
                    for (int n = 0; n < 2; ++n) acc[a][b][m][n] = (f32x4){0.f, 0.f, 0.f, 0.f};
        cur = nxt; cA = nA; cB = nB; ++ui;
    }
    PG8_WAIT_V(0);
    if (wr == 0) PG8_BAR;
    PG8_BAR;
#undef PG8_SA
#undef PG8_SB
#undef PG8_STAGE
#undef PG8_LDA
#undef PG8_LDB
#undef PG8_MMA
#undef PG8_WAIT_V
#undef PG8_WAIT_L
#undef PG8_BAR
#undef PG8_SCHED
}

struct EpiInProj {
    static constexpr bool PERM = true;
    bf16_t* proj; float* dtb; const float* rowss; int nt_main; bf16_t* tails; int tl_lo, tl_hi; bool dry;
    __device__ __forceinline__ void operator()(const f32x4 (&acc)[2][2][4][2], const Unit& u, int wr, int wc, int fr, int fq) const {
        const int row0 = u.pm * BM + wr * 64 + fr;
#pragma unroll
        for (int ai = 0; ai < 2; ++ai)
#pragma unroll
            for (int m = 0; m < 4; ++m) {
                const int r = row0 + ai * HALF + m * 16;
                const f32x4* rp = (const f32x4*)(rowss + (size_t)r * 16);
                const f32x4 p0 = rp[0], p1 = rp[1], p2 = rp[2], p3 = rp[3];
                const float ss = ((p0[0] + p0[1]) + (p0[2] + p0[3])) + ((p1[0] + p1[1]) + (p1[2] + p1[3])) + ((p2[0] + p2[1]) + (p2[2] + p2[3])) + ((p3[0] + p3[1]) + (p3[2] + p3[3]));
                const float rstd = rsqrtf(ss * (1.0f / 1024.0f) + EPS);
                if (u.pn < nt_main) {
                    bf16_t* rowp = proj + (size_t)r * LDP + u.pn * BM + wc * 32 + 8 * fq;
#pragma unroll
                    for (int bj = 0; bj < 2; ++bj) { const f32x4 v0 = acc[ai][bj][m][0] * rstd, v1 = acc[ai][bj][m][1] * rstd;
                        u32x4 w; w.x = cvt_pk_bf16(v0[0], v0[1]); w.y = cvt_pk_bf16(v0[2], v0[3]); w.z = cvt_pk_bf16(v1[0], v1[1]); w.w = cvt_pk_bf16(v1[2], v1[3]);
                        if (dry) { KEEP(w); continue; }
                        *(u32x4*)(rowp + bj * HALF) = w;
                        if (u.pn >= tl_lo && u.pn < tl_hi && r < ROW_S0 && (r & 63) >= 61) *(u32x4*)(tails + ((size_t)(r >> 6) * 3 + ((r & 63) - 61)) * 4096 + (u.pn - tl_lo) * BM + wc * 32 + 8 * fq + bj * HALF) = w; }
                } else if (wc == 0) {
                    float* dp = dtb + (size_t)r * 32 + 8 * fq;
                    if (!dry) { *(f32x4*)(dp) = acc[ai][0][m][0] * rstd; *(f32x4*)(dp + 4) = acc[ai][0][m][1] * rstd; }
                }
            }
    }
};
struct EpiOutProj {
    static constexpr bool PERM = false;
    bf16_t* hb; float* rowss; bool dry; bool wt;
    __device__ __forceinline__ void operator()(const f32x4 (&acc)[2][2][4][2], const Unit& u, int wr, int wc, int fr, int fq) const {
        const int row0 = u.pm * BM + wr * 64 + fr, col0 = u.pn * BM + wc * 32 + 4 * fq;
#pragma unroll
        for (int ai = 0; ai < 2; ++ai)
#pragma unroll
            for (int m = 0; m < 4; ++m) {
                const int r = row0 + ai * HALF + m * 16; float ss = 0.f;
                bf16_t* rowp = hb + (size_t)r * D + col0;
#pragma unroll
                for (int bj = 0; bj < 2; ++bj)
#pragma unroll
                    for (int n = 0; n < 2; ++n) {
                        u32x2* p = (u32x2*)(rowp + bj * HALF + n * 16); const u32x2 o = *p;
                        const f32x4 a = acc[ai][bj][m][n];
                        const float h0 = __uint_as_float(o.x << 16) + a[0], h1 = __uint_as_float(o.x & 0xffff0000u) + a[1];
                        const float h2 = __uint_as_float(o.y << 16) + a[2], h3 = __uint_as_float(o.y & 0xffff0000u) + a[3];
                        ss += (h0 * h0 + h1 * h1) + (h2 * h2 + h3 * h3);
                        u32x2 w; w.x = cvt_pk_bf16(h0, h1); w.y = cvt_pk_bf16(h2, h3);
                        if (dry) KEEP(w); else if (wt) __hip_atomic_store((unsigned long long*)p, ((unsigned long long)w.y << 32) | w.x, __ATOMIC_RELAXED, __HIP_MEMORY_SCOPE_AGENT); else *p = w;
                    }
                ss += __shfl_xor(ss, 16); ss += __shfl_xor(ss, 32);
                if (fq == 0) { if (dry) KEEP(ss); else if (wt) __hip_atomic_store(rowss + (size_t)r * 16 + u.pn * 4 + wc, ss, __ATOMIC_RELAXED, __HIP_MEMORY_SCOPE_AGENT); else rowss[(size_t)r * 16 + u.pn * 4 + wc] = ss; }
            }
    }
};
}

#define XB_TMO      128
#define XB_XCNT(j)  (256  + 64 * (j))
#define XB_XSUB(j)  (1280 + 64 * (j))
#define XB_XGEN(j)  (2304 + 64 * (j))
#define XB_TOP      3328
#define XB_TOPGEN   3392
#define XCD_BAR_WORDS 3456
#define XB_SPIN_CAP (1u << 24)
__device__ __forceinline__ unsigned xb_ld(unsigned* p)              { return __hip_atomic_load(p, __ATOMIC_RELAXED, __HIP_MEMORY_SCOPE_AGENT); }
__device__ __forceinline__ unsigned xb_add(unsigned* p, unsigned v) { return __hip_atomic_fetch_add(p, v, __ATOMIC_RELAXED, __HIP_MEMORY_SCOPE_AGENT); }
__device__ __forceinline__ unsigned xb_xcc_id() { return (unsigned)__builtin_amdgcn_s_getreg((3 << 11) | 20) & 0xFu; }
#define XB_SPIN(cond, bar) do { unsigned _sp = 0; while (cond) { __builtin_amdgcn_s_sleep(1); \
    if ((++_sp & 255u) == 0u) { if (xb_ld(&(bar)[XB_TMO])) break; if (_sp > XB_SPIN_CAP) { atomicAdd(&(bar)[XB_TMO], 1u); break; } } } } while (0)
struct XcdBarrier { unsigned* bar; unsigned x; volatile LAS unsigned* st; };
__device__ __forceinline__ XcdBarrier xcd_barrier_post(unsigned* bar, volatile LAS unsigned* st) {
    XcdBarrier b; b.bar = bar; b.x = xb_xcc_id(); b.st = st;
    if (threadIdx.x == 0) (void)xb_add(&bar[XB_XCNT(b.x)], 1u);
    return b;
}
__device__ __forceinline__ void xcd_barrier_complete(unsigned* bar, unsigned x, unsigned& nloc, unsigned& nx) {
    const unsigned G = gridDim.x * gridDim.y * gridDim.z;
    unsigned sum, cnt, mine, sp = 0u;
    for (;;) {
        sum = 0u; cnt = 0u; mine = 0u;
#pragma unroll
        for (unsigned j = 0; j < 16; ++j) { const unsigned c = xb_ld(&bar[XB_XCNT(j)]); sum += c; cnt += (c > 0u) ? 1u : 0u; mine = (j == x) ? c : mine; }
        if (sum == G) break;
        __builtin_amdgcn_s_sleep(1);
        if ((++sp & 255u) == 0u) { if (xb_ld(&bar[XB_TMO])) break; if (sp > XB_SPIN_CAP) { atomicAdd(&bar[XB_TMO], 1u); break; } }
    }
    nloc = mine > 0u ? mine : 1u; nx = cnt > 0u ? cnt : 1u;
}
__device__ __forceinline__ void xcd_barrier(const XcdBarrier& b) {
    asm volatile("s_waitcnt vmcnt(0)" ::: "memory");
    __syncthreads();
    if (threadIdx.x == 0) {
        unsigned* bar = b.bar;
        __builtin_amdgcn_s_waitcnt(0);
        unsigned nloc = b.st[0], nx = b.st[1];
        if (nloc == 0u) { xcd_barrier_complete(bar, b.x, nloc, nx); b.st[0] = nloc; b.st[1] = nx; }
        const unsigned old = xb_add(&bar[XB_XSUB(b.x)], 1u);
        const unsigned gen = old / nloc;
        if (old + 1u == (gen + 1u) * nloc) {
            __builtin_amdgcn_fence(__ATOMIC_RELEASE, "agent");
            asm volatile("s_waitcnt vmcnt(0)" ::: "memory");
            const unsigned og = xb_add(&bar[XB_TOP], 1u);
            const unsigned tg = og / nx;
            if (og + 1u == (tg + 1u) * nx) xb_add(&bar[XB_TOPGEN], 1u);
            else XB_SPIN(xb_ld(&bar[XB_TOPGEN]) == tg, bar);
            __builtin_amdgcn_fence(__ATOMIC_ACQUIRE, "agent");
            xb_add(&bar[XB_XGEN(b.x)], 1u);
            asm volatile("s_waitcnt vmcnt(0)" ::: "memory");
        } else {
            XB_SPIN(xb_ld(&bar[XB_XGEN(b.x)]) == gen, bar);
            __builtin_amdgcn_fence(__ATOMIC_ACQUIRE, "agent");
            asm volatile("s_waitcnt vmcnt(0)" ::: "memory");
        }
    }
    __syncthreads();
}

struct Args { const float* in[24]; float* out; unsigned char* ws; int ph_lo, ph_hi; };

struct Frame {
    const Args* ap; float* out; unsigned char* ws;
    __device__ __forceinline__ const float* inp(int i) const { asm volatile("" : "+s"(i)); return ap->in[i]; }
    unsigned char* lds; LAS unsigned char* ldsl;
    int tid, lane, wave, G, bid;
    bf16_t* hb; bf16_t* win; bf16_t* wout; float* dtb; float* rss; bf16_t* proj; bf16_t* tails;
};

__device__ __forceinline__ Frame relaunder(Frame F) {
    int t = F.tid; asm volatile("" : "+v"(t));
    F.tid = t; F.lane = t & 63; F.wave = __builtin_amdgcn_readfirstlane(t >> 6);
    unsigned wlo = __builtin_amdgcn_readfirstlane((unsigned)(unsigned long long)F.ws), whi = __builtin_amdgcn_readfirstlane((unsigned)((unsigned long long)F.ws >> 32));
    asm volatile("" : "+s"(wlo), "+s"(whi));
    unsigned char* w = (unsigned char*)(__attribute__((address_space(1))) unsigned char*)(((unsigned long long)whi << 32) | wlo);
    F.ws = w; F.hb = (bf16_t*)(w + WS_HB); F.win = (bf16_t*)(w + WS_WIN); F.wout = (bf16_t*)(w + WS_WOUT);
    F.dtb = (float*)(w + WS_DTB); F.rss = (float*)(w + WS_RSS); F.proj = (bf16_t*)(w + WS_PROJ); F.tails = (bf16_t*)(w + WS_TAIL);
    return F;
}
__device__ __forceinline__ void phase_init_h(const Frame& F0) {
    const Frame F = relaunder(F0);
    const float* xp = F.inp(0); const float* xs = F.inp(1); const float* meta = F.inp(6);
    for (int row = F.bid * 8 + F.wave; row < M_TOT; row += F.G * 8) {
        const float* src = nullptr;
        if (row < ROW_S0) { const int b = row / TPP, r = row % TPP; if (r >= 64) src = xp + ((size_t)b * SEQ + (r - 64)) * D; else if (r >= PADF) src = meta + (size_t)(r - PADF) * D; }
        else src = xs + (size_t)(row - ROW_S0) * D;
        float ss = 0.f;
#pragma unroll
        for (int i = 0; i < 4; ++i) {
            f32x4 v = (f32x4){0.f, 0.f, 0.f, 0.f};
            if (src) v = *(const f32x4*)(src + (F.lane + 64 * i) * 4);
            ss += (v[0] * v[0] + v[1] * v[1]) + (v[2] * v[2] + v[3] * v[3]);
            u32x2 w; w.x = cvt_pk_bf16(v[0], v[1]); w.y = cvt_pk_bf16(v[2], v[3]);
            *(u32x2*)(F.hb + (size_t)row * D + (F.lane + 64 * i) * 4) = w;
        }
        ss = wave_sum(ss);
        if (F.lane < 16) F.rss[(size_t)row * 16 + F.lane] = (F.lane == 0) ? ss : 0.f;
    }
}

__device__ void transpose_convert(const Frame& F, const float* src, int K, int N, int Npad, bf16_t* dst, const float* scale, int smod, int skip) {
    float* tile = (float*)F.lds;
    const int ntk = K / 64, ntn = Npad / 64, ntile = ntk * ntn;
    __syncthreads();
    if (skip < 0 || 2 * skip > F.G) skip = 0;
    if (F.bid < skip) return;
    for (int ti = F.bid - skip; ti < ntile; ti += F.G - skip) {
        const int kt = ti % ntk, nt_ = ti / ntk, k0 = kt * 64, n0 = nt_ * 64;
        const int kk = F.tid >> 4, n4 = (F.tid & 15) * 4;
#pragma unroll
        for (int h = 0; h < 2; ++h) {
            const int k = k0 + kk + 32 * h, n = n0 + n4;
            f32x4 v = (f32x4){0.f, 0.f, 0.f, 0.f};
            if (n < N) v = *(const f32x4*)(src + (size_t)k * N + n);
            const float s = scale[k % smod];
            float* tp = tile + (kk + 32 * h) * 65 + n4;
            tp[0] = v[0] * s; tp[1] = v[1] * s; tp[2] = v[2] * s; tp[3] = v[3] * s;
        }
        __syncthreads();
        const int nn = F.tid >> 3, kg = (F.tid & 7) * 8;
        float x[8];
#pragma unroll
        for (int j = 0; j < 8; ++j) x[j] = tile[(kg + j) * 65 + nn];
        u32x4 w; w.x = cvt_pk_bf16(x[0], x[1]); w.y = cvt_pk_bf16(x[2], x[3]); w.z = cvt_pk_bf16(x[4], x[5]); w.w = cvt_pk_bf16(x[6], x[7]);
        *(u32x4*)(dst + (size_t)(n0 + nn) * K + k0 + kg) = w;
        __syncthreads();
    }
}
__device__ __forceinline__ void phase_wprep_in(const Frame& F0, int L, int skip) {
    const Frame F = relaunder(F0);
    const int j = L >> 1;
    if ((L & 1) == 0) transpose_convert(F, F.inp(8) + (size_t)j * D * SSD_IN, D, SSD_IN, SSD_IN_PAD, F.win, F.inp(7) + j * D, D, skip);
    else transpose_convert(F, F.inp(17) + (size_t)j * D * GDN_IN, D, GDN_IN, GDN_IN_PAD, F.win, F.inp(16) + j * D, D, skip);
}
__device__ __forceinline__ void phase_wprep_out(const Frame& F0, int L, int skip) {
    const Frame F = relaunder(F0);
    const int j = L >> 1;
    if ((L & 1) == 0) transpose_convert(F, F.inp(15) + (size_t)j * SSD_INNER * D, SSD_INNER, D, D, F.wout, F.inp(14) + j * SSD_INNER, SSD_INNER, skip);
    else transpose_convert(F, F.inp(22) + (size_t)j * GDN_VAL * D, GDN_VAL, D, D, F.wout, F.inp(21) + j * GDN_DV, GDN_DV, skip);
}

constexpr size_t WS_READY = 40960;
__device__ __forceinline__ void phase_inproj(const Frame& F0, int L, bool zmode) {
    const Frame F = relaunder(F0);
    const int npad = (L & 1) ? GDN_IN_PAD : SSD_IN_PAD, nN = npad / 256;
    const bool gated = (F.G == 256) && L >= 1, zsplit = gated && (L & 1);
    if (zmode && (!zsplit || F.bid < 128)) return;
    unsigned* ready = (unsigned*)(F.ws + WS_READY) + L;
    pg8::Gemm g{F.hb, F.win, M_TOT, npad, D, D, D};
    pg8::EpiInProj E{F.proj, F.dtb, F.rss, nN - 1, F.tails, (L & 1) ? 0 : 8, 16, false};
    for (int pass = 0; pass < ((gated && !zmode) ? 2 : 1); ++pass) {
        pg8::StaticOrder S;
        if (zmode) { S.init(64 * 256, 8 * 256, 128, F.bid - 128); S.poff = 16; }
        else if (!gated) S.init(M_TOT, npad, F.G, F.bid);
        else if (pass == 0) {
            S.init(64 * 256, zsplit ? 17 * 256 : npad, F.G, F.bid);
            if (zsplit) { S.psplit = 16; S.ptail = 24; }
            const int n = S.count_main();
            if (F.bid >= 252) S.imax = n - 2;
            else if (F.bid >= 64 + nN && F.bid < 72 + nN) {
                const int k = F.bid - 64 - nN; pg8::StaticOrder D2 = S; D2.c = 252 + (k & 3); pg8::Unit u; if (D2.main_unit(D2.count_main() - 1 - (k >> 2), D2.c, u)) { S.xpm = u.pm; S.xpn = u.pn; } }
        } else {
            if (F.bid < 64 || F.bid >= 64 + nN) break;
            if (F.tid < 64) {
                unsigned spins = 0;
                while ((unsigned)__builtin_amdgcn_readfirstlane(__hip_atomic_load(ready, __ATOMIC_RELAXED, __HIP_MEMORY_SCOPE_AGENT)) < 32u) { __builtin_amdgcn_s_sleep(4); if (++spins > (1u << 22)) break; }
                __builtin_amdgcn_fence(__ATOMIC_ACQUIRE, "agent");
                asm volatile("s_waitcnt vmcnt(0)" ::: "memory");
            }
            __syncthreads();
            S.init(64 * 256, npad, F.G, F.bid); S.imax = 0; S.xpm = 64; S.xpn = F.bid - 64;
        }
        pg8::gemm_phase<pg8::EpiInProj>(F.ldsl, g, S, E, F.tid);
    }
}
__device__ __forceinline__ void phase_outproj(const Frame& F0, int L, bool leftover, unsigned pollcnt) {
    const Frame F = relaunder(F0);
    const bf16_t* A = F.proj + ((L & 1) ? 4096 : 0);
    const bool split = (F.G == 256);
    if (leftover && (!split || F.bid < 252)) return;
    if (leftover && pollcnt) {
        if (F.tid < 64) {
            unsigned spins = 0; unsigned* cnt = (unsigned*)(F.ws + WS_READY) + 8;
            while ((unsigned)__builtin_amdgcn_readfirstlane(__hip_atomic_load(cnt, __ATOMIC_RELAXED, __HIP_MEMORY_SCOPE_AGENT)) < pollcnt) { __builtin_amdgcn_s_sleep(4); if (++spins > (1u << 22)) break; }
            __builtin_amdgcn_fence(__ATOMIC_ACQUIRE, "agent");
            asm volatile("s_waitcnt vmcnt(0)" ::: "memory");
        }
        __syncthreads();
    }
    pg8::Gemm g{A, F.wout, M_TOT, D, 2048, LDP, 2048};
    pg8::StaticOrder S;
    if (leftover) { S.init(M_TOT, D, F.G, F.bid); S.imax = 0; S.xpm = 64; S.xpn = F.bid - 252; }
    else S.init(split ? 64 * 256 : M_TOT, D, F.G, F.bid);
    pg8::EpiOutProj E{F.hb, F.rss, false, leftover && L < 3};
    pg8::gemm_phase<pg8::EpiOutProj>(F.ldsl, g, S, E, F.tid);
    if (leftover) {
        asm volatile("s_waitcnt vmcnt(0)" ::: "memory");
        if (F.lane == 0) __hip_atomic_fetch_add((unsigned*)(F.ws + WS_READY) + L + 1, 1u, __ATOMIC_RELAXED, __HIP_MEMORY_SCOPE_AGENT);
        __syncthreads();
    }
}

constexpr int NCHT = 266;
constexpr size_t SC_BT = 0;
constexpr size_t SC_C = SC_BT + (size_t)NCHT * 4 * 16384;
constexpr size_t SC_CB = SC_C + (size_t)NCHT * 4 * 16384;
constexpr size_t SC_VEC = SC_CB + (size_t)NCHT * 4 * 8192;
constexpr size_t SC_XS = SC_VEC + (size_t)NCHT * 32 * 1024;
constexpr size_t SC_HSEG = SC_XS + (size_t)256 * 8192;
constexpr size_t SC_CUM = SC_HSEG + (size_t)256 * 8192 * 4;
constexpr size_t SC_HB16 = SC_CUM + (size_t)258 * 32 * 4;
constexpr size_t SC_SSD_END = SC_HB16 + (size_t)64 * 3 * 8192 * 2;
constexpr int SEGL = 33;
static_assert(SC_SSD_END <= (size_t)16777216 * 4, "scratch must fit the y_prompt region");
__device__ __forceinline__ int qperm(int s) { return (s & ~31) | (((s >> 2) & 3) << 3) | (((s >> 4) & 1) << 2) | (s & 3); }
__device__ __forceinline__ int qnat(int q) { return (q & ~31) | (((q >> 2) & 1) << 4) | (((q >> 3) & 3) << 2) | (q & 3); }
__device__ __forceinline__ bf16x8 pack8(f32x4 a, f32x4 b) {
    u32x4 w; w.x = cvt_pk_bf16(a[0], a[1]); w.y = cvt_pk_bf16(a[2], a[3]); w.z = cvt_pk_bf16(b[0], b[1]); w.w = cvt_pk_bf16(b[2], b[3]);
    return __builtin_bit_cast(bf16x8, w);
}
__device__ __forceinline__ void chunk_of(int cgi, int& seq, int& c) { if (cgi < 258) { seq = cgi / 129; c = cgi % 129; } else { seq = 2 + (cgi - 258); c = 0; } }
__device__ __forceinline__ int cgi_of(int seq, int c) { return seq < 2 ? seq * 129 + c : 258 + (seq - 2); }
struct XTile { bf16_t* p; int stride; };
__device__ __forceinline__ XTile ssd_xtile(const Frame& F, int seq, int c, int head) {
    XTile t;
    if (seq < 2) { t.p = F.proj + (size_t)(seq * TPP + 64 * c) * LDP + 2048 + head * 64; t.stride = LDP; }
    else { t.p = (bf16_t*)((unsigned char*)F.out + SC_XS) + (size_t)((seq - 2) * 32 + head) * 4096; t.stride = 64; }
    return t;
}

__device__ __forceinline__ void ssd_xraw_load(unsigned short (&raw)[32], const Frame& F, int task, int pg) {
    const int cgi = task >> 2, grp = task & 3; int seq, c; chunk_of(cgi, seq, c);
    const int base = seq_base(seq), t0 = 64 * c - PADF + 32 * pg;
    const bf16_t* xcol = F.proj + 2048 + (grp * 8 + (F.tid >> 6)) * 64 + (F.tid & 63);
#pragma unroll
    for (int e = 0; e < 32; ++e) { const int t = t0 + e; raw[e] = xcol[(size_t)(base + (t > 0 ? t : 0)) * LDP]; }
}
__device__ __forceinline__ void ssd_aux_load(float (&aux)[4], const Frame& F, int j, int task) {
    const int cgi = task >> 2, grp = task & 3; int seq, c; chunk_of(cgi, seq, c);
    const int cidx = (grp * 8 + (F.tid >> 6)) * 64 + (F.tid & 63);
    aux[0] = 0.f; aux[1] = 0.f; aux[2] = 0.f; aux[3] = 0.f;
    if (seq < 2 && c > 0) { const bf16_t* tp = F.tails + (size_t)(cgi - 1) * 3 * 4096 + cidx; aux[0] = bf2f(tp[0]); aux[1] = bf2f(tp[4096]); aux[2] = bf2f(tp[2 * 4096]); }
    else if (seq >= 2) { const float* cst = F.inp(3) + (((size_t)j * 8 + (seq - 2)) * 3) * SSD_CONV + cidx; aux[0] = cst[0]; aux[1] = cst[SSD_CONV]; aux[2] = cst[2 * SSD_CONV]; }
    { const int t = 64 * c - PADF + F.lane; if (t >= 0) aux[3] = F.dtb[(size_t)(seq_base(seq) + t) * 32 + grp * 8 + F.wave]; }
}
template <bool ALLPOS>
__device__ __forceinline__ void ssd_xconv32(const unsigned short (&raw)[32], bf16_t* xrow32, int tb, float w0, float w1, float w2, float w3, float cb, float& r3, float& r2, float& r1) {
#pragma unroll
    for (int e8 = 0; e8 < 4; ++e8) {
        float o[8];
#pragma unroll
        for (int h = 0; h < 8; ++h) {
            const int t = tb + 8 * e8 + h;
            const float v = (ALLPOS || t >= 0) ? bf2f(raw[8 * e8 + h]) : 0.f;
            o[h] = silu_f(cb + w0 * r3 + w1 * r2 + w2 * r1 + w3 * v);
            if (ALLPOS || t >= 0) { r3 = r2; r2 = r1; r1 = v; }
        }
        u32x4 w; w.x = cvt_pk_bf16(o[0], o[1]); w.y = cvt_pk_bf16(o[2], o[3]); w.z = cvt_pk_bf16(o[4], o[5]); w.w = cvt_pk_bf16(o[6], o[7]);
        *(u32x4*)(xrow32 + 8 * e8) = w;
    }
}
template <bool DRY>
__device__ __forceinline__ void phase_ssd_prep(const Frame& F0, int j) {
    const Frame F = relaunder(F0);
    bf16_t* Bs = (bf16_t*)F.lds + 512 * 72;
    bf16_t* Cs = Bs + 64 * 136;
    unsigned char* sc = (unsigned char*)F.out;
    const float* conv_w = F.inp(9) + (size_t)j * 4 * SSD_CONV; const float* conv_b = F.inp(10) + (size_t)j * SSD_CONV;
    const int i16 = F.lane & 15, g4 = F.lane >> 4;
    unsigned long long bz_t0 = 0ull;
    unsigned short rawA[32]; float aux[4];
    if (F.bid < NCHT * 4) { ssd_xraw_load(rawA, F, F.bid, 0); ssd_aux_load(aux, F, j, F.bid); }
    asm volatile("" :: "v"((unsigned)rawA[0]), "v"((unsigned)rawA[31]), "v"(aux[0]), "v"(aux[1]), "v"(aux[2]), "v"(aux[3]));
    int wgrp = -1; float xw0 = 0.f, xw1 = 0.f, xw2 = 0.f, xw3 = 0.f, xcb = 0.f, bw0 = 0.f, bw1 = 0.f, bw2 = 0.f, bw3 = 0.f, bcb = 0.f, negA = 0.f, dtbias = 0.f;
    for (int task = F.bid; task < NCHT * 4; task += F.G) {
        const int cgi = task >> 2, grp = task & 3; int seq, c; chunk_of(cgi, seq, c);
        const int base = seq_base(seq), t0 = 64 * c - PADF;
        const int bch = F.tid & 255, half = F.tid >> 8, isC = bch >> 7, bn = bch & 127, bidx = 2048 + isC * 512 + grp * 128 + bn;
        if (grp != wgrp) {
            wgrp = grp;
            const int cidx = (grp * 8 + (F.tid >> 6)) * 64 + (F.tid & 63);
            xw0 = conv_w[cidx]; xw1 = conv_w[SSD_CONV + cidx]; xw2 = conv_w[2 * SSD_CONV + cidx]; xw3 = conv_w[3 * SSD_CONV + cidx]; xcb = conv_b[cidx];
            bw0 = conv_w[bidx]; bw1 = conv_w[SSD_CONV + bidx]; bw2 = conv_w[2 * SSD_CONV + bidx]; bw3 = conv_w[3 * SSD_CONV + bidx]; bcb = conv_b[bidx];
            negA = -__expf(F.inp(12)[j * SSD_HEADS + grp * 8 + F.wave]); dtbias = F.inp(11)[j * SSD_HEADS + grp * 8 + F.wave];
            asm volatile("" :: "v"(xw0), "v"(xw1), "v"(xw2), "v"(xw3), "v"(xcb), "v"(bw0), "v"(bw1), "v"(bw2), "v"(bw3), "v"(bcb), "v"(negA), "v"(dtbias));
        }
        const float dtraw = aux[3];
        __syncthreads();
        if (task != F.bid) { BUSY_T1(13, 0) } BUSY_T0B(11)
        unsigned short rawC[35];
        {
            const int hl = F.tid >> 6, p = F.tid & 63, head = grp * 8 + hl;
            float r3 = aux[0], r2 = aux[1], r1 = aux[2];
            bf16_t* xrow = (bf16_t*)F.lds + F.tid * 72;
            unsigned short rawB[32];
            ssd_xraw_load(rawB, F, task, 1);
            if (t0 >= 0) ssd_xconv32<true>(rawA, xrow, t0, xw0, xw1, xw2, xw3, xcb, r3, r2, r1); else ssd_xconv32<false>(rawA, xrow, t0, xw0, xw1, xw2, xw3, xcb, r3, r2, r1);
            {   const bf16_t* col = F.proj + 2048 + bidx;
#pragma unroll
                for (int e = 0; e < 35; ++e) { const int t = t0 + half * 32 - 3 + e; rawC[e] = col[(size_t)(base + (t > 0 ? t : 0)) * LDP]; } }
            if (t0 >= 0) ssd_xconv32<true>(rawB, xrow + 32, t0 + 32, xw0, xw1, xw2, xw3, xcb, r3, r2, r1); else ssd_xconv32<false>(rawB, xrow + 32, t0 + 32, xw0, xw1, xw2, xw3, xcb, r3, r2, r1);
            const XTile xt = ssd_xtile(F, seq, c, head);
#pragma unroll
            for (int q = 0; q < 8; ++q) { const u32x4 w = *(const u32x4*)(xrow + 8 * q);
                if (!DRY) *(u32x4*)(xt.p + (size_t)p * xt.stride + 8 * q) = w; else KEEP(w); }
        }
        BUSY_T1(11, 0) BUSY_T0B(12)
        {
            bf16_t* dst = (isC ? Cs : Bs) + bn;
            float cs0 = 0.f, cs1 = 0.f, cs2 = 0.f;
            if (seq >= 2) {
                const float* cst = F.inp(3) + (((size_t)j * 8 + (seq - 2)) * 3) * SSD_CONV + bidx;
                cs0 = cst[0]; cs1 = cst[SSD_CONV]; cs2 = cst[2 * SSD_CONV];
                asm volatile("" :: "v"(cs0), "v"(cs1), "v"(cs2));
            }
            const bool smp = seq >= 2 && half == 1;
            float r3, r2, r1;
            {   float rv[3];
#pragma unroll
                for (int q = 0; q < 3; ++q) { const int t = t0 + half * 32 - 3 + q; rv[q] = (t >= 0) ? bf2f(rawC[q]) : 0.f; }
                r3 = rv[0]; r2 = rv[1]; r1 = rv[2]; }
#pragma unroll
            for (int ii = 0; ii < 32; ++ii) {
                const int p = half * 32 + ii, t = t0 + p;
                float v = (t >= 0) ? bf2f(rawC[ii + 3]) : 0.f;
                if (ii >= 13 && ii <= 15) { const float cv = ii == 13 ? cs0 : (ii == 14 ? cs1 : cs2); v = (smp && t < 0) ? cv : v; }
                const float o = silu_f(bcb + bw0 * r3 + bw1 * r2 + bw2 * r1 + bw3 * v);
                r3 = r2; r2 = r1; r1 = v;
                dst[p * 136] = f2bf(o);
            }
        }
        if (task + F.G < NCHT * 4) { ssd_xraw_load(rawA, F, task + F.G, 0); ssd_aux_load(aux, F, j, task + F.G); }
        __syncthreads();
        BUSY_T1(12, 0) BUSY_T0B(13)
        {
            bf16_t* BT = (bf16_t*)(sc + SC_BT) + (size_t)(cgi * 4 + grp) * 8192;
            const int n = F.tid >> 2, qg = (F.tid & 3) * 16;
#pragma unroll
            for (int u = 0; u < 2; ++u) {
                const int q0 = qg + 8 * u; unsigned short e[8];
#pragma unroll
                for (int jj = 0; jj < 8; ++jj) e[jj] = Bs[qnat(q0 + jj) * 136 + n];
                u32x4 w; w.x = e[0] | ((unsigned)e[1] << 16); w.y = e[2] | ((unsigned)e[3] << 16); w.z = e[4] | ((unsigned)e[5] << 16); w.w = e[6] | ((unsigned)e[7] << 16);
                if (!DRY) *(u32x4*)(BT + n * 64 + q0) = w; else KEEP(w);
            }
            bf16_t* Cg = (bf16_t*)(sc + SC_C) + (size_t)(cgi * 4 + grp) * 8192;
#pragma unroll
            for (int u = 0; u < 2; ++u) {
                const int idx = F.tid + 512 * u, l = idx >> 4, qg8 = idx & 15, kk = qg8 >> 2, gg = qg8 & 3;
                const u32x2 a = *(const u32x2*)(Cs + l * 136 + 32 * kk + 4 * gg), b = *(const u32x2*)(Cs + l * 136 + 32 * kk + 16 + 4 * gg);
                u32x4 w; w.x = a.x; w.y = a.y; w.z = b.x; w.w = b.y;
                if (!DRY) *(u32x4*)(Cg + l * 128 + 8 * qg8) = w; else KEEP(w);
            }
        }
        {
            bf16_t* CB = (bf16_t*)(sc + SC_CB) + (size_t)(cgi * 4 + grp) * 4096;
            const int m = F.wave >> 1;
#pragma unroll
            for (int u = 0; u < 2; ++u) {
                const int st = 2 * (F.wave & 1) + u; f32x4 acc = (f32x4){0.f, 0.f, 0.f, 0.f};
#pragma unroll
                for (int kk = 0; kk < 4; ++kk) {
                    const bf16x8 a = *(const bf16x8*)(Cs + (16 * m + i16) * 136 + 32 * kk + 8 * g4);
                    const bf16x8 b = *(const bf16x8*)(Bs + (16 * st + i16) * 136 + 32 * kk + 8 * g4);
                    acc = __builtin_amdgcn_mfma_f32_16x16x32_bf16(a, b, acc, 0, 0, 0);
                }
                const int qs = qperm(16 * st + i16);
#pragma unroll
                for (int jj = 0; jj < 4; ++jj) { if (!DRY) CB[(16 * m + 4 * g4 + jj) * 64 + qs] = f2bf(acc[jj]); else KEEP(acc[jj]); }
            }
        }
        {
            const int head = grp * 8 + F.wave, t = t0 + F.lane;
            float dt = 0.f;
            if (t >= 0) dt = softplus_f(dtraw + dtbias);
            float cs = dt * negA;
            cs = wave_scan_incl(cs, F.lane);
            const float cs_last = __int_as_float(__builtin_amdgcn_readlane(__float_as_int(cs), 63)), cs_be = __int_as_float(__builtin_amdgcn_ds_bpermute((F.lane | 3) << 2, __float_as_int(cs)));
            float* vp = (float*)(sc + SC_VEC) + (size_t)(cgi * 32 + head) * 256;
            const float v1 = __expf(cs_be - cs) * dt, v2 = dt * __expf(cs_last - cs), v3 = __expf(cs);
            if (!DRY) { vp[F.lane] = cs; vp[64 + F.lane] = v1; vp[128 + F.lane] = v2; vp[192 + F.lane] = v3; } else { KEEP(v1); KEEP(v2); KEEP(v3); }
        }
    }
}

constexpr int SL_C = 0, SL_BT = 16384, SL_M = 32768, SL_XT = 40960, SL_VEC = 49152, SL_SIZE = 50176;
struct SsdLdOff { unsigned o16, xt[2], cs[2][3], vec; };
__device__ __forceinline__ SsdLdOff ssd_ld_offsets(int lt, int xstride) {
    SsdLdOff o; o.o16 = (unsigned)lt * 16u; o.vec = (unsigned)(64 + 4 * (lt < 48 ? lt : 0)) * 4u;
#pragma unroll
    for (int r = 0; r < 2; ++r) { const int k = lt + 256 * r, l = k >> 3, ch = k & 7, sa = 32 * (ch >> 2) + 4 * (ch & 3);
        o.xt[r] = (unsigned)(l * xstride + ch * 8) * 2u; o.cs[r][0] = (unsigned)l * 4u; o.cs[r][1] = (unsigned)(sa + 3) * 4u; o.cs[r][2] = (unsigned)(sa + 19) * 4u; }
    return o;
}
__device__ __forceinline__ void ssd_stage_load(u32x4 (&P)[15], unsigned (&D)[4], const Frame& F, const unsigned char* sc, const SsdLdOff& o, int seq, int head, int c) {
    const int cgi = cgi_of(seq, c), grp = head >> 3;
    const char* Cp = (const char*)(sc + SC_C) + (size_t)(cgi * 4 + grp) * 16384;
    const char* BTp = (const char*)(sc + SC_BT) + (size_t)(cgi * 4 + grp) * 16384;
    const char* CBp = (const char*)(sc + SC_CB) + (size_t)(cgi * 4 + grp) * 8192;
    const char* vp = (const char*)(sc + SC_VEC) + (size_t)(cgi * 32 + head) * 1024;
    const char* xp = (const char*)ssd_xtile(F, seq, c, head).p;
#pragma unroll
    for (int r = 0; r < 4; ++r) { P[r] = *(const u32x4*)(Cp + 4096 * r + o.o16); P[4 + r] = *(const u32x4*)(BTp + 4096 * r + o.o16); }
#pragma unroll
    for (int r = 0; r < 2; ++r) {
        P[8 + r] = *(const u32x4*)(CBp + 4096 * r + o.o16);
        D[r] = *(const unsigned*)(vp + o.cs[r][0]);
        P[13 + r] = *(const u32x4*)(xp + o.xt[r]); }
    D[2] = *(const unsigned*)(vp + o.cs[0][1]); D[3] = *(const unsigned*)(vp + o.cs[0][2]);
    P[10] = *(const u32x4*)(vp + o.vec);
}
__device__ __forceinline__ void ssd_stage_write(const u32x4 (&P)[15], const unsigned (&D)[4], LAS unsigned char* img, int lt) {
#pragma unroll
    for (int r = 0; r < 4; ++r) { const int k = lt + 256 * r;
        { const int row = k >> 4, ch = k & 15; *(LAS u32x4*)(img + SL_C + (row * 16 + (ch ^ (row & 15))) * 16) = P[r]; }
        { const int row = k >> 3, ch = k & 7; *(LAS u32x4*)(img + SL_BT + (row * 8 + (ch ^ ((row >> 1) & 7))) * 16) = P[4 + r]; } }
#pragma unroll
    for (int r = 0; r < 2; ++r) {
        const int k = lt + 256 * r, l = k >> 3, ch = k & 7, sa = 32 * (ch >> 2) + 4 * (ch & 3), sb = sa + 16;
        const float csl = __uint_as_float(D[r]), e1a = __expf(csl - __uint_as_float(D[2])), e1b = __expf(csl - __uint_as_float(D[3]));
        const u32x4 cbw = P[8 + r]; f32x4 va, vb;
        va[0] = (sa + 0 <= l) ? __uint_as_float(cbw.x << 16) * e1a : 0.f; va[1] = (sa + 1 <= l) ? __uint_as_float(cbw.x & 0xffff0000u) * e1a : 0.f;
        va[2] = (sa + 2 <= l) ? __uint_as_float(cbw.y << 16) * e1a : 0.f; va[3] = (sa + 3 <= l) ? __uint_as_float(cbw.y & 0xffff0000u) * e1a : 0.f;
        vb[0] = (sb + 0 <= l) ? __uint_as_float(cbw.z << 16) * e1b : 0.f; vb[1] = (sb + 1 <= l) ? __uint_as_float(cbw.z & 0xffff0000u) * e1b : 0.f;
        vb[2] = (sb + 2 <= l) ? __uint_as_float(cbw.w << 16) * e1b : 0.f; vb[3] = (sb + 3 <= l) ? __uint_as_float(cbw.w & 0xffff0000u) * e1b : 0.f;
        u32x4 w; w.x = cvt_pk_bf16(va[0], va[1]); w.y = cvt_pk_bf16(va[2], va[3]); w.z = cvt_pk_bf16(vb[0], vb[1]); w.w = cvt_pk_bf16(vb[2], vb[3]);
        const int slot = l * 8 + (ch ^ ((l >> 1) & 7));
        *(LAS u32x4*)(img + SL_M + slot * 16) = w;
        *(LAS u32x4*)(img + SL_XT + slot * 16) = P[13 + r];
    }
    if (lt < 48) *(LAS u32x4*)(img + SL_VEC + 16 * lt) = P[10];
}
template <bool DRY>
__device__ __forceinline__ void phase_ssd_chain(const Frame& F0, int j) {
    const Frame F = relaunder(F0);
    const unsigned char* sc = (const unsigned char*)F.out;
    const bool loader = F.wave >= 4; const int lt = F.tid - 256, ps = F.wave & 3;
    for (int sh = F.bid; sh < 512; sh += F.G) {
        int seq, head, seg = 0, c0 = 0, nch = 1;
        if (sh < 256) { const int k = sh >> 3, s_ = ((k >> 3) << 3) | (sh & 7); seq = s_ >> 4; head = ((s_ >> 2) & 3) * 8 + (k & 7); seg = s_ & 3; c0 = SEGL * seg; nch = seg == 3 ? 129 - 3 * SEGL : SEGL; }
        else { seq = 2 + ((sh - 256) >> 5); head = sh & 31; }
        const float dsk = F.inp(13)[j * SSD_HEADS + head];
        __syncthreads();
        if (loader) {
            u32x4 A[15], B[15]; unsigned DA[4], DB[4];
            const SsdLdOff lo = ssd_ld_offsets(lt, ssd_xtile(F, seq, 0, head).stride);
            ssd_stage_load(A, DA, F, sc, lo, seq, head, c0); ssd_stage_write(A, DA, F.ldsl, lt);
            if (nch > 1) ssd_stage_load(B, DB, F, sc, lo, seq, head, c0 + 1);
            if (nch > 2) ssd_stage_load(A, DA, F, sc, lo, seq, head, c0 + 2);
            __syncthreads();
#define SSD_LOADER_STEP(CC, ST, DT) { BUSY_T0(2) const int cc_ = (CC); int nxt = ((cc_ + 1) & 1) * SL_SIZE, lt_ = lt; asm volatile("" : "+s"(nxt), "+v"(lt_)); \
                { BUSY_T0(5) if (cc_ + 1 < nch) ssd_stage_write(ST, DT, F.ldsl + nxt, lt_); BUSY_T1(5, 4) } \
                { BUSY_T0(6) if (cc_ + 3 < nch) ssd_stage_load(ST, DT, F, sc, lo, seq, head, c0 + cc_ + 3); BUSY_T1(6, 4) } \
                BUSY_T1(2, 4) \
                __syncthreads(); }
            for (int c = 0; c < nch; c += 2) {
                SSD_LOADER_STEP(c, B, DB)
                if (c + 1 < nch) SSD_LOADER_STEP(c + 1, A, DA)
            }
#undef SSD_LOADER_STEP
        } else {
            f32x4 HT[8];
#pragma unroll
            for (int m8 = 0; m8 < 8; ++m8) HT[m8] = (f32x4){0.f, 0.f, 0.f, 0.f};
            if (seq >= 2) {
                const int i = F.lane & 15, g = F.lane >> 4;
                const float* st = F.inp(2) + ((((size_t)j * 8 + (seq - 2)) * SSD_HEADS + head) * SSD_P + ps * 16 + i) * SSD_N + 4 * g;
#pragma unroll
                for (int m8 = 0; m8 < 8; ++m8) HT[m8] = *(const f32x4*)(st + 16 * m8);
            }
            __syncthreads();
            for (int c = 0; c < nch; ++c) {
                BUSY_T0(1)
                int cur = (c & 1) * SL_SIZE, lane_ = F.lane;
                asm volatile("" : "+s"(cur), "+v"(lane_));
                LAS unsigned char* img = F.ldsl + cur;
                const int i = lane_ & 15, g = lane_ >> 4, prow = ps * 16 + i, psw = (prow >> 1) & 7;
                const LAS unsigned char* pc[4]; const LAS unsigned char* pm[2];
#pragma unroll
                for (int kk = 0; kk < 4; ++kk) pc[kk] = img + SL_C + i * 256 + (((4 * kk + g) ^ i) * 16);
#pragma unroll
                for (int k2 = 0; k2 < 2; ++k2) pm[k2] = img + i * 128 + (((4 * k2 + g) ^ (i >> 1)) * 16);
                const float ecl = *(const LAS float*)(img + SL_VEC + 512 + 63 * 4);
                bf16x8 Hf[4];
#pragma unroll
                for (int kk = 0; kk < 4; ++kk) Hf[kk] = pack8(HT[2 * kk], HT[2 * kk + 1]);
                f32x4 Y[4];
                bf16x8 fr[2][4]; u32x2 xw[4]; f32x4 yf[4]; bf16x8 xsf[2], xwf[2];
                LAS unsigned char* xrow = img + SL_XT + prow * 128 + 8 * (g & 1);
#define SSB() __builtin_amdgcn_sched_barrier(0)
#define SLD_C(SET, M) { _Pragma("unroll") for (int kk = 0; kk < 4; ++kk) fr[SET][kk] = *(const LAS bf16x8*)(pc[kk] + (M) * 4096); }
#define SLD_M(SET, QH) { _Pragma("unroll") for (int q = 0; q < 2; ++q) { _Pragma("unroll") for (int k2 = 0; k2 < 2; ++k2) fr[SET][2 * q + k2] = *(const LAS bf16x8*)(pm[k2] + SL_M + (2 * (QH) + q) * 2048); } }
#define SLD_B(SET, H) { _Pragma("unroll") for (int q = 0; q < 2; ++q) { _Pragma("unroll") for (int k2 = 0; k2 < 2; ++k2) fr[SET][2 * q + k2] = *(const LAS bf16x8*)(pm[k2] + SL_BT + (2 * (H) + q) * 2048); } }
#define SLD_YF(M) yf[M] = *(const LAS f32x4*)(img + SL_VEC + 512 + (16 * (M) + 4 * g) * 4);
#define SMM_C(SET, M) { f32x4 acc = (f32x4){0.f, 0.f, 0.f, 0.f}; \
                    _Pragma("unroll") for (int kk = 0; kk < 4; ++kk) acc = __builtin_amdgcn_mfma_f32_16x16x32_bf16(fr[SET][kk], Hf[kk], acc, 0, 0, 0); \
                    Y[M] = acc * yf[M]; }
#define SMM_M(SET, QH) { _Pragma("unroll") for (int k2 = 0; k2 < 2; ++k2) { _Pragma("unroll") for (int q = 0; q < 2; ++q) Y[2 * (QH) + q] = __builtin_amdgcn_mfma_f32_16x16x32_bf16(fr[SET][2 * q + k2], xsf[k2], Y[2 * (QH) + q], 0, 0, 0); } }
#define SMM_B(SET, H) { f32x4 ac0 = HT[2 * (H)] * ecl, ac1 = HT[2 * (H) + 1] * ecl; \
                    _Pragma("unroll") for (int k2 = 0; k2 < 2; ++k2) { ac0 = __builtin_amdgcn_mfma_f32_16x16x32_bf16(fr[SET][k2], xwf[k2], ac0, 0, 0, 0); ac1 = __builtin_amdgcn_mfma_f32_16x16x32_bf16(fr[SET][2 + k2], xwf[k2], ac1, 0, 0, 0); } \
                    HT[2 * (H)] = ac0; HT[2 * (H) + 1] = ac1; }
#define SXPREP(K2) { const f32x4 ea = *(const LAS f32x4*)(img + SL_VEC + (32 * (K2) + 4 * g) * 4), eb = *(const LAS f32x4*)(img + SL_VEC + (32 * (K2) + 16 + 4 * g) * 4); \
                    const f32x4 wa = *(const LAS f32x4*)(img + SL_VEC + 256 + (32 * (K2) + 4 * g) * 4), wb = *(const LAS f32x4*)(img + SL_VEC + 256 + (32 * (K2) + 16 + 4 * g) * 4); \
                    f32x4 xa, xb; xa[0] = __uint_as_float(xw[2 * (K2)].x << 16); xa[1] = __uint_as_float(xw[2 * (K2)].x & 0xffff0000u); xa[2] = __uint_as_float(xw[2 * (K2)].y << 16); xa[3] = __uint_as_float(xw[2 * (K2)].y & 0xffff0000u); \
                    xb[0] = __uint_as_float(xw[2 * (K2) + 1].x << 16); xb[1] = __uint_as_float(xw[2 * (K2) + 1].x & 0xffff0000u); xb[2] = __uint_as_float(xw[2 * (K2) + 1].y << 16); xb[3] = __uint_as_float(xw[2 * (K2) + 1].y & 0xffff0000u); \
                    xsf[K2] = pack8(xa * ea, xb * eb); xwf[K2] = pack8(xa * wa, xb * wb); }
                SLD_C(0, 0)
#pragma unroll
                for (int m = 0; m < 4; ++m) xw[m] = *(const LAS u32x2*)(xrow + ((2 * m + (g >> 1)) ^ psw) * 16);
                SLD_YF(0) SSB();
                SLD_C(1, 1) SLD_YF(1) SSB(); SMM_C(0, 0) SSB();
                SXPREP(0) SSB();
                SLD_C(0, 2) SLD_YF(2) SSB(); SMM_C(1, 1) SSB();
                SXPREP(1) SSB();
                SLD_C(1, 3) SLD_YF(3) SSB(); SMM_C(0, 2) SSB();
                SLD_M(0, 0) SSB(); SMM_C(1, 3) SSB();
                SLD_M(1, 1) SSB(); SMM_M(0, 0) SSB();
                SLD_B(0, 0) SSB(); SMM_M(1, 1) SSB();
                SLD_B(1, 1) SSB(); SMM_B(0, 0) SSB();
                SLD_B(0, 2) SSB(); SMM_B(1, 1) SSB();
                SLD_B(1, 3) SSB(); SMM_B(0, 2) SSB();
                SMM_B(1, 3)
#undef SSB
#undef SLD_C
#undef SLD_M
#undef SLD_B
#undef SLD_YF
#undef SMM_C
#undef SMM_M
#undef SMM_B
#undef SXPREP
                {
                    const XTile xt = ssd_xtile(F, seq, c0 + c, head);
                    u32x2 yw[4];
#pragma unroll
                    for (int m = 0; m < 4; ++m) { f32x4 xv; xv[0] = __uint_as_float(xw[m].x << 16); xv[1] = __uint_as_float(xw[m].x & 0xffff0000u); xv[2] = __uint_as_float(xw[m].y << 16); xv[3] = __uint_as_float(xw[m].y & 0xffff0000u);
                        const f32x4 y = Y[m] + xv * dsk; yw[m].x = cvt_pk_bf16(y[0], y[1]); yw[m].y = cvt_pk_bf16(y[2], y[3]); }
#pragma unroll
                    for (int q = 0; q < 2; ++q) {
                        const u32x2 snd = (g & 1) ? yw[2 * q] : yw[2 * q + 1];
                        u32x2 rcv; rcv.x = __shfl_xor(snd.x, 16); rcv.y = __shfl_xor(snd.y, 16);
                        u32x4 w; int l0;
                        if (g & 1) { w.x = rcv.x; w.y = rcv.y; w.z = yw[2 * q + 1].x; w.w = yw[2 * q + 1].y; l0 = 32 * q + 16 + 4 * (g - 1); }
                        else { w.x = yw[2 * q].x; w.y = yw[2 * q].y; w.z = rcv.x; w.w = rcv.y; l0 = 32 * q + 4 * g; }
                        if (!DRY) *(u32x4*)(xt.p + (size_t)prow * xt.stride + l0) = w; else KEEP(w);
                    }
                }
                BUSY_T1(1, 0)
                __syncthreads();
            }
            const int i = F.lane & 15, g = F.lane >> 4;
            float* so = (seq < 2) ? (float*)((unsigned char*)F.out + SC_HSEG) + ((size_t)((seq * 32 + head) * 4 + seg) * SSD_P + ps * 16 + i) * SSD_N + 4 * g
                                  : F.out + O_SSSD + ((((size_t)j * 8 + (seq - 2)) * SSD_HEADS + head) * SSD_P + ps * 16 + i) * SSD_N + 4 * g;
#pragma unroll
            for (int m8 = 0; m8 < 8; ++m8) { if (!DRY) *(f32x4*)(so + 16 * m8) = HT[m8]; else KEEP(HT[m8]); }
        }
    }
}


__device__ __forceinline__ void phase_ssd_combine(const Frame& F0, int j) {
    const Frame F = relaunder(F0);
    unsigned char* sc = (unsigned char*)F.out;
    float* dlog = (float*)F.lds;
    for (int t = F.bid; t < 64; t += F.G) {
        const int seq = t >> 5, head = t & 31;
        __syncthreads();
        if (F.wave < 4) {
            const int seg = F.wave, c0 = SEGL * seg, n = seg == 3 ? 129 - 3 * SEGL : SEGL;
            const int cgi = cgi_of(seq, c0 + (F.lane < n ? F.lane : 0));
            const float v = (F.lane < n) ? ((const float*)(sc + SC_VEC))[(size_t)(cgi * 32 + head) * 256 + 63] : 0.f;
            float inc = v;
            inc = wave_scan_incl(inc, F.lane);
            if (F.lane < n) ((float*)(sc + SC_CUM))[cgi * 32 + head] = inc - v;
            if (F.lane == 63) dlog[seg] = inc;
        }
        __syncthreads();
        const float D1 = __expf(dlog[1]), D2 = __expf(dlog[2]), D3 = __expf(dlog[3]);
        float* H = (float*)(sc + SC_HSEG) + (size_t)((seq * 32 + head) * 4) * 8192 + F.tid * 16;
        float* po = F.out + O_PSSD + (((size_t)j * 2 + seq) * SSD_HEADS + head) * 8192 + F.tid * 16;
#pragma unroll
        for (int q = 0; q < 4; ++q) {
            const f32x4 h1 = *(const f32x4*)(H + 4 * q), H1 = *(const f32x4*)(H + 8192 + 4 * q), H2 = *(const f32x4*)(H + 2 * 8192 + 4 * q), H3 = *(const f32x4*)(H + 3 * 8192 + 4 * q);
            const f32x4 h2 = h1 * D1 + H1, h3 = h2 * D2 + H2, fin = h3 * D3 + H3;
            *(f32x4*)(H + 8192 + 4 * q) = h2; *(f32x4*)(H + 2 * 8192 + 4 * q) = h3; *(f32x4*)(po + 4 * q) = fin;
            bf16_t* hb16 = (bf16_t*)(sc + SC_HB16) + (size_t)((seq * 32 + head) * 3) * 8192 + (F.tid >> 3) * 128 + 32 * ((F.tid & 7) >> 1) + 8 * q + 4 * (F.tid & 1);
            u32x2 w; w.x = cvt_pk_bf16(h1[0], h1[1]); w.y = cvt_pk_bf16(h1[2], h1[3]); *(u32x2*)hb16 = w;
            w.x = cvt_pk_bf16(h2[0], h2[1]); w.y = cvt_pk_bf16(h2[2], h2[3]); *(u32x2*)(hb16 + 8192) = w;
            w.x = cvt_pk_bf16(h3[0], h3[1]); w.y = cvt_pk_bf16(h3[2], h3[3]); *(u32x2*)(hb16 + 2 * 8192) = w;
        }
    }
}

template <bool DRY>
__device__ __forceinline__ void phase_ssd_post(const Frame& F0, int j) {
    const Frame F = relaunder(F0);
    constexpr int RL = 524;
    bf16_t* YL = (bf16_t*)F.lds;
    for (int task = F.bid; task < NCHT * 4; task += F.G) {
        const int cgi = task >> 2, grp = task & 3; int seq, c; chunk_of(cgi, seq, c);
        const int base = seq_base(seq), t0 = 64 * c - PADF;
        u32x4 zr[8];
#pragma unroll
        for (int q = 0; q < 8; ++q) { const int l = F.wave + 8 * q, t = t0 + l; const int row = seq < 2 ? seq * TPP + 64 * c + l : base + (t > 0 ? t : 0);
            zr[q] = *(const u32x4*)(F.proj + (size_t)row * LDP + grp * 512 + 8 * F.lane); }
        __syncthreads();
#pragma unroll
        for (int r = 0; r < 8; ++r) {
            const int k = F.tid + 512 * r, hl = k >> 9, p = (k >> 3) & 63, ch = k & 7;
            const XTile xt = ssd_xtile(F, seq, c, grp * 8 + hl);
            const u32x4 w = *(const u32x4*)(xt.p + (size_t)p * xt.stride + ch * 8);
            bf16_t* d = YL + (8 * ch) * RL + ((hl * 64 + p) ^ (8 * ((ch >> 1) & 3)));
            d[0] = (bf16_t)w.x; d[RL] = (bf16_t)(w.x >> 16); d[2 * RL] = (bf16_t)w.y; d[3 * RL] = (bf16_t)(w.y >> 16);
            d[4 * RL] = (bf16_t)w.z; d[5 * RL] = (bf16_t)(w.z >> 16); d[6 * RL] = (bf16_t)w.w; d[7 * RL] = (bf16_t)(w.w >> 16);
        }
        const bool corr = seq < 2 && c >= SEGL;
        if (corr) {
            const unsigned char* sc = (const unsigned char*)F.out;
            const int head = grp * 8 + F.wave, seg = c / SEGL, i = F.lane & 15, g = F.lane >> 4;
            const bf16_t* hk = (const bf16_t*)(sc + SC_HB16) + (size_t)((seq * 32 + head) * 3 + (seg - 1)) * 8192;
            const bf16_t* Cp = (const bf16_t*)(sc + SC_C) + (size_t)(cgi * 4 + grp) * 8192;
            const float* vp = (const float*)(sc + SC_VEC) + (size_t)(cgi * 32 + head) * 256;
            const float cum = ((const float*)(sc + SC_CUM))[cgi * 32 + head];
            bf16_t* CL = YL + 64 * RL;
            bf16x8 cf[4][4];
#pragma unroll
            for (int lt = 0; lt < 4; ++lt)
#pragma unroll
                for (int kk = 0; kk < 4; ++kk) cf[lt][kk] = *(const bf16x8*)(Cp + (16 * lt + i) * 128 + 32 * kk + 8 * g);
            f32x4 fac[4];
#pragma unroll
            for (int lt = 0; lt < 4; ++lt) { const f32x4 cs = *(const f32x4*)(vp + 16 * lt + 4 * g); fac[lt][0] = __expf(cum + cs[0]); fac[lt][1] = __expf(cum + cs[1]); fac[lt][2] = __expf(cum + cs[2]); fac[lt][3] = __expf(cum + cs[3]); }
#pragma unroll
            for (int pt = 0; pt < 4; ++pt) {
                bf16x8 hf[4];
#pragma unroll
                for (int kk = 0; kk < 4; ++kk) hf[kk] = *(const bf16x8*)(hk + (16 * pt + i) * 128 + 32 * kk + 8 * g);
#pragma unroll
                for (int lt = 0; lt < 4; ++lt) {
                    f32x4 acc = (f32x4){0.f, 0.f, 0.f, 0.f};
#pragma unroll
                    for (int kk = 0; kk < 4; ++kk) acc = __builtin_amdgcn_mfma_f32_16x16x32_bf16(cf[lt][kk], hf[kk], acc, 0, 0, 0);
#pragma unroll
                    for (int jj = 0; jj < 4; ++jj) CL[(16 * lt + 4 * g + jj) * RL + F.wave * 64 + 16 * pt + i] = f2bf(acc[jj] * fac[lt][jj]);
                }
            }
        }
        __syncthreads();
#pragma unroll
        for (int q = 0; q < 8; ++q) {
            const int l = F.wave + 8 * q, t = t0 + l;
            if (t < 0 && seq >= 2) continue;
            const int row = seq < 2 ? seq * TPP + 64 * c + l : base + t;
            const int ysw = (8 * F.lane) ^ (8 * ((l >> 4) & 3));
            const u32x2 y0 = *(const u32x2*)(YL + l * RL + ysw), y1 = *(const u32x2*)(YL + l * RL + ysw + 4);
            u32x2 c0_ = (u32x2){0u, 0u}, c1_ = c0_;
            if (corr) { c0_ = *(const u32x2*)(YL + (64 + l) * RL + 8 * F.lane); c1_ = *(const u32x2*)(YL + (64 + l) * RL + 8 * F.lane + 4); }
            const unsigned yw[4] = {y0.x, y0.y, y1.x, y1.y}; const unsigned cw[4] = {c0_.x, c0_.y, c1_.x, c1_.y}; const unsigned zw[4] = {zr[q].x, zr[q].y, zr[q].z, zr[q].w};
            float yg[8]; float ss = 0.f;
#pragma unroll
            for (int e = 0; e < 4; ++e) {
                yg[2 * e] = (__uint_as_float(yw[e] << 16) + __uint_as_float(cw[e] << 16)) * silu_f(__uint_as_float(zw[e] << 16)); yg[2 * e + 1] = (__uint_as_float(yw[e] & 0xffff0000u) + __uint_as_float(cw[e] & 0xffff0000u)) * silu_f(__uint_as_float(zw[e] & 0xffff0000u));
                ss += yg[2 * e] * yg[2 * e] + yg[2 * e + 1] * yg[2 * e + 1]; }
            ss = wave_sum(ss);
            const float rs = rsqrtf(ss * (1.0f / 512.0f) + EPS);
            u32x4 w; w.x = cvt_pk_bf16(yg[0] * rs, yg[1] * rs); w.y = cvt_pk_bf16(yg[2] * rs, yg[3] * rs); w.z = cvt_pk_bf16(yg[4] * rs, yg[5] * rs); w.w = cvt_pk_bf16(yg[6] * rs, yg[7] * rs);
            if (!DRY) *(u32x4*)(F.proj + (size_t)row * LDP + grp * 512 + 8 * F.lane) = w; else KEEP(w);
        }
    }
    for (int e = F.bid * NTHREADS + F.tid; e < NSEQ * 3 * SSD_CONV; e += F.G * NTHREADS) {
        const int s = e / (3 * SSD_CONV), r = (e / SSD_CONV) % 3, c = e % SSD_CONV;
        const int row = seq_base(s) + seq_len(s) - 3 + r;
        float v;
        if (s < 2 && c < 2048) v = bf2f(F.tails[((size_t)(s * 129 + 128) * 3 + r) * 4096 + c]);
        else v = bf2f(F.proj[(size_t)row * LDP + 2048 + c]);
        if (s < 2) F.out[O_PSSDC + (((size_t)j * 2 + s) * 3 + r) * SSD_CONV + c] = v;
        else F.out[O_SSSDC + (((size_t)j * 8 + (s - 2)) * 3 + r) * SSD_CONV + c] = v;
    }
}

constexpr size_t SG_W = 0;
constexpr size_t SG_QK = SG_W + (size_t)NCHT * 8 * 16384;
constexpr size_t SG_VEC = SG_QK + (size_t)NCHT * 8 * 8192;
constexpr size_t SG_SIDE = SG_VEC + (size_t)NCHT * 8 * 1024;
constexpr size_t SG_END = SG_SIDE + (size_t)64 * 65536;
static_assert(SG_END <= (size_t)16777216 * 4, "scratch must fit the y_prompt region");
struct GTile { bf16_t* q; bf16_t* k; bf16_t* v; int sq, sk, sv; };
__device__ __forceinline__ GTile gdn_tile(const Frame& F, int seq, int c, int head) {
    GTile t;
    if (seq < 2) { bf16_t* r0 = F.proj + (size_t)(seq * TPP + 64 * c) * LDP; t.q = r0 + head * 128; t.k = r0 + 1024 + head * 128; t.v = r0 + 2048 + head * 256; t.sq = LDP; t.sk = LDP; t.sv = LDP; }
    else { bf16_t* b = (bf16_t*)((unsigned char*)F.out + SG_SIDE) + (size_t)((seq - 2) * 8 + head) * 32768; t.q = b; t.k = b + 8192; t.v = b + 16384; t.sq = 128; t.sk = 128; t.sv = 256; }
    return t;
}

__device__ __forceinline__ void gdn_raw_load(unsigned short (&raw)[64], const Frame& F, int task) {
    const int cgi = task >> 3, head = task & 7; int seq, c; chunk_of(cgi, seq, c);
    const int base = seq_base(seq), t0 = 64 * c - PADF;
    const int cch = F.tid < 128 ? head * 128 + F.tid : (F.tid < 256 ? 1024 + head * 128 + (F.tid - 128) : 2048 + head * 256 + (F.tid - 256));
    const bf16_t* col = F.proj + cch;
#pragma unroll
    for (int e = 0; e < 64; ++e) { const int t = t0 + e; raw[e] = col[(size_t)(base + (t > 0 ? t : 0)) * LDP]; }
}
__device__ __forceinline__ void gdn_aux_load(float (&aux)[5], const Frame& F, int j, int task) {
    const int cgi = task >> 3, head = task & 7; int seq, c; chunk_of(cgi, seq, c);
    const int cidx = F.tid < 128 ? head * 128 + F.tid : (F.tid < 256 ? 1024 + head * 128 + (F.tid - 128) : 2048 + head * 256 + (F.tid - 256));
    aux[0] = 0.f; aux[1] = 0.f; aux[2] = 0.f; aux[3] = 0.f; aux[4] = 0.f;
    if (seq < 2 && c > 0) { const bf16_t* tailp = F.tails + (size_t)(cgi - 1) * 3 * 4096 + cidx; aux[0] = bf2f(tailp[0]); aux[1] = bf2f(tailp[4096]); aux[2] = bf2f(tailp[2 * 4096]); }
    else if (seq >= 2) { const float* cst = F.inp(5) + (((size_t)j * 8 + (seq - 2)) * 3) * GDN_CONV + cidx; aux[0] = cst[0]; aux[1] = cst[GDN_CONV]; aux[2] = cst[2 * GDN_CONV]; }
    if (F.wave == 0) { const int t = 64 * c - PADF + F.lane; if (t >= 0) { const float* dp = F.dtb + (size_t)(seq_base(seq) + t) * 32; aux[3] = dp[head]; aux[4] = dp[8 + head]; } }
}
template <bool DRY>
__device__ __forceinline__ void phase_gdn_prep(const Frame& F0, int j) {
    const Frame F = relaunder(F0);
    unsigned long long bz_t0 = 0ull;
    float* Am = (float*)F.lds;
    float* vgc = Am + 64 * 68;
    float* vbe = vgc + 64;
    float* vnq = vbe + 64;
    float* vnk = vnq + 64;
    bf16_t* qs = (bf16_t*)(vnk + 64);
    bf16_t* ks = qs + 64 * 136;
    bf16_t* kT = ks + 64 * 136;
    bf16_t* vT = kT + 128 * 72;
    bf16_t* Tb = vT + 256 * 72;
    bf16_t* TT = Tb + 2 * 64 * 72;
    bf16_t* TD = TT + 64 * 72;
    bf16_t* YT = TD + 2 * 4 * 16 * 24;
    unsigned char* sc = (unsigned char*)F.out;
    const float* conv_w = F.inp(18) + (size_t)j * 4 * GDN_CONV;
    const int i16 = F.lane & 15, g4 = F.lane >> 4;
    constexpr float CQ = 0.08838834764831845f;
    unsigned short raw[64]; float aux[5];
    if (F.bid < NCHT * 8) { gdn_raw_load(raw, F, F.bid); gdn_aux_load(aux, F, j, F.bid); }
    asm volatile("" :: "v"((unsigned)raw[0]), "v"((unsigned)raw[63]), "v"(aux[0]), "v"(aux[1]), "v"(aux[2]), "v"(aux[3]), "v"(aux[4]));
    int whead = -1; float w0 = 0.f, w1 = 0.f, w2 = 0.f, w3 = 0.f, negA = 0.f, dtbias = 0.f;
    for (int task = F.bid; task < NCHT * 8; task += F.G) {
        const int cgi = task >> 3, head = task & 7; int seq, c; chunk_of(cgi, seq, c);
        const int t0 = 64 * c - PADF;
        const GTile tl = gdn_tile(F, seq, c, head);
        if (head != whead) {
            whead = head;
            const int cidx = F.tid < 128 ? head * 128 + F.tid : (F.tid < 256 ? 1024 + head * 128 + (F.tid - 128) : 2048 + head * 256 + (F.tid - 256));
            w0 = conv_w[cidx]; w1 = conv_w[GDN_CONV + cidx]; w2 = conv_w[2 * GDN_CONV + cidx]; w3 = conv_w[3 * GDN_CONV + cidx];
            negA = -__expf(F.inp(20)[j * GDN_HEADS + head]); dtbias = F.inp(19)[j * GDN_HEADS + head];
            asm volatile("" :: "v"(w0), "v"(w1), "v"(w2), "v"(w3), "v"(negA), "v"(dtbias));
        }
        __syncthreads();
        BUSY_T1(10, 0) BUSY_T0B(7)
        for (int q = F.tid; q < (3 * 64 * 72 + 64 * 24) / 8; q += NTHREADS) { bf16_t* z0 = (q < 3 * 64 * 72 / 8) ? Tb + 8 * q : YT + 8 * (q - 3 * 64 * 72 / 8); *(u32x4*)z0 = (u32x4){0u, 0u, 0u, 0u}; }
        if (F.wave == 0) {
            const int t = t0 + F.lane; float gg = 0.f, be = 0.f;
            if (t >= 0) { gg = negA * softplus_f(aux[3] + dtbias); be = 1.0f / (1.0f + __expf(-aux[4])); }
            gg = wave_scan_incl(gg, F.lane);
            vgc[F.lane] = gg; vbe[F.lane] = be;
        }
        __syncthreads();
        {
            const int ch = F.tid;
            float r3 = aux[0], r2 = aux[1], r1 = aux[2];
#define GCONV(KIND, ALLPOS) { _Pragma("unroll") for (int e8 = 0; e8 < 8; ++e8) { float o[8]; \
                _Pragma("unroll") for (int h = 0; h < 8; ++h) { \
                    const int p = 8 * e8 + h, t = t0 + p; \
                    const float x = ((ALLPOS) || t >= 0) ? bf2f(raw[p]) : 0.f; \
                    o[h] = silu_f(w0 * r3 + w1 * r2 + w2 * r1 + w3 * x); \
                    if ((ALLPOS) || t >= 0) { r3 = r2; r2 = r1; r1 = x; } \
                    if ((KIND) == 0) qs[p * 136 + ch] = f2bf(o[h]); \
                    else if ((KIND) == 1) ks[p * 136 + (ch - 128)] = f2bf(o[h]); \
                    else o[h] *= vbe[p]; } \
                  \
                if ((KIND) != 0) { u32x4 w; w.x = cvt_pk_bf16(o[0], o[1]); w.y = cvt_pk_bf16(o[2], o[3]); w.z = cvt_pk_bf16(o[4], o[5]); w.w = cvt_pk_bf16(o[6], o[7]); \
                    bf16_t* d = ((KIND) == 1 ? kT + (ch - 128) * 72 : vT + (ch - 256) * 72) + 8 * e8; *(u32x4*)d = w; } } }
            if (t0 >= 0) { if (F.wave < 2) GCONV(0, true) else if (F.wave < 4) GCONV(1, true) else GCONV(2, true) }
            else { if (F.wave < 2) GCONV(0, false) else if (F.wave < 4) GCONV(1, false) else GCONV(2, false) }
#undef GCONV
        }
        if (task + F.G < NCHT * 8) { gdn_raw_load(raw, F, task + F.G); gdn_aux_load(aux, F, j, task + F.G); }
        __syncthreads();
        BUSY_T1(7, 0) BUSY_T0B(8)
        if (F.tid < 128) {
            const int l = F.tid & 63; const bf16_t* rowp = (F.tid < 64 ? qs : ks) + l * 136; float ss = 0.f;
#pragma unroll
            for (int q = 0; q < 16; ++q) { const u32x4 v = *(const u32x4*)(rowp + 8 * q);
                const float a0 = __uint_as_float(v.x << 16), a1 = __uint_as_float(v.x & 0xffff0000u), a2 = __uint_as_float(v.y << 16), a3 = __uint_as_float(v.y & 0xffff0000u);
                const float a4 = __uint_as_float(v.z << 16), a5 = __uint_as_float(v.z & 0xffff0000u), a6 = __uint_as_float(v.w << 16), a7 = __uint_as_float(v.w & 0xffff0000u);
                ss += ((a0 * a0 + a1 * a1) + (a2 * a2 + a3 * a3)) + ((a4 * a4 + a5 * a5) + (a6 * a6 + a7 * a7)); }
            (F.tid < 64 ? vnq : vnk)[l] = rsqrtf(ss + EPS);
        }
        __syncthreads();
        {
            bf16_t* QKg = (bf16_t*)(sc + SG_QK) + (size_t)task * 4096;
            const int m = F.wave >> 1;
            bf16x8 ak[4], aq[4], bb[2][4];
#pragma unroll
            for (int kk = 0; kk < 4; ++kk) {
                ak[kk] = *(const bf16x8*)(ks + (16 * m + i16) * 136 + 32 * kk + 8 * g4);
                aq[kk] = *(const bf16x8*)(qs + (16 * m + i16) * 136 + 32 * kk + 8 * g4);
#pragma unroll
                for (int u = 0; u < 2; ++u) bb[u][kk] = *(const bf16x8*)(ks + (16 * (2 * (F.wave & 1) + u) + i16) * 136 + 32 * kk + 8 * g4);
            }
            const f32x4 gl4 = *(const f32x4*)(vgc + 16 * m + 4 * g4), be4 = *(const f32x4*)(vbe + 16 * m + 4 * g4), nk4 = *(const f32x4*)(vnk + 16 * m + 4 * g4), nq4 = *(const f32x4*)(vnq + 16 * m + 4 * g4);
            float gs2[2], nks2[2];
#pragma unroll
            for (int u = 0; u < 2; ++u) { const int s_ = 16 * (2 * (F.wave & 1) + u) + i16; gs2[u] = vgc[s_]; nks2[u] = vnk[s_]; }
            __builtin_amdgcn_sched_barrier(0);
#pragma unroll
            for (int u = 0; u < 2; ++u) {
                const int st = 2 * (F.wave & 1) + u; f32x4 aK = (f32x4){0.f, 0.f, 0.f, 0.f}, aQ = (f32x4){0.f, 0.f, 0.f, 0.f};
#pragma unroll
                for (int kk = 0; kk < 4; ++kk) {
                    aK = __builtin_amdgcn_mfma_f32_16x16x32_bf16(ak[kk], bb[u][kk], aK, 0, 0, 0);
                    aQ = __builtin_amdgcn_mfma_f32_16x16x32_bf16(aq[kk], bb[u][kk], aQ, 0, 0, 0);
                }
                const int s_ = 16 * st + i16; const float gs = gs2[u], nks = nks2[u]; const int qs_ = qperm(s_);
#pragma unroll
                for (int jj = 0; jj < 4; ++jj) {
                    const int l = 16 * m + 4 * g4 + jj;
                    const float e = __expf(gl4[jj] - gs);
                    const float dec = (s_ <= l) ? e : 0.f;
                    const float av = be4[jj] * nk4[jj] * nks * aK[jj] * dec;
                    Am[l * 68 + s_] = (s_ < l) ? av : 0.f;
                    { const float r = CQ * nq4[jj] * nks * aQ[jj] * dec; if (!DRY) QKg[l * 64 + qs_] = f2bf(r); else KEEP(r); }
                }
            }
        }
        __syncthreads();
        BUSY_T1(8, 0) BUSY_T0B(9)
        if (F.wave == 0) for (int rep = 0; rep < REP_SUBST; ++rep) {
            int ln = F.lane; asm volatile("" : "+v"(ln));
            const int i = ln & 15, g = ln >> 4;
            {   const int b = g, cc = i; float x[16];
#pragma unroll
                for (int r = 0; r < 16; ++r) {
                    float a0 = (r == cc) ? 1.f : 0.f, a1 = 0.f;
#pragma unroll
                    for (int s2 = 0; s2 < r; ++s2) { const float av = Am[(16 * b + r) * 68 + 16 * b + s2]; if (s2 & 1) a1 -= av * x[s2]; else a0 -= av * x[s2]; }
                    x[r] = a0 + a1;
                }
                const int cg = 16 * b + cc; const float csc = vbe[cg] * __expf(vgc[cg]) * vnk[cg];
#pragma unroll
                for (int r = 0; r < 16; ++r) {
                    const bf16_t hi = f2bf(x[r]); const int lg = 16 * b + r;
                    Tb[lg * 72 + cg] = hi; Tb[64 * 72 + lg * 72 + cg] = f2bf(x[r] * csc); TT[cg * 72 + lg] = hi;
                    TD[(b * 16 + r) * 24 + cc] = hi; TD[4 * 16 * 24 + (b * 16 + r) * 24 + cc] = f2bf(x[r] - bf2f(hi));
                }
            }
#pragma unroll
            for (int bi = 1; bi < 4; ++bi) {
#pragma unroll
                for (int nt = 0; nt < bi; ++nt) {
                    f32x4 acc = (f32x4){0.f, 0.f, 0.f, 0.f};
#pragma unroll
                    for (int ks = 0; ks < (16 * bi + 31) / 32; ++ks) {
                        const int k0 = 32 * ks + 8 * g;
                        f32x4 alo4 = (f32x4){0.f, 0.f, 0.f, 0.f}, ahi4 = (f32x4){0.f, 0.f, 0.f, 0.f};
                        if (k0 < 16 * bi) { alo4 = *(const f32x4*)(Am + (16 * bi + i) * 68 + k0); ahi4 = *(const f32x4*)(Am + (16 * bi + i) * 68 + k0 + 4); }
                        const bf16x8 ah = pack8(alo4, ahi4);
                        const u32x4 ahw = __builtin_bit_cast(u32x4, ah);
                        f32x4 r0, r1;
                        r0[0] = alo4[0] - __uint_as_float(ahw.x << 16); r0[1] = alo4[1] - __uint_as_float(ahw.x & 0xffff0000u); r0[2] = alo4[2] - __uint_as_float(ahw.y << 16); r0[3] = alo4[3] - __uint_as_float(ahw.y & 0xffff0000u);
                        r1[0] = ahi4[0] - __uint_as_float(ahw.z << 16); r1[1] = ahi4[1] - __uint_as_float(ahw.z & 0xffff0000u); r1[2] = ahi4[2] - __uint_as_float(ahw.w << 16); r1[3] = ahi4[3] - __uint_as_float(ahw.w & 0xffff0000u);
                        const bf16x8 al = pack8(r0, r1);
                        const bf16x8 bt = *(const bf16x8*)(TT + (16 * nt + i) * 72 + k0);
                        acc = __builtin_amdgcn_mfma_f32_16x16x32_bf16(ah, bt, acc, 0, 0, 0);
                        acc = __builtin_amdgcn_mfma_f32_16x16x32_bf16(al, bt, acc, 0, 0, 0);
                    }
                    u32x2 w; w.x = cvt_pk_bf16(acc[0], acc[1]); w.y = cvt_pk_bf16(acc[2], acc[3]);
                    *(u32x2*)(YT + (16 * nt + i) * 24 + 4 * g) = w;
                }
                bf16x8 th = __builtin_bit_cast(bf16x8, (u32x4){0u, 0u, 0u, 0u}), tlo = th;
                if (g < 2) { th = *(const bf16x8*)(TD + (bi * 16 + i) * 24 + 8 * g); tlo = *(const bf16x8*)(TD + 4 * 16 * 24 + (bi * 16 + i) * 24 + 8 * g); }
#pragma unroll
                for (int nt = 0; nt < bi; ++nt) {
                    bf16x8 yb = __builtin_bit_cast(bf16x8, (u32x4){0u, 0u, 0u, 0u});
                    if (g < 2) yb = *(const bf16x8*)(YT + (16 * nt + i) * 24 + 8 * g);
                    f32x4 acc = (f32x4){0.f, 0.f, 0.f, 0.f};
                    acc = __builtin_amdgcn_mfma_f32_16x16x32_bf16(th, yb, acc, 0, 0, 0);
                    acc = __builtin_amdgcn_mfma_f32_16x16x32_bf16(tlo, yb, acc, 0, 0, 0);
                    const int cg = 16 * nt + i; const float csc = vbe[cg] * __expf(vgc[cg]) * vnk[cg];
                    u32x2 w; w.x = cvt_pk_bf16(-acc[0], -acc[1]); w.y = cvt_pk_bf16(-acc[2], -acc[3]);
                    *(u32x2*)(TT + cg * 72 + 16 * bi + 4 * g) = w;
#pragma unroll
                    for (int jj = 0; jj < 4; ++jj) { const int lg = 16 * bi + 4 * g + jj; Tb[lg * 72 + cg] = f2bf(-acc[jj]); Tb[64 * 72 + lg * 72 + cg] = f2bf(-acc[jj] * csc); }
                }
            }
        } else {
            const int t7 = F.tid - 64;
            const float gl_ = vgc[63];
            for (int idx = t7; idx < 1024; idx += 448) {
                const int l = idx >> 4, qg8 = idx & 15, kk = qg8 >> 2, gg = qg8 & 3;
                const u32x2 a = *(const u32x2*)(qs + l * 136 + 32 * kk + 4 * gg), b = *(const u32x2*)(qs + l * 136 + 32 * kk + 16 + 4 * gg);
                const float sc_ = __expf(vgc[l]) * CQ * vnq[l];
                u32x4 w; w.x = cvt_pk_bf16(__uint_as_float(a.x << 16) * sc_, __uint_as_float(a.x & 0xffff0000u) * sc_); w.y = cvt_pk_bf16(__uint_as_float(a.y << 16) * sc_, __uint_as_float(a.y & 0xffff0000u) * sc_);
                w.z = cvt_pk_bf16(__uint_as_float(b.x << 16) * sc_, __uint_as_float(b.x & 0xffff0000u) * sc_); w.w = cvt_pk_bf16(__uint_as_float(b.y << 16) * sc_, __uint_as_float(b.y & 0xffff0000u) * sc_);
                if (!DRY) *(u32x4*)(tl.q + (size_t)l * tl.sq + 8 * qg8) = w; else KEEP(w);
            }
            for (int idx = t7; idx < 1024; idx += 448) {
                const int kd = idx >> 3, pg = idx & 7, kk2 = pg >> 2, gg = pg & 3, la = 32 * kk2 + 4 * gg, lb = la + 16;
                const u32x2 a = *(const u32x2*)(kT + kd * 72 + la), b = *(const u32x2*)(kT + kd * 72 + lb);
                const f32x4 ga = *(const f32x4*)(vgc + la), gb = *(const f32x4*)(vgc + lb), na = *(const f32x4*)(vnk + la), nb = *(const f32x4*)(vnk + lb);
                u32x4 w;
                w.x = cvt_pk_bf16(__uint_as_float(a.x << 16) * na[0] * __expf(gl_ - ga[0]), __uint_as_float(a.x & 0xffff0000u) * na[1] * __expf(gl_ - ga[1]));
                w.y = cvt_pk_bf16(__uint_as_float(a.y << 16) * na[2] * __expf(gl_ - ga[2]), __uint_as_float(a.y & 0xffff0000u) * na[3] * __expf(gl_ - ga[3]));
                w.z = cvt_pk_bf16(__uint_as_float(b.x << 16) * nb[0] * __expf(gl_ - gb[0]), __uint_as_float(b.x & 0xffff0000u) * nb[1] * __expf(gl_ - gb[1]));
                w.w = cvt_pk_bf16(__uint_as_float(b.y << 16) * nb[2] * __expf(gl_ - gb[2]), __uint_as_float(b.y & 0xffff0000u) * nb[3] * __expf(gl_ - gb[3]));
                if (!DRY) *(u32x4*)(tl.k + (size_t)(kd >> 1) * tl.sk + (kd & 1) * 64 + 8 * pg) = w; else KEEP(w);
            }
            if (t7 < 64) {
                float* vp = (float*)(sc + SG_VEC) + (size_t)task * 256; const float gl = vgc[63];
                const float v0 = __expf(vgc[t7]) * CQ * vnq[t7], v1 = vnk[t7] * __expf(gl - vgc[t7]), v2 = __expf(gl);
                if (!DRY) { vp[t7] = v0; vp[64 + t7] = v1; vp[128 + t7] = v2; vp[192 + t7] = 0.f; } else { KEEP(v0); KEEP(v1); KEEP(v2); }
            }
        }
        __syncthreads();
        BUSY_T1(9, 0) BUSY_T0B(10)
        {
            bf16_t* Wg = (bf16_t*)(sc + SG_W) + (size_t)task * 8192;
            bf16x8 bk[2];
#pragma unroll
            for (int k2 = 0; k2 < 2; ++k2) bk[k2] = *(const bf16x8*)(kT + (16 * F.wave + i16) * 72 + 32 * k2 + 8 * g4);
            const int qkd = qperm(16 * F.wave + i16);
#pragma unroll
            for (int m = 0; m < 4; ++m) {
                f32x4 acc = (f32x4){0.f, 0.f, 0.f, 0.f};
#pragma unroll
                for (int k2 = 0; k2 < 2; ++k2) { const bf16x8 a = *(const bf16x8*)(Tb + 64 * 72 + (16 * m + i16) * 72 + 32 * k2 + 8 * g4); acc = __builtin_amdgcn_mfma_f32_16x16x32_bf16(a, bk[k2], acc, 0, 0, 0); }
#pragma unroll
                for (int jj = 0; jj < 4; ++jj) { if (!DRY) Wg[(16 * m + 4 * g4 + jj) * 128 + qkd] = f2bf(-acc[jj]); else KEEP(acc[jj]); }
            }
#pragma unroll
            for (int u = 0; u < 2; ++u) {
                const int v = 16 * (2 * F.wave + u) + i16;
                bf16x8 bv[2];
#pragma unroll
                for (int k2 = 0; k2 < 2; ++k2) bv[k2] = *(const bf16x8*)(vT + v * 72 + 32 * k2 + 8 * g4);
#pragma unroll
                for (int m = 0; m < 4; ++m) {
                    f32x4 acc = (f32x4){0.f, 0.f, 0.f, 0.f};
#pragma unroll
                    for (int k2 = 0; k2 < 2; ++k2) { const bf16x8 a = *(const bf16x8*)(Tb + (16 * m + i16) * 72 + 32 * k2 + 8 * g4); acc = __builtin_amdgcn_mfma_f32_16x16x32_bf16(a, bv[k2], acc, 0, 0, 0); }
                    u32x2 w; w.x = cvt_pk_bf16(acc[0], acc[1]); w.y = cvt_pk_bf16(acc[2], acc[3]);
                    if (!DRY) *(u32x2*)(tl.v + (size_t)(v >> 2) * tl.sv + (v & 3) * 64 + 16 * m + 4 * g4) = w; else KEEP(w);
                }
            }
        }
    }
}

constexpr int GL_W = 0, GL_Q = 16384, GL_KT = 32768, GL_QK = 49152, GL_U = 57344, GL_VEC = 65536, GL_SIZE = 66560;
__device__ __forceinline__ bf16_t* gdn_urow(const GTile& tl, int v) { return tl.v + (size_t)(v >> 2) * tl.sv + (v & 3) * 64; }
struct GdnLdOff { unsigned o16, q, k, u, vec; };
__device__ __forceinline__ GdnLdOff gdn_ld_offsets(int lt, const GTile& tl) {
    GdnLdOff o; o.o16 = (unsigned)lt * 16u; o.vec = (unsigned)(lt < 48 ? lt : 0) * 16u;
    o.q = (unsigned)((lt >> 4) * tl.sq + (lt & 15) * 8) * 2u;
    o.k = (unsigned)((lt >> 4) * tl.sk + ((lt >> 3) & 1) * 64 + (lt & 7) * 8) * 2u;
    o.u = (unsigned)((lt >> 5) * tl.sv + ((lt >> 3) & 3) * 64 + (lt & 7) * 8) * 2u;
    return o;
}
__device__ __forceinline__ void gdn_stage_load(u32x4 (&P)[17], const Frame& F, const unsigned char* sc, const GdnLdOff& o, int seq, int head, int vq, int c) {
    const int task = cgi_of(seq, c) * 8 + head;
    const GTile tl = gdn_tile(F, seq, c, head);
    const char* Wp = (const char*)(sc + SG_W) + (size_t)task * 16384;
    const char* QKp = (const char*)(sc + SG_QK) + (size_t)task * 8192;
    const char* vp = (const char*)(sc + SG_VEC) + (size_t)task * 1024;
    const char* qp = (const char*)tl.q; const char* kp = (const char*)tl.k; const char* up = (const char*)tl.v + (size_t)(vq * 8) * tl.sv * 2;
#pragma unroll
    for (int r = 0; r < 4; ++r) {
        P[r] = *(const u32x4*)(Wp + 4096 * r + o.o16);
        P[4 + r] = *(const u32x4*)(qp + (size_t)(32 * r) * tl.sq + o.q);
        P[8 + r] = *(const u32x4*)(kp + (size_t)(32 * r) * tl.sk + o.k); }
#pragma unroll
    for (int r = 0; r < 2; ++r) P[12 + r] = *(const u32x4*)(QKp + 4096 * r + o.o16);
    P[14] = *(const u32x4*)(up + o.u);
    P[16] = *(const u32x4*)(vp + o.vec);
}
__device__ __forceinline__ void gdn_stage_write(const u32x4 (&P)[17], LAS unsigned char* img, int lt) {
#pragma unroll
    for (int r = 0; r < 4; ++r) { const int k = lt + 256 * r;
        { const int row = k >> 4, ch = k & 15, slot = row * 16 + (ch ^ (row & 15)); *(LAS u32x4*)(img + GL_W + slot * 16) = P[r]; *(LAS u32x4*)(img + GL_Q + slot * 16) = P[4 + r]; }
        { const int row = k >> 3, ch = k & 7; *(LAS u32x4*)(img + GL_KT + (row * 8 + (ch ^ ((row >> 1) & 7))) * 16) = P[8 + r]; } }
#pragma unroll
    for (int r = 0; r < 2; ++r) { const int k = lt + 256 * r, row = k >> 3, ch = k & 7, slot = row * 8 + (ch ^ ((row >> 1) & 7));
        *(LAS u32x4*)(img + GL_QK + slot * 16) = P[12 + r]; if (r == 0) *(LAS u32x4*)(img + GL_U + slot * 16) = P[14]; }
    if (lt < 48) *(LAS u32x4*)(img + GL_VEC + 16 * lt) = P[16];
}
template <bool DRY>
__device__ __forceinline__ void phase_gdn_chain(const Frame& F0, int j) {
    const Frame F = relaunder(F0);
    const unsigned char* sc = (const unsigned char*)F.out;
    const bool loader = (F.wave & 2) != 0, idle = F.wave == 4 || F.wave == 5;
    const int lt = (((F.wave >> 2) << 1) | (F.wave & 1)) * 64 + F.lane, w4 = F.wave & 1;
    for (int sh = F.bid; sh < 640; sh += (F.bid < 128 && F.G > 128) ? 640 : (F.G > 128 ? F.G - 128 : F.G)) {
        const int seq = sh < 128 ? (sh >> 6) : 2 + ((sh - 128) >> 6), head = sh & 7, vq = (sh >> 3) & 7;
        const int nch = seq_chunks(seq);
        __syncthreads();
        if (loader) {
            u32x4 A[17], B[17];
            const GdnLdOff lo = gdn_ld_offsets(lt, gdn_tile(F, seq, 0, head));
            gdn_stage_load(A, F, sc, lo, seq, head, vq, 0); gdn_stage_write(A, F.ldsl, lt);
            if (nch > 1) gdn_stage_load(B, F, sc, lo, seq, head, vq, 1);
            if (nch > 2) gdn_stage_load(A, F, sc, lo, seq, head, vq, 2);
            __syncthreads();
#define GDN_LOADER_STEP(CC, ST) { BUSY_T0(4) const int cc_ = (CC); int nxt = ((cc_ + 1) & 1) * GL_SIZE, lt_ = lt; asm volatile("" : "+s"(nxt), "+v"(lt_)); \
                if (cc_ + 1 < nch) gdn_stage_write(ST, F.ldsl + nxt, lt_); \
                if (cc_ + 3 < nch) gdn_stage_load(ST, F, sc, lo, seq, head, vq, cc_ + 3); \
                BUSY_T1(4, 2) \
                __syncthreads(); }
            for (int c = 0; c < nch; c += 2) {
                GDN_LOADER_STEP(c, B)
                if (c + 1 < nch) GDN_LOADER_STEP(c + 1, A)
            }
#undef GDN_LOADER_STEP
        } else if (idle) {
            __syncthreads();
            for (int c = 0; c < nch; ++c) __syncthreads();
        } else {
            f32x4 S[8];
#pragma unroll
            for (int m8 = 0; m8 < 8; ++m8) S[m8] = (f32x4){0.f, 0.f, 0.f, 0.f};
            if (seq >= 2) {
                const int i = F.lane & 15, g = F.lane >> 4;
                const float* st = F.inp(4) + (((size_t)j * 8 + (seq - 2)) * GDN_HEADS + head) * GDN_DK * GDN_DV + vq * 32 + w4 * 16 + i;
#pragma unroll
                for (int m8 = 0; m8 < 8; ++m8)
#pragma unroll
                    for (int jj = 0; jj < 4; ++jj) S[m8][jj] = st[(size_t)(16 * m8 + 4 * g + jj) * GDN_DV];
            }
            __syncthreads();
            __builtin_amdgcn_s_setprio(2);
            for (int c = 0; c < nch; ++c) {
                BUSY_T0(3) BUSY_T0B(21)
                int cur = (c & 1) * GL_SIZE, lane_ = F.lane;
                asm volatile("" : "+s"(cur), "+v"(lane_));
                LAS unsigned char* img = F.ldsl + cur;
                const int i = lane_ & 15, g = lane_ >> 4, vrow = w4 * 16 + i, vsw = (vrow >> 1) & 7;
                const LAS unsigned char* pw[4]; const LAS unsigned char* pk[2];
#pragma unroll
                for (int kk = 0; kk < 4; ++kk) pw[kk] = img + i * 256 + (((4 * kk + g) ^ i) * 16);
#pragma unroll
                for (int k2 = 0; k2 < 2; ++k2) pk[k2] = img + i * 128 + (((4 * k2 + g) ^ (i >> 1)) * 16);
                const float egl = *(const LAS float*)(img + GL_VEC + 512);
                bf16x8 Sf[4];
#pragma unroll
                for (int kk = 0; kk < 4; ++kk) Sf[kk] = pack8(S[2 * kk], S[2 * kk + 1]);
                LAS unsigned char* urow = img + GL_U + vrow * 128 + 8 * (g & 1);
                f32x4 vn[4], O[4];
                bf16x8 fr[3][4]; u32x2 uw[4];
#define GSB() __builtin_amdgcn_sched_barrier(0)
#define GLD_WQ(SET, M, KH) { _Pragma("unroll") for (int kk = 0; kk < 2; ++kk) { fr[SET][2 * kk] = *(const LAS bf16x8*)(pw[2 * (KH) + kk] + GL_W + (M) * 4096); fr[SET][2 * kk + 1] = *(const LAS bf16x8*)(pw[2 * (KH) + kk] + GL_Q + (M) * 4096); } }
#define GLD_QK(SET, QH) { _Pragma("unroll") for (int q = 0; q < 2; ++q) { _Pragma("unroll") for (int k2 = 0; k2 < 2; ++k2) fr[SET][2 * q + k2] = *(const LAS bf16x8*)(pk[k2] + GL_QK + (2 * (QH) + q) * 2048); } }
#define GLD_KT(SET, H) { _Pragma("unroll") for (int q = 0; q < 2; ++q) { _Pragma("unroll") for (int k2 = 0; k2 < 2; ++k2) fr[SET][2 * q + k2] = *(const LAS bf16x8*)(pk[k2] + GL_KT + (2 * (H) + q) * 2048); } }
#define GMM_WQ(SET, M, KH) { if ((KH) == 0) { O[M] = (f32x4){0.f, 0.f, 0.f, 0.f}; \
                        vn[M][0] = __uint_as_float(uw[M].x << 16); vn[M][1] = __uint_as_float(uw[M].x & 0xffff0000u); vn[M][2] = __uint_as_float(uw[M].y << 16); vn[M][3] = __uint_as_float(uw[M].y & 0xffff0000u); } \
                    _Pragma("unroll") for (int kk = 0; kk < 2; ++kk) { \
                        vn[M] = __builtin_amdgcn_mfma_f32_16x16x32_bf16(fr[SET][2 * kk], Sf[2 * (KH) + kk], vn[M], 0, 0, 0); \
                        O[M] = __builtin_amdgcn_mfma_f32_16x16x32_bf16(fr[SET][2 * kk + 1], Sf[2 * (KH) + kk], O[M], 0, 0, 0); } }
#define GMM_QK(SET, QH) { _Pragma("unroll") for (int k2 = 0; k2 < 2; ++k2) { _Pragma("unroll") for (int q = 0; q < 2; ++q) O[2 * (QH) + q] = __builtin_amdgcn_mfma_f32_16x16x32_bf16(fr[SET][2 * q + k2], Vf[k2], O[2 * (QH) + q], 0, 0, 0); } }
#define GMM_KT(SET, H) { f32x4 ac0 = S[2 * (H)] * egl, ac1 = S[2 * (H) + 1] * egl; \
                    _Pragma("unroll") for (int k2 = 0; k2 < 2; ++k2) { ac0 = __builtin_amdgcn_mfma_f32_16x16x32_bf16(fr[SET][k2], Vf[k2], ac0, 0, 0, 0); ac1 = __builtin_amdgcn_mfma_f32_16x16x32_bf16(fr[SET][2 + k2], Vf[k2], ac1, 0, 0, 0); } \
                    S[2 * (H)] = ac0; S[2 * (H) + 1] = ac1; }
                GLD_WQ(0, 0, 0)
#pragma unroll
                for (int m = 0; m < 4; ++m) uw[m] = *(const LAS u32x2*)(urow + ((2 * m + (g >> 1)) ^ vsw) * 16);
                GLD_WQ(1, 0, 1) GSB();
                BUSY_T1(21, 0) BUSY_T0B(22) GSB();
                GLD_WQ(2, 1, 0) GSB(); GMM_WQ(0, 0, 0) GSB();
                GLD_WQ(0, 1, 1) GSB(); GMM_WQ(1, 0, 1) GSB();
                GLD_WQ(1, 2, 0) GSB(); GMM_WQ(2, 1, 0) GSB();
                GLD_WQ(2, 2, 1) GSB(); GMM_WQ(0, 1, 1) GSB();
                GLD_WQ(0, 3, 0) GSB(); GMM_WQ(1, 2, 0) GSB();
                GLD_WQ(1, 3, 1) GSB(); GMM_WQ(2, 2, 1) GSB();
                GLD_QK(2, 0) GSB(); GMM_WQ(0, 3, 0) GSB();
                GLD_QK(0, 1) GSB(); GMM_WQ(1, 3, 1) GSB();
                bf16x8 Vf[2];
#pragma unroll
                for (int k2 = 0; k2 < 2; ++k2) Vf[k2] = pack8(vn[2 * k2], vn[2 * k2 + 1]);
                GLD_KT(1, 0) GSB(); GMM_QK(2, 0) GSB();
                GLD_KT(2, 1) GSB(); GMM_QK(0, 1) GSB();
                GLD_KT(0, 2) GSB(); GMM_KT(1, 0) GSB();
                GLD_KT(1, 3) GSB(); GMM_KT(2, 1) GSB();
                GMM_KT(0, 2) GSB();
                GMM_KT(1, 3)
                GSB(); BUSY_T1(22, 0) BUSY_T0B(23) GSB();
#undef GMM_QK
#undef GSB
#undef GLD_WQ
#undef GLD_QK
#undef GLD_KT
#undef GMM_WQ
#undef GMM_KT
                {
                    const GTile tl = gdn_tile(F, seq, c, head);
                    bf16_t* orow = gdn_urow(tl, vq * 32 + vrow);
                    u32x2 ow[4];
#pragma unroll
                    for (int m = 0; m < 4; ++m) { ow[m].x = cvt_pk_bf16(O[m][0], O[m][1]); ow[m].y = cvt_pk_bf16(O[m][2], O[m][3]); }
#pragma unroll
                    for (int q = 0; q < 2; ++q) {
                        const u32x2 snd = (g & 1) ? ow[2 * q] : ow[2 * q + 1];
                        u32x2 rcv; rcv.x = __shfl_xor(snd.x, 16); rcv.y = __shfl_xor(snd.y, 16);
                        u32x4 w; int l0;
                        if (g & 1) { w.x = rcv.x; w.y = rcv.y; w.z = ow[2 * q + 1].x; w.w = ow[2 * q + 1].y; l0 = 32 * q + 16 + 4 * (g - 1); }
                        else { w.x = ow[2 * q].x; w.y = ow[2 * q].y; w.z = rcv.x; w.w = rcv.y; l0 = 32 * q + 4 * g; }
                        if (!DRY) *(u32x4*)(orow + l0) = w; else KEEP(w);
                    }
                }
                BUSY_T1(3, 0) BUSY_T1(23, 0) BUSY_T0B(24)
                __syncthreads();
                BUSY_T1(24, 0)
            }
            __builtin_amdgcn_s_setprio(0);
            const int i = F.lane & 15, g = F.lane >> 4, vcol = vq * 32 + w4 * 16 + i;
            float* so = (seq < 2) ? F.out + O_PGDN + (((size_t)j * 2 + seq) * GDN_HEADS + head) * GDN_DK * GDN_DV + vcol
                                  : F.out + O_SGDN + (((size_t)j * 8 + (seq - 2)) * GDN_HEADS + head) * GDN_DK * GDN_DV + vcol;
#pragma unroll
            for (int m8 = 0; m8 < 8; ++m8)
#pragma unroll
                for (int jj = 0; jj < 4; ++jj) { if (!DRY) so[(size_t)(16 * m8 + 4 * g + jj) * GDN_DV] = S[m8][jj]; else KEEP(S[m8][jj]); }
        }
    }
}

template <bool DRY>
__device__ __forceinline__ void phase_gdn_post2(const Frame& F0, int j, bool early) {
    const Frame F = relaunder(F0);
    constexpr int RL = 260;
    bf16_t* OL = (bf16_t*)F.lds;
    const int nwk = early ? F.G - 4 : F.G, ntask = NCHT * 8, tfirst = 256 * 8;
    for (int vt = (early && F.bid >= nwk) ? ntask : F.bid; vt < ntask; vt += nwk) {
        const int task = early ? (vt + tfirst) % ntask : vt;
        const int cgi = task >> 3, head = task & 7; int seq, c; chunk_of(cgi, seq, c);
        const int base = seq_base(seq), t0 = 64 * c - PADF;
        const GTile tl = gdn_tile(F, seq, c, head);
        u32x2 zr[8];
#pragma unroll
        for (int q = 0; q < 8; ++q) { const int l = F.wave + 8 * q, t = t0 + l; const int row = seq < 2 ? seq * TPP + 64 * c + l : base + (t > 0 ? t : 0);
            zr[q] = *(const u32x2*)(F.proj + (size_t)row * LDP + 4096 + head * 256 + 4 * F.lane); }
        __syncthreads();
#pragma unroll
        for (int r = 0; r < 4; ++r) {
            const int k = F.tid + 512 * r, v = k >> 3, ch = k & 7;
            const u32x4 w = *(const u32x4*)(gdn_urow(tl, v) + ch * 8);
            bf16_t* d = OL + (8 * ch) * RL + (v ^ (8 * ((ch >> 1) & 3)));
            d[0] = (bf16_t)w.x; d[RL] = (bf16_t)(w.x >> 16); d[2 * RL] = (bf16_t)w.y; d[3 * RL] = (bf16_t)(w.y >> 16);
            d[4 * RL] = (bf16_t)w.z; d[5 * RL] = (bf16_t)(w.z >> 16); d[6 * RL] = (bf16_t)w.w; d[7 * RL] = (bf16_t)(w.w >> 16);
        }
        __syncthreads();
#pragma unroll
        for (int q = 0; q < 8; ++q) {
            const int l = F.wave + 8 * q, t = t0 + l;
            if (t < 0 && seq >= 2) continue;
            const int row = seq < 2 ? seq * TPP + 64 * c + l : base + t;
            const u32x2 ow = *(const u32x2*)(OL + l * RL + ((4 * F.lane) ^ (8 * ((l >> 4) & 3))));
            const float o0 = __uint_as_float(ow.x << 16), o1 = __uint_as_float(ow.x & 0xffff0000u), o2 = __uint_as_float(ow.y << 16), o3 = __uint_as_float(ow.y & 0xffff0000u);
            float ss = (o0 * o0 + o1 * o1) + (o2 * o2 + o3 * o3);
            ss = wave_sum(ss);
            const float rs = rsqrtf(ss * (1.0f / 256.0f) + EPS);
            const float z0 = __uint_as_float(zr[q].x << 16), z1 = __uint_as_float(zr[q].x & 0xffff0000u), z2 = __uint_as_float(zr[q].y << 16), z3 = __uint_as_float(zr[q].y & 0xffff0000u);
            u32x2 w; w.x = cvt_pk_bf16(o0 * rs * silu_f(z0), o1 * rs * silu_f(z1)); w.y = cvt_pk_bf16(o2 * rs * silu_f(z2), o3 * rs * silu_f(z3));
            if (!DRY) *(u32x2*)(F.proj + (size_t)row * LDP + 4096 + head * 256 + 4 * F.lane) = w; else KEEP(w);
        }
        if (early && task >= tfirst) {
            asm volatile("s_waitcnt vmcnt(0)" ::: "memory");
            __syncthreads();
            if (F.tid == 0) { __builtin_amdgcn_fence(__ATOMIC_RELEASE, "agent"); __hip_atomic_fetch_add((unsigned*)(F.ws + WS_READY) + 8, 1u, __ATOMIC_RELAXED, __HIP_MEMORY_SCOPE_AGENT); }
        }
    }
    for (int e = F.bid * NTHREADS + F.tid; e < NSEQ * 3 * GDN_CONV; e += F.G * NTHREADS) {
        const int s = e / (3 * GDN_CONV), r = (e / GDN_CONV) % 3, c = e % GDN_CONV;
        if (s < 2) F.out[O_PGDNC + (((size_t)j * 2 + s) * 3 + r) * GDN_CONV + c] = bf2f(F.tails[((size_t)(s * 129 + 128) * 3 + r) * 4096 + c]);
        else F.out[O_SGDNC + (((size_t)j * 8 + (s - 2)) * 3 + r) * GDN_CONV + c] = bf2f(F.proj[(size_t)(seq_base(s) + 13 + r) * LDP + c]);
    }
}

__device__ __forceinline__ void phase_final(const Frame& F0) {
    const Frame F = relaunder(F0);
    const float* fw = F.inp(23);
    for (int it = F.bid * 8 + F.wave; it < 2 * SEQ + 128; it += F.G * 8) {
        int row; float* dst;
        if (it < 2 * SEQ) { const int b = it / SEQ, t = it % SEQ; row = b * TPP + 64 + t; dst = F.out + O_YP + (size_t)it * D; }
        else { row = ROW_S0 + (it - 2 * SEQ); dst = F.out + O_YS + (size_t)(it - 2 * SEQ) * D; }
        float x[16]; float ss = 0.f;
#pragma unroll
        for (int i = 0; i < 4; ++i) {
            const u32x2 v = *(const u32x2*)(F.hb + (size_t)row * D + (F.lane + 64 * i) * 4);
            x[4 * i + 0] = __uint_as_float(v.x << 16); x[4 * i + 1] = __uint_as_float(v.x & 0xffff0000u); x[4 * i + 2] = __uint_as_float(v.y << 16); x[4 * i + 3] = __uint_as_float(v.y & 0xffff0000u);
            ss += (x[4 * i] * x[4 * i] + x[4 * i + 1] * x[4 * i + 1]) + (x[4 * i + 2] * x[4 * i + 2] + x[4 * i + 3] * x[4 * i + 3]);
        }
        ss = wave_sum(ss);
        const float rs = rsqrtf(ss * (1.0f / 1024.0f) + EPS);
#pragma unroll
        for (int i = 0; i < 4; ++i) {
            const int c = (F.lane + 64 * i) * 4; const f32x4 w = *(const f32x4*)(fw + c);
            f32x4 o; o[0] = x[4 * i] * rs * w[0]; o[1] = x[4 * i + 1] * rs * w[1]; o[2] = x[4 * i + 2] * rs * w[2]; o[3] = x[4 * i + 3] * rs * w[3];
            *(f32x4*)(dst + c) = o;
        }
    }
}

constexpr int N_PHASES = 26;
__global__ void __launch_bounds__(NTHREADS, 2) hybrid_fwd(Args args) {
    extern __shared__ __attribute__((aligned(16))) unsigned char lds[];
    volatile LAS unsigned* bst = (volatile LAS unsigned*)((LAS unsigned char*)lds + LDS_BYTES - 16);
    if (threadIdx.x < 4) bst[threadIdx.x] = 0u;
    __syncthreads();
    XcdBarrier bar; bar.bar = (unsigned*)(args.ws + WS_CTL); bar.x = 0; bar.st = bst;
    if (args.ph_hi - args.ph_lo > 1) { bar = xcd_barrier_post((unsigned*)(args.ws + WS_CTL), bst); cg::this_grid().sync(); }
    unsigned long long probe_acc = 0ull;
    for (int ph = args.ph_lo; ph < args.ph_hi; ++ph) {
        if (ph > 0 && ph < N_PHASES - 1 && ((ph - 1) % 6) == 3 && ((((ph - 1) / 6) & 1) == 1)) continue;
        const bool probe_this = PROBE_SPAN_SUB >= 0 && ph > 0 && ph < N_PHASES - 1 && ((ph - 1) % 6) == PROBE_SPAN_SUB && ((((ph - 1) / 6) & 1) == PROBE_SPAN_PAR);
        unsigned long long probe_t0 = 0ull; if (probe_this && blockIdx.x == 0) probe_t0 = __builtin_amdgcn_s_memrealtime();
        int tid_ = threadIdx.x; asm volatile("" : "+v"(tid_));
        Frame F;
        F.ap = &args;
        F.out = args.out; F.ws = args.ws; F.lds = lds; F.ldsl = (LAS unsigned char*)lds;
        F.tid = tid_; F.lane = F.tid & 63; F.wave = __builtin_amdgcn_readfirstlane(F.tid >> 6); F.G = gridDim.x; F.bid = blockIdx.x;
        F.hb = nullptr; F.win = nullptr; F.wout = nullptr; F.dtb = nullptr; F.rss = nullptr; F.proj = nullptr; F.tails = nullptr;
        if (ph == 0) { phase_init_h(F); phase_wprep_in(F, 0, 0); }
        else if (ph == N_PHASES - 1) { for (int r = 0; r < REP_FINAL; ++r) phase_final(F); }
        else {
            const int L = (ph - 1) / 6, sub = (ph - 1) % 6, j = L >> 1;
            if (sub == 2) {
                if (L & 1) { for (int r = 1; r < REP_GDN_CHAIN; ++r) phase_gdn_chain<true>(F, j); phase_gdn_chain<false>(F, j); }
                else { for (int r = 1; r < REP_SSD_CHAIN; ++r) phase_ssd_chain<true>(F, j); phase_ssd_chain<false>(F, j); } }
            const bool early3 = (L == 3) && (F.G == 256);
            if (sub == 4) {
                if (L & 1) { for (int r = 1; r < REP_GDN_POST; ++r) phase_gdn_post2<true>(F, j, false); phase_gdn_post2<false>(F, j, early3); }
                else { for (int r = 1; r < REP_SSD_POST; ++r) phase_ssd_post<true>(F, j); phase_ssd_post<false>(F, j); }
                if (L < 3) { for (int r = 0; r < REP_WPREP; ++r) phase_wprep_in(F, L + 1, (NCHT * ((L & 1) ? 8 : 4)) % F.G); } }
            if (sub == 0 || sub == 5 || sub == 2 || (sub == 4 && early3)) {
                if (sub == 5 || (sub == 0 && L >= 1) || sub == 4) phase_outproj(F, (sub == 5 || sub == 4) ? L : L - 1, sub != 5, sub == 4 ? 80u : 0u);
                if (sub == 0 || sub == 2) phase_inproj(F, L, sub == 2);
            }
            else if (sub == 1) {
                if (L & 1) { for (int r = 1; r < REP_GDN_PREP; ++r) phase_gdn_prep<true>(F, j); phase_gdn_prep<false>(F, j); }
                else { for (int r = 1; r < REP_SSD_PREP; ++r) phase_ssd_prep<true>(F, j); phase_ssd_prep<false>(F, j); }
                for (int r = 0; r < REP_WPREP; ++r) phase_wprep_out(F, L, (NCHT * ((L & 1) ? 8 : 4)) % F.G); }
            else if (sub == 3) { if (!(L & 1)) phase_ssd_combine(F, j); }
        }
        if (probe_this && blockIdx.x == 0 && PROBE_SPAN_MODE != 0) { __syncthreads(); const unsigned long long tn = __builtin_amdgcn_s_memrealtime(); if (PROBE_SPAN_MODE == 2) probe_acc += tn - probe_t0; probe_t0 = tn; }
        if (ph + 1 < args.ph_hi) {
            for (int r = 0; r < REP_BARRIER; ++r) xcd_barrier(bar);
        }
        if (probe_this && blockIdx.x == 0 && PROBE_SPAN_MODE != 2) probe_acc += __builtin_amdgcn_s_memrealtime() - probe_t0;
    }
    if (PROBE_BUSY > 0 && blockIdx.x == 0) { __syncthreads(); const unsigned long long acc_ = __hip_atomic_load((unsigned long long*)(args.ws + 49152), __ATOMIC_RELAXED, __HIP_MEMORY_SCOPE_AGENT); const unsigned long long t1 = __builtin_amdgcn_s_memrealtime(); while (__builtin_amdgcn_s_memrealtime() - t1 < acc_ * 8ull) __builtin_amdgcn_s_sleep(16); }
    if (PROBE_SPAN_SUB >= 0 && blockIdx.x == 0) { const unsigned long long t1 = __builtin_amdgcn_s_memrealtime(); while (__builtin_amdgcn_s_memrealtime() - t1 < probe_acc * 8ull) __builtin_amdgcn_s_sleep(16); }
}

extern "C" void kernel_launch(void* const* d_in, const int* in_sizes, int n_in, void* d_out, int out_size, void* d_ws, size_t ws_size, hipStream_t stream) {
    static int grid = 0;
    if (grid == 0) {
        if (n_in != 24 || ws_size < WS_END) { fprintf(stderr, "kernel_launch: unexpected n_in %d / ws %zu (need %zu)\n", n_in, ws_size, (size_t)WS_END); grid = -1; return; }
        int dev = 0, cus = 0, per_cu = 0;
        if (hipGetDevice(&dev) != hipSuccess || hipDeviceGetAttribute(&cus, hipDeviceAttributeMultiprocessorCount, dev) != hipSuccess) { grid = -1; return; }
        if (hipFuncSetAttribute((const void*)hybrid_fwd, hipFuncAttributeMaxDynamicSharedMemorySize, LDS_BYTES) != hipSuccess) { fprintf(stderr, "kernel_launch: hipFuncSetAttribute failed\n"); grid = -1; return; }
        if (hipOccupancyMaxActiveBlocksPerMultiprocessor(&per_cu, (const void*)hybrid_fwd, NTHREADS, LDS_BYTES) != hipSuccess || per_cu < 1) { fprintf(stderr, "kernel_launch: occupancy query says %d blocks per CU\n", per_cu); grid = -1; return; }
        (void)hipGetLastError();
        grid = cus;
    }
    if (grid < 0) return;
    Args a{};
    for (int i = 0; i < 24; ++i) a.in[i] = (const float*)d_in[i];
    a.out = (float*)d_out; a.ws = (unsigned char*)d_ws;
#if MK_ONE_LAUNCH
    (void)hipMemsetAsync((char*)d_ws + WS_CTL, 0, 65536, stream);
    a.ph_lo = 0; a.ph_hi = N_PHASES;
    void* kargs[] = {&a};
    hipError_t e = hipLaunchCooperativeKernel((const void*)hybrid_fwd, dim3(grid), dim3(NTHREADS), kargs, LDS_BYTES, stream);
    if (e != hipSuccess) fprintf(stderr, "kernel_launch: cooperative launch failed: %s (grid %d)\n", hipGetErrorString(e), grid);
#else
    for (int ph = 0; ph < N_PHASES; ++ph) {
        a.ph_lo = ph; a.ph_hi = ph + 1;
        hipLaunchKernelGGL(hybrid_fwd, dim3(grid), dim3(NTHREADS), LDS_BYTES, stream, a);
    }
#endif
}
```
